# Optimizing an MI355X kernel written in HIP

```python
import math
import jax, jax.numpy as jnp
from jax import lax
import numpy as np

D_MODEL = 2048
BATCH = 32
SEQ = 256
DEPTH = 4
DEC_BATCH = 4
DEC_SEQ = 4096
PAST_LEN = 512

GRID_W = 64
POOL_GROUPS = 4
POOL_WIDTH = 1024
POOL_GROUP_DIM = POOL_WIDTH // POOL_GROUPS
POOL_WINDOWS = (2, 4, 8, 16)
DIFF_HEADS = 8
DIFF_QK_DIM = 64
DIFF_V_DIM = 128
DIFF_QK_WIDTH = DIFF_HEADS * 2 * DIFF_QK_DIM
DIFF_WIDTH = DIFF_HEADS * DIFF_V_DIM
NA_HEADS = 8
NA_HEAD_DIM = 128
NA_WIDTH = NA_HEADS * NA_HEAD_DIM
NA_WIN_R = 8
NA_WIN_C = 16
NA_KEY_COLS = 2 * NA_WIN_C
SGU_GROUPS = 4
SGU_WIDTH = 1024
SGU_CHUNK = 128
MIX_WIDTH = POOL_WIDTH + DIFF_WIDTH
EVEN_SPLITS = (POOL_WIDTH, POOL_WIDTH, DIFF_QK_WIDTH, DIFF_QK_WIDTH, DIFF_WIDTH, DIFF_WIDTH)
ODD_SPLITS = (NA_WIDTH, NA_WIDTH, NA_WIDTH, NA_WIDTH, SGU_WIDTH, SGU_WIDTH, SGU_WIDTH)
EVEN_IN = sum(EVEN_SPLITS)
ODD_IN = sum(ODD_SPLITS)
QUERY_BLOCK = 128
ROPE_BASE = 10000.0
ROPE_AXIS_DIM = DIFF_QK_DIM // 2
LN_EPS = 1e-5
NEG_INF = -1e30
DEEPNORM_ALPHA = (2 * DEPTH) ** 0.25
DEEPNORM_BETA = (8 * DEPTH) ** -0.25

kernel_name = "hybrid_diffusion_pool_diffattn_natten_sgu_step"


def split_cols(x, sizes):
    idx = [int(i) for i in np.cumsum(sizes)[:-1]]
    return jnp.split(x, idx, axis=-1)


def layer_norm(x, g, b=None):
    xf = x.astype(jnp.float32)
    mu = jnp.mean(xf, -1, keepdims=True)
    var = jnp.mean(jnp.square(xf - mu), -1, keepdims=True)
    y = ((xf - mu) * lax.rsqrt(var + LN_EPS)).astype(x.dtype) * g
    return y if b is None else y + b


def rms_norm(x, g):
    xf = x.astype(jnp.float32)
    y = xf * lax.rsqrt(jnp.mean(jnp.square(xf), -1, keepdims=True) + LN_EPS)
    return y.astype(x.dtype) * g


def ada_params(cond, w_mod, b_mod):
    m = jax.nn.silu(cond) @ w_mod + b_mod
    return jnp.split(m, 3, axis=-1)


def _rotate(x, ang):
    cos = jnp.cos(ang).astype(x.dtype)
    sin = jnp.sin(ang).astype(x.dtype)
    x1, x2 = jnp.split(x, 2, axis=-1)
    return jnp.concatenate([x1 * cos - x2 * sin, x1 * sin + x2 * cos], axis=-1)


def rope_2d(x):
    L = x.shape[2]
    t = jnp.arange(L)
    row = (t // GRID_W).astype(jnp.float32)[:, None]
    col = (t % GRID_W).astype(jnp.float32)[:, None]
    inv = 1.0 / (ROPE_BASE ** (jnp.arange(0, ROPE_AXIS_DIM, 2, dtype=jnp.float32) / ROPE_AXIS_DIM))
    xr, xc = jnp.split(x, 2, axis=-1)
    return jnp.concatenate([_rotate(xr, row * inv), _rotate(xc, col * inv)], axis=-1)


def map_query_blocks(fn, *qs):
    b, h, L, _ = qs[0].shape
    nb = L // QUERY_BLOCK
    blocks = tuple(jnp.moveaxis(q.reshape(b, h, nb, QUERY_BLOCK, q.shape[-1]), 2, 0) for q in qs)
    out = lax.map(fn, blocks)
    return jnp.moveaxis(out, 0, 2).reshape(b, h, L, out.shape[-1])


def softmax_attention(q, k, v):
    scale = q.shape[-1] ** -0.5

    def block(qs):
        (qb,) = qs
        s = jnp.einsum('bhqd,bhkd->bhqk', qb, k).astype(jnp.float32) * scale
        p = jax.nn.softmax(s, axis=-1).astype(v.dtype)
        return jnp.einsum('bhqk,bhkd->bhqd', p, v)

    return map_query_blocks(block, q)


def diff_attention(q1, q2, k1, k2, v, lam):
    scale = DIFF_QK_DIM ** -0.5

    def block(qs):
        qb1, qb2 = qs
        s1 = jnp.einsum('bhqd,bhkd->bhqk', qb1, k1).astype(jnp.float32) * scale
        s2 = jnp.einsum('bhqd,bhkd->bhqk', qb2, k2).astype(jnp.float32) * scale
        p = jax.nn.softmax(s1, axis=-1) - lam * jax.nn.softmax(s2, axis=-1)
        return jnp.einsum('bhqk,bhkd->bhqd', p.astype(v.dtype), v)

    return map_query_blocks(block, q1, q2)


def _na_column_tables():
    ncb = GRID_W // NA_WIN_C
    blk = np.arange(ncb)
    qcol = blk[:, None] * NA_WIN_C + np.arange(NA_WIN_C)[None, :]
    kstart = np.clip(blk * NA_WIN_C - NA_WIN_C // 2, 0, GRID_W - NA_KEY_COLS)
    kcol = kstart[:, None] + np.arange(NA_KEY_COLS)[None, :]
    cstart = np.clip(qcol - NA_WIN_C // 2, 0, GRID_W - NA_WIN_C)
    valid = (kcol[:, None, :] >= cstart[:, :, None]) & (kcol[:, None, :] < cstart[:, :, None] + NA_WIN_C)
    dc = np.clip(kcol[:, None, :] - qcol[:, :, None] + NA_WIN_C - 1, 0, 2 * NA_WIN_C - 2)
    return kcol, valid, dc


def neighborhood_attention(q, k, v, ck, cv, rpb):
    B, H, L, d = q.shape
    rows = L // GRID_W
    win_r = min(NA_WIN_R, rows)
    ncb = GRID_W // NA_WIN_C
    kcol, valid, dc = _na_column_tables()
    nloc = win_r * NA_KEY_COLS
    kg = k.reshape(B, H, rows, GRID_W, d)
    vg = v.reshape(B, H, rows, GRID_W, v.shape[-1])
    qg = jnp.moveaxis(q.reshape(B, H, rows, ncb, NA_WIN_C, d), 2, 0)
    mask = jnp.asarray(np.broadcast_to(valid[:, :, None, :], (ncb, NA_WIN_C, win_r, NA_KEY_COLS)).reshape(ncb, NA_WIN_C, nloc))
    rpb_cols = rpb[:, :, dc]
    scale = d ** -0.5

    def row_step(args):
        r, qr = args
        rs = jnp.clip(r - win_r // 2, 0, rows - win_r)
        kr = lax.dynamic_slice_in_dim(kg, rs, win_r, axis=2)
        vr = lax.dynamic_slice_in_dim(vg, rs, win_r, axis=2)
        kb = jnp.moveaxis(kr[:, :, :, kcol, :], 2, 3).reshape(B, H, ncb, nloc, d)
        vb = jnp.moveaxis(vr[:, :, :, kcol, :], 2, 3).reshape(B, H, ncb, nloc, vr.shape[-1])
        dr = rs + jnp.arange(win_r) - r + NA_WIN_R - 1
        bias = jnp.transpose(rpb_cols[:, dr], (0, 2, 3, 1, 4)).reshape(H, ncb, NA_WIN_C, nloc)
        s_loc = jnp.einsum('bhnqd,bhnkd->bhnqk', qr, kb).astype(jnp.float32) * scale + bias.astype(jnp.float32)
        s_loc = jnp.where(mask, s_loc, NEG_INF)
        s_ctx = jnp.einsum('bhnqd,bhpd->bhnqp', qr, ck).astype(jnp.float32) * scale
        p = jax.nn.softmax(jnp.concatenate([s_loc, s_ctx], axis=-1), axis=-1).astype(v.dtype)
        return (jnp.einsum('bhnqk,bhnkd->bhnqd', p[..., :nloc], vb)
                + jnp.einsum('bhnqp,bhpd->bhnqd', p[..., nloc:], cv))

    out = lax.map(row_step, (jnp.arange(rows), qg))
    return jnp.moveaxis(out, 0, 2).reshape(B, H, L, out.shape[-1])


def multi_scale_pool(x, w_pool, pool_scale):
    B, L, C = x.shape
    xf = x.reshape(B, L, POOL_GROUPS, POOL_GROUP_DIM).astype(jnp.float32)
    cs = jnp.concatenate([jnp.zeros_like(xf[:, :1]), jnp.cumsum(xf, axis=1)], axis=1)
    t = jnp.arange(L)[:, None]
    half = jnp.asarray(POOL_WINDOWS)[None, :] // 2
    lo = jnp.clip(t - half, 0, L)
    hi = jnp.clip(t + half, 0, L)
    g = jnp.arange(POOL_GROUPS)[None, :]
    win_sum = cs[:, hi, g] - cs[:, lo, g]
    cnt = (hi - lo).astype(jnp.float32)[None, :, :, None]
    pooled = (win_sum / cnt - xf).astype(x.dtype)
    mixed = jnp.einsum('blgc,gcd->blgd', pooled, w_pool)
    return mixed.reshape(B, L, C) * pool_scale


def spatial_gating(u, v, ln_g, w_s, b_s):
    B, L, C = v.shape
    n = L // SGU_CHUNK
    vn = layer_norm(v, ln_g).reshape(B, n, SGU_CHUNK, SGU_GROUPS, C // SGU_GROUPS)
    s = jnp.einsum('gij,bnjgc->bnigc', w_s, vn) + jnp.transpose(b_s)[:, :, None]
    return u * s.reshape(B, L, C)


def even_branch(h, w_in, pool_w, pool_scale, diff_lam, diff_subln, layer_idx, ctx_k=None, ctx_v=None):
    B, L, _ = h.shape
    a_in, a_gate, q, k, v, b_gate = split_cols(h @ w_in, EVEN_SPLITS)
    ya = multi_scale_pool(a_in, pool_w, pool_scale) * jax.nn.silu(a_gate)
    q = q.reshape(B, L, DIFF_HEADS, 2, DIFF_QK_DIM).transpose(0, 2, 1, 3, 4)
    k = k.reshape(B, L, DIFF_HEADS, 2, DIFF_QK_DIM).transpose(0, 2, 1, 3, 4)
    v = v.reshape(B, L, DIFF_HEADS, DIFF_V_DIM).transpose(0, 2, 1, 3)
    q1, q2, k1, k2 = q[:, :, :, 0], q[:, :, :, 1], k[:, :, :, 0], k[:, :, :, 1]
    lam_init = 0.8 - 0.6 * math.exp(-0.3 * layer_idx)
    lam = (jnp.exp(jnp.sum(diff_lam[0] * diff_lam[1]).astype(jnp.float32))
           - jnp.exp(jnp.sum(diff_lam[2] * diff_lam[3]).astype(jnp.float32)) + lam_init)
    if ctx_k is None:
        new_k, new_v = jnp.concatenate([k1, k2], axis=-1), v
        kk1, kk2, vv = k1, k2, v
    else:
        new_k = new_v = None
        q1, q2 = rope_2d(q1), rope_2d(q2)
        kk1 = jnp.concatenate([rope_2d(k1), ctx_k[..., :DIFF_QK_DIM]], axis=2)
        kk2 = jnp.concatenate([rope_2d(k2), ctx_k[..., DIFF_QK_DIM:]], axis=2)
        vv = jnp.concatenate([v, ctx_v], axis=2)
    o = diff_attention(q1, q2, kk1, kk2, vv, lam)
    o = rms_norm(o, diff_subln) * (1.0 - lam_init)
    yb = o.transpose(0, 2, 1, 3).reshape(B, L, DIFF_WIDTH) * jax.nn.silu(b_gate)
    return jnp.concatenate([ya, yb], axis=-1), new_k, new_v


def odd_branch(h, w_in, rpb, sgu_ln, sgu_w, sgu_b, ctx_k=None, ctx_v=None):
    B, L, _ = h.shape
    q, k, v, c_gate, u, vs, d_gate = split_cols(h @ w_in, ODD_SPLITS)
    q, k, v = (t.reshape(B, L, NA_HEADS, NA_HEAD_DIM).transpose(0, 2, 1, 3) for t in (q, k, v))
    if ctx_k is None:
        new_k, new_v = k, v
        o = softmax_attention(q, k, v)
    else:
        new_k = new_v = None
        o = neighborhood_attention(q, k, v, ctx_k, ctx_v, rpb)
    yc = o.transpose(0, 2, 1, 3).reshape(B, L, NA_WIDTH) * jax.nn.silu(c_gate)
    yd = spatial_gating(u, vs, sgu_ln, sgu_w, sgu_b) * jax.nn.silu(d_gate)
    return jnp.concatenate([yc, yd], axis=-1), new_k, new_v


def setup_inputs(seed: int = 0) -> dict:
    key = jax.random.key(seed)
    ks = iter(jax.random.split(key, 64))

    def nrm(shape, s):
        return jax.random.normal(next(ks), shape, jnp.float32) * s

    d = {}
    d["x_prompt"] = nrm((BATCH, SEQ, D_MODEL), 1.0)
    d["x_sample"] = nrm((DEC_BATCH, DEC_SEQ, D_MODEL), 1.0)
    for l in range(DEPTH):
        if l % 2 == 0:
            d[f"cache_k_l{l}"] = nrm((DEC_BATCH, DIFF_HEADS, PAST_LEN, 2 * DIFF_QK_DIM), 1.0)
            d[f"cache_v_l{l}"] = nrm((DEC_BATCH, DIFF_HEADS, PAST_LEN, DIFF_V_DIM), 1.0)
        else:
            d[f"cache_k_l{l}"] = nrm((DEC_BATCH, NA_HEADS, PAST_LEN, NA_HEAD_DIM), 1.0)
            d[f"cache_v_l{l}"] = nrm((DEC_BATCH, NA_HEADS, PAST_LEN, NA_HEAD_DIM), 1.0)
    d["c"] = nrm((DEC_BATCH, D_MODEL), 1.0)
    d["c_ctx"] = nrm((D_MODEL,), 1.0)
    for l in range(DEPTH):
        d[f"w_mod_{l}"] = nrm((D_MODEL, 3 * D_MODEL), 0.5 * D_MODEL ** -0.5)
        d[f"b_mod_{l}"] = nrm((3 * D_MODEL,), 0.01)
        d[f"w_in_{l}"] = nrm((D_MODEL, EVEN_IN if l % 2 == 0 else ODD_IN), D_MODEL ** -0.5)
        d[f"w_out_{l}"] = nrm((MIX_WIDTH, D_MODEL), MIX_WIDTH ** -0.5 * DEEPNORM_BETA)
        d[f"ln_g_{l}"] = 1.0 + nrm((D_MODEL,), 0.01)
        d[f"ln_b_{l}"] = nrm((D_MODEL,), 0.01)
        if l % 2 == 0:
            d[f"pool_w_{l}"] = nrm((POOL_GROUPS, POOL_GROUP_DIM, POOL_GROUP_DIM), POOL_GROUP_DIM ** -0.5)
            d[f"pool_scale_{l}"] = 1.0 + nrm((POOL_WIDTH,), 0.1)
            d[f"diff_lam_{l}"] = nrm((4, DIFF_QK_DIM), 0.1)
            d[f"diff_subln_{l}"] = 1.0 + nrm((DIFF_V_DIM,), 0.01)
        else:
            d[f"rpb_{l}"] = nrm((NA_HEADS, 2 * NA_WIN_R - 1, 2 * NA_WIN_C - 1), 0.1)
            d[f"sgu_ln_{l}"] = 1.0 + nrm((SGU_WIDTH,), 0.01)
            d[f"sgu_w_{l}"] = nrm((SGU_GROUPS, SGU_CHUNK, SGU_CHUNK), SGU_CHUNK ** -0.5)
            d[f"sgu_b_{l}"] = 1.0 + nrm((SGU_GROUPS, SGU_CHUNK), 0.1)
    return d


def reference(x_prompt, x_sample,
              cache_k_l0, cache_v_l0, cache_k_l1, cache_v_l1,
              cache_k_l2, cache_v_l2, cache_k_l3, cache_v_l3,
              c, c_ctx,
              w_mod_0, b_mod_0, w_in_0, w_out_0, ln_g_0, ln_b_0, pool_w_0, pool_scale_0, diff_lam_0, diff_subln_0,
              w_mod_1, b_mod_1, w_in_1, w_out_1, ln_g_1, ln_b_1, rpb_1, sgu_ln_1, sgu_w_1, sgu_b_1,
              w_mod_2, b_mod_2, w_in_2, w_out_2, ln_g_2, ln_b_2, pool_w_2, pool_scale_2, diff_lam_2, diff_subln_2,
              w_mod_3, b_mod_3, w_in_3, w_out_3, ln_g_3, ln_b_3, rpb_3, sgu_ln_3, sgu_w_3, sgu_b_3):
    cache_k = [cache_k_l0, cache_k_l1, cache_k_l2, cache_k_l3]
    cache_v = [cache_v_l0, cache_v_l1, cache_v_l2, cache_v_l3]
    w_mod = [w_mod_0, w_mod_1, w_mod_2, w_mod_3]
    b_mod = [b_mod_0, b_mod_1, b_mod_2, b_mod_3]
    w_in = [w_in_0, w_in_1, w_in_2, w_in_3]
    w_out = [w_out_0, w_out_1, w_out_2, w_out_3]
    ln_g = [ln_g_0, ln_g_1, ln_g_2, ln_g_3]
    ln_b = [ln_b_0, ln_b_1, ln_b_2, ln_b_3]
    even_p = {0: (pool_w_0, pool_scale_0, diff_lam_0, diff_subln_0),
              2: (pool_w_2, pool_scale_2, diff_lam_2, diff_subln_2)}
    odd_p = {1: (rpb_1, sgu_ln_1, sgu_w_1, sgu_b_1),
             3: (rpb_3, sgu_ln_3, sgu_w_3, sgu_b_3)}

    xp, xs = x_prompt, x_sample
    ks, vs = [], []
    for l in range(DEPTH):
        sh_p, sc_p, g_p = ada_params(c_ctx, w_mod[l], b_mod[l])
        sh_s, sc_s, g_s = (m[:, None, :] for m in ada_params(c, w_mod[l], b_mod[l]))
        hp = xp * (1.0 + sc_p) + sh_p
        hs = xs * (1.0 + sc_s) + sh_s
        if l % 2 == 0:
            yp, nk, nv = even_branch(hp, w_in[l], *even_p[l], l)
            ys, _, _ = even_branch(hs, w_in[l], *even_p[l], l, cache_k[l], cache_v[l])
        else:
            yp, nk, nv = odd_branch(hp, w_in[l], *odd_p[l])
            ys, _, _ = odd_branch(hs, w_in[l], *odd_p[l], cache_k[l], cache_v[l])
        xp = layer_norm(DEEPNORM_ALPHA * xp + g_p * (yp @ w_out[l]), ln_g[l], ln_b[l])
        xs = layer_norm(DEEPNORM_ALPHA * xs + g_s * (ys @ w_out[l]), ln_g[l], ln_b[l])
        ks.append(nk)
        vs.append(nv)
    return (xp, xs, ks[0], vs[0], ks[1], vs[1], ks[2], vs[2], ks[3], vs[3])
```

```cpp
#include <hip/hip_runtime.h>
#include <hip/hip_cooperative_groups.h>
#include <cstdio>
namespace cg = cooperative_groups;

#define DI __device__ __forceinline__
typedef unsigned short u16;
typedef unsigned int u32;
using bf16x8 = __attribute__((ext_vector_type(8))) short;
using f32x4 = __attribute__((ext_vector_type(4))) float;
using f32x16 = __attribute__((ext_vector_type(16))) float;
using u32x4 = __attribute__((ext_vector_type(4))) unsigned;
using u32x2 = __attribute__((ext_vector_type(2))) unsigned;
typedef __bf16 bf2_t __attribute__((ext_vector_type(2)));
typedef float f2_t __attribute__((ext_vector_type(2)));

#ifndef MULTI
#define MULTI 0
#endif
#ifndef ZERO_MASK
#define ZERO_MASK 0
#endif

constexpr int T_ALL = 24576, TP = 8192, DM = 2048;
constexpr float LOG2E = 1.4426950408889634f;
constexpr float ALPHA = 1.6817928305074290f;
constexpr float LN_EPS = 1e-5f;
constexpr int LDS_BYTES = 76288;
constexpr int NPHASE = 18;

constexpr size_t SZ_WIN_E = (size_t)6144 * 2048 * 2, SZ_WIN_O = (size_t)7168 * 2048 * 2;
constexpr size_t WS_WINT = 0;
constexpr size_t WS_WOUTT = WS_WINT + 2 * SZ_WIN_E + 2 * SZ_WIN_O;
constexpr size_t WS_POOLWT = WS_WOUTT + (size_t)4 * 2048 * 2048 * 2;
constexpr size_t WS_SGUW = WS_POOLWT + (size_t)2 * 4 * 256 * 256 * 2;
constexpr size_t WS_CK = WS_SGUW + (size_t)2 * 4 * 128 * 128 * 2;
constexpr size_t WS_CVT = WS_CK + (size_t)4 * 4194304;
constexpr size_t WS_MOD = WS_CVT + (size_t)4 * 4194304;
constexpr size_t WS_ROPE = WS_MOD + (size_t)4 * 5 * 6144 * 4;
constexpr size_t WS_H = WS_ROPE + 8192;
constexpr size_t WS_PROJ = WS_H + (size_t)T_ALL * 2048 * 2;
constexpr size_t WS_VT = WS_PROJ + (size_t)T_ALL * 7168 * 2;
constexpr size_t WS_END = WS_VT + (size_t)T_ALL * 1024 * 2;

struct Params {
  const float* in[52];
  float* out;
  unsigned char* ws;
  int ph_lo, ph_hi;
};

DI size_t ws_wint(int l) { return WS_WINT + (size_t)(l >> 1) * (SZ_WIN_E + SZ_WIN_O) + ((l & 1) ? SZ_WIN_E : 0); }

DI u32 pk2(float a, float b) { f2_t v = {a, b}; bf2_t r = __builtin_convertvector(v, bf2_t); return __builtin_bit_cast(u32, r); }
DI float bflo(u32 w) { return __uint_as_float(w << 16); }
DI float bfhi(u32 w) { return __uint_as_float(w & 0xffff0000u); }
DI float bf1(u16 w) { return __uint_as_float(((u32)w) << 16); }
DI float ex2(float x) { return __builtin_amdgcn_exp2f(x); }
DI float silu(float x) { return x / (1.f + __expf(-x)); }
DI f32x4 mfma16(bf16x8 a, bf16x8 b, f32x4 c) { return __builtin_amdgcn_mfma_f32_16x16x32_bf16(a, b, c, 0, 0, 0); }
DI f32x16 mfma32(bf16x8 a, bf16x8 b, f32x16 c) { return __builtin_amdgcn_mfma_f32_32x32x16_bf16(a, b, c, 0, 0, 0); }
DI bf16x8 ld8(const u16* p) { return *reinterpret_cast<const bf16x8*>(p); }
DI int opq(int x) { asm volatile("" : "+v"(x)); return x; }
#define TIDX opq((int)threadIdx.x)

DI void tr_tile(const float* __restrict__ src, size_t ld_src, u16* __restrict__ dst, size_t ld_dst, float* sT) {
  const int tid = TIDX;
  const int r = tid >> 4, c4 = (tid & 15) * 4;
#pragma unroll
  for (int i = 0; i < 4; ++i) {
    float4 v = *reinterpret_cast<const float4*>(src + (size_t)(r + 16 * i) * ld_src + c4);
    float* d = sT + (r + 16 * i) * 65 + c4;
    d[0] = v.x; d[1] = v.y; d[2] = v.z; d[3] = v.w;
  }
  __syncthreads();
  const int n = tid >> 2, ks = (tid & 3) * 16;
  u32 w[8];
#pragma unroll
  for (int j = 0; j < 8; ++j) w[j] = pk2(sT[(ks + 2 * j) * 65 + n], sT[(ks + 2 * j + 1) * 65 + n]);
  u32x4* o = reinterpret_cast<u32x4*>(dst + (size_t)n * ld_dst + ks);
  o[0] = u32x4{w[0], w[1], w[2], w[3]};
  o[1] = u32x4{w[4], w[5], w[6], w[7]};
  __syncthreads();
}

DI void cvt8(const float* __restrict__ src, u16* __restrict__ dst) {
  float4 a = *reinterpret_cast<const float4*>(src);
  float4 b = *reinterpret_cast<const float4*>(src + 4);
  *reinterpret_cast<u32x4*>(dst) = u32x4{pk2(a.x, a.y), pk2(a.z, a.w), pk2(b.x, b.y), pk2(b.z, b.w)};
}

DI void mod_item(const Params& p, int i, unsigned char* lds) {
  const int tid = TIDX;
  const int l = i / 96, n0 = (i % 96) * 64;
  float* sS = reinterpret_cast<float*>(lds);
  float* red = sS + 5 * 2048;
  const float* c = p.in[10];
  const float* cctx = p.in[11];
  for (int e = tid; e < 5 * 2048; e += 256) {
    int v = e >> 11, k = e & 2047;
    float x = (v == 0) ? cctx[k] : c[(v - 1) * 2048 + k];
    sS[e] = silu(x);
  }
  __syncthreads();
  const int kk = tid >> 4, c4 = (tid & 15) * 4;
  const float* W = p.in[12 + 10 * l] + n0 + c4;
  f32x4 acc[5];
#pragma unroll
  for (int v = 0; v < 5; ++v) acc[v] = f32x4{0.f, 0.f, 0.f, 0.f};
#pragma unroll 8
  for (int k = kk; k < 2048; k += 16) {
    float4 w = *reinterpret_cast<const float4*>(W + (size_t)k * 6144);
#pragma unroll
    for (int v = 0; v < 5; ++v) {
      float s = sS[v * 2048 + k];
      acc[v][0] += s * w.x; acc[v][1] += s * w.y; acc[v][2] += s * w.z; acc[v][3] += s * w.w;
    }
  }
#pragma unroll
  for (int v = 0; v < 5; ++v)
#pragma unroll
    for (int q = 0; q < 4; ++q) red[(kk * 5 + v) * 64 + c4 + q] = acc[v][q];
  __syncthreads();
  for (int t2 = tid; t2 < 320; t2 += 256) {
    int v = t2 >> 6, n = t2 & 63;
    float s = 0.f;
#pragma unroll
    for (int k2 = 0; k2 < 16; ++k2) s += red[(k2 * 5 + v) * 64 + n];
    float* mod = reinterpret_cast<float*>(p.ws + WS_MOD);
    mod[(size_t)(l * 5 + v) * 6144 + n0 + n] = s + p.in[13 + 10 * l][n0 + n];
  }
  __syncthreads();
}

DI void phase_prep(const Params& p, unsigned char* lds) {
  constexpr int N_MOD = 384, N_TRWIN = 13312, N_TRWOUT = 4096, N_TRPOOL = 128, N_SGU = 64, N_CK = 4096, N_CV = 2048;
  constexpr int TOTAL = N_MOD + N_TRWIN + N_TRWOUT + N_TRPOOL + N_SGU + N_CK + N_CV + 1;
  const int tid = TIDX;
  float* sT = reinterpret_cast<float*>(lds);
  for (int it = blockIdx.x; it < TOTAL; it += gridDim.x) {
    int i = it;
    if (i < N_MOD) { mod_item(p, i, lds); continue; }
    i -= N_MOD;
    if (i < N_TRWIN) {
      int l, base;
      if (i < 3072) { l = 0; base = 0; } else if (i < 6656) { l = 1; base = 3072; } else if (i < 9728) { l = 2; base = 6656; } else { l = 3; base = 9728; }
      i -= base;
      const int N = (l & 1) ? 7168 : 6144, nN = N / 64;
      const int kt = i / nN, nt = i % nN;
      tr_tile(p.in[14 + 10 * l] + (size_t)kt * 64 * N + nt * 64, N,
              reinterpret_cast<u16*>(p.ws + ws_wint(l)) + (size_t)nt * 64 * 2048 + kt * 64, 2048, sT);
      continue;
    }
    i -= N_TRWIN;
    if (i < N_TRWOUT) {
      const int l = i >> 10, r = i & 1023, kt = r >> 5, nt = r & 31;
      tr_tile(p.in[15 + 10 * l] + (size_t)kt * 64 * 2048 + nt * 64, 2048,
              reinterpret_cast<u16*>(p.ws + WS_WOUTT) + (size_t)l * 2048 * 2048 + (size_t)nt * 64 * 2048 + kt * 64, 2048, sT);
      continue;
    }
    i -= N_TRWOUT;
    if (i < N_TRPOOL) {
      const int e = i >> 6, r = i & 63, g = r >> 4, t = r & 15, kt = t >> 2, nt = t & 3;
      tr_tile(p.in[18 + 20 * e] + (size_t)g * 65536 + kt * 64 * 256 + nt * 64, 256,
              reinterpret_cast<u16*>(p.ws + WS_POOLWT) + (size_t)e * 262144 + g * 65536 + nt * 64 * 256 + kt * 64, 256, sT);
      continue;
    }
    i -= N_TRPOOL;
    if (i < N_SGU) {
      const int e = i >> 5, ch = i & 31;
      const size_t off = (size_t)ch * 2048 + tid * 8;
      cvt8(p.in[30 + 20 * e] + off, reinterpret_cast<u16*>(p.ws + WS_SGUW) + (size_t)e * 65536 + off);
      continue;
    }
    i -= N_SGU;
    if (i < N_CK) {
      const int l = i >> 10, ch = i & 1023;
      const size_t off = (size_t)ch * 2048 + tid * 8;
      cvt8(p.in[2 + 2 * l] + off, reinterpret_cast<u16*>(p.ws + WS_CK) + (size_t)l * 2097152 + off);
      continue;
    }
    i -= N_CK;
    if (i < N_CV) {
      const int l = i >> 9, r = i & 511, bh = r >> 4, t = r & 15, kt = t >> 1, nt = t & 1;
      tr_tile(p.in[3 + 2 * l] + (size_t)bh * 65536 + kt * 64 * 128 + nt * 64, 128,
              reinterpret_cast<u16*>(p.ws + WS_CVT) + (size_t)l * 2097152 + (size_t)bh * 65536 + nt * 64 * 512 + kt * 64, 512, sT);
      continue;
    }
    {
      float* rc = reinterpret_cast<float*>(p.ws + WS_ROPE);
      for (int e = tid; e < 1024; e += 256) {
        int pos = e >> 4, fi = e & 15;
        float inv = 1.0f / powf(10000.0f, (float)(2 * fi) / 32.0f);
        float ang = (float)pos * inv;
        rc[e] = cosf(ang);
        rc[1024 + e] = sinf(ang);
      }
    }
  }
}

DI void phase_mod0(const Params& p) {
  const int tid = TIDX;
  const float* mod = reinterpret_cast<const float*>(p.ws + WS_MOD);
  u16* H = reinterpret_cast<u16*>(p.ws + WS_H);
  for (int it = blockIdx.x; it < T_ALL / 4; it += gridDim.x) {
#pragma unroll
    for (int rr = 0; rr < 4; ++rr) {
      const int row = it * 4 + rr;
      const int cond = row < TP ? 0 : 1 + ((row - TP) >> 12);
      const float* src = row < TP ? p.in[0] + (size_t)row * 2048 : p.in[1] + (size_t)(row - TP) * 2048;
      const int e = tid * 8;
      const float* sh = mod + (size_t)cond * 6144 + e;
      float4 a = *reinterpret_cast<const float4*>(src + e), b = *reinterpret_cast<const float4*>(src + e + 4);
      float4 s0 = *reinterpret_cast<const float4*>(sh), s1 = *reinterpret_cast<const float4*>(sh + 4);
      float4 c0 = *reinterpret_cast<const float4*>(sh + 2048), c1 = *reinterpret_cast<const float4*>(sh + 2052);
      u32x4 o = {pk2(a.x * (1.f + c0.x) + s0.x, a.y * (1.f + c0.y) + s0.y), pk2(a.z * (1.f + c0.z) + s0.z, a.w * (1.f + c0.w) + s0.w),
                 pk2(b.x * (1.f + c1.x) + s1.x, b.y * (1.f + c1.y) + s1.y), pk2(b.z * (1.f + c1.z) + s1.z, b.w * (1.f + c1.w) + s1.w)};
      *reinterpret_cast<u32x4*>(H + (size_t)row * 2048 + e) = o;
    }
  }
}

enum { G_IN_EVEN = 0, G_IN_ODD = 1, G_OUT = 2 };

template <int MODE>
DI void gemm_phase(const Params& p, int l, unsigned char* lds) {
  constexpr int K = 2048;
  constexpr int N = (MODE == G_OUT) ? 2048 : (MODE == G_IN_EVEN ? 6144 : 7168);
  constexpr int NC = (MODE == G_IN_EVEN) ? 6144 : 7168;
  constexpr int nTn = N / 128;
  constexpr int TOTAL = nTn * 192;
  const u16* A = reinterpret_cast<const u16*>(p.ws + WS_H);
  const u16* Bt = (MODE == G_OUT) ? reinterpret_cast<const u16*>(p.ws + WS_WOUTT) + (size_t)l * 2048 * 2048
                                  : reinterpret_cast<const u16*>(p.ws + ws_wint(l));
  u16* sA = reinterpret_cast<u16*>(lds);
  u16* sB = sA + 2 * 128 * 72;
  const int tid = TIDX, lane = tid & 63, wid = tid >> 6;
  const int wr = wid >> 1, wc = wid & 1, fr = lane & 15, fq = lane >> 4;
  const int lrow = tid >> 3, lkc = (tid & 7) * 8;
  u16* PROJ = reinterpret_cast<u16*>(p.ws + WS_PROJ);
  u16* VT = reinterpret_cast<u16*>(p.ws + WS_VT);
  const float* mod = reinterpret_cast<const float*>(p.ws + WS_MOD);
  const float* ropeC = reinterpret_cast<const float*>(p.ws + WS_ROPE);
  const float* ropeS = ropeC + 1024;

  for (int it = blockIdx.x; it < TOTAL; it += gridDim.x) {
    const int grp = it / (16 * nTn), rem = it % (16 * nTn);
    const int tn = rem >> 4, tm = grp * 16 + (rem & 15);
    const u16* ga = A + (size_t)(tm * 128 + lrow) * K + lkc;
    const u16* gb = Bt + (size_t)(tn * 128 + lrow) * K + lkc;
    f32x4 acc[4][4];
#pragma unroll
    for (int a = 0; a < 4; ++a)
#pragma unroll
      for (int b = 0; b < 4; ++b) acc[a][b] = f32x4{0.f, 0.f, 0.f, 0.f};
    u32x4 ra[4], rb[4];
#pragma unroll
    for (int i = 0; i < 4; ++i) {
      ra[i] = *reinterpret_cast<const u32x4*>(ga + (size_t)i * 32 * K);
      rb[i] = *reinterpret_cast<const u32x4*>(gb + (size_t)i * 32 * K);
    }
#pragma unroll
    for (int i = 0; i < 4; ++i) {
      *reinterpret_cast<u32x4*>(sA + (lrow + 32 * i) * 72 + lkc) = ra[i];
      *reinterpret_cast<u32x4*>(sB + (lrow + 32 * i) * 72 + lkc) = rb[i];
    }
    __syncthreads();
    for (int kt = 0; kt < K / 64; ++kt) {
      const int buf = kt & 1;
      if (kt + 1 < K / 64) {
#pragma unroll
        for (int i = 0; i < 4; ++i) {
          ra[i] = *reinterpret_cast<const u32x4*>(ga + (size_t)i * 32 * K + (kt + 1) * 64);
          rb[i] = *reinterpret_cast<const u32x4*>(gb + (size_t)i * 32 * K + (kt + 1) * 64);
        }
      }
      const u16* cA = sA + buf * 128 * 72 + (wr * 64 + fr) * 72 + fq * 8;
      const u16* cB = sB + buf * 128 * 72 + (wc * 64 + fr) * 72 + fq * 8;
#pragma unroll
      for (int ks = 0; ks < 2; ++ks) {
        bf16x8 af[4], bfr[4];
#pragma unroll
        for (int m = 0; m < 4; ++m) af[m] = ld8(cA + m * 16 * 72 + ks * 32);
#pragma unroll
        for (int n = 0; n < 4; ++n) bfr[n] = ld8(cB + n * 16 * 72 + ks * 32);
#pragma unroll
        for (int m = 0; m < 4; ++m)
#pragma unroll
          for (int n = 0; n < 4; ++n) acc[m][n] = mfma16(af[m], bfr[n], acc[m][n]);
      }
      if (kt + 1 < K / 64) {
        const int nb = buf ^ 1;
#pragma unroll
        for (int i = 0; i < 4; ++i) {
          *reinterpret_cast<u32x4*>(sA + nb * 128 * 72 + (lrow + 32 * i) * 72 + lkc) = ra[i];
          *reinterpret_cast<u32x4*>(sB + nb * 128 * 72 + (lrow + 32 * i) * 72 + lkc) = rb[i];
        }
      }
      __syncthreads();
    }
    const int rowb = tm * 128 + wr * 64 + fq * 4;
    const int colb = tn * 128 + wc * 64 + fr;
    const bool prompt = tm < 64;
    if (MODE == G_OUT) {
      const int cond = prompt ? 0 : 1 + ((tm * 128 - TP) >> 12);
      const float* gate = mod + (size_t)(l * 5 + cond) * 6144 + 4096;
      float* X = p.out;
#pragma unroll
      for (int n = 0; n < 4; ++n) {
        const int col = colb + n * 16;
        const float g = gate[col];
#pragma unroll
        for (int m = 0; m < 4; ++m)
#pragma unroll
          for (int j = 0; j < 4; ++j) {
            const int row = rowb + m * 16 + j;
            float xo;
            if (l == 0) xo = prompt ? p.in[0][(size_t)row * 2048 + col] : p.in[1][(size_t)(row - TP) * 2048 + col];
            else xo = X[(size_t)row * 2048 + col];
            X[(size_t)row * 2048 + col] = ALPHA * xo + g * acc[m][n][j];
          }
      }
    } else {
      const int sec = tn >> 3;
      const int SEC_Q = (MODE == G_IN_EVEN) ? 2 : 0, SEC_K = (MODE == G_IN_EVEN) ? 3 : 1, SEC_V = (MODE == G_IN_EVEN) ? 4 : 2;
      if (sec == SEC_V) {
        const int hh = tn & 7;
        float* vout = p.out + (size_t)T_ALL * 2048 + (size_t)(2 * l + 1) * 8388608;
#pragma unroll
        for (int m = 0; m < 4; ++m) {
          const int row = rowb + m * 16;
#pragma unroll
          for (int n = 0; n < 4; ++n) {
            const int dv = wc * 64 + n * 16 + fr;
            u32x2 w = {pk2(acc[m][n][0], acc[m][n][1]), pk2(acc[m][n][2], acc[m][n][3])};
            if (prompt) {
              const int b = row >> 8, t = row & 255;
              *reinterpret_cast<u32x2*>(VT + ((size_t)((b * 8 + hh) * 128 + dv)) * 256 + t) = w;
#pragma unroll
              for (int j = 0; j < 4; ++j) vout[((size_t)((b * 8 + hh) * 256 + t + j)) * 128 + dv] = acc[m][n][j];
            } else {
              const int rs = row - TP, b = rs >> 12, t = rs & 4095;
              *reinterpret_cast<u32x2*>(VT + 8388608 + ((size_t)((b * 8 + hh) * 128 + dv)) * 4096 + t) = w;
            }
          }
        }
      } else {
        const bool isq = sec == SEC_Q, isk = sec == SEC_K;
        const bool rope = (MODE == G_IN_EVEN) && (isq || isk) && !prompt;
        const float qs = (MODE == G_IN_EVEN) ? 0.125f * LOG2E : 0.08838834764831845f * LOG2E;
        if (isk && prompt) {
          const int hh = tn & 7;
          float* kout = p.out + (size_t)T_ALL * 2048 + (size_t)(2 * l) * 8388608;
#pragma unroll
          for (int m = 0; m < 4; ++m)
#pragma unroll
            for (int n = 0; n < 4; ++n) {
              const int d = wc * 64 + n * 16 + fr;
#pragma unroll
              for (int j = 0; j < 4; ++j) {
                const int row = rowb + m * 16 + j, b = row >> 8, t = row & 255;
                kout[((size_t)((b * 8 + hh) * 256 + t)) * 128 + d] = acc[m][n][j];
              }
            }
        }
        if (rope) {
#pragma unroll
          for (int m = 0; m < 4; ++m)
#pragma unroll
            for (int j = 0; j < 4; ++j) {
              const int t = (rowb + m * 16 + j - TP) & 4095;
              const int pr = t >> 6, pc = t & 63;
#pragma unroll
              for (int ax = 0; ax < 2; ++ax) {
                const int pos = ax ? pc : pr;
                const float cs = ropeC[pos * 16 + fr], sn = ropeS[pos * 16 + fr];
                const float x1 = acc[m][2 * ax][j], x2 = acc[m][2 * ax + 1][j];
                acc[m][2 * ax][j] = x1 * cs - x2 * sn;
                acc[m][2 * ax + 1][j] = x1 * sn + x2 * cs;
              }
            }
        }
#pragma unroll
        for (int m = 0; m < 4; ++m)
#pragma unroll
          for (int n = 0; n < 4; ++n)
#pragma unroll
            for (int j = 0; j < 4; ++j) {
              float v = acc[m][n][j];
              if (isq) v *= qs;
              const int row = rowb + m * 16 + j, col = colb + n * 16;
              PROJ[(size_t)row * NC + col] = (u16)(pk2(v, 0.f) & 0xffffu);
            }
      }
    }
  }
}

DI void phase_ln(const Params& p, int l) {
  const int tid_ = TIDX, lane = tid_ & 63, wid = tid_ >> 6;
  const float* g = p.in[16 + 10 * l];
  const float* bb = p.in[17 + 10 * l];
  const float* mod = reinterpret_cast<const float*>(p.ws + WS_MOD);
  u16* H = reinterpret_cast<u16*>(p.ws + WS_H);
  float* X = p.out;
  for (int it = blockIdx.x; it < T_ALL / 4; it += gridDim.x) {
    const int row = it * 4 + wid;
    float* xr = X + (size_t)row * 2048;
    float4 v[8];
    float s = 0.f;
#pragma unroll
    for (int i = 0; i < 8; ++i) {
      v[i] = *reinterpret_cast<const float4*>(xr + (i * 64 + lane) * 4);
      s += v[i].x + v[i].y + v[i].z + v[i].w;
    }
#pragma unroll
    for (int o = 32; o >= 1; o >>= 1) s += __shfl_xor(s, o);
    const float mu = s * (1.f / 2048.f);
    float ss = 0.f;
#pragma unroll
    for (int i = 0; i < 8; ++i) {
      float a = v[i].x - mu, b = v[i].y - mu, c = v[i].z - mu, d = v[i].w - mu;
      ss += a * a + b * b + c * c + d * d;
    }
#pragma unroll
    for (int o = 32; o >= 1; o >>= 1) ss += __shfl_xor(ss, o);
    const float rstd = rsqrtf(ss * (1.f / 2048.f) + LN_EPS);
    const int cond = row < TP ? 0 : 1 + ((row - TP) >> 12);
    const float* sh = mod + (size_t)((l + 1) * 5 + cond) * 6144;
#pragma unroll
    for (int i = 0; i < 8; ++i) {
      const int e = (i * 64 + lane) * 4;
      float4 gg = *reinterpret_cast<const float4*>(g + e), b4 = *reinterpret_cast<const float4*>(bb + e);
      float4 y;
      y.x = (v[i].x - mu) * rstd * gg.x + b4.x; y.y = (v[i].y - mu) * rstd * gg.y + b4.y;
      y.z = (v[i].z - mu) * rstd * gg.z + b4.z; y.w = (v[i].w - mu) * rstd * gg.w + b4.w;
      *reinterpret_cast<float4*>(xr + e) = y;
      if (l < 3) {
        float4 s0 = *reinterpret_cast<const float4*>(sh + e), c0 = *reinterpret_cast<const float4*>(sh + 2048 + e);
        u32x2 o = {pk2(y.x * (1.f + c0.x) + s0.x, y.y * (1.f + c0.y) + s0.y), pk2(y.z * (1.f + c0.z) + s0.z, y.w * (1.f + c0.w) + s0.w)};
        *reinterpret_cast<u32x2*>(H + (size_t)row * 2048 + e) = o;
      }
    }
  }
}

struct AttnSrc {
  const u16* k0; const u16* vt0; int ks0, vs0, n0;
  const u16* k1; const u16* vt1; int ks1, vs1, n1;
};

template <int DQK>
DI void attn_ldg(const AttnSrc& s, int j, u32x4 (&rk)[DQK / 32], u32x4 (&rv)[4]) {
  const u16* kb; const u16* vb; int ks, vs;
  if (j < s.n0) { kb = s.k0 + (size_t)j * 64 * s.ks0; vb = s.vt0 + j * 64; ks = s.ks0; vs = s.vs0; }
  else { const int jj = j - s.n0; kb = s.k1 + (size_t)jj * 64 * s.ks1; vb = s.vt1 + jj * 64; ks = s.ks1; vs = s.vs1; }
  constexpr int CPR = DQK / 8;
  const int tid = TIDX;
#pragma unroll
  for (int i = 0; i < DQK / 32; ++i) {
    const int c = tid + 256 * i, row = c / CPR, kc = c % CPR;
    rk[i] = *reinterpret_cast<const u32x4*>(kb + (size_t)row * ks + kc * 8);
  }
#pragma unroll
  for (int i = 0; i < 4; ++i) {
    const int c = tid + 256 * i, row = c >> 3, kc = c & 7;
    rv[i] = *reinterpret_cast<const u32x4*>(vb + (size_t)row * vs + kc * 8);
  }
}
template <int DQK>
DI void attn_sts(u16* sK, u16* sVT, const u32x4 (&rk)[DQK / 32], const u32x4 (&rv)[4]) {
  constexpr int CPR = DQK / 8;
  const int tid = TIDX;
#pragma unroll
  for (int i = 0; i < DQK / 32; ++i) {
    const int c = tid + 256 * i, row = c / CPR, kc = c % CPR;
    *reinterpret_cast<u32x4*>(sK + row * (DQK + 8) + kc * 8) = rk[i];
  }
#pragma unroll
  for (int i = 0; i < 4; ++i) {
    const int c = tid + 256 * i, row = c >> 3, kc = c & 7;
    *reinterpret_cast<u32x4*>(sVT + row * 72 + kc * 8) = rv[i];
  }
}

template <int DQK, bool NA>
DI void attn_run(const AttnSrc& src, const u16* qblk, int qstride, u16* sQ, u16* sK, u16* sVT, f32x16 (&O)[4], float& l_out,
                 int qr, int qc, int rsmin, const float* sBias) {
  const int tid = TIDX, lane = tid & 63, wid = tid >> 6;
  const int r = lane & 31, h = lane >> 5;
  const int pr = (r & 0x13) | ((r & 4) << 1) | ((r & 8) >> 1);
  constexpr int CPR = DQK / 8, QS = DQK + 8;
  __syncthreads();
#pragma unroll
  for (int i = 0; i < DQK / 16; ++i) {
    const int c = tid + 256 * i, row = c / CPR, kc = c % CPR;
    *reinterpret_cast<u32x4*>(sQ + row * QS + kc * 8) = *reinterpret_cast<const u32x4*>(qblk + (size_t)row * qstride + kc * 8);
  }
#pragma unroll
  for (int d = 0; d < 4; ++d)
#pragma unroll
    for (int i = 0; i < 16; ++i) O[d][i] = 0.f;
  float m = -1e30f, l = 0.f;
  const int nt = src.n0 + src.n1;
  const int rsq = min(max(qr - 4, 0), 56);
  const int cs = min(max(qc - 8, 0), 48);
  const u16* qw = sQ + (wid * 32 + r) * QS + 8 * h;
  const u16* kw = sK + pr * QS + 8 * h;
  const u16* vw = sVT + r * 72 + 8 * h;
#pragma unroll 1
  for (int j = 0; j < nt; ++j) {
    {
      u32x4 rk[DQK / 32], rv[4];
      attn_ldg<DQK>(src, j, rk, rv);
      if (j > 0) __syncthreads();
      attn_sts<DQK>(sK, sVT, rk, rv);
    }
    __syncthreads();
    bool active = true;
    int kr = 0;
    if (NA && j >= src.n0) { kr = rsmin + (j - src.n0); active = (kr >= rsq) && (kr < rsq + 8); }
    if (active) {
      f32x16 s[2];
#pragma unroll
      for (int t = 0; t < 2; ++t) {
#pragma unroll
        for (int i = 0; i < 16; ++i) s[t][i] = 0.f;
#pragma unroll
        for (int ks = 0; ks < DQK / 16; ++ks) {
          bf16x8 a = ld8(kw + t * 32 * QS + ks * 16);
          bf16x8 q = ld8(qw + ks * 16);
          s[t] = mfma32(a, q, s[t]);
        }
      }
      if (NA && j >= src.n0) {
        const float* bp = sBias + (kr - qr + 7) * 31 + (8 * h - qc + 15);
        const int kb = 8 * h - cs;
#pragma unroll
        for (int t = 0; t < 2; ++t)
#pragma unroll
          for (int i = 0; i < 16; ++i) {
            const int ko = t * 32 + 16 * (i >> 3) + (i & 7);
            const bool ok = (unsigned)(ko + kb) < 16u;
            const float bv = bp[ko];
            s[t][i] = ok ? s[t][i] + bv : -1e30f;
          }
      }
      float mx = -1e30f;
#pragma unroll
      for (int t = 0; t < 2; ++t)
#pragma unroll
        for (int i = 0; i < 16; ++i) mx = fmaxf(mx, s[t][i]);
      mx = fmaxf(mx, __shfl_xor(mx, 32));
      const float mn = fmaxf(m, mx);
      const float alpha = ex2(m - mn);
      float rsum = 0.f;
#pragma unroll
      for (int t = 0; t < 2; ++t)
#pragma unroll
        for (int i = 0; i < 16; ++i) { const float e = ex2(s[t][i] - mn); s[t][i] = e; rsum += e; }
      rsum += __shfl_xor(rsum, 32);
      l = l * alpha + rsum;
      m = mn;
#pragma unroll
      for (int d = 0; d < 4; ++d)
#pragma unroll
        for (int i = 0; i < 16; ++i) O[d][i] *= alpha;
#pragma unroll
      for (int s4 = 0; s4 < 4; ++s4) {
        const int t = s4 >> 1, b0 = (s4 & 1) * 8;
        u32x4 w = {pk2(s[t][b0], s[t][b0 + 1]), pk2(s[t][b0 + 2], s[t][b0 + 3]), pk2(s[t][b0 + 4], s[t][b0 + 5]), pk2(s[t][b0 + 6], s[t][b0 + 7])};
        const bf16x8 pf = __builtin_bit_cast(bf16x8, w);
#pragma unroll
        for (int d = 0; d < 4; ++d) {
          bf16x8 a = ld8(vw + d * 32 * 72 + s4 * 16);
          O[d] = mfma32(a, pf, O[d]);
        }
      }
    }
  }
  l_out = l;
}

DI void heavy_map(int it, int& bh, int& qb) { const int x = it & 7, idx = it >> 3; bh = x + 8 * (idx >> 5); qb = idx & 31; }

DI void diff_item(const Params& p, int l, bool sample, int bh, int qb, unsigned char* lds) {
  constexpr int NC = 6144;
  const int tid_ = TIDX, lane = tid_ & 63, wid = tid_ >> 6, r = lane & 31, h = lane >> 5;
  const int b = bh >> 3, hd = bh & 7;
  u16* sQ = reinterpret_cast<u16*>(lds);
  u16* sK = sQ + 128 * 136;
  u16* sVT = sK + 64 * 136;
  const u16* PROJ = reinterpret_cast<const u16*>(p.ws + WS_PROJ);
  const u16* VT = reinterpret_cast<const u16*>(p.ws + WS_VT);
  const int seq0 = sample ? TP + b * 4096 : b * 256;
  const int token = seq0 + qb * 128 + wid * 32 + r;
  const float* dl = p.in[20 + 10 * l];
  float pa = dl[lane] * dl[64 + lane], pb = dl[128 + lane] * dl[192 + lane];
#pragma unroll
  for (int o = 32; o >= 1; o >>= 1) { pa += __shfl_xor(pa, o); pb += __shfl_xor(pb, o); }
  const float lam_init = 0.8f - 0.6f * __expf(-0.3f * (float)l);
  const float lam = __expf(pa) - __expf(pb) + lam_init;

  u32 o1p[32];
  f32x16 O[4];
  float lsum;
#pragma unroll
  for (int comp = 0; comp < 2; ++comp) {
    AttnSrc s;
    if (sample) {
      s.k0 = reinterpret_cast<const u16*>(p.ws + WS_CK) + (size_t)l * 2097152 + (size_t)bh * 65536 + comp * 64; s.ks0 = 128;
      s.vt0 = reinterpret_cast<const u16*>(p.ws + WS_CVT) + (size_t)l * 2097152 + (size_t)bh * 65536; s.vs0 = 512; s.n0 = 8;
      s.k1 = PROJ + (size_t)seq0 * NC + 3072 + hd * 128 + comp * 64; s.ks1 = NC;
      s.vt1 = VT + 8388608 + (size_t)bh * 128 * 4096; s.vs1 = 4096; s.n1 = 64;
    } else {
      s.k0 = nullptr; s.vt0 = nullptr; s.ks0 = 0; s.vs0 = 0; s.n0 = 0;
      s.k1 = PROJ + (size_t)seq0 * NC + 3072 + hd * 128 + comp * 64; s.ks1 = NC;
      s.vt1 = VT + (size_t)bh * 128 * 256; s.vs1 = 256; s.n1 = 4;
    }
    const u16* qblk = PROJ + (size_t)(seq0 + qb * 128) * NC + 2048 + hd * 128 + comp * 64;
    attn_run<64, false>(s, qblk, NC, sQ, sK, sVT, O, lsum, 0, 0, 0, nullptr);
    const float inv = 1.f / lsum;
    if (comp == 0) {
#pragma unroll
      for (int d = 0; d < 4; ++d)
#pragma unroll
        for (int i = 0; i < 8; ++i) o1p[d * 8 + i] = pk2(O[d][2 * i] * inv, O[d][2 * i + 1] * inv);
    } else {
      float ssq = 0.f;
#pragma unroll
      for (int d = 0; d < 4; ++d)
#pragma unroll
        for (int i = 0; i < 8; ++i) {
          const u32 w = o1p[d * 8 + i];
          const float a = bflo(w) - lam * O[d][2 * i] * inv, c = bfhi(w) - lam * O[d][2 * i + 1] * inv;
          O[d][2 * i] = a; O[d][2 * i + 1] = c;
          ssq += a * a + c * c;
        }
      ssq += __shfl_xor(ssq, 32);
      const float rn = rsqrtf(ssq * (1.f / 128.f) + LN_EPS) * (1.f - lam_init);
      const float* subln = p.in[21 + 10 * l];
      const u16* gp = PROJ + (size_t)token * NC + 5120 + hd * 128;
      u16* yp = reinterpret_cast<u16*>(p.ws + WS_H) + (size_t)token * 2048 + 1024 + hd * 128;
#pragma unroll
      for (int d = 0; d < 4; ++d)
#pragma unroll
        for (int q = 0; q < 4; ++q) {
          const int dv = d * 32 + 8 * q + 4 * h;
          const u32x2 gw = *reinterpret_cast<const u32x2*>(gp + dv);
          const float4 sl = *reinterpret_cast<const float4*>(subln + dv);
          const float y0 = O[d][4 * q] * rn * sl.x * silu(bflo(gw[0]));
          const float y1 = O[d][4 * q + 1] * rn * sl.y * silu(bfhi(gw[0]));
          const float y2 = O[d][4 * q + 2] * rn * sl.z * silu(bflo(gw[1]));
          const float y3 = O[d][4 * q + 3] * rn * sl.w * silu(bfhi(gw[1]));
          *reinterpret_cast<u32x2*>(yp + dv) = (ZERO_MASK & 2) ? u32x2{0u, 0u} : u32x2{pk2(y0, y1), pk2(y2, y3)};
        }
    }
  }
}

DI void pool_item(const Params& p, int l, int pi, unsigned char* lds) {
  constexpr int NC = 6144;
  const int tid = TIDX, lane = tid & 63, wid = tid >> 6, fr = lane & 15, fq = lane >> 4;
  const int tb = pi >> 2, g = pi & 3, row0 = tb * 64;
  const int L = row0 < TP ? 256 : 4096;
  const int t0 = row0 < TP ? (row0 & 255) : ((row0 - TP) & 4095);
  u16* sIn = reinterpret_cast<u16*>(lds);
  u16* sP = sIn + 80 * 264;
  const u16* PROJ = reinterpret_cast<const u16*>(p.ws + WS_PROJ);
  __syncthreads();
#pragma unroll
  for (int i = 0; i < 10; ++i) {
    const int c = tid + 256 * i, rr = c >> 5, oc = c & 31;
    const int t = t0 - 8 + rr;
    u32x4 v = {0u, 0u, 0u, 0u};
    if (t >= 0 && t < L) v = *reinterpret_cast<const u32x4*>(PROJ + (size_t)(row0 - 8 + rr) * NC + g * 256 + oc * 8);
    *reinterpret_cast<u32x4*>(sIn + rr * 264 + oc * 8) = v;
  }
  __syncthreads();
  {
    const int oc = tid & 31, seg = tid >> 5;
    const int half = 1 << g;
#pragma unroll 1
    for (int tt = 0; tt < 8; ++tt) {
      const int tl = seg * 8 + tt, t = t0 + tl;
      const int lo = max(t - half, 0), hi = min(t + half, L);
      float a[8];
#pragma unroll
      for (int k = 0; k < 8; ++k) a[k] = 0.f;
      for (int s = lo; s < hi; ++s) {
        const u32x4 v = *reinterpret_cast<const u32x4*>(sIn + (s - t0 + 8) * 264 + oc * 8);
#pragma unroll
        for (int k = 0; k < 4; ++k) { a[2 * k] += bflo(v[k]); a[2 * k + 1] += bfhi(v[k]); }
      }
      const float ic = 1.f / (float)(hi - lo);
      const u32x4 x = *reinterpret_cast<const u32x4*>(sIn + (tl + 8) * 264 + oc * 8);
      u32x4 o;
#pragma unroll
      for (int k = 0; k < 4; ++k) o[k] = pk2(a[2 * k] * ic - bflo(x[k]), a[2 * k + 1] * ic - bfhi(x[k]));
      *reinterpret_cast<u32x4*>(sP + tl * 264 + oc * 8) = o;
    }
  }
  __syncthreads();
  const u16* W = reinterpret_cast<const u16*>(p.ws + WS_POOLWT) + (size_t)(l >> 1) * 262144 + (size_t)g * 65536;
  f32x4 acc[4][4];
#pragma unroll
  for (int a = 0; a < 4; ++a)
#pragma unroll
    for (int b = 0; b < 4; ++b) acc[a][b] = f32x4{0.f, 0.f, 0.f, 0.f};
#pragma unroll 2
  for (int ks = 0; ks < 8; ++ks) {
    bf16x8 af[4], bfr[4];
#pragma unroll
    for (int m = 0; m < 4; ++m) af[m] = ld8(sP + (m * 16 + fr) * 264 + ks * 32 + fq * 8);
#pragma unroll
    for (int n = 0; n < 4; ++n) bfr[n] = ld8(W + (size_t)(wid * 64 + n * 16 + fr) * 256 + ks * 32 + fq * 8);
#pragma unroll
    for (int m = 0; m < 4; ++m)
#pragma unroll
      for (int n = 0; n < 4; ++n) acc[m][n] = mfma16(af[m], bfr[n], acc[m][n]);
  }
  const float* pscale = p.in[19 + 10 * l];
  u16* Y = reinterpret_cast<u16*>(p.ws + WS_H);
#pragma unroll
  for (int n = 0; n < 4; ++n) {
    const int col = g * 256 + wid * 64 + n * 16 + fr;
    const float sc = pscale[col];
#pragma unroll
    for (int m = 0; m < 4; ++m)
#pragma unroll
      for (int j = 0; j < 4; ++j) {
        const int row = row0 + m * 16 + fq * 4 + j;
        const float gt = bf1(PROJ[(size_t)row * NC + 1024 + col]);
        float y = acc[m][n][j] * sc * silu(gt);
        if (ZERO_MASK & 1) y = 0.f;
        Y[(size_t)row * 2048 + col] = (u16)(pk2(y, 0.f) & 0xffffu);
      }
  }
}

DI void phase_mix_even(const Params& p, int l, unsigned char* lds) {
#pragma unroll 1
  for (int it = blockIdx.x; it < 1024; it += gridDim.x) { int bh, qb; heavy_map(it, bh, qb); diff_item(p, l, true, bh, qb, lds); }
#pragma unroll 1
  for (int it = blockIdx.x; it < 512; it += gridDim.x) diff_item(p, l, false, it >> 1, it & 1, lds);
#pragma unroll 1
  for (int it = blockIdx.x; it < 1536; it += gridDim.x) pool_item(p, l, it, lds);
}

DI void na_item(const Params& p, int l, bool sample, int bh, int qb, unsigned char* lds) {
  constexpr int NC = 7168;
  const int tid = TIDX, lane = tid & 63, wid = tid >> 6, r = lane & 31, h = lane >> 5;
  const int b = bh >> 3, hd = bh & 7;
  u16* sQ = reinterpret_cast<u16*>(lds);
  u16* sK = sQ + 128 * 136;
  u16* sVT = sK + 64 * 136;
  float* sBias = reinterpret_cast<float*>(sVT + 128 * 72) + 64;
  const u16* PROJ = reinterpret_cast<const u16*>(p.ws + WS_PROJ);
  const u16* VT = reinterpret_cast<const u16*>(p.ws + WS_VT);
  const int seq0 = sample ? TP + b * 4096 : b * 256;
  const int token = seq0 + qb * 128 + wid * 32 + r;
  AttnSrc s;
  int qr = 0, qc = 0, rsmin = 0;
  f32x16 O[4];
  float lsum;
  const u16* qblk = PROJ + (size_t)(seq0 + qb * 128) * NC + hd * 128;
  if (sample) {
    __syncthreads();
    const float* rpb = p.in[18 + 10 * l] + hd * 465;
    for (int e = tid; e < 465; e += 256) sBias[e] = rpb[e] * LOG2E;
    const int r0 = qb * 2;
    qr = r0 + (wid >> 1); qc = (wid & 1) * 32 + r;
    rsmin = min(max(r0 - 4, 0), 56);
    const int rs1 = min(max(r0 - 3, 0), 56);
    s.k0 = reinterpret_cast<const u16*>(p.ws + WS_CK) + (size_t)l * 2097152 + (size_t)bh * 65536; s.ks0 = 128;
    s.vt0 = reinterpret_cast<const u16*>(p.ws + WS_CVT) + (size_t)l * 2097152 + (size_t)bh * 65536; s.vs0 = 512; s.n0 = 8;
    s.k1 = PROJ + (size_t)(seq0 + rsmin * 64) * NC + 1024 + hd * 128; s.ks1 = NC;
    s.vt1 = VT + 8388608 + (size_t)bh * 128 * 4096 + rsmin * 64; s.vs1 = 4096; s.n1 = rs1 + 8 - rsmin;
    attn_run<128, true>(s, qblk, NC, sQ, sK, sVT, O, lsum, qr, qc, rsmin, sBias);
  } else {
    s.k0 = nullptr; s.vt0 = nullptr; s.ks0 = 0; s.vs0 = 0; s.n0 = 0;
    s.k1 = PROJ + (size_t)seq0 * NC + 1024 + hd * 128; s.ks1 = NC;
    s.vt1 = VT + (size_t)bh * 128 * 256; s.vs1 = 256; s.n1 = 4;
    attn_run<128, false>(s, qblk, NC, sQ, sK, sVT, O, lsum, 0, 0, 0, nullptr);
  }
  const float inv = 1.f / lsum;
  const u16* gp = PROJ + (size_t)token * NC + 3072 + hd * 128;
  u16* yp = reinterpret_cast<u16*>(p.ws + WS_H) + (size_t)token * 2048 + hd * 128;
#pragma unroll
  for (int d = 0; d < 4; ++d)
#pragma unroll
    for (int q = 0; q < 4; ++q) {
      const int dv = d * 32 + 8 * q + 4 * h;
      const u32x2 gw = *reinterpret_cast<const u32x2*>(gp + dv);
      const float y0 = O[d][4 * q] * inv * silu(bflo(gw[0]));
      const float y1 = O[d][4 * q + 1] * inv * silu(bfhi(gw[0]));
      const float y2 = O[d][4 * q + 2] * inv * silu(bflo(gw[1]));
      const float y3 = O[d][4 * q + 3] * inv * silu(bfhi(gw[1]));
      *reinterpret_cast<u32x2*>(yp + dv) = (ZERO_MASK & 4) ? u32x2{0u, 0u} : u32x2{pk2(y0, y1), pk2(y2, y3)};
    }
}

DI void sgu_item(const Params& p, int l, int si, unsigned char* lds) {
  constexpr int NC = 7168;
  const int tid = TIDX, lane = tid & 63, wid = tid >> 6, fr = lane & 15, fq = lane >> 4;
  const int ch = si >> 2, g = si & 3, row0 = ch * 128;
  u16* vnT = reinterpret_cast<u16*>(lds);
  float* sMu = reinterpret_cast<float*>(vnT + 256 * 136);
  float* sRs = sMu + 128;
  const u16* PROJ = reinterpret_cast<const u16*>(p.ws + WS_PROJ);
  __syncthreads();
  {
    const int grp = tid >> 4, ln = tid & 15;
#pragma unroll 1
    for (int rr = 0; rr < 8; ++rr) {
      const u16* src = PROJ + (size_t)(row0 + grp * 8 + rr) * NC + 5120;
      float s = 0.f, ss = 0.f;
#pragma unroll
      for (int c8 = 0; c8 < 8; ++c8) {
        const u32x4 v = *reinterpret_cast<const u32x4*>(src + (ln + 16 * c8) * 8);
#pragma unroll
        for (int k = 0; k < 4; ++k) { const float a = bflo(v[k]), b = bfhi(v[k]); s += a + b; ss += a * a + b * b; }
      }
#pragma unroll
      for (int o = 8; o >= 1; o >>= 1) { s += __shfl_xor(s, o); ss += __shfl_xor(ss, o); }
      const float mu = s * (1.f / 1024.f);
      const float var = fmaxf(ss * (1.f / 1024.f) - mu * mu, 0.f);
      if (ln == 0) { sMu[grp * 8 + rr] = mu; sRs[grp * 8 + rr] = rsqrtf(var + LN_EPS); }
    }
  }
  __syncthreads();
  {
    const int j = tid & 127, hf = tid >> 7;
    const float mu = sMu[j], rs = sRs[j];
    const float* lng = p.in[19 + 10 * l] + g * 256;
    const u16* src = PROJ + (size_t)(row0 + j) * NC + 5120 + g * 256;
#pragma unroll 1
    for (int oc = hf * 16; oc < hf * 16 + 16; ++oc) {
      const u32x4 v = *reinterpret_cast<const u32x4*>(src + oc * 8);
      const float4 g0 = *reinterpret_cast<const float4*>(lng + oc * 8), g1 = *reinterpret_cast<const float4*>(lng + oc * 8 + 4);
      const float gg[8] = {g0.x, g0.y, g0.z, g0.w, g1.x, g1.y, g1.z, g1.w};
#pragma unroll
      for (int k = 0; k < 4; ++k) {
        const float a = (bflo(v[k]) - mu) * rs * gg[2 * k], b = (bfhi(v[k]) - mu) * rs * gg[2 * k + 1];
        const u32 w = pk2(a, b);
        vnT[(oc * 8 + 2 * k) * 136 + j] = (u16)(w & 0xffffu);
        vnT[(oc * 8 + 2 * k + 1) * 136 + j] = (u16)(w >> 16);
      }
    }
  }
  __syncthreads();
  const u16* W = reinterpret_cast<const u16*>(p.ws + WS_SGUW) + (size_t)(l >> 1) * 65536 + (size_t)g * 16384;
  const float* bs = p.in[21 + 10 * l] + g * 128;
  u16* Y = reinterpret_cast<u16*>(p.ws + WS_H);
#pragma unroll 1
  for (int ih = 0; ih < 2; ++ih) {
    f32x4 acc[4][4];
#pragma unroll
    for (int a = 0; a < 4; ++a)
#pragma unroll
      for (int b = 0; b < 4; ++b) acc[a][b] = f32x4{0.f, 0.f, 0.f, 0.f};
#pragma unroll
    for (int ks = 0; ks < 4; ++ks) {
      bf16x8 af[4], bfr[4];
#pragma unroll
      for (int m = 0; m < 4; ++m) af[m] = ld8(W + (size_t)(ih * 64 + m * 16 + fr) * 128 + ks * 32 + fq * 8);
#pragma unroll
      for (int n = 0; n < 4; ++n) bfr[n] = ld8(vnT + (wid * 64 + n * 16 + fr) * 136 + ks * 32 + fq * 8);
#pragma unroll
      for (int m = 0; m < 4; ++m)
#pragma unroll
        for (int n = 0; n < 4; ++n) acc[m][n] = mfma16(af[m], bfr[n], acc[m][n]);
    }
#pragma unroll
    for (int m = 0; m < 4; ++m)
#pragma unroll
      for (int j = 0; j < 4; ++j) {
        const int ii = ih * 64 + m * 16 + fq * 4 + j;
        const float bias = bs[ii];
        const size_t rb = (size_t)(row0 + ii) * NC;
#pragma unroll
        for (int n = 0; n < 4; ++n) {
          const int c = g * 256 + wid * 64 + n * 16 + fr;
          const float u = bf1(PROJ[rb + 4096 + c]), dg = bf1(PROJ[rb + 6144 + c]);
          float y = u * (acc[m][n][j] + bias) * silu(dg);
          if (ZERO_MASK & 8) y = 0.f;
          Y[(size_t)(row0 + ii) * 2048 + 1024 + c] = (u16)(pk2(y, 0.f) & 0xffffu);
        }
      }
  }
}

DI void phase_mix_odd(const Params& p, int l, unsigned char* lds) {
#pragma unroll 1
  for (int it = blockIdx.x; it < 1024; it += gridDim.x) { int bh, qb; heavy_map(it, bh, qb); na_item(p, l, true, bh, qb, lds); }
#pragma unroll 1
  for (int it = blockIdx.x; it < 512; it += gridDim.x) na_item(p, l, false, it >> 1, it & 1, lds);
#pragma unroll 1
  for (int it = blockIdx.x; it < 768; it += gridDim.x) sgu_item(p, l, it, lds);
}

__global__ void __launch_bounds__(256, 2) fwd_megakernel(Params p) {
  extern __shared__ __attribute__((aligned(16))) unsigned char lds[];
  cg::grid_group grid = cg::this_grid();
  for (int ph = p.ph_lo; ph < p.ph_hi; ++ph) {
    if (ph == 0) phase_prep(p, lds);
    else if (ph == 1) phase_mod0(p);
    else {
      const int l = (ph - 2) >> 2, s = (ph - 2) & 3;
      if (s == 0) { if (l & 1) gemm_phase<G_IN_ODD>(p, l, lds); else gemm_phase<G_IN_EVEN>(p, l, lds); }
      else if (s == 1) { if (l & 1) phase_mix_odd(p, l, lds); else phase_mix_even(p, l, lds); }
      else if (s == 2) gemm_phase<G_OUT>(p, l, lds);
      else phase_ln(p, l);
    }
    if (ph + 1 < p.ph_hi) {
      __builtin_amdgcn_fence(__ATOMIC_RELEASE, "agent");
      grid.sync();
      __builtin_amdgcn_fence(__ATOMIC_ACQUIRE, "agent");
    }
  }
}

extern "C" void kernel_launch(void* const* d_in, const int* in_sizes, int n_in, void* d_out, int out_size, void* d_ws, size_t ws_size,
                              hipStream_t stream) {
  static int grid_blocks = 0;
  if (grid_blocks == 0) {
    if (n_in != 52 || ws_size < WS_END) {
      fprintf(stderr, "kernel_launch: expected 52 inputs and >= %zu bytes of workspace; got %d, %zu\n", (size_t)WS_END, n_in, ws_size);
      grid_blocks = -1;
      return;
    }
    int dev = 0, cus = 0, per_cu = 0;
    hipGetDevice(&dev);
    hipDeviceGetAttribute(&cus, hipDeviceAttributeMultiprocessorCount, dev);
    hipFuncSetAttribute((const void*)fwd_megakernel, hipFuncAttributeMaxDynamicSharedMemorySize, LDS_BYTES);
    hipOccupancyMaxActiveBlocksPerMultiprocessor(&per_cu, (const void*)fwd_megakernel, 256, LDS_BYTES);
    if (per_cu < 1) per_cu = 1;
    if (per_cu > 2) per_cu = 2;
    grid_blocks = cus * per_cu;
  }
  if (grid_blocks < 0) return;
  Params p{};
  for (int i = 0; i < 52; ++i) p.in[i] = (const float*)d_in[i];
  p.out = (float*)d_out;
  p.ws = (unsigned char*)d_ws;
#if MULTI
  for (int ph = 0; ph < NPHASE; ++ph) {
    p.ph_lo = ph; p.ph_hi = ph + 1;
    hipLaunchKernelGGL(fwd_megakernel, dim3(grid_blocks), dim3(256), LDS_BYTES, stream, p);
  }
#else
  p.ph_lo = 0; p.ph_hi = NPHASE;
  void* args[] = {&p};
  hipError_t e = hipLaunchCooperativeKernel((const void*)fwd_megakernel, dim3(grid_blocks), dim3(256), args, LDS_BYTES, stream);
  if (e != hipSuccess) fprintf(stderr, "cooperative launch failed: %s (grid %d)\n", hipGetErrorString(e), grid_blocks);
#endif
}
```

```cpp
#include <hip/hip_runtime.h>
#include <hip/hip_cooperative_groups.h>
#include <cstdio>
namespace cg = cooperative_groups;

#define DI __device__ __forceinline__
typedef unsigned short u16;
typedef unsigned int u32;
using bf16x8 = __attribute__((ext_vector_type(8))) short;
using f32x4 = __attribute__((ext_vector_type(4))) float;
using f32x16 = __attribute__((ext_vector_type(16))) float;
using u32x4 = __attribute__((ext_vector_type(4))) unsigned;
using u32x2 = __attribute__((ext_vector_type(2))) unsigned;
typedef __bf16 bf2_t __attribute__((ext_vector_type(2)));
typedef float f2_t __attribute__((ext_vector_type(2)));

#ifndef MULTI
#define MULTI 0
#endif
#ifndef REP0
#define REP0 1
#endif
#ifndef REP1
#define REP1 1
#endif
#ifndef ZERO_MASK
#define ZERO_MASK 0
#endif

constexpr int T_ALL = 24576, TP = 8192, DM = 2048;
constexpr float LOG2E = 1.4426950408889634f;
constexpr float ALPHA = 1.6817928305074290f;
constexpr float LN_EPS = 1e-5f;
constexpr int LDS_BYTES = 76288;
constexpr int NPHASE = 18;

constexpr size_t SZ_WIN_E = (size_t)6144 * 2048 * 2, SZ_WIN_O = (size_t)7168 * 2048 * 2;
constexpr size_t WS_WINT = 0;
constexpr size_t WS_WOUTT = WS_WINT + 2 * SZ_WIN_E + 2 * SZ_WIN_O;
constexpr size_t WS_POOLWT = WS_WOUTT + (size_t)4 * 2048 * 2048 * 2;
constexpr size_t WS_SGUW = WS_POOLWT + (size_t)2 * 4 * 256 * 256 * 2;
constexpr size_t WS_CK = WS_SGUW + (size_t)2 * 4 * 128 * 128 * 2;
constexpr size_t WS_CVT = WS_CK + (size_t)4 * 4194304;
constexpr size_t WS_MOD = WS_CVT + (size_t)4 * 4194304;
constexpr size_t WS_ROPE = WS_MOD + (size_t)4 * 5 * 6144 * 4;
constexpr size_t WS_H = WS_ROPE + 8192;
constexpr size_t WS_PROJ = WS_H + (size_t)T_ALL * 2048 * 2;
constexpr size_t WS_VT = WS_PROJ + (size_t)T_ALL * 7168 * 2;
constexpr size_t WS_END = WS_VT + (size_t)T_ALL * 1024 * 2;

struct Params {
  const float* in[52];
  float* out;
  unsigned char* ws;
  int ph_lo, ph_hi;
};

DI size_t ws_wint(int l) { return WS_WINT + (size_t)(l >> 1) * (SZ_WIN_E + SZ_WIN_O) + ((l & 1) ? SZ_WIN_E : 0); }

DI u32 pk2(float a, float b) { f2_t v = {a, b}; bf2_t r = __builtin_convertvector(v, bf2_t); return __builtin_bit_cast(u32, r); }
DI float bflo(u32 w) { return __uint_as_float(w << 16); }
DI float bfhi(u32 w) { return __uint_as_float(w & 0xffff0000u); }
DI float bf1(u16 w) { return __uint_as_float(((u32)w) << 16); }
DI float ex2(float x) { return __builtin_amdgcn_exp2f(x); }
DI float silu(float x) { return x / (1.f + __expf(-x)); }
DI f32x4 mfma16(bf16x8 a, bf16x8 b, f32x4 c) { return __builtin_amdgcn_mfma_f32_16x16x32_bf16(a, b, c, 0, 0, 0); }
DI f32x16 mfma32(bf16x8 a, bf16x8 b, f32x16 c) { return __builtin_amdgcn_mfma_f32_32x32x16_bf16(a, b, c, 0, 0, 0); }
DI bf16x8 ld8(const u16* p) { return *reinterpret_cast<const bf16x8*>(p); }
DI int opq(int x) { asm volatile("" : "+v"(x)); return x; }
#define TIDX opq((int)threadIdx.x)

DI void tr_tile(const float* __restrict__ src, size_t ld_src, u16* __restrict__ dst, size_t ld_dst, float* sT) {
  const int tid = TIDX;
  const int r = tid >> 4, c4 = (tid & 15) * 4;
#pragma unroll
  for (int i = 0; i < 4; ++i) {
    float4 v = *reinterpret_cast<const float4*>(src + (size_t)(r + 16 * i) * ld_src + c4);
    float* d = sT + (r + 16 * i) * 65 + c4;
    d[0] = v.x; d[1] = v.y; d[2] = v.z; d[3] = v.w;
  }
  __syncthreads();
  const int n = tid >> 2, ks = (tid & 3) * 16;
  u32 w[8];
#pragma unroll
  for (int j = 0; j < 8; ++j) w[j] = pk2(sT[(ks + 2 * j) * 65 + n], sT[(ks + 2 * j + 1) * 65 + n]);
  u32x4* o = reinterpret_cast<u32x4*>(dst + (size_t)n * ld_dst + ks);
  o[0] = u32x4{w[0], w[1], w[2], w[3]};
  o[1] = u32x4{w[4], w[5], w[6], w[7]};
  __syncthreads();
}

DI void cvt8(const float* __restrict__ src, u16* __restrict__ dst) {
  float4 a = *reinterpret_cast<const float4*>(src);
  float4 b = *reinterpret_cast<const float4*>(src + 4);
  *reinterpret_cast<u32x4*>(dst) = u32x4{pk2(a.x, a.y), pk2(a.z, a.w), pk2(b.x, b.y), pk2(b.z, b.w)};
}

DI void mod_item(const Params& p, int i, unsigned char* lds) {
  const int tid = TIDX;
  const int l = i / 96, n0 = (i % 96) * 64;
  float* sS = reinterpret_cast<float*>(lds);
  float* red = sS + 5 * 2048;
  const float* c = p.in[10];
  const float* cctx = p.in[11];
  for (int e = tid; e < 5 * 2048; e += 256) {
    int v = e >> 11, k = e & 2047;
    float x = (v == 0) ? cctx[k] : c[(v - 1) * 2048 + k];
    sS[e] = silu(x);
  }
  __syncthreads();
  const int kk = tid >> 4, c4 = (tid & 15) * 4;
  const float* W = p.in[12 + 10 * l] + n0 + c4;
  f32x4 acc[5];
#pragma unroll
  for (int v = 0; v < 5; ++v) acc[v] = f32x4{0.f, 0.f, 0.f, 0.f};
#pragma unroll 8
  for (int k = kk; k < 2048; k += 16) {
    float4 w = *reinterpret_cast<const float4*>(W + (size_t)k * 6144);
#pragma unroll
    for (int v = 0; v < 5; ++v) {
      float s = sS[v * 2048 + k];
      acc[v][0] += s * w.x; acc[v][1] += s * w.y; acc[v][2] += s * w.z; acc[v][3] += s * w.w;
    }
  }
#pragma unroll
  for (int v = 0; v < 5; ++v)
#pragma unroll
    for (int q = 0; q < 4; ++q) red[(kk * 5 + v) * 64 + c4 + q] = acc[v][q];
  __syncthreads();
  for (int t2 = tid; t2 < 320; t2 += 256) {
    int v = t2 >> 6, n = t2 & 63;
    float s = 0.f;
#pragma unroll
    for (int k2 = 0; k2 < 16; ++k2) s += red[(k2 * 5 + v) * 64 + n];
    float* mod = reinterpret_cast<float*>(p.ws + WS_MOD);
    mod[(size_t)(l * 5 + v) * 6144 + n0 + n] = s + p.in[13 + 10 * l][n0 + n];
  }
  __syncthreads();
}

DI void phase_prep(const Params& p, unsigned char* lds) {
  constexpr int N_MOD = 384, N_TRWIN = 13312, N_TRWOUT = 4096, N_TRPOOL = 128, N_SGU = 64, N_CK = 4096, N_CV = 2048;
  constexpr int TOTAL = N_MOD + N_TRWIN + N_TRWOUT + N_TRPOOL + N_SGU + N_CK + N_CV + 1;
  const int tid = TIDX;
  float* sT = reinterpret_cast<float*>(lds);
  for (int it = blockIdx.x; it < TOTAL; it += gridDim.x) {
    int i = it;
    if (i < N_MOD) { mod_item(p, i, lds); continue; }
    i -= N_MOD;
    if (i < N_TRWIN) {
      int l, base;
      if (i < 3072) { l = 0; base = 0; } else if (i < 6656) { l = 1; base = 3072; } else if (i < 9728) { l = 2; base = 6656; } else { l = 3; base = 9728; }
      i -= base;
      const int N = (l & 1) ? 7168 : 6144, nN = N / 64;
      const int kt = i / nN, nt = i % nN;
      tr_tile(p.in[14 + 10 * l] + (size_t)kt * 64 * N + nt * 64, N,
              reinterpret_cast<u16*>(p.ws + ws_wint(l)) + (size_t)nt * 64 * 2048 + kt * 64, 2048, sT);
      continue;
    }
    i -= N_TRWIN;
    if (i < N_TRWOUT) {
      const int l = i >> 10, r = i & 1023, kt = r >> 5, nt = r & 31;
      tr_tile(p.in[15 + 10 * l] + (size_t)kt * 64 * 2048 + nt * 64, 2048,
              reinterpret_cast<u16*>(p.ws + WS_WOUTT) + (size_t)l * 2048 * 2048 + (size_t)nt * 64 * 2048 + kt * 64, 2048, sT);
      continue;
    }
    i -= N_TRWOUT;
    if (i < N_TRPOOL) {
      const int e = i >> 6, r = i & 63, g = r >> 4, t = r & 15, kt = t >> 2, nt = t & 3;
      tr_tile(p.in[18 + 20 * e] + (size_t)g * 65536 + kt * 64 * 256 + nt * 64, 256,
              reinterpret_cast<u16*>(p.ws + WS_POOLWT) + (size_t)e * 262144 + g * 65536 + nt * 64 * 256 + kt * 64, 256, sT);
      continue;
    }
    i -= N_TRPOOL;
    if (i < N_SGU) {
      const int e = i >> 5, ch = i & 31;
      const size_t off = (size_t)ch * 2048 + tid * 8;
      cvt8(p.in[30 + 20 * e] + off, reinterpret_cast<u16*>(p.ws + WS_SGUW) + (size_t)e * 65536 + off);
      continue;
    }
    i -= N_SGU;
    if (i < N_CK) {
      const int l = i >> 10, ch = i & 1023;
      const size_t off = (size_t)ch * 2048 + tid * 8;
      cvt8(p.in[2 + 2 * l] + off, reinterpret_cast<u16*>(p.ws + WS_CK) + (size_t)l * 2097152 + off);
      continue;
    }
    i -= N_CK;
    if (i < N_CV) {
      const int l = i >> 9, r = i & 511, bh = r >> 4, t = r & 15, kt = t >> 1, nt = t & 1;
      tr_tile(p.in[3 + 2 * l] + (size_t)bh * 65536 + kt * 64 * 128 + nt * 64, 128,
              reinterpret_cast<u16*>(p.ws + WS_CVT) + (size_t)l * 2097152 + (size_t)bh * 65536 + nt * 64 * 512 + kt * 64, 512, sT);
      continue;
    }
    {
      float* rc = reinterpret_cast<float*>(p.ws + WS_ROPE);
      for (int e = tid; e < 1024; e += 256) {
        int pos = e >> 4, fi = e & 15;
        float inv = 1.0f / powf(10000.0f, (float)(2 * fi) / 32.0f);
        float ang = (float)pos * inv;
        rc[e] = cosf(ang);
        rc[1024 + e] = sinf(ang);
      }
    }
  }
}

DI void phase_mod0(const Params& p) {
  const int tid = TIDX;
  const float* mod = reinterpret_cast<const float*>(p.ws + WS_MOD);
  u16* H = reinterpret_cast<u16*>(p.ws + WS_H);
  for (int it = blockIdx.x; it < T_ALL / 4; it += gridDim.x) {
#pragma unroll
    for (int rr = 0; rr < 4; ++rr) {
      const int row = it * 4 + rr;
      const int cond = row < TP ? 0 : 1 + ((row - TP) >> 12);
      const float* src = row < TP ? p.in[0] + (size_t)row * 2048 : p.in[1] + (size_t)(row - TP) * 2048;
      const int e = tid * 8;
      const float* sh = mod + (size_t)cond * 6144 + e;
      float4 a = *reinterpret_cast<const float4*>(src + e), b = *reinterpret_cast<const float4*>(src + e + 4);
      float4 s0 = *reinterpret_cast<const float4*>(sh), s1 = *reinterpret_cast<const float4*>(sh + 4);
      float4 c0 = *reinterpret_cast<const float4*>(sh + 2048), c1 = *reinterpret_cast<const float4*>(sh + 2052);
      u32x4 o = {pk2(a.x * (1.f + c0.x) + s0.x, a.y * (1.f + c0.y) + s0.y), pk2(a.z * (1.f + c0.z) + s0.z, a.w * (1.f + c0.w) + s0.w),
                 pk2(b.x * (1.f + c1.x) + s1.x, b.y * (1.f + c1.y) + s1.y), pk2(b.z * (1.f + c1.z) + s1.z, b.w * (1.f + c1.w) + s1.w)};
      *reinterpret_cast<u32x4*>(H + (size_t)row * 2048 + e) = o;
    }
  }
}

enum { G_IN_EVEN = 0, G_IN_ODD = 1, G_OUT = 2 };

template <int MODE>
DI void gemm_phase(const Params& p, int l, unsigned char* lds) {
  constexpr int K = 2048;
  constexpr int N = (MODE == G_OUT) ? 2048 : (MODE == G_IN_EVEN ? 6144 : 7168);
  constexpr int NC = (MODE == G_IN_EVEN) ? 6144 : 7168;
  constexpr int nTn = N / 128;
  constexpr int TOTAL = nTn * 192;
  const u16* A = reinterpret_cast<const u16*>(p.ws + WS_H);
  const u16* Bt = (MODE == G_OUT) ? reinterpret_cast<const u16*>(p.ws + WS_WOUTT) + (size_t)l * 2048 * 2048
                                  : reinterpret_cast<const u16*>(p.ws + ws_wint(l));
  u16* sA = reinterpret_cast<u16*>(lds);
  u16* sB = sA + 2 * 128 * 72;
  const int tid = TIDX, lane = tid & 63, wid = tid >> 6;
  const int wr = wid >> 1, wc = wid & 1, fr = lane & 15, fq = lane >> 4;
  const int lrow = tid >> 3, lkc = (tid & 7) * 8;
  u16* PROJ = reinterpret_cast<u16*>(p.ws + WS_PROJ);
  u16* VT = reinterpret_cast<u16*>(p.ws + WS_VT);
  const float* mod = reinterpret_cast<const float*>(p.ws + WS_MOD);
  const float* ropeC = reinterpret_cast<const float*>(p.ws + WS_ROPE);
  const float* ropeS = ropeC + 1024;

  for (int it = blockIdx.x; it < TOTAL; it += gridDim.x) {
    constexpr int PN = nTn / 8;
    const int rnd = it >> 9, vb = it & 511, q = rnd * 8 + (vb & 7), jj = vb >> 3;
    const int tm = (q / PN) * 8 + (jj & 7), tn = (q % PN) * 8 + (jj >> 3);
    const u16* ga = A + (size_t)(tm * 128 + lrow) * K + lkc;
    const u16* gb = Bt + (size_t)(tn * 128 + lrow) * K + lkc;
    f32x4 acc[4][4];
#pragma unroll
    for (int a = 0; a < 4; ++a)
#pragma unroll
      for (int b = 0; b < 4; ++b) acc[a][b] = f32x4{0.f, 0.f, 0.f, 0.f};
    u32x4 ra[4], rb[4];
#pragma unroll
    for (int i = 0; i < 4; ++i) {
      ra[i] = *reinterpret_cast<const u32x4*>(ga + (size_t)i * 32 * K);
      rb[i] = *reinterpret_cast<const u32x4*>(gb + (size_t)i * 32 * K);
    }
#pragma unroll
    for (int i = 0; i < 4; ++i) {
      *reinterpret_cast<u32x4*>(sA + (lrow + 32 * i) * 72 + lkc) = ra[i];
      *reinterpret_cast<u32x4*>(sB + (lrow + 32 * i) * 72 + lkc) = rb[i];
    }
    __syncthreads();
    for (int kt = 0; kt < K / 64; ++kt) {
      const int buf = kt & 1;
      if (kt + 1 < K / 64) {
#pragma unroll
        for (int i = 0; i < 4; ++i) {
          ra[i] = *reinterpret_cast<const u32x4*>(ga + (size_t)i * 32 * K + (kt + 1) * 64);
          rb[i] = *reinterpret_cast<const u32x4*>(gb + (size_t)i * 32 * K + (kt + 1) * 64);
        }
      }
      __builtin_amdgcn_sched_barrier(0);
      const u16* cA = sA + buf * 128 * 72 + (wr * 64 + fr) * 72 + fq * 8;
      const u16* cB = sB + buf * 128 * 72 + (wc * 64 + fr) * 72 + fq * 8;
#pragma unroll
      for (int ks = 0; ks < 2; ++ks) {
        bf16x8 af[4], bfr[4];
#pragma unroll
        for (int m = 0; m < 4; ++m) af[m] = ld8(cA + m * 16 * 72 + ks * 32);
#pragma unroll
        for (int n = 0; n < 4; ++n) bfr[n] = ld8(cB + n * 16 * 72 + ks * 32);
#pragma unroll
        for (int m = 0; m < 4; ++m)
#pragma unroll
          for (int n = 0; n < 4; ++n) acc[m][n] = mfma16(af[m], bfr[n], acc[m][n]);
      }
      __builtin_amdgcn_sched_barrier(0);
      if (kt + 1 < K / 64) {
        const int nb = buf ^ 1;
#pragma unroll
        for (int i = 0; i < 4; ++i) {
          *reinterpret_cast<u32x4*>(sA + nb * 128 * 72 + (lrow + 32 * i) * 72 + lkc) = ra[i];
          *reinterpret_cast<u32x4*>(sB + nb * 128 * 72 + (lrow + 32 * i) * 72 + lkc) = rb[i];
        }
      }
      __syncthreads();
    }
    const int rowb = tm * 128 + wr * 64 + fq * 4;
    const int colb = tn * 128 + wc * 64 + fr;
    const bool prompt = tm < 64;
    if (MODE == G_OUT) {
      const int cond = prompt ? 0 : 1 + ((tm * 128 - TP) >> 12);
      const float* gate = mod + (size_t)(l * 5 + cond) * 6144 + 4096;
      float* X = p.out;
#pragma unroll
      for (int n = 0; n < 4; ++n) {
        const int col = colb + n * 16;
        const float g = gate[col];
#pragma unroll
        for (int m = 0; m < 4; ++m)
#pragma unroll
          for (int j = 0; j < 4; ++j) {
            const int row = rowb + m * 16 + j;
            float xo;
            if (l == 0) xo = prompt ? p.in[0][(size_t)row * 2048 + col] : p.in[1][(size_t)(row - TP) * 2048 + col];
            else xo = X[(size_t)row * 2048 + col];
            X[(size_t)row * 2048 + col] = ALPHA * xo + g * acc[m][n][j];
          }
      }
    } else {
      const int sec = tn >> 3;
      const int SEC_Q = (MODE == G_IN_EVEN) ? 2 : 0, SEC_K = (MODE == G_IN_EVEN) ? 3 : 1, SEC_V = (MODE == G_IN_EVEN) ? 4 : 2;
      if (sec == SEC_V) {
        const int hh = tn & 7;
        float* vout = p.out + (size_t)T_ALL * 2048 + (size_t)(2 * l + 1) * 8388608;
#pragma unroll
        for (int m = 0; m < 4; ++m) {
          const int row = rowb + m * 16;
#pragma unroll
          for (int n = 0; n < 4; ++n) {
            const int dv = wc * 64 + n * 16 + fr;
            u32x2 w = {pk2(acc[m][n][0], acc[m][n][1]), pk2(acc[m][n][2], acc[m][n][3])};
            if (prompt) {
              const int b = row >> 8, t = row & 255;
              *reinterpret_cast<u32x2*>(VT + ((size_t)((b * 8 + hh) * 128 + dv)) * 256 + t) = w;
#pragma unroll
              for (int j = 0; j < 4; ++j) vout[((size_t)((b * 8 + hh) * 256 + t + j)) * 128 + dv] = acc[m][n][j];
            } else {
              const int rs = row - TP, b = rs >> 12, t = rs & 4095;
              *reinterpret_cast<u32x2*>(VT + 8388608 + ((size_t)((b * 8 + hh) * 128 + dv)) * 4096 + t) = w;
            }
          }
        }
      } else {
        const bool isq = sec == SEC_Q, isk = sec == SEC_K;
        const bool rope = (MODE == G_IN_EVEN) && (isq || isk) && !prompt;
        const float qs = (MODE == G_IN_EVEN) ? 0.125f * LOG2E : 0.08838834764831845f * LOG2E;
        if (isk && prompt) {
          const int hh = tn & 7;
          float* kout = p.out + (size_t)T_ALL * 2048 + (size_t)(2 * l) * 8388608;
#pragma unroll
          for (int m = 0; m < 4; ++m)
#pragma unroll
            for (int n = 0; n < 4; ++n) {
              const int d = wc * 64 + n * 16 + fr;
#pragma unroll
              for (int j = 0; j < 4; ++j) {
                const int row = rowb + m * 16 + j, b = row >> 8, t = row & 255;
                kout[((size_t)((b * 8 + hh) * 256 + t)) * 128 + d] = acc[m][n][j];
              }
            }
        }
        if (rope) {
#pragma unroll
          for (int m = 0; m < 4; ++m)
#pragma unroll
            for (int j = 0; j < 4; ++j) {
              const int t = (rowb + m * 16 + j - TP) & 4095;
              const int pr = t >> 6, pc = t & 63;
#pragma unroll
              for (int ax = 0; ax < 2; ++ax) {
                const int pos = ax ? pc : pr;
                const float cs = ropeC[pos * 16 + fr], sn = ropeS[pos * 16 + fr];
                const float x1 = acc[m][2 * ax][j], x2 = acc[m][2 * ax + 1][j];
                acc[m][2 * ax][j] = x1 * cs - x2 * sn;
                acc[m][2 * ax + 1][j] = x1 * sn + x2 * cs;
              }
            }
        }
#pragma unroll
        for (int m = 0; m < 4; ++m)
#pragma unroll
          for (int n = 0; n < 4; ++n)
#pragma unroll
            for (int j = 0; j < 4; ++j) {
              float v = acc[m][n][j];
              if (isq) v *= qs;
              const int row = rowb + m * 16 + j, col = colb + n * 16;
              PROJ[(size_t)row * NC + col] = (u16)(pk2(v, 0.f) & 0xffffu);
            }
      }
    }
  }
}

DI void phase_ln(const Params& p, int l) {
  const int tid_ = TIDX, lane = tid_ & 63, wid = tid_ >> 6;
  const float* g = p.in[16 + 10 * l];
  const float* bb = p.in[17 + 10 * l];
  const float* mod = reinterpret_cast<const float*>(p.ws + WS_MOD);
  u16* H = reinterpret_cast<u16*>(p.ws + WS_H);
  float* X = p.out;
  for (int it = blockIdx.x; it < T_ALL / 4; it += gridDim.x) {
    const int row = it * 4 + wid;
    float* xr = X + (size_t)row * 2048;
    float4 v[8];
    float s = 0.f;
#pragma unroll
    for (int i = 0; i < 8; ++i) {
      v[i] = *reinterpret_cast<const float4*>(xr + (i * 64 + lane) * 4);
      s += v[i].x + v[i].y + v[i].z + v[i].w;
    }
#pragma unroll
    for (int o = 32; o >= 1; o >>= 1) s += __shfl_xor(s, o);
    const float mu = s * (1.f / 2048.f);
    float ss = 0.f;
#pragma unroll
    for (int i = 0; i < 8; ++i) {
      float a = v[i].x - mu, b = v[i].y - mu, c = v[i].z - mu, d = v[i].w - mu;
      ss += a * a + b * b + c * c + d * d;
    }
#pragma unroll
    for (int o = 32; o >= 1; o >>= 1) ss += __shfl_xor(ss, o);
    const float rstd = rsqrtf(ss * (1.f / 2048.f) + LN_EPS);
    const int cond = row < TP ? 0 : 1 + ((row - TP) >> 12);
    const float* sh = mod + (size_t)((l + 1) * 5 + cond) * 6144;
#pragma unroll
    for (int i = 0; i < 8; ++i) {
      const int e = (i * 64 + lane) * 4;
      float4 gg = *reinterpret_cast<const float4*>(g + e), b4 = *reinterpret_cast<const float4*>(bb + e);
      float4 y;
      y.x = (v[i].x - mu) * rstd * gg.x + b4.x; y.y = (v[i].y - mu) * rstd * gg.y + b4.y;
      y.z = (v[i].z - mu) * rstd * gg.z + b4.z; y.w = (v[i].w - mu) * rstd * gg.w + b4.w;
      *reinterpret_cast<float4*>(xr + e) = y;
      if (l < 3) {
        float4 s0 = *reinterpret_cast<const float4*>(sh + e), c0 = *reinterpret_cast<const float4*>(sh + 2048 + e);
        u32x2 o = {pk2(y.x * (1.f + c0.x) + s0.x, y.y * (1.f + c0.y) + s0.y), pk2(y.z * (1.f + c0.z) + s0.z, y.w * (1.f + c0.w) + s0.w)};
        *reinterpret_cast<u32x2*>(H + (size_t)row * 2048 + e) = o;
      }
    }
  }
}

struct AttnSrc {
  const u16* k0; const u16* vt0; int ks0, vs0, n0;
  const u16* k1; const u16* vt1; int ks1, vs1, n1;
};

template <int DQK>
DI void attn_ldg(const AttnSrc& s, int j, u32x4 (&rk)[DQK / 32], u32x4 (&rv)[4]) {
  const u16* kb; const u16* vb; int ks, vs;
  if (j < s.n0) { kb = s.k0 + (size_t)j * 64 * s.ks0; vb = s.vt0 + j * 64; ks = s.ks0; vs = s.vs0; }
  else { const int jj = j - s.n0; kb = s.k1 + (size_t)jj * 64 * s.ks1; vb = s.vt1 + jj * 64; ks = s.ks1; vs = s.vs1; }
  constexpr int CPR = DQK / 8;
  const int tid = TIDX;
#pragma unroll
  for (int i = 0; i < DQK / 32; ++i) {
    const int c = tid + 256 * i, row = c / CPR, kc = c % CPR;
    rk[i] = *reinterpret_cast<const u32x4*>(kb + (size_t)row * ks + kc * 8);
  }
#pragma unroll
  for (int i = 0; i < 4; ++i) {
    const int c = tid + 256 * i, row = c >> 3, kc = c & 7;
    rv[i] = *reinterpret_cast<const u32x4*>(vb + (size_t)row * vs + kc * 8);
  }
}
template <int DQK>
DI void attn_sts(u16* sK, u16* sVT, const u32x4 (&rk)[DQK / 32], const u32x4 (&rv)[4]) {
  constexpr int CPR = DQK / 8;
  const int tid = TIDX;
#pragma unroll
  for (int i = 0; i < DQK / 32; ++i) {
    const int c = tid + 256 * i, row = c / CPR, kc = c % CPR;
    *reinterpret_cast<u32x4*>(sK + row * (DQK + 8) + kc * 8) = rk[i];
  }
#pragma unroll
  for (int i = 0; i < 4; ++i) {
    const int c = tid + 256 * i, row = c >> 3, kc = c & 7;
    *reinterpret_cast<u32x4*>(sVT + row * 72 + kc * 8) = rv[i];
  }
}

template <int DQK, bool NA>
DI void attn_run(const AttnSrc& src, const u16* qblk, int qstride, u16* sQ, u16* sK, u16* sVT, f32x16 (&O)[4], float& l_out,
                 int qr, int qc, int rsmin, const float* sBias) {
  const int tid = TIDX, lane = tid & 63, wid = tid >> 6;
  const int r = lane & 31, h = lane >> 5;
  const int pr = (r & 0x13) | ((r & 4) << 1) | ((r & 8) >> 1);
  constexpr int CPR = DQK / 8, QS = DQK + 8;
  __syncthreads();
#pragma unroll
  for (int i = 0; i < DQK / 16; ++i) {
    const int c = tid + 256 * i, row = c / CPR, kc = c % CPR;
    *reinterpret_cast<u32x4*>(sQ + row * QS + kc * 8) = *reinterpret_cast<const u32x4*>(qblk + (size_t)row * qstride + kc * 8);
  }
#pragma unroll
  for (int d = 0; d < 4; ++d)
#pragma unroll
    for (int i = 0; i < 16; ++i) O[d][i] = 0.f;
  float m = -1e30f, l = 0.f;
  const int nt = src.n0 + src.n1;
  const int rsq = min(max(qr - 4, 0), 56);
  const int cs = min(max(qc - 8, 0), 48);
  const u16* qw = sQ + (wid * 32 + r) * QS + 8 * h;
  const u16* kw = sK + pr * QS + 8 * h;
  const u16* vw = sVT + r * 72 + 8 * h;
#pragma unroll 1
  for (int j = 0; j < nt; ++j) {
    {
      u32x4 rk[DQK / 32], rv[4];
      attn_ldg<DQK>(src, j, rk, rv);
      if (j > 0) __syncthreads();
      attn_sts<DQK>(sK, sVT, rk, rv);
    }
    __syncthreads();
    bool active = true;
    int kr = 0;
    if (NA && j >= src.n0) { kr = rsmin + (j - src.n0); active = (kr >= rsq) && (kr < rsq + 8); }
    if (active) {
      f32x16 s[2];
#pragma unroll
      for (int t = 0; t < 2; ++t) {
#pragma unroll
        for (int i = 0; i < 16; ++i) s[t][i] = 0.f;
#pragma unroll
        for (int ks = 0; ks < DQK / 16; ++ks) {
          bf16x8 a = ld8(kw + t * 32 * QS + ks * 16);
          bf16x8 q = ld8(qw + ks * 16);
          s[t] = mfma32(a, q, s[t]);
        }
      }
      if (NA && j >= src.n0) {
        const float* bp = sBias + (kr - qr + 7) * 31 + (8 * h - qc + 15);
        const int kb = 8 * h - cs;
#pragma unroll
        for (int t = 0; t < 2; ++t)
#pragma unroll
          for (int i = 0; i < 16; ++i) {
            const int ko = t * 32 + 16 * (i >> 3) + (i & 7);
            const bool ok = (unsigned)(ko + kb) < 16u;
            const float bv = bp[ko];
            s[t][i] = ok ? s[t][i] + bv : -1e30f;
          }
      }
      float mx = -1e30f;
#pragma unroll
      for (int t = 0; t < 2; ++t)
#pragma unroll
        for (int i = 0; i < 16; ++i) mx = fmaxf(mx, s[t][i]);
      mx = fmaxf(mx, __shfl_xor(mx, 32));
      const float mn = fmaxf(m, mx);
      const float alpha = ex2(m - mn);
      float rsum = 0.f;
#pragma unroll
      for (int t = 0; t < 2; ++t)
#pragma unroll
        for (int i = 0; i < 16; ++i) { const float e = ex2(s[t][i] - mn); s[t][i] = e; rsum += e; }
      rsum += __shfl_xor(rsum, 32);
      l = l * alpha + rsum;
      m = mn;
#pragma unroll
      for (int d = 0; d < 4; ++d)
#pragma unroll
        for (int i = 0; i < 16; ++i) O[d][i] *= alpha;
#pragma unroll
      for (int s4 = 0; s4 < 4; ++s4) {
        const int t = s4 >> 1, b0 = (s4 & 1) * 8;
        u32x4 w = {pk2(s[t][b0], s[t][b0 + 1]), pk2(s[t][b0 + 2], s[t][b0 + 3]), pk2(s[t][b0 + 4], s[t][b0 + 5]), pk2(s[t][b0 + 6], s[t][b0 + 7])};
        const bf16x8 pf = __builtin_bit_cast(bf16x8, w);
#pragma unroll
        for (int d = 0; d < 4; ++d) {
          bf16x8 a = ld8(vw + d * 32 * 72 + s4 * 16);
          O[d] = mfma32(a, pf, O[d]);
        }
      }
    }
  }
  l_out = l;
}

DI void heavy_map(int it, int& bh, int& qb) { const int x = it & 7, idx = it >> 3; bh = x + 8 * (idx >> 5); qb = idx & 31; }

DI void diff_item(const Params& p, int l, bool sample, int bh, int qb, unsigned char* lds) {
  constexpr int NC = 6144;
  const int tid_ = TIDX, lane = tid_ & 63, wid = tid_ >> 6, r = lane & 31, h = lane >> 5;
  const int b = bh >> 3, hd = bh & 7;
  u16* sQ = reinterpret_cast<u16*>(lds);
  u16* sK = sQ + 128 * 136;
  u16* sVT = sK + 64 * 136;
  const u16* PROJ = reinterpret_cast<const u16*>(p.ws + WS_PROJ);
  const u16* VT = reinterpret_cast<const u16*>(p.ws + WS_VT);
  const int seq0 = sample ? TP + b * 4096 : b * 256;
  const int token = seq0 + qb * 128 + wid * 32 + r;
  const float* dl = p.in[20 + 10 * l];
  float pa = dl[lane] * dl[64 + lane], pb = dl[128 + lane] * dl[192 + lane];
#pragma unroll
  for (int o = 32; o >= 1; o >>= 1) { pa += __shfl_xor(pa, o); pb += __shfl_xor(pb, o); }
  const float lam_init = 0.8f - 0.6f * __expf(-0.3f * (float)l);
  const float lam = __expf(pa) - __expf(pb) + lam_init;

  u32 o1p[32];
  f32x16 O[4];
  float lsum;
#pragma unroll
  for (int comp = 0; comp < 2; ++comp) {
    AttnSrc s;
    if (sample) {
      s.k0 = reinterpret_cast<const u16*>(p.ws + WS_CK) + (size_t)l * 2097152 + (size_t)bh * 65536 + comp * 64; s.ks0 = 128;
      s.vt0 = reinterpret_cast<const u16*>(p.ws + WS_CVT) + (size_t)l * 2097152 + (size_t)bh * 65536; s.vs0 = 512; s.n0 = 8;
      s.k1 = PROJ + (size_t)seq0 * NC + 3072 + hd * 128 + comp * 64; s.ks1 = NC;
      s.vt1 = VT + 8388608 + (size_t)bh * 128 * 4096; s.vs1 = 4096; s.n1 = 64;
    } else {
      s.k0 = nullptr; s.vt0 = nullptr; s.ks0 = 0; s.vs0 = 0; s.n0 = 0;
      s.k1 = PROJ + (size_t)seq0 * NC + 3072 + hd * 128 + comp * 64; s.ks1 = NC;
      s.vt1 = VT + (size_t)bh * 128 * 256; s.vs1 = 256; s.n1 = 4;
    }
    const u16* qblk = PROJ + (size_t)(seq0 + qb * 128) * NC + 2048 + hd * 128 + comp * 64;
    attn_run<64, false>(s, qblk, NC, sQ, sK, sVT, O, lsum, 0, 0, 0, nullptr);
    const float inv = 1.f / lsum;
    if (comp == 0) {
#pragma unroll
      for (int d = 0; d < 4; ++d)
#pragma unroll
        for (int i = 0; i < 8; ++i) o1p[d * 8 + i] = pk2(O[d][2 * i] * inv, O[d][2 * i + 1] * inv);
    } else {
      float ssq = 0.f;
#pragma unroll
      for (int d = 0; d < 4; ++d)
#pragma unroll
        for (int i = 0; i < 8; ++i) {
          const u32 w = o1p[d * 8 + i];
          const float a = bflo(w) - lam * O[d][2 * i] * inv, c = bfhi(w) - lam * O[d][2 * i + 1] * inv;
          O[d][2 * i] = a; O[d][2 * i + 1] = c;
          ssq += a * a + c * c;
        }
      ssq += __shfl_xor(ssq, 32);
      const float rn = rsqrtf(ssq * (1.f / 128.f) + LN_EPS) * (1.f - lam_init);
      const float* subln = p.in[21 + 10 * l];
      const u16* gp = PROJ + (size_t)token * NC + 5120 + hd * 128;
      u16* yp = reinterpret_cast<u16*>(p.ws + WS_H) + (size_t)token * 2048 + 1024 + hd * 128;
#pragma unroll
      for (int d = 0; d < 4; ++d)
#pragma unroll
        for (int q = 0; q < 4; ++q) {
          const int dv = d * 32 + 8 * q + 4 * h;
          const u32x2 gw = *reinterpret_cast<const u32x2*>(gp + dv);
          const float4 sl = *reinterpret_cast<const float4*>(subln + dv);
          const float y0 = O[d][4 * q] * rn * sl.x * silu(bflo(gw[0]));
          const float y1 = O[d][4 * q + 1] * rn * sl.y * silu(bfhi(gw[0]));
          const float y2 = O[d][4 * q + 2] * rn * sl.z * silu(bflo(gw[1]));
          const float y3 = O[d][4 * q + 3] * rn * sl.w * silu(bfhi(gw[1]));
          *reinterpret_cast<u32x2*>(yp + dv) = (ZERO_MASK & 2) ? u32x2{0u, 0u} : u32x2{pk2(y0, y1), pk2(y2, y3)};
        }
    }
  }
}

DI void pool_item(const Params& p, int l, int pi, unsigned char* lds) {
  constexpr int NC = 6144;
  const int tid = TIDX, lane = tid & 63, wid = tid >> 6, fr = lane & 15, fq = lane >> 4;
  const int tb = pi >> 2, g = pi & 3, row0 = tb * 64;
  const int L = row0 < TP ? 256 : 4096;
  const int t0 = row0 < TP ? (row0 & 255) : ((row0 - TP) & 4095);
  u16* sIn = reinterpret_cast<u16*>(lds);
  u16* sP = sIn + 80 * 264;
  const u16* PROJ = reinterpret_cast<const u16*>(p.ws + WS_PROJ);
  __syncthreads();
#pragma unroll
  for (int i = 0; i < 10; ++i) {
    const int c = tid + 256 * i, rr = c >> 5, oc = c & 31;
    const int t = t0 - 8 + rr;
    u32x4 v = {0u, 0u, 0u, 0u};
    if (t >= 0 && t < L) v = *reinterpret_cast<const u32x4*>(PROJ + (size_t)(row0 - 8 + rr) * NC + g * 256 + oc * 8);
    *reinterpret_cast<u32x4*>(sIn + rr * 264 + oc * 8) = v;
  }
  __syncthreads();
  {
    const int oc = tid & 31, seg = tid >> 5;
    const int half = 1 << g;
#pragma unroll 1
    for (int tt = 0; tt < 8; ++tt) {
      const int tl = seg * 8 + tt, t = t0 + tl;
      const int lo = max(t - half, 0), hi = min(t + half, L);
      float a[8];
#pragma unroll
      for (int k = 0; k < 8; ++k) a[k] = 0.f;
      for (int s = lo; s < hi; ++s) {
        const u32x4 v = *reinterpret_cast<const u32x4*>(sIn + (s - t0 + 8) * 264 + oc * 8);
#pragma unroll
        for (int k = 0; k < 4; ++k) { a[2 * k] += bflo(v[k]); a[2 * k + 1] += bfhi(v[k]); }
      }
      const float ic = 1.f / (float)(hi - lo);
      const u32x4 x = *reinterpret_cast<const u32x4*>(sIn + (tl + 8) * 264 + oc * 8);
      u32x4 o;
#pragma unroll
      for (int k = 0; k < 4; ++k) o[k] = pk2(a[2 * k] * ic - bflo(x[k]), a[2 * k + 1] * ic - bfhi(x[k]));
      *reinterpret_cast<u32x4*>(sP + tl * 264 + oc * 8) = o;
    }
  }
  __syncthreads();
  const u16* W = reinterpret_cast<const u16*>(p.ws + WS_POOLWT) + (size_t)(l >> 1) * 262144 + (size_t)g * 65536;
  f32x4 acc[4][4];
#pragma unroll
  for (int a = 0; a < 4; ++a)
#pragma unroll
    for (int b = 0; b < 4; ++b) acc[a][b] = f32x4{0.f, 0.f, 0.f, 0.f};
#pragma unroll 2
  for (int ks = 0; ks < 8; ++ks) {
    bf16x8 af[4], bfr[4];
#pragma unroll
    for (int m = 0; m < 4; ++m) af[m] = ld8(sP + (m * 16 + fr) * 264 + ks * 32 + fq * 8);
#pragma unroll
    for (int n = 0; n < 4; ++n) bfr[n] = ld8(W + (size_t)(wid * 64 + n * 16 + fr) * 256 + ks * 32 + fq * 8);
#pragma unroll
    for (int m = 0; m < 4; ++m)
#pragma unroll
      for (int n = 0; n < 4; ++n) acc[m][n] = mfma16(af[m], bfr[n], acc[m][n]);
  }
  const float* pscale = p.in[19 + 10 * l];
  u16* Y = reinterpret_cast<u16*>(p.ws + WS_H);
#pragma unroll
  for (int n = 0; n < 4; ++n) {
    const int col = g * 256 + wid * 64 + n * 16 + fr;
    const float sc = pscale[col];
#pragma unroll
    for (int m = 0; m < 4; ++m)
#pragma unroll
      for (int j = 0; j < 4; ++j) {
        const int row = row0 + m * 16 + fq * 4 + j;
        const float gt = bf1(PROJ[(size_t)row * NC + 1024 + col]);
        float y = acc[m][n][j] * sc * silu(gt);
        if (ZERO_MASK & 1) y = 0.f;
        Y[(size_t)row * 2048 + col] = (u16)(pk2(y, 0.f) & 0xffffu);
      }
  }
}

DI void phase_mix_even(const Params& p, int l, unsigned char* lds) {
#pragma unroll 1
  for (int it = blockIdx.x; it < 1024; it += gridDim.x) { int bh, qb; heavy_map(it, bh, qb); diff_item(p, l, true, bh, qb, lds); }
#pragma unroll 1
  for (int it = blockIdx.x; it < 512; it += gridDim.x) diff_item(p, l, false, it >> 1, it & 1, lds);
#pragma unroll 1
  for (int it = blockIdx.x; it < 1536; it += gridDim.x) pool_item(p, l, it, lds);
}

DI void na_item(const Params& p, int l, bool sample, int bh, int qb, unsigned char* lds) {
  constexpr int NC = 7168;
  const int tid = TIDX, lane = tid & 63, wid = tid >> 6, r = lane & 31, h = lane >> 5;
  const int b = bh >> 3, hd = bh & 7;
  u16* sQ = reinterpret_cast<u16*>(lds);
  u16* sK = sQ + 128 * 136;
  u16* sVT = sK + 64 * 136;
  float* sBias = reinterpret_cast<float*>(sVT + 128 * 72) + 64;
  const u16* PROJ = reinterpret_cast<const u16*>(p.ws + WS_PROJ);
  const u16* VT = reinterpret_cast<const u16*>(p.ws + WS_VT);
  const int seq0 = sample ? TP + b * 4096 : b * 256;
  const int token = seq0 + qb * 128 + wid * 32 + r;
  AttnSrc s;
  int qr = 0, qc = 0, rsmin = 0;
  f32x16 O[4];
  float lsum;
  const u16* qblk = PROJ + (size_t)(seq0 + qb * 128) * NC + hd * 128;
  if (sample) {
    __syncthreads();
    const float* rpb = p.in[18 + 10 * l] + hd * 465;
    for (int e = tid; e < 465; e += 256) sBias[e] = rpb[e] * LOG2E;
    const int r0 = qb * 2;
    qr = r0 + (wid >> 1); qc = (wid & 1) * 32 + r;
    rsmin = min(max(r0 - 4, 0), 56);
    const int rs1 = min(max(r0 - 3, 0), 56);
    s.k0 = reinterpret_cast<const u16*>(p.ws + WS_CK) + (size_t)l * 2097152 + (size_t)bh * 65536; s.ks0 = 128;
    s.vt0 = reinterpret_cast<const u16*>(p.ws + WS_CVT) + (size_t)l * 2097152 + (size_t)bh * 65536; s.vs0 = 512; s.n0 = 8;
    s.k1 = PROJ + (size_t)(seq0 + rsmin * 64) * NC + 1024 + hd * 128; s.ks1 = NC;
    s.vt1 = VT + 8388608 + (size_t)bh * 128 * 4096 + rsmin * 64; s.vs1 = 4096; s.n1 = rs1 + 8 - rsmin;
    attn_run<128, true>(s, qblk, NC, sQ, sK, sVT, O, lsum, qr, qc, rsmin, sBias);
  } else {
    s.k0 = nullptr; s.vt0 = nullptr; s.ks0 = 0; s.vs0 = 0; s.n0 = 0;
    s.k1 = PROJ + (size_t)seq0 * NC + 1024 + hd * 128; s.ks1 = NC;
    s.vt1 = VT + (size_t)bh * 128 * 256; s.vs1 = 256; s.n1 = 4;
    attn_run<128, false>(s, qblk, NC, sQ, sK, sVT, O, lsum, 0, 0, 0, nullptr);
  }
  const float inv = 1.f / lsum;
  const u16* gp = PROJ + (size_t)token * NC + 3072 + hd * 128;
  u16* yp = reinterpret_cast<u16*>(p.ws + WS_H) + (size_t)token * 2048 + hd * 128;
#pragma unroll
  for (int d = 0; d < 4; ++d)
#pragma unroll
    for (int q = 0; q < 4; ++q) {
      const int dv = d * 32 + 8 * q + 4 * h;
      const u32x2 gw = *reinterpret_cast<const u32x2*>(gp + dv);
      const float y0 = O[d][4 * q] * inv * silu(bflo(gw[0]));
      const float y1 = O[d][4 * q + 1] * inv * silu(bfhi(gw[0]));
      const float y2 = O[d][4 * q + 2] * inv * silu(bflo(gw[1]));
      const float y3 = O[d][4 * q + 3] * inv * silu(bfhi(gw[1]));
      *reinterpret_cast<u32x2*>(yp + dv) = (ZERO_MASK & 4) ? u32x2{0u, 0u} : u32x2{pk2(y0, y1), pk2(y2, y3)};
    }
}

DI void sgu_item(const Params& p, int l, int si, unsigned char* lds) {
  constexpr int NC = 7168;
  const int tid = TIDX, lane = tid & 63, wid = tid >> 6, fr = lane & 15, fq = lane >> 4;
  const int ch = si >> 2, g = si & 3, row0 = ch * 128;
  u16* vnT = reinterpret_cast<u16*>(lds);
  float* sMu = reinterpret_cast<float*>(vnT + 256 * 136);
  float* sRs = sMu + 128;
  const u16* PROJ = reinterpret_cast<const u16*>(p.ws + WS_PROJ);
  __syncthreads();
  {
    const int grp = tid >> 4, ln = tid & 15;
#pragma unroll 1
    for (int rr = 0; rr < 8; ++rr) {
      const u16* src = PROJ + (size_t)(row0 + grp * 8 + rr) * NC + 5120;
      float s = 0.f, ss = 0.f;
#pragma unroll
      for (int c8 = 0; c8 < 8; ++c8) {
        const u32x4 v = *reinterpret_cast<const u32x4*>(src + (ln + 16 * c8) * 8);
#pragma unroll
        for (int k = 0; k < 4; ++k) { const float a = bflo(v[k]), b = bfhi(v[k]); s += a + b; ss += a * a + b * b; }
      }
#pragma unroll
      for (int o = 8; o >= 1; o >>= 1) { s += __shfl_xor(s, o); ss += __shfl_xor(ss, o); }
      const float mu = s * (1.f / 1024.f);
      const float var = fmaxf(ss * (1.f / 1024.f) - mu * mu, 0.f);
      if (ln == 0) { sMu[grp * 8 + rr] = mu; sRs[grp * 8 + rr] = rsqrtf(var + LN_EPS); }
    }
  }
  __syncthreads();
  {
    const int j = tid & 127, hf = tid >> 7;
    const float mu = sMu[j], rs = sRs[j];
    const float* lng = p.in[19 + 10 * l] + g * 256;
    const u16* src = PROJ + (size_t)(row0 + j) * NC + 5120 + g * 256;
#pragma unroll 1
    for (int oc = hf * 16; oc < hf * 16 + 16; ++oc) {
      const u32x4 v = *reinterpret_cast<const u32x4*>(src + oc * 8);
      const float4 g0 = *reinterpret_cast<const float4*>(lng + oc * 8), g1 = *reinterpret_cast<const float4*>(lng + oc * 8 + 4);
      const float gg[8] = {g0.x, g0.y, g0.z, g0.w, g1.x, g1.y, g1.z, g1.w};
#pragma unroll
      for (int k = 0; k < 4; ++k) {
        const float a = (bflo(v[k]) - mu) * rs * gg[2 * k], b = (bfhi(v[k]) - mu) * rs * gg[2 * k + 1];
        const u32 w = pk2(a, b);
        vnT[(oc * 8 + 2 * k) * 136 + j] = (u16)(w & 0xffffu);
        vnT[(oc * 8 + 2 * k + 1) * 136 + j] = (u16)(w >> 16);
      }
    }
  }
  __syncthreads();
  const u16* W = reinterpret_cast<const u16*>(p.ws + WS_SGUW) + (size_t)(l >> 1) * 65536 + (size_t)g * 16384;
  const float* bs = p.in[21 + 10 * l] + g * 128;
  u16* Y = reinterpret_cast<u16*>(p.ws + WS_H);
#pragma unroll 1
  for (int ih = 0; ih < 2; ++ih) {
    f32x4 acc[4][4];
#pragma unroll
    for (int a = 0; a < 4; ++a)
#pragma unroll
      for (int b = 0; b < 4; ++b) acc[a][b] = f32x4{0.f, 0.f, 0.f, 0.f};
#pragma unroll
    for (int ks = 0; ks < 4; ++ks) {
      bf16x8 af[4], bfr[4];
#pragma unroll
      for (int m = 0; m < 4; ++m) af[m] = ld8(W + (size_t)(ih * 64 + m * 16 + fr) * 128 + ks * 32 + fq * 8);
#pragma unroll
      for (int n = 0; n < 4; ++n) bfr[n] = ld8(vnT + (wid * 64 + n * 16 + fr) * 136 + ks * 32 + fq * 8);
#pragma unroll
      for (int m = 0; m < 4; ++m)
#pragma unroll
        for (int n = 0; n < 4; ++n) acc[m][n] = mfma16(af[m], bfr[n], acc[m][n]);
    }
#pragma unroll
    for (int m = 0; m < 4; ++m)
#pragma unroll
      for (int j = 0; j < 4; ++j) {
        const int ii = ih * 64 + m * 16 + fq * 4 + j;
        const float bias = bs[ii];
        const size_t rb = (size_t)(row0 + ii) * NC;
#pragma unroll
        for (int n = 0; n < 4; ++n) {
          const int c = g * 256 + wid * 64 + n * 16 + fr;
          const float u = bf1(PROJ[rb + 4096 + c]), dg = bf1(PROJ[rb + 6144 + c]);
          float y = u * (acc[m][n][j] + bias) * silu(dg);
          if (ZERO_MASK & 8) y = 0.f;
          Y[(size_t)(row0 + ii) * 2048 + 1024 + c] = (u16)(pk2(y, 0.f) & 0xffffu);
        }
      }
  }
}

DI void phase_mix_odd(const Params& p, int l, unsigned char* lds) {
#pragma unroll 1
  for (int it = blockIdx.x; it < 1024; it += gridDim.x) { int bh, qb; heavy_map(it, bh, qb); na_item(p, l, true, bh, qb, lds); }
#pragma unroll 1
  for (int it = blockIdx.x; it < 512; it += gridDim.x) na_item(p, l, false, it >> 1, it & 1, lds);
#pragma unroll 1
  for (int it = blockIdx.x; it < 768; it += gridDim.x) sgu_item(p, l, it, lds);
}

__global__ void __launch_bounds__(256, 2) fwd_megakernel(Params p) {
  extern __shared__ __attribute__((aligned(16))) unsigned char lds[];
  cg::grid_group grid = cg::this_grid();
  for (int ph = p.ph_lo; ph < p.ph_hi; ++ph) {
    if (ph == 0) phase_prep(p, lds);
    else if (ph == 1) phase_mod0(p);
    else {
      const int l = (ph - 2) >> 2, s = (ph - 2) & 3;
      if (s == 0) { for (int rep = 0; rep < REP0; ++rep) { if (l & 1) gemm_phase<G_IN_ODD>(p, l, lds); else gemm_phase<G_IN_EVEN>(p, l, lds); } }
      else if (s == 1) { for (int rep = 0; rep < REP1; ++rep) { if (l & 1) phase_mix_odd(p, l, lds); else phase_mix_even(p, l, lds); } }
      else if (s == 2) gemm_phase<G_OUT>(p, l, lds);
      else phase_ln(p, l);
    }
    if (ph + 1 < p.ph_hi) {
      __builtin_amdgcn_fence(__ATOMIC_RELEASE, "agent");
      grid.sync();
      __builtin_amdgcn_fence(__ATOMIC_ACQUIRE, "agent");
    }
  }
}

extern "C" void kernel_launch(void* const* d_in, const int* in_sizes, int n_in, void* d_out, int out_size, void* d_ws, size_t ws_size,
                              hipStream_t stream) {
  static int grid_blocks = 0;
  if (grid_blocks == 0) {
    if (n_in != 52 || ws_size < WS_END) {
      fprintf(stderr, "kernel_launch: expected 52 inputs and >= %zu bytes of workspace; got %d, %zu\n", (size_t)WS_END, n_in, ws_size);
      grid_blocks = -1;
      return;
    }
    int dev = 0, cus = 0, per_cu = 0;
    hipGetDevice(&dev);
    hipDeviceGetAttribute(&cus, hipDeviceAttributeMultiprocessorCount, dev);
    hipFuncSetAttribute((const void*)fwd_megakernel, hipFuncAttributeMaxDynamicSharedMemorySize, LDS_BYTES);
    hipOccupancyMaxActiveBlocksPerMultiprocessor(&per_cu, (const void*)fwd_megakernel, 256, LDS_BYTES);
    if (per_cu < 1) per_cu = 1;
    if (per_cu > 2) per_cu = 2;
    grid_blocks = cus * per_cu;
  }
  if (grid_blocks < 0) return;
  Params p{};
  for (int i = 0; i < 52; ++i) p.in[i] = (const float*)d_in[i];
  p.out = (float*)d_out;
  p.ws = (unsigned char*)d_ws;
#if MULTI
  for (int ph = 0; ph < NPHASE; ++ph) {
    p.ph_lo = ph; p.ph_hi = ph + 1;
    hipLaunchKernelGGL(fwd_megakernel, dim3(grid_blocks), dim3(256), LDS_BYTES, stream, p);
  }
#else
  p.ph_lo = 0; p.ph_hi = NPHASE;
  void* args[] = {&p};
  hipError_t e = hipLaunchCooperativeKernel((const void*)fwd_megakernel, dim3(grid_blocks), dim3(256), args, LDS_BYTES, stream);
  if (e != hipSuccess) fprintf(stderr, "cooperative launch failed: %s (grid %d)\n", hipGetErrorString(e), grid_blocks);
#endif
}
```

```cpp
#include <hip/hip_runtime.h>
#include <hip/hip_cooperative_groups.h>
#include <cstdio>
namespace cg = cooperative_groups;

#define DI __device__ __forceinline__
typedef unsigned short u16;
typedef unsigned int u32;
using bf16x8 = __attribute__((ext_vector_type(8))) short;
using f32x4 = __attribute__((ext_vector_type(4))) float;
using f32x16 = __attribute__((ext_vector_type(16))) float;
using u32x4 = __attribute__((ext_vector_type(4))) unsigned;
using u32x2 = __attribute__((ext_vector_type(2))) unsigned;
typedef __bf16 bf2_t __attribute__((ext_vector_type(2)));
typedef float f2_t __attribute__((ext_vector_type(2)));

#ifndef MULTI
#define MULTI 0
#endif
#ifndef REP0
#define REP0 1
#endif
#ifndef REP1
#define REP1 1
#endif
#ifndef ZERO_MASK
#define ZERO_MASK 0
#endif

constexpr int T_ALL = 24576, TP = 8192, DM = 2048;
constexpr float LOG2E = 1.4426950408889634f;
constexpr float ALPHA = 1.6817928305074290f;
constexpr float LN_EPS = 1e-5f;
constexpr int LDS_BYTES = 76288;
constexpr int NPHASE = 18;

constexpr size_t SZ_WIN_E = (size_t)6144 * 2048 * 2, SZ_WIN_O = (size_t)7168 * 2048 * 2;
constexpr size_t WS_WINT = 0;
constexpr size_t WS_WOUTT = WS_WINT + 2 * SZ_WIN_E + 2 * SZ_WIN_O;
constexpr size_t WS_POOLWT = WS_WOUTT + (size_t)4 * 2048 * 2048 * 2;
constexpr size_t WS_SGUW = WS_POOLWT + (size_t)2 * 4 * 256 * 256 * 2;
constexpr size_t WS_CK = WS_SGUW + (size_t)2 * 4 * 128 * 128 * 2;
constexpr size_t WS_CVT = WS_CK + (size_t)4 * 4194304;
constexpr size_t WS_MOD = WS_CVT + (size_t)4 * 4194304;
constexpr size_t WS_ROPE = WS_MOD + (size_t)4 * 5 * 6144 * 4;
constexpr size_t WS_H = WS_ROPE + 8192;
constexpr size_t WS_PROJ = WS_H + (size_t)T_ALL * 2048 * 2;
constexpr size_t WS_VT = WS_PROJ + (size_t)T_ALL * 7168 * 2;
constexpr size_t WS_END = WS_VT + (size_t)T_ALL * 1024 * 2;

struct Params {
  const float* in[52];
  float* out;
  unsigned char* ws;
  int ph_lo, ph_hi;
};

DI size_t ws_wint(int l) { return WS_WINT + (size_t)(l >> 1) * (SZ_WIN_E + SZ_WIN_O) + ((l & 1) ? SZ_WIN_E : 0); }

DI u32 pk2(float a, float b) { f2_t v = {a, b}; bf2_t r = __builtin_convertvector(v, bf2_t); return __builtin_bit_cast(u32, r); }
DI float bflo(u32 w) { return __uint_as_float(w << 16); }
DI float bfhi(u32 w) { return __uint_as_float(w & 0xffff0000u); }
DI float bf1(u16 w) { return __uint_as_float(((u32)w) << 16); }
DI float ex2(float x) { return __builtin_amdgcn_exp2f(x); }
DI float silu(float x) { return x / (1.f + __expf(-x)); }
DI f32x4 mfma16(bf16x8 a, bf16x8 b, f32x4 c) { return __builtin_amdgcn_mfma_f32_16x16x32_bf16(a, b, c, 0, 0, 0); }
DI f32x16 mfma32(bf16x8 a, bf16x8 b, f32x16 c) { return __builtin_amdgcn_mfma_f32_32x32x16_bf16(a, b, c, 0, 0, 0); }
DI bf16x8 ld8(const u16* p) { return *reinterpret_cast<const bf16x8*>(p); }
DI int opq(int x) { asm volatile("" : "+v"(x)); return x; }
#define TIDX opq((int)threadIdx.x)

DI void tr_tile(const float* __restrict__ src, size_t ld_src, u16* __restrict__ dst, size_t ld_dst, float* sT) {
  const int tid = TIDX;
  const int r = tid >> 4, c4 = (tid & 15) * 4;
#pragma unroll
  for (int i = 0; i < 4; ++i) {
    float4 v = *reinterpret_cast<const float4*>(src + (size_t)(r + 16 * i) * ld_src + c4);
    float* d = sT + (r + 16 * i) * 65 + c4;
    d[0] = v.x; d[1] = v.y; d[2] = v.z; d[3] = v.w;
  }
  __syncthreads();
  const int n = tid >> 2, ks = (tid & 3) * 16;
  u32 w[8];
#pragma unroll
  for (int j = 0; j < 8; ++j) w[j] = pk2(sT[(ks + 2 * j) * 65 + n], sT[(ks + 2 * j + 1) * 65 + n]);
  u32x4* o = reinterpret_cast<u32x4*>(dst + (size_t)n * ld_dst + ks);
  o[0] = u32x4{w[0], w[1], w[2], w[3]};
  o[1] = u32x4{w[4], w[5], w[6], w[7]};
  __syncthreads();
}

DI void cvt8(const float* __restrict__ src, u16* __restrict__ dst) {
  float4 a = *reinterpret_cast<const float4*>(src);
  float4 b = *reinterpret_cast<const float4*>(src + 4);
  *reinterpret_cast<u32x4*>(dst) = u32x4{pk2(a.x, a.y), pk2(a.z, a.w), pk2(b.x, b.y), pk2(b.z, b.w)};
}

DI void mod_item(const Params& p, int i, unsigned char* lds) {
  const int tid = TIDX;
  const int l = i / 96, n0 = (i % 96) * 64;
  float* sS = reinterpret_cast<float*>(lds);
  float* red = sS + 5 * 2048;
  const float* c = p.in[10];
  const float* cctx = p.in[11];
  for (int e = tid; e < 5 * 2048; e += 256) {
    int v = e >> 11, k = e & 2047;
    float x = (v == 0) ? cctx[k] : c[(v - 1) * 2048 + k];
    sS[e] = silu(x);
  }
  __syncthreads();
  const int kk = tid >> 4, c4 = (tid & 15) * 4;
  const float* W = p.in[12 + 10 * l] + n0 + c4;
  f32x4 acc[5];
#pragma unroll
  for (int v = 0; v < 5; ++v) acc[v] = f32x4{0.f, 0.f, 0.f, 0.f};
#pragma unroll 8
  for (int k = kk; k < 2048; k += 16) {
    float4 w = *reinterpret_cast<const float4*>(W + (size_t)k * 6144);
#pragma unroll
    for (int v = 0; v < 5; ++v) {
      float s = sS[v * 2048 + k];
      acc[v][0] += s * w.x; acc[v][1] += s * w.y; acc[v][2] += s * w.z; acc[v][3] += s * w.w;
    }
  }
#pragma unroll
  for (int v = 0; v < 5; ++v)
#pragma unroll
    for (int q = 0; q < 4; ++q) red[(kk * 5 + v) * 64 + c4 + q] = acc[v][q];
  __syncthreads();
  for (int t2 = tid; t2 < 320; t2 += 256) {
    int v = t2 >> 6, n = t2 & 63;
    float s = 0.f;
#pragma unroll
    for (int k2 = 0; k2 < 16; ++k2) s += red[(k2 * 5 + v) * 64 + n];
    float* mod = reinterpret_cast<float*>(p.ws + WS_MOD);
    mod[(size_t)(l * 5 + v) * 6144 + n0 + n] = s + p.in[13 + 10 * l][n0 + n];
  }
  __syncthreads();
}

DI void phase_prep(const Params& p, unsigned char* lds) {
  constexpr int N_MOD = 384, N_TRWIN = 13312, N_TRWOUT = 4096, N_TRPOOL = 128, N_SGU = 64, N_CK = 4096, N_CV = 2048;
  constexpr int TOTAL = N_MOD + N_TRWIN + N_TRWOUT + N_TRPOOL + N_SGU + N_CK + N_CV + 1;
  const int tid = TIDX;
  float* sT = reinterpret_cast<float*>(lds);
  for (int it = blockIdx.x; it < TOTAL; it += gridDim.x) {
    int i = it;
    if (i < N_MOD) { mod_item(p, i, lds); continue; }
    i -= N_MOD;
    if (i < N_TRWIN) {
      int l, base;
      if (i < 3072) { l = 0; base = 0; } else if (i < 6656) { l = 1; base = 3072; } else if (i < 9728) { l = 2; base = 6656; } else { l = 3; base = 9728; }
      i -= base;
      const int N = (l & 1) ? 7168 : 6144, nN = N / 64;
      const int kt = i / nN, nt = i % nN;
      tr_tile(p.in[14 + 10 * l] + (size_t)kt * 64 * N + nt * 64, N,
              reinterpret_cast<u16*>(p.ws + ws_wint(l)) + (size_t)nt * 64 * 2048 + kt * 64, 2048, sT);
      continue;
    }
    i -= N_TRWIN;
    if (i < N_TRWOUT) {
      const int l = i >> 10, r = i & 1023, kt = r >> 5, nt = r & 31;
      tr_tile(p.in[15 + 10 * l] + (size_t)kt * 64 * 2048 + nt * 64, 2048,
              reinterpret_cast<u16*>(p.ws + WS_WOUTT) + (size_t)l * 2048 * 2048 + (size_t)nt * 64 * 2048 + kt * 64, 2048, sT);
      continue;
    }
    i -= N_TRWOUT;
    if (i < N_TRPOOL) {
      const int e = i >> 6, r = i & 63, g = r >> 4, t = r & 15, kt = t >> 2, nt = t & 3;
      tr_tile(p.in[18 + 20 * e] + (size_t)g * 65536 + kt * 64 * 256 + nt * 64, 256,
              reinterpret_cast<u16*>(p.ws + WS_POOLWT) + (size_t)e * 262144 + g * 65536 + nt * 64 * 256 + kt * 64, 256, sT);
      continue;
    }
    i -= N_TRPOOL;
    if (i < N_SGU) {
      const int e = i >> 5, ch = i & 31;
      const size_t off = (size_t)ch * 2048 + tid * 8;
      cvt8(p.in[30 + 20 * e] + off, reinterpret_cast<u16*>(p.ws + WS_SGUW) + (size_t)e * 65536 + off);
      continue;
    }
    i -= N_SGU;
    if (i < N_CK) {
      const int l = i >> 10, ch = i & 1023;
      const size_t off = (size_t)ch * 2048 + tid * 8;
      cvt8(p.in[2 + 2 * l] + off, reinterpret_cast<u16*>(p.ws + WS_CK) + (size_t)l * 2097152 + off);
      continue;
    }
    i -= N_CK;
    if (i < N_CV) {
      const int l = i >> 9, r = i & 511, bh = r >> 4, t = r & 15, kt = t >> 1, nt = t & 1;
      tr_tile(p.in[3 + 2 * l] + (size_t)bh * 65536 + kt * 64 * 128 + nt * 64, 128,
              reinterpret_cast<u16*>(p.ws + WS_CVT) + (size_t)l * 2097152 + (size_t)bh * 65536 + nt * 64 * 512 + kt * 64, 512, sT);
      continue;
    }
    {
      float* rc = reinterpret_cast<float*>(p.ws + WS_ROPE);
      for (int e = tid; e < 1024; e += 256) {
        int pos = e >> 4, fi = e & 15;
        float inv = 1.0f / powf(10000.0f, (float)(2 * fi) / 32.0f);
        float ang = (float)pos * inv;
        rc[e] = cosf(ang);
        rc[1024 + e] = sinf(ang);
      }
    }
  }
}

DI void phase_mod0(const Params& p) {
  const int tid = TIDX;
  const float* mod = reinterpret_cast<const float*>(p.ws + WS_MOD);
  u16* H = reinterpret_cast<u16*>(p.ws + WS_H);
  for (int it = blockIdx.x; it < T_ALL / 4; it += gridDim.x) {
#pragma unroll
    for (int rr = 0; rr < 4; ++rr) {
      const int row = it * 4 + rr;
      const int cond = row < TP ? 0 : 1 + ((row - TP) >> 12);
      const float* src = row < TP ? p.in[0] + (size_t)row * 2048 : p.in[1] + (size_t)(row - TP) * 2048;
      const int e = tid * 8;
      const float* sh = mod + (size_t)cond * 6144 + e;
      float4 a = *reinterpret_cast<const float4*>(src + e), b = *reinterpret_cast<const float4*>(src + e + 4);
      float4 s0 = *reinterpret_cast<const float4*>(sh), s1 = *reinterpret_cast<const float4*>(sh + 4);
      float4 c0 = *reinterpret_cast<const float4*>(sh + 2048), c1 = *reinterpret_cast<const float4*>(sh + 2052);
      u32x4 o = {pk2(a.x * (1.f + c0.x) + s0.x, a.y * (1.f + c0.y) + s0.y), pk2(a.z * (1.f + c0.z) + s0.z, a.w * (1.f + c0.w) + s0.w),
                 pk2(b.x * (1.f + c1.x) + s1.x, b.y * (1.f + c1.y) + s1.y), pk2(b.z * (1.f + c1.z) + s1.z, b.w * (1.f + c1.w) + s1.w)};
      *reinterpret_cast<u32x4*>(H + (size_t)row * 2048 + e) = o;
    }
  }
}

enum { G_IN_EVEN = 0, G_IN_ODD = 1, G_OUT = 2 };

template <int MODE>
DI void gemm_phase(const Params& p, int l, unsigned char* lds) {
  constexpr int K = 2048;
  constexpr int N = (MODE == G_OUT) ? 2048 : (MODE == G_IN_EVEN ? 6144 : 7168);
  constexpr int NC = (MODE == G_IN_EVEN) ? 6144 : 7168;
  constexpr int nTn = N / 128;
  constexpr int TOTAL = nTn * 192;
  const u16* A = reinterpret_cast<const u16*>(p.ws + WS_H);
  const u16* Bt = (MODE == G_OUT) ? reinterpret_cast<const u16*>(p.ws + WS_WOUTT) + (size_t)l * 2048 * 2048
                                  : reinterpret_cast<const u16*>(p.ws + ws_wint(l));
  u16* sA = reinterpret_cast<u16*>(lds);
  u16* sB = sA + 2 * 128 * 72;
  const int tid = TIDX, lane = tid & 63, wid = tid >> 6;
  const int wr = wid >> 1, wc = wid & 1, fr = lane & 15, fq = lane >> 4;
  const int lrow = tid >> 3, lkc = (tid & 7) * 8;
  u16* PROJ = reinterpret_cast<u16*>(p.ws + WS_PROJ);
  u16* VT = reinterpret_cast<u16*>(p.ws + WS_VT);
  const float* mod = reinterpret_cast<const float*>(p.ws + WS_MOD);
  const float* ropeC = reinterpret_cast<const float*>(p.ws + WS_ROPE);
  const float* ropeS = ropeC + 1024;

  for (int it = blockIdx.x; it < TOTAL; it += gridDim.x) {
    constexpr int PN = nTn / 8;
    const int rnd = it >> 9, vb = it & 511, q = rnd * 8 + (vb & 7), jj = vb >> 3;
    const int tm = (q / PN) * 8 + (jj & 7), tn = (q % PN) * 8 + (jj >> 3);
    const u16* ga = A + (size_t)(tm * 128 + lrow) * K + lkc;
    const u16* gb = Bt + (size_t)(tn * 128 + lrow) * K + lkc;
    f32x4 acc[4][4];
#pragma unroll
    for (int a = 0; a < 4; ++a)
#pragma unroll
      for (int b = 0; b < 4; ++b) acc[a][b] = f32x4{0.f, 0.f, 0.f, 0.f};
    u32x4 ra[4], rb[4];
#pragma unroll
    for (int i = 0; i < 4; ++i) {
      ra[i] = *reinterpret_cast<const u32x4*>(ga + (size_t)i * 32 * K);
      rb[i] = *reinterpret_cast<const u32x4*>(gb + (size_t)i * 32 * K);
    }
#pragma unroll
    for (int i = 0; i < 4; ++i) {
      *reinterpret_cast<u32x4*>(sA + (lrow + 32 * i) * 72 + lkc) = ra[i];
      *reinterpret_cast<u32x4*>(sB + (lrow + 32 * i) * 72 + lkc) = rb[i];
    }
    __syncthreads();
    for (int kt = 0; kt < K / 64; ++kt) {
      const int buf = kt & 1;
      if (kt + 1 < K / 64) {
#pragma unroll
        for (int i = 0; i < 4; ++i) {
          ra[i] = *reinterpret_cast<const u32x4*>(ga + (size_t)i * 32 * K + (kt + 1) * 64);
          rb[i] = *reinterpret_cast<const u32x4*>(gb + (size_t)i * 32 * K + (kt + 1) * 64);
        }
      }
      __builtin_amdgcn_sched_barrier(0);
      const u16* cA = sA + buf * 128 * 72 + (wr * 64 + fr) * 72 + fq * 8;
      const u16* cB = sB + buf * 128 * 72 + (wc * 64 + fr) * 72 + fq * 8;
#pragma unroll
      for (int ks = 0; ks < 2; ++ks) {
        bf16x8 af[4], bfr[4];
#pragma unroll
        for (int m = 0; m < 4; ++m) af[m] = ld8(cA + m * 16 * 72 + ks * 32);
#pragma unroll
        for (int n = 0; n < 4; ++n) bfr[n] = ld8(cB + n * 16 * 72 + ks * 32);
#pragma unroll
        for (int m = 0; m < 4; ++m)
#pragma unroll
          for (int n = 0; n < 4; ++n) acc[m][n] = mfma16(af[m], bfr[n], acc[m][n]);
      }
      __builtin_amdgcn_sched_barrier(0);
      if (kt + 1 < K / 64) {
        const int nb = buf ^ 1;
#pragma unroll
        for (int i = 0; i < 4; ++i) {
          *reinterpret_cast<u32x4*>(sA + nb * 128 * 72 + (lrow + 32 * i) * 72 + lkc) = ra[i];
          *reinterpret_cast<u32x4*>(sB + nb * 128 * 72 + (lrow + 32 * i) * 72 + lkc) = rb[i];
        }
      }
      __syncthreads();
    }
    const int rowb = tm * 128 + wr * 64 + fq * 4;
    const int colb = tn * 128 + wc * 64 + fr;
    const bool prompt = tm < 64;
    if (MODE == G_OUT) {
      const int cond = prompt ? 0 : 1 + ((tm * 128 - TP) >> 12);
      const float* gate = mod + (size_t)(l * 5 + cond) * 6144 + 4096;
      float* X = p.out;
#pragma unroll
      for (int n = 0; n < 4; ++n) {
        const int col = colb + n * 16;
        const float g = gate[col];
#pragma unroll
        for (int m = 0; m < 4; ++m)
#pragma unroll
          for (int j = 0; j < 4; ++j) {
            const int row = rowb + m * 16 + j;
            float xo;
            if (l == 0) xo = prompt ? p.in[0][(size_t)row * 2048 + col] : p.in[1][(size_t)(row - TP) * 2048 + col];
            else xo = X[(size_t)row * 2048 + col];
            X[(size_t)row * 2048 + col] = ALPHA * xo + g * acc[m][n][j];
          }
      }
    } else {
      const int sec = tn >> 3;
      const int SEC_Q = (MODE == G_IN_EVEN) ? 2 : 0, SEC_K = (MODE == G_IN_EVEN) ? 3 : 1, SEC_V = (MODE == G_IN_EVEN) ? 4 : 2;
      if (sec == SEC_V) {
        const int hh = tn & 7;
        float* vout = p.out + (size_t)T_ALL * 2048 + (size_t)(2 * l + 1) * 8388608;
#pragma unroll
        for (int m = 0; m < 4; ++m) {
          const int row = rowb + m * 16;
#pragma unroll
          for (int n = 0; n < 4; ++n) {
            const int dv = wc * 64 + n * 16 + fr;
            u32x2 w = {pk2(acc[m][n][0], acc[m][n][1]), pk2(acc[m][n][2], acc[m][n][3])};
            if (prompt) {
              const int b = row >> 8, t = row & 255;
              *reinterpret_cast<u32x2*>(VT + ((size_t)((b * 8 + hh) * 128 + dv)) * 256 + t) = w;
#pragma unroll
              for (int j = 0; j < 4; ++j) vout[((size_t)((b * 8 + hh) * 256 + t + j)) * 128 + dv] = acc[m][n][j];
            } else {
              const int rs = row - TP, b = rs >> 12, t = rs & 4095;
              *reinterpret_cast<u32x2*>(VT + 8388608 + ((size_t)((b * 8 + hh) * 128 + dv)) * 4096 + t) = w;
            }
          }
        }
      } else {
        const bool isq = sec == SEC_Q, isk = sec == SEC_K;
        const bool rope = (MODE == G_IN_EVEN) && (isq || isk) && !prompt;
        const float qs = (MODE == G_IN_EVEN) ? 0.125f * LOG2E : 0.08838834764831845f * LOG2E;
        if (isk && prompt) {
          const int hh = tn & 7;
          float* kout = p.out + (size_t)T_ALL * 2048 + (size_t)(2 * l) * 8388608;
#pragma unroll
          for (int m = 0; m < 4; ++m)
#pragma unroll
            for (int n = 0; n < 4; ++n) {
              const int d = wc * 64 + n * 16 + fr;
#pragma unroll
              for (int j = 0; j < 4; ++j) {
                const int row = rowb + m * 16 + j, b = row >> 8, t = row & 255;
                kout[((size_t)((b * 8 + hh) * 256 + t)) * 128 + d] = acc[m][n][j];
              }
            }
        }
        if (rope) {
#pragma unroll
          for (int m = 0; m < 4; ++m)
#pragma unroll
            for (int j = 0; j < 4; ++j) {
              const int t = (rowb + m * 16 + j - TP) & 4095;
              const int pr = t >> 6, pc = t & 63;
#pragma unroll
              for (int ax = 0; ax < 2; ++ax) {
                const int pos = ax ? pc : pr;
                const float cs = ropeC[pos * 16 + fr], sn = ropeS[pos * 16 + fr];
                const float x1 = acc[m][2 * ax][j], x2 = acc[m][2 * ax + 1][j];
                acc[m][2 * ax][j] = x1 * cs - x2 * sn;
                acc[m][2 * ax + 1][j] = x1 * sn + x2 * cs;
              }
            }
        }
#pragma unroll
        for (int m = 0; m < 4; ++m)
#pragma unroll
          for (int n = 0; n < 4; ++n)
#pragma unroll
            for (int j = 0; j < 4; ++j) {
              float v = acc[m][n][j];
              if (isq) v *= qs;
              const int row = rowb + m * 16 + j, col = colb + n * 16;
              PROJ[(size_t)row * NC + col] = (u16)(pk2(v, 0.f) & 0xffffu);
            }
      }
    }
  }
}

DI void phase_ln(const Params& p, int l) {
  const int tid_ = TIDX, lane = tid_ & 63, wid = tid_ >> 6;
  const float* g = p.in[16 + 10 * l];
  const float* bb = p.in[17 + 10 * l];
  const float* mod = reinterpret_cast<const float*>(p.ws + WS_MOD);
  u16* H = reinterpret_cast<u16*>(p.ws + WS_H);
  float* X = p.out;
  for (int it = blockIdx.x; it < T_ALL / 4; it += gridDim.x) {
    const int row = it * 4 + wid;
    float* xr = X + (size_t)row * 2048;
    float4 v[8];
    float s = 0.f;
#pragma unroll
    for (int i = 0; i < 8; ++i) {
      v[i] = *reinterpret_cast<const float4*>(xr + (i * 64 + lane) * 4);
      s += v[i].x + v[i].y + v[i].z + v[i].w;
    }
#pragma unroll
    for (int o = 32; o >= 1; o >>= 1) s += __shfl_xor(s, o);
    const float mu = s * (1.f / 2048.f);
    float ss = 0.f;
#pragma unroll
    for (int i = 0; i < 8; ++i) {
      float a = v[i].x - mu, b = v[i].y - mu, c = v[i].z - mu, d = v[i].w - mu;
      ss += a * a + b * b + c * c + d * d;
    }
#pragma unroll
    for (int o = 32; o >= 1; o >>= 1) ss += __shfl_xor(ss, o);
    const float rstd = rsqrtf(ss * (1.f / 2048.f) + LN_EPS);
    const int cond = row < TP ? 0 : 1 + ((row - TP) >> 12);
    const float* sh = mod + (size_t)((l + 1) * 5 + cond) * 6144;
#pragma unroll
    for (int i = 0; i < 8; ++i) {
      const int e = (i * 64 + lane) * 4;
      float4 gg = *reinterpret_cast<const float4*>(g + e), b4 = *reinterpret_cast<const float4*>(bb + e);
      float4 y;
      y.x = (v[i].x - mu) * rstd * gg.x + b4.x; y.y = (v[i].y - mu) * rstd * gg.y + b4.y;
      y.z = (v[i].z - mu) * rstd * gg.z + b4.z; y.w = (v[i].w - mu) * rstd * gg.w + b4.w;
      *reinterpret_cast<float4*>(xr + e) = y;
      if (l < 3) {
        float4 s0 = *reinterpret_cast<const float4*>(sh + e), c0 = *reinterpret_cast<const float4*>(sh + 2048 + e);
        u32x2 o = {pk2(y.x * (1.f + c0.x) + s0.x, y.y * (1.f + c0.y) + s0.y), pk2(y.z * (1.f + c0.z) + s0.z, y.w * (1.f + c0.w) + s0.w)};
        *reinterpret_cast<u32x2*>(H + (size_t)row * 2048 + e) = o;
      }
    }
  }
}

struct AttnSrc {
  const u16* k0; const u16* vt0; int ks0, vs0, n0;
  const u16* k1; const u16* vt1; int ks1, vs1, n1;
};

template <int DQK>
DI void attn_ldg(const AttnSrc& s, int j, u32x4 (&rk)[DQK / 32], u32x4 (&rv)[4]) {
  const u16* kb; const u16* vb; int ks, vs;
  if (j < s.n0) { kb = s.k0 + (size_t)j * 64 * s.ks0; vb = s.vt0 + j * 64; ks = s.ks0; vs = s.vs0; }
  else { const int jj = j - s.n0; kb = s.k1 + (size_t)jj * 64 * s.ks1; vb = s.vt1 + jj * 64; ks = s.ks1; vs = s.vs1; }
  constexpr int CPR = DQK / 8;
  const int tid = TIDX;
#pragma unroll
  for (int i = 0; i < DQK / 32; ++i) {
    const int c = tid + 256 * i, row = c / CPR, kc = c % CPR;
    rk[i] = *reinterpret_cast<const u32x4*>(kb + (size_t)row * ks + kc * 8);
  }
#pragma unroll
  for (int i = 0; i < 4; ++i) {
    const int c = tid + 256 * i, row = c >> 3, kc = c & 7;
    rv[i] = *reinterpret_cast<const u32x4*>(vb + (size_t)row * vs + kc * 8);
  }
}
template <int DQK>
DI void attn_sts(u16* sK, u16* sVT, const u32x4 (&rk)[DQK / 32], const u32x4 (&rv)[4]) {
  constexpr int CPR = DQK / 8;
  const int tid = TIDX;
#pragma unroll
  for (int i = 0; i < DQK / 32; ++i) {
    const int c = tid + 256 * i, row = c / CPR, kc = c % CPR;
    *reinterpret_cast<u32x4*>(sK + row * (DQK + 8) + kc * 8) = rk[i];
  }
#pragma unroll
  for (int i = 0; i < 4; ++i) {
    const int c = tid + 256 * i, row = c >> 3, kc = c & 7;
    *reinterpret_cast<u32x4*>(sVT + row * 72 + kc * 8) = rv[i];
  }
}

template <int DQK, bool NA>
DI void attn_run(const AttnSrc& src, const u16* qblk, int qstride, u16* sQ, u16* sK, u16* sVT, f32x16 (&O)[4], float& l_out,
                 int qr, int qc, int rsmin, const float* sBias) {
  const int tid = TIDX, lane = tid & 63, wid = tid >> 6;
  const int r = lane & 31, h = lane >> 5;
  const int pr = (r & 0x13) | ((r & 4) << 1) | ((r & 8) >> 1);
  constexpr int CPR = DQK / 8, QS = DQK + 8;
  __syncthreads();
#pragma unroll
  for (int i = 0; i < DQK / 16; ++i) {
    const int c = tid + 256 * i, row = c / CPR, kc = c % CPR;
    *reinterpret_cast<u32x4*>(sQ + row * QS + kc * 8) = *reinterpret_cast<const u32x4*>(qblk + (size_t)row * qstride + kc * 8);
  }
#pragma unroll
  for (int d = 0; d < 4; ++d)
#pragma unroll
    for (int i = 0; i < 16; ++i) O[d][i] = 0.f;
  float m = -1e30f, l = 0.f;
  const int nt = src.n0 + src.n1;
  const int rsq = min(max(qr - 4, 0), 56);
  const int cs = min(max(qc - 8, 0), 48);
  const u16* qw = sQ + (wid * 32 + r) * QS + 8 * h;
  const u16* kw = sK + pr * QS + 8 * h;
  const u16* vw = sVT + r * 72 + 8 * h;
  u32x4 rk[DQK / 32], rv[4];
  attn_ldg<DQK>(src, 0, rk, rv);
#pragma unroll 1
  for (int j = 0; j < nt; ++j) {
    if (j > 0) __syncthreads();
    attn_sts<DQK>(sK, sVT, rk, rv);
    __syncthreads();
    if (j + 1 < nt) attn_ldg<DQK>(src, j + 1, rk, rv);
    __builtin_amdgcn_sched_barrier(0);
    bool active = true;
    int kr = 0;
    if (NA && j >= src.n0) { kr = rsmin + (j - src.n0); active = (kr >= rsq) && (kr < rsq + 8); }
    if (active) {
      f32x16 s[2];
#pragma unroll
      for (int t = 0; t < 2; ++t) {
#pragma unroll
        for (int i = 0; i < 16; ++i) s[t][i] = 0.f;
#pragma unroll
        for (int ks = 0; ks < DQK / 16; ++ks) {
          bf16x8 a = ld8(kw + t * 32 * QS + ks * 16);
          bf16x8 q = ld8(qw + ks * 16);
          s[t] = mfma32(a, q, s[t]);
        }
      }
      if (NA && j >= src.n0) {
        const float* bp = sBias + (kr - qr + 7) * 31 + (8 * h - qc + 15);
        const int kb = 8 * h - cs;
#pragma unroll
        for (int t = 0; t < 2; ++t)
#pragma unroll
          for (int i = 0; i < 16; ++i) {
            const int ko = t * 32 + 16 * (i >> 3) + (i & 7);
            const bool ok = (unsigned)(ko + kb) < 16u;
            const float bv = bp[ko];
            s[t][i] = ok ? s[t][i] + bv : -1e30f;
          }
      }
      float mx = -1e30f;
#pragma unroll
      for (int t = 0; t < 2; ++t)
#pragma unroll
        for (int i = 0; i < 16; ++i) mx = fmaxf(mx, s[t][i]);
      mx = fmaxf(mx, __shfl_xor(mx, 32));
      const float mn = fmaxf(m, mx);
      const float alpha = ex2(m - mn);
      float rsum = 0.f;
#pragma unroll
      for (int t = 0; t < 2; ++t)
#pragma unroll
        for (int i = 0; i < 16; ++i) { const float e = ex2(s[t][i] - mn); s[t][i] = e; rsum += e; }
      rsum += __shfl_xor(rsum, 32);
      l = l * alpha + rsum;
      m = mn;
#pragma unroll
      for (int d = 0; d < 4; ++d)
#pragma unroll
        for (int i = 0; i < 16; ++i) O[d][i] *= alpha;
#pragma unroll
      for (int s4 = 0; s4 < 4; ++s4) {
        const int t = s4 >> 1, b0 = (s4 & 1) * 8;
        u32x4 w = {pk2(s[t][b0], s[t][b0 + 1]), pk2(s[t][b0 + 2], s[t][b0 + 3]), pk2(s[t][b0 + 4], s[t][b0 + 5]), pk2(s[t][b0 + 6], s[t][b0 + 7])};
        const bf16x8 pf = __builtin_bit_cast(bf16x8, w);
#pragma unroll
        for (int d = 0; d < 4; ++d) {
          bf16x8 a = ld8(vw + d * 32 * 72 + s4 * 16);
          O[d] = mfma32(a, pf, O[d]);
        }
      }
    }
  }
  l_out = l;
}

DI void heavy_map(int it, int& bh, int& qb) { const int x = it & 7, idx = it >> 3; bh = x + 8 * (idx >> 5); qb = idx & 31; }

DI void diff_item(const Params& p, int l, bool sample, int bh, int qb, unsigned char* lds) {
  constexpr int NC = 6144;
  const int tid_ = TIDX, lane = tid_ & 63, wid = tid_ >> 6, r = lane & 31, h = lane >> 5;
  const int b = bh >> 3, hd = bh & 7;
  u16* sQ = reinterpret_cast<u16*>(lds);
  u16* sK = sQ + 128 * 136;
  u16* sVT = sK + 64 * 136;
  const u16* PROJ = reinterpret_cast<const u16*>(p.ws + WS_PROJ);
  const u16* VT = reinterpret_cast<const u16*>(p.ws + WS_VT);
  const int seq0 = sample ? TP + b * 4096 : b * 256;
  const int token = seq0 + qb * 128 + wid * 32 + r;
  const float* dl = p.in[20 + 10 * l];
  float pa = dl[lane] * dl[64 + lane], pb = dl[128 + lane] * dl[192 + lane];
#pragma unroll
  for (int o = 32; o >= 1; o >>= 1) { pa += __shfl_xor(pa, o); pb += __shfl_xor(pb, o); }
  const float lam_init = 0.8f - 0.6f * __expf(-0.3f * (float)l);
  const float lam = __expf(pa) - __expf(pb) + lam_init;

  u32 o1p[32];
  f32x16 O[4];
  float lsum;
#pragma unroll
  for (int comp = 0; comp < 2; ++comp) {
    AttnSrc s;
    if (sample) {
      s.k0 = reinterpret_cast<const u16*>(p.ws + WS_CK) + (size_t)l * 2097152 + (size_t)bh * 65536 + comp * 64; s.ks0 = 128;
      s.vt0 = reinterpret_cast<const u16*>(p.ws + WS_CVT) + (size_t)l * 2097152 + (size_t)bh * 65536; s.vs0 = 512; s.n0 = 8;
      s.k1 = PROJ + (size_t)seq0 * NC + 3072 + hd * 128 + comp * 64; s.ks1 = NC;
      s.vt1 = VT + 8388608 + (size_t)bh * 128 * 4096; s.vs1 = 4096; s.n1 = 64;
    } else {
      s.k0 = nullptr; s.vt0 = nullptr; s.ks0 = 0; s.vs0 = 0; s.n0 = 0;
      s.k1 = PROJ + (size_t)seq0 * NC + 3072 + hd * 128 + comp * 64; s.ks1 = NC;
      s.vt1 = VT + (size_t)bh * 128 * 256; s.vs1 = 256; s.n1 = 4;
    }
    const u16* qblk = PROJ + (size_t)(seq0 + qb * 128) * NC + 2048 + hd * 128 + comp * 64;
    attn_run<64, false>(s, qblk, NC, sQ, sK, sVT, O, lsum, 0, 0, 0, nullptr);
    const float inv = 1.f / lsum;
    if (comp == 0) {
#pragma unroll
      for (int d = 0; d < 4; ++d)
#pragma unroll
        for (int i = 0; i < 8; ++i) o1p[d * 8 + i] = pk2(O[d][2 * i] * inv, O[d][2 * i + 1] * inv);
    } else {
      float ssq = 0.f;
#pragma unroll
      for (int d = 0; d < 4; ++d)
#pragma unroll
        for (int i = 0; i < 8; ++i) {
          const u32 w = o1p[d * 8 + i];
          const float a = bflo(w) - lam * O[d][2 * i] * inv, c = bfhi(w) - lam * O[d][2 * i + 1] * inv;
          O[d][2 * i] = a; O[d][2 * i + 1] = c;
          ssq += a * a + c * c;
        }
      ssq += __shfl_xor(ssq, 32);
      const float rn = rsqrtf(ssq * (1.f / 128.f) + LN_EPS) * (1.f - lam_init);
      const float* subln = p.in[21 + 10 * l];
      const u16* gp = PROJ + (size_t)token * NC + 5120 + hd * 128;
      u16* yp = reinterpret_cast<u16*>(p.ws + WS_H) + (size_t)token * 2048 + 1024 + hd * 128;
#pragma unroll
      for (int d = 0; d < 4; ++d)
#pragma unroll
        for (int q = 0; q < 4; ++q) {
          const int dv = d * 32 + 8 * q + 4 * h;
          const u32x2 gw = *reinterpret_cast<const u32x2*>(gp + dv);
          const float4 sl = *reinterpret_cast<const float4*>(subln + dv);
          const float y0 = O[d][4 * q] * rn * sl.x * silu(bflo(gw[0]));
          const float y1 = O[d][4 * q + 1] * rn * sl.y * silu(bfhi(gw[0]));
          const float y2 = O[d][4 * q + 2] * rn * sl.z * silu(bflo(gw[1]));
          const float y3 = O[d][4 * q + 3] * rn * sl.w * silu(bfhi(gw[1]));
          *reinterpret_cast<u32x2*>(yp + dv) = (ZERO_MASK & 2) ? u32x2{0u, 0u} : u32x2{pk2(y0, y1), pk2(y2, y3)};
        }
    }
  }
}

DI void pool_item(const Params& p, int l, int pi, unsigned char* lds) {
  constexpr int NC = 6144;
  const int tid = TIDX, lane = tid & 63, wid = tid >> 6, fr = lane & 15, fq = lane >> 4;
  const int tb = pi >> 2, g = pi & 3, row0 = tb * 64;
  const int L = row0 < TP ? 256 : 4096;
  const int t0 = row0 < TP ? (row0 & 255) : ((row0 - TP) & 4095);
  u16* sIn = reinterpret_cast<u16*>(lds);
  u16* sP = sIn + 80 * 264;
  const u16* PROJ = reinterpret_cast<const u16*>(p.ws + WS_PROJ);
  __syncthreads();
#pragma unroll
  for (int i = 0; i < 10; ++i) {
    const int c = tid + 256 * i, rr = c >> 5, oc = c & 31;
    const int t = t0 - 8 + rr;
    u32x4 v = {0u, 0u, 0u, 0u};
    if (t >= 0 && t < L) v = *reinterpret_cast<const u32x4*>(PROJ + (size_t)(row0 - 8 + rr) * NC + g * 256 + oc * 8);
    *reinterpret_cast<u32x4*>(sIn + rr * 264 + oc * 8) = v;
  }
  __syncthreads();
  {
    const int oc = tid & 31, seg = tid >> 5;
    const int half = 1 << g;
#pragma unroll 1
    for (int tt = 0; tt < 8; ++tt) {
      const int tl = seg * 8 + tt, t = t0 + tl;
      const int lo = max(t - half, 0), hi = min(t + half, L);
      float a[8];
#pragma unroll
      for (int k = 0; k < 8; ++k) a[k] = 0.f;
      for (int s = lo; s < hi; ++s) {
        const u32x4 v = *reinterpret_cast<const u32x4*>(sIn + (s - t0 + 8) * 264 + oc * 8);
#pragma unroll
        for (int k = 0; k < 4; ++k) { a[2 * k] += bflo(v[k]); a[2 * k + 1] += bfhi(v[k]); }
      }
      const float ic = 1.f / (float)(hi - lo);
      const u32x4 x = *reinterpret_cast<const u32x4*>(sIn + (tl + 8) * 264 + oc * 8);
      u32x4 o;
#pragma unroll
      for (int k = 0; k < 4; ++k) o[k] = pk2(a[2 * k] * ic - bflo(x[k]), a[2 * k + 1] * ic - bfhi(x[k]));
      *reinterpret_cast<u32x4*>(sP + tl * 264 + oc * 8) = o;
    }
  }
  __syncthreads();
  const u16* W = reinterpret_cast<const u16*>(p.ws + WS_POOLWT) + (size_t)(l >> 1) * 262144 + (size_t)g * 65536;
  f32x4 acc[4][4];
#pragma unroll
  for (int a = 0; a < 4; ++a)
#pragma unroll
    for (int b = 0; b < 4; ++b) acc[a][b] = f32x4{0.f, 0.f, 0.f, 0.f};
#pragma unroll 2
  for (int ks = 0; ks < 8; ++ks) {
    bf16x8 af[4], bfr[4];
#pragma unroll
    for (int m = 0; m < 4; ++m) af[m] = ld8(sP + (m * 16 + fr) * 264 + ks * 32 + fq * 8);
#pragma unroll
    for (int n = 0; n < 4; ++n) bfr[n] = ld8(W + (size_t)(wid * 64 + n * 16 + fr) * 256 + ks * 32 + fq * 8);
#pragma unroll
    for (int m = 0; m < 4; ++m)
#pragma unroll
      for (int n = 0; n < 4; ++n) acc[m][n] = mfma16(af[m], bfr[n], acc[m][n]);
  }
  const float* pscale = p.in[19 + 10 * l];
  u16* Y = reinterpret_cast<u16*>(p.ws + WS_H);
#pragma unroll
  for (int n = 0; n < 4; ++n) {
    const int col = g * 256 + wid * 64 + n * 16 + fr;
    const float sc = pscale[col];
#pragma unroll
    for (int m = 0; m < 4; ++m)
#pragma unroll
      for (int j = 0; j < 4; ++j) {
        const int row = row0 + m * 16 + fq * 4 + j;
        const float gt = bf1(PROJ[(size_t)row * NC + 1024 + col]);
        float y = acc[m][n][j] * sc * silu(gt);
        if (ZERO_MASK & 1) y = 0.f;
        Y[(size_t)row * 2048 + col] = (u16)(pk2(y, 0.f) & 0xffffu);
      }
  }
}

DI void phase_mix_even(const Params& p, int l, unsigned char* lds) {
#pragma unroll 1
  for (int it = blockIdx.x; it < 1024; it += gridDim.x) { int bh, qb; heavy_map(it, bh, qb); diff_item(p, l, true, bh, qb, lds); }
#pragma unroll 1
  for (int it = blockIdx.x; it < 512; it += gridDim.x) diff_item(p, l, false, it >> 1, it & 1, lds);
#pragma unroll 1
  for (int it = blockIdx.x; it < 1536; it += gridDim.x) pool_item(p, l, it, lds);
}

DI void na_item(const Params& p, int l, bool sample, int bh, int qb, unsigned char* lds) {
  constexpr int NC = 7168;
  const int tid = TIDX, lane = tid & 63, wid = tid >> 6, r = lane & 31, h = lane >> 5;
  const int b = bh >> 3, hd = bh & 7;
  u16* sQ = reinterpret_cast<u16*>(lds);
  u16* sK = sQ + 128 * 136;
  u16* sVT = sK + 64 * 136;
  float* sBias = reinterpret_cast<float*>(sVT + 128 * 72) + 64;
  const u16* PROJ = reinterpret_cast<const u16*>(p.ws + WS_PROJ);
  const u16* VT = reinterpret_cast<const u16*>(p.ws + WS_VT);
  const int seq0 = sample ? TP + b * 4096 : b * 256;
  const int token = seq0 + qb * 128 + wid * 32 + r;
  AttnSrc s;
  int qr = 0, qc = 0, rsmin = 0;
  f32x16 O[4];
  float lsum;
  const u16* qblk = PROJ + (size_t)(seq0 + qb * 128) * NC + hd * 128;
  if (sample) {
    __syncthreads();
    const float* rpb = p.in[18 + 10 * l] + hd * 465;
    for (int e = tid; e < 465; e += 256) sBias[e] = rpb[e] * LOG2E;
    const int r0 = qb * 2;
    qr = r0 + (wid >> 1); qc = (wid & 1) * 32 + r;
    rsmin = min(max(r0 - 4, 0), 56);
    const int rs1 = min(max(r0 - 3, 0), 56);
    s.k0 = reinterpret_cast<const u16*>(p.ws + WS_CK) + (size_t)l * 2097152 + (size_t)bh * 65536; s.ks0 = 128;
    s.vt0 = reinterpret_cast<const u16*>(p.ws + WS_CVT) + (size_t)l * 2097152 + (size_t)bh * 65536; s.vs0 = 512; s.n0 = 8;
    s.k1 = PROJ + (size_t)(seq0 + rsmin * 64) * NC + 1024 + hd * 128; s.ks1 = NC;
    s.vt1 = VT + 8388608 + (size_t)bh * 128 * 4096 + rsmin * 64; s.vs1 = 4096; s.n1 = rs1 + 8 - rsmin;
    attn_run<128, true>(s, qblk, NC, sQ, sK, sVT, O, lsum, qr, qc, rsmin, sBias);
  } else {
    s.k0 = nullptr; s.vt0 = nullptr; s.ks0 = 0; s.vs0 = 0; s.n0 = 0;
    s.k1 = PROJ + (size_t)seq0 * NC + 1024 + hd * 128; s.ks1 = NC;
    s.vt1 = VT + (size_t)bh * 128 * 256; s.vs1 = 256; s.n1 = 4;
    attn_run<128, false>(s, qblk, NC, sQ, sK, sVT, O, lsum, 0, 0, 0, nullptr);
  }
  const float inv = 1.f / lsum;
  const u16* gp = PROJ + (size_t)token * NC + 3072 + hd * 128;
  u16* yp = reinterpret_cast<u16*>(p.ws + WS_H) + (size_t)token * 2048 + hd * 128;
#pragma unroll
  for (int d = 0; d < 4; ++d)
#pragma unroll
    for (int q = 0; q < 4; ++q) {
      const int dv = d * 32 + 8 * q + 4 * h;
      const u32x2 gw = *reinterpret_cast<const u32x2*>(gp + dv);
      const float y0 = O[d][4 * q] * inv * silu(bflo(gw[0]));
      const float y1 = O[d][4 * q + 1] * inv * silu(bfhi(gw[0]));
      const float y2 = O[d][4 * q + 2] * inv * silu(bflo(gw[1]));
      const float y3 = O[d][4 * q + 3] * inv * silu(bfhi(gw[1]));
      *reinterpret_cast<u32x2*>(yp + dv) = (ZERO_MASK & 4) ? u32x2{0u, 0u} : u32x2{pk2(y0, y1), pk2(y2, y3)};
    }
}

DI void sgu_item(const Params& p, int l, int si, unsigned char* lds) {
  constexpr int NC = 7168;
  const int tid = TIDX, lane = tid & 63, wid = tid >> 6, fr = lane & 15, fq = lane >> 4;
  const int ch = si >> 2, g = si & 3, row0 = ch * 128;
  u16* vnT = reinterpret_cast<u16*>(lds);
  float* sMu = reinterpret_cast<float*>(vnT + 256 * 136);
  float* sRs = sMu + 128;
  const u16* PROJ = reinterpret_cast<const u16*>(p.ws + WS_PROJ);
  __syncthreads();
  {
    const int grp = tid >> 4, ln = tid & 15;
#pragma unroll 1
    for (int rr = 0; rr < 8; ++rr) {
      const u16* src = PROJ + (size_t)(row0 + grp * 8 + rr) * NC + 5120;
      float s = 0.f, ss = 0.f;
#pragma unroll
      for (int c8 = 0; c8 < 8; ++c8) {
        const u32x4 v = *reinterpret_cast<const u32x4*>(src + (ln + 16 * c8) * 8);
#pragma unroll
        for (int k = 0; k < 4; ++k) { const float a = bflo(v[k]), b = bfhi(v[k]); s += a + b; ss += a * a + b * b; }
      }
#pragma unroll
      for (int o = 8; o >= 1; o >>= 1) { s += __shfl_xor(s, o); ss += __shfl_xor(ss, o); }
      const float mu = s * (1.f / 1024.f);
      const float var = fmaxf(ss * (1.f / 1024.f) - mu * mu, 0.f);
      if (ln == 0) { sMu[grp * 8 + rr] = mu; sRs[grp * 8 + rr] = rsqrtf(var + LN_EPS); }
    }
  }
  __syncthreads();
  {
    const int j = tid & 127, hf = tid >> 7;
    const float mu = sMu[j], rs = sRs[j];
    const float* lng = p.in[19 + 10 * l] + g * 256;
    const u16* src = PROJ + (size_t)(row0 + j) * NC + 5120 + g * 256;
#pragma unroll 1
    for (int oc = hf * 16; oc < hf * 16 + 16; ++oc) {
      const u32x4 v = *reinterpret_cast<const u32x4*>(src + oc * 8);
      const float4 g0 = *reinterpret_cast<const float4*>(lng + oc * 8), g1 = *reinterpret_cast<const float4*>(lng + oc * 8 + 4);
      const float gg[8] = {g0.x, g0.y, g0.z, g0.w, g1.x, g1.y, g1.z, g1.w};
#pragma unroll
      for (int k = 0; k < 4; ++k) {
        const float a = (bflo(v[k]) - mu) * rs * gg[2 * k], b = (bfhi(v[k]) - mu) * rs * gg[2 * k + 1];
        const u32 w = pk2(a, b);
        vnT[(oc * 8 + 2 * k) * 136 + j] = (u16)(w & 0xffffu);
        vnT[(oc * 8 + 2 * k + 1) * 136 + j] = (u16)(w >> 16);
      }
    }
  }
  __syncthreads();
  const u16* W = reinterpret_cast<const u16*>(p.ws + WS_SGUW) + (size_t)(l >> 1) * 65536 + (size_t)g * 16384;
  const float* bs = p.in[21 + 10 * l] + g * 128;
  u16* Y = reinterpret_cast<u16*>(p.ws + WS_H);
#pragma unroll 1
  for (int ih = 0; ih < 2; ++ih) {
    f32x4 acc[4][4];
#pragma unroll
    for (int a = 0; a < 4; ++a)
#pragma unroll
      for (int b = 0; b < 4; ++b) acc[a][b] = f32x4{0.f, 0.f, 0.f, 0.f};
#pragma unroll
    for (int ks = 0; ks < 4; ++ks) {
      bf16x8 af[4], bfr[4];
#pragma unroll
      for (int m = 0; m < 4; ++m) af[m] = ld8(W + (size_t)(ih * 64 + m * 16 + fr) * 128 + ks * 32 + fq * 8);
#pragma unroll
      for (int n = 0; n < 4; ++n) bfr[n] = ld8(vnT + (wid * 64 + n * 16 + fr) * 136 + ks * 32 + fq * 8);
#pragma unroll
      for (int m = 0; m < 4; ++m)
#pragma unroll
        for (int n = 0; n < 4; ++n) acc[m][n] = mfma16(af[m], bfr[n], acc[m][n]);
    }
#pragma unroll
    for (int m = 0; m < 4; ++m)
#pragma unroll
      for (int j = 0; j < 4; ++j) {
        const int ii = ih * 64 + m * 16 + fq * 4 + j;
        const float bias = bs[ii];
        const size_t rb = (size_t)(row0 + ii) * NC;
#pragma unroll
        for (int n = 0; n < 4; ++n) {
          const int c = g * 256 + wid * 64 + n * 16 + fr;
          const float u = bf1(PROJ[rb + 4096 + c]), dg = bf1(PROJ[rb + 6144 + c]);
          float y = u * (acc[m][n][j] + bias) * silu(dg);
          if (ZERO_MASK & 8) y = 0.f;
          Y[(size_t)(row0 + ii) * 2048 + 1024 + c] = (u16)(pk2(y, 0.f) & 0xffffu);
        }
      }
  }
}

DI void phase_mix_odd(const Params& p, int l, unsigned char* lds) {
#pragma unroll 1
  for (int it = blockIdx.x; it < 1024; it += gridDim.x) { int bh, qb; heavy_map(it, bh, qb); na_item(p, l, true, bh, qb, lds); }
#pragma unroll 1
  for (int it = blockIdx.x; it < 512; it += gridDim.x) na_item(p, l, false, it >> 1, it & 1, lds);
#pragma unroll 1
  for (int it = blockIdx.x; it < 768; it += gridDim.x) sgu_item(p, l, it, lds);
}

__global__ void __launch_bounds__(256, 2) fwd_megakernel(Params p) {
  extern __shared__ __attribute__((aligned(16))) unsigned char lds[];
  cg::grid_group grid = cg::this_grid();
  for (int ph = p.ph_lo; ph < p.ph_hi; ++ph) {
    if (ph == 0) phase_prep(p, lds);
    else if (ph == 1) phase_mod0(p);
    else {
      const int l = (ph - 2) >> 2, s = (ph - 2) & 3;
      if (s == 0) { for (int rep = 0; rep < REP0; ++rep) { if (l & 1) gemm_phase<G_IN_ODD>(p, l, lds); else gemm_phase<G_IN_EVEN>(p, l, lds); } }
      else if (s == 1) { for (int rep = 0; rep < REP1; ++rep) { if (l & 1) phase_mix_odd(p, l, lds); else phase_mix_even(p, l, lds); } }
      else if (s == 2) gemm_phase<G_OUT>(p, l, lds);
      else phase_ln(p, l);
    }
    if (ph + 1 < p.ph_hi) {
      __builtin_amdgcn_fence(__ATOMIC_RELEASE, "agent");
      grid.sync();
      __builtin_amdgcn_fence(__ATOMIC_ACQUIRE, "agent");
    }
  }
}

extern "C" void kernel_launch(void* const* d_in, const int* in_sizes, int n_in, void* d_out, int out_size, void* d_ws, size_t ws_size,
                              hipStream_t stream) {
  static int grid_blocks = 0;
  if (grid_blocks == 0) {
    if (n_in != 52 || ws_size < WS_END) {
      fprintf(stderr, "kernel_launch: expected 52 inputs and >= %zu bytes of workspace; got %d, %zu\n", (size_t)WS_END, n_in, ws_size);
      grid_blocks = -1;
      return;
    }
    int dev = 0, cus = 0, per_cu = 0;
    hipGetDevice(&dev);
    hipDeviceGetAttribute(&cus, hipDeviceAttributeMultiprocessorCount, dev);
    hipFuncSetAttribute((const void*)fwd_megakernel, hipFuncAttributeMaxDynamicSharedMemorySize, LDS_BYTES);
    hipOccupancyMaxActiveBlocksPerMultiprocessor(&per_cu, (const void*)fwd_megakernel, 256, LDS_BYTES);
    if (per_cu < 1) per_cu = 1;
    if (per_cu > 2) per_cu = 2;
    grid_blocks = cus * per_cu;
  }
  if (grid_blocks < 0) return;
  Params p{};
  for (int i = 0; i < 52; ++i) p.in[i] = (const float*)d_in[i];
  p.out = (float*)d_out;
  p.ws = (unsigned char*)d_ws;
#if MULTI
  for (int ph = 0; ph < NPHASE; ++ph) {
    p.ph_lo = ph; p.ph_hi = ph + 1;
    hipLaunchKernelGGL(fwd_megakernel, dim3(grid_blocks), dim3(256), LDS_BYTES, stream, p);
  }
#else
  p.ph_lo = 0; p.ph_hi = NPHASE;
  void* args[] = {&p};
  hipError_t e = hipLaunchCooperativeKernel((const void*)fwd_megakernel, dim3(grid_blocks), dim3(256), args, LDS_BYTES, stream);
  if (e != hipSuccess) fprintf(stderr, "cooperative launch failed: %s (grid %d)\n", hipGetErrorString(e), grid_blocks);
#endif
}
```

```cpp
#include <hip/hip_runtime.h>
#include <hip/hip_cooperative_groups.h>
#include <cstdio>
namespace cg = cooperative_groups;

#define DI __device__ __forceinline__
typedef unsigned short u16;
typedef unsigned int u32;
using bf16x8 = __attribute__((ext_vector_type(8))) short;
using f32x4 = __attribute__((ext_vector_type(4))) float;
using f32x16 = __attribute__((ext_vector_type(16))) float;
using u32x4 = __attribute__((ext_vector_type(4))) unsigned;
using u32x2 = __attribute__((ext_vector_type(2))) unsigned;
typedef __bf16 bf2_t __attribute__((ext_vector_type(2)));
typedef float f2_t __attribute__((ext_vector_type(2)));

#ifndef MULTI
#define MULTI 0
#endif
#ifndef REP0
#define REP0 1
#endif
#ifndef REP1
#define REP1 1
#endif
#ifndef ZERO_MASK
#define ZERO_MASK 0
#endif

constexpr int T_ALL = 24576, TP = 8192, DM = 2048;
constexpr float LOG2E = 1.4426950408889634f;
constexpr float ALPHA = 1.6817928305074290f;
constexpr float LN_EPS = 1e-5f;
constexpr int LDS_BYTES = 76288;
constexpr int NPHASE = 18;

constexpr size_t SZ_WIN_E = (size_t)6144 * 2048 * 2, SZ_WIN_O = (size_t)7168 * 2048 * 2;
constexpr size_t WS_WINT = 0;
constexpr size_t WS_WOUTT = WS_WINT + 2 * SZ_WIN_E + 2 * SZ_WIN_O;
constexpr size_t WS_POOLWT = WS_WOUTT + (size_t)4 * 2048 * 2048 * 2;
constexpr size_t WS_SGUW = WS_POOLWT + (size_t)2 * 4 * 256 * 256 * 2;
constexpr size_t WS_CK = WS_SGUW + (size_t)2 * 4 * 128 * 128 * 2;
constexpr size_t WS_CVT = WS_CK + (size_t)4 * 4194304;
constexpr size_t WS_MOD = WS_CVT + (size_t)4 * 4194304;
constexpr size_t WS_ROPE = WS_MOD + (size_t)4 * 5 * 6144 * 4;
constexpr size_t WS_H = WS_ROPE + 8192;
constexpr size_t WS_PROJ = WS_H + (size_t)T_ALL * 2048 * 2;
constexpr size_t WS_VT = WS_PROJ + (size_t)T_ALL * 7168 * 2;
constexpr size_t WS_END = WS_VT + (size_t)T_ALL * 1024 * 2;

struct Params {
  const float* in[52];
  float* out;
  unsigned char* ws;
  int ph_lo, ph_hi;
};

DI size_t ws_wint(int l) { return WS_WINT + (size_t)(l >> 1) * (SZ_WIN_E + SZ_WIN_O) + ((l & 1) ? SZ_WIN_E : 0); }

DI u32 pk2(float a, float b) { f2_t v = {a, b}; bf2_t r = __builtin_convertvector(v, bf2_t); return __builtin_bit_cast(u32, r); }
DI float bflo(u32 w) { return __uint_as_float(w << 16); }
DI float bfhi(u32 w) { return __uint_as_float(w & 0xffff0000u); }
DI float bf1(u16 w) { return __uint_as_float(((u32)w) << 16); }
DI float ex2(float x) { return __builtin_amdgcn_exp2f(x); }
DI float silu(float x) { return x / (1.f + __expf(-x)); }
DI f32x4 mfma16(bf16x8 a, bf16x8 b, f32x4 c) { return __builtin_amdgcn_mfma_f32_16x16x32_bf16(a, b, c, 0, 0, 0); }
DI f32x16 mfma32(bf16x8 a, bf16x8 b, f32x16 c) { return __builtin_amdgcn_mfma_f32_32x32x16_bf16(a, b, c, 0, 0, 0); }
DI bf16x8 ld8(const u16* p) { return *reinterpret_cast<const bf16x8*>(p); }
DI int opq(int x) { asm volatile("" : "+v"(x)); return x; }
#define TIDX opq((int)threadIdx.x)

DI void tr_tile(const float* __restrict__ src, size_t ld_src, u16* __restrict__ dst, size_t ld_dst, float* sT) {
  const int tid = TIDX;
  const int r = tid >> 4, c4 = (tid & 15) * 4;
#pragma unroll
  for (int i = 0; i < 4; ++i) {
    float4 v = *reinterpret_cast<const float4*>(src + (size_t)(r + 16 * i) * ld_src + c4);
    float* d = sT + (r + 16 * i) * 65 + c4;
    d[0] = v.x; d[1] = v.y; d[2] = v.z; d[3] = v.w;
  }
  __syncthreads();
  const int n = tid >> 2, ks = (tid & 3) * 16;
  u32 w[8];
#pragma unroll
  for (int j = 0; j < 8; ++j) w[j] = pk2(sT[(ks + 2 * j) * 65 + n], sT[(ks + 2 * j + 1) * 65 + n]);
  u32x4* o = reinterpret_cast<u32x4*>(dst + (size_t)n * ld_dst + ks);
  o[0] = u32x4{w[0], w[1], w[2], w[3]};
  o[1] = u32x4{w[4], w[5], w[6], w[7]};
  __syncthreads();
}

DI void cvt8(const float* __restrict__ src, u16* __restrict__ dst) {
  float4 a = *reinterpret_cast<const float4*>(src);
  float4 b = *reinterpret_cast<const float4*>(src + 4);
  *reinterpret_cast<u32x4*>(dst) = u32x4{pk2(a.x, a.y), pk2(a.z, a.w), pk2(b.x, b.y), pk2(b.z, b.w)};
}

DI void mod_item(const Params& p, int i, unsigned char* lds) {
  const int tid = TIDX;
  const int l = i / 96, n0 = (i % 96) * 64;
  float* sS = reinterpret_cast<float*>(lds);
  float* red = sS + 5 * 2048;
  const float* c = p.in[10];
  const float* cctx = p.in[11];
  for (int e = tid; e < 5 * 2048; e += 256) {
    int v = e >> 11, k = e & 2047;
    float x = (v == 0) ? cctx[k] : c[(v - 1) * 2048 + k];
    sS[e] = silu(x);
  }
  __syncthreads();
  const int kk = tid >> 4, c4 = (tid & 15) * 4;
  const float* W = p.in[12 + 10 * l] + n0 + c4;
  f32x4 acc[5];
#pragma unroll
  for (int v = 0; v < 5; ++v) acc[v] = f32x4{0.f, 0.f, 0.f, 0.f};
#pragma unroll 8
  for (int k = kk; k < 2048; k += 16) {
    float4 w = *reinterpret_cast<const float4*>(W + (size_t)k * 6144);
#pragma unroll
    for (int v = 0; v < 5; ++v) {
      float s = sS[v * 2048 + k];
      acc[v][0] += s * w.x; acc[v][1] += s * w.y; acc[v][2] += s * w.z; acc[v][3] += s * w.w;
    }
  }
#pragma unroll
  for (int v = 0; v < 5; ++v)
#pragma unroll
    for (int q = 0; q < 4; ++q) red[(kk * 5 + v) * 64 + c4 + q] = acc[v][q];
  __syncthreads();
  for (int t2 = tid; t2 < 320; t2 += 256) {
    int v = t2 >> 6, n = t2 & 63;
    float s = 0.f;
#pragma unroll
    for (int k2 = 0; k2 < 16; ++k2) s += red[(k2 * 5 + v) * 64 + n];
    float* mod = reinterpret_cast<float*>(p.ws + WS_MOD);
    mod[(size_t)(l * 5 + v) * 6144 + n0 + n] = s + p.in[13 + 10 * l][n0 + n];
  }
  __syncthreads();
}

DI void phase_prep(const Params& p, unsigned char* lds) {
  constexpr int N_MOD = 384, N_TRWIN = 13312, N_TRWOUT = 4096, N_TRPOOL = 128, N_SGU = 64, N_CK = 4096, N_CV = 2048;
  constexpr int TOTAL = N_MOD + N_TRWIN + N_TRWOUT + N_TRPOOL + N_SGU + N_CK + N_CV + 1;
  const int tid = TIDX;
  float* sT = reinterpret_cast<float*>(lds);
  for (int it = blockIdx.x; it < TOTAL; it += gridDim.x) {
    int i = it;
    if (i < N_MOD) { mod_item(p, i, lds); continue; }
    i -= N_MOD;
    if (i < N_TRWIN) {
      int l, base;
      if (i < 3072) { l = 0; base = 0; } else if (i < 6656) { l = 1; base = 3072; } else if (i < 9728) { l = 2; base = 6656; } else { l = 3; base = 9728; }
      i -= base;
      const int N = (l & 1) ? 7168 : 6144, nN = N / 64;
      const int kt = i / nN, nt = i % nN;
      tr_tile(p.in[14 + 10 * l] + (size_t)kt * 64 * N + nt * 64, N,
              reinterpret_cast<u16*>(p.ws + ws_wint(l)) + (size_t)nt * 64 * 2048 + kt * 64, 2048, sT);
      continue;
    }
    i -= N_TRWIN;
    if (i < N_TRWOUT) {
      const int l = i >> 10, r = i & 1023, kt = r >> 5, nt = r & 31;
      tr_tile(p.in[15 + 10 * l] + (size_t)kt * 64 * 2048 + nt * 64, 2048,
              reinterpret_cast<u16*>(p.ws + WS_WOUTT) + (size_t)l * 2048 * 2048 + (size_t)nt * 64 * 2048 + kt * 64, 2048, sT);
      continue;
    }
    i -= N_TRWOUT;
    if (i < N_TRPOOL) {
      const int e = i >> 6, r = i & 63, g = r >> 4, t = r & 15, kt = t >> 2, nt = t & 3;
      tr_tile(p.in[18 + 20 * e] + (size_t)g * 65536 + kt * 64 * 256 + nt * 64, 256,
              reinterpret_cast<u16*>(p.ws + WS_POOLWT) + (size_t)e * 262144 + g * 65536 + nt * 64 * 256 + kt * 64, 256, sT);
      continue;
    }
    i -= N_TRPOOL;
    if (i < N_SGU) {
      const int e = i >> 5, ch = i & 31;
      const size_t off = (size_t)ch * 2048 + tid * 8;
      cvt8(p.in[30 + 20 * e] + off, reinterpret_cast<u16*>(p.ws + WS_SGUW) + (size_t)e * 65536 + off);
      continue;
    }
    i -= N_SGU;
    if (i < N_CK) {
      const int l = i >> 10, ch = i & 1023;
      const size_t off = (size_t)ch * 2048 + tid * 8;
      cvt8(p.in[2 + 2 * l] + off, reinterpret_cast<u16*>(p.ws + WS_CK) + (size_t)l * 2097152 + off);
      continue;
    }
    i -= N_CK;
    if (i < N_CV) {
      const int l = i >> 9, r = i & 511, bh = r >> 4, t = r & 15, kt = t >> 1, nt = t & 1;
      tr_tile(p.in[3 + 2 * l] + (size_t)bh * 65536 + kt * 64 * 128 + nt * 64, 128,
              reinterpret_cast<u16*>(p.ws + WS_CVT) + (size_t)l * 2097152 + (size_t)bh * 65536 + nt * 64 * 512 + kt * 64, 512, sT);
      continue;
    }
    {
      float* rc = reinterpret_cast<float*>(p.ws + WS_ROPE);
      for (int e = tid; e < 1024; e += 256) {
        int pos = e >> 4, fi = e & 15;
        float inv = 1.0f / powf(10000.0f, (float)(2 * fi) / 32.0f);
        float ang = (float)pos * inv;
        rc[e] = cosf(ang);
        rc[1024 + e] = sinf(ang);
      }
    }
  }
}

DI void phase_mod0(const Params& p) {
  const int tid = TIDX;
  const float* mod = reinterpret_cast<const float*>(p.ws + WS_MOD);
  u16* H = reinterpret_cast<u16*>(p.ws + WS_H);
  for (int it = blockIdx.x; it < T_ALL / 4; it += gridDim.x) {
#pragma unroll
    for (int rr = 0; rr < 4; ++rr) {
      const int row = it * 4 + rr;
      const int cond = row < TP ? 0 : 1 + ((row - TP) >> 12);
      const float* src = row < TP ? p.in[0] + (size_t)row * 2048 : p.in[1] + (size_t)(row - TP) * 2048;
      const int e = tid * 8;
      const float* sh = mod + (size_t)cond * 6144 + e;
      float4 a = *reinterpret_cast<const float4*>(src + e), b = *reinterpret_cast<const float4*>(src + e + 4);
      float4 s0 = *reinterpret_cast<const float4*>(sh), s1 = *reinterpret_cast<const float4*>(sh + 4);
      float4 c0 = *reinterpret_cast<const float4*>(sh + 2048), c1 = *reinterpret_cast<const float4*>(sh + 2052);
      u32x4 o = {pk2(a.x * (1.f + c0.x) + s0.x, a.y * (1.f + c0.y) + s0.y), pk2(a.z * (1.f + c0.z) + s0.z, a.w * (1.f + c0.w) + s0.w),
                 pk2(b.x * (1.f + c1.x) + s1.x, b.y * (1.f + c1.y) + s1.y), pk2(b.z * (1.f + c1.z) + s1.z, b.w * (1.f + c1.w) + s1.w)};
      *reinterpret_cast<u32x4*>(H + (size_t)row * 2048 + e) = o;
    }
  }
}

enum { G_IN_EVEN = 0, G_IN_ODD = 1, G_OUT = 2 };

template <int MODE>
DI void gemm_phase(const Params& p, int l, unsigned char* lds) {
  constexpr int K = 2048;
  constexpr int N = (MODE == G_OUT) ? 2048 : (MODE == G_IN_EVEN ? 6144 : 7168);
  constexpr int NC = (MODE == G_IN_EVEN) ? 6144 : 7168;
  constexpr int nTn = N / 128;
  constexpr int TOTAL = nTn * 192;
  const u16* A = reinterpret_cast<const u16*>(p.ws + WS_H);
  const u16* Bt = (MODE == G_OUT) ? reinterpret_cast<const u16*>(p.ws + WS_WOUTT) + (size_t)l * 2048 * 2048
                                  : reinterpret_cast<const u16*>(p.ws + ws_wint(l));
  u16* sA = reinterpret_cast<u16*>(lds);
  u16* sB = sA + 2 * 128 * 64;
  const int tid = TIDX, lane = tid & 63, wid = tid >> 6;
  const int wr = wid >> 1, wc = wid & 1, fr = lane & 15, fq = lane >> 4;
  const int lrow = tid >> 3;
  const int csrc = ((tid & 7) ^ ((lrow >> 1) & 7)) * 8;
  const int swz = (fr >> 1) & 7;
  const int fo0 = (fq ^ swz) * 8, fo1 = ((4 + fq) ^ swz) * 8;
  u16* PROJ = reinterpret_cast<u16*>(p.ws + WS_PROJ);
  u16* VT = reinterpret_cast<u16*>(p.ws + WS_VT);
  const float* mod = reinterpret_cast<const float*>(p.ws + WS_MOD);
  const float* ropeC = reinterpret_cast<const float*>(p.ws + WS_ROPE);
  const float* ropeS = ropeC + 1024;

  for (int it = blockIdx.x; it < TOTAL; it += gridDim.x) {
    constexpr int PN = nTn / 8;
    const int rnd = it >> 9, vb = it & 511, q = rnd * 8 + (vb & 7), jj = vb >> 3;
    const int tm = (q / PN) * 8 + (jj & 7), tn = (q % PN) * 8 + (jj >> 3);
    const u16* ga = A + (size_t)(tm * 128 + lrow) * K + csrc;
    const u16* gb = Bt + (size_t)(tn * 128 + lrow) * K + csrc;
    f32x4 acc[4][4];
#pragma unroll
    for (int a = 0; a < 4; ++a)
#pragma unroll
      for (int b = 0; b < 4; ++b) acc[a][b] = f32x4{0.f, 0.f, 0.f, 0.f};
#define GSTAGE(B_, KT_)                                                                                                   \
  _Pragma("unroll") for (int i = 0; i < 4; ++i) {                                                                         \
    __builtin_amdgcn_global_load_lds((const unsigned*)(ga + (size_t)i * 32 * K + (KT_) * 64),                             \
                                     (unsigned*)(sA + (B_) * 8192 + i * 2048 + tid * 8), 16, 0, 0);                       \
    __builtin_amdgcn_global_load_lds((const unsigned*)(gb + (size_t)i * 32 * K + (KT_) * 64),                             \
                                     (unsigned*)(sB + (B_) * 8192 + i * 2048 + tid * 8), 16, 0, 0);                       \
  }
    GSTAGE(0, 0)
    asm volatile("s_waitcnt vmcnt(0)" ::: "memory");
    __syncthreads();
    for (int kt = 0; kt < K / 64; ++kt) {
      const int buf = kt & 1;
      if (kt + 1 < K / 64) { GSTAGE(buf ^ 1, kt + 1) }
      const u16* cA = sA + buf * 8192 + (wr * 64 + fr) * 64;
      const u16* cB = sB + buf * 8192 + (wc * 64 + fr) * 64;
#pragma unroll
      for (int ks = 0; ks < 2; ++ks) {
        const int fo = ks ? fo1 : fo0;
        bf16x8 af[4], bfr[4];
#pragma unroll
        for (int m = 0; m < 4; ++m) af[m] = ld8(cA + m * 1024 + fo);
#pragma unroll
        for (int n = 0; n < 4; ++n) bfr[n] = ld8(cB + n * 1024 + fo);
#pragma unroll
        for (int m = 0; m < 4; ++m)
#pragma unroll
          for (int n = 0; n < 4; ++n) acc[m][n] = mfma16(af[m], bfr[n], acc[m][n]);
      }
      asm volatile("s_waitcnt vmcnt(0)" ::: "memory");
      __syncthreads();
    }
#undef GSTAGE
    const int rowb = tm * 128 + wr * 64 + fq * 4;
    const int colb = tn * 128 + wc * 64 + fr;
    const bool prompt = tm < 64;
    if (MODE == G_OUT) {
      const int cond = prompt ? 0 : 1 + ((tm * 128 - TP) >> 12);
      const float* gate = mod + (size_t)(l * 5 + cond) * 6144 + 4096;
      float* X = p.out;
#pragma unroll
      for (int n = 0; n < 4; ++n) {
        const int col = colb + n * 16;
        const float g = gate[col];
#pragma unroll
        for (int m = 0; m < 4; ++m)
#pragma unroll
          for (int j = 0; j < 4; ++j) {
            const int row = rowb + m * 16 + j;
            float xo;
            if (l == 0) xo = prompt ? p.in[0][(size_t)row * 2048 + col] : p.in[1][(size_t)(row - TP) * 2048 + col];
            else xo = X[(size_t)row * 2048 + col];
            X[(size_t)row * 2048 + col] = ALPHA * xo + g * acc[m][n][j];
          }
      }
    } else {
      const int sec = tn >> 3;
      const int SEC_Q = (MODE == G_IN_EVEN) ? 2 : 0, SEC_K = (MODE == G_IN_EVEN) ? 3 : 1, SEC_V = (MODE == G_IN_EVEN) ? 4 : 2;
      if (sec == SEC_V) {
        const int hh = tn & 7;
        float* vout = p.out + (size_t)T_ALL * 2048 + (size_t)(2 * l + 1) * 8388608;
#pragma unroll
        for (int m = 0; m < 4; ++m) {
          const int row = rowb + m * 16;
#pragma unroll
          for (int n = 0; n < 4; ++n) {
            const int dv = wc * 64 + n * 16 + fr;
            u32x2 w = {pk2(acc[m][n][0], acc[m][n][1]), pk2(acc[m][n][2], acc[m][n][3])};
            if (prompt) {
              const int b = row >> 8, t = row & 255;
              *reinterpret_cast<u32x2*>(VT + ((size_t)((b * 8 + hh) * 128 + dv)) * 256 + t) = w;
#pragma unroll
              for (int j = 0; j < 4; ++j) vout[((size_t)((b * 8 + hh) * 256 + t + j)) * 128 + dv] = acc[m][n][j];
            } else {
              const int rs = row - TP, b = rs >> 12, t = rs & 4095;
              *reinterpret_cast<u32x2*>(VT + 8388608 + ((size_t)((b * 8 + hh) * 128 + dv)) * 4096 + t) = w;
            }
          }
        }
      } else {
        const bool isq = sec == SEC_Q, isk = sec == SEC_K;
        const bool rope = (MODE == G_IN_EVEN) && (isq || isk) && !prompt;
        const float qs = (MODE == G_IN_EVEN) ? 0.125f * LOG2E : 0.08838834764831845f * LOG2E;
        if (isk && prompt) {
          const int hh = tn & 7;
          float* kout = p.out + (size_t)T_ALL * 2048 + (size_t)(2 * l) * 8388608;
#pragma unroll
          for (int m = 0; m < 4; ++m)
#pragma unroll
            for (int n = 0; n < 4; ++n) {
              const int d = wc * 64 + n * 16 + fr;
#pragma unroll
              for (int j = 0; j < 4; ++j) {
                const int row = rowb + m * 16 + j, b = row >> 8, t = row & 255;
                kout[((size_t)((b * 8 + hh) * 256 + t)) * 128 + d] = acc[m][n][j];
              }
            }
        }
        if (rope) {
#pragma unroll
          for (int m = 0; m < 4; ++m)
#pragma unroll
            for (int j = 0; j < 4; ++j) {
              const int t = (rowb + m * 16 + j - TP) & 4095;
              const int pr = t >> 6, pc = t & 63;
#pragma unroll
              for (int ax = 0; ax < 2; ++ax) {
                const int pos = ax ? pc : pr;
                const float cs = ropeC[pos * 16 + fr], sn = ropeS[pos * 16 + fr];
                const float x1 = acc[m][2 * ax][j], x2 = acc[m][2 * ax + 1][j];
                acc[m][2 * ax][j] = x1 * cs - x2 * sn;
                acc[m][2 * ax + 1][j] = x1 * sn + x2 * cs;
              }
            }
        }
#pragma unroll
        for (int m = 0; m < 4; ++m)
#pragma unroll
          for (int n = 0; n < 4; ++n)
#pragma unroll
            for (int j = 0; j < 4; ++j) {
              float v = acc[m][n][j];
              if (isq) v *= qs;
              const int row = rowb + m * 16 + j, col = colb + n * 16;
              PROJ[(size_t)row * NC + col] = (u16)(pk2(v, 0.f) & 0xffffu);
            }
      }
    }
  }
}

DI void phase_ln(const Params& p, int l) {
  const int tid_ = TIDX, lane = tid_ & 63, wid = tid_ >> 6;
  const float* g = p.in[16 + 10 * l];
  const float* bb = p.in[17 + 10 * l];
  const float* mod = reinterpret_cast<const float*>(p.ws + WS_MOD);
  u16* H = reinterpret_cast<u16*>(p.ws + WS_H);
  float* X = p.out;
  for (int it = blockIdx.x; it < T_ALL / 4; it += gridDim.x) {
    const int row = it * 4 + wid;
    float* xr = X + (size_t)row * 2048;
    float4 v[8];
    float s = 0.f;
#pragma unroll
    for (int i = 0; i < 8; ++i) {
      v[i] = *reinterpret_cast<const float4*>(xr + (i * 64 + lane) * 4);
      s += v[i].x + v[i].y + v[i].z + v[i].w;
    }
#pragma unroll
    for (int o = 32; o >= 1; o >>= 1) s += __shfl_xor(s, o);
    const float mu = s * (1.f / 2048.f);
    float ss = 0.f;
#pragma unroll
    for (int i = 0; i < 8; ++i) {
      float a = v[i].x - mu, b = v[i].y - mu, c = v[i].z - mu, d = v[i].w - mu;
      ss += a * a + b * b + c * c + d * d;
    }
#pragma unroll
    for (int o = 32; o >= 1; o >>= 1) ss += __shfl_xor(ss, o);
    const float rstd = rsqrtf(ss * (1.f / 2048.f) + LN_EPS);
    const int cond = row < TP ? 0 : 1 + ((row - TP) >> 12);
    const float* sh = mod + (size_t)((l + 1) * 5 + cond) * 6144;
#pragma unroll
    for (int i = 0; i < 8; ++i) {
      const int e = (i * 64 + lane) * 4;
      float4 gg = *reinterpret_cast<const float4*>(g + e), b4 = *reinterpret_cast<const float4*>(bb + e);
      float4 y;
      y.x = (v[i].x - mu) * rstd * gg.x + b4.x; y.y = (v[i].y - mu) * rstd * gg.y + b4.y;
      y.z = (v[i].z - mu) * rstd * gg.z + b4.z; y.w = (v[i].w - mu) * rstd * gg.w + b4.w;
      *reinterpret_cast<float4*>(xr + e) = y;
      if (l < 3) {
        float4 s0 = *reinterpret_cast<const float4*>(sh + e), c0 = *reinterpret_cast<const float4*>(sh + 2048 + e);
        u32x2 o = {pk2(y.x * (1.f + c0.x) + s0.x, y.y * (1.f + c0.y) + s0.y), pk2(y.z * (1.f + c0.z) + s0.z, y.w * (1.f + c0.w) + s0.w)};
        *reinterpret_cast<u32x2*>(H + (size_t)row * 2048 + e) = o;
      }
    }
  }
}

struct AttnSrc {
  const u16* k0; const u16* vt0; int ks0, vs0, n0;
  const u16* k1; const u16* vt1; int ks1, vs1, n1;
};

template <int DQK>
DI void attn_ldg(const AttnSrc& s, int j, u32x4 (&rk)[DQK / 32], u32x4 (&rv)[4]) {
  const u16* kb; const u16* vb; int ks, vs;
  if (j < s.n0) { kb = s.k0 + (size_t)j * 64 * s.ks0; vb = s.vt0 + j * 64; ks = s.ks0; vs = s.vs0; }
  else { const int jj = j - s.n0; kb = s.k1 + (size_t)jj * 64 * s.ks1; vb = s.vt1 + jj * 64; ks = s.ks1; vs = s.vs1; }
  constexpr int CPR = DQK / 8;
  const int tid = TIDX;
#pragma unroll
  for (int i = 0; i < DQK / 32; ++i) {
    const int c = tid + 256 * i, row = c / CPR, kc = c % CPR;
    rk[i] = *reinterpret_cast<const u32x4*>(kb + (size_t)row * ks + kc * 8);
  }
#pragma unroll
  for (int i = 0; i < 4; ++i) {
    const int c = tid + 256 * i, row = c >> 3, kc = c & 7;
    rv[i] = *reinterpret_cast<const u32x4*>(vb + (size_t)row * vs + kc * 8);
  }
}
template <int DQK>
DI void attn_sts(u16* sK, u16* sVT, const u32x4 (&rk)[DQK / 32], const u32x4 (&rv)[4]) {
  constexpr int CPR = DQK / 8;
  const int tid = TIDX;
#pragma unroll
  for (int i = 0; i < DQK / 32; ++i) {
    const int c = tid + 256 * i, row = c / CPR, kc = c % CPR;
    *reinterpret_cast<u32x4*>(sK + row * (DQK + 8) + kc * 8) = rk[i];
  }
#pragma unroll
  for (int i = 0; i < 4; ++i) {
    const int c = tid + 256 * i, row = c >> 3, kc = c & 7;
    *reinterpret_cast<u32x4*>(sVT + row * 72 + kc * 8) = rv[i];
  }
}

template <int DQK, bool NA>
DI void attn_run(const AttnSrc& src, const u16* qblk, int qstride, u16* sQ, u16* sK, u16* sVT, f32x16 (&O)[4], float& l_out,
                 int qr, int qc, int rsmin, const float* sBias) {
  const int tid = TIDX, lane = tid & 63, wid = tid >> 6;
  const int r = lane & 31, h = lane >> 5;
  const int pr = (r & 0x13) | ((r & 4) << 1) | ((r & 8) >> 1);
  constexpr int CPR = DQK / 8, QS = DQK + 8;
  __syncthreads();
#pragma unroll
  for (int i = 0; i < DQK / 16; ++i) {
    const int c = tid + 256 * i, row = c / CPR, kc = c % CPR;
    *reinterpret_cast<u32x4*>(sQ + row * QS + kc * 8) = *reinterpret_cast<const u32x4*>(qblk + (size_t)row * qstride + kc * 8);
  }
#pragma unroll
  for (int d = 0; d < 4; ++d)
#pragma unroll
    for (int i = 0; i < 16; ++i) O[d][i] = 0.f;
  float m = -1e30f, l = 0.f;
  const int nt = src.n0 + src.n1;
  const int rsq = min(max(qr - 4, 0), 56);
  const int cs = min(max(qc - 8, 0), 48);
  const u16* qw = sQ + (wid * 32 + r) * QS + 8 * h;
  const u16* kw = sK + pr * QS + 8 * h;
  const u16* vw = sVT + r * 72 + 8 * h;
  u32x4 rk[DQK / 32], rv[4];
  attn_ldg<DQK>(src, 0, rk, rv);
#pragma unroll 1
  for (int j = 0; j < nt; ++j) {
    if (j > 0) __syncthreads();
    attn_sts<DQK>(sK, sVT, rk, rv);
    __syncthreads();
    if (j + 1 < nt) attn_ldg<DQK>(src, j + 1, rk, rv);
    __builtin_amdgcn_sched_barrier(0);
    bool active = true;
    int kr = 0;
    if (NA && j >= src.n0) { kr = rsmin + (j - src.n0); active = (kr >= rsq) && (kr < rsq + 8); }
    if (active) {
      f32x16 s[2];
#pragma unroll
      for (int t = 0; t < 2; ++t) {
#pragma unroll
        for (int i = 0; i < 16; ++i) s[t][i] = 0.f;
#pragma unroll
        for (int ks = 0; ks < DQK / 16; ++ks) {
          bf16x8 a = ld8(kw + t * 32 * QS + ks * 16);
          bf16x8 q = ld8(qw + ks * 16);
          s[t] = mfma32(a, q, s[t]);
        }
      }
      if (NA && j >= src.n0) {
        const float* bp = sBias + (kr - qr + 7) * 31 + (8 * h - qc + 15);
        const int kb = 8 * h - cs;
#pragma unroll
        for (int t = 0; t < 2; ++t)
#pragma unroll
          for (int i = 0; i < 16; ++i) {
            const int ko = t * 32 + 16 * (i >> 3) + (i & 7);
            const bool ok = (unsigned)(ko + kb) < 16u;
            const float bv = bp[ko];
            s[t][i] = ok ? s[t][i] + bv : -1e30f;
          }
      }
      float mx = -1e30f;
#pragma unroll
      for (int t = 0; t < 2; ++t)
#pragma unroll
        for (int i = 0; i < 16; ++i) mx = fmaxf(mx, s[t][i]);
      mx = fmaxf(mx, __shfl_xor(mx, 32));
      const float mn = fmaxf(m, mx);
      const float alpha = ex2(m - mn);
      float rsum = 0.f;
#pragma unroll
      for (int t = 0; t < 2; ++t)
#pragma unroll
        for (int i = 0; i < 16; ++i) { const float e = ex2(s[t][i] - mn); s[t][i] = e; rsum += e; }
      rsum += __shfl_xor(rsum, 32);
      l = l * alpha + rsum;
      m = mn;
#pragma unroll
      for (int d = 0; d < 4; ++d)
#pragma unroll
        for (int i = 0; i < 16; ++i) O[d][i] *= alpha;
#pragma unroll
      for (int s4 = 0; s4 < 4; ++s4) {
        const int t = s4 >> 1, b0 = (s4 & 1) * 8;
        u32x4 w = {pk2(s[t][b0], s[t][b0 + 1]), pk2(s[t][b0 + 2], s[t][b0 + 3]), pk2(s[t][b0 + 4], s[t][b0 + 5]), pk2(s[t][b0 + 6], s[t][b0 + 7])};
        const bf16x8 pf = __builtin_bit_cast(bf16x8, w);
#pragma unroll
        for (int d = 0; d < 4; ++d) {
          bf16x8 a = ld8(vw + d * 32 * 72 + s4 * 16);
          O[d] = mfma32(a, pf, O[d]);
        }
      }
    }
  }
  l_out = l;
}

DI void heavy_map(int it, int& bh, int& qb) { const int x = it & 7, idx = it >> 3; bh = x + 8 * (idx >> 5); qb = idx & 31; }

DI void diff_item(const Params& p, int l, bool sample, int bh, int qb, unsigned char* lds) {
  constexpr int NC = 6144;
  const int tid_ = TIDX, lane = tid_ & 63, wid = tid_ >> 6, r = lane & 31, h = lane >> 5;
  const int b = bh >> 3, hd = bh & 7;
  u16* sQ = reinterpret_cast<u16*>(lds);
  u16* sK = sQ + 128 * 136;
  u16* sVT = sK + 64 * 136;
  const u16* PROJ = reinterpret_cast<const u16*>(p.ws + WS_PROJ);
  const u16* VT = reinterpret_cast<const u16*>(p.ws + WS_VT);
  const int seq0 = sample ? TP + b * 4096 : b * 256;
  const int token = seq0 + qb * 128 + wid * 32 + r;
  const float* dl = p.in[20 + 10 * l];
  float pa = dl[lane] * dl[64 + lane], pb = dl[128 + lane] * dl[192 + lane];
#pragma unroll
  for (int o = 32; o >= 1; o >>= 1) { pa += __shfl_xor(pa, o); pb += __shfl_xor(pb, o); }
  const float lam_init = 0.8f - 0.6f * __expf(-0.3f * (float)l);
  const float lam = __expf(pa) - __expf(pb) + lam_init;

  u32 o1p[32];
  f32x16 O[4];
  float lsum;
#pragma unroll
  for (int comp = 0; comp < 2; ++comp) {
    AttnSrc s;
    if (sample) {
      s.k0 = reinterpret_cast<const u16*>(p.ws + WS_CK) + (size_t)l * 2097152 + (size_t)bh * 65536 + comp * 64; s.ks0 = 128;
      s.vt0 = reinterpret_cast<const u16*>(p.ws + WS_CVT) + (size_t)l * 2097152 + (size_t)bh * 65536; s.vs0 = 512; s.n0 = 8;
      s.k1 = PROJ + (size_t)seq0 * NC + 3072 + hd * 128 + comp * 64; s.ks1 = NC;
      s.vt1 = VT + 8388608 + (size_t)bh * 128 * 4096; s.vs1 = 4096; s.n1 = 64;
    } else {
      s.k0 = nullptr; s.vt0 = nullptr; s.ks0 = 0; s.vs0 = 0; s.n0 = 0;
      s.k1 = PROJ + (size_t)seq0 * NC + 3072 + hd * 128 + comp * 64; s.ks1 = NC;
      s.vt1 = VT + (size_t)bh * 128 * 256; s.vs1 = 256; s.n1 = 4;
    }
    const u16* qblk = PROJ + (size_t)(seq0 + qb * 128) * NC + 2048 + hd * 128 + comp * 64;
    attn_run<64, false>(s, qblk, NC, sQ, sK, sVT, O, lsum, 0, 0, 0, nullptr);
    const float inv = 1.f / lsum;
    if (comp == 0) {
#pragma unroll
      for (int d = 0; d < 4; ++d)
#pragma unroll
        for (int i = 0; i < 8; ++i) o1p[d * 8 + i] = pk2(O[d][2 * i] * inv, O[d][2 * i + 1] * inv);
    } else {
      float ssq = 0.f;
#pragma unroll
      for (int d = 0; d < 4; ++d)
#pragma unroll
        for (int i = 0; i < 8; ++i) {
          const u32 w = o1p[d * 8 + i];
          const float a = bflo(w) - lam * O[d][2 * i] * inv, c = bfhi(w) - lam * O[d][2 * i + 1] * inv;
          O[d][2 * i] = a; O[d][2 * i + 1] = c;
          ssq += a * a + c * c;
        }
      ssq += __shfl_xor(ssq, 32);
      const float rn = rsqrtf(ssq * (1.f / 128.f) + LN_EPS) * (1.f - lam_init);
      const float* subln = p.in[21 + 10 * l];
      const u16* gp = PROJ + (size_t)token * NC + 5120 + hd * 128;
      u16* yp = reinterpret_cast<u16*>(p.ws + WS_H) + (size_t)token * 2048 + 1024 + hd * 128;
#pragma unroll
      for (int d = 0; d < 4; ++d)
#pragma unroll
        for (int q = 0; q < 4; ++q) {
          const int dv = d * 32 + 8 * q + 4 * h;
          const u32x2 gw = *reinterpret_cast<const u32x2*>(gp + dv);
          const float4 sl = *reinterpret_cast<const float4*>(subln + dv);
          const float y0 = O[d][4 * q] * rn * sl.x * silu(bflo(gw[0]));
          const float y1 = O[d][4 * q + 1] * rn * sl.y * silu(bfhi(gw[0]));
          const float y2 = O[d][4 * q + 2] * rn * sl.z * silu(bflo(gw[1]));
          const float y3 = O[d][4 * q + 3] * rn * sl.w * silu(bfhi(gw[1]));
          *reinterpret_cast<u32x2*>(yp + dv) = (ZERO_MASK & 2) ? u32x2{0u, 0u} : u32x2{pk2(y0, y1), pk2(y2, y3)};
        }
    }
  }
}

DI void pool_item(const Params& p, int l, int pi, unsigned char* lds) {
  constexpr int NC = 6144;
  const int tid = TIDX, lane = tid & 63, wid = tid >> 6, fr = lane & 15, fq = lane >> 4;
  const int tb = pi >> 2, g = pi & 3, row0 = tb * 64;
  const int L = row0 < TP ? 256 : 4096;
  const int t0 = row0 < TP ? (row0 & 255) : ((row0 - TP) & 4095);
  u16* sIn = reinterpret_cast<u16*>(lds);
  u16* sP = sIn + 80 * 264;
  const u16* PROJ = reinterpret_cast<const u16*>(p.ws + WS_PROJ);
  __syncthreads();
#pragma unroll
  for (int i = 0; i < 10; ++i) {
    const int c = tid + 256 * i, rr = c >> 5, oc = c & 31;
    const int t = t0 - 8 + rr;
    u32x4 v = {0u, 0u, 0u, 0u};
    if (t >= 0 && t < L) v = *reinterpret_cast<const u32x4*>(PROJ + (size_t)(row0 - 8 + rr) * NC + g * 256 + oc * 8);
    *reinterpret_cast<u32x4*>(sIn + rr * 264 + oc * 8) = v;
  }
  __syncthreads();
  {
    const int oc = tid & 31, seg = tid >> 5;
    const int half = 1 << g;
#pragma unroll 1
    for (int tt = 0; tt < 8; ++tt) {
      const int tl = seg * 8 + tt, t = t0 + tl;
      const int lo = max(t - half, 0), hi = min(t + half, L);
      float a[8];
#pragma unroll
      for (int k = 0; k < 8; ++k) a[k] = 0.f;
      for (int s = lo; s < hi; ++s) {
        const u32x4 v = *reinterpret_cast<const u32x4*>(sIn + (s - t0 + 8) * 264 + oc * 8);
#pragma unroll
        for (int k = 0; k < 4; ++k) { a[2 * k] += bflo(v[k]); a[2 * k + 1] += bfhi(v[k]); }
      }
      const float ic = 1.f / (float)(hi - lo);
      const u32x4 x = *reinterpret_cast<const u32x4*>(sIn + (tl + 8) * 264 + oc * 8);
      u32x4 o;
#pragma unroll
      for (int k = 0; k < 4; ++k) o[k] = pk2(a[2 * k] * ic - bflo(x[k]), a[2 * k + 1] * ic - bfhi(x[k]));
      *reinterpret_cast<u32x4*>(sP + tl * 264 + oc * 8) = o;
    }
  }
  __syncthreads();
  const u16* W = reinterpret_cast<const u16*>(p.ws + WS_POOLWT) + (size_t)(l >> 1) * 262144 + (size_t)g * 65536;
  f32x4 acc[4][4];
#pragma unroll
  for (int a = 0; a < 4; ++a)
#pragma unroll
    for (int b = 0; b < 4; ++b) acc[a][b] = f32x4{0.f, 0.f, 0.f, 0.f};
#pragma unroll 2
  for (int ks = 0; ks < 8; ++ks) {
    bf16x8 af[4], bfr[4];
#pragma unroll
    for (int m = 0; m < 4; ++m) af[m] = ld8(sP + (m * 16 + fr) * 264 + ks * 32 + fq * 8);
#pragma unroll
    for (int n = 0; n < 4; ++n) bfr[n] = ld8(W + (size_t)(wid * 64 + n * 16 + fr) * 256 + ks * 32 + fq * 8);
#pragma unroll
    for (int m = 0; m < 4; ++m)
#pragma unroll
      for (int n = 0; n < 4; ++n) acc[m][n] = mfma16(af[m], bfr[n], acc[m][n]);
  }
  const float* pscale = p.in[19 + 10 * l];
  u16* Y = reinterpret_cast<u16*>(p.ws + WS_H);
#pragma unroll
  for (int n = 0; n < 4; ++n) {
    const int col = g * 256 + wid * 64 + n * 16 + fr;
    const float sc = pscale[col];
#pragma unroll
    for (int m = 0; m < 4; ++m)
#pragma unroll
      for (int j = 0; j < 4; ++j) {
        const int row = row0 + m * 16 + fq * 4 + j;
        const float gt = bf1(PROJ[(size_t)row * NC + 1024 + col]);
        float y = acc[m][n][j] * sc * silu(gt);
        if (ZERO_MASK & 1) y = 0.f;
        Y[(size_t)row * 2048 + col] = (u16)(pk2(y, 0.f) & 0xffffu);
      }
  }
}

DI void phase_mix_even(const Params& p, int l, unsigned char* lds) {
#pragma unroll 1
  for (int it = blockIdx.x; it < 1024; it += gridDim.x) { int bh, qb; heavy_map(it, bh, qb); diff_item(p, l, true, bh, qb, lds); }
#pragma unroll 1
  for (int it = blockIdx.x; it < 512; it += gridDim.x) diff_item(p, l, false, it >> 1, it & 1, lds);
#pragma unroll 1
  for (int it = blockIdx.x; it < 1536; it += gridDim.x) pool_item(p, l, it, lds);
}

DI void na_item(const Params& p, int l, bool sample, int bh, int qb, unsigned char* lds) {
  constexpr int NC = 7168;
  const int tid = TIDX, lane = tid & 63, wid = tid >> 6, r = lane & 31, h = lane >> 5;
  const int b = bh >> 3, hd = bh & 7;
  u16* sQ = reinterpret_cast<u16*>(lds);
  u16* sK = sQ + 128 * 136;
  u16* sVT = sK + 64 * 136;
  float* sBias = reinterpret_cast<float*>(sVT + 128 * 72) + 64;
  const u16* PROJ = reinterpret_cast<const u16*>(p.ws + WS_PROJ);
  const u16* VT = reinterpret_cast<const u16*>(p.ws + WS_VT);
  const int seq0 = sample ? TP + b * 4096 : b * 256;
  const int token = seq0 + qb * 128 + wid * 32 + r;
  AttnSrc s;
  int qr = 0, qc = 0, rsmin = 0;
  f32x16 O[4];
  float lsum;
  const u16* qblk = PROJ + (size_t)(seq0 + qb * 128) * NC + hd * 128;
  if (sample) {
    __syncthreads();
    const float* rpb = p.in[18 + 10 * l] + hd * 465;
    for (int e = tid; e < 465; e += 256) sBias[e] = rpb[e] * LOG2E;
    const int r0 = qb * 2;
    qr = r0 + (wid >> 1); qc = (wid & 1) * 32 + r;
    rsmin = min(max(r0 - 4, 0), 56);
    const int rs1 = min(max(r0 - 3, 0), 56);
    s.k0 = reinterpret_cast<const u16*>(p.ws + WS_CK) + (size_t)l * 2097152 + (size_t)bh * 65536; s.ks0 = 128;
    s.vt0 = reinterpret_cast<const u16*>(p.ws + WS_CVT) + (size_t)l * 2097152 + (size_t)bh * 65536; s.vs0 = 512; s.n0 = 8;
    s.k1 = PROJ + (size_t)(seq0 + rsmin * 64) * NC + 1024 + hd * 128; s.ks1 = NC;
    s.vt1 = VT + 8388608 + (size_t)bh * 128 * 4096 + rsmin * 64; s.vs1 = 4096; s.n1 = rs1 + 8 - rsmin;
    attn_run<128, true>(s, qblk, NC, sQ, sK, sVT, O, lsum, qr, qc, rsmin, sBias);
  } else {
    s.k0 = nullptr; s.vt0 = nullptr; s.ks0 = 0; s.vs0 = 0; s.n0 = 0;
    s.k1 = PROJ + (size_t)seq0 * NC + 1024 + hd * 128; s.ks1 = NC;
    s.vt1 = VT + (size_t)bh * 128 * 256; s.vs1 = 256; s.n1 = 4;
    attn_run<128, false>(s, qblk, NC, sQ, sK, sVT, O, lsum, 0, 0, 0, nullptr);
  }
  const float inv = 1.f / lsum;
  const u16* gp = PROJ + (size_t)token * NC + 3072 + hd * 128;
  u16* yp = reinterpret_cast<u16*>(p.ws + WS_H) + (size_t)token * 2048 + hd * 128;
#pragma unroll
  for (int d = 0; d < 4; ++d)
#pragma unroll
    for (int q = 0; q < 4; ++q) {
      const int dv = d * 32 + 8 * q + 4 * h;
      const u32x2 gw = *reinterpret_cast<const u32x2*>(gp + dv);
      const float y0 = O[d][4 * q] * inv * silu(bflo(gw[0]));
      const float y1 = O[d][4 * q + 1] * inv * silu(bfhi(gw[0]));
      const float y2 = O[d][4 * q + 2] * inv * silu(bflo(gw[1]));
      const float y3 = O[d][4 * q + 3] * inv * silu(bfhi(gw[1]));
      *reinterpret_cast<u32x2*>(yp + dv) = (ZERO_MASK & 4) ? u32x2{0u, 0u} : u32x2{pk2(y0, y1), pk2(y2, y3)};
    }
}

DI void sgu_item(const Params& p, int l, int si, unsigned char* lds) {
  constexpr int NC = 7168;
  const int tid = TIDX, lane = tid & 63, wid = tid >> 6, fr = lane & 15, fq = lane >> 4;
  const int ch = si >> 2, g = si & 3, row0 = ch * 128;
  u16* vnT = reinterpret_cast<u16*>(lds);
  float* sMu = reinterpret_cast<float*>(vnT + 256 * 136);
  float* sRs = sMu + 128;
  const u16* PROJ = reinterpret_cast<const u16*>(p.ws + WS_PROJ);
  __syncthreads();
  {
    const int grp = tid >> 4, ln = tid & 15;
#pragma unroll 1
    for (int rr = 0; rr < 8; ++rr) {
      const u16* src = PROJ + (size_t)(row0 + grp * 8 + rr) * NC + 5120;
      float s = 0.f, ss = 0.f;
#pragma unroll
      for (int c8 = 0; c8 < 8; ++c8) {
        const u32x4 v = *reinterpret_cast<const u32x4*>(src + (ln + 16 * c8) * 8);
#pragma unroll
        for (int k = 0; k < 4; ++k) { const float a = bflo(v[k]), b = bfhi(v[k]); s += a + b; ss += a * a + b * b; }
      }
#pragma unroll
      for (int o = 8; o >= 1; o >>= 1) { s += __shfl_xor(s, o); ss += __shfl_xor(ss, o); }
      const float mu = s * (1.f / 1024.f);
      const float var = fmaxf(ss * (1.f / 1024.f) - mu * mu, 0.f);
      if (ln == 0) { sMu[grp * 8 + rr] = mu; sRs[grp * 8 + rr] = rsqrtf(var + LN_EPS); }
    }
  }
  __syncthreads();
  {
    const int j = tid & 127, hf = tid >> 7;
    const float mu = sMu[j], rs = sRs[j];
    const float* lng = p.in[19 + 10 * l] + g * 256;
    const u16* src = PROJ + (size_t)(row0 + j) * NC + 5120 + g * 256;
#pragma unroll 1
    for (int oc = hf * 16; oc < hf * 16 + 16; ++oc) {
      const u32x4 v = *reinterpret_cast<const u32x4*>(src + oc * 8);
      const float4 g0 = *reinterpret_cast<const float4*>(lng + oc * 8), g1 = *reinterpret_cast<const float4*>(lng + oc * 8 + 4);
      const float gg[8] = {g0.x, g0.y, g0.z, g0.w, g1.x, g1.y, g1.z, g1.w};
#pragma unroll
      for (int k = 0; k < 4; ++k) {
        const float a = (bflo(v[k]) - mu) * rs * gg[2 * k], b = (bfhi(v[k]) - mu) * rs * gg[2 * k + 1];
        const u32 w = pk2(a, b);
        vnT[(oc * 8 + 2 * k) * 136 + j] = (u16)(w & 0xffffu);
        vnT[(oc * 8 + 2 * k + 1) * 136 + j] = (u16)(w >> 16);
      }
    }
  }
  __syncthreads();
  const u16* W = reinterpret_cast<const u16*>(p.ws + WS_SGUW) + (size_t)(l >> 1) * 65536 + (size_t)g * 16384;
  const float* bs = p.in[21 + 10 * l] + g * 128;
  u16* Y = reinterpret_cast<u16*>(p.ws + WS_H);
#pragma unroll 1
  for (int ih = 0; ih < 2; ++ih) {
    f32x4 acc[4][4];
#pragma unroll
    for (int a = 0; a < 4; ++a)
#pragma unroll
      for (int b = 0; b < 4; ++b) acc[a][b] = f32x4{0.f, 0.f, 0.f, 0.f};
#pragma unroll
    for (int ks = 0; ks < 4; ++ks) {
      bf16x8 af[4], bfr[4];
#pragma unroll
      for (int m = 0; m < 4; ++m) af[m] = ld8(W + (size_t)(ih * 64 + m * 16 + fr) * 128 + ks * 32 + fq * 8);
#pragma unroll
      for (int n = 0; n < 4; ++n) bfr[n] = ld8(vnT + (wid * 64 + n * 16 + fr) * 136 + ks * 32 + fq * 8);
#pragma unroll
      for (int m = 0; m < 4; ++m)
#pragma unroll
        for (int n = 0; n < 4; ++n) acc[m][n] = mfma16(af[m], bfr[n], acc[m][n]);
    }
#pragma unroll
    for (int m = 0; m < 4; ++m)
#pragma unroll
      for (int j = 0; j < 4; ++j) {
        const int ii = ih * 64 + m * 16 + fq * 4 + j;
        const float bias = bs[ii];
        const size_t rb = (size_t)(row0 + ii) * NC;
#pragma unroll
        for (int n = 0; n < 4; ++n) {
          const int c = g * 256 + wid * 64 + n * 16 + fr;
          const float u = bf1(PROJ[rb + 4096 + c]), dg = bf1(PROJ[rb + 6144 + c]);
          float y = u * (acc[m][n][j] + bias) * silu(dg);
          if (ZERO_MASK & 8) y = 0.f;
          Y[(size_t)(row0 + ii) * 2048 + 1024 + c] = (u16)(pk2(y, 0.f) & 0xffffu);
        }
      }
  }
}

DI void phase_mix_odd(const Params& p, int l, unsigned char* lds) {
#pragma unroll 1
  for (int it = blockIdx.x; it < 1024; it += gridDim.x) { int bh, qb; heavy_map(it, bh, qb); na_item(p, l, true, bh, qb, lds); }
#pragma unroll 1
  for (int it = blockIdx.x; it < 512; it += gridDim.x) na_item(p, l, false, it >> 1, it & 1, lds);
#pragma unroll 1
  for (int it = blockIdx.x; it < 768; it += gridDim.x) sgu_item(p, l, it, lds);
}

__global__ void __launch_bounds__(256, 2) fwd_megakernel(Params p) {
  extern __shared__ __attribute__((aligned(16))) unsigned char lds[];
  cg::grid_group grid = cg::this_grid();
  for (int ph = p.ph_lo; ph < p.ph_hi; ++ph) {
    if (ph == 0) phase_prep(p, lds);
    else if (ph == 1) phase_mod0(p);
    else {
      const int l = (ph - 2) >> 2, s = (ph - 2) & 3;
      if (s == 0) { for (int rep = 0; rep < REP0; ++rep) { if (l & 1) gemm_phase<G_IN_ODD>(p, l, lds); else gemm_phase<G_IN_EVEN>(p, l, lds); } }
      else if (s == 1) { for (int rep = 0; rep < REP1; ++rep) { if (l & 1) phase_mix_odd(p, l, lds); else phase_mix_even(p, l, lds); } }
      else if (s == 2) gemm_phase<G_OUT>(p, l, lds);
      else phase_ln(p, l);
    }
    if (ph + 1 < p.ph_hi) {
      __builtin_amdgcn_fence(__ATOMIC_RELEASE, "agent");
      grid.sync();
      __builtin_amdgcn_fence(__ATOMIC_ACQUIRE, "agent");
    }
  }
}

extern "C" void kernel_launch(void* const* d_in, const int* in_sizes, int n_in, void* d_out, int out_size, void* d_ws, size_t ws_size,
                              hipStream_t stream) {
  static int grid_blocks = 0;
  if (grid_blocks == 0) {
    if (n_in != 52 || ws_size < WS_END) {
      fprintf(stderr, "kernel_launch: expected 52 inputs and >= %zu bytes of workspace; got %d, %zu\n", (size_t)WS_END, n_in, ws_size);
      grid_blocks = -1;
      return;
    }
    int dev = 0, cus = 0, per_cu = 0;
    hipGetDevice(&dev);
    hipDeviceGetAttribute(&cus, hipDeviceAttributeMultiprocessorCount, dev);
    hipFuncSetAttribute((const void*)fwd_megakernel, hipFuncAttributeMaxDynamicSharedMemorySize, LDS_BYTES);
    hipOccupancyMaxActiveBlocksPerMultiprocessor(&per_cu, (const void*)fwd_megakernel, 256, LDS_BYTES);
    if (per_cu < 1) per_cu = 1;
    if (per_cu > 2) per_cu = 2;
    grid_blocks = cus * per_cu;
  }
  if (grid_blocks < 0) return;
  Params p{};
  for (int i = 0; i < 52; ++i) p.in[i] = (const float*)d_in[i];
  p.out = (float*)d_out;
  p.ws = (unsigned char*)d_ws;
#if MULTI
  for (int ph = 0; ph < NPHASE; ++ph) {
    p.ph_lo = ph; p.ph_hi = ph + 1;
    hipLaunchKernelGGL(fwd_megakernel, dim3(grid_blocks), dim3(256), LDS_BYTES, stream, p);
  }
#else
  p.ph_lo = 0; p.ph_hi = NPHASE;
  void* args[] = {&p};
  hipError_t e = hipLaunchCooperativeKernel((const void*)fwd_megakernel, dim3(grid_blocks), dim3(256), args, LDS_BYTES, stream);
  if (e != hipSuccess) fprintf(stderr, "cooperative launch failed: %s (grid %d)\n", hipGetErrorString(e), grid_blocks);
#endif
}
```

```cpp
#include <hip/hip_runtime.h>
#include <hip/hip_cooperative_groups.h>
#include <cstdio>
namespace cg = cooperative_groups;

#define DI __device__ __forceinline__
typedef unsigned short u16;
typedef unsigned int u32;
using bf16x8 = __attribute__((ext_vector_type(8))) short;
using f32x4 = __attribute__((ext_vector_type(4))) float;
using f32x16 = __attribute__((ext_vector_type(16))) float;
using u32x4 = __attribute__((ext_vector_type(4))) unsigned;
using u32x2 = __attribute__((ext_vector_type(2))) unsigned;
typedef __bf16 bf2_t __attribute__((ext_vector_type(2)));
typedef float f2_t __attribute__((ext_vector_type(2)));

#ifndef MULTI
#define MULTI 0
#endif
#ifndef REP0
#define REP0 1
#endif
#ifndef REP1
#define REP1 1
#endif
#ifndef ZERO_MASK
#define ZERO_MASK 0
#endif

constexpr int T_ALL = 24576, TP = 8192, DM = 2048;
constexpr float LOG2E = 1.4426950408889634f;
constexpr float ALPHA = 1.6817928305074290f;
constexpr float LN_EPS = 1e-5f;
constexpr int LDS_BYTES = 76288;
constexpr int NPHASE = 18;

constexpr size_t SZ_WIN_E = (size_t)6144 * 2048 * 2, SZ_WIN_O = (size_t)7168 * 2048 * 2;
constexpr size_t WS_WINT = 0;
constexpr size_t WS_WOUTT = WS_WINT + 2 * SZ_WIN_E + 2 * SZ_WIN_O;
constexpr size_t WS_POOLWT = WS_WOUTT + (size_t)4 * 2048 * 2048 * 2;
constexpr size_t WS_SGUW = WS_POOLWT + (size_t)2 * 4 * 256 * 256 * 2;
constexpr size_t WS_CK = WS_SGUW + (size_t)2 * 4 * 128 * 128 * 2;
constexpr size_t WS_CVT = WS_CK + (size_t)4 * 4194304;
constexpr size_t WS_MOD = WS_CVT + (size_t)4 * 4194304;
constexpr size_t WS_ROPE = WS_MOD + (size_t)4 * 5 * 6144 * 4;
constexpr size_t WS_H = WS_ROPE + 8192;
constexpr size_t WS_PROJ = WS_H + (size_t)T_ALL * 2048 * 2;
constexpr size_t WS_VT = WS_PROJ + (size_t)T_ALL * 7168 * 2;
constexpr size_t WS_END = WS_VT + (size_t)T_ALL * 1024 * 2;

struct Params {
  const float* in[52];
  float* out;
  unsigned char* ws;
  int ph_lo, ph_hi;
};

DI size_t ws_wint(int l) { return WS_WINT + (size_t)(l >> 1) * (SZ_WIN_E + SZ_WIN_O) + ((l & 1) ? SZ_WIN_E : 0); }

DI u32 pk2(float a, float b) { f2_t v = {a, b}; bf2_t r = __builtin_convertvector(v, bf2_t); return __builtin_bit_cast(u32, r); }
DI float bflo(u32 w) { return __uint_as_float(w << 16); }
DI float bfhi(u32 w) { return __uint_as_float(w & 0xffff0000u); }
DI float bf1(u16 w) { return __uint_as_float(((u32)w) << 16); }
DI float ex2(float x) { return __builtin_amdgcn_exp2f(x); }
DI float silu(float x) { return x / (1.f + __expf(-x)); }
DI f32x4 mfma16(bf16x8 a, bf16x8 b, f32x4 c) { return __builtin_amdgcn_mfma_f32_16x16x32_bf16(a, b, c, 0, 0, 0); }
DI f32x16 mfma32(bf16x8 a, bf16x8 b, f32x16 c) { return __builtin_amdgcn_mfma_f32_32x32x16_bf16(a, b, c, 0, 0, 0); }
DI bf16x8 ld8(const u16* p) { return *reinterpret_cast<const bf16x8*>(p); }
DI int opq(int x) { asm volatile("" : "+v"(x)); return x; }
#define TIDX opq((int)threadIdx.x)

DI void tr_tile(const float* __restrict__ src, size_t ld_src, u16* __restrict__ dst, size_t ld_dst, float* sT) {
  const int tid = TIDX;
  const int r = tid >> 4, c4 = (tid & 15) * 4;
#pragma unroll
  for (int i = 0; i < 4; ++i) {
    float4 v = *reinterpret_cast<const float4*>(src + (size_t)(r + 16 * i) * ld_src + c4);
    float* d = sT + (r + 16 * i) * 65 + c4;
    d[0] = v.x; d[1] = v.y; d[2] = v.z; d[3] = v.w;
  }
  __syncthreads();
  const int n = tid >> 2, ks = (tid & 3) * 16;
  u32 w[8];
#pragma unroll
  for (int j = 0; j < 8; ++j) w[j] = pk2(sT[(ks + 2 * j) * 65 + n], sT[(ks + 2 * j + 1) * 65 + n]);
  u32x4* o = reinterpret_cast<u32x4*>(dst + (size_t)n * ld_dst + ks);
  o[0] = u32x4{w[0], w[1], w[2], w[3]};
  o[1] = u32x4{w[4], w[5], w[6], w[7]};
  __syncthreads();
}

DI void cvt8(const float* __restrict__ src, u16* __restrict__ dst) {
  float4 a = *reinterpret_cast<const float4*>(src);
  float4 b = *reinterpret_cast<const float4*>(src + 4);
  *reinterpret_cast<u32x4*>(dst) = u32x4{pk2(a.x, a.y), pk2(a.z, a.w), pk2(b.x, b.y), pk2(b.z, b.w)};
}

DI void mod_item(const Params& p, int i, unsigned char* lds) {
  const int tid = TIDX;
  const int l = i / 96, n0 = (i % 96) * 64;
  float* sS = reinterpret_cast<float*>(lds);
  float* red = sS + 5 * 2048;
  const float* c = p.in[10];
  const float* cctx = p.in[11];
  for (int e = tid; e < 5 * 2048; e += 256) {
    int v = e >> 11, k = e & 2047;
    float x = (v == 0) ? cctx[k] : c[(v - 1) * 2048 + k];
    sS[e] = silu(x);
  }
  __syncthreads();
  const int kk = tid >> 4, c4 = (tid & 15) * 4;
  const float* W = p.in[12 + 10 * l] + n0 + c4;
  f32x4 acc[5];
#pragma unroll
  for (int v = 0; v < 5; ++v) acc[v] = f32x4{0.f, 0.f, 0.f, 0.f};
#pragma unroll 8
  for (int k = kk; k < 2048; k += 16) {
    float4 w = *reinterpret_cast<const float4*>(W + (size_t)k * 6144);
#pragma unroll
    for (int v = 0; v < 5; ++v) {
      float s = sS[v * 2048 + k];
      acc[v][0] += s * w.x; acc[v][1] += s * w.y; acc[v][2] += s * w.z; acc[v][3] += s * w.w;
    }
  }
#pragma unroll
  for (int v = 0; v < 5; ++v)
#pragma unroll
    for (int q = 0; q < 4; ++q) red[(kk * 5 + v) * 64 + c4 + q] = acc[v][q];
  __syncthreads();
  for (int t2 = tid; t2 < 320; t2 += 256) {
    int v = t2 >> 6, n = t2 & 63;
    float s = 0.f;
#pragma unroll
    for (int k2 = 0; k2 < 16; ++k2) s += red[(k2 * 5 + v) * 64 + n];
    float* mod = reinterpret_cast<float*>(p.ws + WS_MOD);
    mod[(size_t)(l * 5 + v) * 6144 + n0 + n] = s + p.in[13 + 10 * l][n0 + n];
  }
  __syncthreads();
}

DI void phase_prep(const Params& p, unsigned char* lds) {
  constexpr int N_MOD = 384, N_TRWIN = 13312, N_TRWOUT = 4096, N_TRPOOL = 128, N_SGU = 64, N_CK = 4096, N_CV = 2048;
  constexpr int TOTAL = N_MOD + N_TRWIN + N_TRWOUT + N_TRPOOL + N_SGU + N_CK + N_CV + 1;
  const int tid = TIDX;
  float* sT = reinterpret_cast<float*>(lds);
  for (int it = blockIdx.x; it < TOTAL; it += gridDim.x) {
    int i = it;
    if (i < N_MOD) { mod_item(p, i, lds); continue; }
    i -= N_MOD;
    if (i < N_TRWIN) {
      int l, base;
      if (i < 3072) { l = 0; base = 0; } else if (i < 6656) { l = 1; base = 3072; } else if (i < 9728) { l = 2; base = 6656; } else { l = 3; base = 9728; }
      i -= base;
      const int N = (l & 1) ? 7168 : 6144, nN = N / 64;
      const int kt = i / nN, nt = i % nN;
      tr_tile(p.in[14 + 10 * l] + (size_t)kt * 64 * N + nt * 64, N,
              reinterpret_cast<u16*>(p.ws + ws_wint(l)) + (size_t)nt * 64 * 2048 + kt * 64, 2048, sT);
      continue;
    }
    i -= N_TRWIN;
    if (i < N_TRWOUT) {
      const int l = i >> 10, r = i & 1023, kt = r >> 5, nt = r & 31;
      tr_tile(p.in[15 + 10 * l] + (size_t)kt * 64 * 2048 + nt * 64, 2048,
              reinterpret_cast<u16*>(p.ws + WS_WOUTT) + (size_t)l * 2048 * 2048 + (size_t)nt * 64 * 2048 + kt * 64, 2048, sT);
      continue;
    }
    i -= N_TRWOUT;
    if (i < N_TRPOOL) {
      const int e = i >> 6, r = i & 63, g = r >> 4, t = r & 15, kt = t >> 2, nt = t & 3;
      tr_tile(p.in[18 + 20 * e] + (size_t)g * 65536 + kt * 64 * 256 + nt * 64, 256,
              reinterpret_cast<u16*>(p.ws + WS_POOLWT) + (size_t)e * 262144 + g * 65536 + nt * 64 * 256 + kt * 64, 256, sT);
      continue;
    }
    i -= N_TRPOOL;
    if (i < N_SGU) {
      const int e = i >> 5, ch = i & 31;
      const size_t off = (size_t)ch * 2048 + tid * 8;
      cvt8(p.in[30 + 20 * e] + off, reinterpret_cast<u16*>(p.ws + WS_SGUW) + (size_t)e * 65536 + off);
      continue;
    }
    i -= N_SGU;
    if (i < N_CK) {
      const int l = i >> 10, ch = i & 1023;
      const size_t off = (size_t)ch * 2048 + tid * 8;
      cvt8(p.in[2 + 2 * l] + off, reinterpret_cast<u16*>(p.ws + WS_CK) + (size_t)l * 2097152 + off);
      continue;
    }
    i -= N_CK;
    if (i < N_CV) {
      const int l = i >> 9, r = i & 511, bh = r >> 4, t = r & 15, kt = t >> 1, nt = t & 1;
      tr_tile(p.in[3 + 2 * l] + (size_t)bh * 65536 + kt * 64 * 128 + nt * 64, 128,
              reinterpret_cast<u16*>(p.ws + WS_CVT) + (size_t)l * 2097152 + (size_t)bh * 65536 + nt * 64 * 512 + kt * 64, 512, sT);
      continue;
    }
    {
      float* rc = reinterpret_cast<float*>(p.ws + WS_ROPE);
      for (int e = tid; e < 1024; e += 256) {
        int pos = e >> 4, fi = e & 15;
        float inv = 1.0f / powf(10000.0f, (float)(2 * fi) / 32.0f);
        float ang = (float)pos * inv;
        rc[e] = cosf(ang);
        rc[1024 + e] = sinf(ang);
      }
    }
  }
}

DI void phase_mod0(const Params& p) {
  const int tid = TIDX;
  const float* mod = reinterpret_cast<const float*>(p.ws + WS_MOD);
  u16* H = reinterpret_cast<u16*>(p.ws + WS_H);
  for (int it = blockIdx.x; it < T_ALL / 4; it += gridDim.x) {
#pragma unroll
    for (int rr = 0; rr < 4; ++rr) {
      const int row = it * 4 + rr;
      const int cond = row < TP ? 0 : 1 + ((row - TP) >> 12);
      const float* src = row < TP ? p.in[0] + (size_t)row * 2048 : p.in[1] + (size_t)(row - TP) * 2048;
      const int e = tid * 8;
      const float* sh = mod + (size_t)cond * 6144 + e;
      float4 a = *reinterpret_cast<const float4*>(src + e), b = *reinterpret_cast<const float4*>(src + e + 4);
      float4 s0 = *reinterpret_cast<const float4*>(sh), s1 = *reinterpret_cast<const float4*>(sh + 4);
      float4 c0 = *reinterpret_cast<const float4*>(sh + 2048), c1 = *reinterpret_cast<const float4*>(sh + 2052);
      u32x4 o = {pk2(a.x * (1.f + c0.x) + s0.x, a.y * (1.f + c0.y) + s0.y), pk2(a.z * (1.f + c0.z) + s0.z, a.w * (1.f + c0.w) + s0.w),
                 pk2(b.x * (1.f + c1.x) + s1.x, b.y * (1.f + c1.y) + s1.y), pk2(b.z * (1.f + c1.z) + s1.z, b.w * (1.f + c1.w) + s1.w)};
      *reinterpret_cast<u32x4*>(H + (size_t)row * 2048 + e) = o;
    }
  }
}

enum { G_IN_EVEN = 0, G_IN_ODD = 1, G_OUT = 2 };

template <int MODE>
DI void gemm_phase(const Params& p, int l, unsigned char* lds) {
  constexpr int K = 2048;
  constexpr int N = (MODE == G_OUT) ? 2048 : (MODE == G_IN_EVEN ? 6144 : 7168);
  constexpr int NC = (MODE == G_IN_EVEN) ? 6144 : 7168;
  constexpr int nTn = N / 128;
  constexpr int TOTAL = nTn * 192;
  const u16* A = reinterpret_cast<const u16*>(p.ws + WS_H);
  const u16* Bt = (MODE == G_OUT) ? reinterpret_cast<const u16*>(p.ws + WS_WOUTT) + (size_t)l * 2048 * 2048
                                  : reinterpret_cast<const u16*>(p.ws + ws_wint(l));
  u16* sA = reinterpret_cast<u16*>(lds);
  u16* sB = sA + 2 * 128 * 64;
  const int tid = TIDX, lane = tid & 63, wid = tid >> 6;
  const int wr = wid >> 1, wc = wid & 1, fr = lane & 15, fq = lane >> 4;
  const int lrow = tid >> 3;
  const int csrc = ((tid & 7) ^ ((lrow >> 1) & 7)) * 8;
  const int swz = (fr >> 1) & 7;
  const int fo0 = (fq ^ swz) * 8, fo1 = ((4 + fq) ^ swz) * 8;
  u16* PROJ = reinterpret_cast<u16*>(p.ws + WS_PROJ);
  u16* VT = reinterpret_cast<u16*>(p.ws + WS_VT);
  const float* mod = reinterpret_cast<const float*>(p.ws + WS_MOD);
  const float* ropeC = reinterpret_cast<const float*>(p.ws + WS_ROPE);
  const float* ropeS = ropeC + 1024;

  for (int it = blockIdx.x; it < TOTAL; it += gridDim.x) {
    constexpr int PN = nTn / 8;
    const int rnd = it >> 9, vb = it & 511, q = rnd * 8 + (vb & 7), jj = vb >> 3;
    const int tm = (q / PN) * 8 + (jj & 7), tn = (q % PN) * 8 + (jj >> 3);
    const u16* ga = A + (size_t)(tm * 128 + lrow) * K + csrc;
    const u16* gb = Bt + (size_t)(tn * 128 + lrow) * K + csrc;
    f32x4 acc[4][4];
#pragma unroll
    for (int a = 0; a < 4; ++a)
#pragma unroll
      for (int b = 0; b < 4; ++b) acc[a][b] = f32x4{0.f, 0.f, 0.f, 0.f};
#define GSTAGE(B_, KT_)                                                                                                   \
  _Pragma("unroll") for (int i = 0; i < 4; ++i) {                                                                         \
    __builtin_amdgcn_global_load_lds((const unsigned*)(ga + (size_t)i * 32 * K + (KT_) * 64),                             \
                                     (unsigned*)(sA + (B_) * 8192 + i * 2048 + tid * 8), 16, 0, 0);                       \
    __builtin_amdgcn_global_load_lds((const unsigned*)(gb + (size_t)i * 32 * K + (KT_) * 64),                             \
                                     (unsigned*)(sB + (B_) * 8192 + i * 2048 + tid * 8), 16, 0, 0);                       \
  }
    GSTAGE(0, 0)
    asm volatile("s_waitcnt vmcnt(0)" ::: "memory");
    __syncthreads();
    for (int kt = 0; kt < K / 64; ++kt) {
      const int buf = kt & 1;
      if (kt + 1 < K / 64) { GSTAGE(buf ^ 1, kt + 1) }
      const u16* cA = sA + buf * 8192 + (wr * 64 + fr) * 64;
      const u16* cB = sB + buf * 8192 + (wc * 64 + fr) * 64;
#pragma unroll
      for (int ks = 0; ks < 2; ++ks) {
        const int fo = ks ? fo1 : fo0;
        bf16x8 af[4], bfr[4];
#pragma unroll
        for (int m = 0; m < 4; ++m) af[m] = ld8(cA + m * 1024 + fo);
#pragma unroll
        for (int n = 0; n < 4; ++n) bfr[n] = ld8(cB + n * 1024 + fo);
#pragma unroll
        for (int m = 0; m < 4; ++m)
#pragma unroll
          for (int n = 0; n < 4; ++n) acc[m][n] = mfma16(af[m], bfr[n], acc[m][n]);
      }
      asm volatile("s_waitcnt vmcnt(0)" ::: "memory");
      __syncthreads();
    }
#undef GSTAGE
    const int rowb = tm * 128 + wr * 64 + fq * 4;
    const int colb = tn * 128 + wc * 64 + fr;
    const bool prompt = tm < 64;
    if (MODE == G_OUT) {
      const int cond = prompt ? 0 : 1 + ((tm * 128 - TP) >> 12);
      const float* gate = mod + (size_t)(l * 5 + cond) * 6144 + 4096;
      float* X = p.out;
#pragma unroll
      for (int n = 0; n < 4; ++n) {
        const int col = colb + n * 16;
        const float g = gate[col];
#pragma unroll
        for (int m = 0; m < 4; ++m)
#pragma unroll
          for (int j = 0; j < 4; ++j) {
            const int row = rowb + m * 16 + j;
            float xo;
            if (l == 0) xo = prompt ? p.in[0][(size_t)row * 2048 + col] : p.in[1][(size_t)(row - TP) * 2048 + col];
            else xo = X[(size_t)row * 2048 + col];
            X[(size_t)row * 2048 + col] = ALPHA * xo + g * acc[m][n][j];
          }
      }
    } else {
      const int sec = tn >> 3;
      const int SEC_Q = (MODE == G_IN_EVEN) ? 2 : 0, SEC_K = (MODE == G_IN_EVEN) ? 3 : 1, SEC_V = (MODE == G_IN_EVEN) ? 4 : 2;
      if (sec == SEC_V) {
        const int hh = tn & 7;
        float* vout = p.out + (size_t)T_ALL * 2048 + (size_t)(2 * l + 1) * 8388608;
#pragma unroll
        for (int m = 0; m < 4; ++m) {
          const int row = rowb + m * 16;
#pragma unroll
          for (int n = 0; n < 4; ++n) {
            const int dv = wc * 64 + n * 16 + fr;
            u32x2 w = {pk2(acc[m][n][0], acc[m][n][1]), pk2(acc[m][n][2], acc[m][n][3])};
            if (prompt) {
              const int b = row >> 8, t = row & 255;
              *reinterpret_cast<u32x2*>(VT + ((size_t)((b * 8 + hh) * 128 + dv)) * 256 + t) = w;
#pragma unroll
              for (int j = 0; j < 4; ++j) vout[((size_t)((b * 8 + hh) * 256 + t + j)) * 128 + dv] = acc[m][n][j];
            } else {
              const int rs = row - TP, b = rs >> 12, t = rs & 4095;
              *reinterpret_cast<u32x2*>(VT + 8388608 + ((size_t)((b * 8 + hh) * 128 + dv)) * 4096 + t) = w;
            }
          }
        }
      } else {
        const bool isq = sec == SEC_Q, isk = sec == SEC_K;
        const bool rope = (MODE == G_IN_EVEN) && (isq || isk) && !prompt;
        const float qs = (MODE == G_IN_EVEN) ? 0.125f * LOG2E : 0.08838834764831845f * LOG2E;
        if (isk && prompt) {
          const int hh = tn & 7;
          float* kout = p.out + (size_t)T_ALL * 2048 + (size_t)(2 * l) * 8388608;
#pragma unroll
          for (int m = 0; m < 4; ++m)
#pragma unroll
            for (int n = 0; n < 4; ++n) {
              const int d = wc * 64 + n * 16 + fr;
#pragma unroll
              for (int j = 0; j < 4; ++j) {
                const int row = rowb + m * 16 + j, b = row >> 8, t = row & 255;
                kout[((size_t)((b * 8 + hh) * 256 + t)) * 128 + d] = acc[m][n][j];
              }
            }
        }
        if (rope) {
#pragma unroll
          for (int m = 0; m < 4; ++m)
#pragma unroll
            for (int j = 0; j < 4; ++j) {
              const int t = (rowb + m * 16 + j - TP) & 4095;
              const int pr = t >> 6, pc = t & 63;
#pragma unroll
              for (int ax = 0; ax < 2; ++ax) {
                const int pos = ax ? pc : pr;
                const float cs = ropeC[pos * 16 + fr], sn = ropeS[pos * 16 + fr];
                const float x1 = acc[m][2 * ax][j], x2 = acc[m][2 * ax + 1][j];
                acc[m][2 * ax][j] = x1 * cs - x2 * sn;
                acc[m][2 * ax + 1][j] = x1 * sn + x2 * cs;
              }
            }
        }
#pragma unroll
        for (int m = 0; m < 4; ++m)
#pragma unroll
          for (int n = 0; n < 4; ++n)
#pragma unroll
            for (int j = 0; j < 4; ++j) {
              float v = acc[m][n][j];
              if (isq) v *= qs;
              const int row = rowb + m * 16 + j, col = colb + n * 16;
              PROJ[(size_t)row * NC + col] = (u16)(pk2(v, 0.f) & 0xffffu);
            }
      }
    }
  }
}

DI void phase_ln(const Params& p, int l) {
  const int tid_ = TIDX, lane = tid_ & 63, wid = tid_ >> 6;
  const float* g = p.in[16 + 10 * l];
  const float* bb = p.in[17 + 10 * l];
  const float* mod = reinterpret_cast<const float*>(p.ws + WS_MOD);
  u16* H = reinterpret_cast<u16*>(p.ws + WS_H);
  float* X = p.out;
  for (int it = blockIdx.x; it < T_ALL / 4; it += gridDim.x) {
    const int row = it * 4 + wid;
    float* xr = X + (size_t)row * 2048;
    float4 v[8];
    float s = 0.f;
#pragma unroll
    for (int i = 0; i < 8; ++i) {
      v[i] = *reinterpret_cast<const float4*>(xr + (i * 64 + lane) * 4);
      s += v[i].x + v[i].y + v[i].z + v[i].w;
    }
#pragma unroll
    for (int o = 32; o >= 1; o >>= 1) s += __shfl_xor(s, o);
    const float mu = s * (1.f / 2048.f);
    float ss = 0.f;
#pragma unroll
    for (int i = 0; i < 8; ++i) {
      float a = v[i].x - mu, b = v[i].y - mu, c = v[i].z - mu, d = v[i].w - mu;
      ss += a * a + b * b + c * c + d * d;
    }
#pragma unroll
    for (int o = 32; o >= 1; o >>= 1) ss += __shfl_xor(ss, o);
    const float rstd = rsqrtf(ss * (1.f / 2048.f) + LN_EPS);
    const int cond = row < TP ? 0 : 1 + ((row - TP) >> 12);
    const float* sh = mod + (size_t)((l + 1) * 5 + cond) * 6144;
#pragma unroll
    for (int i = 0; i < 8; ++i) {
      const int e = (i * 64 + lane) * 4;
      float4 gg = *reinterpret_cast<const float4*>(g + e), b4 = *reinterpret_cast<const float4*>(bb + e);
      float4 y;
      y.x = (v[i].x - mu) * rstd * gg.x + b4.x; y.y = (v[i].y - mu) * rstd * gg.y + b4.y;
      y.z = (v[i].z - mu) * rstd * gg.z + b4.z; y.w = (v[i].w - mu) * rstd * gg.w + b4.w;
      *reinterpret_cast<float4*>(xr + e) = y;
      if (l < 3) {
        float4 s0 = *reinterpret_cast<const float4*>(sh + e), c0 = *reinterpret_cast<const float4*>(sh + 2048 + e);
        u32x2 o = {pk2(y.x * (1.f + c0.x) + s0.x, y.y * (1.f + c0.y) + s0.y), pk2(y.z * (1.f + c0.z) + s0.z, y.w * (1.f + c0.w) + s0.w)};
        *reinterpret_cast<u32x2*>(H + (size_t)row * 2048 + e) = o;
      }
    }
  }
}

struct AttnSrc {
  const u16* k0; const u16* vt0; int ks0, vs0, n0;
  const u16* k1; const u16* vt1; int ks1, vs1, n1;
};

template <int DQK>
DI void attn_ldg(const AttnSrc& s, int j, u32x4 (&rk)[DQK / 32], u32x4 (&rv)[4]) {
  const u16* kb; const u16* vb; int ks, vs;
  if (j < s.n0) { kb = s.k0 + (size_t)j * 64 * s.ks0; vb = s.vt0 + j * 64; ks = s.ks0; vs = s.vs0; }
  else { const int jj = j - s.n0; kb = s.k1 + (size_t)jj * 64 * s.ks1; vb = s.vt1 + jj * 64; ks = s.ks1; vs = s.vs1; }
  constexpr int CPR = DQK / 8;
  const int tid = TIDX;
#pragma unroll
  for (int i = 0; i < DQK / 32; ++i) {
    const int c = tid + 256 * i, row = c / CPR, kc = c % CPR;
    rk[i] = *reinterpret_cast<const u32x4*>(kb + (size_t)row * ks + kc * 8);
  }
#pragma unroll
  for (int i = 0; i < 4; ++i) {
    const int c = tid + 256 * i, row = c >> 3, kc = c & 7;
    rv[i] = *reinterpret_cast<const u32x4*>(vb + (size_t)row * vs + kc * 8);
  }
}
template <int DQK>
DI void attn_sts(u16* sK, u16* sVT, const u32x4 (&rk)[DQK / 32], const u32x4 (&rv)[4]) {
  constexpr int CPR = DQK / 8;
  const int tid = TIDX;
#pragma unroll
  for (int i = 0; i < DQK / 32; ++i) {
    const int c = tid + 256 * i, row = c / CPR, kc = c % CPR;
    *reinterpret_cast<u32x4*>(sK + row * (DQK + 8) + kc * 8) = rk[i];
  }
#pragma unroll
  for (int i = 0; i < 4; ++i) {
    const int c = tid + 256 * i, row = c >> 3, kc = c & 7;
    *reinterpret_cast<u32x4*>(sVT + row * 72 + kc * 8) = rv[i];
  }
}

template <int DQK, bool NA>
DI void attn_run(const AttnSrc& src, const u16* qblk, int qstride, u16* sQ, u16* sK, u16* sVT, f32x16 (&O)[4], float& l_out,
                 int qr, int qc, int rsmin, const float* sBias) {
  const int tid = TIDX, lane = tid & 63, wid = tid >> 6;
  const int r = lane & 31, h = lane >> 5;
  const int pr = (r & 0x13) | ((r & 4) << 1) | ((r & 8) >> 1);
  constexpr int CPR = DQK / 8, QS = DQK + 8;
  __syncthreads();
#pragma unroll
  for (int i = 0; i < DQK / 16; ++i) {
    const int c = tid + 256 * i, row = c / CPR, kc = c % CPR;
    *reinterpret_cast<u32x4*>(sQ + row * QS + kc * 8) = *reinterpret_cast<const u32x4*>(qblk + (size_t)row * qstride + kc * 8);
  }
#pragma unroll
  for (int d = 0; d < 4; ++d)
#pragma unroll
    for (int i = 0; i < 16; ++i) O[d][i] = 0.f;
  float m = -1e30f, l = 0.f;
  const int nt = src.n0 + src.n1;
  const int rsq = min(max(qr - 4, 0), 56);
  const int cs = min(max(qc - 8, 0), 48);
  const u16* qw = sQ + (wid * 32 + r) * QS + 8 * h;
  const u16* kw = sK + pr * QS + 8 * h;
  const u16* vw = sVT + r * 72 + 8 * h;
  u32x4 rk[DQK / 32], rv[4];
  attn_ldg<DQK>(src, 0, rk, rv);
#pragma unroll 1
  for (int j = 0; j < nt; ++j) {
    if (j > 0) __syncthreads();
    attn_sts<DQK>(sK, sVT, rk, rv);
    __syncthreads();
    if (j + 1 < nt) attn_ldg<DQK>(src, j + 1, rk, rv);
    __builtin_amdgcn_sched_barrier(0);
    bool active = true;
    int kr = 0;
    if (NA && j >= src.n0) { kr = rsmin + (j - src.n0); active = (kr >= rsq) && (kr < rsq + 8); }
    if (active) {
      f32x16 s[2];
#pragma unroll
      for (int t = 0; t < 2; ++t) {
#pragma unroll
        for (int i = 0; i < 16; ++i) s[t][i] = 0.f;
#pragma unroll
        for (int ks = 0; ks < DQK / 16; ++ks) {
          bf16x8 a = ld8(kw + t * 32 * QS + ks * 16);
          bf16x8 q = ld8(qw + ks * 16);
          s[t] = mfma32(a, q, s[t]);
        }
      }
      if (NA && j >= src.n0) {
        const float* bp = sBias + (kr - qr + 7) * 31 + (8 * h - qc + 15);
        const int kb = 8 * h - cs;
#pragma unroll
        for (int t = 0; t < 2; ++t)
#pragma unroll
          for (int i = 0; i < 16; ++i) {
            const int ko = t * 32 + 16 * (i >> 3) + (i & 7);
            const bool ok = (unsigned)(ko + kb) < 16u;
            const float bv = bp[ko];
            s[t][i] = ok ? s[t][i] + bv : -1e30f;
          }
      }
      float mx = -1e30f;
#pragma unroll
      for (int t = 0; t < 2; ++t)
#pragma unroll
        for (int i = 0; i < 16; ++i) mx = fmaxf(mx, s[t][i]);
      mx = fmaxf(mx, __shfl_xor(mx, 32));
      const float mn = fmaxf(m, mx);
      const float alpha = ex2(m - mn);
      float rsum = 0.f;
#pragma unroll
      for (int t = 0; t < 2; ++t)
#pragma unroll
        for (int i = 0; i < 16; ++i) { const float e = ex2(s[t][i] - mn); s[t][i] = e; rsum += e; }
      rsum += __shfl_xor(rsum, 32);
      l = l * alpha + rsum;
      m = mn;
#pragma unroll
      for (int d = 0; d < 4; ++d)
#pragma unroll
        for (int i = 0; i < 16; ++i) O[d][i] *= alpha;
#pragma unroll
      for (int s4 = 0; s4 < 4; ++s4) {
        const int t = s4 >> 1, b0 = (s4 & 1) * 8;
        u32x4 w = {pk2(s[t][b0], s[t][b0 + 1]), pk2(s[t][b0 + 2], s[t][b0 + 3]), pk2(s[t][b0 + 4], s[t][b0 + 5]), pk2(s[t][b0 + 6], s[t][b0 + 7])};
        const bf16x8 pf = __builtin_bit_cast(bf16x8, w);
#pragma unroll
        for (int d = 0; d < 4; ++d) {
          bf16x8 a = ld8(vw + d * 32 * 72 + s4 * 16);
          O[d] = mfma32(a, pf, O[d]);
        }
      }
    }
  }
  l_out = l;
}

DI void heavy_map(int it, int& bh, int& qb) { const int x = it & 7, idx = it >> 3; bh = x + 8 * (idx >> 5); qb = idx & 31; }

DI void diff_item(const Params& p, int l, bool sample, int bh, int qb, unsigned char* lds) {
  constexpr int NC = 6144;
  const int tid_ = TIDX, lane = tid_ & 63, wid = tid_ >> 6, r = lane & 31, h = lane >> 5;
  const int b = bh >> 3, hd = bh & 7;
  u16* sQ = reinterpret_cast<u16*>(lds);
  u16* sK = sQ + 128 * 136;
  u16* sVT = sK + 64 * 136;
  const u16* PROJ = reinterpret_cast<const u16*>(p.ws + WS_PROJ);
  const u16* VT = reinterpret_cast<const u16*>(p.ws + WS_VT);
  const int seq0 = sample ? TP + b * 4096 : b * 256;
  const int token = seq0 + qb * 128 + wid * 32 + r;
  const float* dl = p.in[20 + 10 * l];
  float pa = dl[lane] * dl[64 + lane], pb = dl[128 + lane] * dl[192 + lane];
#pragma unroll
  for (int o = 32; o >= 1; o >>= 1) { pa += __shfl_xor(pa, o); pb += __shfl_xor(pb, o); }
  const float lam_init = 0.8f - 0.6f * __expf(-0.3f * (float)l);
  const float lam = __expf(pa) - __expf(pb) + lam_init;

  u32 o1p[32];
  f32x16 O[4];
  float lsum;
#pragma unroll
  for (int comp = 0; comp < 2; ++comp) {
    AttnSrc s;
    if (sample) {
      s.k0 = reinterpret_cast<const u16*>(p.ws + WS_CK) + (size_t)l * 2097152 + (size_t)bh * 65536 + comp * 64; s.ks0 = 128;
      s.vt0 = reinterpret_cast<const u16*>(p.ws + WS_CVT) + (size_t)l * 2097152 + (size_t)bh * 65536; s.vs0 = 512; s.n0 = 8;
      s.k1 = PROJ + (size_t)seq0 * NC + 3072 + hd * 128 + comp * 64; s.ks1 = NC;
      s.vt1 = VT + 8388608 + (size_t)bh * 128 * 4096; s.vs1 = 4096; s.n1 = 64;
    } else {
      s.k0 = nullptr; s.vt0 = nullptr; s.ks0 = 0; s.vs0 = 0; s.n0 = 0;
      s.k1 = PROJ + (size_t)seq0 * NC + 3072 + hd * 128 + comp * 64; s.ks1 = NC;
      s.vt1 = VT + (size_t)bh * 128 * 256; s.vs1 = 256; s.n1 = 4;
    }
    const u16* qblk = PROJ + (size_t)(seq0 + qb * 128) * NC + 2048 + hd * 128 + comp * 64;
    attn_run<64, false>(s, qblk, NC, sQ, sK, sVT, O, lsum, 0, 0, 0, nullptr);
    const float inv = 1.f / lsum;
    if (comp == 0) {
#pragma unroll
      for (int d = 0; d < 4; ++d)
#pragma unroll
        for (int i = 0; i < 8; ++i) o1p[d * 8 + i] = pk2(O[d][2 * i] * inv, O[d][2 * i + 1] * inv);
    } else {
      float ssq = 0.f;
#pragma unroll
      for (int d = 0; d < 4; ++d)
#pragma unroll
        for (int i = 0; i < 8; ++i) {
          const u32 w = o1p[d * 8 + i];
          const float a = bflo(w) - lam * O[d][2 * i] * inv, c = bfhi(w) - lam * O[d][2 * i + 1] * inv;
          O[d][2 * i] = a; O[d][2 * i + 1] = c;
          ssq += a * a + c * c;
        }
      ssq += __shfl_xor(ssq, 32);
      const float rn = rsqrtf(ssq * (1.f / 128.f) + LN_EPS) * (1.f - lam_init);
      const float* subln = p.in[21 + 10 * l];
      const u16* gp = PROJ + (size_t)token * NC + 5120 + hd * 128;
      u16* yp = reinterpret_cast<u16*>(p.ws + WS_H) + (size_t)token * 2048 + 1024 + hd * 128;
#pragma unroll
      for (int d = 0; d < 4; ++d)
#pragma unroll
        for (int q = 0; q < 4; ++q) {
          const int dv = d * 32 + 8 * q + 4 * h;
          const u32x2 gw = *reinterpret_cast<const u32x2*>(gp + dv);
          const float4 sl = *reinterpret_cast<const float4*>(subln + dv);
          const float y0 = O[d][4 * q] * rn * sl.x * silu(bflo(gw[0]));
          const float y1 = O[d][4 * q + 1] * rn * sl.y * silu(bfhi(gw[0]));
          const float y2 = O[d][4 * q + 2] * rn * sl.z * silu(bflo(gw[1]));
          const float y3 = O[d][4 * q + 3] * rn * sl.w * silu(bfhi(gw[1]));
          *reinterpret_cast<u32x2*>(yp + dv) = (ZERO_MASK & 2) ? u32x2{0u, 0u} : u32x2{pk2(y0, y1), pk2(y2, y3)};
        }
    }
  }
}

DI void pool_item(const Params& p, int l, int pi, unsigned char* lds) {
  constexpr int NC = 6144;
  const int tid = TIDX, lane = tid & 63, wid = tid >> 6, fr = lane & 15, fq = lane >> 4;
  const int tb = pi >> 2, g = pi & 3, row0 = tb * 64;
  const int L = row0 < TP ? 256 : 4096;
  const int t0 = row0 < TP ? (row0 & 255) : ((row0 - TP) & 4095);
  u16* sIn = reinterpret_cast<u16*>(lds);
  u16* sP = sIn + 80 * 264;
  const u16* PROJ = reinterpret_cast<const u16*>(p.ws + WS_PROJ);
  __syncthreads();
#pragma unroll
  for (int i = 0; i < 10; ++i) {
    const int c = tid + 256 * i, rr = c >> 5, oc = c & 31;
    const int t = t0 - 8 + rr;
    u32x4 v = {0u, 0u, 0u, 0u};
    if (t >= 0 && t < L) v = *reinterpret_cast<const u32x4*>(PROJ + (size_t)(row0 - 8 + rr) * NC + g * 256 + oc * 8);
    *reinterpret_cast<u32x4*>(sIn + rr * 264 + oc * 8) = v;
  }
  __syncthreads();
  {
    const int oc = tid & 31, seg = tid >> 5;
    const int half = 1 << g;
#pragma unroll 1
    for (int tt = 0; tt < 8; ++tt) {
      const int tl = seg * 8 + tt, t = t0 + tl;
      const int lo = max(t - half, 0), hi = min(t + half, L);
      float a[8];
#pragma unroll
      for (int k = 0; k < 8; ++k) a[k] = 0.f;
      for (int s = lo; s < hi; ++s) {
        const u32x4 v = *reinterpret_cast<const u32x4*>(sIn + (s - t0 + 8) * 264 + oc * 8);
#pragma unroll
        for (int k = 0; k < 4; ++k) { a[2 * k] += bflo(v[k]); a[2 * k + 1] += bfhi(v[k]); }
      }
      const float ic = 1.f / (float)(hi - lo);
      const u32x4 x = *reinterpret_cast<const u32x4*>(sIn + (tl + 8) * 264 + oc * 8);
      u32x4 o;
#pragma unroll
      for (int k = 0; k < 4; ++k) o[k] = pk2(a[2 * k] * ic - bflo(x[k]), a[2 * k + 1] * ic - bfhi(x[k]));
      *reinterpret_cast<u32x4*>(sP + tl * 264 + oc * 8) = o;
    }
  }
  __syncthreads();
  const u16* W = reinterpret_cast<const u16*>(p.ws + WS_POOLWT) + (size_t)(l >> 1) * 262144 + (size_t)g * 65536;
  f32x4 acc[4][4];
#pragma unroll
  for (int a = 0; a < 4; ++a)
#pragma unroll
    for (int b = 0; b < 4; ++b) acc[a][b] = f32x4{0.f, 0.f, 0.f, 0.f};
#pragma unroll 2
  for (int ks = 0; ks < 8; ++ks) {
    bf16x8 af[4], bfr[4];
#pragma unroll
    for (int m = 0; m < 4; ++m) af[m] = ld8(sP + (m * 16 + fr) * 264 + ks * 32 + fq * 8);
#pragma unroll
    for (int n = 0; n < 4; ++n) bfr[n] = ld8(W + (size_t)(wid * 64 + n * 16 + fr) * 256 + ks * 32 + fq * 8);
#pragma unroll
    for (int m = 0; m < 4; ++m)
#pragma unroll
      for (int n = 0; n < 4; ++n) acc[m][n] = mfma16(af[m], bfr[n], acc[m][n]);
  }
  const float* pscale = p.in[19 + 10 * l];
  u16* Y = reinterpret_cast<u16*>(p.ws + WS_H);
#pragma unroll
  for (int n = 0; n < 4; ++n) {
    const int col = g * 256 + wid * 64 + n * 16 + fr;
    const float sc = pscale[col];
#pragma unroll
    for (int m = 0; m < 4; ++m)
#pragma unroll
      for (int j = 0; j < 4; ++j) {
        const int row = row0 + m * 16 + fq * 4 + j;
        const float gt = bf1(PROJ[(size_t)row * NC + 1024 + col]);
        float y = acc[m][n][j] * sc * silu(gt);
        if (ZERO_MASK & 1) y = 0.f;
        Y[(size_t)row * 2048 + col] = (u16)(pk2(y, 0.f) & 0xffffu);
      }
  }
}

DI void phase_mix_even(const Params& p, int l, unsigned char* lds) {
#pragma unroll 1
  for (int it = blockIdx.x; it < 1024; it += gridDim.x) { int bh, qb; heavy_map(it, bh, qb); diff_item(p, l, true, bh, qb, lds); }
#pragma unroll 1
  for (int it = blockIdx.x; it < 512; it += gridDim.x) diff_item(p, l, false, it >> 1, it & 1, lds);
#pragma unroll 1
  for (int it = blockIdx.x; it < 1536; it += gridDim.x) pool_item(p, l, it, lds);
}

DI void na_item(const Params& p, int l, bool sample, int bh, int qb, unsigned char* lds) {
  constexpr int NC = 7168;
  const int tid = TIDX, lane = tid & 63, wid = tid >> 6, r = lane & 31, h = lane >> 5;
  const int b = bh >> 3, hd = bh & 7;
  u16* sQ = reinterpret_cast<u16*>(lds);
  u16* sK = sQ + 128 * 136;
  u16* sVT = sK + 64 * 136;
  float* sBias = reinterpret_cast<float*>(sVT + 128 * 72) + 64;
  const u16* PROJ = reinterpret_cast<const u16*>(p.ws + WS_PROJ);
  const u16* VT = reinterpret_cast<const u16*>(p.ws + WS_VT);
  const int seq0 = sample ? TP + b * 4096 : b * 256;
  const int token = seq0 + qb * 128 + wid * 32 + r;
  AttnSrc s;
  int qr = 0, qc = 0, rsmin = 0;
  f32x16 O[4];
  float lsum;
  const u16* qblk = PROJ + (size_t)(seq0 + qb * 128) * NC + hd * 128;
  if (sample) {
    __syncthreads();
    const float* rpb = p.in[18 + 10 * l] + hd * 465;
    for (int e = tid; e < 465; e += 256) sBias[e] = rpb[e] * LOG2E;
    const int r0 = qb * 2;
    qr = r0 + (wid >> 1); qc = (wid & 1) * 32 + r;
    rsmin = min(max(r0 - 4, 0), 56);
    const int rs1 = min(max(r0 - 3, 0), 56);
    s.k0 = reinterpret_cast<const u16*>(p.ws + WS_CK) + (size_t)l * 2097152 + (size_t)bh * 65536; s.ks0 = 128;
    s.vt0 = reinterpret_cast<const u16*>(p.ws + WS_CVT) + (size_t)l * 2097152 + (size_t)bh * 65536; s.vs0 = 512; s.n0 = 8;
    s.k1 = PROJ + (size_t)(seq0 + rsmin * 64) * NC + 1024 + hd * 128; s.ks1 = NC;
    s.vt1 = VT + 8388608 + (size_t)bh * 128 * 4096 + rsmin * 64; s.vs1 = 4096; s.n1 = rs1 + 8 - rsmin;
    attn_run<128, true>(s, qblk, NC, sQ, sK, sVT, O, lsum, qr, qc, rsmin, sBias);
  } else {
    s.k0 = nullptr; s.vt0 = nullptr; s.ks0 = 0; s.vs0 = 0; s.n0 = 0;
    s.k1 = PROJ + (size_t)seq0 * NC + 1024 + hd * 128; s.ks1 = NC;
    s.vt1 = VT + (size_t)bh * 128 * 256; s.vs1 = 256; s.n1 = 4;
    attn_run<128, false>(s, qblk, NC, sQ, sK, sVT, O, lsum, 0, 0, 0, nullptr);
  }
  const float inv = 1.f / lsum;
  const u16* gp = PROJ + (size_t)token * NC + 3072 + hd * 128;
  u16* yp = reinterpret_cast<u16*>(p.ws + WS_H) + (size_t)token * 2048 + hd * 128;
#pragma unroll
  for (int d = 0; d < 4; ++d)
#pragma unroll
    for (int q = 0; q < 4; ++q) {
      const int dv = d * 32 + 8 * q + 4 * h;
      const u32x2 gw = *reinterpret_cast<const u32x2*>(gp + dv);
      const float y0 = O[d][4 * q] * inv * silu(bflo(gw[0]));
      const float y1 = O[d][4 * q + 1] * inv * silu(bfhi(gw[0]));
      const float y2 = O[d][4 * q + 2] * inv * silu(bflo(gw[1]));
      const float y3 = O[d][4 * q + 3] * inv * silu(bfhi(gw[1]));
      *reinterpret_cast<u32x2*>(yp + dv) = (ZERO_MASK & 4) ? u32x2{0u, 0u} : u32x2{pk2(y0, y1), pk2(y2, y3)};
    }
}

DI void sgu_item(const Params& p, int l, int si, unsigned char* lds) {
  constexpr int NC = 7168;
  const int tid = TIDX, lane = tid & 63, wid = tid >> 6, fr = lane & 15, fq = lane >> 4;
  const int ch = si >> 2, g = si & 3, row0 = ch * 128;
  u16* vnT = reinterpret_cast<u16*>(lds);
  float* sMu = reinterpret_cast<float*>(vnT + 256 * 136);
  float* sRs = sMu + 128;
  const u16* PROJ = reinterpret_cast<const u16*>(p.ws + WS_PROJ);
  __syncthreads();
  {
    const int grp = tid >> 4, ln = tid & 15;
#pragma unroll 1
    for (int rr = 0; rr < 8; ++rr) {
      const u16* src = PROJ + (size_t)(row0 + grp * 8 + rr) * NC + 5120;
      float s = 0.f, ss = 0.f;
#pragma unroll
      for (int c8 = 0; c8 < 8; ++c8) {
        const u32x4 v = *reinterpret_cast<const u32x4*>(src + (ln + 16 * c8) * 8);
#pragma unroll
        for (int k = 0; k < 4; ++k) { const float a = bflo(v[k]), b = bfhi(v[k]); s += a + b; ss += a * a + b * b; }
      }
#pragma unroll
      for (int o = 8; o >= 1; o >>= 1) { s += __shfl_xor(s, o); ss += __shfl_xor(ss, o); }
      const float mu = s * (1.f / 1024.f);
      const float var = fmaxf(ss * (1.f / 1024.f) - mu * mu, 0.f);
      if (ln == 0) { sMu[grp * 8 + rr] = mu; sRs[grp * 8 + rr] = rsqrtf(var + LN_EPS); }
    }
  }
  __syncthreads();
  {
    const int j = tid & 127, hf = tid >> 7;
    const float mu = sMu[j], rs = sRs[j];
    const float* lng = p.in[19 + 10 * l] + g * 256;
    const u16* src = PROJ + (size_t)(row0 + j) * NC + 5120 + g * 256;
#pragma unroll 1
    for (int oc = hf * 16; oc < hf * 16 + 16; ++oc) {
      const u32x4 v = *reinterpret_cast<const u32x4*>(src + oc * 8);
      const float4 g0 = *reinterpret_cast<const float4*>(lng + oc * 8), g1 = *reinterpret_cast<const float4*>(lng + oc * 8 + 4);
      const float gg[8] = {g0.x, g0.y, g0.z, g0.w, g1.x, g1.y, g1.z, g1.w};
#pragma unroll
      for (int k = 0; k < 4; ++k) {
        const float a = (bflo(v[k]) - mu) * rs * gg[2 * k], b = (bfhi(v[k]) - mu) * rs * gg[2 * k + 1];
        const u32 w = pk2(a, b);
        vnT[(oc * 8 + 2 * k) * 136 + j] = (u16)(w & 0xffffu);
        vnT[(oc * 8 + 2 * k + 1) * 136 + j] = (u16)(w >> 16);
      }
    }
  }
  __syncthreads();
  const u16* W = reinterpret_cast<const u16*>(p.ws + WS_SGUW) + (size_t)(l >> 1) * 65536 + (size_t)g * 16384;
  const float* bs = p.in[21 + 10 * l] + g * 128;
  u16* Y = reinterpret_cast<u16*>(p.ws + WS_H);
#pragma unroll 1
  for (int ih = 0; ih < 2; ++ih) {
    f32x4 acc[4][4];
#pragma unroll
    for (int a = 0; a < 4; ++a)
#pragma unroll
      for (int b = 0; b < 4; ++b) acc[a][b] = f32x4{0.f, 0.f, 0.f, 0.f};
#pragma unroll
    for (int ks = 0; ks < 4; ++ks) {
      bf16x8 af[4], bfr[4];
#pragma unroll
      for (int m = 0; m < 4; ++m) af[m] = ld8(W + (size_t)(ih * 64 + m * 16 + fr) * 128 + ks * 32 + fq * 8);
#pragma unroll
      for (int n = 0; n < 4; ++n) bfr[n] = ld8(vnT + (wid * 64 + n * 16 + fr) * 136 + ks * 32 + fq * 8);
#pragma unroll
      for (int m = 0; m < 4; ++m)
#pragma unroll
        for (int n = 0; n < 4; ++n) acc[m][n] = mfma16(af[m], bfr[n], acc[m][n]);
    }
#pragma unroll
    for (int m = 0; m < 4; ++m)
#pragma unroll
      for (int j = 0; j < 4; ++j) {
        const int ii = ih * 64 + m * 16 + fq * 4 + j;
        const float bias = bs[ii];
        const size_t rb = (size_t)(row0 + ii) * NC;
#pragma unroll
        for (int n = 0; n < 4; ++n) {
          const int c = g * 256 + wid * 64 + n * 16 + fr;
          const float u = bf1(PROJ[rb + 4096 + c]), dg = bf1(PROJ[rb + 6144 + c]);
          float y = u * (acc[m][n][j] + bias) * silu(dg);
          if (ZERO_MASK & 8) y = 0.f;
          Y[(size_t)(row0 + ii) * 2048 + 1024 + c] = (u16)(pk2(y, 0.f) & 0xffffu);
        }
      }
  }
}

DI void phase_mix_odd(const Params& p, int l, unsigned char* lds) {
#pragma unroll 1
  for (int it = blockIdx.x; it < 1024; it += gridDim.x) { int bh, qb; heavy_map(it, bh, qb); na_item(p, l, true, bh, qb, lds); }
#pragma unroll 1
  for (int it = blockIdx.x; it < 512; it += gridDim.x) na_item(p, l, false, it >> 1, it & 1, lds);
#pragma unroll 1
  for (int it = blockIdx.x; it < 768; it += gridDim.x) sgu_item(p, l, it, lds);
}

__global__ void __launch_bounds__(256, 2) fwd_megakernel(Params p) {
  extern __shared__ __attribute__((aligned(16))) unsigned char lds[];
  cg::grid_group grid = cg::this_grid();
  for (int ph = p.ph_lo; ph < p.ph_hi; ++ph) {
    if (ph == 0) phase_prep(p, lds);
    else if (ph == 1) phase_mod0(p);
    else {
      const int l = (ph - 2) >> 2, s = (ph - 2) & 3;
      if (s == 0) { for (int rep = 0; rep < REP0; ++rep) { if (l & 1) gemm_phase<G_IN_ODD>(p, l, lds); else gemm_phase<G_IN_EVEN>(p, l, lds); } }
      else if (s == 1) { for (int rep = 0; rep < REP1; ++rep) { if (l & 1) phase_mix_odd(p, l, lds); else phase_mix_even(p, l, lds); } }
      else if (s == 2) gemm_phase<G_OUT>(p, l, lds);
      else phase_ln(p, l);
    }
    if (ph + 1 < p.ph_hi) {
      grid.sync();
    }
  }
}

extern "C" void kernel_launch(void* const* d_in, const int* in_sizes, int n_in, void* d_out, int out_size, void* d_ws, size_t ws_size,
                              hipStream_t stream) {
  static int grid_blocks = 0;
  if (grid_blocks == 0) {
    if (n_in != 52 || ws_size < WS_END) {
      fprintf(stderr, "kernel_launch: expected 52 inputs and >= %zu bytes of workspace; got %d, %zu\n", (size_t)WS_END, n_in, ws_size);
      grid_blocks = -1;
      return;
    }
    int dev = 0, cus = 0, per_cu = 0;
    hipGetDevice(&dev);
    hipDeviceGetAttribute(&cus, hipDeviceAttributeMultiprocessorCount, dev);
    hipFuncSetAttribute((const void*)fwd_megakernel, hipFuncAttributeMaxDynamicSharedMemorySize, LDS_BYTES);
    hipOccupancyMaxActiveBlocksPerMultiprocessor(&per_cu, (const void*)fwd_megakernel, 256, LDS_BYTES);
    if (per_cu < 1) per_cu = 1;
    if (per_cu > 2) per_cu = 2;
    grid_blocks = cus * per_cu;
  }
  if (grid_blocks < 0) return;
  Params p{};
  for (int i = 0; i < 52; ++i) p.in[i] = (const float*)d_in[i];
  p.out = (float*)d_out;
  p.ws = (unsigned char*)d_ws;
#if MULTI
  for (int ph = 0; ph < NPHASE; ++ph) {
    p.ph_lo = ph; p.ph_hi = ph + 1;
    hipLaunchKernelGGL(fwd_megakernel, dim3(grid_blocks), dim3(256), LDS_BYTES, stream, p);
  }
#else
  p.ph_lo = 0; p.ph_hi = NPHASE;
  void* args[] = {&p};
  hipError_t e = hipLaunchCooperativeKernel((const void*)fwd_megakernel, dim3(grid_blocks), dim3(256), args, LDS_BYTES, stream);
  if (e != hipSuccess) fprintf(stderr, "cooperative launch failed: %s (grid %d)\n", hipGetErrorString(e), grid_blocks);
#endif
}
```

```cpp
#include <hip/hip_runtime.h>
#include <hip/hip_cooperative_groups.h>
#include <cstdio>
namespace cg = cooperative_groups;

#define DI __device__ __forceinline__
typedef unsigned short u16;
typedef unsigned int u32;
using bf16x8 = __attribute__((ext_vector_type(8))) short;
using f32x4 = __attribute__((ext_vector_type(4))) float;
using f32x16 = __attribute__((ext_vector_type(16))) float;
using u32x4 = __attribute__((ext_vector_type(4))) unsigned;
using u32x2 = __attribute__((ext_vector_type(2))) unsigned;
typedef __bf16 bf2_t __attribute__((ext_vector_type(2)));
typedef float f2_t __attribute__((ext_vector_type(2)));

#ifndef MULTI
#define MULTI 0
#endif
#ifndef REP0
#define REP0 1
#endif
#ifndef REP1
#define REP1 1
#endif
#ifndef ZERO_MASK
#define ZERO_MASK 0
#endif

constexpr int T_ALL = 24576, TP = 8192, DM = 2048;
constexpr float LOG2E = 1.4426950408889634f;
constexpr float ALPHA = 1.6817928305074290f;
constexpr float LN_EPS = 1e-5f;
constexpr int LDS_BYTES = 76288;
constexpr int NPHASE = 18;

constexpr size_t SZ_WIN_E = (size_t)6144 * 2048 * 2, SZ_WIN_O = (size_t)7168 * 2048 * 2;
constexpr size_t WS_WINT = 0;
constexpr size_t WS_WOUTT = WS_WINT + 2 * SZ_WIN_E + 2 * SZ_WIN_O;
constexpr size_t WS_POOLWT = WS_WOUTT + (size_t)4 * 2048 * 2048 * 2;
constexpr size_t WS_SGUW = WS_POOLWT + (size_t)2 * 4 * 256 * 256 * 2;
constexpr size_t WS_CK = WS_SGUW + (size_t)2 * 4 * 128 * 128 * 2;
constexpr size_t WS_CVT = WS_CK + (size_t)4 * 4194304;
constexpr size_t WS_MOD = WS_CVT + (size_t)4 * 4194304;
constexpr size_t WS_ROPE = WS_MOD + (size_t)4 * 5 * 6144 * 4;
constexpr size_t WS_H = WS_ROPE + 8192;
constexpr size_t WS_PROJ = WS_H + (size_t)T_ALL * 2048 * 2;
constexpr size_t WS_VT = WS_PROJ + (size_t)T_ALL * 7168 * 2;
constexpr size_t WS_END = WS_VT + (size_t)T_ALL * 1024 * 2;

struct Params {
  const float* in[52];
  float* out;
  unsigned char* ws;
  int ph_lo, ph_hi;
};

DI size_t ws_wint(int l) { return WS_WINT + (size_t)(l >> 1) * (SZ_WIN_E + SZ_WIN_O) + ((l & 1) ? SZ_WIN_E : 0); }

DI u32 pk2(float a, float b) { f2_t v = {a, b}; bf2_t r = __builtin_convertvector(v, bf2_t); return __builtin_bit_cast(u32, r); }
DI float bflo(u32 w) { return __uint_as_float(w << 16); }
DI float bfhi(u32 w) { return __uint_as_float(w & 0xffff0000u); }
DI float bf1(u16 w) { return __uint_as_float(((u32)w) << 16); }
DI float ex2(float x) { return __builtin_amdgcn_exp2f(x); }
DI float silu(float x) { return x / (1.f + __expf(-x)); }
DI f32x4 mfma16(bf16x8 a, bf16x8 b, f32x4 c) { return __builtin_amdgcn_mfma_f32_16x16x32_bf16(a, b, c, 0, 0, 0); }
DI f32x16 mfma32(bf16x8 a, bf16x8 b, f32x16 c) { return __builtin_amdgcn_mfma_f32_32x32x16_bf16(a, b, c, 0, 0, 0); }
DI bf16x8 ld8(const u16* p) { return *reinterpret_cast<const bf16x8*>(p); }
DI int opq(int x) { asm volatile("" : "+v"(x)); return x; }
#define TIDX opq((int)threadIdx.x)

DI void tr_tile(const float* __restrict__ src, size_t ld_src, u16* __restrict__ dst, size_t ld_dst, float* sT) {
  const int tid = TIDX;
  const int r = tid >> 4, c4 = (tid & 15) * 4;
#pragma unroll
  for (int i = 0; i < 4; ++i) {
    float4 v = *reinterpret_cast<const float4*>(src + (size_t)(r + 16 * i) * ld_src + c4);
    float* d = sT + (r + 16 * i) * 65 + c4;
    d[0] = v.x; d[1] = v.y; d[2] = v.z; d[3] = v.w;
  }
  __syncthreads();
  const int n = tid >> 2, ks = (tid & 3) * 16;
  u32 w[8];
#pragma unroll
  for (int j = 0; j < 8; ++j) w[j] = pk2(sT[(ks + 2 * j) * 65 + n], sT[(ks + 2 * j + 1) * 65 + n]);
  u32x4* o = reinterpret_cast<u32x4*>(dst + (size_t)n * ld_dst + ks);
  o[0] = u32x4{w[0], w[1], w[2], w[3]};
  o[1] = u32x4{w[4], w[5], w[6], w[7]};
  __syncthreads();
}

DI void cvt8(const float* __restrict__ src, u16* __restrict__ dst) {
  float4 a = *reinterpret_cast<const float4*>(src);
  float4 b = *reinterpret_cast<const float4*>(src + 4);
  *reinterpret_cast<u32x4*>(dst) = u32x4{pk2(a.x, a.y), pk2(a.z, a.w), pk2(b.x, b.y), pk2(b.z, b.w)};
}

DI void mod_item(const Params& p, int i, unsigned char* lds) {
  const int tid = TIDX;
  const int l = i / 96, n0 = (i % 96) * 64;
  float* sS = reinterpret_cast<float*>(lds);
  float* red = sS + 5 * 2048;
  const float* c = p.in[10];
  const float* cctx = p.in[11];
  for (int e = tid; e < 5 * 2048; e += 256) {
    int v = e >> 11, k = e & 2047;
    float x = (v == 0) ? cctx[k] : c[(v - 1) * 2048 + k];
    sS[e] = silu(x);
  }
  __syncthreads();
  const int kk = tid >> 4, c4 = (tid & 15) * 4;
  const float* W = p.in[12 + 10 * l] + n0 + c4;
  f32x4 acc[5];
#pragma unroll
  for (int v = 0; v < 5; ++v) acc[v] = f32x4{0.f, 0.f, 0.f, 0.f};
#pragma unroll 8
  for (int k = kk; k < 2048; k += 16) {
    float4 w = *reinterpret_cast<const float4*>(W + (size_t)k * 6144);
#pragma unroll
    for (int v = 0; v < 5; ++v) {
      float s = sS[v * 2048 + k];
      acc[v][0] += s * w.x; acc[v][1] += s * w.y; acc[v][2] += s * w.z; acc[v][3] += s * w.w;
    }
  }
#pragma unroll
  for (int v = 0; v < 5; ++v)
#pragma unroll
    for (int q = 0; q < 4; ++q) red[(kk * 5 + v) * 64 + c4 + q] = acc[v][q];
  __syncthreads();
  for (int t2 = tid; t2 < 320; t2 += 256) {
    int v = t2 >> 6, n = t2 & 63;
    float s = 0.f;
#pragma unroll
    for (int k2 = 0; k2 < 16; ++k2) s += red[(k2 * 5 + v) * 64 + n];
    float* mod = reinterpret_cast<float*>(p.ws + WS_MOD);
    mod[(size_t)(l * 5 + v) * 6144 + n0 + n] = s + p.in[13 + 10 * l][n0 + n];
  }
  __syncthreads();
}

DI void phase_prep(const Params& p, unsigned char* lds) {
  constexpr int N_MOD = 384, N_TRWIN = 13312, N_TRWOUT = 4096, N_TRPOOL = 128, N_SGU = 64, N_CK = 4096, N_CV = 2048;
  constexpr int TOTAL = N_MOD + N_TRWIN + N_TRWOUT + N_TRPOOL + N_SGU + N_CK + N_CV + 1;
  const int tid = TIDX;
  float* sT = reinterpret_cast<float*>(lds);
  for (int it = blockIdx.x; it < TOTAL; it += gridDim.x) {
    int i = it;
    if (i < N_MOD) { mod_item(p, i, lds); continue; }
    i -= N_MOD;
    if (i < N_TRWIN) {
      int l, base;
      if (i < 3072) { l = 0; base = 0; } else if (i < 6656) { l = 1; base = 3072; } else if (i < 9728) { l = 2; base = 6656; } else { l = 3; base = 9728; }
      i -= base;
      const int N = (l & 1) ? 7168 : 6144, nN = N / 64;
      const int kt = i / nN, nt = i % nN;
      tr_tile(p.in[14 + 10 * l] + (size_t)kt * 64 * N + nt * 64, N,
              reinterpret_cast<u16*>(p.ws + ws_wint(l)) + (size_t)nt * 64 * 2048 + kt * 64, 2048, sT);
      continue;
    }
    i -= N_TRWIN;
    if (i < N_TRWOUT) {
      const int l = i >> 10, r = i & 1023, kt = r >> 5, nt = r & 31;
      tr_tile(p.in[15 + 10 * l] + (size_t)kt * 64 * 2048 + nt * 64, 2048,
              reinterpret_cast<u16*>(p.ws + WS_WOUTT) + (size_t)l * 2048 * 2048 + (size_t)nt * 64 * 2048 + kt * 64, 2048, sT);
      continue;
    }
    i -= N_TRWOUT;
    if (i < N_TRPOOL) {
      const int e = i >> 6, r = i & 63, g = r >> 4, t = r & 15, kt = t >> 2, nt = t & 3;
      tr_tile(p.in[18 + 20 * e] + (size_t)g * 65536 + kt * 64 * 256 + nt * 64, 256,
              reinterpret_cast<u16*>(p.ws + WS_POOLWT) + (size_t)e * 262144 + g * 65536 + nt * 64 * 256 + kt * 64, 256, sT);
      continue;
    }
    i -= N_TRPOOL;
    if (i < N_SGU) {
      const int e = i >> 5, ch = i & 31;
      const size_t off = (size_t)ch * 2048 + tid * 8;
      cvt8(p.in[30 + 20 * e] + off, reinterpret_cast<u16*>(p.ws + WS_SGUW) + (size_t)e * 65536 + off);
      continue;
    }
    i -= N_SGU;
    if (i < N_CK) {
      const int l = i >> 10, ch = i & 1023;
      const size_t off = (size_t)ch * 2048 + tid * 8;
      cvt8(p.in[2 + 2 * l] + off, reinterpret_cast<u16*>(p.ws + WS_CK) + (size_t)l * 2097152 + off);
      continue;
    }
    i -= N_CK;
    if (i < N_CV) {
      const int l = i >> 9, r = i & 511, bh = r >> 4, t = r & 15, kt = t >> 1, nt = t & 1;
      tr_tile(p.in[3 + 2 * l] + (size_t)bh * 65536 + kt * 64 * 128 + nt * 64, 128,
              reinterpret_cast<u16*>(p.ws + WS_CVT) + (size_t)l * 2097152 + (size_t)bh * 65536 + nt * 64 * 512 + kt * 64, 512, sT);
      continue;
    }
    {
      float* rc = reinterpret_cast<float*>(p.ws + WS_ROPE);
      for (int e = tid; e < 1024; e += 256) {
        int pos = e >> 4, fi = e & 15;
        float inv = 1.0f / powf(10000.0f, (float)(2 * fi) / 32.0f);
        float ang = (float)pos * inv;
        rc[e] = cosf(ang);
        rc[1024 + e] = sinf(ang);
      }
    }
  }
}

DI void phase_mod0(const Params& p) {
  const int tid = TIDX;
  const float* mod = reinterpret_cast<const float*>(p.ws + WS_MOD);
  u16* H = reinterpret_cast<u16*>(p.ws + WS_H);
  for (int it = blockIdx.x; it < T_ALL / 4; it += gridDim.x) {
#pragma unroll
    for (int rr = 0; rr < 4; ++rr) {
      const int row = it * 4 + rr;
      const int cond = row < TP ? 0 : 1 + ((row - TP) >> 12);
      const float* src = row < TP ? p.in[0] + (size_t)row * 2048 : p.in[1] + (size_t)(row - TP) * 2048;
      const int e = tid * 8;
      const float* sh = mod + (size_t)cond * 6144 + e;
      float4 a = *reinterpret_cast<const float4*>(src + e), b = *reinterpret_cast<const float4*>(src + e + 4);
      float4 s0 = *reinterpret_cast<const float4*>(sh), s1 = *reinterpret_cast<const float4*>(sh + 4);
      float4 c0 = *reinterpret_cast<const float4*>(sh + 2048), c1 = *reinterpret_cast<const float4*>(sh + 2052);
      u32x4 o = {pk2(a.x * (1.f + c0.x) + s0.x, a.y * (1.f + c0.y) + s0.y), pk2(a.z * (1.f + c0.z) + s0.z, a.w * (1.f + c0.w) + s0.w),
                 pk2(b.x * (1.f + c1.x) + s1.x, b.y * (1.f + c1.y) + s1.y), pk2(b.z * (1.f + c1.z) + s1.z, b.w * (1.f + c1.w) + s1.w)};
      *reinterpret_cast<u32x4*>(H + (size_t)row * 2048 + e) = o;
    }
  }
}

enum { G_IN_EVEN = 0, G_IN_ODD = 1, G_OUT = 2 };

template <int MODE>
DI void gemm_phase(const Params& p, int l, unsigned char* lds) {
  constexpr int K = 2048;
  constexpr int N = (MODE == G_OUT) ? 2048 : (MODE == G_IN_EVEN ? 6144 : 7168);
  constexpr int NC = (MODE == G_IN_EVEN) ? 6144 : 7168;
  constexpr int nTn = N / 128;
  constexpr int TOTAL = nTn * 192;
  const u16* A = reinterpret_cast<const u16*>(p.ws + WS_H);
  const u16* Bt = (MODE == G_OUT) ? reinterpret_cast<const u16*>(p.ws + WS_WOUTT) + (size_t)l * 2048 * 2048
                                  : reinterpret_cast<const u16*>(p.ws + ws_wint(l));
  u16* sA = reinterpret_cast<u16*>(lds);
  u16* sB = sA + 2 * 128 * 64;
  const int tid = TIDX, lane = tid & 63, wid = tid >> 6;
  const int wr = wid >> 1, wc = wid & 1, fr = lane & 15, fq = lane >> 4;
  const int lrow = tid >> 3;
  const int csrc = ((tid & 7) ^ ((lrow >> 1) & 7)) * 8;
  const int swz = (fr >> 1) & 7;
  const int fo0 = (fq ^ swz) * 8, fo1 = ((4 + fq) ^ swz) * 8;
  u16* PROJ = reinterpret_cast<u16*>(p.ws + WS_PROJ);
  u16* VT = reinterpret_cast<u16*>(p.ws + WS_VT);
  const float* mod = reinterpret_cast<const float*>(p.ws + WS_MOD);
  const float* ropeC = reinterpret_cast<const float*>(p.ws + WS_ROPE);
  const float* ropeS = ropeC + 1024;

  for (int it = blockIdx.x; it < TOTAL; it += gridDim.x) {
    constexpr int PN = nTn / 8;
    const int rnd = it >> 9, vb = it & 511, q = rnd * 8 + (vb & 7), jj = vb >> 3;
    const int tm = (q / PN) * 8 + (jj & 7), tn = (q % PN) * 8 + (jj >> 3);
    const u16* ga = A + (size_t)(tm * 128 + lrow) * K + csrc;
    const u16* gb = Bt + (size_t)(tn * 128 + lrow) * K + csrc;
    f32x4 acc[4][4];
#pragma unroll
    for (int a = 0; a < 4; ++a)
#pragma unroll
      for (int b = 0; b < 4; ++b) acc[a][b] = f32x4{0.f, 0.f, 0.f, 0.f};
#define GSTAGE(B_, KT_)                                                                                                   \
  _Pragma("unroll") for (int i = 0; i < 4; ++i) {                                                                         \
    __builtin_amdgcn_global_load_lds((const unsigned*)(ga + (size_t)i * 32 * K + (KT_) * 64),                             \
                                     (unsigned*)(sA + (B_) * 8192 + i * 2048 + tid * 8), 16, 0, 0);                       \
    __builtin_amdgcn_global_load_lds((const unsigned*)(gb + (size_t)i * 32 * K + (KT_) * 64),                             \
                                     (unsigned*)(sB + (B_) * 8192 + i * 2048 + tid * 8), 16, 0, 0);                       \
  }
    GSTAGE(0, 0)
    asm volatile("s_waitcnt vmcnt(0)" ::: "memory");
    __syncthreads();
    for (int kt = 0; kt < K / 64; ++kt) {
      const int buf = kt & 1;
      if (kt + 1 < K / 64) { GSTAGE(buf ^ 1, kt + 1) }
      const u16* cA = sA + buf * 8192 + (wr * 64 + fr) * 64;
      const u16* cB = sB + buf * 8192 + (wc * 64 + fr) * 64;
#pragma unroll
      for (int ks = 0; ks < 2; ++ks) {
        const int fo = ks ? fo1 : fo0;
        bf16x8 af[4], bfr[4];
#pragma unroll
        for (int m = 0; m < 4; ++m) af[m] = ld8(cA + m * 1024 + fo);
#pragma unroll
        for (int n = 0; n < 4; ++n) bfr[n] = ld8(cB + n * 1024 + fo);
#pragma unroll
        for (int m = 0; m < 4; ++m)
#pragma unroll
          for (int n = 0; n < 4; ++n) acc[m][n] = mfma16(af[m], bfr[n], acc[m][n]);
      }
      asm volatile("s_waitcnt vmcnt(0)" ::: "memory");
      __syncthreads();
    }
#undef GSTAGE
    const int rowb = tm * 128 + wr * 64 + fq * 4;
    const int colb = tn * 128 + wc * 64 + fr;
    const bool prompt = tm < 64;
    if (MODE == G_OUT) {
      const int cond = prompt ? 0 : 1 + ((tm * 128 - TP) >> 12);
      const float* gate = mod + (size_t)(l * 5 + cond) * 6144 + 4096;
      float* X = p.out;
#pragma unroll
      for (int n = 0; n < 4; ++n) {
        const int col = colb + n * 16;
        const float g = gate[col];
#pragma unroll
        for (int m = 0; m < 4; ++m)
#pragma unroll
          for (int j = 0; j < 4; ++j) {
            const int row = rowb + m * 16 + j;
            float xo;
            if (l == 0) xo = prompt ? p.in[0][(size_t)row * 2048 + col] : p.in[1][(size_t)(row - TP) * 2048 + col];
            else xo = X[(size_t)row * 2048 + col];
            X[(size_t)row * 2048 + col] = ALPHA * xo + g * acc[m][n][j];
          }
      }
    } else {
      const int sec = tn >> 3;
      const int SEC_Q = (MODE == G_IN_EVEN) ? 2 : 0, SEC_K = (MODE == G_IN_EVEN) ? 3 : 1, SEC_V = (MODE == G_IN_EVEN) ? 4 : 2;
      if (sec == SEC_V) {
        const int hh = tn & 7;
        float* vout = p.out + (size_t)T_ALL * 2048 + (size_t)(2 * l + 1) * 8388608;
#pragma unroll
        for (int m = 0; m < 4; ++m) {
          const int row = rowb + m * 16;
#pragma unroll
          for (int n = 0; n < 4; ++n) {
            const int dv = wc * 64 + n * 16 + fr;
            u32x2 w = {pk2(acc[m][n][0], acc[m][n][1]), pk2(acc[m][n][2], acc[m][n][3])};
            if (prompt) {
              const int b = row >> 8, t = row & 255;
              *reinterpret_cast<u32x2*>(VT + ((size_t)((b * 8 + hh) * 128 + dv)) * 256 + t) = w;
#pragma unroll
              for (int j = 0; j < 4; ++j) vout[((size_t)((b * 8 + hh) * 256 + t + j)) * 128 + dv] = acc[m][n][j];
            } else {
              const int rs = row - TP, b = rs >> 12, t = rs & 4095;
              *reinterpret_cast<u32x2*>(VT + 8388608 + ((size_t)((b * 8 + hh) * 128 + dv)) * 4096 + t) = w;
            }
          }
        }
      } else {
        const bool isq = sec == SEC_Q, isk = sec == SEC_K;
        const bool rope = (MODE == G_IN_EVEN) && (isq || isk) && !prompt;
        const float qs = (MODE == G_IN_EVEN) ? 0.125f * LOG2E : 0.08838834764831845f * LOG2E;
        if (isk && prompt) {
          const int hh = tn & 7;
          float* kout = p.out + (size_t)T_ALL * 2048 + (size_t)(2 * l) * 8388608;
#pragma unroll
          for (int m = 0; m < 4; ++m)
#pragma unroll
            for (int n = 0; n < 4; ++n) {
              const int d = wc * 64 + n * 16 + fr;
#pragma unroll
              for (int j = 0; j < 4; ++j) {
                const int row = rowb + m * 16 + j, b = row >> 8, t = row & 255;
                kout[((size_t)((b * 8 + hh) * 256 + t)) * 128 + d] = acc[m][n][j];
              }
            }
        }
        if (rope) {
#pragma unroll
          for (int m = 0; m < 4; ++m)
#pragma unroll
            for (int j = 0; j < 4; ++j) {
              const int t = (rowb + m * 16 + j - TP) & 4095;
              const int pr = t >> 6, pc = t & 63;
#pragma unroll
              for (int ax = 0; ax < 2; ++ax) {
                const int pos = ax ? pc : pr;
                const float cs = ropeC[pos * 16 + fr], sn = ropeS[pos * 16 + fr];
                const float x1 = acc[m][2 * ax][j], x2 = acc[m][2 * ax + 1][j];
                acc[m][2 * ax][j] = x1 * cs - x2 * sn;
                acc[m][2 * ax + 1][j] = x1 * sn + x2 * cs;
              }
            }
        }
#pragma unroll
        for (int m = 0; m < 4; ++m)
#pragma unroll
          for (int n = 0; n < 4; ++n)
#pragma unroll
            for (int j = 0; j < 4; ++j) {
              float v = acc[m][n][j];
              if (isq) v *= qs;
              const int row = rowb + m * 16 + j, col = colb + n * 16;
              PROJ[(size_t)row * NC + col] = (u16)(pk2(v, 0.f) & 0xffffu);
            }
      }
    }
  }
}

DI void phase_ln(const Params& p, int l) {
  const int tid_ = TIDX, lane = tid_ & 63, wid = tid_ >> 6;
  const float* g = p.in[16 + 10 * l];
  const float* bb = p.in[17 + 10 * l];
  const float* mod = reinterpret_cast<const float*>(p.ws + WS_MOD);
  u16* H = reinterpret_cast<u16*>(p.ws + WS_H);
  float* X = p.out;
  for (int it = blockIdx.x; it < T_ALL / 4; it += gridDim.x) {
    const int row = it * 4 + wid;
    float* xr = X + (size_t)row * 2048;
    float4 v[8];
    float s = 0.f;
#pragma unroll
    for (int i = 0; i < 8; ++i) {
      v[i] = *reinterpret_cast<const float4*>(xr + (i * 64 + lane) * 4);
      s += v[i].x + v[i].y + v[i].z + v[i].w;
    }
#pragma unroll
    for (int o = 32; o >= 1; o >>= 1) s += __shfl_xor(s, o);
    const float mu = s * (1.f / 2048.f);
    float ss = 0.f;
#pragma unroll
    for (int i = 0; i < 8; ++i) {
      float a = v[i].x - mu, b = v[i].y - mu, c = v[i].z - mu, d = v[i].w - mu;
      ss += a * a + b * b + c * c + d * d;
    }
#pragma unroll
    for (int o = 32; o >= 1; o >>= 1) ss += __shfl_xor(ss, o);
    const float rstd = rsqrtf(ss * (1.f / 2048.f) + LN_EPS);
    const int cond = row < TP ? 0 : 1 + ((row - TP) >> 12);
    const float* sh = mod + (size_t)((l + 1) * 5 + cond) * 6144;
#pragma unroll
    for (int i = 0; i < 8; ++i) {
      const int e = (i * 64 + lane) * 4;
      float4 gg = *reinterpret_cast<const float4*>(g + e), b4 = *reinterpret_cast<const float4*>(bb + e);
      float4 y;
      y.x = (v[i].x - mu) * rstd * gg.x + b4.x; y.y = (v[i].y - mu) * rstd * gg.y + b4.y;
      y.z = (v[i].z - mu) * rstd * gg.z + b4.z; y.w = (v[i].w - mu) * rstd * gg.w + b4.w;
      *reinterpret_cast<float4*>(xr + e) = y;
      if (l < 3) {
        float4 s0 = *reinterpret_cast<const float4*>(sh + e), c0 = *reinterpret_cast<const float4*>(sh + 2048 + e);
        u32x2 o = {pk2(y.x * (1.f + c0.x) + s0.x, y.y * (1.f + c0.y) + s0.y), pk2(y.z * (1.f + c0.z) + s0.z, y.w * (1.f + c0.w) + s0.w)};
        *reinterpret_cast<u32x2*>(H + (size_t)row * 2048 + e) = o;
      }
    }
  }
}

struct AttnSrc {
  const u16* k0; const u16* vt0; int ks0, vs0, n0;
  const u16* k1; const u16* vt1; int ks1, vs1, n1;
};

template <int DQK>
DI void attn_ldg(const AttnSrc& s, int j, u32x4 (&rk)[DQK / 32], u32x4 (&rv)[4]) {
  const u16* kb; const u16* vb; int ks, vs;
  if (j < s.n0) { kb = s.k0 + (size_t)j * 64 * s.ks0; vb = s.vt0 + j * 64; ks = s.ks0; vs = s.vs0; }
  else { const int jj = j - s.n0; kb = s.k1 + (size_t)jj * 64 * s.ks1; vb = s.vt1 + jj * 64; ks = s.ks1; vs = s.vs1; }
  constexpr int CPR = DQK / 8;
  const int tid = TIDX;
#pragma unroll
  for (int i = 0; i < DQK / 32; ++i) {
    const int c = tid + 256 * i, row = c / CPR, kc = c % CPR;
    rk[i] = *reinterpret_cast<const u32x4*>(kb + (size_t)row * ks + kc * 8);
  }
#pragma unroll
  for (int i = 0; i < 4; ++i) {
    const int c = tid + 256 * i, row = c >> 3, kc = c & 7;
    rv[i] = *reinterpret_cast<const u32x4*>(vb + (size_t)row * vs + kc * 8);
  }
}
template <int DQK>
DI void attn_sts(u16* sK, u16* sVT, const u32x4 (&rk)[DQK / 32], const u32x4 (&rv)[4]) {
  constexpr int CPR = DQK / 8;
  const int tid = TIDX;
#pragma unroll
  for (int i = 0; i < DQK / 32; ++i) {
    const int c = tid + 256 * i, row = c / CPR, kc = c % CPR;
    *reinterpret_cast<u32x4*>(sK + row * (DQK + 8) + kc * 8) = rk[i];
  }
#pragma unroll
  for (int i = 0; i < 4; ++i) {
    const int c = tid + 256 * i, row = c >> 3, kc = c & 7;
    *reinterpret_cast<u32x4*>(sVT + row * 72 + kc * 8) = rv[i];
  }
}

template <int DQK, bool NA>
DI void attn_run(const AttnSrc& src, const u16* qblk, int qstride, u16* sQ, u16* sK, u16* sVT, f32x16 (&O)[4], float& l_out,
                 int qr, int qc, int rsmin, const float* sBias) {
  const int tid = TIDX, lane = tid & 63, wid = tid >> 6;
  const int r = lane & 31, h = lane >> 5;
  const int pr = (r & 0x13) | ((r & 4) << 1) | ((r & 8) >> 1);
  constexpr int CPR = DQK / 8, QS = DQK + 8;
  __syncthreads();
#pragma unroll
  for (int i = 0; i < DQK / 16; ++i) {
    const int c = tid + 256 * i, row = c / CPR, kc = c % CPR;
    *reinterpret_cast<u32x4*>(sQ + row * QS + kc * 8) = *reinterpret_cast<const u32x4*>(qblk + (size_t)row * qstride + kc * 8);
  }
#pragma unroll
  for (int d = 0; d < 4; ++d)
#pragma unroll
    for (int i = 0; i < 16; ++i) O[d][i] = 0.f;
  float m = -1e30f, l = 0.f;
  const int nt = src.n0 + src.n1;
  const int rsq = min(max(qr - 4, 0), 56);
  const int cs = min(max(qc - 8, 0), 48);
  const u16* qw = sQ + (wid * 32 + r) * QS + 8 * h;
  const u16* kw = sK + pr * QS + 8 * h;
  const u16* vw = sVT + r * 72 + 8 * h;
  u32x4 rk[DQK / 32], rv[4];
  attn_ldg<DQK>(src, 0, rk, rv);
#pragma unroll 1
  for (int j = 0; j < nt; ++j) {
    if (j > 0) __syncthreads();
    attn_sts<DQK>(sK, sVT, rk, rv);
    __syncthreads();
    if (j + 1 < nt) attn_ldg<DQK>(src, j + 1, rk, rv);
    __builtin_amdgcn_sched_barrier(0);
    bool active = true;
    int kr = 0;
    if (NA && j >= src.n0) { kr = rsmin + (j - src.n0); active = (kr >= rsq) && (kr < rsq + 8); }
    if (active) {
      f32x16 s[2];
#pragma unroll
      for (int t = 0; t < 2; ++t) {
#pragma unroll
        for (int i = 0; i < 16; ++i) s[t][i] = 0.f;
#pragma unroll
        for (int ks = 0; ks < DQK / 16; ++ks) {
          bf16x8 a = ld8(kw + t * 32 * QS + ks * 16);
          bf16x8 q = ld8(qw + ks * 16);
          s[t] = mfma32(a, q, s[t]);
        }
      }
      if (NA && j >= src.n0) {
        const float* bp = sBias + (kr - qr + 7) * 31 + (8 * h - qc + 15);
        const int kb = 8 * h - cs;
#pragma unroll
        for (int t = 0; t < 2; ++t)
#pragma unroll
          for (int i = 0; i < 16; ++i) {
            const int ko = t * 32 + 16 * (i >> 3) + (i & 7);
            const bool ok = (unsigned)(ko + kb) < 16u;
            const float bv = bp[ko];
            s[t][i] = ok ? s[t][i] + bv : -1e30f;
          }
      }
      float mx = -1e30f;
#pragma unroll
      for (int t = 0; t < 2; ++t)
#pragma unroll
        for (int i = 0; i < 16; ++i) mx = fmaxf(mx, s[t][i]);
      mx = fmaxf(mx, __shfl_xor(mx, 32));
      if (__builtin_amdgcn_ballot_w64(mx > m + 8.0f) != 0ull) {
        const float mn = fmaxf(m, mx);
        const float alpha = ex2(m - mn);
        l *= alpha;
        m = mn;
#pragma unroll
        for (int d = 0; d < 4; ++d)
#pragma unroll
          for (int i = 0; i < 16; ++i) O[d][i] *= alpha;
      }
      float rsum = 0.f;
#pragma unroll
      for (int t = 0; t < 2; ++t)
#pragma unroll
        for (int i = 0; i < 16; ++i) { const float e = ex2(s[t][i] - m); s[t][i] = e; rsum += e; }
      rsum += __shfl_xor(rsum, 32);
      l += rsum;
#pragma unroll
      for (int s4 = 0; s4 < 4; ++s4) {
        const int t = s4 >> 1, b0 = (s4 & 1) * 8;
        u32x4 w = {pk2(s[t][b0], s[t][b0 + 1]), pk2(s[t][b0 + 2], s[t][b0 + 3]), pk2(s[t][b0 + 4], s[t][b0 + 5]), pk2(s[t][b0 + 6], s[t][b0 + 7])};
        const bf16x8 pf = __builtin_bit_cast(bf16x8, w);
#pragma unroll
        for (int d = 0; d < 4; ++d) {
          bf16x8 a = ld8(vw + d * 32 * 72 + s4 * 16);
          O[d] = mfma32(a, pf, O[d]);
        }
      }
    }
  }
  l_out = l;
}

DI void heavy_map(int it, int& bh, int& qb) { const int x = it & 7, idx = it >> 3; bh = x + 8 * (idx >> 5); qb = idx & 31; }

DI void diff_item(const Params& p, int l, bool sample, int bh, int qb, unsigned char* lds) {
  constexpr int NC = 6144;
  const int tid_ = TIDX, lane = tid_ & 63, wid = tid_ >> 6, r = lane & 31, h = lane >> 5;
  const int b = bh >> 3, hd = bh & 7;
  u16* sQ = reinterpret_cast<u16*>(lds);
  u16* sK = sQ + 128 * 136;
  u16* sVT = sK + 64 * 136;
  const u16* PROJ = reinterpret_cast<const u16*>(p.ws + WS_PROJ);
  const u16* VT = reinterpret_cast<const u16*>(p.ws + WS_VT);
  const int seq0 = sample ? TP + b * 4096 : b * 256;
  const int token = seq0 + qb * 128 + wid * 32 + r;
  const float* dl = p.in[20 + 10 * l];
  float pa = dl[lane] * dl[64 + lane], pb = dl[128 + lane] * dl[192 + lane];
#pragma unroll
  for (int o = 32; o >= 1; o >>= 1) { pa += __shfl_xor(pa, o); pb += __shfl_xor(pb, o); }
  const float lam_init = 0.8f - 0.6f * __expf(-0.3f * (float)l);
  const float lam = __expf(pa) - __expf(pb) + lam_init;

  u32 o1p[32];
  f32x16 O[4];
  float lsum;
#pragma unroll
  for (int comp = 0; comp < 2; ++comp) {
    AttnSrc s;
    if (sample) {
      s.k0 = reinterpret_cast<const u16*>(p.ws + WS_CK) + (size_t)l * 2097152 + (size_t)bh * 65536 + comp * 64; s.ks0 = 128;
      s.vt0 = reinterpret_cast<const u16*>(p.ws + WS_CVT) + (size_t)l * 2097152 + (size_t)bh * 65536; s.vs0 = 512; s.n0 = 8;
      s.k1 = PROJ + (size_t)seq0 * NC + 3072 + hd * 128 + comp * 64; s.ks1 = NC;
      s.vt1 = VT + 8388608 + (size_t)bh * 128 * 4096; s.vs1 = 4096; s.n1 = 64;
    } else {
      s.k0 = nullptr; s.vt0 = nullptr; s.ks0 = 0; s.vs0 = 0; s.n0 = 0;
      s.k1 = PROJ + (size_t)seq0 * NC + 3072 + hd * 128 + comp * 64; s.ks1 = NC;
      s.vt1 = VT + (size_t)bh * 128 * 256; s.vs1 = 256; s.n1 = 4;
    }
    const u16* qblk = PROJ + (size_t)(seq0 + qb * 128) * NC + 2048 + hd * 128 + comp * 64;
    attn_run<64, false>(s, qblk, NC, sQ, sK, sVT, O, lsum, 0, 0, 0, nullptr);
    const float inv = 1.f / lsum;
    if (comp == 0) {
#pragma unroll
      for (int d = 0; d < 4; ++d)
#pragma unroll
        for (int i = 0; i < 8; ++i) o1p[d * 8 + i] = pk2(O[d][2 * i] * inv, O[d][2 * i + 1] * inv);
    } else {
      float ssq = 0.f;
#pragma unroll
      for (int d = 0; d < 4; ++d)
#pragma unroll
        for (int i = 0; i < 8; ++i) {
          const u32 w = o1p[d * 8 + i];
          const float a = bflo(w) - lam * O[d][2 * i] * inv, c = bfhi(w) - lam * O[d][2 * i + 1] * inv;
          O[d][2 * i] = a; O[d][2 * i + 1] = c;
          ssq += a * a + c * c;
        }
      ssq += __shfl_xor(ssq, 32);
      const float rn = rsqrtf(ssq * (1.f / 128.f) + LN_EPS) * (1.f - lam_init);
      const float* subln = p.in[21 + 10 * l];
      const u16* gp = PROJ + (size_t)token * NC + 5120 + hd * 128;
      u16* yp = reinterpret_cast<u16*>(p.ws + WS_H) + (size_t)token * 2048 + 1024 + hd * 128;
#pragma unroll
      for (int d = 0; d < 4; ++d)
#pragma unroll
        for (int q = 0; q < 4; ++q) {
          const int dv = d * 32 + 8 * q + 4 * h;
          const u32x2 gw = *reinterpret_cast<const u32x2*>(gp + dv);
          const float4 sl = *reinterpret_cast<const float4*>(subln + dv);
          const float y0 = O[d][4 * q] * rn * sl.x * silu(bflo(gw[0]));
          const float y1 = O[d][4 * q + 1] * rn * sl.y * silu(bfhi(gw[0]));
          const float y2 = O[d][4 * q + 2] * rn * sl.z * silu(bflo(gw[1]));
          const float y3 = O[d][4 * q + 3] * rn * sl.w * silu(bfhi(gw[1]));
          *reinterpret_cast<u32x2*>(yp + dv) = (ZERO_MASK & 2) ? u32x2{0u, 0u} : u32x2{pk2(y0, y1), pk2(y2, y3)};
        }
    }
  }
}

DI void pool_item(const Params& p, int l, int pi, unsigned char* lds) {
  constexpr int NC = 6144;
  const int tid = TIDX, lane = tid & 63, wid = tid >> 6, fr = lane & 15, fq = lane >> 4;
  const int tb = pi >> 2, g = pi & 3, row0 = tb * 64;
  const int L = row0 < TP ? 256 : 4096;
  const int t0 = row0 < TP ? (row0 & 255) : ((row0 - TP) & 4095);
  u16* sIn = reinterpret_cast<u16*>(lds);
  u16* sP = sIn + 80 * 264;
  const u16* PROJ = reinterpret_cast<const u16*>(p.ws + WS_PROJ);
  __syncthreads();
#pragma unroll
  for (int i = 0; i < 10; ++i) {
    const int c = tid + 256 * i, rr = c >> 5, oc = c & 31;
    const int t = t0 - 8 + rr;
    u32x4 v = {0u, 0u, 0u, 0u};
    if (t >= 0 && t < L) v = *reinterpret_cast<const u32x4*>(PROJ + (size_t)(row0 - 8 + rr) * NC + g * 256 + oc * 8);
    *reinterpret_cast<u32x4*>(sIn + rr * 264 + oc * 8) = v;
  }
  __syncthreads();
  {
    const int oc = tid & 31, seg = tid >> 5;
    const int half = 1 << g;
#pragma unroll 1
    for (int tt = 0; tt < 8; ++tt) {
      const int tl = seg * 8 + tt, t = t0 + tl;
      const int lo = max(t - half, 0), hi = min(t + half, L);
      float a[8];
#pragma unroll
      for (int k = 0; k < 8; ++k) a[k] = 0.f;
      for (int s = lo; s < hi; ++s) {
        const u32x4 v = *reinterpret_cast<const u32x4*>(sIn + (s - t0 + 8) * 264 + oc * 8);
#pragma unroll
        for (int k = 0; k < 4; ++k) { a[2 * k] += bflo(v[k]); a[2 * k + 1] += bfhi(v[k]); }
      }
      const float ic = 1.f / (float)(hi - lo);
      const u32x4 x = *reinterpret_cast<const u32x4*>(sIn + (tl + 8) * 264 + oc * 8);
      u32x4 o;
#pragma unroll
      for (int k = 0; k < 4; ++k) o[k] = pk2(a[2 * k] * ic - bflo(x[k]), a[2 * k + 1] * ic - bfhi(x[k]));
      *reinterpret_cast<u32x4*>(sP + tl * 264 + oc * 8) = o;
    }
  }
  __syncthreads();
  const u16* W = reinterpret_cast<const u16*>(p.ws + WS_POOLWT) + (size_t)(l >> 1) * 262144 + (size_t)g * 65536;
  f32x4 acc[4][4];
#pragma unroll
  for (int a = 0; a < 4; ++a)
#pragma unroll
    for (int b = 0; b < 4; ++b) acc[a][b] = f32x4{0.f, 0.f, 0.f, 0.f};
#pragma unroll 2
  for (int ks = 0; ks < 8; ++ks) {
    bf16x8 af[4], bfr[4];
#pragma unroll
    for (int m = 0; m < 4; ++m) af[m] = ld8(sP + (m * 16 + fr) * 264 + ks * 32 + fq * 8);
#pragma unroll
    for (int n = 0; n < 4; ++n) bfr[n] = ld8(W + (size_t)(wid * 64 + n * 16 + fr) * 256 + ks * 32 + fq * 8);
#pragma unroll
    for (int m = 0; m < 4; ++m)
#pragma unroll
      for (int n = 0; n < 4; ++n) acc[m][n] = mfma16(af[m], bfr[n], acc[m][n]);
  }
  const float* pscale = p.in[19 + 10 * l];
  u16* Y = reinterpret_cast<u16*>(p.ws + WS_H);
#pragma unroll
  for (int n = 0; n < 4; ++n) {
    const int col = g * 256 + wid * 64 + n * 16 + fr;
    const float sc = pscale[col];
#pragma unroll
    for (int m = 0; m < 4; ++m)
#pragma unroll
      for (int j = 0; j < 4; ++j) {
        const int row = row0 + m * 16 + fq * 4 + j;
        const float gt = bf1(PROJ[(size_t)row * NC + 1024 + col]);
        float y = acc[m][n][j] * sc * silu(gt);
        if (ZERO_MASK & 1) y = 0.f;
        Y[(size_t)row * 2048 + col] = (u16)(pk2(y, 0.f) & 0xffffu);
      }
  }
}

DI void phase_mix_even(const Params& p, int l, unsigned char* lds) {
#pragma unroll 1
  for (int it = blockIdx.x; it < 1024; it += gridDim.x) { int bh, qb; heavy_map(it, bh, qb); diff_item(p, l, true, bh, qb, lds); }
#pragma unroll 1
  for (int it = blockIdx.x; it < 512; it += gridDim.x) diff_item(p, l, false, it >> 1, it & 1, lds);
#pragma unroll 1
  for (int it = blockIdx.x; it < 1536; it += gridDim.x) pool_item(p, l, it, lds);
}

DI void na_item(const Params& p, int l, bool sample, int bh, int qb, unsigned char* lds) {
  constexpr int NC = 7168;
  const int tid = TIDX, lane = tid & 63, wid = tid >> 6, r = lane & 31, h = lane >> 5;
  const int b = bh >> 3, hd = bh & 7;
  u16* sQ = reinterpret_cast<u16*>(lds);
  u16* sK = sQ + 128 * 136;
  u16* sVT = sK + 64 * 136;
  float* sBias = reinterpret_cast<float*>(sVT + 128 * 72) + 64;
  const u16* PROJ = reinterpret_cast<const u16*>(p.ws + WS_PROJ);
  const u16* VT = reinterpret_cast<const u16*>(p.ws + WS_VT);
  const int seq0 = sample ? TP + b * 4096 : b * 256;
  const int token = seq0 + qb * 128 + wid * 32 + r;
  AttnSrc s;
  int qr = 0, qc = 0, rsmin = 0;
  f32x16 O[4];
  float lsum;
  const u16* qblk = PROJ + (size_t)(seq0 + qb * 128) * NC + hd * 128;
  if (sample) {
    __syncthreads();
    const float* rpb = p.in[18 + 10 * l] + hd * 465;
    for (int e = tid; e < 465; e += 256) sBias[e] = rpb[e] * LOG2E;
    const int r0 = qb * 2;
    qr = r0 + (wid >> 1); qc = (wid & 1) * 32 + r;
    rsmin = min(max(r0 - 4, 0), 56);
    const int rs1 = min(max(r0 - 3, 0), 56);
    s.k0 = reinterpret_cast<const u16*>(p.ws + WS_CK) + (size_t)l * 2097152 + (size_t)bh * 65536; s.ks0 = 128;
    s.vt0 = reinterpret_cast<const u16*>(p.ws + WS_CVT) + (size_t)l * 2097152 + (size_t)bh * 65536; s.vs0 = 512; s.n0 = 8;
    s.k1 = PROJ + (size_t)(seq0 + rsmin * 64) * NC + 1024 + hd * 128; s.ks1 = NC;
    s.vt1 = VT + 8388608 + (size_t)bh * 128 * 4096 + rsmin * 64; s.vs1 = 4096; s.n1 = rs1 + 8 - rsmin;
    attn_run<128, true>(s, qblk, NC, sQ, sK, sVT, O, lsum, qr, qc, rsmin, sBias);
  } else {
    s.k0 = nullptr; s.vt0 = nullptr; s.ks0 = 0; s.vs0 = 0; s.n0 = 0;
    s.k1 = PROJ + (size_t)seq0 * NC + 1024 + hd * 128; s.ks1 = NC;
    s.vt1 = VT + (size_t)bh * 128 * 256; s.vs1 = 256; s.n1 = 4;
    attn_run<128, false>(s, qblk, NC, sQ, sK, sVT, O, lsum, 0, 0, 0, nullptr);
  }
  const float inv = 1.f / lsum;
  const u16* gp = PROJ + (size_t)token * NC + 3072 + hd * 128;
  u16* yp = reinterpret_cast<u16*>(p.ws + WS_H) + (size_t)token * 2048 + hd * 128;
#pragma unroll
  for (int d = 0; d < 4; ++d)
#pragma unroll
    for (int q = 0; q < 4; ++q) {
      const int dv = d * 32 + 8 * q + 4 * h;
      const u32x2 gw = *reinterpret_cast<const u32x2*>(gp + dv);
      const float y0 = O[d][4 * q] * inv * silu(bflo(gw[0]));
      const float y1 = O[d][4 * q + 1] * inv * silu(bfhi(gw[0]));
      const float y2 = O[d][4 * q + 2] * inv * silu(bflo(gw[1]));
      const float y3 = O[d][4 * q + 3] * inv * silu(bfhi(gw[1]));
      *reinterpret_cast<u32x2*>(yp + dv) = (ZERO_MASK & 4) ? u32x2{0u, 0u} : u32x2{pk2(y0, y1), pk2(y2, y3)};
    }
}

DI void sgu_item(const Params& p, int l, int si, unsigned char* lds) {
  constexpr int NC = 7168;
  const int tid = TIDX, lane = tid & 63, wid = tid >> 6, fr = lane & 15, fq = lane >> 4;
  const int ch = si >> 2, g = si & 3, row0 = ch * 128;
  u16* vnT = reinterpret_cast<u16*>(lds);
  float* sMu = reinterpret_cast<float*>(vnT + 256 * 136);
  float* sRs = sMu + 128;
  const u16* PROJ = reinterpret_cast<const u16*>(p.ws + WS_PROJ);
  __syncthreads();
  {
    const int grp = tid >> 4, ln = tid & 15;
#pragma unroll 1
    for (int rr = 0; rr < 8; ++rr) {
      const u16* src = PROJ + (size_t)(row0 + grp * 8 + rr) * NC + 5120;
      float s = 0.f, ss = 0.f;
#pragma unroll
      for (int c8 = 0; c8 < 8; ++c8) {
        const u32x4 v = *reinterpret_cast<const u32x4*>(src + (ln + 16 * c8) * 8);
#pragma unroll
        for (int k = 0; k < 4; ++k) { const float a = bflo(v[k]), b = bfhi(v[k]); s += a + b; ss += a * a + b * b; }
      }
#pragma unroll
      for (int o = 8; o >= 1; o >>= 1) { s += __shfl_xor(s, o); ss += __shfl_xor(ss, o); }
      const float mu = s * (1.f / 1024.f);
      const float var = fmaxf(ss * (1.f / 1024.f) - mu * mu, 0.f);
      if (ln == 0) { sMu[grp * 8 + rr] = mu; sRs[grp * 8 + rr] = rsqrtf(var + LN_EPS); }
    }
  }
  __syncthreads();
  {
    const int j = tid & 127, hf = tid >> 7;
    const float mu = sMu[j], rs = sRs[j];
    const float* lng = p.in[19 + 10 * l] + g * 256;
    const u16* src = PROJ + (size_t)(row0 + j) * NC + 5120 + g * 256;
#pragma unroll 1
    for (int oc = hf * 16; oc < hf * 16 + 16; ++oc) {
      const u32x4 v = *reinterpret_cast<const u32x4*>(src + oc * 8);
      const float4 g0 = *reinterpret_cast<const float4*>(lng + oc * 8), g1 = *reinterpret_cast<const float4*>(lng + oc * 8 + 4);
      const float gg[8] = {g0.x, g0.y, g0.z, g0.w, g1.x, g1.y, g1.z, g1.w};
#pragma unroll
      for (int k = 0; k < 4; ++k) {
        const float a = (bflo(v[k]) - mu) * rs * gg[2 * k], b = (bfhi(v[k]) - mu) * rs * gg[2 * k + 1];
        const u32 w = pk2(a, b);
        vnT[(oc * 8 + 2 * k) * 136 + j] = (u16)(w & 0xffffu);
        vnT[(oc * 8 + 2 * k + 1) * 136 + j] = (u16)(w >> 16);
      }
    }
  }
  __syncthreads();
  const u16* W = reinterpret_cast<const u16*>(p.ws + WS_SGUW) + (size_t)(l >> 1) * 65536 + (size_t)g * 16384;
  const float* bs = p.in[21 + 10 * l] + g * 128;
  u16* Y = reinterpret_cast<u16*>(p.ws + WS_H);
#pragma unroll 1
  for (int ih = 0; ih < 2; ++ih) {
    f32x4 acc[4][4];
#pragma unroll
    for (int a = 0; a < 4; ++a)
#pragma unroll
      for (int b = 0; b < 4; ++b) acc[a][b] = f32x4{0.f, 0.f, 0.f, 0.f};
#pragma unroll
    for (int ks = 0; ks < 4; ++ks) {
      bf16x8 af[4], bfr[4];
#pragma unroll
      for (int m = 0; m < 4; ++m) af[m] = ld8(W + (size_t)(ih * 64 + m * 16 + fr) * 128 + ks * 32 + fq * 8);
#pragma unroll
      for (int n = 0; n < 4; ++n) bfr[n] = ld8(vnT + (wid * 64 + n * 16 + fr) * 136 + ks * 32 + fq * 8);
#pragma unroll
      for (int m = 0; m < 4; ++m)
#pragma unroll
        for (int n = 0; n < 4; ++n) acc[m][n] = mfma16(af[m], bfr[n], acc[m][n]);
    }
#pragma unroll
    for (int m = 0; m < 4; ++m)
#pragma unroll
      for (int j = 0; j < 4; ++j) {
        const int ii = ih * 64 + m * 16 + fq * 4 + j;
        const float bias = bs[ii];
        const size_t rb = (size_t)(row0 + ii) * NC;
#pragma unroll
        for (int n = 0; n < 4; ++n) {
          const int c = g * 256 + wid * 64 + n * 16 + fr;
          const float u = bf1(PROJ[rb + 4096 + c]), dg = bf1(PROJ[rb + 6144 + c]);
          float y = u * (acc[m][n][j] + bias) * silu(dg);
          if (ZERO_MASK & 8) y = 0.f;
          Y[(size_t)(row0 + ii) * 2048 + 1024 + c] = (u16)(pk2(y, 0.f) & 0xffffu);
        }
      }
  }
}

DI void phase_mix_odd(const Params& p, int l, unsigned char* lds) {
#pragma unroll 1
  for (int it = blockIdx.x; it < 1024; it += gridDim.x) { int bh, qb; heavy_map(it, bh, qb); na_item(p, l, true, bh, qb, lds); }
#pragma unroll 1
  for (int it = blockIdx.x; it < 512; it += gridDim.x) na_item(p, l, false, it >> 1, it & 1, lds);
#pragma unroll 1
  for (int it = blockIdx.x; it < 768; it += gridDim.x) sgu_item(p, l, it, lds);
}

__global__ void __launch_bounds__(256, 2) fwd_megakernel(Params p) {
  extern __shared__ __attribute__((aligned(16))) unsigned char lds[];
  cg::grid_group grid = cg::this_grid();
  for (int ph = p.ph_lo; ph < p.ph_hi; ++ph) {
    if (ph == 0) phase_prep(p, lds);
    else if (ph == 1) phase_mod0(p);
    else {
      const int l = (ph - 2) >> 2, s = (ph - 2) & 3;
      if (s == 0) { for (int rep = 0; rep < REP0; ++rep) { if (l & 1) gemm_phase<G_IN_ODD>(p, l, lds); else gemm_phase<G_IN_EVEN>(p, l, lds); } }
      else if (s == 1) { for (int rep = 0; rep < REP1; ++rep) { if (l & 1) phase_mix_odd(p, l, lds); else phase_mix_even(p, l, lds); } }
      else if (s == 2) gemm_phase<G_OUT>(p, l, lds);
      else phase_ln(p, l);
    }
    if (ph + 1 < p.ph_hi) {
      grid.sync();
    }
  }
}

extern "C" void kernel_launch(void* const* d_in, const int* in_sizes, int n_in, void* d_out, int out_size, void* d_ws, size_t ws_size,
                              hipStream_t stream) {
  static int grid_blocks = 0;
  if (grid_blocks == 0) {
    if (n_in != 52 || ws_size < WS_END) {
      fprintf(stderr, "kernel_launch: expected 52 inputs and >= %zu bytes of workspace; got %d, %zu\n", (size_t)WS_END, n_in, ws_size);
      grid_blocks = -1;
      return;
    }
    int dev = 0, cus = 0, per_cu = 0;
    hipGetDevice(&dev);
    hipDeviceGetAttribute(&cus, hipDeviceAttributeMultiprocessorCount, dev);
    hipFuncSetAttribute((const void*)fwd_megakernel, hipFuncAttributeMaxDynamicSharedMemorySize, LDS_BYTES);
    hipOccupancyMaxActiveBlocksPerMultiprocessor(&per_cu, (const void*)fwd_megakernel, 256, LDS_BYTES);
    if (per_cu < 1) per_cu = 1;
    if (per_cu > 2) per_cu = 2;
    grid_blocks = cus * per_cu;
  }
  if (grid_blocks < 0) return;
  Params p{};
  for (int i = 0; i < 52; ++i) p.in[i] = (const float*)d_in[i];
  p.out = (float*)d_out;
  p.ws = (unsigned char*)d_ws;
#if MULTI
  for (int ph = 0; ph < NPHASE; ++ph) {
    p.ph_lo = ph; p.ph_hi = ph + 1;
    hipLaunchKernelGGL(fwd_megakernel, dim3(grid_blocks), dim3(256), LDS_BYTES, stream, p);
  }
#else
  p.ph_lo = 0; p.ph_hi = NPHASE;
  void* args[] = {&p};
  hipError_t e = hipLaunchCooperativeKernel((const void*)fwd_megakernel, dim3(grid_blocks), dim3(256), args, LDS_BYTES, stream);
  if (e != hipSuccess) fprintf(stderr, "cooperative launch failed: %s (grid %d)\n", hipGetErrorString(e), grid_blocks);
#endif
}
```

```cpp
#include <hip/hip_runtime.h>
#include <hip/hip_cooperative_groups.h>
#include <cstdio>
namespace cg = cooperative_groups;

#define DI __device__ __forceinline__
typedef unsigned short u16;
typedef unsigned int u32;
using bf16x8 = __attribute__((ext_vector_type(8))) short;
using f32x4 = __attribute__((ext_vector_type(4))) float;
using f32x16 = __attribute__((ext_vector_type(16))) float;
using u32x4 = __attribute__((ext_vector_type(4))) unsigned;
using u32x2 = __attribute__((ext_vector_type(2))) unsigned;
typedef __bf16 bf2_t __attribute__((ext_vector_type(2)));
typedef float f2_t __attribute__((ext_vector_type(2)));

#ifndef MULTI
#define MULTI 0
#endif
#ifndef REP0
#define REP0 1
#endif
#ifndef REP1
#define REP1 1
#endif
#ifndef ZERO_MASK
#define ZERO_MASK 0
#endif

constexpr int T_ALL = 24576, TP = 8192, DM = 2048;
constexpr float LOG2E = 1.4426950408889634f;
constexpr float ALPHA = 1.6817928305074290f;
constexpr float LN_EPS = 1e-5f;
constexpr int LDS_BYTES = 76288;
constexpr int NPHASE = 18;

constexpr size_t SZ_WIN_E = (size_t)6144 * 2048 * 2, SZ_WIN_O = (size_t)7168 * 2048 * 2;
constexpr size_t WS_WINT = 0;
constexpr size_t WS_WOUTT = WS_WINT + 2 * SZ_WIN_E + 2 * SZ_WIN_O;
constexpr size_t WS_POOLWT = WS_WOUTT + (size_t)4 * 2048 * 2048 * 2;
constexpr size_t WS_SGUW = WS_POOLWT + (size_t)2 * 4 * 256 * 256 * 2;
constexpr size_t WS_CK = WS_SGUW + (size_t)2 * 4 * 128 * 128 * 2;
constexpr size_t WS_CVT = WS_CK + (size_t)4 * 4194304;
constexpr size_t WS_MOD = WS_CVT + (size_t)4 * 4194304;
constexpr size_t WS_ROPE = WS_MOD + (size_t)4 * 5 * 6144 * 4;
constexpr size_t WS_H = WS_ROPE + 8192;
constexpr size_t WS_PROJ = WS_H + (size_t)T_ALL * 2048 * 2;
constexpr size_t WS_VT = WS_PROJ + (size_t)T_ALL * 7168 * 2;
constexpr size_t WS_END = WS_VT + (size_t)T_ALL * 1024 * 2;

struct Params {
  const float* in[52];
  float* out;
  unsigned char* ws;
  int ph_lo, ph_hi;
};

DI size_t ws_wint(int l) { return WS_WINT + (size_t)(l >> 1) * (SZ_WIN_E + SZ_WIN_O) + ((l & 1) ? SZ_WIN_E : 0); }

DI u32 pk2(float a, float b) { f2_t v = {a, b}; bf2_t r = __builtin_convertvector(v, bf2_t); return __builtin_bit_cast(u32, r); }
DI float bflo(u32 w) { return __uint_as_float(w << 16); }
DI float bfhi(u32 w) { return __uint_as_float(w & 0xffff0000u); }
DI float bf1(u16 w) { return __uint_as_float(((u32)w) << 16); }
DI float ex2(float x) { return __builtin_amdgcn_exp2f(x); }
DI float silu(float x) { return x / (1.f + __expf(-x)); }
DI f32x4 mfma16(bf16x8 a, bf16x8 b, f32x4 c) { return __builtin_amdgcn_mfma_f32_16x16x32_bf16(a, b, c, 0, 0, 0); }
DI f32x16 mfma32(bf16x8 a, bf16x8 b, f32x16 c) { return __builtin_amdgcn_mfma_f32_32x32x16_bf16(a, b, c, 0, 0, 0); }
DI bf16x8 ld8(const u16* p) { return *reinterpret_cast<const bf16x8*>(p); }
DI int opq(int x) { asm volatile("" : "+v"(x)); return x; }
#define TIDX opq((int)threadIdx.x)

DI void tr_tile(const float* __restrict__ src, size_t ld_src, u16* __restrict__ dst, size_t ld_dst, float* sT) {
  const int tid = TIDX;
  const int r = tid >> 4, c4 = (tid & 15) * 4;
#pragma unroll
  for (int i = 0; i < 4; ++i) {
    float4 v = *reinterpret_cast<const float4*>(src + (size_t)(r + 16 * i) * ld_src + c4);
    float* d = sT + (r + 16 * i) * 65 + c4;
    d[0] = v.x; d[1] = v.y; d[2] = v.z; d[3] = v.w;
  }
  __syncthreads();
  const int n = tid >> 2, ks = (tid & 3) * 16;
  u32 w[8];
#pragma unroll
  for (int j = 0; j < 8; ++j) w[j] = pk2(sT[(ks + 2 * j) * 65 + n], sT[(ks + 2 * j + 1) * 65 + n]);
  u32x4* o = reinterpret_cast<u32x4*>(dst + (size_t)n * ld_dst + ks);
  o[0] = u32x4{w[0], w[1], w[2], w[3]};
  o[1] = u32x4{w[4], w[5], w[6], w[7]};
  __syncthreads();
}

DI void cvt8(const float* __restrict__ src, u16* __restrict__ dst) {
  float4 a = *reinterpret_cast<const float4*>(src);
  float4 b = *reinterpret_cast<const float4*>(src + 4);
  *reinterpret_cast<u32x4*>(dst) = u32x4{pk2(a.x, a.y), pk2(a.z, a.w), pk2(b.x, b.y), pk2(b.z, b.w)};
}

DI void mod_item(const Params& p, int i, unsigned char* lds) {
  const int tid = TIDX;
  const int l = i / 96, n0 = (i % 96) * 64;
  float* sS = reinterpret_cast<float*>(lds);
  float* red = sS + 5 * 2048;
  const float* c = p.in[10];
  const float* cctx = p.in[11];
  for (int e = tid; e < 5 * 2048; e += 256) {
    int v = e >> 11, k = e & 2047;
    float x = (v == 0) ? cctx[k] : c[(v - 1) * 2048 + k];
    sS[e] = silu(x);
  }
  __syncthreads();
  const int kk = tid >> 4, c4 = (tid & 15) * 4;
  const float* W = p.in[12 + 10 * l] + n0 + c4;
  f32x4 acc[5];
#pragma unroll
  for (int v = 0; v < 5; ++v) acc[v] = f32x4{0.f, 0.f, 0.f, 0.f};
#pragma unroll 8
  for (int k = kk; k < 2048; k += 16) {
    float4 w = *reinterpret_cast<const float4*>(W + (size_t)k * 6144);
#pragma unroll
    for (int v = 0; v < 5; ++v) {
      float s = sS[v * 2048 + k];
      acc[v][0] += s * w.x; acc[v][1] += s * w.y; acc[v][2] += s * w.z; acc[v][3] += s * w.w;
    }
  }
#pragma unroll
  for (int v = 0; v < 5; ++v)
#pragma unroll
    for (int q = 0; q < 4; ++q) red[(kk * 5 + v) * 64 + c4 + q] = acc[v][q];
  __syncthreads();
  for (int t2 = tid; t2 < 320; t2 += 256) {
    int v = t2 >> 6, n = t2 & 63;
    float s = 0.f;
#pragma unroll
    for (int k2 = 0; k2 < 16; ++k2) s += red[(k2 * 5 + v) * 64 + n];
    float* mod = reinterpret_cast<float*>(p.ws + WS_MOD);
    mod[(size_t)(l * 5 + v) * 6144 + n0 + n] = s + p.in[13 + 10 * l][n0 + n];
  }
  __syncthreads();
}

DI void phase_prep(const Params& p, unsigned char* lds) {
  constexpr int N_MOD = 384, N_TRWIN = 13312, N_TRWOUT = 4096, N_TRPOOL = 128, N_SGU = 64, N_CK = 4096, N_CV = 2048;
  constexpr int TOTAL = N_MOD + N_TRWIN + N_TRWOUT + N_TRPOOL + N_SGU + N_CK + N_CV + 1;
  const int tid = TIDX;
  float* sT = reinterpret_cast<float*>(lds);
  for (int it = blockIdx.x; it < TOTAL; it += gridDim.x) {
    int i = it;
    if (i < N_MOD) { mod_item(p, i, lds); continue; }
    i -= N_MOD;
    if (i < N_TRWIN) {
      int l, base;
      if (i < 3072) { l = 0; base = 0; } else if (i < 6656) { l = 1; base = 3072; } else if (i < 9728) { l = 2; base = 6656; } else { l = 3; base = 9728; }
      i -= base;
      const int N = (l & 1) ? 7168 : 6144, nN = N / 64;
      const int kt = i / nN, nt = i % nN;
      tr_tile(p.in[14 + 10 * l] + (size_t)kt * 64 * N + nt * 64, N,
              reinterpret_cast<u16*>(p.ws + ws_wint(l)) + (size_t)nt * 64 * 2048 + kt * 64, 2048, sT);
      continue;
    }
    i -= N_TRWIN;
    if (i < N_TRWOUT) {
      const int l = i >> 10, r = i & 1023, kt = r >> 5, nt = r & 31;
      tr_tile(p.in[15 + 10 * l] + (size_t)kt * 64 * 2048 + nt * 64, 2048,
              reinterpret_cast<u16*>(p.ws + WS_WOUTT) + (size_t)l * 2048 * 2048 + (size_t)nt * 64 * 2048 + kt * 64, 2048, sT);
      continue;
    }
    i -= N_TRWOUT;
    if (i < N_TRPOOL) {
      const int e = i >> 6, r = i & 63, g = r >> 4, t = r & 15, kt = t >> 2, nt = t & 3;
      tr_tile(p.in[18 + 20 * e] + (size_t)g * 65536 + kt * 64 * 256 + nt * 64, 256,
              reinterpret_cast<u16*>(p.ws + WS_POOLWT) + (size_t)e * 262144 + g * 65536 + nt * 64 * 256 + kt * 64, 256, sT);
      continue;
    }
    i -= N_TRPOOL;
    if (i < N_SGU) {
      const int e = i >> 5, ch = i & 31;
      const size_t off = (size_t)ch * 2048 + tid * 8;
      cvt8(p.in[30 + 20 * e] + off, reinterpret_cast<u16*>(p.ws + WS_SGUW) + (size_t)e * 65536 + off);
      continue;
    }
    i -= N_SGU;
    if (i < N_CK) {
      const int l = i >> 10, ch = i & 1023;
      const size_t off = (size_t)ch * 2048 + tid * 8;
      cvt8(p.in[2 + 2 * l] + off, reinterpret_cast<u16*>(p.ws + WS_CK) + (size_t)l * 2097152 + off);
      continue;
    }
    i -= N_CK;
    if (i < N_CV) {
      const int l = i >> 9, r = i & 511, bh = r >> 4, t = r & 15, kt = t >> 1, nt = t & 1;
      tr_tile(p.in[3 + 2 * l] + (size_t)bh * 65536 + kt * 64 * 128 + nt * 64, 128,
              reinterpret_cast<u16*>(p.ws + WS_CVT) + (size_t)l * 2097152 + (size_t)bh * 65536 + nt * 64 * 512 + kt * 64, 512, sT);
      continue;
    }
    {
      float* rc = reinterpret_cast<float*>(p.ws + WS_ROPE);
      for (int e = tid; e < 1024; e += 256) {
        int pos = e >> 4, fi = e & 15;
        float inv = 1.0f / powf(10000.0f, (float)(2 * fi) / 32.0f);
        float ang = (float)pos * inv;
        rc[e] = cosf(ang);
        rc[1024 + e] = sinf(ang);
      }
    }
  }
}

DI void phase_mod0(const Params& p) {
  const int tid = TIDX;
  const float* mod = reinterpret_cast<const float*>(p.ws + WS_MOD);
  u16* H = reinterpret_cast<u16*>(p.ws + WS_H);
  for (int it = blockIdx.x; it < T_ALL / 4; it += gridDim.x) {
#pragma unroll
    for (int rr = 0; rr < 4; ++rr) {
      const int row = it * 4 + rr;
      const int cond = row < TP ? 0 : 1 + ((row - TP) >> 12);
      const float* src = row < TP ? p.in[0] + (size_t)row * 2048 : p.in[1] + (size_t)(row - TP) * 2048;
      const int e = tid * 8;
      const float* sh = mod + (size_t)cond * 6144 + e;
      float4 a = *reinterpret_cast<const float4*>(src + e), b = *reinterpret_cast<const float4*>(src + e + 4);
      float4 s0 = *reinterpret_cast<const float4*>(sh), s1 = *reinterpret_cast<const float4*>(sh + 4);
      float4 c0 = *reinterpret_cast<const float4*>(sh + 2048), c1 = *reinterpret_cast<const float4*>(sh + 2052);
      u32x4 o = {pk2(a.x * (1.f + c0.x) + s0.x, a.y * (1.f + c0.y) + s0.y), pk2(a.z * (1.f + c0.z) + s0.z, a.w * (1.f + c0.w) + s0.w),
                 pk2(b.x * (1.f + c1.x) + s1.x, b.y * (1.f + c1.y) + s1.y), pk2(b.z * (1.f + c1.z) + s1.z, b.w * (1.f + c1.w) + s1.w)};
      *reinterpret_cast<u32x4*>(H + (size_t)row * 2048 + e) = o;
    }
  }
}

enum { G_IN_EVEN = 0, G_IN_ODD = 1, G_OUT = 2 };

template <bool TR>
DI void gemm_tile(const u16* ga, const u16* gb, u16* sA, u16* sB, int tid, int wr, int wc, int fr, int fo0, int fo1, f32x4 (&acc)[4][4]) {
  constexpr int K = 2048;
#pragma unroll
  for (int a = 0; a < 4; ++a)
#pragma unroll
    for (int b = 0; b < 4; ++b) acc[a][b] = f32x4{0.f, 0.f, 0.f, 0.f};
#define GSTAGE(B_, KT_)                                                                                                   \
  _Pragma("unroll") for (int i = 0; i < 4; ++i) {                                                                         \
    __builtin_amdgcn_global_load_lds((const unsigned*)(ga + (size_t)i * 32 * K + (KT_) * 64),                             \
                                     (unsigned*)(sA + (B_) * 8192 + i * 2048 + tid * 8), 16, 0, 0);                       \
    __builtin_amdgcn_global_load_lds((const unsigned*)(gb + (size_t)i * 32 * K + (KT_) * 64),                             \
                                     (unsigned*)(sB + (B_) * 8192 + i * 2048 + tid * 8), 16, 0, 0);                       \
  }
  GSTAGE(0, 0)
  asm volatile("s_waitcnt vmcnt(0)" ::: "memory");
  __syncthreads();
  for (int kt = 0; kt < K / 64; ++kt) {
    const int buf = kt & 1;
    if (kt + 1 < K / 64) { GSTAGE(buf ^ 1, kt + 1) }
    const u16* cA = sA + buf * 8192 + (wr * 64 + fr) * 64;
    const u16* cB = sB + buf * 8192 + (wc * 64 + fr) * 64;
#pragma unroll
    for (int ks = 0; ks < 2; ++ks) {
      const int fo = ks ? fo1 : fo0;
      bf16x8 af[4], bfr[4];
#pragma unroll
      for (int m = 0; m < 4; ++m) af[m] = ld8(cA + m * 1024 + fo);
#pragma unroll
      for (int n = 0; n < 4; ++n) bfr[n] = ld8(cB + n * 1024 + fo);
#pragma unroll
      for (int m = 0; m < 4; ++m)
#pragma unroll
        for (int n = 0; n < 4; ++n) acc[m][n] = TR ? mfma16(bfr[n], af[m], acc[m][n]) : mfma16(af[m], bfr[n], acc[m][n]);
    }
    asm volatile("s_waitcnt vmcnt(0)" ::: "memory");
    __syncthreads();
  }
#undef GSTAGE
}

template <int MODE>
DI void gemm_phase(const Params& p, int l, unsigned char* lds) {
  constexpr int K = 2048;
  constexpr int N = (MODE == G_OUT) ? 2048 : (MODE == G_IN_EVEN ? 6144 : 7168);
  constexpr int NC = (MODE == G_IN_EVEN) ? 6144 : 7168;
  constexpr int nTn = N / 128;
  constexpr int TOTAL = nTn * 192;
  const u16* A = reinterpret_cast<const u16*>(p.ws + WS_H);
  const u16* Bt = (MODE == G_OUT) ? reinterpret_cast<const u16*>(p.ws + WS_WOUTT) + (size_t)l * 2048 * 2048
                                  : reinterpret_cast<const u16*>(p.ws + ws_wint(l));
  u16* sA = reinterpret_cast<u16*>(lds);
  u16* sB = sA + 2 * 128 * 64;
  const int tid = TIDX, lane = tid & 63, wid = tid >> 6;
  const int wr = wid >> 1, wc = wid & 1, fr = lane & 15, fq = lane >> 4;
  const int lrow = tid >> 3;
  const int csrc = ((tid & 7) ^ ((lrow >> 1) & 7)) * 8;
  const int swz = (fr >> 1) & 7;
  const int fo0 = (fq ^ swz) * 8, fo1 = ((4 + fq) ^ swz) * 8;
  u16* PROJ = reinterpret_cast<u16*>(p.ws + WS_PROJ);
  u16* VT = reinterpret_cast<u16*>(p.ws + WS_VT);
  const float* mod = reinterpret_cast<const float*>(p.ws + WS_MOD);
  const float* ropeC = reinterpret_cast<const float*>(p.ws + WS_ROPE);
  const float* ropeS = ropeC + 1024;

  for (int it = blockIdx.x; it < TOTAL; it += gridDim.x) {
    constexpr int PN = nTn / 8;
    const int rnd = it >> 9, vb = it & 511, q = rnd * 8 + (vb & 7), jj = vb >> 3;
    const int tm = (q / PN) * 8 + (jj & 7), tn = (q % PN) * 8 + (jj >> 3);
    const u16* ga = A + (size_t)(tm * 128 + lrow) * K + csrc;
    const u16* gb = Bt + (size_t)(tn * 128 + lrow) * K + csrc;
    f32x4 acc[4][4];
    const bool prompt = tm < 64;
    const int R0 = tm * 128 + wr * 64, C0 = tn * 128 + wc * 64;
    if (MODE == G_OUT) {
      gemm_tile<true>(ga, gb, sA, sB, tid, wr, wc, fr, fo0, fo1, acc);
      const int cond = prompt ? 0 : 1 + ((tm * 128 - TP) >> 12);
      const float* gate = mod + (size_t)(l * 5 + cond) * 6144 + 4096;
      float* X = p.out;
#pragma unroll
      for (int n = 0; n < 4; ++n) {
        const int col = C0 + n * 16 + 4 * fq;
        const float4 g4 = *reinterpret_cast<const float4*>(gate + col);
#pragma unroll
        for (int m = 0; m < 4; ++m) {
          const int row = R0 + m * 16 + fr;
          float4 xo;
          if (l == 0) xo = prompt ? *reinterpret_cast<const float4*>(p.in[0] + (size_t)row * 2048 + col)
                                  : *reinterpret_cast<const float4*>(p.in[1] + (size_t)(row - TP) * 2048 + col);
          else xo = *reinterpret_cast<const float4*>(X + (size_t)row * 2048 + col);
          float4 o;
          o.x = ALPHA * xo.x + g4.x * acc[m][n][0]; o.y = ALPHA * xo.y + g4.y * acc[m][n][1];
          o.z = ALPHA * xo.z + g4.z * acc[m][n][2]; o.w = ALPHA * xo.w + g4.w * acc[m][n][3];
          *reinterpret_cast<float4*>(X + (size_t)row * 2048 + col) = o;
        }
      }
    } else {
      const int sec = tn >> 3;
      const int SEC_Q = (MODE == G_IN_EVEN) ? 2 : 0, SEC_K = (MODE == G_IN_EVEN) ? 3 : 1, SEC_V = (MODE == G_IN_EVEN) ? 4 : 2;
      if (sec == SEC_V) {
        gemm_tile<false>(ga, gb, sA, sB, tid, wr, wc, fr, fo0, fo1, acc);
        const int rowb = R0 + fq * 4;
        const int hh = tn & 7;
        float* vout = p.out + (size_t)T_ALL * 2048 + (size_t)(2 * l + 1) * 8388608;
#pragma unroll
        for (int m = 0; m < 4; ++m) {
          const int row = rowb + m * 16;
#pragma unroll
          for (int n = 0; n < 4; ++n) {
            const int dv = wc * 64 + n * 16 + fr;
            u32x2 w = {pk2(acc[m][n][0], acc[m][n][1]), pk2(acc[m][n][2], acc[m][n][3])};
            if (prompt) {
              const int b = row >> 8, t = row & 255;
              *reinterpret_cast<u32x2*>(VT + ((size_t)((b * 8 + hh) * 128 + dv)) * 256 + t) = w;
#pragma unroll
              for (int j = 0; j < 4; ++j) vout[((size_t)((b * 8 + hh) * 256 + t + j)) * 128 + dv] = acc[m][n][j];
            } else {
              const int rs = row - TP, b = rs >> 12, t = rs & 4095;
              *reinterpret_cast<u32x2*>(VT + 8388608 + ((size_t)((b * 8 + hh) * 128 + dv)) * 4096 + t) = w;
            }
          }
        }
      } else {
        gemm_tile<true>(ga, gb, sA, sB, tid, wr, wc, fr, fo0, fo1, acc);
        const bool isq = sec == SEC_Q, isk = sec == SEC_K;
        const bool rope = (MODE == G_IN_EVEN) && (isq || isk) && !prompt;
        const float qs = (MODE == G_IN_EVEN) ? 0.125f * LOG2E : 0.08838834764831845f * LOG2E;
        if (isk && prompt) {
          const int hh = tn & 7;
          float* kout = p.out + (size_t)T_ALL * 2048 + (size_t)(2 * l) * 8388608;
#pragma unroll
          for (int m = 0; m < 4; ++m) {
            const int row = R0 + m * 16 + fr, b = row >> 8, t = row & 255;
#pragma unroll
            for (int n = 0; n < 4; ++n) {
              const int d = wc * 64 + n * 16 + 4 * fq;
              *reinterpret_cast<float4*>(kout + ((size_t)((b * 8 + hh) * 256 + t)) * 128 + d) =
                  float4{acc[m][n][0], acc[m][n][1], acc[m][n][2], acc[m][n][3]};
            }
          }
        }
        if (rope) {
#pragma unroll
          for (int m = 0; m < 4; ++m) {
            const int t = (R0 + m * 16 + fr - TP) & 4095;
#pragma unroll
            for (int ax = 0; ax < 2; ++ax) {
              const int pos = ax ? (t & 63) : (t >> 6);
              const float4 cs = *reinterpret_cast<const float4*>(ropeC + pos * 16 + 4 * fq);
              const float4 sn = *reinterpret_cast<const float4*>(ropeS + pos * 16 + 4 * fq);
              const float c4[4] = {cs.x, cs.y, cs.z, cs.w}, s4[4] = {sn.x, sn.y, sn.z, sn.w};
#pragma unroll
              for (int j = 0; j < 4; ++j) {
                const float x1 = acc[m][2 * ax][j], x2 = acc[m][2 * ax + 1][j];
                acc[m][2 * ax][j] = x1 * c4[j] - x2 * s4[j];
                acc[m][2 * ax + 1][j] = x1 * s4[j] + x2 * c4[j];
              }
            }
          }
        }
        const float sc = isq ? qs : 1.0f;
#pragma unroll
        for (int m = 0; m < 4; ++m) {
          const int row = R0 + m * 16 + fr;
#pragma unroll
          for (int n = 0; n < 4; ++n) {
            const int col = C0 + n * 16 + 4 * fq;
            *reinterpret_cast<u32x2*>(PROJ + (size_t)row * NC + col) =
                u32x2{pk2(acc[m][n][0] * sc, acc[m][n][1] * sc), pk2(acc[m][n][2] * sc, acc[m][n][3] * sc)};
          }
        }
      }
    }
  }
}

DI void phase_ln(const Params& p, int l) {
  const int tid_ = TIDX, lane = tid_ & 63, wid = tid_ >> 6;
  const float* g = p.in[16 + 10 * l];
  const float* bb = p.in[17 + 10 * l];
  const float* mod = reinterpret_cast<const float*>(p.ws + WS_MOD);
  u16* H = reinterpret_cast<u16*>(p.ws + WS_H);
  float* X = p.out;
  for (int it = blockIdx.x; it < T_ALL / 4; it += gridDim.x) {
    const int row = it * 4 + wid;
    float* xr = X + (size_t)row * 2048;
    float4 v[8];
    float s = 0.f;
#pragma unroll
    for (int i = 0; i < 8; ++i) {
      v[i] = *reinterpret_cast<const float4*>(xr + (i * 64 + lane) * 4);
      s += v[i].x + v[i].y + v[i].z + v[i].w;
    }
#pragma unroll
    for (int o = 32; o >= 1; o >>= 1) s += __shfl_xor(s, o);
    const float mu = s * (1.f / 2048.f);
    float ss = 0.f;
#pragma unroll
    for (int i = 0; i < 8; ++i) {
      float a = v[i].x - mu, b = v[i].y - mu, c = v[i].z - mu, d = v[i].w - mu;
      ss += a * a + b * b + c * c + d * d;
    }
#pragma unroll
    for (int o = 32; o >= 1; o >>= 1) ss += __shfl_xor(ss, o);
    const float rstd = rsqrtf(ss * (1.f / 2048.f) + LN_EPS);
    const int cond = row < TP ? 0 : 1 + ((row - TP) >> 12);
    const float* sh = mod + (size_t)((l + 1) * 5 + cond) * 6144;
#pragma unroll
    for (int i = 0; i < 8; ++i) {
      const int e = (i * 64 + lane) * 4;
      float4 gg = *reinterpret_cast<const float4*>(g + e), b4 = *reinterpret_cast<const float4*>(bb + e);
      float4 y;
      y.x = (v[i].x - mu) * rstd * gg.x + b4.x; y.y = (v[i].y - mu) * rstd * gg.y + b4.y;
      y.z = (v[i].z - mu) * rstd * gg.z + b4.z; y.w = (v[i].w - mu) * rstd * gg.w + b4.w;
      *reinterpret_cast<float4*>(xr + e) = y;
      if (l < 3) {
        float4 s0 = *reinterpret_cast<const float4*>(sh + e), c0 = *reinterpret_cast<const float4*>(sh + 2048 + e);
        u32x2 o = {pk2(y.x * (1.f + c0.x) + s0.x, y.y * (1.f + c0.y) + s0.y), pk2(y.z * (1.f + c0.z) + s0.z, y.w * (1.f + c0.w) + s0.w)};
        *reinterpret_cast<u32x2*>(H + (size_t)row * 2048 + e) = o;
      }
    }
  }
}

struct AttnSrc {
  const u16* k0; const u16* vt0; int ks0, vs0, n0;
  const u16* k1; const u16* vt1; int ks1, vs1, n1;
};

template <int DQK>
DI void attn_ldg(const AttnSrc& s, int j, u32x4 (&rk)[DQK / 32], u32x4 (&rv)[4]) {
  const u16* kb; const u16* vb; int ks, vs;
  if (j < s.n0) { kb = s.k0 + (size_t)j * 64 * s.ks0; vb = s.vt0 + j * 64; ks = s.ks0; vs = s.vs0; }
  else { const int jj = j - s.n0; kb = s.k1 + (size_t)jj * 64 * s.ks1; vb = s.vt1 + jj * 64; ks = s.ks1; vs = s.vs1; }
  constexpr int CPR = DQK / 8;
  const int tid = TIDX;
#pragma unroll
  for (int i = 0; i < DQK / 32; ++i) {
    const int c = tid + 256 * i, row = c / CPR, kc = c % CPR;
    rk[i] = *reinterpret_cast<const u32x4*>(kb + (size_t)row * ks + kc * 8);
  }
#pragma unroll
  for (int i = 0; i < 4; ++i) {
    const int c = tid + 256 * i, row = c >> 3, kc = c & 7;
    rv[i] = *reinterpret_cast<const u32x4*>(vb + (size_t)row * vs + kc * 8);
  }
}
template <int DQK>
DI void attn_sts(u16* sK, u16* sVT, const u32x4 (&rk)[DQK / 32], const u32x4 (&rv)[4]) {
  constexpr int CPR = DQK / 8;
  const int tid = TIDX;
#pragma unroll
  for (int i = 0; i < DQK / 32; ++i) {
    const int c = tid + 256 * i, row = c / CPR, kc = c % CPR;
    *reinterpret_cast<u32x4*>(sK + row * (DQK + 8) + kc * 8) = rk[i];
  }
#pragma unroll
  for (int i = 0; i < 4; ++i) {
    const int c = tid + 256 * i, row = c >> 3, kc = c & 7;
    *reinterpret_cast<u32x4*>(sVT + row * 72 + kc * 8) = rv[i];
  }
}

template <int DQK, bool NA>
DI void attn_run(const AttnSrc& src, const u16* qblk, int qstride, u16* sQ, u16* sK, u16* sVT, f32x16 (&O)[4], float& l_out,
                 int qr, int qc, int rsmin, const float* sBias) {
  const int tid = TIDX, lane = tid & 63, wid = tid >> 6;
  const int r = lane & 31, h = lane >> 5;
  const int pr = (r & 0x13) | ((r & 4) << 1) | ((r & 8) >> 1);
  constexpr int CPR = DQK / 8, QS = DQK + 8;
  __syncthreads();
#pragma unroll
  for (int i = 0; i < DQK / 16; ++i) {
    const int c = tid + 256 * i, row = c / CPR, kc = c % CPR;
    *reinterpret_cast<u32x4*>(sQ + row * QS + kc * 8) = *reinterpret_cast<const u32x4*>(qblk + (size_t)row * qstride + kc * 8);
  }
#pragma unroll
  for (int d = 0; d < 4; ++d)
#pragma unroll
    for (int i = 0; i < 16; ++i) O[d][i] = 0.f;
  float m = -1e30f, l = 0.f;
  const int nt = src.n0 + src.n1;
  const int rsq = min(max(qr - 4, 0), 56);
  const int cs = min(max(qc - 8, 0), 48);
  const u16* qw = sQ + (wid * 32 + r) * QS + 8 * h;
  const u16* kw = sK + pr * QS + 8 * h;
  const u16* vw = sVT + r * 72 + 8 * h;
  u32x4 rk[DQK / 32], rv[4];
  attn_ldg<DQK>(src, 0, rk, rv);
#pragma unroll 1
  for (int j = 0; j < nt; ++j) {
    if (j > 0) __syncthreads();
    attn_sts<DQK>(sK, sVT, rk, rv);
    __syncthreads();
    if (j + 1 < nt) attn_ldg<DQK>(src, j + 1, rk, rv);
    __builtin_amdgcn_sched_barrier(0);
    bool active = true;
    int kr = 0;
    if (NA && j >= src.n0) { kr = rsmin + (j - src.n0); active = (kr >= rsq) && (kr < rsq + 8); }
    if (active) {
      f32x16 s[2];
#pragma unroll
      for (int t = 0; t < 2; ++t) {
#pragma unroll
        for (int i = 0; i < 16; ++i) s[t][i] = 0.f;
#pragma unroll
        for (int ks = 0; ks < DQK / 16; ++ks) {
          bf16x8 a = ld8(kw + t * 32 * QS + ks * 16);
          bf16x8 q = ld8(qw + ks * 16);
          s[t] = mfma32(a, q, s[t]);
        }
      }
      if (NA && j >= src.n0) {
        const float* bp = sBias + (kr - qr + 7) * 31 + (8 * h - qc + 15);
        const int kb = 8 * h - cs;
#pragma unroll
        for (int t = 0; t < 2; ++t)
#pragma unroll
          for (int i = 0; i < 16; ++i) {
            const int ko = t * 32 + 16 * (i >> 3) + (i & 7);
            const bool ok = (unsigned)(ko + kb) < 16u;
            const float bv = bp[ko];
            s[t][i] = ok ? s[t][i] + bv : -1e30f;
          }
      }
      float mx = -1e30f;
#pragma unroll
      for (int t = 0; t < 2; ++t)
#pragma unroll
        for (int i = 0; i < 16; ++i) mx = fmaxf(mx, s[t][i]);
      mx = fmaxf(mx, __shfl_xor(mx, 32));
      if (__builtin_amdgcn_ballot_w64(mx > m + 8.0f) != 0ull) {
        const float mn = fmaxf(m, mx);
        const float alpha = ex2(m - mn);
        l *= alpha;
        m = mn;
#pragma unroll
        for (int d = 0; d < 4; ++d)
#pragma unroll
          for (int i = 0; i < 16; ++i) O[d][i] *= alpha;
      }
      float rsum = 0.f;
#pragma unroll
      for (int t = 0; t < 2; ++t)
#pragma unroll
        for (int i = 0; i < 16; ++i) { const float e = ex2(s[t][i] - m); s[t][i] = e; rsum += e; }
      rsum += __shfl_xor(rsum, 32);
      l += rsum;
#pragma unroll
      for (int s4 = 0; s4 < 4; ++s4) {
        const int t = s4 >> 1, b0 = (s4 & 1) * 8;
        u32x4 w = {pk2(s[t][b0], s[t][b0 + 1]), pk2(s[t][b0 + 2], s[t][b0 + 3]), pk2(s[t][b0 + 4], s[t][b0 + 5]), pk2(s[t][b0 + 6], s[t][b0 + 7])};
        const bf16x8 pf = __builtin_bit_cast(bf16x8, w);
#pragma unroll
        for (int d = 0; d < 4; ++d) {
          bf16x8 a = ld8(vw + d * 32 * 72 + s4 * 16);
          O[d] = mfma32(a, pf, O[d]);
        }
      }
    }
  }
  l_out = l;
}

DI void heavy_map(int it, int& bh, int& qb) { const int x = it & 7, idx = it >> 3; bh = x + 8 * (idx >> 5); qb = idx & 31; }

DI void diff_item(const Params& p, int l, bool sample, int bh, int qb, unsigned char* lds) {
  constexpr int NC = 6144;
  const int tid_ = TIDX, lane = tid_ & 63, wid = tid_ >> 6, r = lane & 31, h = lane >> 5;
  const int b = bh >> 3, hd = bh & 7;
  u16* sQ = reinterpret_cast<u16*>(lds);
  u16* sK = sQ + 128 * 136;
  u16* sVT = sK + 64 * 136;
  const u16* PROJ = reinterpret_cast<const u16*>(p.ws + WS_PROJ);
  const u16* VT = reinterpret_cast<const u16*>(p.ws + WS_VT);
  const int seq0 = sample ? TP + b * 4096 : b * 256;
  const int token = seq0 + qb * 128 + wid * 32 + r;
  const float* dl = p.in[20 + 10 * l];
  float pa = dl[lane] * dl[64 + lane], pb = dl[128 + lane] * dl[192 + lane];
#pragma unroll
  for (int o = 32; o >= 1; o >>= 1) { pa += __shfl_xor(pa, o); pb += __shfl_xor(pb, o); }
  const float lam_init = 0.8f - 0.6f * __expf(-0.3f * (float)l);
  const float lam = __expf(pa) - __expf(pb) + lam_init;

  u32 o1p[32];
  f32x16 O[4];
  float lsum;
#pragma unroll
  for (int comp = 0; comp < 2; ++comp) {
    AttnSrc s;
    if (sample) {
      s.k0 = reinterpret_cast<const u16*>(p.ws + WS_CK) + (size_t)l * 2097152 + (size_t)bh * 65536 + comp * 64; s.ks0 = 128;
      s.vt0 = reinterpret_cast<const u16*>(p.ws + WS_CVT) + (size_t)l * 2097152 + (size_t)bh * 65536; s.vs0 = 512; s.n0 = 8;
      s.k1 = PROJ + (size_t)seq0 * NC + 3072 + hd * 128 + comp * 64; s.ks1 = NC;
      s.vt1 = VT + 8388608 + (size_t)bh * 128 * 4096; s.vs1 = 4096; s.n1 = 64;
    } else {
      s.k0 = nullptr; s.vt0 = nullptr; s.ks0 = 0; s.vs0 = 0; s.n0 = 0;
      s.k1 = PROJ + (size_t)seq0 * NC + 3072 + hd * 128 + comp * 64; s.ks1 = NC;
      s.vt1 = VT + (size_t)bh * 128 * 256; s.vs1 = 256; s.n1 = 4;
    }
    const u16* qblk = PROJ + (size_t)(seq0 + qb * 128) * NC + 2048 + hd * 128 + comp * 64;
    attn_run<64, false>(s, qblk, NC, sQ, sK, sVT, O, lsum, 0, 0, 0, nullptr);
    const float inv = 1.f / lsum;
    if (comp == 0) {
#pragma unroll
      for (int d = 0; d < 4; ++d)
#pragma unroll
        for (int i = 0; i < 8; ++i) o1p[d * 8 + i] = pk2(O[d][2 * i] * inv, O[d][2 * i + 1] * inv);
    } else {
      float ssq = 0.f;
#pragma unroll
      for (int d = 0; d < 4; ++d)
#pragma unroll
        for (int i = 0; i < 8; ++i) {
          const u32 w = o1p[d * 8 + i];
          const float a = bflo(w) - lam * O[d][2 * i] * inv, c = bfhi(w) - lam * O[d][2 * i + 1] * inv;
          O[d][2 * i] = a; O[d][2 * i + 1] = c;
          ssq += a * a + c * c;
        }
      ssq += __shfl_xor(ssq, 32);
      const float rn = rsqrtf(ssq * (1.f / 128.f) + LN_EPS) * (1.f - lam_init);
      const float* subln = p.in[21 + 10 * l];
      const u16* gp = PROJ + (size_t)token * NC + 5120 + hd * 128;
      u16* yp = reinterpret_cast<u16*>(p.ws + WS_H) + (size_t)token * 2048 + 1024 + hd * 128;
#pragma unroll
      for (int d = 0; d < 4; ++d)
#pragma unroll
        for (int q = 0; q < 4; ++q) {
          const int dv = d * 32 + 8 * q + 4 * h;
          const u32x2 gw = *reinterpret_cast<const u32x2*>(gp + dv);
          const float4 sl = *reinterpret_cast<const float4*>(subln + dv);
          const float y0 = O[d][4 * q] * rn * sl.x * silu(bflo(gw[0]));
          const float y1 = O[d][4 * q + 1] * rn * sl.y * silu(bfhi(gw[0]));
          const float y2 = O[d][4 * q + 2] * rn * sl.z * silu(bflo(gw[1]));
          const float y3 = O[d][4 * q + 3] * rn * sl.w * silu(bfhi(gw[1]));
          *reinterpret_cast<u32x2*>(yp + dv) = (ZERO_MASK & 2) ? u32x2{0u, 0u} : u32x2{pk2(y0, y1), pk2(y2, y3)};
        }
    }
  }
}

DI void pool_item(const Params& p, int l, int pi, unsigned char* lds) {
  constexpr int NC = 6144;
  const int tid = TIDX, lane = tid & 63, wid = tid >> 6, fr = lane & 15, fq = lane >> 4;
  const int tb = pi >> 2, g = pi & 3, row0 = tb * 64;
  const int L = row0 < TP ? 256 : 4096;
  const int t0 = row0 < TP ? (row0 & 255) : ((row0 - TP) & 4095);
  u16* sIn = reinterpret_cast<u16*>(lds);
  u16* sP = sIn + 80 * 264;
  const u16* PROJ = reinterpret_cast<const u16*>(p.ws + WS_PROJ);
  __syncthreads();
#pragma unroll
  for (int i = 0; i < 10; ++i) {
    const int c = tid + 256 * i, rr = c >> 5, oc = c & 31;
    const int t = t0 - 8 + rr;
    u32x4 v = {0u, 0u, 0u, 0u};
    if (t >= 0 && t < L) v = *reinterpret_cast<const u32x4*>(PROJ + (size_t)(row0 - 8 + rr) * NC + g * 256 + oc * 8);
    *reinterpret_cast<u32x4*>(sIn + rr * 264 + oc * 8) = v;
  }
  __syncthreads();
  {
    const int oc = tid & 31, seg = tid >> 5;
    const int half = 1 << g;
#pragma unroll 1
    for (int tt = 0; tt < 8; ++tt) {
      const int tl = seg * 8 + tt, t = t0 + tl;
      const int lo = max(t - half, 0), hi = min(t + half, L);
      float a[8];
#pragma unroll
      for (int k = 0; k < 8; ++k) a[k] = 0.f;
      for (int s = lo; s < hi; ++s) {
        const u32x4 v = *reinterpret_cast<const u32x4*>(sIn + (s - t0 + 8) * 264 + oc * 8);
#pragma unroll
        for (int k = 0; k < 4; ++k) { a[2 * k] += bflo(v[k]); a[2 * k + 1] += bfhi(v[k]); }
      }
      const float ic = 1.f / (float)(hi - lo);
      const u32x4 x = *reinterpret_cast<const u32x4*>(sIn + (tl + 8) * 264 + oc * 8);
      u32x4 o;
#pragma unroll
      for (int k = 0; k < 4; ++k) o[k] = pk2(a[2 * k] * ic - bflo(x[k]), a[2 * k + 1] * ic - bfhi(x[k]));
      *reinterpret_cast<u32x4*>(sP + tl * 264 + oc * 8) = o;
    }
  }
  __syncthreads();
  const u16* W = reinterpret_cast<const u16*>(p.ws + WS_POOLWT) + (size_t)(l >> 1) * 262144 + (size_t)g * 65536;
  f32x4 acc[4][4];
#pragma unroll
  for (int a = 0; a < 4; ++a)
#pragma unroll
    for (int b = 0; b < 4; ++b) acc[a][b] = f32x4{0.f, 0.f, 0.f, 0.f};
#pragma unroll 2
  for (int ks = 0; ks < 8; ++ks) {
    bf16x8 af[4], bfr[4];
#pragma unroll
    for (int m = 0; m < 4; ++m) af[m] = ld8(sP + (m * 16 + fr) * 264 + ks * 32 + fq * 8);
#pragma unroll
    for (int n = 0; n < 4; ++n) bfr[n] = ld8(W + (size_t)(wid * 64 + n * 16 + fr) * 256 + ks * 32 + fq * 8);
#pragma unroll
    for (int m = 0; m < 4; ++m)
#pragma unroll
      for (int n = 0; n < 4; ++n) acc[m][n] = mfma16(af[m], bfr[n], acc[m][n]);
  }
  const float* pscale = p.in[19 + 10 * l];
  u16* Y = reinterpret_cast<u16*>(p.ws + WS_H);
#pragma unroll
  for (int n = 0; n < 4; ++n) {
    const int col = g * 256 + wid * 64 + n * 16 + fr;
    const float sc = pscale[col];
#pragma unroll
    for (int m = 0; m < 4; ++m)
#pragma unroll
      for (int j = 0; j < 4; ++j) {
        const int row = row0 + m * 16 + fq * 4 + j;
        const float gt = bf1(PROJ[(size_t)row * NC + 1024 + col]);
        float y = acc[m][n][j] * sc * silu(gt);
        if (ZERO_MASK & 1) y = 0.f;
        Y[(size_t)row * 2048 + col] = (u16)(pk2(y, 0.f) & 0xffffu);
      }
  }
}

DI void phase_mix_even(const Params& p, int l, unsigned char* lds) {
#pragma unroll 1
  for (int it = blockIdx.x; it < 1024; it += gridDim.x) { int bh, qb; heavy_map(it, bh, qb); diff_item(p, l, true, bh, qb, lds); }
#pragma unroll 1
  for (int it = blockIdx.x; it < 512; it += gridDim.x) diff_item(p, l, false, it >> 1, it & 1, lds);
#pragma unroll 1
  for (int it = blockIdx.x; it < 1536; it += gridDim.x) pool_item(p, l, it, lds);
}

DI void na_item(const Params& p, int l, bool sample, int bh, int qb, unsigned char* lds) {
  constexpr int NC = 7168;
  const int tid = TIDX, lane = tid & 63, wid = tid >> 6, r = lane & 31, h = lane >> 5;
  const int b = bh >> 3, hd = bh & 7;
  u16* sQ = reinterpret_cast<u16*>(lds);
  u16* sK = sQ + 128 * 136;
  u16* sVT = sK + 64 * 136;
  float* sBias = reinterpret_cast<float*>(sVT + 128 * 72) + 64;
  const u16* PROJ = reinterpret_cast<const u16*>(p.ws + WS_PROJ);
  const u16* VT = reinterpret_cast<const u16*>(p.ws + WS_VT);
  const int seq0 = sample ? TP + b * 4096 : b * 256;
  const int token = seq0 + qb * 128 + wid * 32 + r;
  AttnSrc s;
  int qr = 0, qc = 0, rsmin = 0;
  f32x16 O[4];
  float lsum;
  const u16* qblk = PROJ + (size_t)(seq0 + qb * 128) * NC + hd * 128;
  if (sample) {
    __syncthreads();
    const float* rpb = p.in[18 + 10 * l] + hd * 465;
    for (int e = tid; e < 465; e += 256) sBias[e] = rpb[e] * LOG2E;
    const int r0 = qb * 2;
    qr = r0 + (wid >> 1); qc = (wid & 1) * 32 + r;
    rsmin = min(max(r0 - 4, 0), 56);
    const int rs1 = min(max(r0 - 3, 0), 56);
    s.k0 = reinterpret_cast<const u16*>(p.ws + WS_CK) + (size_t)l * 2097152 + (size_t)bh * 65536; s.ks0 = 128;
    s.vt0 = reinterpret_cast<const u16*>(p.ws + WS_CVT) + (size_t)l * 2097152 + (size_t)bh * 65536; s.vs0 = 512; s.n0 = 8;
    s.k1 = PROJ + (size_t)(seq0 + rsmin * 64) * NC + 1024 + hd * 128; s.ks1 = NC;
    s.vt1 = VT + 8388608 + (size_t)bh * 128 * 4096 + rsmin * 64; s.vs1 = 4096; s.n1 = rs1 + 8 - rsmin;
    attn_run<128, true>(s, qblk, NC, sQ, sK, sVT, O, lsum, qr, qc, rsmin, sBias);
  } else {
    s.k0 = nullptr; s.vt0 = nullptr; s.ks0 = 0; s.vs0 = 0; s.n0 = 0;
    s.k1 = PROJ + (size_t)seq0 * NC + 1024 + hd * 128; s.ks1 = NC;
    s.vt1 = VT + (size_t)bh * 128 * 256; s.vs1 = 256; s.n1 = 4;
    attn_run<128, false>(s, qblk, NC, sQ, sK, sVT, O, lsum, 0, 0, 0, nullptr);
  }
  const float inv = 1.f / lsum;
  const u16* gp = PROJ + (size_t)token * NC + 3072 + hd * 128;
  u16* yp = reinterpret_cast<u16*>(p.ws + WS_H) + (size_t)token * 2048 + hd * 128;
#pragma unroll
  for (int d = 0; d < 4; ++d)
#pragma unroll
    for (int q = 0; q < 4; ++q) {
      const int dv = d * 32 + 8 * q + 4 * h;
      const u32x2 gw = *reinterpret_cast<const u32x2*>(gp + dv);
      const float y0 = O[d][4 * q] * inv * silu(bflo(gw[0]));
      const float y1 = O[d][4 * q + 1] * inv * silu(bfhi(gw[0]));
      const float y2 = O[d][4 * q + 2] * inv * silu(bflo(gw[1]));
      const float y3 = O[d][4 * q + 3] * inv * silu(bfhi(gw[1]));
      *reinterpret_cast<u32x2*>(yp + dv) = (ZERO_MASK & 4) ? u32x2{0u, 0u} : u32x2{pk2(y0, y1), pk2(y2, y3)};
    }
}

DI void sgu_item(const Params& p, int l, int si, unsigned char* lds) {
  constexpr int NC = 7168;
  const int tid = TIDX, lane = tid & 63, wid = tid >> 6, fr = lane & 15, fq = lane >> 4;
  const int ch = si >> 2, g = si & 3, row0 = ch * 128;
  u16* vnT = reinterpret_cast<u16*>(lds);
  float* sMu = reinterpret_cast<float*>(vnT + 256 * 136);
  float* sRs = sMu + 128;
  const u16* PROJ = reinterpret_cast<const u16*>(p.ws + WS_PROJ);
  __syncthreads();
  {
    const int grp = tid >> 4, ln = tid & 15;
#pragma unroll 1
    for (int rr = 0; rr < 8; ++rr) {
      const u16* src = PROJ + (size_t)(row0 + grp * 8 + rr) * NC + 5120;
      float s = 0.f, ss = 0.f;
#pragma unroll
      for (int c8 = 0; c8 < 8; ++c8) {
        const u32x4 v = *reinterpret_cast<const u32x4*>(src + (ln + 16 * c8) * 8);
#pragma unroll
        for (int k = 0; k < 4; ++k) { const float a = bflo(v[k]), b = bfhi(v[k]); s += a + b; ss += a * a + b * b; }
      }
#pragma unroll
      for (int o = 8; o >= 1; o >>= 1) { s += __shfl_xor(s, o); ss += __shfl_xor(ss, o); }
      const float mu = s * (1.f / 1024.f);
      const float var = fmaxf(ss * (1.f / 1024.f) - mu * mu, 0.f);
      if (ln == 0) { sMu[grp * 8 + rr] = mu; sRs[grp * 8 + rr] = rsqrtf(var + LN_EPS); }
    }
  }
  __syncthreads();
  {
    const int j = tid & 127, hf = tid >> 7;
    const float mu = sMu[j], rs = sRs[j];
    const float* lng = p.in[19 + 10 * l] + g * 256;
    const u16* src = PROJ + (size_t)(row0 + j) * NC + 5120 + g * 256;
#pragma unroll 1
    for (int oc = hf * 16; oc < hf * 16 + 16; ++oc) {
      const u32x4 v = *reinterpret_cast<const u32x4*>(src + oc * 8);
      const float4 g0 = *reinterpret_cast<const float4*>(lng + oc * 8), g1 = *reinterpret_cast<const float4*>(lng + oc * 8 + 4);
      const float gg[8] = {g0.x, g0.y, g0.z, g0.w, g1.x, g1.y, g1.z, g1.w};
#pragma unroll
      for (int k = 0; k < 4; ++k) {
        const float a = (bflo(v[k]) - mu) * rs * gg[2 * k], b = (bfhi(v[k]) - mu) * rs * gg[2 * k + 1];
        const u32 w = pk2(a, b);
        vnT[(oc * 8 + 2 * k) * 136 + j] = (u16)(w & 0xffffu);
        vnT[(oc * 8 + 2 * k + 1) * 136 + j] = (u16)(w >> 16);
      }
    }
  }
  __syncthreads();
  const u16* W = reinterpret_cast<const u16*>(p.ws + WS_SGUW) + (size_t)(l >> 1) * 65536 + (size_t)g * 16384;
  const float* bs = p.in[21 + 10 * l] + g * 128;
  u16* Y = reinterpret_cast<u16*>(p.ws + WS_H);
#pragma unroll 1
  for (int ih = 0; ih < 2; ++ih) {
    f32x4 acc[4][4];
#pragma unroll
    for (int a = 0; a < 4; ++a)
#pragma unroll
      for (int b = 0; b < 4; ++b) acc[a][b] = f32x4{0.f, 0.f, 0.f, 0.f};
#pragma unroll
    for (int ks = 0; ks < 4; ++ks) {
      bf16x8 af[4], bfr[4];
#pragma unroll
      for (int m = 0; m < 4; ++m) af[m] = ld8(W + (size_t)(ih * 64 + m * 16 + fr) * 128 + ks * 32 + fq * 8);
#pragma unroll
      for (int n = 0; n < 4; ++n) bfr[n] = ld8(vnT + (wid * 64 + n * 16 + fr) * 136 + ks * 32 + fq * 8);
#pragma unroll
      for (int m = 0; m < 4; ++m)
#pragma unroll
        for (int n = 0; n < 4; ++n) acc[m][n] = mfma16(af[m], bfr[n], acc[m][n]);
    }
#pragma unroll
    for (int m = 0; m < 4; ++m)
#pragma unroll
      for (int j = 0; j < 4; ++j) {
        const int ii = ih * 64 + m * 16 + fq * 4 + j;
        const float bias = bs[ii];
        const size_t rb = (size_t)(row0 + ii) * NC;
#pragma unroll
        for (int n = 0; n < 4; ++n) {
          const int c = g * 256 + wid * 64 + n * 16 + fr;
          const float u = bf1(PROJ[rb + 4096 + c]), dg = bf1(PROJ[rb + 6144 + c]);
          float y = u * (acc[m][n][j] + bias) * silu(dg);
          if (ZERO_MASK & 8) y = 0.f;
          Y[(size_t)(row0 + ii) * 2048 + 1024 + c] = (u16)(pk2(y, 0.f) & 0xffffu);
        }
      }
  }
}

DI void phase_mix_odd(const Params& p, int l, unsigned char* lds) {
#pragma unroll 1
  for (int it = blockIdx.x; it < 1024; it += gridDim.x) { int bh, qb; heavy_map(it, bh, qb); na_item(p, l, true, bh, qb, lds); }
#pragma unroll 1
  for (int it = blockIdx.x; it < 512; it += gridDim.x) na_item(p, l, false, it >> 1, it & 1, lds);
#pragma unroll 1
  for (int it = blockIdx.x; it < 768; it += gridDim.x) sgu_item(p, l, it, lds);
}

__global__ void __launch_bounds__(256, 2) fwd_megakernel(Params p) {
  extern __shared__ __attribute__((aligned(16))) unsigned char lds[];
  cg::grid_group grid = cg::this_grid();
  for (int ph = p.ph_lo; ph < p.ph_hi; ++ph) {
    if (ph == 0) phase_prep(p, lds);
    else if (ph == 1) phase_mod0(p);
    else {
      const int l = (ph - 2) >> 2, s = (ph - 2) & 3;
      if (s == 0) { for (int rep = 0; rep < REP0; ++rep) { if (l & 1) gemm_phase<G_IN_ODD>(p, l, lds); else gemm_phase<G_IN_EVEN>(p, l, lds); } }
      else if (s == 1) { for (int rep = 0; rep < REP1; ++rep) { if (l & 1) phase_mix_odd(p, l, lds); else phase_mix_even(p, l, lds); } }
      else if (s == 2) gemm_phase<G_OUT>(p, l, lds);
      else phase_ln(p, l);
    }
    if (ph + 1 < p.ph_hi) {
      grid.sync();
    }
  }
}

extern "C" void kernel_launch(void* const* d_in, const int* in_sizes, int n_in, void* d_out, int out_size, void* d_ws, size_t ws_size,
                              hipStream_t stream) {
  static int grid_blocks = 0;
  if (grid_blocks == 0) {
    if (n_in != 52 || ws_size < WS_END) {
      fprintf(stderr, "kernel_launch: expected 52 inputs and >= %zu bytes of workspace; got %d, %zu\n", (size_t)WS_END, n_in, ws_size);
      grid_blocks = -1;
      return;
    }
    int dev = 0, cus = 0, per_cu = 0;
    hipGetDevice(&dev);
    hipDeviceGetAttribute(&cus, hipDeviceAttributeMultiprocessorCount, dev);
    hipFuncSetAttribute((const void*)fwd_megakernel, hipFuncAttributeMaxDynamicSharedMemorySize, LDS_BYTES);
    hipOccupancyMaxActiveBlocksPerMultiprocessor(&per_cu, (const void*)fwd_megakernel, 256, LDS_BYTES);
    if (per_cu < 1) per_cu = 1;
    if (per_cu > 2) per_cu = 2;
    grid_blocks = cus * per_cu;
  }
  if (grid_blocks < 0) return;
  Params p{};
  for (int i = 0; i < 52; ++i) p.in[i] = (const float*)d_in[i];
  p.out = (float*)d_out;
  p.ws = (unsigned char*)d_ws;
#if MULTI
  for (int ph = 0; ph < NPHASE; ++ph) {
    p.ph_lo = ph; p.ph_hi = ph + 1;
    hipLaunchKernelGGL(fwd_megakernel, dim3(grid_blocks), dim3(256), LDS_BYTES, stream, p);
  }
#else
  p.ph_lo = 0; p.ph_hi = NPHASE;
  void* args[] = {&p};
  hipError_t e = hipLaunchCooperativeKernel((const void*)fwd_megakernel, dim3(grid_blocks), dim3(256), args, LDS_BYTES, stream);
  if (e != hipSuccess) fprintf(stderr, "cooperative launch failed: %s (grid %d)\n", hipGetErrorString(e), grid_blocks);
#endif
}
```

```cpp
#include <hip/hip_runtime.h>
#include <hip/hip_cooperative_groups.h>
#include <cstdio>
namespace cg = cooperative_groups;

#define DI __device__ __forceinline__
typedef unsigned short u16;
typedef unsigned int u32;
using bf16x8 = __attribute__((ext_vector_type(8))) short;
using f32x4 = __attribute__((ext_vector_type(4))) float;
using f32x16 = __attribute__((ext_vector_type(16))) float;
using u32x4 = __attribute__((ext_vector_type(4))) unsigned;
using u32x2 = __attribute__((ext_vector_type(2))) unsigned;
typedef __bf16 bf2_t __attribute__((ext_vector_type(2)));
typedef float f2_t __attribute__((ext_vector_type(2)));

#ifndef MULTI
#define MULTI 0
#endif
#ifndef REP0
#define REP0 1
#endif
#ifndef REP1
#define REP1 1
#endif
#ifndef ZERO_MASK
#define ZERO_MASK 0
#endif

constexpr int T_ALL = 24576, TP = 8192, DM = 2048;
constexpr float LOG2E = 1.4426950408889634f;
constexpr float ALPHA = 1.6817928305074290f;
constexpr float LN_EPS = 1e-5f;
constexpr int LDS_BYTES = 76288;
constexpr int NPHASE = 18;

constexpr size_t SZ_WIN_E = (size_t)6144 * 2048 * 2, SZ_WIN_O = (size_t)7168 * 2048 * 2;
constexpr size_t WS_WINT = 0;
constexpr size_t WS_WOUTT = WS_WINT + 2 * SZ_WIN_E + 2 * SZ_WIN_O;
constexpr size_t WS_POOLWT = WS_WOUTT + (size_t)4 * 2048 * 2048 * 2;
constexpr size_t WS_SGUW = WS_POOLWT + (size_t)2 * 4 * 256 * 256 * 2;
constexpr size_t WS_CK = WS_SGUW + (size_t)2 * 4 * 128 * 128 * 2;
constexpr size_t WS_CVT = WS_CK + (size_t)4 * 4194304;
constexpr size_t WS_MOD = WS_CVT + (size_t)4 * 4194304;
constexpr size_t WS_ROPE = WS_MOD + (size_t)4 * 5 * 6144 * 4;
constexpr size_t WS_H = WS_ROPE + 8192;
constexpr size_t WS_PROJ = WS_H + (size_t)T_ALL * 2048 * 2;
constexpr size_t WS_VT = WS_PROJ + (size_t)T_ALL * 7168 * 2;
constexpr size_t WS_END = WS_VT + (size_t)T_ALL * 1024 * 2;

struct Params {
  const float* in[52];
  float* out;
  unsigned char* ws;
  int ph_lo, ph_hi;
};

DI size_t ws_wint(int l) { return WS_WINT + (size_t)(l >> 1) * (SZ_WIN_E + SZ_WIN_O) + ((l & 1) ? SZ_WIN_E : 0); }

DI u32 pk2(float a, float b) { f2_t v = {a, b}; bf2_t r = __builtin_convertvector(v, bf2_t); return __builtin_bit_cast(u32, r); }
DI float bflo(u32 w) { return __uint_as_float(w << 16); }
DI float bfhi(u32 w) { return __uint_as_float(w & 0xffff0000u); }
DI float bf1(u16 w) { return __uint_as_float(((u32)w) << 16); }
DI float ex2(float x) { return __builtin_amdgcn_exp2f(x); }
DI float silu(float x) { return x / (1.f + __expf(-x)); }
DI f32x4 mfma16(bf16x8 a, bf16x8 b, f32x4 c) { return __builtin_amdgcn_mfma_f32_16x16x32_bf16(a, b, c, 0, 0, 0); }
DI f32x16 mfma32(bf16x8 a, bf16x8 b, f32x16 c) { return __builtin_amdgcn_mfma_f32_32x32x16_bf16(a, b, c, 0, 0, 0); }
DI bf16x8 ld8(const u16* p) { return *reinterpret_cast<const bf16x8*>(p); }
DI int opq(int x) { asm volatile("" : "+v"(x)); return x; }
#define TIDX opq((int)threadIdx.x)

DI void tr_tile(const float* __restrict__ src, size_t ld_src, u16* __restrict__ dst, size_t ld_dst, float* sT) {
  const int tid = TIDX;
  const int r = tid >> 4, c4 = (tid & 15) * 4;
#pragma unroll
  for (int i = 0; i < 4; ++i) {
    float4 v = *reinterpret_cast<const float4*>(src + (size_t)(r + 16 * i) * ld_src + c4);
    float* d = sT + (r + 16 * i) * 65 + c4;
    d[0] = v.x; d[1] = v.y; d[2] = v.z; d[3] = v.w;
  }
  __syncthreads();
  const int n = tid >> 2, ks = (tid & 3) * 16;
  u32 w[8];
#pragma unroll
  for (int j = 0; j < 8; ++j) w[j] = pk2(sT[(ks + 2 * j) * 65 + n], sT[(ks + 2 * j + 1) * 65 + n]);
  u32x4* o = reinterpret_cast<u32x4*>(dst + (size_t)n * ld_dst + ks);
  o[0] = u32x4{w[0], w[1], w[2], w[3]};
  o[1] = u32x4{w[4], w[5], w[6], w[7]};
  __syncthreads();
}

DI void cvt8(const float* __restrict__ src, u16* __restrict__ dst) {
  float4 a = *reinterpret_cast<const float4*>(src);
  float4 b = *reinterpret_cast<const float4*>(src + 4);
  *reinterpret_cast<u32x4*>(dst) = u32x4{pk2(a.x, a.y), pk2(a.z, a.w), pk2(b.x, b.y), pk2(b.z, b.w)};
}

DI void mod_item(const Params& p, int i, unsigned char* lds) {
  const int tid = TIDX;
  const int l = i / 96, n0 = (i % 96) * 64;
  float* sS = reinterpret_cast<float*>(lds);
  float* red = sS + 5 * 2048;
  const float* c = p.in[10];
  const float* cctx = p.in[11];
  for (int e = tid; e < 5 * 2048; e += 256) {
    int v = e >> 11, k = e & 2047;
    float x = (v == 0) ? cctx[k] : c[(v - 1) * 2048 + k];
    sS[e] = silu(x);
  }
  __syncthreads();
  const int kk = tid >> 4, c4 = (tid & 15) * 4;
  const float* W = p.in[12 + 10 * l] + n0 + c4;
  f32x4 acc[5];
#pragma unroll
  for (int v = 0; v < 5; ++v) acc[v] = f32x4{0.f, 0.f, 0.f, 0.f};
#pragma unroll 8
  for (int k = kk; k < 2048; k += 16) {
    float4 w = *reinterpret_cast<const float4*>(W + (size_t)k * 6144);
#pragma unroll
    for (int v = 0; v < 5; ++v) {
      float s = sS[v * 2048 + k];
      acc[v][0] += s * w.x; acc[v][1] += s * w.y; acc[v][2] += s * w.z; acc[v][3] += s * w.w;
    }
  }
#pragma unroll
  for (int v = 0; v < 5; ++v)
#pragma unroll
    for (int q = 0; q < 4; ++q) red[(kk * 5 + v) * 64 + c4 + q] = acc[v][q];
  __syncthreads();
  for (int t2 = tid; t2 < 320; t2 += 256) {
    int v = t2 >> 6, n = t2 & 63;
    float s = 0.f;
#pragma unroll
    for (int k2 = 0; k2 < 16; ++k2) s += red[(k2 * 5 + v) * 64 + n];
    float* mod = reinterpret_cast<float*>(p.ws + WS_MOD);
    mod[(size_t)(l * 5 + v) * 6144 + n0 + n] = s + p.in[13 + 10 * l][n0 + n];
  }
  __syncthreads();
}

DI void phase_prep(const Params& p, unsigned char* lds) {
  constexpr int N_MOD = 384, N_TRWIN = 13312, N_TRWOUT = 4096, N_TRPOOL = 128, N_SGU = 64, N_CK = 4096, N_CV = 2048;
  constexpr int TOTAL = N_MOD + N_TRWIN + N_TRWOUT + N_TRPOOL + N_SGU + N_CK + N_CV + 1;
  const int tid = TIDX;
  float* sT = reinterpret_cast<float*>(lds);
  for (int it = blockIdx.x; it < TOTAL; it += gridDim.x) {
    int i = it;
    if (i < N_MOD) { mod_item(p, i, lds); continue; }
    i -= N_MOD;
    if (i < N_TRWIN) {
      int l, base;
      if (i < 3072) { l = 0; base = 0; } else if (i < 6656) { l = 1; base = 3072; } else if (i < 9728) { l = 2; base = 6656; } else { l = 3; base = 9728; }
      i -= base;
      const int N = (l & 1) ? 7168 : 6144, nN = N / 64;
      const int kt = i / nN, nt = i % nN;
      tr_tile(p.in[14 + 10 * l] + (size_t)kt * 64 * N + nt * 64, N,
              reinterpret_cast<u16*>(p.ws + ws_wint(l)) + (size_t)nt * 64 * 2048 + kt * 64, 2048, sT);
      continue;
    }
    i -= N_TRWIN;
    if (i < N_TRWOUT) {
      const int l = i >> 10, r = i & 1023, kt = r >> 5, nt = r & 31;
      tr_tile(p.in[15 + 10 * l] + (size_t)kt * 64 * 2048 + nt * 64, 2048,
              reinterpret_cast<u16*>(p.ws + WS_WOUTT) + (size_t)l * 2048 * 2048 + (size_t)nt * 64 * 2048 + kt * 64, 2048, sT);
      continue;
    }
    i -= N_TRWOUT;
    if (i < N_TRPOOL) {
      const int e = i >> 6, r = i & 63, g = r >> 4, t = r & 15, kt = t >> 2, nt = t & 3;
      tr_tile(p.in[18 + 20 * e] + (size_t)g * 65536 + kt * 64 * 256 + nt * 64, 256,
              reinterpret_cast<u16*>(p.ws + WS_POOLWT) + (size_t)e * 262144 + g * 65536 + nt * 64 * 256 + kt * 64, 256, sT);
      continue;
    }
    i -= N_TRPOOL;
    if (i < N_SGU) {
      const int e = i >> 5, ch = i & 31;
      const size_t off = (size_t)ch * 2048 + tid * 8;
      cvt8(p.in[30 + 20 * e] + off, reinterpret_cast<u16*>(p.ws + WS_SGUW) + (size_t)e * 65536 + off);
      continue;
    }
    i -= N_SGU;
    if (i < N_CK) {
      const int l = i >> 10, ch = i & 1023;
      const size_t off = (size_t)ch * 2048 + tid * 8;
      cvt8(p.in[2 + 2 * l] + off, reinterpret_cast<u16*>(p.ws + WS_CK) + (size_t)l * 2097152 + off);
      continue;
    }
    i -= N_CK;
    if (i < N_CV) {
      const int l = i >> 9, r = i & 511, bh = r >> 4, t = r & 15, kt = t >> 1, nt = t & 1;
      tr_tile(p.in[3 + 2 * l] + (size_t)bh * 65536 + kt * 64 * 128 + nt * 64, 128,
              reinterpret_cast<u16*>(p.ws + WS_CVT) + (size_t)l * 2097152 + (size_t)bh * 65536 + nt * 64 * 512 + kt * 64, 512, sT);
      continue;
    }
    {
      float* rc = reinterpret_cast<float*>(p.ws + WS_ROPE);
      for (int e = tid; e < 1024; e += 256) {
        int pos = e >> 4, fi = e & 15;
        float inv = 1.0f / powf(10000.0f, (float)(2 * fi) / 32.0f);
        float ang = (float)pos * inv;
        rc[e] = cosf(ang);
        rc[1024 + e] = sinf(ang);
      }
    }
  }
}

DI void phase_mod0(const Params& p) {
  const int tid = TIDX;
  const float* mod = reinterpret_cast<const float*>(p.ws + WS_MOD);
  u16* H = reinterpret_cast<u16*>(p.ws + WS_H);
  for (int it = blockIdx.x; it < T_ALL / 4; it += gridDim.x) {
#pragma unroll
    for (int rr = 0; rr < 4; ++rr) {
      const int row = it * 4 + rr;
      const int cond = row < TP ? 0 : 1 + ((row - TP) >> 12);
      const float* src = row < TP ? p.in[0] + (size_t)row * 2048 : p.in[1] + (size_t)(row - TP) * 2048;
      const int e = tid * 8;
      const float* sh = mod + (size_t)cond * 6144 + e;
      float4 a = *reinterpret_cast<const float4*>(src + e), b = *reinterpret_cast<const float4*>(src + e + 4);
      float4 s0 = *reinterpret_cast<const float4*>(sh), s1 = *reinterpret_cast<const float4*>(sh + 4);
      float4 c0 = *reinterpret_cast<const float4*>(sh + 2048), c1 = *reinterpret_cast<const float4*>(sh + 2052);
      u32x4 o = {pk2(a.x * (1.f + c0.x) + s0.x, a.y * (1.f + c0.y) + s0.y), pk2(a.z * (1.f + c0.z) + s0.z, a.w * (1.f + c0.w) + s0.w),
                 pk2(b.x * (1.f + c1.x) + s1.x, b.y * (1.f + c1.y) + s1.y), pk2(b.z * (1.f + c1.z) + s1.z, b.w * (1.f + c1.w) + s1.w)};
      *reinterpret_cast<u32x4*>(H + (size_t)row * 2048 + e) = o;
    }
  }
}

enum { G_IN_EVEN = 0, G_IN_ODD = 1, G_OUT = 2 };

template <bool TR>
DI void gemm_tile(const u16* ga, const u16* gb, u16* sA, u16* sB, int tid, int wr, int wc, int fr, int fo0, int fo1, f32x4 (&acc)[4][4]) {
  constexpr int K = 2048;
#pragma unroll
  for (int a = 0; a < 4; ++a)
#pragma unroll
    for (int b = 0; b < 4; ++b) acc[a][b] = f32x4{0.f, 0.f, 0.f, 0.f};
#define GSTAGE(B_, KT_)                                                                                                   \
  _Pragma("unroll") for (int i = 0; i < 4; ++i) {                                                                         \
    __builtin_amdgcn_global_load_lds((const unsigned*)(ga + (size_t)i * 32 * K + (KT_) * 64),                             \
                                     (unsigned*)(sA + (B_) * 8192 + i * 2048 + tid * 8), 16, 0, 0);                       \
    __builtin_amdgcn_global_load_lds((const unsigned*)(gb + (size_t)i * 32 * K + (KT_) * 64),                             \
                                     (unsigned*)(sB + (B_) * 8192 + i * 2048 + tid * 8), 16, 0, 0);                       \
  }
  GSTAGE(0, 0)
  asm volatile("s_waitcnt vmcnt(0)" ::: "memory");
  __syncthreads();
  for (int kt = 0; kt < K / 64; ++kt) {
    const int buf = kt & 1;
    if (kt + 1 < K / 64) { GSTAGE(buf ^ 1, kt + 1) }
    const u16* cA = sA + buf * 8192 + (wr * 64 + fr) * 64;
    const u16* cB = sB + buf * 8192 + (wc * 64 + fr) * 64;
#pragma unroll
    for (int ks = 0; ks < 2; ++ks) {
      const int fo = ks ? fo1 : fo0;
      bf16x8 af[4], bfr[4];
#pragma unroll
      for (int m = 0; m < 4; ++m) af[m] = ld8(cA + m * 1024 + fo);
#pragma unroll
      for (int n = 0; n < 4; ++n) bfr[n] = ld8(cB + n * 1024 + fo);
#pragma unroll
      for (int m = 0; m < 4; ++m)
#pragma unroll
        for (int n = 0; n < 4; ++n) acc[m][n] = TR ? mfma16(bfr[n], af[m], acc[m][n]) : mfma16(af[m], bfr[n], acc[m][n]);
    }
    asm volatile("s_waitcnt vmcnt(0)" ::: "memory");
    __syncthreads();
  }
#undef GSTAGE
}

template <int MODE>
DI void gemm_phase(const Params& p, int l, unsigned char* lds) {
  constexpr int K = 2048;
  constexpr int N = (MODE == G_OUT) ? 2048 : (MODE == G_IN_EVEN ? 6144 : 7168);
  constexpr int NC = (MODE == G_IN_EVEN) ? 6144 : 7168;
  constexpr int nTn = N / 128;
  constexpr int TOTAL = nTn * 192;
  const u16* A = reinterpret_cast<const u16*>(p.ws + WS_H);
  const u16* Bt = (MODE == G_OUT) ? reinterpret_cast<const u16*>(p.ws + WS_WOUTT) + (size_t)l * 2048 * 2048
                                  : reinterpret_cast<const u16*>(p.ws + ws_wint(l));
  u16* sA = reinterpret_cast<u16*>(lds);
  u16* sB = sA + 2 * 128 * 64;
  const int tid = TIDX, lane = tid & 63, wid = tid >> 6;
  const int wr = wid >> 1, wc = wid & 1, fr = lane & 15, fq = lane >> 4;
  const int lrow = tid >> 3;
  const int csrc = ((tid & 7) ^ ((lrow >> 1) & 7)) * 8;
  const int swz = (fr >> 1) & 7;
  const int fo0 = (fq ^ swz) * 8, fo1 = ((4 + fq) ^ swz) * 8;
  u16* PROJ = reinterpret_cast<u16*>(p.ws + WS_PROJ);
  u16* VT = reinterpret_cast<u16*>(p.ws + WS_VT);
  const float* mod = reinterpret_cast<const float*>(p.ws + WS_MOD);
  const float* ropeC = reinterpret_cast<const float*>(p.ws + WS_ROPE);
  const float* ropeS = ropeC + 1024;

  for (int it = blockIdx.x; it < TOTAL; it += gridDim.x) {
    constexpr int PN = nTn / 8;
    const int rnd = it >> 9, vb = it & 511, q = rnd * 8 + (vb & 7), jj = vb >> 3;
    const int tm = (q / PN) * 8 + (jj & 7), tn = (q % PN) * 8 + (jj >> 3);
    const u16* ga = A + (size_t)(tm * 128 + lrow) * K + csrc;
    const u16* gb = Bt + (size_t)(tn * 128 + lrow) * K + csrc;
    f32x4 acc[4][4];
    const bool prompt = tm < 64;
    const int R0 = tm * 128 + wr * 64, C0 = tn * 128 + wc * 64;
    if (MODE == G_OUT) {
      gemm_tile<true>(ga, gb, sA, sB, tid, wr, wc, fr, fo0, fo1, acc);
      const int cond = prompt ? 0 : 1 + ((tm * 128 - TP) >> 12);
      const float* gate = mod + (size_t)(l * 5 + cond) * 6144 + 4096;
      float* X = p.out;
#pragma unroll
      for (int n = 0; n < 4; ++n) {
        const int col = C0 + n * 16 + 4 * fq;
        const float4 g4 = *reinterpret_cast<const float4*>(gate + col);
#pragma unroll
        for (int m = 0; m < 4; ++m) {
          const int row = R0 + m * 16 + fr;
          float4 xo;
          if (l == 0) xo = prompt ? *reinterpret_cast<const float4*>(p.in[0] + (size_t)row * 2048 + col)
                                  : *reinterpret_cast<const float4*>(p.in[1] + (size_t)(row - TP) * 2048 + col);
          else xo = *reinterpret_cast<const float4*>(X + (size_t)row * 2048 + col);
          float4 o;
          o.x = ALPHA * xo.x + g4.x * acc[m][n][0]; o.y = ALPHA * xo.y + g4.y * acc[m][n][1];
          o.z = ALPHA * xo.z + g4.z * acc[m][n][2]; o.w = ALPHA * xo.w + g4.w * acc[m][n][3];
          *reinterpret_cast<float4*>(X + (size_t)row * 2048 + col) = o;
        }
      }
    } else {
      const int sec = tn >> 3;
      const int SEC_Q = (MODE == G_IN_EVEN) ? 2 : 0, SEC_K = (MODE == G_IN_EVEN) ? 3 : 1, SEC_V = (MODE == G_IN_EVEN) ? 4 : 2;
      if (sec == SEC_V) {
        gemm_tile<false>(ga, gb, sA, sB, tid, wr, wc, fr, fo0, fo1, acc);
        const int rowb = R0 + fq * 4;
        const int hh = tn & 7;
        float* vout = p.out + (size_t)T_ALL * 2048 + (size_t)(2 * l + 1) * 8388608;
#pragma unroll
        for (int m = 0; m < 4; ++m) {
          const int row = rowb + m * 16;
#pragma unroll
          for (int n = 0; n < 4; ++n) {
            const int dv = wc * 64 + n * 16 + fr;
            u32x2 w = {pk2(acc[m][n][0], acc[m][n][1]), pk2(acc[m][n][2], acc[m][n][3])};
            if (prompt) {
              const int b = row >> 8, t = row & 255;
              *reinterpret_cast<u32x2*>(VT + ((size_t)((b * 8 + hh) * 128 + dv)) * 256 + t) = w;
#pragma unroll
              for (int j = 0; j < 4; ++j) vout[((size_t)((b * 8 + hh) * 256 + t + j)) * 128 + dv] = acc[m][n][j];
            } else {
              const int rs = row - TP, b = rs >> 12, t = rs & 4095;
              *reinterpret_cast<u32x2*>(VT + 8388608 + ((size_t)((b * 8 + hh) * 128 + dv)) * 4096 + t) = w;
            }
          }
        }
      } else {
        gemm_tile<true>(ga, gb, sA, sB, tid, wr, wc, fr, fo0, fo1, acc);
        const bool isq = sec == SEC_Q, isk = sec == SEC_K;
        const bool rope = (MODE == G_IN_EVEN) && (isq || isk) && !prompt;
        const float qs = (MODE == G_IN_EVEN) ? 0.125f * LOG2E : 0.08838834764831845f * LOG2E;
        if (isk && prompt) {
          const int hh = tn & 7;
          float* kout = p.out + (size_t)T_ALL * 2048 + (size_t)(2 * l) * 8388608;
#pragma unroll
          for (int m = 0; m < 4; ++m) {
            const int row = R0 + m * 16 + fr, b = row >> 8, t = row & 255;
#pragma unroll
            for (int n = 0; n < 4; ++n) {
              const int d = wc * 64 + n * 16 + 4 * fq;
              *reinterpret_cast<float4*>(kout + ((size_t)((b * 8 + hh) * 256 + t)) * 128 + d) =
                  float4{acc[m][n][0], acc[m][n][1], acc[m][n][2], acc[m][n][3]};
            }
          }
        }
        if (rope) {
#pragma unroll
          for (int m = 0; m < 4; ++m) {
            const int t = (R0 + m * 16 + fr - TP) & 4095;
#pragma unroll
            for (int ax = 0; ax < 2; ++ax) {
              const int pos = ax ? (t & 63) : (t >> 6);
              const float4 cs = *reinterpret_cast<const float4*>(ropeC + pos * 16 + 4 * fq);
              const float4 sn = *reinterpret_cast<const float4*>(ropeS + pos * 16 + 4 * fq);
              const float c4[4] = {cs.x, cs.y, cs.z, cs.w}, s4[4] = {sn.x, sn.y, sn.z, sn.w};
#pragma unroll
              for (int j = 0; j < 4; ++j) {
                const float x1 = acc[m][2 * ax][j], x2 = acc[m][2 * ax + 1][j];
                acc[m][2 * ax][j] = x1 * c4[j] - x2 * s4[j];
                acc[m][2 * ax + 1][j] = x1 * s4[j] + x2 * c4[j];
              }
            }
          }
        }
        const float sc = isq ? qs : 1.0f;
#pragma unroll
        for (int m = 0; m < 4; ++m) {
          const int row = R0 + m * 16 + fr;
#pragma unroll
          for (int n = 0; n < 4; ++n) {
            const int col = C0 + n * 16 + 4 * fq;
            *reinterpret_cast<u32x2*>(PROJ + (size_t)row * NC + col) =
                u32x2{pk2(acc[m][n][0] * sc, acc[m][n][1] * sc), pk2(acc[m][n][2] * sc, acc[m][n][3] * sc)};
          }
        }
      }
    }
  }
}

DI void phase_ln(const Params& p, int l) {
  const int tid_ = TIDX, lane = tid_ & 63, wid = tid_ >> 6;
  const float* g = p.in[16 + 10 * l];
  const float* bb = p.in[17 + 10 * l];
  const float* mod = reinterpret_cast<const float*>(p.ws + WS_MOD);
  u16* H = reinterpret_cast<u16*>(p.ws + WS_H);
  float* X = p.out;
  for (int it = blockIdx.x; it < T_ALL / 4; it += gridDim.x) {
    const int row = it * 4 + wid;
    float* xr = X + (size_t)row * 2048;
    float4 v[8];
    float s = 0.f;
#pragma unroll
    for (int i = 0; i < 8; ++i) {
      v[i] = *reinterpret_cast<const float4*>(xr + (i * 64 + lane) * 4);
      s += v[i].x + v[i].y + v[i].z + v[i].w;
    }
#pragma unroll
    for (int o = 32; o >= 1; o >>= 1) s += __shfl_xor(s, o);
    const float mu = s * (1.f / 2048.f);
    float ss = 0.f;
#pragma unroll
    for (int i = 0; i < 8; ++i) {
      float a = v[i].x - mu, b = v[i].y - mu, c = v[i].z - mu, d = v[i].w - mu;
      ss += a * a + b * b + c * c + d * d;
    }
#pragma unroll
    for (int o = 32; o >= 1; o >>= 1) ss += __shfl_xor(ss, o);
    const float rstd = rsqrtf(ss * (1.f / 2048.f) + LN_EPS);
    const int cond = row < TP ? 0 : 1 + ((row - TP) >> 12);
    const float* sh = mod + (size_t)((l + 1) * 5 + cond) * 6144;
#pragma unroll
    for (int i = 0; i < 8; ++i) {
      const int e = (i * 64 + lane) * 4;
      float4 gg = *reinterpret_cast<const float4*>(g + e), b4 = *reinterpret_cast<const float4*>(bb + e);
      float4 y;
      y.x = (v[i].x - mu) * rstd * gg.x + b4.x; y.y = (v[i].y - mu) * rstd * gg.y + b4.y;
      y.z = (v[i].z - mu) * rstd * gg.z + b4.z; y.w = (v[i].w - mu) * rstd * gg.w + b4.w;
      *reinterpret_cast<float4*>(xr + e) = y;
      if (l < 3) {
        float4 s0 = *reinterpret_cast<const float4*>(sh + e), c0 = *reinterpret_cast<const float4*>(sh + 2048 + e);
        u32x2 o = {pk2(y.x * (1.f + c0.x) + s0.x, y.y * (1.f + c0.y) + s0.y), pk2(y.z * (1.f + c0.z) + s0.z, y.w * (1.f + c0.w) + s0.w)};
        *reinterpret_cast<u32x2*>(H + (size_t)row * 2048 + e) = o;
      }
    }
  }
}

struct AttnSrc {
  const u16* k0; const u16* vt0; int ks0, vs0, n0;
  const u16* k1; const u16* vt1; int ks1, vs1, n1;
};

template <int DQK>
DI void attn_ldg(const AttnSrc& s, int j, u32x4 (&rk)[DQK / 32], u32x4 (&rv)[4]) {
  const u16* kb; const u16* vb; int ks, vs;
  if (j < s.n0) { kb = s.k0 + (size_t)j * 64 * s.ks0; vb = s.vt0 + j * 64; ks = s.ks0; vs = s.vs0; }
  else { const int jj = j - s.n0; kb = s.k1 + (size_t)jj * 64 * s.ks1; vb = s.vt1 + jj * 64; ks = s.ks1; vs = s.vs1; }
  constexpr int CPR = DQK / 8;
  const int tid = TIDX;
#pragma unroll
  for (int i = 0; i < DQK / 32; ++i) {
    const int c = tid + 256 * i, row = c / CPR, kc = c % CPR;
    rk[i] = *reinterpret_cast<const u32x4*>(kb + (size_t)row * ks + kc * 8);
  }
#pragma unroll
  for (int i = 0; i < 4; ++i) {
    const int c = tid + 256 * i, row = c >> 3, kc = c & 7;
    rv[i] = *reinterpret_cast<const u32x4*>(vb + (size_t)row * vs + kc * 8);
  }
}
template <int DQK>
DI void attn_sts(u16* sK, u16* sVT, const u32x4 (&rk)[DQK / 32], const u32x4 (&rv)[4]) {
  constexpr int CPR = DQK / 8;
  const int tid = TIDX;
#pragma unroll
  for (int i = 0; i < DQK / 32; ++i) {
    const int c = tid + 256 * i, row = c / CPR, kc = c % CPR;
    *reinterpret_cast<u32x4*>(sK + row * (DQK + 8) + kc * 8) = rk[i];
  }
#pragma unroll
  for (int i = 0; i < 4; ++i) {
    const int c = tid + 256 * i, row = c >> 3, kc = c & 7;
    *reinterpret_cast<u32x4*>(sVT + row * 72 + kc * 8) = rv[i];
  }
}

template <int DQK, bool NA>
DI void attn_run(const AttnSrc& src, const u16* qblk, int qstride, u16* sQ, u16* sK, u16* sVT, f32x16 (&O)[4], float& l_out,
                 int qr, int qc, int rsmin, const float* sBias) {
  const int tid = TIDX, lane = tid & 63, wid = tid >> 6;
  const int r = lane & 31, h = lane >> 5;
  const int pr = (r & 0x13) | ((r & 4) << 1) | ((r & 8) >> 1);
  constexpr int CPR = DQK / 8, QS = DQK + 8;
  __syncthreads();
#pragma unroll
  for (int i = 0; i < DQK / 16; ++i) {
    const int c = tid + 256 * i, row = c / CPR, kc = c % CPR;
    *reinterpret_cast<u32x4*>(sQ + row * QS + kc * 8) = *reinterpret_cast<const u32x4*>(qblk + (size_t)row * qstride + kc * 8);
  }
#pragma unroll
  for (int d = 0; d < 4; ++d)
#pragma unroll
    for (int i = 0; i < 16; ++i) O[d][i] = 0.f;
  float m = -1e30f, l = 0.f;
  const int nt = src.n0 + src.n1;
  const int rsq = min(max(qr - 4, 0), 56);
  const int cs = min(max(qc - 8, 0), 48);
  const u16* qw = sQ + (wid * 32 + r) * QS + 8 * h;
  const u16* kw = sK + pr * QS + 8 * h;
  const u16* vw = sVT + r * 72 + 8 * h;
  u32x4 rk[DQK / 32], rv[4];
  attn_ldg<DQK>(src, 0, rk, rv);
#pragma unroll 1
  for (int j = 0; j < nt; ++j) {
    if (j > 0) __syncthreads();
    attn_sts<DQK>(sK, sVT, rk, rv);
    __syncthreads();
    if (j + 1 < nt) attn_ldg<DQK>(src, j + 1, rk, rv);
    __builtin_amdgcn_sched_barrier(0);
    bool active = true;
    int kr = 0;
    if (NA && j >= src.n0) { kr = rsmin + (j - src.n0); active = (kr >= rsq) && (kr < rsq + 8); }
    if (active) {
      f32x16 s[2];
      __builtin_amdgcn_s_setprio(1);
#pragma unroll
      for (int t = 0; t < 2; ++t) {
#pragma unroll
        for (int i = 0; i < 16; ++i) s[t][i] = 0.f;
#pragma unroll
        for (int ks = 0; ks < DQK / 16; ++ks) {
          bf16x8 a = ld8(kw + t * 32 * QS + ks * 16);
          bf16x8 q = ld8(qw + ks * 16);
          s[t] = mfma32(a, q, s[t]);
        }
      }
      __builtin_amdgcn_s_setprio(0);
      if (NA && j >= src.n0) {
        const float* bp = sBias + (kr - qr + 7) * 31 + (8 * h - qc + 15);
        const int kb = 8 * h - cs;
#pragma unroll
        for (int t = 0; t < 2; ++t)
#pragma unroll
          for (int i = 0; i < 16; ++i) {
            const int ko = t * 32 + 16 * (i >> 3) + (i & 7);
            const bool ok = (unsigned)(ko + kb) < 16u;
            const float bv = bp[ko];
            s[t][i] = ok ? s[t][i] + bv : -1e30f;
          }
      }
      float mx = -1e30f;
#pragma unroll
      for (int t = 0; t < 2; ++t)
#pragma unroll
        for (int i = 0; i < 16; ++i) mx = fmaxf(mx, s[t][i]);
      mx = fmaxf(mx, __shfl_xor(mx, 32));
      if (__builtin_amdgcn_ballot_w64(mx > m + 8.0f) != 0ull) {
        const float mn = fmaxf(m, mx);
        const float alpha = ex2(m - mn);
        l *= alpha;
        m = mn;
#pragma unroll
        for (int d = 0; d < 4; ++d)
#pragma unroll
          for (int i = 0; i < 16; ++i) O[d][i] *= alpha;
      }
      float rsum = 0.f;
#pragma unroll
      for (int t = 0; t < 2; ++t)
#pragma unroll
        for (int i = 0; i < 16; ++i) { const float e = ex2(s[t][i] - m); s[t][i] = e; rsum += e; }
      rsum += __shfl_xor(rsum, 32);
      l += rsum;
      __builtin_amdgcn_s_setprio(1);
#pragma unroll
      for (int s4 = 0; s4 < 4; ++s4) {
        const int t = s4 >> 1, b0 = (s4 & 1) * 8;
        u32x4 w = {pk2(s[t][b0], s[t][b0 + 1]), pk2(s[t][b0 + 2], s[t][b0 + 3]), pk2(s[t][b0 + 4], s[t][b0 + 5]), pk2(s[t][b0 + 6], s[t][b0 + 7])};
        const bf16x8 pf = __builtin_bit_cast(bf16x8, w);
#pragma unroll
        for (int d = 0; d < 4; ++d) {
          bf16x8 a = ld8(vw + d * 32 * 72 + s4 * 16);
          O[d] = mfma32(a, pf, O[d]);
        }
      }
      __builtin_amdgcn_s_setprio(0);
    }
  }
  l_out = l;
}

DI void heavy_map(int it, int& bh, int& qb) { const int x = it & 7, idx = it >> 3; bh = x + 8 * (idx >> 5); qb = idx & 31; }

DI void diff_item(const Params& p, int l, bool sample, int bh, int qb, unsigned char* lds) {
  constexpr int NC = 6144;
  const int tid_ = TIDX, lane = tid_ & 63, wid = tid_ >> 6, r = lane & 31, h = lane >> 5;
  const int b = bh >> 3, hd = bh & 7;
  u16* sQ = reinterpret_cast<u16*>(lds);
  u16* sK = sQ + 128 * 136;
  u16* sVT = sK + 64 * 136;
  const u16* PROJ = reinterpret_cast<const u16*>(p.ws + WS_PROJ);
  const u16* VT = reinterpret_cast<const u16*>(p.ws + WS_VT);
  const int seq0 = sample ? TP + b * 4096 : b * 256;
  const int token = seq0 + qb * 128 + wid * 32 + r;
  const float* dl = p.in[20 + 10 * l];
  float pa = dl[lane] * dl[64 + lane], pb = dl[128 + lane] * dl[192 + lane];
#pragma unroll
  for (int o = 32; o >= 1; o >>= 1) { pa += __shfl_xor(pa, o); pb += __shfl_xor(pb, o); }
  const float lam_init = 0.8f - 0.6f * __expf(-0.3f * (float)l);
  const float lam = __expf(pa) - __expf(pb) + lam_init;

  u32 o1p[32];
  f32x16 O[4];
  float lsum;
#pragma unroll
  for (int comp = 0; comp < 2; ++comp) {
    AttnSrc s;
    if (sample) {
      s.k0 = reinterpret_cast<const u16*>(p.ws + WS_CK) + (size_t)l * 2097152 + (size_t)bh * 65536 + comp * 64; s.ks0 = 128;
      s.vt0 = reinterpret_cast<const u16*>(p.ws + WS_CVT) + (size_t)l * 2097152 + (size_t)bh * 65536; s.vs0 = 512; s.n0 = 8;
      s.k1 = PROJ + (size_t)seq0 * NC + 3072 + hd * 128 + comp * 64; s.ks1 = NC;
      s.vt1 = VT + 8388608 + (size_t)bh * 128 * 4096; s.vs1 = 4096; s.n1 = 64;
    } else {
      s.k0 = nullptr; s.vt0 = nullptr; s.ks0 = 0; s.vs0 = 0; s.n0 = 0;
      s.k1 = PROJ + (size_t)seq0 * NC + 3072 + hd * 128 + comp * 64; s.ks1 = NC;
      s.vt1 = VT + (size_t)bh * 128 * 256; s.vs1 = 256; s.n1 = 4;
    }
    const u16* qblk = PROJ + (size_t)(seq0 + qb * 128) * NC + 2048 + hd * 128 + comp * 64;
    attn_run<64, false>(s, qblk, NC, sQ, sK, sVT, O, lsum, 0, 0, 0, nullptr);
    const float inv = 1.f / lsum;
    if (comp == 0) {
#pragma unroll
      for (int d = 0; d < 4; ++d)
#pragma unroll
        for (int i = 0; i < 8; ++i) o1p[d * 8 + i] = pk2(O[d][2 * i] * inv, O[d][2 * i + 1] * inv);
    } else {
      float ssq = 0.f;
#pragma unroll
      for (int d = 0; d < 4; ++d)
#pragma unroll
        for (int i = 0; i < 8; ++i) {
          const u32 w = o1p[d * 8 + i];
          const float a = bflo(w) - lam * O[d][2 * i] * inv, c = bfhi(w) - lam * O[d][2 * i + 1] * inv;
          O[d][2 * i] = a; O[d][2 * i + 1] = c;
          ssq += a * a + c * c;
        }
      ssq += __shfl_xor(ssq, 32);
      const float rn = rsqrtf(ssq * (1.f / 128.f) + LN_EPS) * (1.f - lam_init);
      const float* subln = p.in[21 + 10 * l];
      const u16* gp = PROJ + (size_t)token * NC + 5120 + hd * 128;
      u16* yp = reinterpret_cast<u16*>(p.ws + WS_H) + (size_t)token * 2048 + 1024 + hd * 128;
#pragma unroll
      for (int d = 0; d < 4; ++d)
#pragma unroll
        for (int q = 0; q < 4; ++q) {
          const int dv = d * 32 + 8 * q + 4 * h;
          const u32x2 gw = *reinterpret_cast<const u32x2*>(gp + dv);
          const float4 sl = *reinterpret_cast<const float4*>(subln + dv);
          const float y0 = O[d][4 * q] * rn * sl.x * silu(bflo(gw[0]));
          const float y1 = O[d][4 * q + 1] * rn * sl.y * silu(bfhi(gw[0]));
          const float y2 = O[d][4 * q + 2] * rn * sl.z * silu(bflo(gw[1]));
          const float y3 = O[d][4 * q + 3] * rn * sl.w * silu(bfhi(gw[1]));
          *reinterpret_cast<u32x2*>(yp + dv) = (ZERO_MASK & 2) ? u32x2{0u, 0u} : u32x2{pk2(y0, y1), pk2(y2, y3)};
        }
    }
  }
}

DI void pool_item(const Params& p, int l, int pi, unsigned char* lds) {
  constexpr int NC = 6144;
  const int tid = TIDX, lane = tid & 63, wid = tid >> 6, fr = lane & 15, fq = lane >> 4;
  const int tb = pi >> 2, g = pi & 3, row0 = tb * 64;
  const int L = row0 < TP ? 256 : 4096;
  const int t0 = row0 < TP ? (row0 & 255) : ((row0 - TP) & 4095);
  u16* sIn = reinterpret_cast<u16*>(lds);
  u16* sP = sIn + 80 * 264;
  const u16* PROJ = reinterpret_cast<const u16*>(p.ws + WS_PROJ);
  __syncthreads();
#pragma unroll
  for (int i = 0; i < 10; ++i) {
    const int c = tid + 256 * i, rr = c >> 5, oc = c & 31;
    const int t = t0 - 8 + rr;
    u32x4 v = {0u, 0u, 0u, 0u};
    if (t >= 0 && t < L) v = *reinterpret_cast<const u32x4*>(PROJ + (size_t)(row0 - 8 + rr) * NC + g * 256 + oc * 8);
    *reinterpret_cast<u32x4*>(sIn + rr * 264 + oc * 8) = v;
  }
  __syncthreads();
  {
    const int oc = tid & 31, seg = tid >> 5;
    const int half = 1 << g;
#pragma unroll 1
    for (int tt = 0; tt < 8; ++tt) {
      const int tl = seg * 8 + tt, t = t0 + tl;
      const int lo = max(t - half, 0), hi = min(t + half, L);
      float a[8];
#pragma unroll
      for (int k = 0; k < 8; ++k) a[k] = 0.f;
      for (int s = lo; s < hi; ++s) {
        const u32x4 v = *reinterpret_cast<const u32x4*>(sIn + (s - t0 + 8) * 264 + oc * 8);
#pragma unroll
        for (int k = 0; k < 4; ++k) { a[2 * k] += bflo(v[k]); a[2 * k + 1] += bfhi(v[k]); }
      }
      const float ic = 1.f / (float)(hi - lo);
      const u32x4 x = *reinterpret_cast<const u32x4*>(sIn + (tl + 8) * 264 + oc * 8);
      u32x4 o;
#pragma unroll
      for (int k = 0; k < 4; ++k) o[k] = pk2(a[2 * k] * ic - bflo(x[k]), a[2 * k + 1] * ic - bfhi(x[k]));
      *reinterpret_cast<u32x4*>(sP + tl * 264 + oc * 8) = o;
    }
  }
  __syncthreads();
  const u16* W = reinterpret_cast<const u16*>(p.ws + WS_POOLWT) + (size_t)(l >> 1) * 262144 + (size_t)g * 65536;
  f32x4 acc[4][4];
#pragma unroll
  for (int a = 0; a < 4; ++a)
#pragma unroll
    for (int b = 0; b < 4; ++b) acc[a][b] = f32x4{0.f, 0.f, 0.f, 0.f};
#pragma unroll 2
  for (int ks = 0; ks < 8; ++ks) {
    bf16x8 af[4], bfr[4];
#pragma unroll
    for (int m = 0; m < 4; ++m) af[m] = ld8(sP + (m * 16 + fr) * 264 + ks * 32 + fq * 8);
#pragma unroll
    for (int n = 0; n < 4; ++n) bfr[n] = ld8(W + (size_t)(wid * 64 + n * 16 + fr) * 256 + ks * 32 + fq * 8);
#pragma unroll
    for (int m = 0; m < 4; ++m)
#pragma unroll
      for (int n = 0; n < 4; ++n) acc[m][n] = mfma16(bfr[n], af[m], acc[m][n]);
  }
  const float* pscale = p.in[19 + 10 * l];
  u16* Y = reinterpret_cast<u16*>(p.ws + WS_H);
#pragma unroll
  for (int n = 0; n < 4; ++n) {
    const int col = g * 256 + wid * 64 + n * 16 + 4 * fq;
    const float4 sc = *reinterpret_cast<const float4*>(pscale + col);
#pragma unroll
    for (int m = 0; m < 4; ++m) {
      const int row = row0 + m * 16 + fr;
      const u32x2 gw = *reinterpret_cast<const u32x2*>(PROJ + (size_t)row * NC + 1024 + col);
      float y0 = acc[m][n][0] * sc.x * silu(bflo(gw[0])), y1 = acc[m][n][1] * sc.y * silu(bfhi(gw[0]));
      float y2 = acc[m][n][2] * sc.z * silu(bflo(gw[1])), y3 = acc[m][n][3] * sc.w * silu(bfhi(gw[1]));
      if (ZERO_MASK & 1) { y0 = y1 = y2 = y3 = 0.f; }
      *reinterpret_cast<u32x2*>(Y + (size_t)row * 2048 + col) = u32x2{pk2(y0, y1), pk2(y2, y3)};
    }
  }
}

DI void phase_mix_even(const Params& p, int l, unsigned char* lds) {
#pragma unroll 1
  for (int it = blockIdx.x; it < 1024; it += gridDim.x) { int bh, qb; heavy_map(it, bh, qb); diff_item(p, l, true, bh, qb, lds); }
#pragma unroll 1
  for (int it = blockIdx.x; it < 512; it += gridDim.x) diff_item(p, l, false, it >> 1, it & 1, lds);
#pragma unroll 1
  for (int it = blockIdx.x; it < 1536; it += gridDim.x) pool_item(p, l, it, lds);
}

DI void na_item(const Params& p, int l, bool sample, int bh, int qb, unsigned char* lds) {
  constexpr int NC = 7168;
  const int tid = TIDX, lane = tid & 63, wid = tid >> 6, r = lane & 31, h = lane >> 5;
  const int b = bh >> 3, hd = bh & 7;
  u16* sQ = reinterpret_cast<u16*>(lds);
  u16* sK = sQ + 128 * 136;
  u16* sVT = sK + 64 * 136;
  float* sBias = reinterpret_cast<float*>(sVT + 128 * 72) + 64;
  const u16* PROJ = reinterpret_cast<const u16*>(p.ws + WS_PROJ);
  const u16* VT = reinterpret_cast<const u16*>(p.ws + WS_VT);
  const int seq0 = sample ? TP + b * 4096 : b * 256;
  const int token = seq0 + qb * 128 + wid * 32 + r;
  AttnSrc s;
  int qr = 0, qc = 0, rsmin = 0;
  f32x16 O[4];
  float lsum;
  const u16* qblk = PROJ + (size_t)(seq0 + qb * 128) * NC + hd * 128;
  if (sample) {
    __syncthreads();
    const float* rpb = p.in[18 + 10 * l] + hd * 465;
    for (int e = tid; e < 465; e += 256) sBias[e] = rpb[e] * LOG2E;
    const int r0 = qb * 2;
    qr = r0 + (wid >> 1); qc = (wid & 1) * 32 + r;
    rsmin = min(max(r0 - 4, 0), 56);
    const int rs1 = min(max(r0 - 3, 0), 56);
    s.k0 = reinterpret_cast<const u16*>(p.ws + WS_CK) + (size_t)l * 2097152 + (size_t)bh * 65536; s.ks0 = 128;
    s.vt0 = reinterpret_cast<const u16*>(p.ws + WS_CVT) + (size_t)l * 2097152 + (size_t)bh * 65536; s.vs0 = 512; s.n0 = 8;
    s.k1 = PROJ + (size_t)(seq0 + rsmin * 64) * NC + 1024 + hd * 128; s.ks1 = NC;
    s.vt1 = VT + 8388608 + (size_t)bh * 128 * 4096 + rsmin * 64; s.vs1 = 4096; s.n1 = rs1 + 8 - rsmin;
    attn_run<128, true>(s, qblk, NC, sQ, sK, sVT, O, lsum, qr, qc, rsmin, sBias);
  } else {
    s.k0 = nullptr; s.vt0 = nullptr; s.ks0 = 0; s.vs0 = 0; s.n0 = 0;
    s.k1 = PROJ + (size_t)seq0 * NC + 1024 + hd * 128; s.ks1 = NC;
    s.vt1 = VT + (size_t)bh * 128 * 256; s.vs1 = 256; s.n1 = 4;
    attn_run<128, false>(s, qblk, NC, sQ, sK, sVT, O, lsum, 0, 0, 0, nullptr);
  }
  const float inv = 1.f / lsum;
  const u16* gp = PROJ + (size_t)token * NC + 3072 + hd * 128;
  u16* yp = reinterpret_cast<u16*>(p.ws + WS_H) + (size_t)token * 2048 + hd * 128;
#pragma unroll
  for (int d = 0; d < 4; ++d)
#pragma unroll
    for (int q = 0; q < 4; ++q) {
      const int dv = d * 32 + 8 * q + 4 * h;
      const u32x2 gw = *reinterpret_cast<const u32x2*>(gp + dv);
      const float y0 = O[d][4 * q] * inv * silu(bflo(gw[0]));
      const float y1 = O[d][4 * q + 1] * inv * silu(bfhi(gw[0]));
      const float y2 = O[d][4 * q + 2] * inv * silu(bflo(gw[1]));
      const float y3 = O[d][4 * q + 3] * inv * silu(bfhi(gw[1]));
      *reinterpret_cast<u32x2*>(yp + dv) = (ZERO_MASK & 4) ? u32x2{0u, 0u} : u32x2{pk2(y0, y1), pk2(y2, y3)};
    }
}

DI void sgu_item(const Params& p, int l, int si, unsigned char* lds) {
  constexpr int NC = 7168;
  const int tid = TIDX, lane = tid & 63, wid = tid >> 6, fr = lane & 15, fq = lane >> 4;
  const int ch = si >> 2, g = si & 3, row0 = ch * 128;
  u16* vnT = reinterpret_cast<u16*>(lds);
  float* sMu = reinterpret_cast<float*>(vnT + 256 * 136);
  float* sRs = sMu + 128;
  const u16* PROJ = reinterpret_cast<const u16*>(p.ws + WS_PROJ);
  __syncthreads();
  {
    const int grp = tid >> 4, ln = tid & 15;
#pragma unroll 1
    for (int rr = 0; rr < 8; ++rr) {
      const u16* src = PROJ + (size_t)(row0 + grp * 8 + rr) * NC + 5120;
      float s = 0.f, ss = 0.f;
#pragma unroll
      for (int c8 = 0; c8 < 8; ++c8) {
        const u32x4 v = *reinterpret_cast<const u32x4*>(src + (ln + 16 * c8) * 8);
#pragma unroll
        for (int k = 0; k < 4; ++k) { const float a = bflo(v[k]), b = bfhi(v[k]); s += a + b; ss += a * a + b * b; }
      }
#pragma unroll
      for (int o = 8; o >= 1; o >>= 1) { s += __shfl_xor(s, o); ss += __shfl_xor(ss, o); }
      const float mu = s * (1.f / 1024.f);
      const float var = fmaxf(ss * (1.f / 1024.f) - mu * mu, 0.f);
      if (ln == 0) { sMu[grp * 8 + rr] = mu; sRs[grp * 8 + rr] = rsqrtf(var + LN_EPS); }
    }
  }
  __syncthreads();
  {
    const int j = tid & 127, hf = tid >> 7;
    const float mu = sMu[j], rs = sRs[j];
    const float* lng = p.in[19 + 10 * l] + g * 256;
    const u16* src = PROJ + (size_t)(row0 + j) * NC + 5120 + g * 256;
#pragma unroll 1
    for (int oc = hf * 16; oc < hf * 16 + 16; ++oc) {
      const u32x4 v = *reinterpret_cast<const u32x4*>(src + oc * 8);
      const float4 g0 = *reinterpret_cast<const float4*>(lng + oc * 8), g1 = *reinterpret_cast<const float4*>(lng + oc * 8 + 4);
      const float gg[8] = {g0.x, g0.y, g0.z, g0.w, g1.x, g1.y, g1.z, g1.w};
#pragma unroll
      for (int k = 0; k < 4; ++k) {
        const float a = (bflo(v[k]) - mu) * rs * gg[2 * k], b = (bfhi(v[k]) - mu) * rs * gg[2 * k + 1];
        const u32 w = pk2(a, b);
        vnT[(oc * 8 + 2 * k) * 136 + j] = (u16)(w & 0xffffu);
        vnT[(oc * 8 + 2 * k + 1) * 136 + j] = (u16)(w >> 16);
      }
    }
  }
  __syncthreads();
  const u16* W = reinterpret_cast<const u16*>(p.ws + WS_SGUW) + (size_t)(l >> 1) * 65536 + (size_t)g * 16384;
  const float* bs = p.in[21 + 10 * l] + g * 128;
  u16* Y = reinterpret_cast<u16*>(p.ws + WS_H);
#pragma unroll 1
  for (int ih = 0; ih < 2; ++ih) {
    f32x4 acc[4][4];
#pragma unroll
    for (int a = 0; a < 4; ++a)
#pragma unroll
      for (int b = 0; b < 4; ++b) acc[a][b] = f32x4{0.f, 0.f, 0.f, 0.f};
#pragma unroll
    for (int ks = 0; ks < 4; ++ks) {
      bf16x8 af[4], bfr[4];
#pragma unroll
      for (int m = 0; m < 4; ++m) af[m] = ld8(W + (size_t)(ih * 64 + m * 16 + fr) * 128 + ks * 32 + fq * 8);
#pragma unroll
      for (int n = 0; n < 4; ++n) bfr[n] = ld8(vnT + (wid * 64 + n * 16 + fr) * 136 + ks * 32 + fq * 8);
#pragma unroll
      for (int m = 0; m < 4; ++m)
#pragma unroll
        for (int n = 0; n < 4; ++n) acc[m][n] = mfma16(bfr[n], af[m], acc[m][n]);
    }
#pragma unroll
    for (int m = 0; m < 4; ++m) {
      const int ii = ih * 64 + m * 16 + fr;
      const float bias = bs[ii];
      const size_t rb = (size_t)(row0 + ii) * NC;
#pragma unroll
      for (int n = 0; n < 4; ++n) {
        const int c = g * 256 + wid * 64 + n * 16 + 4 * fq;
        const u32x2 uw = *reinterpret_cast<const u32x2*>(PROJ + rb + 4096 + c);
        const u32x2 dw = *reinterpret_cast<const u32x2*>(PROJ + rb + 6144 + c);
        float y0 = bflo(uw[0]) * (acc[m][n][0] + bias) * silu(bflo(dw[0])), y1 = bfhi(uw[0]) * (acc[m][n][1] + bias) * silu(bfhi(dw[0]));
        float y2 = bflo(uw[1]) * (acc[m][n][2] + bias) * silu(bflo(dw[1])), y3 = bfhi(uw[1]) * (acc[m][n][3] + bias) * silu(bfhi(dw[1]));
        if (ZERO_MASK & 8) { y0 = y1 = y2 = y3 = 0.f; }
        *reinterpret_cast<u32x2*>(Y + (size_t)(row0 + ii) * 2048 + 1024 + c) = u32x2{pk2(y0, y1), pk2(y2, y3)};
      }
    }
  }
}

DI void phase_mix_odd(const Params& p, int l, unsigned char* lds) {
#pragma unroll 1
  for (int it = blockIdx.x; it < 1024; it += gridDim.x) { int bh, qb; heavy_map(it, bh, qb); na_item(p, l, true, bh, qb, lds); }
#pragma unroll 1
  for (int it = blockIdx.x; it < 512; it += gridDim.x) na_item(p, l, false, it >> 1, it & 1, lds);
#pragma unroll 1
  for (int it = blockIdx.x; it < 768; it += gridDim.x) sgu_item(p, l, it, lds);
}

__global__ void __launch_bounds__(256, 2) fwd_megakernel(Params p) {
  extern __shared__ __attribute__((aligned(16))) unsigned char lds[];
  cg::grid_group grid = cg::this_grid();
  for (int ph = p.ph_lo; ph < p.ph_hi; ++ph) {
    if (ph == 0) phase_prep(p, lds);
    else if (ph == 1) phase_mod0(p);
    else {
      const int l = (ph - 2) >> 2, s = (ph - 2) & 3;
      if (s == 0) { for (int rep = 0; rep < REP0; ++rep) { if (l & 1) gemm_phase<G_IN_ODD>(p, l, lds); else gemm_phase<G_IN_EVEN>(p, l, lds); } }
      else if (s == 1) { for (int rep = 0; rep < REP1; ++rep) { if (l & 1) phase_mix_odd(p, l, lds); else phase_mix_even(p, l, lds); } }
      else if (s == 2) gemm_phase<G_OUT>(p, l, lds);
      else phase_ln(p, l);
    }
    if (ph + 1 < p.ph_hi) {
      grid.sync();
    }
  }
}

extern "C" void kernel_launch(void* const* d_in, const int* in_sizes, int n_in, void* d_out, int out_size, void* d_ws, size_t ws_size,
                              hipStream_t stream) {
  static int grid_blocks = 0;
  if (grid_blocks == 0) {
    if (n_in != 52 || ws_size < WS_END) {
      fprintf(stderr, "kernel_launch: expected 52 inputs and >= %zu bytes of workspace; got %d, %zu\n", (size_t)WS_END, n_in, ws_size);
      grid_blocks = -1;
      return;
    }
    int dev = 0, cus = 0, per_cu = 0;
    hipGetDevice(&dev);
    hipDeviceGetAttribute(&cus, hipDeviceAttributeMultiprocessorCount, dev);
    hipFuncSetAttribute((const void*)fwd_megakernel, hipFuncAttributeMaxDynamicSharedMemorySize, LDS_BYTES);
    hipOccupancyMaxActiveBlocksPerMultiprocessor(&per_cu, (const void*)fwd_megakernel, 256, LDS_BYTES);
    if (per_cu < 1) per_cu = 1;
    if (per_cu > 2) per_cu = 2;
    grid_blocks = cus * per_cu;
  }
  if (grid_blocks < 0) return;
  Params p{};
  for (int i = 0; i < 52; ++i) p.in[i] = (const float*)d_in[i];
  p.out = (float*)d_out;
  p.ws = (unsigned char*)d_ws;
#if MULTI
  for (int ph = 0; ph < NPHASE; ++ph) {
    p.ph_lo = ph; p.ph_hi = ph + 1;
    hipLaunchKernelGGL(fwd_megakernel, dim3(grid_blocks), dim3(256), LDS_BYTES, stream, p);
  }
#else
  p.ph_lo = 0; p.ph_hi = NPHASE;
  void* args[] = {&p};
  hipError_t e = hipLaunchCooperativeKernel((const void*)fwd_megakernel, dim3(grid_blocks), dim3(256), args, LDS_BYTES, stream);
  if (e != hipSuccess) fprintf(stderr, "cooperative launch failed: %s (grid %d)\n", hipGetErrorString(e), grid_blocks);
#endif
}
```

```cpp
#include <hip/hip_runtime.h>
#include <hip/hip_cooperative_groups.h>
#include <cstdio>
namespace cg = cooperative_groups;

#define DI __device__ __forceinline__
typedef unsigned short u16;
typedef unsigned int u32;
using bf16x8 = __attribute__((ext_vector_type(8))) short;
using f32x4 = __attribute__((ext_vector_type(4))) float;
using f32x16 = __attribute__((ext_vector_type(16))) float;
using u32x4 = __attribute__((ext_vector_type(4))) unsigned;
using u32x2 = __attribute__((ext_vector_type(2))) unsigned;
typedef __bf16 bf2_t __attribute__((ext_vector_type(2)));
typedef float f2_t __attribute__((ext_vector_type(2)));

#ifndef MULTI
#define MULTI 0
#endif
#ifndef REP0
#define REP0 1
#endif
#ifndef REP1
#define REP1 1
#endif
#ifndef ZERO_MASK
#define ZERO_MASK 0
#endif

constexpr int T_ALL = 24576, TP = 8192, DM = 2048;
constexpr float LOG2E = 1.4426950408889634f;
constexpr float ALPHA = 1.6817928305074290f;
constexpr float LN_EPS = 1e-5f;
constexpr int LDS_BYTES = 76288;
constexpr int NPHASE = 18;

constexpr size_t SZ_WIN_E = (size_t)6144 * 2048 * 2, SZ_WIN_O = (size_t)7168 * 2048 * 2;
constexpr size_t WS_WINT = 0;
constexpr size_t WS_WOUTT = WS_WINT + 2 * SZ_WIN_E + 2 * SZ_WIN_O;
constexpr size_t WS_POOLWT = WS_WOUTT + (size_t)4 * 2048 * 2048 * 2;
constexpr size_t WS_SGUW = WS_POOLWT + (size_t)2 * 4 * 256 * 256 * 2;
constexpr size_t WS_CK = WS_SGUW + (size_t)2 * 4 * 128 * 128 * 2;
constexpr size_t WS_CVT = WS_CK + (size_t)4 * 4194304;
constexpr size_t WS_MOD = WS_CVT + (size_t)4 * 4194304;
constexpr size_t WS_ROPE = WS_MOD + (size_t)4 * 5 * 6144 * 4;
constexpr size_t WS_H = WS_ROPE + 8192;
constexpr size_t WS_PROJ = WS_H + (size_t)T_ALL * 2048 * 2;
constexpr size_t WS_VT = WS_PROJ + (size_t)T_ALL * 7168 * 2;
constexpr size_t WS_END = WS_VT + (size_t)T_ALL * 1024 * 2;

struct Params {
  const float* in[52];
  float* out;
  unsigned char* ws;
  int ph_lo, ph_hi;
};

DI size_t ws_wint(int l) { return WS_WINT + (size_t)(l >> 1) * (SZ_WIN_E + SZ_WIN_O) + ((l & 1) ? SZ_WIN_E : 0); }

DI u32 pk2(float a, float b) { f2_t v = {a, b}; bf2_t r = __builtin_convertvector(v, bf2_t); return __builtin_bit_cast(u32, r); }
DI float bflo(u32 w) { return __uint_as_float(w << 16); }
DI float bfhi(u32 w) { return __uint_as_float(w & 0xffff0000u); }
DI float bf1(u16 w) { return __uint_as_float(((u32)w) << 16); }
DI float ex2(float x) { return __builtin_amdgcn_exp2f(x); }
DI float silu(float x) { return x / (1.f + __expf(-x)); }
DI f32x4 mfma16(bf16x8 a, bf16x8 b, f32x4 c) { return __builtin_amdgcn_mfma_f32_16x16x32_bf16(a, b, c, 0, 0, 0); }
DI f32x16 mfma32(bf16x8 a, bf16x8 b, f32x16 c) { return __builtin_amdgcn_mfma_f32_32x32x16_bf16(a, b, c, 0, 0, 0); }
DI bf16x8 ld8(const u16* p) { return *reinterpret_cast<const bf16x8*>(p); }
DI int opq(int x) { asm volatile("" : "+v"(x)); return x; }
#define TIDX opq((int)threadIdx.x)

DI void tr_tile(const float* __restrict__ src, size_t ld_src, u16* __restrict__ dst, size_t ld_dst, float* sT) {
  const int tid = TIDX;
  const int r = tid >> 4, c4 = (tid & 15) * 4;
#pragma unroll
  for (int i = 0; i < 4; ++i) {
    float4 v = *reinterpret_cast<const float4*>(src + (size_t)(r + 16 * i) * ld_src + c4);
    float* d = sT + (r + 16 * i) * 65 + c4;
    d[0] = v.x; d[1] = v.y; d[2] = v.z; d[3] = v.w;
  }
  __syncthreads();
  const int n = tid >> 2, ks = (tid & 3) * 16;
  u32 w[8];
#pragma unroll
  for (int j = 0; j < 8; ++j) w[j] = pk2(sT[(ks + 2 * j) * 65 + n], sT[(ks + 2 * j + 1) * 65 + n]);
  u32x4* o = reinterpret_cast<u32x4*>(dst + (size_t)n * ld_dst + ks);
  o[0] = u32x4{w[0], w[1], w[2], w[3]};
  o[1] = u32x4{w[4], w[5], w[6], w[7]};
  __syncthreads();
}

DI void cvt8(const float* __restrict__ src, u16* __restrict__ dst) {
  float4 a = *reinterpret_cast<const float4*>(src);
  float4 b = *reinterpret_cast<const float4*>(src + 4);
  *reinterpret_cast<u32x4*>(dst) = u32x4{pk2(a.x, a.y), pk2(a.z, a.w), pk2(b.x, b.y), pk2(b.z, b.w)};
}

DI void mod_item(const Params& p, int i, unsigned char* lds) {
  const int tid = TIDX;
  const int l = i / 96, n0 = (i % 96) * 64;
  float* sS = reinterpret_cast<float*>(lds);
  float* red = sS + 5 * 2048;
  const float* c = p.in[10];
  const float* cctx = p.in[11];
  for (int e = tid; e < 5 * 2048; e += 256) {
    int v = e >> 11, k = e & 2047;
    float x = (v == 0) ? cctx[k] : c[(v - 1) * 2048 + k];
    sS[e] = silu(x);
  }
  __syncthreads();
  const int kk = tid >> 4, c4 = (tid & 15) * 4;
  const float* W = p.in[12 + 10 * l] + n0 + c4;
  f32x4 acc[5];
#pragma unroll
  for (int v = 0; v < 5; ++v) acc[v] = f32x4{0.f, 0.f, 0.f, 0.f};
#pragma unroll 8
  for (int k = kk; k < 2048; k += 16) {
    float4 w = *reinterpret_cast<const float4*>(W + (size_t)k * 6144);
#pragma unroll
    for (int v = 0; v < 5; ++v) {
      float s = sS[v * 2048 + k];
      acc[v][0] += s * w.x; acc[v][1] += s * w.y; acc[v][2] += s * w.z; acc[v][3] += s * w.w;
    }
  }
#pragma unroll
  for (int v = 0; v < 5; ++v)
#pragma unroll
    for (int q = 0; q < 4; ++q) red[(kk * 5 + v) * 64 + c4 + q] = acc[v][q];
  __syncthreads();
  for (int t2 = tid; t2 < 320; t2 += 256) {
    int v = t2 >> 6, n = t2 & 63;
    float s = 0.f;
#pragma unroll
    for (int k2 = 0; k2 < 16; ++k2) s += red[(k2 * 5 + v) * 64 + n];
    float* mod = reinterpret_cast<float*>(p.ws + WS_MOD);
    mod[(size_t)(l * 5 + v) * 6144 + n0 + n] = s + p.in[13 + 10 * l][n0 + n];
  }
  __syncthreads();
}

DI void phase_prep(const Params& p, unsigned char* lds) {
  constexpr int N_MOD = 384, N_TRWIN = 13312, N_TRWOUT = 4096, N_TRPOOL = 128, N_SGU = 64, N_CK = 4096, N_CV = 2048;
  constexpr int TOTAL = N_MOD + N_TRWIN + N_TRWOUT + N_TRPOOL + N_SGU + N_CK + N_CV + 1;
  const int tid = TIDX;
  float* sT = reinterpret_cast<float*>(lds);
  for (int it = blockIdx.x; it < TOTAL; it += gridDim.x) {
    int i = it;
    if (i < N_MOD) { mod_item(p, i, lds); continue; }
    i -= N_MOD;
    if (i < N_TRWIN) {
      int l, base;
      if (i < 3072) { l = 0; base = 0; } else if (i < 6656) { l = 1; base = 3072; } else if (i < 9728) { l = 2; base = 6656; } else { l = 3; base = 9728; }
      i -= base;
      const int N = (l & 1) ? 7168 : 6144, nN = N / 64;
      const int kt = i / nN, nt = i % nN;
      tr_tile(p.in[14 + 10 * l] + (size_t)kt * 64 * N + nt * 64, N,
              reinterpret_cast<u16*>(p.ws + ws_wint(l)) + (size_t)nt * 64 * 2048 + kt * 64, 2048, sT);
      continue;
    }
    i -= N_TRWIN;
    if (i < N_TRWOUT) {
      const int l = i >> 10, r = i & 1023, kt = r >> 5, nt = r & 31;
      tr_tile(p.in[15 + 10 * l] + (size_t)kt * 64 * 2048 + nt * 64, 2048,
              reinterpret_cast<u16*>(p.ws + WS_WOUTT) + (size_t)l * 2048 * 2048 + (size_t)nt * 64 * 2048 + kt * 64, 2048, sT);
      continue;
    }
    i -= N_TRWOUT;
    if (i < N_TRPOOL) {
      const int e = i >> 6, r = i & 63, g = r >> 4, t = r & 15, kt = t >> 2, nt = t & 3;
      tr_tile(p.in[18 + 20 * e] + (size_t)g * 65536 + kt * 64 * 256 + nt * 64, 256,
              reinterpret_cast<u16*>(p.ws + WS_POOLWT) + (size_t)e * 262144 + g * 65536 + nt * 64 * 256 + kt * 64, 256, sT);
      continue;
    }
    i -= N_TRPOOL;
    if (i < N_SGU) {
      const int e = i >> 5, ch = i & 31;
      const size_t off = (size_t)ch * 2048 + tid * 8;
      cvt8(p.in[30 + 20 * e] + off, reinterpret_cast<u16*>(p.ws + WS_SGUW) + (size_t)e * 65536 + off);
      continue;
    }
    i -= N_SGU;
    if (i < N_CK) {
      const int l = i >> 10, ch = i & 1023;
      const size_t off = (size_t)ch * 2048 + tid * 8;
      cvt8(p.in[2 + 2 * l] + off, reinterpret_cast<u16*>(p.ws + WS_CK) + (size_t)l * 2097152 + off);
      continue;
    }
    i -= N_CK;
    if (i < N_CV) {
      const int l = i >> 9, r = i & 511, bh = r >> 4, t = r & 15, kt = t >> 1, nt = t & 1;
      tr_tile(p.in[3 + 2 * l] + (size_t)bh * 65536 + kt * 64 * 128 + nt * 64, 128,
              reinterpret_cast<u16*>(p.ws + WS_CVT) + (size_t)l * 2097152 + (size_t)bh * 65536 + nt * 64 * 512 + kt * 64, 512, sT);
      continue;
    }
    {
      float* rc = reinterpret_cast<float*>(p.ws + WS_ROPE);
      for (int e = tid; e < 1024; e += 256) {
        int pos = e >> 4, fi = e & 15;
        float inv = 1.0f / powf(10000.0f, (float)(2 * fi) / 32.0f);
        float ang = (float)pos * inv;
        rc[e] = cosf(ang);
        rc[1024 + e] = sinf(ang);
      }
    }
  }
}

DI void phase_mod0(const Params& p) {
  const int tid = TIDX;
  const float* mod = reinterpret_cast<const float*>(p.ws + WS_MOD);
  u16* H = reinterpret_cast<u16*>(p.ws + WS_H);
  for (int it = blockIdx.x; it < T_ALL / 4; it += gridDim.x) {
#pragma unroll
    for (int rr = 0; rr < 4; ++rr) {
      const int row = it * 4 + rr;
      const int cond = row < TP ? 0 : 1 + ((row - TP) >> 12);
      const float* src = row < TP ? p.in[0] + (size_t)row * 2048 : p.in[1] + (size_t)(row - TP) * 2048;
      const int e = tid * 8;
      const float* sh = mod + (size_t)cond * 6144 + e;
      float4 a = *reinterpret_cast<const float4*>(src + e), b = *reinterpret_cast<const float4*>(src + e + 4);
      float4 s0 = *reinterpret_cast<const float4*>(sh), s1 = *reinterpret_cast<const float4*>(sh + 4);
      float4 c0 = *reinterpret_cast<const float4*>(sh + 2048), c1 = *reinterpret_cast<const float4*>(sh + 2052);
      u32x4 o = {pk2(a.x * (1.f + c0.x) + s0.x, a.y * (1.f + c0.y) + s0.y), pk2(a.z * (1.f + c0.z) + s0.z, a.w * (1.f + c0.w) + s0.w),
                 pk2(b.x * (1.f + c1.x) + s1.x, b.y * (1.f + c1.y) + s1.y), pk2(b.z * (1.f + c1.z) + s1.z, b.w * (1.f + c1.w) + s1.w)};
      *reinterpret_cast<u32x4*>(H + (size_t)row * 2048 + e) = o;
    }
  }
}

enum { G_IN_EVEN = 0, G_IN_ODD = 1, G_OUT = 2 };

template <bool TR>
DI void gemm_tile(const u16* ga, const u16* gb, u16* sA, u16* sB, int tid, int wr, int wc, int fr, int fo0, int fo1, f32x4 (&acc)[4][4]) {
  constexpr int K = 2048;
#pragma unroll
  for (int a = 0; a < 4; ++a)
#pragma unroll
    for (int b = 0; b < 4; ++b) acc[a][b] = f32x4{0.f, 0.f, 0.f, 0.f};
#define GSTAGE(B_, KT_)                                                                                                   \
  _Pragma("unroll") for (int i = 0; i < 4; ++i) {                                                                         \
    __builtin_amdgcn_global_load_lds((const unsigned*)(ga + (size_t)i * 32 * K + (KT_) * 64),                             \
                                     (unsigned*)(sA + (B_) * 8192 + i * 2048 + tid * 8), 16, 0, 0);                       \
    __builtin_amdgcn_global_load_lds((const unsigned*)(gb + (size_t)i * 32 * K + (KT_) * 64),                             \
                                     (unsigned*)(sB + (B_) * 8192 + i * 2048 + tid * 8), 16, 0, 0);                       \
  }
  GSTAGE(0, 0)
  asm volatile("s_waitcnt vmcnt(0)" ::: "memory");
  __syncthreads();
  for (int kt = 0; kt < K / 64; ++kt) {
    const int buf = kt & 1;
    if (kt + 1 < K / 64) { GSTAGE(buf ^ 1, kt + 1) }
    const u16* cA = sA + buf * 8192 + (wr * 64 + fr) * 64;
    const u16* cB = sB + buf * 8192 + (wc * 64 + fr) * 64;
#pragma unroll
    for (int ks = 0; ks < 2; ++ks) {
      const int fo = ks ? fo1 : fo0;
      bf16x8 af[4], bfr[4];
#pragma unroll
      for (int m = 0; m < 4; ++m) af[m] = ld8(cA + m * 1024 + fo);
#pragma unroll
      for (int n = 0; n < 4; ++n) bfr[n] = ld8(cB + n * 1024 + fo);
#pragma unroll
      for (int m = 0; m < 4; ++m)
#pragma unroll
        for (int n = 0; n < 4; ++n) acc[m][n] = TR ? mfma16(bfr[n], af[m], acc[m][n]) : mfma16(af[m], bfr[n], acc[m][n]);
    }
    asm volatile("s_waitcnt vmcnt(0)" ::: "memory");
    __syncthreads();
  }
#undef GSTAGE
}

template <int MODE>
DI void gemm_phase(const Params& p, int l, unsigned char* lds) {
  constexpr int K = 2048;
  constexpr int N = (MODE == G_OUT) ? 2048 : (MODE == G_IN_EVEN ? 6144 : 7168);
  constexpr int NC = (MODE == G_IN_EVEN) ? 6144 : 7168;
  constexpr int nTn = N / 128;
  constexpr int TOTAL = nTn * 192;
  const u16* A = reinterpret_cast<const u16*>(p.ws + WS_H);
  const u16* Bt = (MODE == G_OUT) ? reinterpret_cast<const u16*>(p.ws + WS_WOUTT) + (size_t)l * 2048 * 2048
                                  : reinterpret_cast<const u16*>(p.ws + ws_wint(l));
  u16* sA = reinterpret_cast<u16*>(lds);
  u16* sB = sA + 2 * 128 * 64;
  const int tid = TIDX, lane = tid & 63, wid = tid >> 6;
  const int wr = wid >> 1, wc = wid & 1, fr = lane & 15, fq = lane >> 4;
  const int lrow = tid >> 3;
  const int csrc = ((tid & 7) ^ ((lrow >> 1) & 7)) * 8;
  const int swz = (fr >> 1) & 7;
  const int fo0 = (fq ^ swz) * 8, fo1 = ((4 + fq) ^ swz) * 8;
  u16* PROJ = reinterpret_cast<u16*>(p.ws + WS_PROJ);
  u16* VT = reinterpret_cast<u16*>(p.ws + WS_VT);
  const float* mod = reinterpret_cast<const float*>(p.ws + WS_MOD);
  const float* ropeC = reinterpret_cast<const float*>(p.ws + WS_ROPE);
  const float* ropeS = ropeC + 1024;

  for (int it = blockIdx.x; it < TOTAL; it += gridDim.x) {
    constexpr int PN = nTn / 8;
    const int rnd = it >> 9, vb = it & 511, q = rnd * 8 + (vb & 7), jj = vb >> 3;
    const int tm = (q / PN) * 8 + (jj & 7), tn = (q % PN) * 8 + (jj >> 3);
    const u16* ga = A + (size_t)(tm * 128 + lrow) * K + csrc;
    const u16* gb = Bt + (size_t)(tn * 128 + lrow) * K + csrc;
    f32x4 acc[4][4];
    const bool prompt = tm < 64;
    const int R0 = tm * 128 + wr * 64, C0 = tn * 128 + wc * 64;
    if (MODE == G_OUT) {
      gemm_tile<true>(ga, gb, sA, sB, tid, wr, wc, fr, fo0, fo1, acc);
      const int cond = prompt ? 0 : 1 + ((tm * 128 - TP) >> 12);
      const float* gate = mod + (size_t)(l * 5 + cond) * 6144 + 4096;
      float* X = p.out;
#pragma unroll
      for (int n = 0; n < 4; ++n) {
        const int col = C0 + n * 16 + 4 * fq;
        const float4 g4 = *reinterpret_cast<const float4*>(gate + col);
#pragma unroll
        for (int m = 0; m < 4; ++m) {
          const int row = R0 + m * 16 + fr;
          float4 xo;
          if (l == 0) xo = prompt ? *reinterpret_cast<const float4*>(p.in[0] + (size_t)row * 2048 + col)
                                  : *reinterpret_cast<const float4*>(p.in[1] + (size_t)(row - TP) * 2048 + col);
          else xo = *reinterpret_cast<const float4*>(X + (size_t)row * 2048 + col);
          float4 o;
          o.x = ALPHA * xo.x + g4.x * acc[m][n][0]; o.y = ALPHA * xo.y + g4.y * acc[m][n][1];
          o.z = ALPHA * xo.z + g4.z * acc[m][n][2]; o.w = ALPHA * xo.w + g4.w * acc[m][n][3];
          *reinterpret_cast<float4*>(X + (size_t)row * 2048 + col) = o;
        }
      }
    } else {
      const int sec = tn >> 3;
      const int SEC_Q = (MODE == G_IN_EVEN) ? 2 : 0, SEC_K = (MODE == G_IN_EVEN) ? 3 : 1, SEC_V = (MODE == G_IN_EVEN) ? 4 : 2;
      if (sec == SEC_V) {
        gemm_tile<false>(ga, gb, sA, sB, tid, wr, wc, fr, fo0, fo1, acc);
        const int rowb = R0 + fq * 4;
        const int hh = tn & 7;
        float* vout = p.out + (size_t)T_ALL * 2048 + (size_t)(2 * l + 1) * 8388608;
#pragma unroll
        for (int m = 0; m < 4; ++m) {
          const int row = rowb + m * 16;
#pragma unroll
          for (int n = 0; n < 4; ++n) {
            const int dv = wc * 64 + n * 16 + fr;
            u32x2 w = {pk2(acc[m][n][0], acc[m][n][1]), pk2(acc[m][n][2], acc[m][n][3])};
            if (prompt) {
              const int b = row >> 8, t = row & 255;
              *reinterpret_cast<u32x2*>(VT + ((size_t)((b * 8 + hh) * 128 + dv)) * 256 + t) = w;
#pragma unroll
              for (int j = 0; j < 4; ++j) vout[((size_t)((b * 8 + hh) * 256 + t + j)) * 128 + dv] = acc[m][n][j];
            } else {
              const int rs = row - TP, b = rs >> 12, t = rs & 4095;
              *reinterpret_cast<u32x2*>(VT + 8388608 + ((size_t)((b * 8 + hh) * 128 + dv)) * 4096 + t) = w;
            }
          }
        }
      } else {
        gemm_tile<true>(ga, gb, sA, sB, tid, wr, wc, fr, fo0, fo1, acc);
        const bool isq = sec == SEC_Q, isk = sec == SEC_K;
        const bool rope = (MODE == G_IN_EVEN) && (isq || isk) && !prompt;
        const float qs = (MODE == G_IN_EVEN) ? 0.125f * LOG2E : 0.08838834764831845f * LOG2E;
        if (isk && prompt) {
          const int hh = tn & 7;
          float* kout = p.out + (size_t)T_ALL * 2048 + (size_t)(2 * l) * 8388608;
#pragma unroll
          for (int m = 0; m < 4; ++m) {
            const int row = R0 + m * 16 + fr, b = row >> 8, t = row & 255;
#pragma unroll
            for (int n = 0; n < 4; ++n) {
              const int d = wc * 64 + n * 16 + 4 * fq;
              *reinterpret_cast<float4*>(kout + ((size_t)((b * 8 + hh) * 256 + t)) * 128 + d) =
                  float4{acc[m][n][0], acc[m][n][1], acc[m][n][2], acc[m][n][3]};
            }
          }
        }
        if (rope) {
#pragma unroll
          for (int m = 0; m < 4; ++m) {
            const int t = (R0 + m * 16 + fr - TP) & 4095;
#pragma unroll
            for (int ax = 0; ax < 2; ++ax) {
              const int pos = ax ? (t & 63) : (t >> 6);
              const float4 cs = *reinterpret_cast<const float4*>(ropeC + pos * 16 + 4 * fq);
              const float4 sn = *reinterpret_cast<const float4*>(ropeS + pos * 16 + 4 * fq);
              const float c4[4] = {cs.x, cs.y, cs.z, cs.w}, s4[4] = {sn.x, sn.y, sn.z, sn.w};
#pragma unroll
              for (int j = 0; j < 4; ++j) {
                const float x1 = acc[m][2 * ax][j], x2 = acc[m][2 * ax + 1][j];
                acc[m][2 * ax][j] = x1 * c4[j] - x2 * s4[j];
                acc[m][2 * ax + 1][j] = x1 * s4[j] + x2 * c4[j];
              }
            }
          }
        }
        const float sc = isq ? qs : 1.0f;
#pragma unroll
        for (int m = 0; m < 4; ++m) {
          const int row = R0 + m * 16 + fr;
#pragma unroll
          for (int n = 0; n < 4; ++n) {
            const int col = C0 + n * 16 + 4 * fq;
            *reinterpret_cast<u32x2*>(PROJ + (size_t)row * NC + col) =
                u32x2{pk2(acc[m][n][0] * sc, acc[m][n][1] * sc), pk2(acc[m][n][2] * sc, acc[m][n][3] * sc)};
          }
        }
      }
    }
  }
}

DI void phase_ln(const Params& p, int l) {
  const int tid_ = TIDX, lane = tid_ & 63, wid = tid_ >> 6;
  const float* g = p.in[16 + 10 * l];
  const float* bb = p.in[17 + 10 * l];
  const float* mod = reinterpret_cast<const float*>(p.ws + WS_MOD);
  u16* H = reinterpret_cast<u16*>(p.ws + WS_H);
  float* X = p.out;
  for (int it = blockIdx.x; it < T_ALL / 4; it += gridDim.x) {
    const int row = it * 4 + wid;
    float* xr = X + (size_t)row * 2048;
    float4 v[8];
    float s = 0.f;
#pragma unroll
    for (int i = 0; i < 8; ++i) {
      v[i] = *reinterpret_cast<const float4*>(xr + (i * 64 + lane) * 4);
      s += v[i].x + v[i].y + v[i].z + v[i].w;
    }
#pragma unroll
    for (int o = 32; o >= 1; o >>= 1) s += __shfl_xor(s, o);
    const float mu = s * (1.f / 2048.f);
    float ss = 0.f;
#pragma unroll
    for (int i = 0; i < 8; ++i) {
      float a = v[i].x - mu, b = v[i].y - mu, c = v[i].z - mu, d = v[i].w - mu;
      ss += a * a + b * b + c * c + d * d;
    }
#pragma unroll
    for (int o = 32; o >= 1; o >>= 1) ss += __shfl_xor(ss, o);
    const float rstd = rsqrtf(ss * (1.f / 2048.f) + LN_EPS);
    const int cond = row < TP ? 0 : 1 + ((row - TP) >> 12);
    const float* sh = mod + (size_t)((l + 1) * 5 + cond) * 6144;
#pragma unroll
    for (int i = 0; i < 8; ++i) {
      const int e = (i * 64 + lane) * 4;
      float4 gg = *reinterpret_cast<const float4*>(g + e), b4 = *reinterpret_cast<const float4*>(bb + e);
      float4 y;
      y.x = (v[i].x - mu) * rstd * gg.x + b4.x; y.y = (v[i].y - mu) * rstd * gg.y + b4.y;
      y.z = (v[i].z - mu) * rstd * gg.z + b4.z; y.w = (v[i].w - mu) * rstd * gg.w + b4.w;
      *reinterpret_cast<float4*>(xr + e) = y;
      if (l < 3) {
        float4 s0 = *reinterpret_cast<const float4*>(sh + e), c0 = *reinterpret_cast<const float4*>(sh + 2048 + e);
        u32x2 o = {pk2(y.x * (1.f + c0.x) + s0.x, y.y * (1.f + c0.y) + s0.y), pk2(y.z * (1.f + c0.z) + s0.z, y.w * (1.f + c0.w) + s0.w)};
        *reinterpret_cast<u32x2*>(H + (size_t)row * 2048 + e) = o;
      }
    }
  }
}

struct AttnSrc {
  const u16* k0; const u16* vt0; int ks0, vs0, n0;
  const u16* k1; const u16* vt1; int ks1, vs1, n1;
};

template <int DQK>
DI void attn_ldg(const AttnSrc& s, int j, u32x4 (&rk)[DQK / 32], u32x4 (&rv)[4]) {
  const u16* kb; const u16* vb; int ks, vs;
  if (j < s.n0) { kb = s.k0 + (size_t)j * 64 * s.ks0; vb = s.vt0 + j * 64; ks = s.ks0; vs = s.vs0; }
  else { const int jj = j - s.n0; kb = s.k1 + (size_t)jj * 64 * s.ks1; vb = s.vt1 + jj * 64; ks = s.ks1; vs = s.vs1; }
  constexpr int CPR = DQK / 8;
  const int tid = TIDX;
#pragma unroll
  for (int i = 0; i < DQK / 32; ++i) {
    const int c = tid + 256 * i, row = c / CPR, kc = c % CPR;
    rk[i] = *reinterpret_cast<const u32x4*>(kb + (size_t)row * ks + kc * 8);
  }
#pragma unroll
  for (int i = 0; i < 4; ++i) {
    const int c = tid + 256 * i, row = c >> 3, kc = c & 7;
    rv[i] = *reinterpret_cast<const u32x4*>(vb + (size_t)row * vs + kc * 8);
  }
}
template <int DQK>
DI void attn_sts(u16* sK, u16* sVT, const u32x4 (&rk)[DQK / 32], const u32x4 (&rv)[4]) {
  constexpr int CPR = DQK / 8;
  const int tid = TIDX;
#pragma unroll
  for (int i = 0; i < DQK / 32; ++i) {
    const int c = tid + 256 * i, row = c / CPR, kc = c % CPR;
    *reinterpret_cast<u32x4*>(sK + row * (DQK + 8) + kc * 8) = rk[i];
  }
#pragma unroll
  for (int i = 0; i < 4; ++i) {
    const int c = tid + 256 * i, row = c >> 3, kc = c & 7;
    *reinterpret_cast<u32x4*>(sVT + row * 72 + kc * 8) = rv[i];
  }
}

template <int DQK, bool NA>
DI void attn_run(const AttnSrc& src, const u16* qblk, int qstride, u16* sQ, u16* sK, u16* sVT, f32x16 (&O)[4], float& l_out,
                 int qr, int qc, int rsmin, const float* sBias) {
  const int tid = TIDX, lane = tid & 63, wid = tid >> 6;
  const int r = lane & 31, h = lane >> 5;
  const int pr = (r & 0x13) | ((r & 4) << 1) | ((r & 8) >> 1);
  constexpr int CPR = DQK / 8, QS = DQK + 8;
  constexpr bool DB = (DQK == 64);
  __syncthreads();
  bf16x8 qf[DB ? DQK / 16 : 1];
  if constexpr (DB) {
#pragma unroll
    for (int ks = 0; ks < DQK / 16; ++ks) qf[ks] = ld8(qblk + (size_t)(wid * 32 + r) * qstride + ks * 16 + 8 * h);
  } else {
#pragma unroll
    for (int i = 0; i < DQK / 16; ++i) {
      const int c = tid + 256 * i, row = c / CPR, kc = c % CPR;
      *reinterpret_cast<u32x4*>(sQ + row * QS + kc * 8) = *reinterpret_cast<const u32x4*>(qblk + (size_t)row * qstride + kc * 8);
    }
  }
#pragma unroll
  for (int d = 0; d < 4; ++d)
#pragma unroll
    for (int i = 0; i < 16; ++i) O[d][i] = 0.f;
  float m = -1e30f, l = 0.f;
  const int nt = src.n0 + src.n1;
  const int rsq = min(max(qr - 4, 0), 56);
  const int cs = min(max(qc - 8, 0), 48);
  const u16* qw = sQ + (wid * 32 + r) * QS + 8 * h;
  u16* sK1 = sQ;
  u16* sVT1 = sQ + 64 * QS;
  u32x4 rk[DQK / 32], rv[4];
  attn_ldg<DQK>(src, 0, rk, rv);
  if constexpr (DB) {
    attn_sts<DQK>(sK, sVT, rk, rv);
    if (nt > 1) attn_ldg<DQK>(src, 1, rk, rv);
    __syncthreads();
  }
#pragma unroll 1
  for (int j = 0; j < nt; ++j) {
    const u16* kw;
    const u16* vw;
    if constexpr (DB) {
      const int cur = j & 1;
      if (j + 1 < nt) { if (cur) attn_sts<DQK>(sK, sVT, rk, rv); else attn_sts<DQK>(sK1, sVT1, rk, rv); }
      if (j + 2 < nt) attn_ldg<DQK>(src, j + 2, rk, rv);
      kw = (cur ? sK1 : sK) + pr * QS + 8 * h;
      vw = (cur ? sVT1 : sVT) + r * 72 + 8 * h;
    } else {
      if (j > 0) __syncthreads();
      attn_sts<DQK>(sK, sVT, rk, rv);
      __syncthreads();
      if (j + 1 < nt) attn_ldg<DQK>(src, j + 1, rk, rv);
      kw = sK + pr * QS + 8 * h;
      vw = sVT + r * 72 + 8 * h;
    }
    __builtin_amdgcn_sched_barrier(0);
    bool active = true;
    int kr = 0;
    if (NA && j >= src.n0) { kr = rsmin + (j - src.n0); active = (kr >= rsq) && (kr < rsq + 8); }
    if (active) {
      f32x16 s[2];
      __builtin_amdgcn_s_setprio(1);
#pragma unroll
      for (int t = 0; t < 2; ++t) {
#pragma unroll
        for (int i = 0; i < 16; ++i) s[t][i] = 0.f;
#pragma unroll
        for (int ks = 0; ks < DQK / 16; ++ks) {
          bf16x8 a = ld8(kw + t * 32 * QS + ks * 16);
          bf16x8 q;
          if constexpr (DB) q = qf[ks]; else q = ld8(qw + ks * 16);
          s[t] = mfma32(a, q, s[t]);
        }
      }
      __builtin_amdgcn_s_setprio(0);
      if (NA && j >= src.n0) {
        const float* bp = sBias + (kr - qr + 7) * 31 + (8 * h - qc + 15);
        const int kb = 8 * h - cs;
#pragma unroll
        for (int t = 0; t < 2; ++t)
#pragma unroll
          for (int i = 0; i < 16; ++i) {
            const int ko = t * 32 + 16 * (i >> 3) + (i & 7);
            const bool ok = (unsigned)(ko + kb) < 16u;
            const float bv = bp[ko];
            s[t][i] = ok ? s[t][i] + bv : -1e30f;
          }
      }
      float mx = -1e30f;
#pragma unroll
      for (int t = 0; t < 2; ++t)
#pragma unroll
        for (int i = 0; i < 16; ++i) mx = fmaxf(mx, s[t][i]);
      mx = fmaxf(mx, __shfl_xor(mx, 32));
      if (__builtin_amdgcn_ballot_w64(mx > m + 8.0f) != 0ull) {
        const float mn = fmaxf(m, mx);
        const float alpha = ex2(m - mn);
        l *= alpha;
        m = mn;
#pragma unroll
        for (int d = 0; d < 4; ++d)
#pragma unroll
          for (int i = 0; i < 16; ++i) O[d][i] *= alpha;
      }
      float rsum = 0.f;
#pragma unroll
      for (int t = 0; t < 2; ++t)
#pragma unroll
        for (int i = 0; i < 16; ++i) { const float e = ex2(s[t][i] - m); s[t][i] = e; rsum += e; }
      rsum += __shfl_xor(rsum, 32);
      l += rsum;
      __builtin_amdgcn_s_setprio(1);
#pragma unroll
      for (int s4 = 0; s4 < 4; ++s4) {
        const int t = s4 >> 1, b0 = (s4 & 1) * 8;
        u32x4 w = {pk2(s[t][b0], s[t][b0 + 1]), pk2(s[t][b0 + 2], s[t][b0 + 3]), pk2(s[t][b0 + 4], s[t][b0 + 5]), pk2(s[t][b0 + 6], s[t][b0 + 7])};
        const bf16x8 pf = __builtin_bit_cast(bf16x8, w);
#pragma unroll
        for (int d = 0; d < 4; ++d) {
          bf16x8 a = ld8(vw + d * 32 * 72 + s4 * 16);
          O[d] = mfma32(a, pf, O[d]);
        }
      }
      __builtin_amdgcn_s_setprio(0);
    }
    if constexpr (DB) __syncthreads();
  }
  l_out = l;
}

DI void heavy_map(int it, int& bh, int& qb) { const int x = it & 7, idx = it >> 3; bh = x + 8 * (idx >> 5); qb = idx & 31; }

DI void diff_item(const Params& p, int l, bool sample, int bh, int qb, unsigned char* lds) {
  constexpr int NC = 6144;
  const int tid_ = TIDX, lane = tid_ & 63, wid = tid_ >> 6, r = lane & 31, h = lane >> 5;
  const int b = bh >> 3, hd = bh & 7;
  u16* sQ = reinterpret_cast<u16*>(lds);
  u16* sK = sQ + 128 * 136;
  u16* sVT = sK + 64 * 136;
  const u16* PROJ = reinterpret_cast<const u16*>(p.ws + WS_PROJ);
  const u16* VT = reinterpret_cast<const u16*>(p.ws + WS_VT);
  const int seq0 = sample ? TP + b * 4096 : b * 256;
  const int token = seq0 + qb * 128 + wid * 32 + r;
  const float* dl = p.in[20 + 10 * l];
  float pa = dl[lane] * dl[64 + lane], pb = dl[128 + lane] * dl[192 + lane];
#pragma unroll
  for (int o = 32; o >= 1; o >>= 1) { pa += __shfl_xor(pa, o); pb += __shfl_xor(pb, o); }
  const float lam_init = 0.8f - 0.6f * __expf(-0.3f * (float)l);
  const float lam = __expf(pa) - __expf(pb) + lam_init;

  u32 o1p[32];
  f32x16 O[4];
  float lsum;
#pragma unroll
  for (int comp = 0; comp < 2; ++comp) {
    AttnSrc s;
    if (sample) {
      s.k0 = reinterpret_cast<const u16*>(p.ws + WS_CK) + (size_t)l * 2097152 + (size_t)bh * 65536 + comp * 64; s.ks0 = 128;
      s.vt0 = reinterpret_cast<const u16*>(p.ws + WS_CVT) + (size_t)l * 2097152 + (size_t)bh * 65536; s.vs0 = 512; s.n0 = 8;
      s.k1 = PROJ + (size_t)seq0 * NC + 3072 + hd * 128 + comp * 64; s.ks1 = NC;
      s.vt1 = VT + 8388608 + (size_t)bh * 128 * 4096; s.vs1 = 4096; s.n1 = 64;
    } else {
      s.k0 = nullptr; s.vt0 = nullptr; s.ks0 = 0; s.vs0 = 0; s.n0 = 0;
      s.k1 = PROJ + (size_t)seq0 * NC + 3072 + hd * 128 + comp * 64; s.ks1 = NC;
      s.vt1 = VT + (size_t)bh * 128 * 256; s.vs1 = 256; s.n1 = 4;
    }
    const u16* qblk = PROJ + (size_t)(seq0 + qb * 128) * NC + 2048 + hd * 128 + comp * 64;
    attn_run<64, false>(s, qblk, NC, sQ, sK, sVT, O, lsum, 0, 0, 0, nullptr);
    const float inv = 1.f / lsum;
    if (comp == 0) {
#pragma unroll
      for (int d = 0; d < 4; ++d)
#pragma unroll
        for (int i = 0; i < 8; ++i) o1p[d * 8 + i] = pk2(O[d][2 * i] * inv, O[d][2 * i + 1] * inv);
    } else {
      float ssq = 0.f;
#pragma unroll
      for (int d = 0; d < 4; ++d)
#pragma unroll
        for (int i = 0; i < 8; ++i) {
          const u32 w = o1p[d * 8 + i];
          const float a = bflo(w) - lam * O[d][2 * i] * inv, c = bfhi(w) - lam * O[d][2 * i + 1] * inv;
          O[d][2 * i] = a; O[d][2 * i + 1] = c;
          ssq += a * a + c * c;
        }
      ssq += __shfl_xor(ssq, 32);
      const float rn = rsqrtf(ssq * (1.f / 128.f) + LN_EPS) * (1.f - lam_init);
      const float* subln = p.in[21 + 10 * l];
      const u16* gp = PROJ + (size_t)token * NC + 5120 + hd * 128;
      u16* yp = reinterpret_cast<u16*>(p.ws + WS_H) + (size_t)token * 2048 + 1024 + hd * 128;
#pragma unroll
      for (int d = 0; d < 4; ++d)
#pragma unroll
        for (int q = 0; q < 4; ++q) {
          const int dv = d * 32 + 8 * q + 4 * h;
          const u32x2 gw = *reinterpret_cast<const u32x2*>(gp + dv);
          const float4 sl = *reinterpret_cast<const float4*>(subln + dv);
          const float y0 = O[d][4 * q] * rn * sl.x * silu(bflo(gw[0]));
          const float y1 = O[d][4 * q + 1] * rn * sl.y * silu(bfhi(gw[0]));
          const float y2 = O[d][4 * q + 2] * rn * sl.z * silu(bflo(gw[1]));
          const float y3 = O[d][4 * q + 3] * rn * sl.w * silu(bfhi(gw[1]));
          *reinterpret_cast<u32x2*>(yp + dv) = (ZERO_MASK & 2) ? u32x2{0u, 0u} : u32x2{pk2(y0, y1), pk2(y2, y3)};
        }
    }
  }
}

DI void pool_item(const Params& p, int l, int pi, unsigned char* lds) {
  constexpr int NC = 6144;
  const int tid = TIDX, lane = tid & 63, wid = tid >> 6, fr = lane & 15, fq = lane >> 4;
  const int tb = pi >> 2, g = pi & 3, row0 = tb * 64;
  const int L = row0 < TP ? 256 : 4096;
  const int t0 = row0 < TP ? (row0 & 255) : ((row0 - TP) & 4095);
  u16* sIn = reinterpret_cast<u16*>(lds);
  u16* sP = sIn + 80 * 264;
  const u16* PROJ = reinterpret_cast<const u16*>(p.ws + WS_PROJ);
  __syncthreads();
#pragma unroll
  for (int i = 0; i < 10; ++i) {
    const int c = tid + 256 * i, rr = c >> 5, oc = c & 31;
    const int t = t0 - 8 + rr;
    u32x4 v = {0u, 0u, 0u, 0u};
    if (t >= 0 && t < L) v = *reinterpret_cast<const u32x4*>(PROJ + (size_t)(row0 - 8 + rr) * NC + g * 256 + oc * 8);
    *reinterpret_cast<u32x4*>(sIn + rr * 264 + oc * 8) = v;
  }
  __syncthreads();
  {
    const int oc = tid & 31, seg = tid >> 5;
    const int half = 1 << g;
#pragma unroll 1
    for (int tt = 0; tt < 8; ++tt) {
      const int tl = seg * 8 + tt, t = t0 + tl;
      const int lo = max(t - half, 0), hi = min(t + half, L);
      float a[8];
#pragma unroll
      for (int k = 0; k < 8; ++k) a[k] = 0.f;
      for (int s = lo; s < hi; ++s) {
        const u32x4 v = *reinterpret_cast<const u32x4*>(sIn + (s - t0 + 8) * 264 + oc * 8);
#pragma unroll
        for (int k = 0; k < 4; ++k) { a[2 * k] += bflo(v[k]); a[2 * k + 1] += bfhi(v[k]); }
      }
      const float ic = 1.f / (float)(hi - lo);
      const u32x4 x = *reinterpret_cast<const u32x4*>(sIn + (tl + 8) * 264 + oc * 8);
      u32x4 o;
#pragma unroll
      for (int k = 0; k < 4; ++k) o[k] = pk2(a[2 * k] * ic - bflo(x[k]), a[2 * k + 1] * ic - bfhi(x[k]));
      *reinterpret_cast<u32x4*>(sP + tl * 264 + oc * 8) = o;
    }
  }
  __syncthreads();
  const u16* W = reinterpret_cast<const u16*>(p.ws + WS_POOLWT) + (size_t)(l >> 1) * 262144 + (size_t)g * 65536;
  f32x4 acc[4][4];
#pragma unroll
  for (int a = 0; a < 4; ++a)
#pragma unroll
    for (int b = 0; b < 4; ++b) acc[a][b] = f32x4{0.f, 0.f, 0.f, 0.f};
#pragma unroll 2
  for (int ks = 0; ks < 8; ++ks) {
    bf16x8 af[4], bfr[4];
#pragma unroll
    for (int m = 0; m < 4; ++m) af[m] = ld8(sP + (m * 16 + fr) * 264 + ks * 32 + fq * 8);
#pragma unroll
    for (int n = 0; n < 4; ++n) bfr[n] = ld8(W + (size_t)(wid * 64 + n * 16 + fr) * 256 + ks * 32 + fq * 8);
#pragma unroll
    for (int m = 0; m < 4; ++m)
#pragma unroll
      for (int n = 0; n < 4; ++n) acc[m][n] = mfma16(bfr[n], af[m], acc[m][n]);
  }
  const float* pscale = p.in[19 + 10 * l];
  u16* Y = reinterpret_cast<u16*>(p.ws + WS_H);
#pragma unroll
  for (int n = 0; n < 4; ++n) {
    const int col = g * 256 + wid * 64 + n * 16 + 4 * fq;
    const float4 sc = *reinterpret_cast<const float4*>(pscale + col);
#pragma unroll
    for (int m = 0; m < 4; ++m) {
      const int row = row0 + m * 16 + fr;
      const u32x2 gw = *reinterpret_cast<const u32x2*>(PROJ + (size_t)row * NC + 1024 + col);
      float y0 = acc[m][n][0] * sc.x * silu(bflo(gw[0])), y1 = acc[m][n][1] * sc.y * silu(bfhi(gw[0]));
      float y2 = acc[m][n][2] * sc.z * silu(bflo(gw[1])), y3 = acc[m][n][3] * sc.w * silu(bfhi(gw[1]));
      if (ZERO_MASK & 1) { y0 = y1 = y2 = y3 = 0.f; }
      *reinterpret_cast<u32x2*>(Y + (size_t)row * 2048 + col) = u32x2{pk2(y0, y1), pk2(y2, y3)};
    }
  }
}

DI void phase_mix_even(const Params& p, int l, unsigned char* lds) {
#pragma unroll 1
  for (int it = blockIdx.x; it < 1024; it += gridDim.x) { int bh, qb; heavy_map(it, bh, qb); diff_item(p, l, true, bh, qb, lds); }
#pragma unroll 1
  for (int it = blockIdx.x; it < 512; it += gridDim.x) diff_item(p, l, false, it >> 1, it & 1, lds);
#pragma unroll 1
  for (int it = blockIdx.x; it < 1536; it += gridDim.x) pool_item(p, l, it, lds);
}

DI void na_item(const Params& p, int l, bool sample, int bh, int qb, unsigned char* lds) {
  constexpr int NC = 7168;
  const int tid = TIDX, lane = tid & 63, wid = tid >> 6, r = lane & 31, h = lane >> 5;
  const int b = bh >> 3, hd = bh & 7;
  u16* sQ = reinterpret_cast<u16*>(lds);
  u16* sK = sQ + 128 * 136;
  u16* sVT = sK + 64 * 136;
  float* sBias = reinterpret_cast<float*>(sVT + 128 * 72) + 64;
  const u16* PROJ = reinterpret_cast<const u16*>(p.ws + WS_PROJ);
  const u16* VT = reinterpret_cast<const u16*>(p.ws + WS_VT);
  const int seq0 = sample ? TP + b * 4096 : b * 256;
  const int token = seq0 + qb * 128 + wid * 32 + r;
  AttnSrc s;
  int qr = 0, qc = 0, rsmin = 0;
  f32x16 O[4];
  float lsum;
  const u16* qblk = PROJ + (size_t)(seq0 + qb * 128) * NC + hd * 128;
  if (sample) {
    __syncthreads();
    const float* rpb = p.in[18 + 10 * l] + hd * 465;
    for (int e = tid; e < 465; e += 256) sBias[e] = rpb[e] * LOG2E;
    const int r0 = qb * 2;
    qr = r0 + (wid >> 1); qc = (wid & 1) * 32 + r;
    rsmin = min(max(r0 - 4, 0), 56);
    const int rs1 = min(max(r0 - 3, 0), 56);
    s.k0 = reinterpret_cast<const u16*>(p.ws + WS_CK) + (size_t)l * 2097152 + (size_t)bh * 65536; s.ks0 = 128;
    s.vt0 = reinterpret_cast<const u16*>(p.ws + WS_CVT) + (size_t)l * 2097152 + (size_t)bh * 65536; s.vs0 = 512; s.n0 = 8;
    s.k1 = PROJ + (size_t)(seq0 + rsmin * 64) * NC + 1024 + hd * 128; s.ks1 = NC;
    s.vt1 = VT + 8388608 + (size_t)bh * 128 * 4096 + rsmin * 64; s.vs1 = 4096; s.n1 = rs1 + 8 - rsmin;
    attn_run<128, true>(s, qblk, NC, sQ, sK, sVT, O, lsum, qr, qc, rsmin, sBias);
  } else {
    s.k0 = nullptr; s.vt0 = nullptr; s.ks0 = 0; s.vs0 = 0; s.n0 = 0;
    s.k1 = PROJ + (size_t)seq0 * NC + 1024 + hd * 128; s.ks1 = NC;
    s.vt1 = VT + (size_t)bh * 128 * 256; s.vs1 = 256; s.n1 = 4;
    attn_run<128, false>(s, qblk, NC, sQ, sK, sVT, O, lsum, 0, 0, 0, nullptr);
  }
  const float inv = 1.f / lsum;
  const u16* gp = PROJ + (size_t)token * NC + 3072 + hd * 128;
  u16* yp = reinterpret_cast<u16*>(p.ws + WS_H) + (size_t)token * 2048 + hd * 128;
#pragma unroll
  for (int d = 0; d < 4; ++d)
#pragma unroll
    for (int q = 0; q < 4; ++q) {
      const int dv = d * 32 + 8 * q + 4 * h;
      const u32x2 gw = *reinterpret_cast<const u32x2*>(gp + dv);
      const float y0 = O[d][4 * q] * inv * silu(bflo(gw[0]));
      const float y1 = O[d][4 * q + 1] * inv * silu(bfhi(gw[0]));
      const float y2 = O[d][4 * q + 2] * inv * silu(bflo(gw[1]));
      const float y3 = O[d][4 * q + 3] * inv * silu(bfhi(gw[1]));
      *reinterpret_cast<u32x2*>(yp + dv) = (ZERO_MASK & 4) ? u32x2{0u, 0u} : u32x2{pk2(y0, y1), pk2(y2, y3)};
    }
}

DI void sgu_item(const Params& p, int l, int si, unsigned char* lds) {
  constexpr int NC = 7168;
  const int tid = TIDX, lane = tid & 63, wid = tid >> 6, fr = lane & 15, fq = lane >> 4;
  const int ch = si >> 2, g = si & 3, row0 = ch * 128;
  u16* vnT = reinterpret_cast<u16*>(lds);
  float* sMu = reinterpret_cast<float*>(vnT + 256 * 136);
  float* sRs = sMu + 128;
  const u16* PROJ = reinterpret_cast<const u16*>(p.ws + WS_PROJ);
  __syncthreads();
  {
    const int grp = tid >> 4, ln = tid & 15;
#pragma unroll 1
    for (int rr = 0; rr < 8; ++rr) {
      const u16* src = PROJ + (size_t)(row0 + grp * 8 + rr) * NC + 5120;
      float s = 0.f, ss = 0.f;
#pragma unroll
      for (int c8 = 0; c8 < 8; ++c8) {
        const u32x4 v = *reinterpret_cast<const u32x4*>(src + (ln + 16 * c8) * 8);
#pragma unroll
        for (int k = 0; k < 4; ++k) { const float a = bflo(v[k]), b = bfhi(v[k]); s += a + b; ss += a * a + b * b; }
      }
#pragma unroll
      for (int o = 8; o >= 1; o >>= 1) { s += __shfl_xor(s, o); ss += __shfl_xor(ss, o); }
      const float mu = s * (1.f / 1024.f);
      const float var = fmaxf(ss * (1.f / 1024.f) - mu * mu, 0.f);
      if (ln == 0) { sMu[grp * 8 + rr] = mu; sRs[grp * 8 + rr] = rsqrtf(var + LN_EPS); }
    }
  }
  __syncthreads();
  {
    const int j = tid & 127, hf = tid >> 7;
    const float mu = sMu[j], rs = sRs[j];
    const float* lng = p.in[19 + 10 * l] + g * 256;
    const u16* src = PROJ + (size_t)(row0 + j) * NC + 5120 + g * 256;
#pragma unroll 1
    for (int oc = hf * 16; oc < hf * 16 + 16; ++oc) {
      const u32x4 v = *reinterpret_cast<const u32x4*>(src + oc * 8);
      const float4 g0 = *reinterpret_cast<const float4*>(lng + oc * 8), g1 = *reinterpret_cast<const float4*>(lng + oc * 8 + 4);
      const float gg[8] = {g0.x, g0.y, g0.z, g0.w, g1.x, g1.y, g1.z, g1.w};
#pragma unroll
      for (int k = 0; k < 4; ++k) {
        const float a = (bflo(v[k]) - mu) * rs * gg[2 * k], b = (bfhi(v[k]) - mu) * rs * gg[2 * k + 1];
        const u32 w = pk2(a, b);
        vnT[(oc * 8 + 2 * k) * 136 + j] = (u16)(w & 0xffffu);
        vnT[(oc * 8 + 2 * k + 1) * 136 + j] = (u16)(w >> 16);
      }
    }
  }
  __syncthreads();
  const u16* W = reinterpret_cast<const u16*>(p.ws + WS_SGUW) + (size_t)(l >> 1) * 65536 + (size_t)g * 16384;
  const float* bs = p.in[21 + 10 * l] + g * 128;
  u16* Y = reinterpret_cast<u16*>(p.ws + WS_H);
#pragma unroll 1
  for (int ih = 0; ih < 2; ++ih) {
    f32x4 acc[4][4];
#pragma unroll
    for (int a = 0; a < 4; ++a)
#pragma unroll
      for (int b = 0; b < 4; ++b) acc[a][b] = f32x4{0.f, 0.f, 0.f, 0.f};
#pragma unroll
    for (int ks = 0; ks < 4; ++ks) {
      bf16x8 af[4], bfr[4];
#pragma unroll
      for (int m = 0; m < 4; ++m) af[m] = ld8(W + (size_t)(ih * 64 + m * 16 + fr) * 128 + ks * 32 + fq * 8);
#pragma unroll
      for (int n = 0; n < 4; ++n) bfr[n] = ld8(vnT + (wid * 64 + n * 16 + fr) * 136 + ks * 32 + fq * 8);
#pragma unroll
      for (int m = 0; m < 4; ++m)
#pragma unroll
        for (int n = 0; n < 4; ++n) acc[m][n] = mfma16(bfr[n], af[m], acc[m][n]);
    }
#pragma unroll
    for (int m = 0; m < 4; ++m) {
      const int ii = ih * 64 + m * 16 + fr;
      const float bias = bs[ii];
      const size_t rb = (size_t)(row0 + ii) * NC;
#pragma unroll
      for (int n = 0; n < 4; ++n) {
        const int c = g * 256 + wid * 64 + n * 16 + 4 * fq;
        const u32x2 uw = *reinterpret_cast<const u32x2*>(PROJ + rb + 4096 + c);
        const u32x2 dw = *reinterpret_cast<const u32x2*>(PROJ + rb + 6144 + c);
        float y0 = bflo(uw[0]) * (acc[m][n][0] + bias) * silu(bflo(dw[0])), y1 = bfhi(uw[0]) * (acc[m][n][1] + bias) * silu(bfhi(dw[0]));
        float y2 = bflo(uw[1]) * (acc[m][n][2] + bias) * silu(bflo(dw[1])), y3 = bfhi(uw[1]) * (acc[m][n][3] + bias) * silu(bfhi(dw[1]));
        if (ZERO_MASK & 8) { y0 = y1 = y2 = y3 = 0.f; }
        *reinterpret_cast<u32x2*>(Y + (size_t)(row0 + ii) * 2048 + 1024 + c) = u32x2{pk2(y0, y1), pk2(y2, y3)};
      }
    }
  }
}

DI void phase_mix_odd(const Params& p, int l, unsigned char* lds) {
#pragma unroll 1
  for (int it = blockIdx.x; it < 1024; it += gridDim.x) { int bh, qb; heavy_map(it, bh, qb); na_item(p, l, true, bh, qb, lds); }
#pragma unroll 1
  for (int it = blockIdx.x; it < 512; it += gridDim.x) na_item(p, l, false, it >> 1, it & 1, lds);
#pragma unroll 1
  for (int it = blockIdx.x; it < 768; it += gridDim.x) sgu_item(p, l, it, lds);
}

__global__ void __launch_bounds__(256, 2) fwd_megakernel(Params p) {
  extern __shared__ __attribute__((aligned(16))) unsigned char lds[];
  cg::grid_group grid = cg::this_grid();
  for (int ph = p.ph_lo; ph < p.ph_hi; ++ph) {
    if (ph == 0) phase_prep(p, lds);
    else if (ph == 1) phase_mod0(p);
    else {
      const int l = (ph - 2) >> 2, s = (ph - 2) & 3;
      if (s == 0) { for (int rep = 0; rep < REP0; ++rep) { if (l & 1) gemm_phase<G_IN_ODD>(p, l, lds); else gemm_phase<G_IN_EVEN>(p, l, lds); } }
      else if (s == 1) { for (int rep = 0; rep < REP1; ++rep) { if (l & 1) phase_mix_odd(p, l, lds); else phase_mix_even(p, l, lds); } }
      else if (s == 2) gemm_phase<G_OUT>(p, l, lds);
      else phase_ln(p, l);
    }
    if (ph + 1 < p.ph_hi) {
      grid.sync();
    }
  }
}

extern "C" void kernel_launch(void* const* d_in, const int* in_sizes, int n_in, void* d_out, int out_size, void* d_ws, size_t ws_size,
                              hipStream_t stream) {
  static int grid_blocks = 0;
  if (grid_blocks == 0) {
    if (n_in != 52 || ws_size < WS_END) {
      fprintf(stderr, "kernel_launch: expected 52 inputs and >= %zu bytes of workspace; got %d, %zu\n", (size_t)WS_END, n_in, ws_size);
      grid_blocks = -1;
      return;
    }
    int dev = 0, cus = 0, per_cu = 0;
    hipGetDevice(&dev);
    hipDeviceGetAttribute(&cus, hipDeviceAttributeMultiprocessorCount, dev);
    hipFuncSetAttribute((const void*)fwd_megakernel, hipFuncAttributeMaxDynamicSharedMemorySize, LDS_BYTES);
    hipOccupancyMaxActiveBlocksPerMultiprocessor(&per_cu, (const void*)fwd_megakernel, 256, LDS_BYTES);
    if (per_cu < 1) per_cu = 1;
    if (per_cu > 2) per_cu = 2;
    grid_blocks = cus * per_cu;
  }
  if (grid_blocks < 0) return;
  Params p{};
  for (int i = 0; i < 52; ++i) p.in[i] = (const float*)d_in[i];
  p.out = (float*)d_out;
  p.ws = (unsigned char*)d_ws;
#if MULTI
  for (int ph = 0; ph < NPHASE; ++ph) {
    p.ph_lo = ph; p.ph_hi = ph + 1;
    hipLaunchKernelGGL(fwd_megakernel, dim3(grid_blocks), dim3(256), LDS_BYTES, stream, p);
  }
#else
  p.ph_lo = 0; p.ph_hi = NPHASE;
  void* args[] = {&p};
  hipError_t e = hipLaunchCooperativeKernel((const void*)fwd_megakernel, dim3(grid_blocks), dim3(256), args, LDS_BYTES, stream);
  if (e != hipSuccess) fprintf(stderr, "cooperative launch failed: %s (grid %d)\n", hipGetErrorString(e), grid_blocks);
#endif
}
```

```cpp
#include <hip/hip_runtime.h>
#include <hip/hip_cooperative_groups.h>
#include <cstdio>
namespace cg = cooperative_groups;

#define DI __device__ __forceinline__
typedef unsigned short u16;
typedef unsigned int u32;
using bf16x8 = __attribute__((ext_vector_type(8))) short;
using f32x4 = __attribute__((ext_vector_type(4))) float;
using f32x16 = __attribute__((ext_vector_type(16))) float;
using u32x4 = __attribute__((ext_vector_type(4))) unsigned;
using u32x2 = __attribute__((ext_vector_type(2))) unsigned;
typedef __bf16 bf2_t __attribute__((ext_vector_type(2)));
typedef float f2_t __attribute__((ext_vector_type(2)));

#ifndef MULTI
#define MULTI 0
#endif
#ifndef REP0
#define REP0 1
#endif
#ifndef REP1
#define REP1 1
#endif
#ifndef ZERO_MASK
#define ZERO_MASK 0
#endif

constexpr int T_ALL = 24576, TP = 8192, DM = 2048;
constexpr float LOG2E = 1.4426950408889634f;
constexpr float ALPHA = 1.6817928305074290f;
constexpr float LN_EPS = 1e-5f;
constexpr int LDS_BYTES = 76288;
constexpr int NPHASE = 18;

constexpr size_t SZ_WIN_E = (size_t)6144 * 2048 * 2, SZ_WIN_O = (size_t)7168 * 2048 * 2;
constexpr size_t WS_WINT = 0;
constexpr size_t WS_WOUTT = WS_WINT + 2 * SZ_WIN_E + 2 * SZ_WIN_O;
constexpr size_t WS_POOLWT = WS_WOUTT + (size_t)4 * 2048 * 2048 * 2;
constexpr size_t WS_SGUW = WS_POOLWT + (size_t)2 * 4 * 256 * 256 * 2;
constexpr size_t WS_CK = WS_SGUW + (size_t)2 * 4 * 128 * 128 * 2;
constexpr size_t WS_CVT = WS_CK + (size_t)4 * 4194304;
constexpr size_t WS_MOD = WS_CVT + (size_t)4 * 4194304;
constexpr size_t WS_ROPE = WS_MOD + (size_t)4 * 5 * 6144 * 4;
constexpr size_t WS_H = WS_ROPE + 8192;
constexpr size_t WS_PROJ = WS_H + (size_t)T_ALL * 2048 * 2;
constexpr size_t WS_VT = WS_PROJ + (size_t)T_ALL * 7168 * 2;
constexpr size_t WS_BAR = WS_VT + (size_t)T_ALL * 1024 * 2;
constexpr size_t WS_END = WS_BAR + 16384;

struct Params {
  const float* in[52];
  float* out;
  unsigned char* ws;
  int ph_lo, ph_hi;
};

DI size_t ws_wint(int l) { return WS_WINT + (size_t)(l >> 1) * (SZ_WIN_E + SZ_WIN_O) + ((l & 1) ? SZ_WIN_E : 0); }

DI u32 pk2(float a, float b) { f2_t v = {a, b}; bf2_t r = __builtin_convertvector(v, bf2_t); return __builtin_bit_cast(u32, r); }
DI float bflo(u32 w) { return __uint_as_float(w << 16); }
DI float bfhi(u32 w) { return __uint_as_float(w & 0xffff0000u); }
DI float bf1(u16 w) { return __uint_as_float(((u32)w) << 16); }
DI float ex2(float x) { return __builtin_amdgcn_exp2f(x); }
DI float silu(float x) { return x / (1.f + __expf(-x)); }
DI f32x4 mfma16(bf16x8 a, bf16x8 b, f32x4 c) { return __builtin_amdgcn_mfma_f32_16x16x32_bf16(a, b, c, 0, 0, 0); }
DI f32x16 mfma32(bf16x8 a, bf16x8 b, f32x16 c) { return __builtin_amdgcn_mfma_f32_32x32x16_bf16(a, b, c, 0, 0, 0); }
DI bf16x8 ld8(const u16* p) { return *reinterpret_cast<const bf16x8*>(p); }
DI int opq(int x) { asm volatile("" : "+v"(x)); return x; }
#define TIDX opq((int)threadIdx.x)

DI void tr_tile(const float* __restrict__ src, size_t ld_src, u16* __restrict__ dst, size_t ld_dst, float* sT) {
  const int tid = TIDX;
  const int r = tid >> 4, c4 = (tid & 15) * 4;
#pragma unroll
  for (int i = 0; i < 4; ++i) {
    float4 v = *reinterpret_cast<const float4*>(src + (size_t)(r + 16 * i) * ld_src + c4);
    float* d = sT + (r + 16 * i) * 65 + c4;
    d[0] = v.x; d[1] = v.y; d[2] = v.z; d[3] = v.w;
  }
  __syncthreads();
  const int n = tid >> 2, ks = (tid & 3) * 16;
  u32 w[8];
#pragma unroll
  for (int j = 0; j < 8; ++j) w[j] = pk2(sT[(ks + 2 * j) * 65 + n], sT[(ks + 2 * j + 1) * 65 + n]);
  u32x4* o = reinterpret_cast<u32x4*>(dst + (size_t)n * ld_dst + ks);
  o[0] = u32x4{w[0], w[1], w[2], w[3]};
  o[1] = u32x4{w[4], w[5], w[6], w[7]};
  __syncthreads();
}

DI void cvt8(const float* __restrict__ src, u16* __restrict__ dst) {
  float4 a = *reinterpret_cast<const float4*>(src);
  float4 b = *reinterpret_cast<const float4*>(src + 4);
  *reinterpret_cast<u32x4*>(dst) = u32x4{pk2(a.x, a.y), pk2(a.z, a.w), pk2(b.x, b.y), pk2(b.z, b.w)};
}

DI void mod_item(const Params& p, int i, unsigned char* lds) {
  const int tid = TIDX;
  const int l = i / 96, n0 = (i % 96) * 64;
  float* sS = reinterpret_cast<float*>(lds);
  float* red = sS + 5 * 2048;
  const float* c = p.in[10];
  const float* cctx = p.in[11];
  for (int e = tid; e < 5 * 2048; e += 256) {
    int v = e >> 11, k = e & 2047;
    float x = (v == 0) ? cctx[k] : c[(v - 1) * 2048 + k];
    sS[e] = silu(x);
  }
  __syncthreads();
  const int kk = tid >> 4, c4 = (tid & 15) * 4;
  const float* W = p.in[12 + 10 * l] + n0 + c4;
  f32x4 acc[5];
#pragma unroll
  for (int v = 0; v < 5; ++v) acc[v] = f32x4{0.f, 0.f, 0.f, 0.f};
#pragma unroll 8
  for (int k = kk; k < 2048; k += 16) {
    float4 w = *reinterpret_cast<const float4*>(W + (size_t)k * 6144);
#pragma unroll
    for (int v = 0; v < 5; ++v) {
      float s = sS[v * 2048 + k];
      acc[v][0] += s * w.x; acc[v][1] += s * w.y; acc[v][2] += s * w.z; acc[v][3] += s * w.w;
    }
  }
#pragma unroll
  for (int v = 0; v < 5; ++v)
#pragma unroll
    for (int q = 0; q < 4; ++q) red[(kk * 5 + v) * 64 + c4 + q] = acc[v][q];
  __syncthreads();
  for (int t2 = tid; t2 < 320; t2 += 256) {
    int v = t2 >> 6, n = t2 & 63;
    float s = 0.f;
#pragma unroll
    for (int k2 = 0; k2 < 16; ++k2) s += red[(k2 * 5 + v) * 64 + n];
    float* mod = reinterpret_cast<float*>(p.ws + WS_MOD);
    mod[(size_t)(l * 5 + v) * 6144 + n0 + n] = s + p.in[13 + 10 * l][n0 + n];
  }
  __syncthreads();
}

DI void phase_prep(const Params& p, unsigned char* lds) {
  constexpr int N_MOD = 384, N_TRWIN = 13312, N_TRWOUT = 4096, N_TRPOOL = 128, N_SGU = 64, N_CK = 4096, N_CV = 2048;
  constexpr int TOTAL = N_MOD + N_TRWIN + N_TRWOUT + N_TRPOOL + N_SGU + N_CK + N_CV + 1;
  const int tid = TIDX;
  float* sT = reinterpret_cast<float*>(lds);
  for (int it = blockIdx.x; it < TOTAL; it += gridDim.x) {
    int i = it;
    if (i < N_MOD) { mod_item(p, i, lds); continue; }
    i -= N_MOD;
    if (i < N_TRWIN) {
      int l, base;
      if (i < 3072) { l = 0; base = 0; } else if (i < 6656) { l = 1; base = 3072; } else if (i < 9728) { l = 2; base = 6656; } else { l = 3; base = 9728; }
      i -= base;
      const int N = (l & 1) ? 7168 : 6144, nN = N / 64;
      const int kt = i / nN, nt = i % nN;
      tr_tile(p.in[14 + 10 * l] + (size_t)kt * 64 * N + nt * 64, N,
              reinterpret_cast<u16*>(p.ws + ws_wint(l)) + (size_t)nt * 64 * 2048 + kt * 64, 2048, sT);
      continue;
    }
    i -= N_TRWIN;
    if (i < N_TRWOUT) {
      const int l = i >> 10, r = i & 1023, kt = r >> 5, nt = r & 31;
      tr_tile(p.in[15 + 10 * l] + (size_t)kt * 64 * 2048 + nt * 64, 2048,
              reinterpret_cast<u16*>(p.ws + WS_WOUTT) + (size_t)l * 2048 * 2048 + (size_t)nt * 64 * 2048 + kt * 64, 2048, sT);
      continue;
    }
    i -= N_TRWOUT;
    if (i < N_TRPOOL) {
      const int e = i >> 6, r = i & 63, g = r >> 4, t = r & 15, kt = t >> 2, nt = t & 3;
      tr_tile(p.in[18 + 20 * e] + (size_t)g * 65536 + kt * 64 * 256 + nt * 64, 256,
              reinterpret_cast<u16*>(p.ws + WS_POOLWT) + (size_t)e * 262144 + g * 65536 + nt * 64 * 256 + kt * 64, 256, sT);
      continue;
    }
    i -= N_TRPOOL;
    if (i < N_SGU) {
      const int e = i >> 5, ch = i & 31;
      const size_t off = (size_t)ch * 2048 + tid * 8;
      cvt8(p.in[30 + 20 * e] + off, reinterpret_cast<u16*>(p.ws + WS_SGUW) + (size_t)e * 65536 + off);
      continue;
    }
    i -= N_SGU;
    if (i < N_CK) {
      const int l = i >> 10, ch = i & 1023;
      const size_t off = (size_t)ch * 2048 + tid * 8;
      cvt8(p.in[2 + 2 * l] + off, reinterpret_cast<u16*>(p.ws + WS_CK) + (size_t)l * 2097152 + off);
      continue;
    }
    i -= N_CK;
    if (i < N_CV) {
      const int l = i >> 9, r = i & 511, bh = r >> 4, t = r & 15, kt = t >> 1, nt = t & 1;
      tr_tile(p.in[3 + 2 * l] + (size_t)bh * 65536 + kt * 64 * 128 + nt * 64, 128,
              reinterpret_cast<u16*>(p.ws + WS_CVT) + (size_t)l * 2097152 + (size_t)bh * 65536 + nt * 64 * 512 + kt * 64, 512, sT);
      continue;
    }
    {
      float* rc = reinterpret_cast<float*>(p.ws + WS_ROPE);
      for (int e = tid; e < 1024; e += 256) {
        int pos = e >> 4, fi = e & 15;
        float inv = 1.0f / powf(10000.0f, (float)(2 * fi) / 32.0f);
        float ang = (float)pos * inv;
        rc[e] = cosf(ang);
        rc[1024 + e] = sinf(ang);
      }
    }
  }
}

DI void phase_mod0(const Params& p) {
  const int tid = TIDX;
  const float* mod = reinterpret_cast<const float*>(p.ws + WS_MOD);
  u16* H = reinterpret_cast<u16*>(p.ws + WS_H);
  for (int it = blockIdx.x; it < T_ALL / 4; it += gridDim.x) {
#pragma unroll
    for (int rr = 0; rr < 4; ++rr) {
      const int row = it * 4 + rr;
      const int cond = row < TP ? 0 : 1 + ((row - TP) >> 12);
      const float* src = row < TP ? p.in[0] + (size_t)row * 2048 : p.in[1] + (size_t)(row - TP) * 2048;
      const int e = tid * 8;
      const float* sh = mod + (size_t)cond * 6144 + e;
      float4 a = *reinterpret_cast<const float4*>(src + e), b = *reinterpret_cast<const float4*>(src + e + 4);
      float4 s0 = *reinterpret_cast<const float4*>(sh), s1 = *reinterpret_cast<const float4*>(sh + 4);
      float4 c0 = *reinterpret_cast<const float4*>(sh + 2048), c1 = *reinterpret_cast<const float4*>(sh + 2052);
      u32x4 o = {pk2(a.x * (1.f + c0.x) + s0.x, a.y * (1.f + c0.y) + s0.y), pk2(a.z * (1.f + c0.z) + s0.z, a.w * (1.f + c0.w) + s0.w),
                 pk2(b.x * (1.f + c1.x) + s1.x, b.y * (1.f + c1.y) + s1.y), pk2(b.z * (1.f + c1.z) + s1.z, b.w * (1.f + c1.w) + s1.w)};
      *reinterpret_cast<u32x4*>(H + (size_t)row * 2048 + e) = o;
    }
  }
}

enum { G_IN_EVEN = 0, G_IN_ODD = 1, G_OUT = 2 };

template <bool TR>
DI void gemm_tile(const u16* ga, const u16* gb, u16* sA, u16* sB, int tid, int wr, int wc, int fr, int fo0, int fo1, f32x4 (&acc)[4][4]) {
  constexpr int K = 2048;
#pragma unroll
  for (int a = 0; a < 4; ++a)
#pragma unroll
    for (int b = 0; b < 4; ++b) acc[a][b] = f32x4{0.f, 0.f, 0.f, 0.f};
#define GSTAGE(B_, KT_)                                                                                                   \
  _Pragma("unroll") for (int i = 0; i < 4; ++i) {                                                                         \
    __builtin_amdgcn_global_load_lds((const unsigned*)(ga + (size_t)i * 32 * K + (KT_) * 64),                             \
                                     (unsigned*)(sA + (B_) * 8192 + i * 2048 + tid * 8), 16, 0, 0);                       \
    __builtin_amdgcn_global_load_lds((const unsigned*)(gb + (size_t)i * 32 * K + (KT_) * 64),                             \
                                     (unsigned*)(sB + (B_) * 8192 + i * 2048 + tid * 8), 16, 0, 0);                       \
  }
  GSTAGE(0, 0)
  asm volatile("s_waitcnt vmcnt(0)" ::: "memory");
  __syncthreads();
  for (int kt = 0; kt < K / 64; ++kt) {
    const int buf = kt & 1;
    if (kt + 1 < K / 64) { GSTAGE(buf ^ 1, kt + 1) }
    const u16* cA = sA + buf * 8192 + (wr * 64 + fr) * 64;
    const u16* cB = sB + buf * 8192 + (wc * 64 + fr) * 64;
#pragma unroll
    for (int ks = 0; ks < 2; ++ks) {
      const int fo = ks ? fo1 : fo0;
      bf16x8 af[4], bfr[4];
#pragma unroll
      for (int m = 0; m < 4; ++m) af[m] = ld8(cA + m * 1024 + fo);
#pragma unroll
      for (int n = 0; n < 4; ++n) bfr[n] = ld8(cB + n * 1024 + fo);
#pragma unroll
      for (int m = 0; m < 4; ++m)
#pragma unroll
        for (int n = 0; n < 4; ++n) acc[m][n] = TR ? mfma16(bfr[n], af[m], acc[m][n]) : mfma16(af[m], bfr[n], acc[m][n]);
    }
    asm volatile("s_waitcnt vmcnt(0)" ::: "memory");
    __syncthreads();
  }
#undef GSTAGE
}

template <int MODE>
DI void gemm_phase(const Params& p, int l, unsigned char* lds) {
  constexpr int K = 2048;
  constexpr int N = (MODE == G_OUT) ? 2048 : (MODE == G_IN_EVEN ? 6144 : 7168);
  constexpr int NC = (MODE == G_IN_EVEN) ? 6144 : 7168;
  constexpr int nTn = N / 128;
  constexpr int TOTAL = nTn * 192;
  const u16* A = reinterpret_cast<const u16*>(p.ws + WS_H);
  const u16* Bt = (MODE == G_OUT) ? reinterpret_cast<const u16*>(p.ws + WS_WOUTT) + (size_t)l * 2048 * 2048
                                  : reinterpret_cast<const u16*>(p.ws + ws_wint(l));
  u16* sA = reinterpret_cast<u16*>(lds);
  u16* sB = sA + 2 * 128 * 64;
  const int tid = TIDX, lane = tid & 63, wid = tid >> 6;
  const int wr = wid >> 1, wc = wid & 1, fr = lane & 15, fq = lane >> 4;
  const int lrow = tid >> 3;
  const int csrc = ((tid & 7) ^ ((lrow >> 1) & 7)) * 8;
  const int swz = (fr >> 1) & 7;
  const int fo0 = (fq ^ swz) * 8, fo1 = ((4 + fq) ^ swz) * 8;
  u16* PROJ = reinterpret_cast<u16*>(p.ws + WS_PROJ);
  u16* VT = reinterpret_cast<u16*>(p.ws + WS_VT);
  const float* mod = reinterpret_cast<const float*>(p.ws + WS_MOD);
  const float* ropeC = reinterpret_cast<const float*>(p.ws + WS_ROPE);
  const float* ropeS = ropeC + 1024;

  for (int it = blockIdx.x; it < TOTAL; it += gridDim.x) {
    constexpr int PN = nTn / 8;
    const int rnd = it >> 9, vb = it & 511, q = rnd * 8 + (vb & 7), jj = vb >> 3;
    const int tm = (q / PN) * 8 + (jj & 7), tn = (q % PN) * 8 + (jj >> 3);
    const u16* ga = A + (size_t)(tm * 128 + lrow) * K + csrc;
    const u16* gb = Bt + (size_t)(tn * 128 + lrow) * K + csrc;
    f32x4 acc[4][4];
    const bool prompt = tm < 64;
    const int R0 = tm * 128 + wr * 64, C0 = tn * 128 + wc * 64;
    if (MODE == G_OUT) {
      gemm_tile<true>(ga, gb, sA, sB, tid, wr, wc, fr, fo0, fo1, acc);
      const int cond = prompt ? 0 : 1 + ((tm * 128 - TP) >> 12);
      const float* gate = mod + (size_t)(l * 5 + cond) * 6144 + 4096;
      float* X = p.out;
#pragma unroll
      for (int n = 0; n < 4; ++n) {
        const int col = C0 + n * 16 + 4 * fq;
        const float4 g4 = *reinterpret_cast<const float4*>(gate + col);
#pragma unroll
        for (int m = 0; m < 4; ++m) {
          const int row = R0 + m * 16 + fr;
          float4 xo;
          if (l == 0) xo = prompt ? *reinterpret_cast<const float4*>(p.in[0] + (size_t)row * 2048 + col)
                                  : *reinterpret_cast<const float4*>(p.in[1] + (size_t)(row - TP) * 2048 + col);
          else xo = *reinterpret_cast<const float4*>(X + (size_t)row * 2048 + col);
          float4 o;
          o.x = ALPHA * xo.x + g4.x * acc[m][n][0]; o.y = ALPHA * xo.y + g4.y * acc[m][n][1];
          o.z = ALPHA * xo.z + g4.z * acc[m][n][2]; o.w = ALPHA * xo.w + g4.w * acc[m][n][3];
          *reinterpret_cast<float4*>(X + (size_t)row * 2048 + col) = o;
        }
      }
    } else {
      const int sec = tn >> 3;
      const int SEC_Q = (MODE == G_IN_EVEN) ? 2 : 0, SEC_K = (MODE == G_IN_EVEN) ? 3 : 1, SEC_V = (MODE == G_IN_EVEN) ? 4 : 2;
      if (sec == SEC_V) {
        gemm_tile<false>(ga, gb, sA, sB, tid, wr, wc, fr, fo0, fo1, acc);
        const int rowb = R0 + fq * 4;
        const int hh = tn & 7;
        float* vout = p.out + (size_t)T_ALL * 2048 + (size_t)(2 * l + 1) * 8388608;
#pragma unroll
        for (int m = 0; m < 4; ++m) {
          const int row = rowb + m * 16;
#pragma unroll
          for (int n = 0; n < 4; ++n) {
            const int dv = wc * 64 + n * 16 + fr;
            u32x2 w = {pk2(acc[m][n][0], acc[m][n][1]), pk2(acc[m][n][2], acc[m][n][3])};
            if (prompt) {
              const int b = row >> 8, t = row & 255;
              *reinterpret_cast<u32x2*>(VT + ((size_t)((b * 8 + hh) * 128 + dv)) * 256 + t) = w;
#pragma unroll
              for (int j = 0; j < 4; ++j) vout[((size_t)((b * 8 + hh) * 256 + t + j)) * 128 + dv] = acc[m][n][j];
            } else {
              const int rs = row - TP, b = rs >> 12, t = rs & 4095;
              *reinterpret_cast<u32x2*>(VT + 8388608 + ((size_t)((b * 8 + hh) * 128 + dv)) * 4096 + t) = w;
            }
          }
        }
      } else {
        gemm_tile<true>(ga, gb, sA, sB, tid, wr, wc, fr, fo0, fo1, acc);
        const bool isq = sec == SEC_Q, isk = sec == SEC_K;
        const bool rope = (MODE == G_IN_EVEN) && (isq || isk) && !prompt;
        const float qs = (MODE == G_IN_EVEN) ? 0.125f * LOG2E : 0.08838834764831845f * LOG2E;
        if (isk && prompt) {
          const int hh = tn & 7;
          float* kout = p.out + (size_t)T_ALL * 2048 + (size_t)(2 * l) * 8388608;
#pragma unroll
          for (int m = 0; m < 4; ++m) {
            const int row = R0 + m * 16 + fr, b = row >> 8, t = row & 255;
#pragma unroll
            for (int n = 0; n < 4; ++n) {
              const int d = wc * 64 + n * 16 + 4 * fq;
              *reinterpret_cast<float4*>(kout + ((size_t)((b * 8 + hh) * 256 + t)) * 128 + d) =
                  float4{acc[m][n][0], acc[m][n][1], acc[m][n][2], acc[m][n][3]};
            }
          }
        }
        if (rope) {
#pragma unroll
          for (int m = 0; m < 4; ++m) {
            const int t = (R0 + m * 16 + fr - TP) & 4095;
#pragma unroll
            for (int ax = 0; ax < 2; ++ax) {
              const int pos = ax ? (t & 63) : (t >> 6);
              const float4 cs = *reinterpret_cast<const float4*>(ropeC + pos * 16 + 4 * fq);
              const float4 sn = *reinterpret_cast<const float4*>(ropeS + pos * 16 + 4 * fq);
              const float c4[4] = {cs.x, cs.y, cs.z, cs.w}, s4[4] = {sn.x, sn.y, sn.z, sn.w};
#pragma unroll
              for (int j = 0; j < 4; ++j) {
                const float x1 = acc[m][2 * ax][j], x2 = acc[m][2 * ax + 1][j];
                acc[m][2 * ax][j] = x1 * c4[j] - x2 * s4[j];
                acc[m][2 * ax + 1][j] = x1 * s4[j] + x2 * c4[j];
              }
            }
          }
        }
        const float sc = isq ? qs : 1.0f;
#pragma unroll
        for (int m = 0; m < 4; ++m) {
          const int row = R0 + m * 16 + fr;
#pragma unroll
          for (int n = 0; n < 4; ++n) {
            const int col = C0 + n * 16 + 4 * fq;
            *reinterpret_cast<u32x2*>(PROJ + (size_t)row * NC + col) =
                u32x2{pk2(acc[m][n][0] * sc, acc[m][n][1] * sc), pk2(acc[m][n][2] * sc, acc[m][n][3] * sc)};
          }
        }
      }
    }
  }
}

DI void phase_ln(const Params& p, int l) {
  const int tid_ = TIDX, lane = tid_ & 63, wid = tid_ >> 6;
  const float* g = p.in[16 + 10 * l];
  const float* bb = p.in[17 + 10 * l];
  const float* mod = reinterpret_cast<const float*>(p.ws + WS_MOD);
  u16* H = reinterpret_cast<u16*>(p.ws + WS_H);
  float* X = p.out;
  for (int it = blockIdx.x; it < T_ALL / 4; it += gridDim.x) {
    const int row = it * 4 + wid;
    float* xr = X + (size_t)row * 2048;
    float4 v[8];
    float s = 0.f;
#pragma unroll
    for (int i = 0; i < 8; ++i) {
      v[i] = *reinterpret_cast<const float4*>(xr + (i * 64 + lane) * 4);
      s += v[i].x + v[i].y + v[i].z + v[i].w;
    }
#pragma unroll
    for (int o = 32; o >= 1; o >>= 1) s += __shfl_xor(s, o);
    const float mu = s * (1.f / 2048.f);
    float ss = 0.f;
#pragma unroll
    for (int i = 0; i < 8; ++i) {
      float a = v[i].x - mu, b = v[i].y - mu, c = v[i].z - mu, d = v[i].w - mu;
      ss += a * a + b * b + c * c + d * d;
    }
#pragma unroll
    for (int o = 32; o >= 1; o >>= 1) ss += __shfl_xor(ss, o);
    const float rstd = rsqrtf(ss * (1.f / 2048.f) + LN_EPS);
    const int cond = row < TP ? 0 : 1 + ((row - TP) >> 12);
    const float* sh = mod + (size_t)((l + 1) * 5 + cond) * 6144;
#pragma unroll
    for (int i = 0; i < 8; ++i) {
      const int e = (i * 64 + lane) * 4;
      float4 gg = *reinterpret_cast<const float4*>(g + e), b4 = *reinterpret_cast<const float4*>(bb + e);
      float4 y;
      y.x = (v[i].x - mu) * rstd * gg.x + b4.x; y.y = (v[i].y - mu) * rstd * gg.y + b4.y;
      y.z = (v[i].z - mu) * rstd * gg.z + b4.z; y.w = (v[i].w - mu) * rstd * gg.w + b4.w;
      *reinterpret_cast<float4*>(xr + e) = y;
      if (l < 3) {
        float4 s0 = *reinterpret_cast<const float4*>(sh + e), c0 = *reinterpret_cast<const float4*>(sh + 2048 + e);
        u32x2 o = {pk2(y.x * (1.f + c0.x) + s0.x, y.y * (1.f + c0.y) + s0.y), pk2(y.z * (1.f + c0.z) + s0.z, y.w * (1.f + c0.w) + s0.w)};
        *reinterpret_cast<u32x2*>(H + (size_t)row * 2048 + e) = o;
      }
    }
  }
}

struct AttnSrc {
  const u16* k0; const u16* vt0; int ks0, vs0, n0;
  const u16* k1; const u16* vt1; int ks1, vs1, n1;
};

template <int DQK>
DI void attn_ldg(const AttnSrc& s, int j, u32x4 (&rk)[DQK / 32], u32x4 (&rv)[4]) {
  const u16* kb; const u16* vb; int ks, vs;
  if (j < s.n0) { kb = s.k0 + (size_t)j * 64 * s.ks0; vb = s.vt0 + j * 64; ks = s.ks0; vs = s.vs0; }
  else { const int jj = j - s.n0; kb = s.k1 + (size_t)jj * 64 * s.ks1; vb = s.vt1 + jj * 64; ks = s.ks1; vs = s.vs1; }
  constexpr int CPR = DQK / 8;
  const int tid = TIDX;
#pragma unroll
  for (int i = 0; i < DQK / 32; ++i) {
    const int c = tid + 256 * i, row = c / CPR, kc = c % CPR;
    rk[i] = *reinterpret_cast<const u32x4*>(kb + (size_t)row * ks + kc * 8);
  }
#pragma unroll
  for (int i = 0; i < 4; ++i) {
    const int c = tid + 256 * i, row = c >> 3, kc = c & 7;
    rv[i] = *reinterpret_cast<const u32x4*>(vb + (size_t)row * vs + kc * 8);
  }
}
template <int DQK>
DI void attn_sts(u16* sK, u16* sVT, const u32x4 (&rk)[DQK / 32], const u32x4 (&rv)[4]) {
  constexpr int CPR = DQK / 8;
  const int tid = TIDX;
#pragma unroll
  for (int i = 0; i < DQK / 32; ++i) {
    const int c = tid + 256 * i, row = c / CPR, kc = c % CPR;
    *reinterpret_cast<u32x4*>(sK + row * (DQK + 8) + kc * 8) = rk[i];
  }
#pragma unroll
  for (int i = 0; i < 4; ++i) {
    const int c = tid + 256 * i, row = c >> 3, kc = c & 7;
    *reinterpret_cast<u32x4*>(sVT + row * 72 + kc * 8) = rv[i];
  }
}

template <int DQK, bool NA>
DI void attn_run(const AttnSrc& src, const u16* qblk, int qstride, u16* sQ, u16* sK, u16* sVT, f32x16 (&O)[4], float& l_out,
                 int qr, int qc, int rsmin, const float* sBias) {
  const int tid = TIDX, lane = tid & 63, wid = tid >> 6;
  const int r = lane & 31, h = lane >> 5;
  const int pr = (r & 0x13) | ((r & 4) << 1) | ((r & 8) >> 1);
  constexpr int CPR = DQK / 8, QS = DQK + 8;
  constexpr bool DB = (DQK == 64);
  __syncthreads();
  bf16x8 qf[DB ? DQK / 16 : 1];
  if constexpr (DB) {
#pragma unroll
    for (int ks = 0; ks < DQK / 16; ++ks) qf[ks] = ld8(qblk + (size_t)(wid * 32 + r) * qstride + ks * 16 + 8 * h);
  } else {
#pragma unroll
    for (int i = 0; i < DQK / 16; ++i) {
      const int c = tid + 256 * i, row = c / CPR, kc = c % CPR;
      *reinterpret_cast<u32x4*>(sQ + row * QS + kc * 8) = *reinterpret_cast<const u32x4*>(qblk + (size_t)row * qstride + kc * 8);
    }
  }
#pragma unroll
  for (int d = 0; d < 4; ++d)
#pragma unroll
    for (int i = 0; i < 16; ++i) O[d][i] = 0.f;
  float m = -1e30f, l = 0.f;
  const int nt = src.n0 + src.n1;
  const int rsq = min(max(qr - 4, 0), 56);
  const int cs = min(max(qc - 8, 0), 48);
  const u16* qw = sQ + (wid * 32 + r) * QS + 8 * h;
  u16* sK1 = sQ;
  u16* sVT1 = sQ + 64 * QS;
  u32x4 rk[DQK / 32], rv[4];
  attn_ldg<DQK>(src, 0, rk, rv);
  if constexpr (DB) {
    attn_sts<DQK>(sK, sVT, rk, rv);
    if (nt > 1) attn_ldg<DQK>(src, 1, rk, rv);
    __syncthreads();
  }
#pragma unroll 1
  for (int j = 0; j < nt; ++j) {
    const u16* kw;
    const u16* vw;
    if constexpr (DB) {
      const int cur = j & 1;
      if (j + 1 < nt) { if (cur) attn_sts<DQK>(sK, sVT, rk, rv); else attn_sts<DQK>(sK1, sVT1, rk, rv); }
      if (j + 2 < nt) attn_ldg<DQK>(src, j + 2, rk, rv);
      kw = (cur ? sK1 : sK) + pr * QS + 8 * h;
      vw = (cur ? sVT1 : sVT) + r * 72 + 8 * h;
    } else {
      if (j > 0) __syncthreads();
      attn_sts<DQK>(sK, sVT, rk, rv);
      __syncthreads();
      if (j + 1 < nt) attn_ldg<DQK>(src, j + 1, rk, rv);
      kw = sK + pr * QS + 8 * h;
      vw = sVT + r * 72 + 8 * h;
    }
    __builtin_amdgcn_sched_barrier(0);
    bool active = true;
    int kr = 0;
    if (NA && j >= src.n0) { kr = rsmin + (j - src.n0); active = (kr >= rsq) && (kr < rsq + 8); }
    if (active) {
      f32x16 s[2];
      __builtin_amdgcn_s_setprio(1);
#pragma unroll
      for (int t = 0; t < 2; ++t) {
#pragma unroll
        for (int i = 0; i < 16; ++i) s[t][i] = 0.f;
#pragma unroll
        for (int ks = 0; ks < DQK / 16; ++ks) {
          bf16x8 a = ld8(kw + t * 32 * QS + ks * 16);
          bf16x8 q;
          if constexpr (DB) q = qf[ks]; else q = ld8(qw + ks * 16);
          s[t] = mfma32(a, q, s[t]);
        }
      }
      __builtin_amdgcn_s_setprio(0);
      if (NA && j >= src.n0) {
        const float* bp = sBias + (kr - qr + 7) * 31 + (8 * h - qc + 15);
        const int kb = 8 * h - cs;
#pragma unroll
        for (int t = 0; t < 2; ++t)
#pragma unroll
          for (int i = 0; i < 16; ++i) {
            const int ko = t * 32 + 16 * (i >> 3) + (i & 7);
            const bool ok = (unsigned)(ko + kb) < 16u;
            const float bv = bp[ko];
            s[t][i] = ok ? s[t][i] + bv : -1e30f;
          }
      }
      float mx = -1e30f;
#pragma unroll
      for (int t = 0; t < 2; ++t)
#pragma unroll
        for (int i = 0; i < 16; ++i) mx = fmaxf(mx, s[t][i]);
      mx = fmaxf(mx, __shfl_xor(mx, 32));
      if (__builtin_amdgcn_ballot_w64(mx > m + 8.0f) != 0ull) {
        const float mn = fmaxf(m, mx);
        const float alpha = ex2(m - mn);
        l *= alpha;
        m = mn;
#pragma unroll
        for (int d = 0; d < 4; ++d)
#pragma unroll
          for (int i = 0; i < 16; ++i) O[d][i] *= alpha;
      }
      float rsum = 0.f;
#pragma unroll
      for (int t = 0; t < 2; ++t)
#pragma unroll
        for (int i = 0; i < 16; ++i) { const float e = ex2(s[t][i] - m); s[t][i] = e; rsum += e; }
      rsum += __shfl_xor(rsum, 32);
      l += rsum;
      __builtin_amdgcn_s_setprio(1);
#pragma unroll
      for (int s4 = 0; s4 < 4; ++s4) {
        const int t = s4 >> 1, b0 = (s4 & 1) * 8;
        u32x4 w = {pk2(s[t][b0], s[t][b0 + 1]), pk2(s[t][b0 + 2], s[t][b0 + 3]), pk2(s[t][b0 + 4], s[t][b0 + 5]), pk2(s[t][b0 + 6], s[t][b0 + 7])};
        const bf16x8 pf = __builtin_bit_cast(bf16x8, w);
#pragma unroll
        for (int d = 0; d < 4; ++d) {
          bf16x8 a = ld8(vw + d * 32 * 72 + s4 * 16);
          O[d] = mfma32(a, pf, O[d]);
        }
      }
      __builtin_amdgcn_s_setprio(0);
    }
    if constexpr (DB) __syncthreads();
  }
  l_out = l;
}

DI void heavy_map(int it, int& bh, int& qb) { const int x = it & 7, idx = it >> 3; bh = x + 8 * (idx >> 5); qb = idx & 31; }

DI void diff_item(const Params& p, int l, bool sample, int bh, int qb, unsigned char* lds) {
  constexpr int NC = 6144;
  const int tid_ = TIDX, lane = tid_ & 63, wid = tid_ >> 6, r = lane & 31, h = lane >> 5;
  const int b = bh >> 3, hd = bh & 7;
  u16* sQ = reinterpret_cast<u16*>(lds);
  u16* sK = sQ + 128 * 136;
  u16* sVT = sK + 64 * 136;
  const u16* PROJ = reinterpret_cast<const u16*>(p.ws + WS_PROJ);
  const u16* VT = reinterpret_cast<const u16*>(p.ws + WS_VT);
  const int seq0 = sample ? TP + b * 4096 : b * 256;
  const int token = seq0 + qb * 128 + wid * 32 + r;
  const float* dl = p.in[20 + 10 * l];
  float pa = dl[lane] * dl[64 + lane], pb = dl[128 + lane] * dl[192 + lane];
#pragma unroll
  for (int o = 32; o >= 1; o >>= 1) { pa += __shfl_xor(pa, o); pb += __shfl_xor(pb, o); }
  const float lam_init = 0.8f - 0.6f * __expf(-0.3f * (float)l);
  const float lam = __expf(pa) - __expf(pb) + lam_init;

  u32 o1p[32];
  f32x16 O[4];
  float lsum;
#pragma unroll
  for (int comp = 0; comp < 2; ++comp) {
    AttnSrc s;
    if (sample) {
      s.k0 = reinterpret_cast<const u16*>(p.ws + WS_CK) + (size_t)l * 2097152 + (size_t)bh * 65536 + comp * 64; s.ks0 = 128;
      s.vt0 = reinterpret_cast<const u16*>(p.ws + WS_CVT) + (size_t)l * 2097152 + (size_t)bh * 65536; s.vs0 = 512; s.n0 = 8;
      s.k1 = PROJ + (size_t)seq0 * NC + 3072 + hd * 128 + comp * 64; s.ks1 = NC;
      s.vt1 = VT + 8388608 + (size_t)bh * 128 * 4096; s.vs1 = 4096; s.n1 = 64;
    } else {
      s.k0 = nullptr; s.vt0 = nullptr; s.ks0 = 0; s.vs0 = 0; s.n0 = 0;
      s.k1 = PROJ + (size_t)seq0 * NC + 3072 + hd * 128 + comp * 64; s.ks1 = NC;
      s.vt1 = VT + (size_t)bh * 128 * 256; s.vs1 = 256; s.n1 = 4;
    }
    const u16* qblk = PROJ + (size_t)(seq0 + qb * 128) * NC + 2048 + hd * 128 + comp * 64;
    attn_run<64, false>(s, qblk, NC, sQ, sK, sVT, O, lsum, 0, 0, 0, nullptr);
    const float inv = 1.f / lsum;
    if (comp == 0) {
#pragma unroll
      for (int d = 0; d < 4; ++d)
#pragma unroll
        for (int i = 0; i < 8; ++i) o1p[d * 8 + i] = pk2(O[d][2 * i] * inv, O[d][2 * i + 1] * inv);
    } else {
      float ssq = 0.f;
#pragma unroll
      for (int d = 0; d < 4; ++d)
#pragma unroll
        for (int i = 0; i < 8; ++i) {
          const u32 w = o1p[d * 8 + i];
          const float a = bflo(w) - lam * O[d][2 * i] * inv, c = bfhi(w) - lam * O[d][2 * i + 1] * inv;
          O[d][2 * i] = a; O[d][2 * i + 1] = c;
          ssq += a * a + c * c;
        }
      ssq += __shfl_xor(ssq, 32);
      const float rn = rsqrtf(ssq * (1.f / 128.f) + LN_EPS) * (1.f - lam_init);
      const float* subln = p.in[21 + 10 * l];
      const u16* gp = PROJ + (size_t)token * NC + 5120 + hd * 128;
      u16* yp = reinterpret_cast<u16*>(p.ws + WS_H) + (size_t)token * 2048 + 1024 + hd * 128;
#pragma unroll
      for (int d = 0; d < 4; ++d)
#pragma unroll
        for (int q = 0; q < 4; ++q) {
          const int dv = d * 32 + 8 * q + 4 * h;
          const u32x2 gw = *reinterpret_cast<const u32x2*>(gp + dv);
          const float4 sl = *reinterpret_cast<const float4*>(subln + dv);
          const float y0 = O[d][4 * q] * rn * sl.x * silu(bflo(gw[0]));
          const float y1 = O[d][4 * q + 1] * rn * sl.y * silu(bfhi(gw[0]));
          const float y2 = O[d][4 * q + 2] * rn * sl.z * silu(bflo(gw[1]));
          const float y3 = O[d][4 * q + 3] * rn * sl.w * silu(bfhi(gw[1]));
          *reinterpret_cast<u32x2*>(yp + dv) = (ZERO_MASK & 2) ? u32x2{0u, 0u} : u32x2{pk2(y0, y1), pk2(y2, y3)};
        }
    }
  }
}

DI void pool_item(const Params& p, int l, int pi, unsigned char* lds) {
  constexpr int NC = 6144;
  const int tid = TIDX, lane = tid & 63, wid = tid >> 6, fr = lane & 15, fq = lane >> 4;
  const int tb = pi >> 2, g = pi & 3, row0 = tb * 64;
  const int L = row0 < TP ? 256 : 4096;
  const int t0 = row0 < TP ? (row0 & 255) : ((row0 - TP) & 4095);
  u16* sIn = reinterpret_cast<u16*>(lds);
  u16* sP = sIn + 80 * 264;
  const u16* PROJ = reinterpret_cast<const u16*>(p.ws + WS_PROJ);
  __syncthreads();
#pragma unroll
  for (int i = 0; i < 10; ++i) {
    const int c = tid + 256 * i, rr = c >> 5, oc = c & 31;
    const int t = t0 - 8 + rr;
    u32x4 v = {0u, 0u, 0u, 0u};
    if (t >= 0 && t < L) v = *reinterpret_cast<const u32x4*>(PROJ + (size_t)(row0 - 8 + rr) * NC + g * 256 + oc * 8);
    *reinterpret_cast<u32x4*>(sIn + rr * 264 + oc * 8) = v;
  }
  __syncthreads();
  {
    const int oc = tid & 31, seg = tid >> 5;
    const int half = 1 << g;
#pragma unroll 1
    for (int tt = 0; tt < 8; ++tt) {
      const int tl = seg * 8 + tt, t = t0 + tl;
      const int lo = max(t - half, 0), hi = min(t + half, L);
      float a[8];
#pragma unroll
      for (int k = 0; k < 8; ++k) a[k] = 0.f;
      for (int s = lo; s < hi; ++s) {
        const u32x4 v = *reinterpret_cast<const u32x4*>(sIn + (s - t0 + 8) * 264 + oc * 8);
#pragma unroll
        for (int k = 0; k < 4; ++k) { a[2 * k] += bflo(v[k]); a[2 * k + 1] += bfhi(v[k]); }
      }
      const float ic = 1.f / (float)(hi - lo);
      const u32x4 x = *reinterpret_cast<const u32x4*>(sIn + (tl + 8) * 264 + oc * 8);
      u32x4 o;
#pragma unroll
      for (int k = 0; k < 4; ++k) o[k] = pk2(a[2 * k] * ic - bflo(x[k]), a[2 * k + 1] * ic - bfhi(x[k]));
      *reinterpret_cast<u32x4*>(sP + tl * 264 + oc * 8) = o;
    }
  }
  __syncthreads();
  const u16* W = reinterpret_cast<const u16*>(p.ws + WS_POOLWT) + (size_t)(l >> 1) * 262144 + (size_t)g * 65536;
  f32x4 acc[4][4];
#pragma unroll
  for (int a = 0; a < 4; ++a)
#pragma unroll
    for (int b = 0; b < 4; ++b) acc[a][b] = f32x4{0.f, 0.f, 0.f, 0.f};
#pragma unroll 2
  for (int ks = 0; ks < 8; ++ks) {
    bf16x8 af[4], bfr[4];
#pragma unroll
    for (int m = 0; m < 4; ++m) af[m] = ld8(sP + (m * 16 + fr) * 264 + ks * 32 + fq * 8);
#pragma unroll
    for (int n = 0; n < 4; ++n) bfr[n] = ld8(W + (size_t)(wid * 64 + n * 16 + fr) * 256 + ks * 32 + fq * 8);
#pragma unroll
    for (int m = 0; m < 4; ++m)
#pragma unroll
      for (int n = 0; n < 4; ++n) acc[m][n] = mfma16(bfr[n], af[m], acc[m][n]);
  }
  const float* pscale = p.in[19 + 10 * l];
  u16* Y = reinterpret_cast<u16*>(p.ws + WS_H);
#pragma unroll
  for (int n = 0; n < 4; ++n) {
    const int col = g * 256 + wid * 64 + n * 16 + 4 * fq;
    const float4 sc = *reinterpret_cast<const float4*>(pscale + col);
#pragma unroll
    for (int m = 0; m < 4; ++m) {
      const int row = row0 + m * 16 + fr;
      const u32x2 gw = *reinterpret_cast<const u32x2*>(PROJ + (size_t)row * NC + 1024 + col);
      float y0 = acc[m][n][0] * sc.x * silu(bflo(gw[0])), y1 = acc[m][n][1] * sc.y * silu(bfhi(gw[0]));
      float y2 = acc[m][n][2] * sc.z * silu(bflo(gw[1])), y3 = acc[m][n][3] * sc.w * silu(bfhi(gw[1]));
      if (ZERO_MASK & 1) { y0 = y1 = y2 = y3 = 0.f; }
      *reinterpret_cast<u32x2*>(Y + (size_t)row * 2048 + col) = u32x2{pk2(y0, y1), pk2(y2, y3)};
    }
  }
}

DI void phase_mix_even(const Params& p, int l, unsigned char* lds) {
#pragma unroll 1
  for (int it = blockIdx.x; it < 1024; it += gridDim.x) { int bh, qb; heavy_map(it, bh, qb); diff_item(p, l, true, bh, qb, lds); }
#pragma unroll 1
  for (int it = blockIdx.x; it < 512; it += gridDim.x) diff_item(p, l, false, it >> 1, it & 1, lds);
#pragma unroll 1
  for (int it = blockIdx.x; it < 1536; it += gridDim.x) pool_item(p, l, it, lds);
}

DI void na_item(const Params& p, int l, bool sample, int bh, int qb, unsigned char* lds) {
  constexpr int NC = 7168;
  const int tid = TIDX, lane = tid & 63, wid = tid >> 6, r = lane & 31, h = lane >> 5;
  const int b = bh >> 3, hd = bh & 7;
  u16* sQ = reinterpret_cast<u16*>(lds);
  u16* sK = sQ + 128 * 136;
  u16* sVT = sK + 64 * 136;
  float* sBias = reinterpret_cast<float*>(sVT + 128 * 72) + 64;
  const u16* PROJ = reinterpret_cast<const u16*>(p.ws + WS_PROJ);
  const u16* VT = reinterpret_cast<const u16*>(p.ws + WS_VT);
  const int seq0 = sample ? TP + b * 4096 : b * 256;
  const int token = seq0 + qb * 128 + wid * 32 + r;
  AttnSrc s;
  int qr = 0, qc = 0, rsmin = 0;
  f32x16 O[4];
  float lsum;
  const u16* qblk = PROJ + (size_t)(seq0 + qb * 128) * NC + hd * 128;
  if (sample) {
    __syncthreads();
    const float* rpb = p.in[18 + 10 * l] + hd * 465;
    for (int e = tid; e < 465; e += 256) sBias[e] = rpb[e] * LOG2E;
    const int r0 = qb * 2;
    qr = r0 + (wid >> 1); qc = (wid & 1) * 32 + r;
    rsmin = min(max(r0 - 4, 0), 56);
    const int rs1 = min(max(r0 - 3, 0), 56);
    s.k0 = reinterpret_cast<const u16*>(p.ws + WS_CK) + (size_t)l * 2097152 + (size_t)bh * 65536; s.ks0 = 128;
    s.vt0 = reinterpret_cast<const u16*>(p.ws + WS_CVT) + (size_t)l * 2097152 + (size_t)bh * 65536; s.vs0 = 512; s.n0 = 8;
    s.k1 = PROJ + (size_t)(seq0 + rsmin * 64) * NC + 1024 + hd * 128; s.ks1 = NC;
    s.vt1 = VT + 8388608 + (size_t)bh * 128 * 4096 + rsmin * 64; s.vs1 = 4096; s.n1 = rs1 + 8 - rsmin;
    attn_run<128, true>(s, qblk, NC, sQ, sK, sVT, O, lsum, qr, qc, rsmin, sBias);
  } else {
    s.k0 = nullptr; s.vt0 = nullptr; s.ks0 = 0; s.vs0 = 0; s.n0 = 0;
    s.k1 = PROJ + (size_t)seq0 * NC + 1024 + hd * 128; s.ks1 = NC;
    s.vt1 = VT + (size_t)bh * 128 * 256; s.vs1 = 256; s.n1 = 4;
    attn_run<128, false>(s, qblk, NC, sQ, sK, sVT, O, lsum, 0, 0, 0, nullptr);
  }
  const float inv = 1.f / lsum;
  const u16* gp = PROJ + (size_t)token * NC + 3072 + hd * 128;
  u16* yp = reinterpret_cast<u16*>(p.ws + WS_H) + (size_t)token * 2048 + hd * 128;
#pragma unroll
  for (int d = 0; d < 4; ++d)
#pragma unroll
    for (int q = 0; q < 4; ++q) {
      const int dv = d * 32 + 8 * q + 4 * h;
      const u32x2 gw = *reinterpret_cast<const u32x2*>(gp + dv);
      const float y0 = O[d][4 * q] * inv * silu(bflo(gw[0]));
      const float y1 = O[d][4 * q + 1] * inv * silu(bfhi(gw[0]));
      const float y2 = O[d][4 * q + 2] * inv * silu(bflo(gw[1]));
      const float y3 = O[d][4 * q + 3] * inv * silu(bfhi(gw[1]));
      *reinterpret_cast<u32x2*>(yp + dv) = (ZERO_MASK & 4) ? u32x2{0u, 0u} : u32x2{pk2(y0, y1), pk2(y2, y3)};
    }
}

DI void sgu_item(const Params& p, int l, int si, unsigned char* lds) {
  constexpr int NC = 7168;
  const int tid = TIDX, lane = tid & 63, wid = tid >> 6, fr = lane & 15, fq = lane >> 4;
  const int ch = si >> 2, g = si & 3, row0 = ch * 128;
  u16* vnT = reinterpret_cast<u16*>(lds);
  float* sMu = reinterpret_cast<float*>(vnT + 256 * 136);
  float* sRs = sMu + 128;
  const u16* PROJ = reinterpret_cast<const u16*>(p.ws + WS_PROJ);
  __syncthreads();
  {
    const int grp = tid >> 4, ln = tid & 15;
#pragma unroll 1
    for (int rr = 0; rr < 8; ++rr) {
      const u16* src = PROJ + (size_t)(row0 + grp * 8 + rr) * NC + 5120;
      float s = 0.f, ss = 0.f;
#pragma unroll
      for (int c8 = 0; c8 < 8; ++c8) {
        const u32x4 v = *reinterpret_cast<const u32x4*>(src + (ln + 16 * c8) * 8);
#pragma unroll
        for (int k = 0; k < 4; ++k) { const float a = bflo(v[k]), b = bfhi(v[k]); s += a + b; ss += a * a + b * b; }
      }
#pragma unroll
      for (int o = 8; o >= 1; o >>= 1) { s += __shfl_xor(s, o); ss += __shfl_xor(ss, o); }
      const float mu = s * (1.f / 1024.f);
      const float var = fmaxf(ss * (1.f / 1024.f) - mu * mu, 0.f);
      if (ln == 0) { sMu[grp * 8 + rr] = mu; sRs[grp * 8 + rr] = rsqrtf(var + LN_EPS); }
    }
  }
  __syncthreads();
  {
    const int j = tid & 127, hf = tid >> 7;
    const float mu = sMu[j], rs = sRs[j];
    const float* lng = p.in[19 + 10 * l] + g * 256;
    const u16* src = PROJ + (size_t)(row0 + j) * NC + 5120 + g * 256;
#pragma unroll 1
    for (int oc = hf * 16; oc < hf * 16 + 16; ++oc) {
      const u32x4 v = *reinterpret_cast<const u32x4*>(src + oc * 8);
      const float4 g0 = *reinterpret_cast<const float4*>(lng + oc * 8), g1 = *reinterpret_cast<const float4*>(lng + oc * 8 + 4);
      const float gg[8] = {g0.x, g0.y, g0.z, g0.w, g1.x, g1.y, g1.z, g1.w};
#pragma unroll
      for (int k = 0; k < 4; ++k) {
        const float a = (bflo(v[k]) - mu) * rs * gg[2 * k], b = (bfhi(v[k]) - mu) * rs * gg[2 * k + 1];
        const u32 w = pk2(a, b);
        vnT[(oc * 8 + 2 * k) * 136 + j] = (u16)(w & 0xffffu);
        vnT[(oc * 8 + 2 * k + 1) * 136 + j] = (u16)(w >> 16);
      }
    }
  }
  __syncthreads();
  const u16* W = reinterpret_cast<const u16*>(p.ws + WS_SGUW) + (size_t)(l >> 1) * 65536 + (size_t)g * 16384;
  const float* bs = p.in[21 + 10 * l] + g * 128;
  u16* Y = reinterpret_cast<u16*>(p.ws + WS_H);
#pragma unroll 1
  for (int ih = 0; ih < 2; ++ih) {
    f32x4 acc[4][4];
#pragma unroll
    for (int a = 0; a < 4; ++a)
#pragma unroll
      for (int b = 0; b < 4; ++b) acc[a][b] = f32x4{0.f, 0.f, 0.f, 0.f};
#pragma unroll
    for (int ks = 0; ks < 4; ++ks) {
      bf16x8 af[4], bfr[4];
#pragma unroll
      for (int m = 0; m < 4; ++m) af[m] = ld8(W + (size_t)(ih * 64 + m * 16 + fr) * 128 + ks * 32 + fq * 8);
#pragma unroll
      for (int n = 0; n < 4; ++n) bfr[n] = ld8(vnT + (wid * 64 + n * 16 + fr) * 136 + ks * 32 + fq * 8);
#pragma unroll
      for (int m = 0; m < 4; ++m)
#pragma unroll
        for (int n = 0; n < 4; ++n) acc[m][n] = mfma16(bfr[n], af[m], acc[m][n]);
    }
#pragma unroll
    for (int m = 0; m < 4; ++m) {
      const int ii = ih * 64 + m * 16 + fr;
      const float bias = bs[ii];
      const size_t rb = (size_t)(row0 + ii) * NC;
#pragma unroll
      for (int n = 0; n < 4; ++n) {
        const int c = g * 256 + wid * 64 + n * 16 + 4 * fq;
        const u32x2 uw = *reinterpret_cast<const u32x2*>(PROJ + rb + 4096 + c);
        const u32x2 dw = *reinterpret_cast<const u32x2*>(PROJ + rb + 6144 + c);
        float y0 = bflo(uw[0]) * (acc[m][n][0] + bias) * silu(bflo(dw[0])), y1 = bfhi(uw[0]) * (acc[m][n][1] + bias) * silu(bfhi(dw[0]));
        float y2 = bflo(uw[1]) * (acc[m][n][2] + bias) * silu(bflo(dw[1])), y3 = bfhi(uw[1]) * (acc[m][n][3] + bias) * silu(bfhi(dw[1]));
        if (ZERO_MASK & 8) { y0 = y1 = y2 = y3 = 0.f; }
        *reinterpret_cast<u32x2*>(Y + (size_t)(row0 + ii) * 2048 + 1024 + c) = u32x2{pk2(y0, y1), pk2(y2, y3)};
      }
    }
  }
}

DI void phase_mix_odd(const Params& p, int l, unsigned char* lds) {
#pragma unroll 1
  for (int it = blockIdx.x; it < 1024; it += gridDim.x) { int bh, qb; heavy_map(it, bh, qb); na_item(p, l, true, bh, qb, lds); }
#pragma unroll 1
  for (int it = blockIdx.x; it < 512; it += gridDim.x) na_item(p, l, false, it >> 1, it & 1, lds);
#pragma unroll 1
  for (int it = blockIdx.x; it < 768; it += gridDim.x) sgu_item(p, l, it, lds);
}

#define XB_TMO      128
#define XB_XCNT(j)  (256  + 64 * (j))
#define XB_XSUB(j)  (1280 + 64 * (j))
#define XB_XGEN(j)  (2304 + 64 * (j))
#define XB_TOP      3328
#define XB_TOPGEN   3392
#define XCD_BAR_WORDS 3456
#define XB_SPIN_CAP (1u << 18)
#define LAS __attribute__((address_space(3)))
DI unsigned xb_ld(unsigned* p)              { return __hip_atomic_load(p, __ATOMIC_RELAXED, __HIP_MEMORY_SCOPE_AGENT); }
DI unsigned xb_add(unsigned* p, unsigned v) { return __hip_atomic_fetch_add(p, v, __ATOMIC_RELAXED, __HIP_MEMORY_SCOPE_AGENT); }
DI unsigned xb_xcc_id() { return (unsigned)__builtin_amdgcn_s_getreg((3 << 11) | 20) & 0xFu; }
#define XB_SPIN(cond, bar) do { unsigned _sp = 0; while (cond) { __builtin_amdgcn_s_sleep(1); \
    if ((++_sp & 255u) == 0u) { if (xb_ld(&(bar)[XB_TMO])) break; if (_sp > XB_SPIN_CAP) { atomicAdd(&(bar)[XB_TMO], 1u); break; } } } } while (0)
struct XcdBarrier { unsigned* bar; unsigned x; volatile LAS unsigned* st; };
DI XcdBarrier xcd_barrier_post(unsigned* bar, volatile LAS unsigned* st) {
  XcdBarrier b; b.bar = bar; b.x = xb_xcc_id(); b.st = st;
  if (threadIdx.x == 0) (void)xb_add(&bar[XB_XCNT(b.x)], 1u);
  return b;
}
DI void xcd_barrier_complete(unsigned* bar, unsigned x, unsigned& nloc, unsigned& nx) {
  const unsigned G = gridDim.x * gridDim.y * gridDim.z;
  unsigned sum, cnt, mine, sp = 0u;
  for (;;) {
    sum = 0u; cnt = 0u; mine = 0u;
#pragma unroll
    for (unsigned j = 0; j < 16; ++j) { const unsigned c = xb_ld(&bar[XB_XCNT(j)]); sum += c; cnt += (c > 0u) ? 1u : 0u; mine = (j == x) ? c : mine; }
    if (sum == G) break;
    __builtin_amdgcn_s_sleep(1);
    if ((++sp & 255u) == 0u) { if (xb_ld(&bar[XB_TMO])) break; if (sp > XB_SPIN_CAP) { atomicAdd(&bar[XB_TMO], 1u); break; } }
  }
  nloc = mine > 0u ? mine : 1u; nx = cnt > 0u ? cnt : 1u;
}
DI void xcd_barrier(const XcdBarrier& b) {
  asm volatile("s_waitcnt vmcnt(0)" ::: "memory");
  __syncthreads();
  if (threadIdx.x == 0) {
    unsigned* bar = b.bar;
    __builtin_amdgcn_s_waitcnt(0);
    unsigned nloc = b.st[0], nx = b.st[1];
    if (nloc == 0u) { xcd_barrier_complete(bar, b.x, nloc, nx); b.st[0] = nloc; b.st[1] = nx; }
    const unsigned old = xb_add(&bar[XB_XSUB(b.x)], 1u);
    const unsigned gen = old / nloc;
    if (old + 1u == (gen + 1u) * nloc) {
      __builtin_amdgcn_fence(__ATOMIC_RELEASE, "agent");
      asm volatile("s_waitcnt vmcnt(0)" ::: "memory");
      const unsigned og = xb_add(&bar[XB_TOP], 1u);
      const unsigned tg = og / nx;
      if (og + 1u == (tg + 1u) * nx) xb_add(&bar[XB_TOPGEN], 1u);
      else XB_SPIN(xb_ld(&bar[XB_TOPGEN]) == tg, bar);
      __builtin_amdgcn_fence(__ATOMIC_ACQUIRE, "agent");
      xb_add(&bar[XB_XGEN(b.x)], 1u);
      asm volatile("s_waitcnt vmcnt(0)" ::: "memory");
    } else {
      XB_SPIN(xb_ld(&bar[XB_XGEN(b.x)]) == gen, bar);
      __builtin_amdgcn_fence(__ATOMIC_ACQUIRE, "agent");
      asm volatile("s_waitcnt vmcnt(0)" ::: "memory");
    }
  }
  __syncthreads();
}

__global__ void __launch_bounds__(256, 2) fwd_megakernel(Params p) {
  extern __shared__ __attribute__((aligned(16))) unsigned char lds[];
  cg::grid_group grid = cg::this_grid();
  volatile LAS unsigned* xst = (volatile LAS unsigned*)(lds + LDS_BYTES - 16);
  if (threadIdx.x == 0) { xst[0] = 0u; xst[1] = 0u; }
  __syncthreads();
  const XcdBarrier xb = xcd_barrier_post(reinterpret_cast<unsigned*>(p.ws + WS_BAR), xst);
  for (int ph = p.ph_lo; ph < p.ph_hi; ++ph) {
    if (ph == 0) phase_prep(p, lds);
    else if (ph == 1) phase_mod0(p);
    else {
      const int l = (ph - 2) >> 2, s = (ph - 2) & 3;
      if (s == 0) { for (int rep = 0; rep < REP0; ++rep) { if (l & 1) gemm_phase<G_IN_ODD>(p, l, lds); else gemm_phase<G_IN_EVEN>(p, l, lds); } }
      else if (s == 1) { for (int rep = 0; rep < REP1; ++rep) { if (l & 1) phase_mix_odd(p, l, lds); else phase_mix_even(p, l, lds); } }
      else if (s == 2) gemm_phase<G_OUT>(p, l, lds);
      else phase_ln(p, l);
    }
    if (ph + 1 < p.ph_hi) {
      if (ph == p.ph_lo) grid.sync();
      else xcd_barrier(xb);
    }
  }
}

extern "C" void kernel_launch(void* const* d_in, const int* in_sizes, int n_in, void* d_out, int out_size, void* d_ws, size_t ws_size,
                              hipStream_t stream) {
  static int grid_blocks = 0;
  if (grid_blocks == 0) {
    if (n_in != 52 || ws_size < WS_END) {
      fprintf(stderr, "kernel_launch: expected 52 inputs and >= %zu bytes of workspace; got %d, %zu\n", (size_t)WS_END, n_in, ws_size);
      grid_blocks = -1;
      return;
    }
    int dev = 0, cus = 0, per_cu = 0;
    hipGetDevice(&dev);
    hipDeviceGetAttribute(&cus, hipDeviceAttributeMultiprocessorCount, dev);
    hipFuncSetAttribute((const void*)fwd_megakernel, hipFuncAttributeMaxDynamicSharedMemorySize, LDS_BYTES);
    hipOccupancyMaxActiveBlocksPerMultiprocessor(&per_cu, (const void*)fwd_megakernel, 256, LDS_BYTES);
    if (per_cu < 1) per_cu = 1;
    if (per_cu > 2) per_cu = 2;
    grid_blocks = cus * per_cu;
  }
  if (grid_blocks < 0) return;
  Params p{};
  for (int i = 0; i < 52; ++i) p.in[i] = (const float*)d_in[i];
  p.out = (float*)d_out;
  p.ws = (unsigned char*)d_ws;
#if MULTI
  for (int ph = 0; ph < NPHASE; ++ph) {
    p.ph_lo = ph; p.ph_hi = ph + 1;
    hipLaunchKernelGGL(fwd_megakernel, dim3(grid_blocks), dim3(256), LDS_BYTES, stream, p);
  }
#else
  p.ph_lo = 0; p.ph_hi = NPHASE;
  if (hipMemsetAsync((char*)d_ws + WS_BAR, 0, XCD_BAR_WORDS * 4, stream) != hipSuccess) { fprintf(stderr, "kernel_launch: memset of barrier words failed\n"); return; }
  void* args[] = {&p};
  hipError_t e = hipLaunchCooperativeKernel((const void*)fwd_megakernel, dim3(grid_blocks), dim3(256), args, LDS_BYTES, stream);
  if (e != hipSuccess) fprintf(stderr, "cooperative launch failed: %s (grid %d)\n", hipGetErrorString(e), grid_blocks);
#endif
}
```

```cpp
#include <hip/hip_runtime.h>
#include <hip/hip_cooperative_groups.h>
#include <cstdio>
namespace cg = cooperative_groups;

#define DI __device__ __forceinline__
typedef unsigned short u16;
typedef unsigned int u32;
using bf16x8 = __attribute__((ext_vector_type(8))) short;
using f32x4 = __attribute__((ext_vector_type(4))) float;
using f32x16 = __attribute__((ext_vector_type(16))) float;
using u32x4 = __attribute__((ext_vector_type(4))) unsigned;
using u32x2 = __attribute__((ext_vector_type(2))) unsigned;
typedef __bf16 bf2_t __attribute__((ext_vector_type(2)));
typedef float f2_t __attribute__((ext_vector_type(2)));

#ifndef MULTI
#define MULTI 0
#endif
#ifndef REP0
#define REP0 1
#endif
#ifndef REP1
#define REP1 1
#endif
#ifndef ZERO_MASK
#define ZERO_MASK 0
#endif

constexpr int T_ALL = 24576, TP = 8192, DM = 2048;
constexpr float LOG2E = 1.4426950408889634f;
constexpr float ALPHA = 1.6817928305074290f;
constexpr float LN_EPS = 1e-5f;
constexpr int HALF_LDS = 76288;
constexpr int LDS_BYTES = 2 * HALF_LDS + 16;
constexpr int NPHASE = 18;

constexpr size_t SZ_WIN_E = (size_t)6144 * 2048 * 2, SZ_WIN_O = (size_t)7168 * 2048 * 2;
constexpr size_t WS_WINT = 0;
constexpr size_t WS_WOUTT = WS_WINT + 2 * SZ_WIN_E + 2 * SZ_WIN_O;
constexpr size_t WS_POOLWT = WS_WOUTT + (size_t)4 * 2048 * 2048 * 2;
constexpr size_t WS_SGUW = WS_POOLWT + (size_t)2 * 4 * 256 * 256 * 2;
constexpr size_t WS_CK = WS_SGUW + (size_t)2 * 4 * 128 * 128 * 2;
constexpr size_t WS_CVT = WS_CK + (size_t)4 * 4194304;
constexpr size_t WS_MOD = WS_CVT + (size_t)4 * 4194304;
constexpr size_t WS_ROPE = WS_MOD + (size_t)4 * 5 * 6144 * 4;
constexpr size_t WS_H = WS_ROPE + 8192;
constexpr size_t WS_PROJ = WS_H + (size_t)T_ALL * 2048 * 2;
constexpr size_t WS_VT = WS_PROJ + (size_t)T_ALL * 7168 * 2;
constexpr size_t WS_BAR = WS_VT + (size_t)T_ALL * 1024 * 2;
constexpr size_t WS_END = WS_BAR + 16384;

struct Params {
  const float* in[52];
  float* out;
  unsigned char* ws;
  int ph_lo, ph_hi;
};

DI size_t ws_wint(int l) { return WS_WINT + (size_t)(l >> 1) * (SZ_WIN_E + SZ_WIN_O) + ((l & 1) ? SZ_WIN_E : 0); }

DI u32 pk2(float a, float b) { f2_t v = {a, b}; bf2_t r = __builtin_convertvector(v, bf2_t); return __builtin_bit_cast(u32, r); }
DI float bflo(u32 w) { return __uint_as_float(w << 16); }
DI float bfhi(u32 w) { return __uint_as_float(w & 0xffff0000u); }
DI float bf1(u16 w) { return __uint_as_float(((u32)w) << 16); }
DI float ex2(float x) { return __builtin_amdgcn_exp2f(x); }
DI float silu(float x) { return x / (1.f + __expf(-x)); }
DI f32x4 mfma16(bf16x8 a, bf16x8 b, f32x4 c) { return __builtin_amdgcn_mfma_f32_16x16x32_bf16(a, b, c, 0, 0, 0); }
DI f32x16 mfma32(bf16x8 a, bf16x8 b, f32x16 c) { return __builtin_amdgcn_mfma_f32_32x32x16_bf16(a, b, c, 0, 0, 0); }
DI bf16x8 ld8(const u16* p) { return *reinterpret_cast<const bf16x8*>(p); }
DI int opq(int x) { asm volatile("" : "+v"(x)); return x; }
#define TIDX (opq((int)threadIdx.x) & 255)
#define HALF_ID (opq((int)threadIdx.x) >> 8)
#define VBID ((int)((blockIdx.x & 7u) | ((unsigned)HALF_ID << 3) | ((blockIdx.x >> 3) << 4)))
#define VGRID ((int)gridDim.x * 2)

enum { G_IN_EVEN = 0, G_IN_ODD = 1, G_OUT = 2 };

namespace pg8 {
#define PG8_LAS __attribute__((address_space(3)))
typedef unsigned short bf16_t;
typedef short bf16x8 __attribute__((ext_vector_type(8)));
typedef float f32x4 __attribute__((ext_vector_type(4)));
typedef unsigned u32x4 __attribute__((ext_vector_type(4)));
constexpr int BM = 256, BK = 64, HALF = 128, HTB = HALF * BK * 2  , STAGE_BYTES = 8 * HTB, NXCD = 8, WGM = 8;

__host__ __device__ __forceinline__ int lds_byte(int r, int c) { const int st = (r >> 4) * 2 + (c >> 5), rr = r & 15, cc = c & 31, ob = rr * 64 + cc * 2; return st * 1024 + (ob ^ (((ob >> 9) & 1) << 5)); }
__host__ __device__ __forceinline__ void stage_rc(int b, int& R, int& C) { const int st = b / 1024, sb = b % 1024, swz = sb ^ (((sb >> 9) & 1) << 5); R = (st >> 1) * 16 + swz / 64; C = (st & 1) * 32 + (swz % 64) / 2; }
__host__ __device__ __forceinline__ int perm32(int rho) { const int n = rho >> 4, i = rho & 15; return 8 * (i >> 2) + 4 * n + (i & 3); }

struct Unit { int pm, pn; };
struct Gemm { const bf16_t* A; const bf16_t* Bt; int M, N, K; };

struct StaticOrder {
    int nM, nN, nwg, G, c;
    __host__ __device__ void init(int M, int N, int G_, int c_) { nM = M / BM; nN = N / BM; nwg = nM * nN; G = G_; c = c_; }
    __host__ __device__ bool next(int i, Unit& u) const {
        const long L = (long)i * G + c; if (L >= nwg) return false;
        int wgid = (int)L; { const int q = nwg / NXCD, r = nwg % NXCD, xcd = wgid % NXCD, off = wgid / NXCD; wgid = (xcd < r ? xcd * (q + 1) : r * (q + 1) + (xcd - r) * q) + off; }
        const int nig = WGM * nN, gid = wgid / nig, fm = gid * WGM, gsz = (nM - fm) < WGM ? (nM - fm) : WGM;
        u.pm = fm + ((wgid % nig) % gsz); u.pn = (wgid % nig) / gsz; return true;
    }
    __device__ __forceinline__ void a_ready(const Unit&) const {}
    __device__ __forceinline__ void done(const Unit&) const {}
};

template <class Epi, class Sched, bool STAMP = false>
__device__ __forceinline__ void gemm_phase(PG8_LAS unsigned char* lds, const Gemm g, const Sched& S, const Epi& E, unsigned long long* stamps) {
    const int tid = opq((int)threadIdx.x), wid = __builtin_amdgcn_readfirstlane(tid >> 6), lane = tid & 63, wr = wid >> 2, wc = wid & 3, fr = lane & 15, fq = lane >> 4;
    const int K = g.K, nt = K / BK;
    int ts_lo = 0, ts_hi = 0, nts = 0; const unsigned long long rt_entry = STAMP ? (unsigned long long)wall_clock64() : 0ull;
#define PG8_STAMP() do { if (STAMP && wid == 0 && nts < 64) { const unsigned long long _c = (unsigned long long)clock64(); \
        ts_lo = (lane == nts) ? (int)(unsigned)_c : ts_lo; ts_hi = (lane == nts) ? (int)(unsigned)(_c >> 32) : ts_hi; ++nts; } } while (0)
    PG8_STAMP();
    unsigned voffA[2], voffB[2];
#pragma unroll
    for (int i = 0; i < 2; ++i) { int R, C; stage_rc(tid * 16 + i * 8192, R, C); const int Rb = Epi::PERM ? ((R & ~31) + perm32(R & 31)) : R;
        voffA[i] = (unsigned)(R * K + C) * 2u; voffB[i] = (unsigned)(Rb * K + C) * 2u; }
    const size_t kstep = (size_t)(BK * 2);
    const size_t hstep = (size_t)HALF * K * 2;
    const size_t tstep = 2 * hstep;
    const unsigned ldsw = (unsigned)wid * 1024u;
    const int aoff = lds_byte(wr * 64 + fr, fq * 8), boff = lds_byte(wc * 32 + fr, fq * 8);
#define PG8_SA(b, h) (((b) * 2 + (h)) * HTB)
#define PG8_SB(b, h) ((4 + (b) * 2 + (h)) * HTB)
#define PG8_STAGE(bufoff, gbase, voff) do { _Pragma("unroll") for (int _i = 0; _i < 2; ++_i) \
        __builtin_amdgcn_global_load_lds((const unsigned*)((const char*)(gbase) + (voff)[_i]), (PG8_LAS unsigned*)(lds + (bufoff) + ldsw + _i * 8192), 16, 0, 0); } while (0)
#define PG8_LDA(dst, b, h) do { _Pragma("unroll") for (int m = 0; m < 4; ++m) _Pragma("unroll") for (int k = 0; k < 2; ++k) dst[m][k] = *(const PG8_LAS bf16x8*)(lds + PG8_SA(b, h) + aoff + m * 2048 + k * 1024); } while (0)
#define PG8_LDB(dst, b, h) do { _Pragma("unroll") for (int n = 0; n < 2; ++n) _Pragma("unroll") for (int k = 0; k < 2; ++k) dst[n][k] = *(const PG8_LAS bf16x8*)(lds + PG8_SB(b, h) + boff + n * 2048 + k * 1024); } while (0)
#define PG8_MMA(ai, bj, At, Bt) do { __builtin_amdgcn_s_setprio(1); _Pragma("unroll") for (int m = 0; m < 4; ++m) _Pragma("unroll") for (int n = 0; n < 2; ++n) _Pragma("unroll") for (int k = 0; k < 2; ++k) \
        acc[ai][bj][m][n] = __builtin_amdgcn_mfma_f32_16x16x32_bf16(Bt[n][k], At[m][k], acc[ai][bj][m][n], 0, 0, 0); __builtin_amdgcn_s_setprio(0); } while (0)
#define PG8_WAIT_V(n) asm volatile("s_waitcnt vmcnt(" #n ")" ::: "memory")
#define PG8_WAIT_L(n) asm volatile("s_waitcnt lgkmcnt(" #n ")" ::: "memory")
#define PG8_BAR __builtin_amdgcn_s_barrier()
#define PG8_SCHED __builtin_amdgcn_sched_barrier(0)
    Unit cur, nxt; int ui = 0;
    if (!S.next(0, cur)) return;
    f32x4 acc[2][2][4][2];
#pragma unroll
    for (int a = 0; a < 2; ++a)
#pragma unroll
        for (int b = 0; b < 2; ++b)
#pragma unroll
            for (int m = 0; m < 4; ++m)
#pragma unroll
                for (int n = 0; n < 2; ++n) acc[a][b][m][n] = (f32x4){0.f, 0.f, 0.f, 0.f};
    bf16x8 At[4][2], B0[2][2], B1[2][2];
    const char* cA = (const char*)g.A + (size_t)cur.pm * tstep; const char* cB = (const char*)g.Bt + (size_t)cur.pn * tstep;
    S.a_ready(cur);
    PG8_STAGE(PG8_SB(0, 0), cB, voffB); PG8_STAGE(PG8_SA(0, 0), cA, voffA); PG8_STAGE(PG8_SB(0, 1), cB + hstep, voffB); PG8_STAGE(PG8_SA(0, 1), cA + hstep, voffA);
    if (wr == 1) PG8_BAR;
    PG8_WAIT_V(4); PG8_BAR;
    PG8_STAGE(PG8_SB(1, 0), cB + kstep, voffB); PG8_STAGE(PG8_SA(1, 0), cA + kstep, voffA); PG8_STAGE(PG8_SB(1, 1), cB + hstep + kstep, voffB);
    PG8_WAIT_V(6); PG8_BAR;
    PG8_STAMP();
    for (;;) {
        const bool has_next = S.next(ui + 1, nxt);
        const char* nA = has_next ? (const char*)g.A + (size_t)nxt.pm * tstep : cA; const char* nB = has_next ? (const char*)g.Bt + (size_t)nxt.pn * tstep : cB;
        for (int t = 0; t < nt; t += 2) {
            const bool last = (t == nt - 2);
            const char* a1 = cA + (size_t)(t + 1) * kstep;
            const char* a2 = last ? nA : cA + (size_t)(t + 2) * kstep; const char* b2 = last ? nB : cB + (size_t)(t + 2) * kstep;
            const char* a3 = a2 + kstep; const char* b3 = b2 + kstep;
            if (last && has_next) S.a_ready(nxt);
            PG8_LDB(B0, 0, 0); PG8_SCHED; PG8_LDA(At, 0, 0); PG8_STAGE(PG8_SA(1, 1), a1 + hstep, voffA);
            PG8_WAIT_L(8); PG8_BAR; PG8_WAIT_L(0); PG8_MMA(0, 0, At, B0); PG8_BAR; PG8_SCHED;
            PG8_LDB(B1, 0, 1); PG8_STAGE(PG8_SB(0, 0), b2, voffB);
            PG8_BAR; PG8_WAIT_L(0); PG8_MMA(0, 1, At, B1); PG8_BAR;
            PG8_LDA(At, 0, 1); PG8_STAGE(PG8_SA(0, 0), a2, voffA);
            PG8_BAR; PG8_WAIT_L(0); PG8_MMA(1, 0, At, B0); PG8_BAR; PG8_SCHED;
            PG8_STAGE(PG8_SB(0, 1), b2 + hstep, voffB);
            PG8_WAIT_V(6); PG8_BAR; PG8_MMA(1, 1, At, B1); PG8_BAR;
            PG8_LDB(B0, 1, 0); PG8_SCHED; PG8_LDA(At, 1, 0); PG8_STAGE(PG8_SA(0, 1), a2 + hstep, voffA);
            PG8_WAIT_L(8); PG8_BAR; PG8_WAIT_L(0); PG8_MMA(0, 0, At, B0); PG8_BAR; PG8_SCHED;
            PG8_LDB(B1, 1, 1); PG8_STAGE(PG8_SB(1, 0), b3, voffB);
            PG8_BAR; PG8_WAIT_L(0); PG8_MMA(0, 1, At, B1); PG8_BAR;
            PG8_LDA(At, 1, 1); PG8_STAGE(PG8_SA(1, 0), a3, voffA);
            PG8_BAR; PG8_WAIT_L(0); PG8_MMA(1, 0, At, B0); PG8_BAR; PG8_SCHED;
            PG8_STAGE(PG8_SB(1, 1), b3 + hstep, voffB);
            PG8_WAIT_V(6); PG8_BAR; PG8_MMA(1, 1, At, B1); PG8_BAR;
        }
        PG8_STAMP();
        if constexpr (!Epi::AFTER_DRAIN) { E(acc, cur, wr, wc, fr, fq); S.done(cur); }
        PG8_STAMP();
        if (!has_next) break;
#pragma unroll
        for (int a = 0; a < 2; ++a)
#pragma unroll
            for (int b = 0; b < 2; ++b)
#pragma unroll
                for (int m = 0; m < 4; ++m)
#pragma unroll
                    for (int n = 0; n < 2; ++n) acc[a][b][m][n] = (f32x4){0.f, 0.f, 0.f, 0.f};
        cur = nxt; cA = nA; cB = nB; ++ui;
    }
    PG8_WAIT_V(0);
    if (wr == 0) PG8_BAR;
    PG8_BAR;
    if constexpr (Epi::AFTER_DRAIN) { E.fused(acc, cur, wr, wc, fr, fq, lds, wid, lane); S.done(cur); }
    PG8_STAMP();
    if (STAMP && wid == 0) { stamps[lane] = lane < nts ? (((unsigned long long)(unsigned)ts_hi << 32) | (unsigned)ts_lo) : 0ull;
        if (lane == 62) stamps[62] = rt_entry; if (lane == 63) stamps[63] = (unsigned long long)wall_clock64(); }
#undef PG8_STAMP
#undef PG8_SA
#undef PG8_SB
#undef PG8_STAGE
#undef PG8_LDA
#undef PG8_LDB
#undef PG8_MMA
#undef PG8_WAIT_V
#undef PG8_WAIT_L
#undef PG8_BAR
#undef PG8_SCHED
}
}

DI void tr_tile(const float* __restrict__ src, size_t ld_src, u16* __restrict__ dst, size_t ld_dst, float* sT) {
  const int tid = TIDX;
  const int r = tid >> 4, c4 = (tid & 15) * 4;
#pragma unroll
  for (int i = 0; i < 4; ++i) {
    float4 v = *reinterpret_cast<const float4*>(src + (size_t)(r + 16 * i) * ld_src + c4);
    float* d = sT + (r + 16 * i) * 65 + c4;
    d[0] = v.x; d[1] = v.y; d[2] = v.z; d[3] = v.w;
  }
  __syncthreads();
  const int n = tid >> 2, ks = (tid & 3) * 16;
  u32 w[8];
#pragma unroll
  for (int j = 0; j < 8; ++j) w[j] = pk2(sT[(ks + 2 * j) * 65 + n], sT[(ks + 2 * j + 1) * 65 + n]);
  u32x4* o = reinterpret_cast<u32x4*>(dst + (size_t)n * ld_dst + ks);
  o[0] = u32x4{w[0], w[1], w[2], w[3]};
  o[1] = u32x4{w[4], w[5], w[6], w[7]};
  __syncthreads();
}

DI void cvt8(const float* __restrict__ src, u16* __restrict__ dst) {
  float4 a = *reinterpret_cast<const float4*>(src);
  float4 b = *reinterpret_cast<const float4*>(src + 4);
  *reinterpret_cast<u32x4*>(dst) = u32x4{pk2(a.x, a.y), pk2(a.z, a.w), pk2(b.x, b.y), pk2(b.z, b.w)};
}

DI void mod_item(const Params& p, int i, unsigned char* lds) {
  const int tid = TIDX;
  const int l = i / 96, n0 = (i % 96) * 64;
  float* sS = reinterpret_cast<float*>(lds);
  float* red = sS + 5 * 2048;
  const float* c = p.in[10];
  const float* cctx = p.in[11];
  for (int e = tid; e < 5 * 2048; e += 256) {
    int v = e >> 11, k = e & 2047;
    float x = (v == 0) ? cctx[k] : c[(v - 1) * 2048 + k];
    sS[e] = silu(x);
  }
  __syncthreads();
  const int kk = tid >> 4, c4 = (tid & 15) * 4;
  const float* W = p.in[12 + 10 * l] + n0 + c4;
  f32x4 acc[5];
#pragma unroll
  for (int v = 0; v < 5; ++v) acc[v] = f32x4{0.f, 0.f, 0.f, 0.f};
#pragma unroll 8
  for (int k = kk; k < 2048; k += 16) {
    float4 w = *reinterpret_cast<const float4*>(W + (size_t)k * 6144);
#pragma unroll
    for (int v = 0; v < 5; ++v) {
      float s = sS[v * 2048 + k];
      acc[v][0] += s * w.x; acc[v][1] += s * w.y; acc[v][2] += s * w.z; acc[v][3] += s * w.w;
    }
  }
#pragma unroll
  for (int v = 0; v < 5; ++v)
#pragma unroll
    for (int q = 0; q < 4; ++q) red[(kk * 5 + v) * 64 + c4 + q] = acc[v][q];
  __syncthreads();
  for (int t2 = tid; t2 < 320; t2 += 256) {
    int v = t2 >> 6, n = t2 & 63;
    float s = 0.f;
#pragma unroll
    for (int k2 = 0; k2 < 16; ++k2) s += red[(k2 * 5 + v) * 64 + n];
    float* mod = reinterpret_cast<float*>(p.ws + WS_MOD);
    mod[(size_t)(l * 5 + v) * 6144 + n0 + n] = s + p.in[13 + 10 * l][n0 + n];
  }
  __syncthreads();
}

DI void phase_prep(const Params& p, unsigned char* lds) {
  constexpr int N_MOD = 384, N_TRWIN = 13312, N_TRWOUT = 4096, N_TRPOOL = 128, N_SGU = 64, N_CK = 4096, N_CV = 2048;
  constexpr int TOTAL = N_MOD + N_TRWIN + N_TRWOUT + N_TRPOOL + N_SGU + N_CK + N_CV + 1;
  const int tid = TIDX;
  float* sT = reinterpret_cast<float*>(lds);
  for (int it = VBID; it < TOTAL; it += VGRID) {
    int i = it;
    if (i < N_MOD) { mod_item(p, i, lds); continue; }
    i -= N_MOD;
    if (i < N_TRWIN) {
      int l, base;
      if (i < 3072) { l = 0; base = 0; } else if (i < 6656) { l = 1; base = 3072; } else if (i < 9728) { l = 2; base = 6656; } else { l = 3; base = 9728; }
      i -= base;
      const int N = (l & 1) ? 7168 : 6144, nN = N / 64;
      const int kt = i / nN, nt = i % nN;
      tr_tile(p.in[14 + 10 * l] + (size_t)kt * 64 * N + nt * 64, N,
              reinterpret_cast<u16*>(p.ws + ws_wint(l)) + (size_t)nt * 64 * 2048 + kt * 64, 2048, sT);
      continue;
    }
    i -= N_TRWIN;
    if (i < N_TRWOUT) {
      const int l = i >> 10, r = i & 1023, kt = r >> 5, nt = r & 31;
      tr_tile(p.in[15 + 10 * l] + (size_t)kt * 64 * 2048 + nt * 64, 2048,
              reinterpret_cast<u16*>(p.ws + WS_WOUTT) + (size_t)l * 2048 * 2048 + (size_t)nt * 64 * 2048 + kt * 64, 2048, sT);
      continue;
    }
    i -= N_TRWOUT;
    if (i < N_TRPOOL) {
      const int e = i >> 6, r = i & 63, g = r >> 4, t = r & 15, kt = t >> 2, nt = t & 3;
      tr_tile(p.in[18 + 20 * e] + (size_t)g * 65536 + kt * 64 * 256 + nt * 64, 256,
              reinterpret_cast<u16*>(p.ws + WS_POOLWT) + (size_t)e * 262144 + g * 65536 + nt * 64 * 256 + kt * 64, 256, sT);
      continue;
    }
    i -= N_TRPOOL;
    if (i < N_SGU) {
      const int e = i >> 5, ch = i & 31;
      const size_t off = (size_t)ch * 2048 + tid * 8;
      cvt8(p.in[30 + 20 * e] + off, reinterpret_cast<u16*>(p.ws + WS_SGUW) + (size_t)e * 65536 + off);
      continue;
    }
    i -= N_SGU;
    if (i < N_CK) {
      const int l = i >> 10, ch = i & 1023;
      const size_t off = (size_t)ch * 2048 + tid * 8;
      cvt8(p.in[2 + 2 * l] + off, reinterpret_cast<u16*>(p.ws + WS_CK) + (size_t)l * 2097152 + off);
      continue;
    }
    i -= N_CK;
    if (i < N_CV) {
      const int l = i >> 9, r = i & 511, bh = r >> 4, t = r & 15, kt = t >> 1, nt = t & 1;
      tr_tile(p.in[3 + 2 * l] + (size_t)bh * 65536 + kt * 64 * 128 + nt * 64, 128,
              reinterpret_cast<u16*>(p.ws + WS_CVT) + (size_t)l * 2097152 + (size_t)bh * 65536 + nt * 64 * 512 + kt * 64, 512, sT);
      continue;
    }
    {
      float* rc = reinterpret_cast<float*>(p.ws + WS_ROPE);
      for (int e = tid; e < 1024; e += 256) {
        int pos = e >> 4, fi = e & 15;
        float inv = 1.0f / powf(10000.0f, (float)(2 * fi) / 32.0f);
        float ang = (float)pos * inv;
        rc[e] = cosf(ang);
        rc[1024 + e] = sinf(ang);
      }
    }
  }
}

DI void phase_mod0(const Params& p) {
  const int tid = TIDX;
  const float* mod = reinterpret_cast<const float*>(p.ws + WS_MOD);
  u16* H = reinterpret_cast<u16*>(p.ws + WS_H);
  for (int it = VBID; it < T_ALL / 4; it += VGRID) {
#pragma unroll
    for (int rr = 0; rr < 4; ++rr) {
      const int row = it * 4 + rr;
      const int cond = row < TP ? 0 : 1 + ((row - TP) >> 12);
      const float* src = row < TP ? p.in[0] + (size_t)row * 2048 : p.in[1] + (size_t)(row - TP) * 2048;
      const int e = tid * 8;
      const float* sh = mod + (size_t)cond * 6144 + e;
      float4 a = *reinterpret_cast<const float4*>(src + e), b = *reinterpret_cast<const float4*>(src + e + 4);
      float4 s0 = *reinterpret_cast<const float4*>(sh), s1 = *reinterpret_cast<const float4*>(sh + 4);
      float4 c0 = *reinterpret_cast<const float4*>(sh + 2048), c1 = *reinterpret_cast<const float4*>(sh + 2052);
      u32x4 o = {pk2(a.x * (1.f + c0.x) + s0.x, a.y * (1.f + c0.y) + s0.y), pk2(a.z * (1.f + c0.z) + s0.z, a.w * (1.f + c0.w) + s0.w),
                 pk2(b.x * (1.f + c1.x) + s1.x, b.y * (1.f + c1.y) + s1.y), pk2(b.z * (1.f + c1.z) + s1.z, b.w * (1.f + c1.w) + s1.w)};
      *reinterpret_cast<u32x4*>(H + (size_t)row * 2048 + e) = o;
    }
  }
}


template <int MODE>
struct EpiIn {
  static constexpr bool PERM = false, AFTER_DRAIN = false;
  u16* PROJ; u16* VT; float* kout; float* vout; const float* ropeC; const float* ropeS;
  DI void operator()(const f32x4 (&acc)[2][2][4][2], const pg8::Unit& u, int wr, int wc, int fr, int fq) const {
    constexpr int NC = (MODE == G_IN_EVEN) ? 6144 : 7168;
    constexpr int SEC_Q = (MODE == G_IN_EVEN) ? 2 : 0, SEC_K = (MODE == G_IN_EVEN) ? 3 : 1, SEC_V = (MODE == G_IN_EVEN) ? 4 : 2;
    const int sec = u.pn >> 2;
    const bool prompt = u.pm < 32;
    const bool isq = sec == SEC_Q, isk = sec == SEC_K;
    const bool rope = (MODE == G_IN_EVEN) && (isq || isk) && !prompt;
    const float sc = isq ? ((MODE == G_IN_EVEN) ? 0.125f * LOG2E : 0.08838834764831845f * LOG2E) : 1.0f;
#pragma unroll
    for (int ai = 0; ai < 2; ++ai)
#pragma unroll
      for (int m = 0; m < 4; ++m) {
        const int row = u.pm * 256 + ai * 128 + wr * 64 + m * 16 + fr;
        int b, t;
        if (prompt) { b = row >> 8; t = row & 255; } else { const int rs = row - TP; b = rs >> 12; t = rs & 4095; }
#pragma unroll
        for (int bj = 0; bj < 2; ++bj) {
          const int hh = (u.pn & 3) * 2 + bj;
          const int d0 = wc * 32 + 4 * fq;
          if (sec == SEC_V) {
#pragma unroll
            for (int n = 0; n < 2; ++n) {
              const f32x4 v = acc[ai][bj][m][n];
              const int dv = d0 + 16 * n;
              const u32 w01 = pk2(v[0], v[1]), w23 = pk2(v[2], v[3]);
              if (prompt) {
                u16* vt = VT + ((size_t)((b * 8 + hh) * 128 + dv)) * 256 + t;
                vt[0] = (u16)(w01 & 0xffffu); vt[256] = (u16)(w01 >> 16); vt[512] = (u16)(w23 & 0xffffu); vt[768] = (u16)(w23 >> 16);
                *reinterpret_cast<float4*>(vout + ((size_t)((b * 8 + hh) * 256 + t)) * 128 + dv) = float4{v[0], v[1], v[2], v[3]};
              } else {
                u16* vt = VT + 8388608 + ((size_t)((b * 8 + hh) * 128 + dv)) * 4096 + t;
                vt[0] = (u16)(w01 & 0xffffu); vt[4096] = (u16)(w01 >> 16); vt[8192] = (u16)(w23 & 0xffffu); vt[12288] = (u16)(w23 >> 16);
              }
            }
          } else {
            f32x4 v0 = acc[ai][bj][m][0], v1 = acc[ai][bj][m][1];
            if (isk && prompt) {
              float* ko = kout + ((size_t)((b * 8 + hh) * 256 + t)) * 128 + d0;
              *reinterpret_cast<float4*>(ko) = float4{v0[0], v0[1], v0[2], v0[3]};
              *reinterpret_cast<float4*>(ko + 16) = float4{v1[0], v1[1], v1[2], v1[3]};
            }
            if (rope) {
              const int pos = (wc & 1) ? (t & 63) : (t >> 6);
              const float4 cs = *reinterpret_cast<const float4*>(ropeC + pos * 16 + 4 * fq);
              const float4 sn = *reinterpret_cast<const float4*>(ropeS + pos * 16 + 4 * fq);
              const float c4[4] = {cs.x, cs.y, cs.z, cs.w}, s4[4] = {sn.x, sn.y, sn.z, sn.w};
#pragma unroll
              for (int j = 0; j < 4; ++j) {
                const float x1 = v0[j], x2 = v1[j];
                v0[j] = x1 * c4[j] - x2 * s4[j];
                v1[j] = x1 * s4[j] + x2 * c4[j];
              }
            }
            u16* dst = PROJ + (size_t)row * NC + u.pn * 256 + bj * 128 + d0;
            *reinterpret_cast<u32x2*>(dst) = u32x2{pk2(v0[0] * sc, v0[1] * sc), pk2(v0[2] * sc, v0[3] * sc)};
            *reinterpret_cast<u32x2*>(dst + 16) = u32x2{pk2(v1[0] * sc, v1[1] * sc), pk2(v1[2] * sc, v1[3] * sc)};
          }
        }
      }
  }
};

struct EpiOut {
  static constexpr bool PERM = false, AFTER_DRAIN = false;
  float* X; const float* x0; const float* x1; const float* mod; int l;
  DI void operator()(const f32x4 (&acc)[2][2][4][2], const pg8::Unit& u, int wr, int wc, int fr, int fq) const {
    const bool prompt = u.pm < 32;
    const int cond = prompt ? 0 : 1 + ((u.pm * 256 - TP) >> 12);
    const float* gate = mod + (size_t)(l * 5 + cond) * 6144 + 4096;
#pragma unroll
    for (int bj = 0; bj < 2; ++bj)
#pragma unroll
      for (int n = 0; n < 2; ++n) {
        const int col = u.pn * 256 + bj * 128 + wc * 32 + 16 * n + 4 * fq;
        const float4 g4 = *reinterpret_cast<const float4*>(gate + col);
#pragma unroll
        for (int ai = 0; ai < 2; ++ai)
#pragma unroll
          for (int m = 0; m < 4; ++m) {
            const int row = u.pm * 256 + ai * 128 + wr * 64 + m * 16 + fr;
            float4 xo;
            if (l == 0) xo = prompt ? *reinterpret_cast<const float4*>(x0 + (size_t)row * 2048 + col)
                                    : *reinterpret_cast<const float4*>(x1 + (size_t)(row - TP) * 2048 + col);
            else xo = *reinterpret_cast<const float4*>(X + (size_t)row * 2048 + col);
            const f32x4 a = acc[ai][bj][m][n];
            float4 o;
            o.x = ALPHA * xo.x + g4.x * a[0]; o.y = ALPHA * xo.y + g4.y * a[1];
            o.z = ALPHA * xo.z + g4.z * a[2]; o.w = ALPHA * xo.w + g4.w * a[3];
            *reinterpret_cast<float4*>(X + (size_t)row * 2048 + col) = o;
          }
      }
  }
};

template <int MODE>
DI void gemm_phase(const Params& p, int l, unsigned char* lds) {
  constexpr int N = (MODE == G_OUT) ? 2048 : (MODE == G_IN_EVEN ? 6144 : 7168);
  pg8::Gemm g;
  g.A = reinterpret_cast<const u16*>(p.ws + WS_H);
  g.Bt = (MODE == G_OUT) ? reinterpret_cast<const u16*>(p.ws + WS_WOUTT) + (size_t)l * 2048 * 2048
                         : reinterpret_cast<const u16*>(p.ws + ws_wint(l));
  g.M = T_ALL; g.N = N; g.K = 2048;
  pg8::StaticOrder S;
  S.init(T_ALL, N, (int)gridDim.x, (int)blockIdx.x);
  PG8_LAS unsigned char* l3 = (PG8_LAS unsigned char*)lds;
  if constexpr (MODE == G_OUT) {
    EpiOut E;
    E.X = p.out; E.x0 = p.in[0]; E.x1 = p.in[1]; E.mod = reinterpret_cast<const float*>(p.ws + WS_MOD); E.l = l;
    pg8::gemm_phase<EpiOut, pg8::StaticOrder, false>(l3, g, S, E, nullptr);
  } else {
    EpiIn<MODE> E;
    E.PROJ = reinterpret_cast<u16*>(p.ws + WS_PROJ); E.VT = reinterpret_cast<u16*>(p.ws + WS_VT);
    E.kout = p.out + (size_t)T_ALL * 2048 + (size_t)(2 * l) * 8388608;
    E.vout = p.out + (size_t)T_ALL * 2048 + (size_t)(2 * l + 1) * 8388608;
    E.ropeC = reinterpret_cast<const float*>(p.ws + WS_ROPE); E.ropeS = E.ropeC + 1024;
    pg8::gemm_phase<EpiIn<MODE>, pg8::StaticOrder, false>(l3, g, S, E, nullptr);
  }
}

DI void phase_ln(const Params& p, int l) {
  const int tid_ = TIDX, lane = tid_ & 63, wid = tid_ >> 6;
  const float* g = p.in[16 + 10 * l];
  const float* bb = p.in[17 + 10 * l];
  const float* mod = reinterpret_cast<const float*>(p.ws + WS_MOD);
  u16* H = reinterpret_cast<u16*>(p.ws + WS_H);
  float* X = p.out;
  for (int it = VBID; it < T_ALL / 4; it += VGRID) {
    const int row = it * 4 + wid;
    float* xr = X + (size_t)row * 2048;
    float4 v[8];
    float s = 0.f;
#pragma unroll
    for (int i = 0; i < 8; ++i) {
      v[i] = *reinterpret_cast<const float4*>(xr + (i * 64 + lane) * 4);
      s += v[i].x + v[i].y + v[i].z + v[i].w;
    }
#pragma unroll
    for (int o = 32; o >= 1; o >>= 1) s += __shfl_xor(s, o);
    const float mu = s * (1.f / 2048.f);
    float ss = 0.f;
#pragma unroll
    for (int i = 0; i < 8; ++i) {
      float a = v[i].x - mu, b = v[i].y - mu, c = v[i].z - mu, d = v[i].w - mu;
      ss += a * a + b * b + c * c + d * d;
    }
#pragma unroll
    for (int o = 32; o >= 1; o >>= 1) ss += __shfl_xor(ss, o);
    const float rstd = rsqrtf(ss * (1.f / 2048.f) + LN_EPS);
    const int cond = row < TP ? 0 : 1 + ((row - TP) >> 12);
    const float* sh = mod + (size_t)((l + 1) * 5 + cond) * 6144;
#pragma unroll
    for (int i = 0; i < 8; ++i) {
      const int e = (i * 64 + lane) * 4;
      float4 gg = *reinterpret_cast<const float4*>(g + e), b4 = *reinterpret_cast<const float4*>(bb + e);
      float4 y;
      y.x = (v[i].x - mu) * rstd * gg.x + b4.x; y.y = (v[i].y - mu) * rstd * gg.y + b4.y;
      y.z = (v[i].z - mu) * rstd * gg.z + b4.z; y.w = (v[i].w - mu) * rstd * gg.w + b4.w;
      *reinterpret_cast<float4*>(xr + e) = y;
      if (l < 3) {
        float4 s0 = *reinterpret_cast<const float4*>(sh + e), c0 = *reinterpret_cast<const float4*>(sh + 2048 + e);
        u32x2 o = {pk2(y.x * (1.f + c0.x) + s0.x, y.y * (1.f + c0.y) + s0.y), pk2(y.z * (1.f + c0.z) + s0.z, y.w * (1.f + c0.w) + s0.w)};
        *reinterpret_cast<u32x2*>(H + (size_t)row * 2048 + e) = o;
      }
    }
  }
}

struct AttnSrc {
  const u16* k0; const u16* vt0; int ks0, vs0, n0;
  const u16* k1; const u16* vt1; int ks1, vs1, n1;
};

template <int DQK>
DI void attn_ldg(const AttnSrc& s, int j, u32x4 (&rk)[DQK / 32], u32x4 (&rv)[4]) {
  const u16* kb; const u16* vb; int ks, vs;
  if (j < s.n0) { kb = s.k0 + (size_t)j * 64 * s.ks0; vb = s.vt0 + j * 64; ks = s.ks0; vs = s.vs0; }
  else { const int jj = j - s.n0; kb = s.k1 + (size_t)jj * 64 * s.ks1; vb = s.vt1 + jj * 64; ks = s.ks1; vs = s.vs1; }
  constexpr int CPR = DQK / 8;
  const int tid = TIDX;
#pragma unroll
  for (int i = 0; i < DQK / 32; ++i) {
    const int c = tid + 256 * i, row = c / CPR, kc = c % CPR;
    rk[i] = *reinterpret_cast<const u32x4*>(kb + (size_t)row * ks + kc * 8);
  }
#pragma unroll
  for (int i = 0; i < 4; ++i) {
    const int c = tid + 256 * i, row = c >> 3, kc = c & 7;
    rv[i] = *reinterpret_cast<const u32x4*>(vb + (size_t)row * vs + kc * 8);
  }
}
template <int DQK>
DI void attn_sts(u16* sK, u16* sVT, const u32x4 (&rk)[DQK / 32], const u32x4 (&rv)[4]) {
  constexpr int CPR = DQK / 8;
  const int tid = TIDX;
#pragma unroll
  for (int i = 0; i < DQK / 32; ++i) {
    const int c = tid + 256 * i, row = c / CPR, kc = c % CPR;
    *reinterpret_cast<u32x4*>(sK + row * (DQK + 8) + kc * 8) = rk[i];
  }
#pragma unroll
  for (int i = 0; i < 4; ++i) {
    const int c = tid + 256 * i, row = c >> 3, kc = c & 7;
    *reinterpret_cast<u32x4*>(sVT + row * 72 + kc * 8) = rv[i];
  }
}

template <int DQK, bool NA>
DI void attn_run(const AttnSrc& src, const u16* qblk, int qstride, u16* sQ, u16* sK, u16* sVT, f32x16 (&O)[4], float& l_out,
                 int qr, int qc, int rsmin, const float* sBias) {
  const int tid = TIDX, lane = tid & 63, wid = tid >> 6;
  const int r = lane & 31, h = lane >> 5;
  const int pr = (r & 0x13) | ((r & 4) << 1) | ((r & 8) >> 1);
  constexpr int CPR = DQK / 8, QS = DQK + 8;
  constexpr bool DB = false;
  __syncthreads();
  bf16x8 qf[DB ? DQK / 16 : 1];
  if constexpr (DB) {
#pragma unroll
    for (int ks = 0; ks < DQK / 16; ++ks) qf[ks] = ld8(qblk + (size_t)(wid * 32 + r) * qstride + ks * 16 + 8 * h);
  } else {
#pragma unroll
    for (int i = 0; i < DQK / 16; ++i) {
      const int c = tid + 256 * i, row = c / CPR, kc = c % CPR;
      *reinterpret_cast<u32x4*>(sQ + row * QS + kc * 8) = *reinterpret_cast<const u32x4*>(qblk + (size_t)row * qstride + kc * 8);
    }
  }
#pragma unroll
  for (int d = 0; d < 4; ++d)
#pragma unroll
    for (int i = 0; i < 16; ++i) O[d][i] = 0.f;
  float m = -1e30f, l = 0.f;
  const int nt = src.n0 + src.n1;
  const int rsq = min(max(qr - 4, 0), 56);
  const int cs = min(max(qc - 8, 0), 48);
  const u16* qw = sQ + (wid * 32 + r) * QS + 8 * h;
  u16* sK1 = sQ;
  u16* sVT1 = sQ + 64 * QS;
  u32x4 rk[DQK / 32], rv[4];
  attn_ldg<DQK>(src, 0, rk, rv);
  if constexpr (DB) {
    attn_sts<DQK>(sK, sVT, rk, rv);
    if (nt > 1) attn_ldg<DQK>(src, 1, rk, rv);
    __syncthreads();
  }
#pragma unroll 1
  for (int j = 0; j < nt; ++j) {
    const u16* kw;
    const u16* vw;
    if constexpr (DB) {
      const int cur = j & 1;
      if (j + 1 < nt) { if (cur) attn_sts<DQK>(sK, sVT, rk, rv); else attn_sts<DQK>(sK1, sVT1, rk, rv); }
      if (j + 2 < nt) attn_ldg<DQK>(src, j + 2, rk, rv);
      kw = (cur ? sK1 : sK) + pr * QS + 8 * h;
      vw = (cur ? sVT1 : sVT) + r * 72 + 8 * h;
    } else {
      constexpr bool PF = (DQK != 64);
      if (!PF && j > 0) attn_ldg<DQK>(src, j, rk, rv);
      if (j > 0) __syncthreads();
      attn_sts<DQK>(sK, sVT, rk, rv);
      __syncthreads();
      if (PF && j + 1 < nt) attn_ldg<DQK>(src, j + 1, rk, rv);
      kw = sK + pr * QS + 8 * h;
      vw = sVT + r * 72 + 8 * h;
    }
    __builtin_amdgcn_sched_barrier(0);
    bool active = true;
    int kr = 0;
    if (NA && j >= src.n0) { kr = rsmin + (j - src.n0); active = (kr >= rsq) && (kr < rsq + 8); }
    if (active) {
      f32x16 s[2];
      __builtin_amdgcn_s_setprio(1);
#pragma unroll
      for (int t = 0; t < 2; ++t) {
#pragma unroll
        for (int i = 0; i < 16; ++i) s[t][i] = 0.f;
#pragma unroll
        for (int ks = 0; ks < DQK / 16; ++ks) {
          bf16x8 a = ld8(kw + t * 32 * QS + ks * 16);
          bf16x8 q;
          if constexpr (DB) q = qf[ks]; else q = ld8(qw + ks * 16);
          s[t] = mfma32(a, q, s[t]);
        }
      }
      __builtin_amdgcn_s_setprio(0);
      if (NA && j >= src.n0) {
        const float* bp = sBias + (kr - qr + 7) * 31 + (8 * h - qc + 15);
        const int kb = 8 * h - cs;
#pragma unroll
        for (int t = 0; t < 2; ++t)
#pragma unroll
          for (int i = 0; i < 16; ++i) {
            const int ko = t * 32 + 16 * (i >> 3) + (i & 7);
            const bool ok = (unsigned)(ko + kb) < 16u;
            const float bv = bp[ko];
            s[t][i] = ok ? s[t][i] + bv : -1e30f;
          }
      }
      float mx = -1e30f;
#pragma unroll
      for (int t = 0; t < 2; ++t)
#pragma unroll
        for (int i = 0; i < 16; ++i) mx = fmaxf(mx, s[t][i]);
      mx = fmaxf(mx, __shfl_xor(mx, 32));
      if (__builtin_amdgcn_ballot_w64(mx > m + 8.0f) != 0ull) {
        const float mn = fmaxf(m, mx);
        const float alpha = ex2(m - mn);
        l *= alpha;
        m = mn;
#pragma unroll
        for (int d = 0; d < 4; ++d)
#pragma unroll
          for (int i = 0; i < 16; ++i) O[d][i] *= alpha;
      }
      float rsum = 0.f;
#pragma unroll
      for (int t = 0; t < 2; ++t)
#pragma unroll
        for (int i = 0; i < 16; ++i) { const float e = ex2(s[t][i] - m); s[t][i] = e; rsum += e; }
      rsum += __shfl_xor(rsum, 32);
      l += rsum;
      __builtin_amdgcn_s_setprio(1);
#pragma unroll
      for (int s4 = 0; s4 < 4; ++s4) {
        const int t = s4 >> 1, b0 = (s4 & 1) * 8;
        u32x4 w = {pk2(s[t][b0], s[t][b0 + 1]), pk2(s[t][b0 + 2], s[t][b0 + 3]), pk2(s[t][b0 + 4], s[t][b0 + 5]), pk2(s[t][b0 + 6], s[t][b0 + 7])};
        const bf16x8 pf = __builtin_bit_cast(bf16x8, w);
#pragma unroll
        for (int d = 0; d < 4; ++d) {
          bf16x8 a = ld8(vw + d * 32 * 72 + s4 * 16);
          O[d] = mfma32(a, pf, O[d]);
        }
      }
      __builtin_amdgcn_s_setprio(0);
    }
    if constexpr (DB) __syncthreads();
  }
  l_out = l;
}

DI void heavy_map(int it, int& bh, int& qb) { const int x = it & 7, hf = (it >> 3) & 1, rest = it >> 4; qb = rest & 31; bh = x + 8 * (hf + 2 * (rest >> 5)); }

DI void diff_item(const Params& p, int l, bool sample, int bh, int qb, unsigned char* lds) {
  constexpr int NC = 6144;
  const int tid_ = TIDX, lane = tid_ & 63, wid = tid_ >> 6, r = lane & 31, h = lane >> 5;
  const int b = bh >> 3, hd = bh & 7;
  u16* sQ = reinterpret_cast<u16*>(lds);
  u16* sK = sQ + 128 * 136;
  u16* sVT = sK + 64 * 136;
  const u16* PROJ = reinterpret_cast<const u16*>(p.ws + WS_PROJ);
  const u16* VT = reinterpret_cast<const u16*>(p.ws + WS_VT);
  const int seq0 = sample ? TP + b * 4096 : b * 256;
  const int token = seq0 + qb * 128 + wid * 32 + r;
  const float* dl = p.in[20 + 10 * l];
  float pa = dl[lane] * dl[64 + lane], pb = dl[128 + lane] * dl[192 + lane];
#pragma unroll
  for (int o = 32; o >= 1; o >>= 1) { pa += __shfl_xor(pa, o); pb += __shfl_xor(pb, o); }
  const float lam_init = 0.8f - 0.6f * __expf(-0.3f * (float)l);
  const float lam = __expf(pa) - __expf(pb) + lam_init;

  u32 o1p[32];
  f32x16 O[4];
  float lsum;
#pragma unroll
  for (int comp = 0; comp < 2; ++comp) {
    AttnSrc s;
    if (sample) {
      s.k0 = reinterpret_cast<const u16*>(p.ws + WS_CK) + (size_t)l * 2097152 + (size_t)bh * 65536 + comp * 64; s.ks0 = 128;
      s.vt0 = reinterpret_cast<const u16*>(p.ws + WS_CVT) + (size_t)l * 2097152 + (size_t)bh * 65536; s.vs0 = 512; s.n0 = 8;
      s.k1 = PROJ + (size_t)seq0 * NC + 3072 + hd * 128 + comp * 64; s.ks1 = NC;
      s.vt1 = VT + 8388608 + (size_t)bh * 128 * 4096; s.vs1 = 4096; s.n1 = 64;
    } else {
      s.k0 = nullptr; s.vt0 = nullptr; s.ks0 = 0; s.vs0 = 0; s.n0 = 0;
      s.k1 = PROJ + (size_t)seq0 * NC + 3072 + hd * 128 + comp * 64; s.ks1 = NC;
      s.vt1 = VT + (size_t)bh * 128 * 256; s.vs1 = 256; s.n1 = 4;
    }
    const u16* qblk = PROJ + (size_t)(seq0 + qb * 128) * NC + 2048 + hd * 128 + comp * 64;
    attn_run<64, false>(s, qblk, NC, sQ, sK, sVT, O, lsum, 0, 0, 0, nullptr);
    const float inv = 1.f / lsum;
    if (comp == 0) {
#pragma unroll
      for (int d = 0; d < 4; ++d)
#pragma unroll
        for (int i = 0; i < 8; ++i) o1p[d * 8 + i] = pk2(O[d][2 * i] * inv, O[d][2 * i + 1] * inv);
    } else {
      float ssq = 0.f;
#pragma unroll
      for (int d = 0; d < 4; ++d)
#pragma unroll
        for (int i = 0; i < 8; ++i) {
          const u32 w = o1p[d * 8 + i];
          const float a = bflo(w) - lam * O[d][2 * i] * inv, c = bfhi(w) - lam * O[d][2 * i + 1] * inv;
          O[d][2 * i] = a; O[d][2 * i + 1] = c;
          ssq += a * a + c * c;
        }
      ssq += __shfl_xor(ssq, 32);
      const float rn = rsqrtf(ssq * (1.f / 128.f) + LN_EPS) * (1.f - lam_init);
      const float* subln = p.in[21 + 10 * l];
      const u16* gp = PROJ + (size_t)token * NC + 5120 + hd * 128;
      u16* yp = reinterpret_cast<u16*>(p.ws + WS_H) + (size_t)token * 2048 + 1024 + hd * 128;
#pragma unroll
      for (int d = 0; d < 4; ++d)
#pragma unroll
        for (int q = 0; q < 4; ++q) {
          const int dv = d * 32 + 8 * q + 4 * h;
          const u32x2 gw = *reinterpret_cast<const u32x2*>(gp + dv);
          const float4 sl = *reinterpret_cast<const float4*>(subln + dv);
          const float y0 = O[d][4 * q] * rn * sl.x * silu(bflo(gw[0]));
          const float y1 = O[d][4 * q + 1] * rn * sl.y * silu(bfhi(gw[0]));
          const float y2 = O[d][4 * q + 2] * rn * sl.z * silu(bflo(gw[1]));
          const float y3 = O[d][4 * q + 3] * rn * sl.w * silu(bfhi(gw[1]));
          *reinterpret_cast<u32x2*>(yp + dv) = (ZERO_MASK & 2) ? u32x2{0u, 0u} : u32x2{pk2(y0, y1), pk2(y2, y3)};
        }
    }
  }
}

DI void pool_item(const Params& p, int l, int pi, unsigned char* lds) {
  constexpr int NC = 6144;
  const int tid = TIDX, lane = tid & 63, wid = tid >> 6, fr = lane & 15, fq = lane >> 4;
  const int tb = pi >> 2, g = pi & 3, row0 = tb * 64;
  const int L = row0 < TP ? 256 : 4096;
  const int t0 = row0 < TP ? (row0 & 255) : ((row0 - TP) & 4095);
  u16* sIn = reinterpret_cast<u16*>(lds);
  u16* sP = sIn + 80 * 264;
  const u16* PROJ = reinterpret_cast<const u16*>(p.ws + WS_PROJ);
  __syncthreads();
#pragma unroll
  for (int i = 0; i < 10; ++i) {
    const int c = tid + 256 * i, rr = c >> 5, oc = c & 31;
    const int t = t0 - 8 + rr;
    u32x4 v = {0u, 0u, 0u, 0u};
    if (t >= 0 && t < L) v = *reinterpret_cast<const u32x4*>(PROJ + (size_t)(row0 - 8 + rr) * NC + g * 256 + oc * 8);
    *reinterpret_cast<u32x4*>(sIn + rr * 264 + oc * 8) = v;
  }
  __syncthreads();
  {
    const int oc = tid & 31, seg = tid >> 5;
    const int half = 1 << g;
#pragma unroll 1
    for (int tt = 0; tt < 8; ++tt) {
      const int tl = seg * 8 + tt, t = t0 + tl;
      const int lo = max(t - half, 0), hi = min(t + half, L);
      float a[8];
#pragma unroll
      for (int k = 0; k < 8; ++k) a[k] = 0.f;
      for (int s = lo; s < hi; ++s) {
        const u32x4 v = *reinterpret_cast<const u32x4*>(sIn + (s - t0 + 8) * 264 + oc * 8);
#pragma unroll
        for (int k = 0; k < 4; ++k) { a[2 * k] += bflo(v[k]); a[2 * k + 1] += bfhi(v[k]); }
      }
      const float ic = 1.f / (float)(hi - lo);
      const u32x4 x = *reinterpret_cast<const u32x4*>(sIn + (tl + 8) * 264 + oc * 8);
      u32x4 o;
#pragma unroll
      for (int k = 0; k < 4; ++k) o[k] = pk2(a[2 * k] * ic - bflo(x[k]), a[2 * k + 1] * ic - bfhi(x[k]));
      *reinterpret_cast<u32x4*>(sP + tl * 264 + oc * 8) = o;
    }
  }
  __syncthreads();
  const u16* W = reinterpret_cast<const u16*>(p.ws + WS_POOLWT) + (size_t)(l >> 1) * 262144 + (size_t)g * 65536;
  f32x4 acc[4][4];
#pragma unroll
  for (int a = 0; a < 4; ++a)
#pragma unroll
    for (int b = 0; b < 4; ++b) acc[a][b] = f32x4{0.f, 0.f, 0.f, 0.f};
#pragma unroll 2
  for (int ks = 0; ks < 8; ++ks) {
    bf16x8 af[4], bfr[4];
#pragma unroll
    for (int m = 0; m < 4; ++m) af[m] = ld8(sP + (m * 16 + fr) * 264 + ks * 32 + fq * 8);
#pragma unroll
    for (int n = 0; n < 4; ++n) bfr[n] = ld8(W + (size_t)(wid * 64 + n * 16 + fr) * 256 + ks * 32 + fq * 8);
#pragma unroll
    for (int m = 0; m < 4; ++m)
#pragma unroll
      for (int n = 0; n < 4; ++n) acc[m][n] = mfma16(bfr[n], af[m], acc[m][n]);
  }
  const float* pscale = p.in[19 + 10 * l];
  u16* Y = reinterpret_cast<u16*>(p.ws + WS_H);
#pragma unroll
  for (int n = 0; n < 4; ++n) {
    const int col = g * 256 + wid * 64 + n * 16 + 4 * fq;
    const float4 sc = *reinterpret_cast<const float4*>(pscale + col);
#pragma unroll
    for (int m = 0; m < 4; ++m) {
      const int row = row0 + m * 16 + fr;
      const u32x2 gw = *reinterpret_cast<const u32x2*>(PROJ + (size_t)row * NC + 1024 + col);
      float y0 = acc[m][n][0] * sc.x * silu(bflo(gw[0])), y1 = acc[m][n][1] * sc.y * silu(bfhi(gw[0]));
      float y2 = acc[m][n][2] * sc.z * silu(bflo(gw[1])), y3 = acc[m][n][3] * sc.w * silu(bfhi(gw[1]));
      if (ZERO_MASK & 1) { y0 = y1 = y2 = y3 = 0.f; }
      *reinterpret_cast<u32x2*>(Y + (size_t)row * 2048 + col) = u32x2{pk2(y0, y1), pk2(y2, y3)};
    }
  }
}

DI void phase_mix_even(const Params& p, int l, unsigned char* lds) {
#pragma unroll 1
  for (int it = VBID; it < 1024; it += VGRID) { int bh, qb; heavy_map(it, bh, qb); diff_item(p, l, true, bh, qb, lds); }
#pragma unroll 1
  for (int it = VBID; it < 512; it += VGRID) diff_item(p, l, false, it >> 1, it & 1, lds);
#pragma unroll 1
  for (int it = VBID; it < 1536; it += VGRID) pool_item(p, l, it, lds);
}

DI void na_item(const Params& p, int l, bool sample, int bh, int qb, unsigned char* lds) {
  constexpr int NC = 7168;
  const int tid = TIDX, lane = tid & 63, wid = tid >> 6, r = lane & 31, h = lane >> 5;
  const int b = bh >> 3, hd = bh & 7;
  u16* sQ = reinterpret_cast<u16*>(lds);
  u16* sK = sQ + 128 * 136;
  u16* sVT = sK + 64 * 136;
  float* sBias = reinterpret_cast<float*>(sVT + 128 * 72) + 64;
  const u16* PROJ = reinterpret_cast<const u16*>(p.ws + WS_PROJ);
  const u16* VT = reinterpret_cast<const u16*>(p.ws + WS_VT);
  const int seq0 = sample ? TP + b * 4096 : b * 256;
  const int token = seq0 + qb * 128 + wid * 32 + r;
  AttnSrc s;
  int qr = 0, qc = 0, rsmin = 0;
  f32x16 O[4];
  float lsum;
  const u16* qblk = PROJ + (size_t)(seq0 + qb * 128) * NC + hd * 128;
  if (sample) {
    __syncthreads();
    const float* rpb = p.in[18 + 10 * l] + hd * 465;
    for (int e = tid; e < 465; e += 256) sBias[e] = rpb[e] * LOG2E;
    const int r0 = qb * 2;
    qr = r0 + (wid >> 1); qc = (wid & 1) * 32 + r;
    rsmin = min(max(r0 - 4, 0), 56);
    const int rs1 = min(max(r0 - 3, 0), 56);
    s.k0 = reinterpret_cast<const u16*>(p.ws + WS_CK) + (size_t)l * 2097152 + (size_t)bh * 65536; s.ks0 = 128;
    s.vt0 = reinterpret_cast<const u16*>(p.ws + WS_CVT) + (size_t)l * 2097152 + (size_t)bh * 65536; s.vs0 = 512; s.n0 = 8;
    s.k1 = PROJ + (size_t)(seq0 + rsmin * 64) * NC + 1024 + hd * 128; s.ks1 = NC;
    s.vt1 = VT + 8388608 + (size_t)bh * 128 * 4096 + rsmin * 64; s.vs1 = 4096; s.n1 = rs1 + 8 - rsmin;
    attn_run<128, true>(s, qblk, NC, sQ, sK, sVT, O, lsum, qr, qc, rsmin, sBias);
  } else {
    s.k0 = nullptr; s.vt0 = nullptr; s.ks0 = 0; s.vs0 = 0; s.n0 = 0;
    s.k1 = PROJ + (size_t)seq0 * NC + 1024 + hd * 128; s.ks1 = NC;
    s.vt1 = VT + (size_t)bh * 128 * 256; s.vs1 = 256; s.n1 = 4;
    attn_run<128, false>(s, qblk, NC, sQ, sK, sVT, O, lsum, 0, 0, 0, nullptr);
  }
  const float inv = 1.f / lsum;
  const u16* gp = PROJ + (size_t)token * NC + 3072 + hd * 128;
  u16* yp = reinterpret_cast<u16*>(p.ws + WS_H) + (size_t)token * 2048 + hd * 128;
#pragma unroll
  for (int d = 0; d < 4; ++d)
#pragma unroll
    for (int q = 0; q < 4; ++q) {
      const int dv = d * 32 + 8 * q + 4 * h;
      const u32x2 gw = *reinterpret_cast<const u32x2*>(gp + dv);
      const float y0 = O[d][4 * q] * inv * silu(bflo(gw[0]));
      const float y1 = O[d][4 * q + 1] * inv * silu(bfhi(gw[0]));
      const float y2 = O[d][4 * q + 2] * inv * silu(bflo(gw[1]));
      const float y3 = O[d][4 * q + 3] * inv * silu(bfhi(gw[1]));
      *reinterpret_cast<u32x2*>(yp + dv) = (ZERO_MASK & 4) ? u32x2{0u, 0u} : u32x2{pk2(y0, y1), pk2(y2, y3)};
    }
}

DI void sgu_item(const Params& p, int l, int si, unsigned char* lds) {
  constexpr int NC = 7168;
  const int tid = TIDX, lane = tid & 63, wid = tid >> 6, fr = lane & 15, fq = lane >> 4;
  const int ch = si >> 2, g = si & 3, row0 = ch * 128;
  u16* vnT = reinterpret_cast<u16*>(lds);
  float* sMu = reinterpret_cast<float*>(vnT + 256 * 136);
  float* sRs = sMu + 128;
  const u16* PROJ = reinterpret_cast<const u16*>(p.ws + WS_PROJ);
  __syncthreads();
  {
    const int grp = tid >> 4, ln = tid & 15;
#pragma unroll 1
    for (int rr = 0; rr < 8; ++rr) {
      const u16* src = PROJ + (size_t)(row0 + grp * 8 + rr) * NC + 5120;
      float s = 0.f, ss = 0.f;
#pragma unroll
      for (int c8 = 0; c8 < 8; ++c8) {
        const u32x4 v = *reinterpret_cast<const u32x4*>(src + (ln + 16 * c8) * 8);
#pragma unroll
        for (int k = 0; k < 4; ++k) { const float a = bflo(v[k]), b = bfhi(v[k]); s += a + b; ss += a * a + b * b; }
      }
#pragma unroll
      for (int o = 8; o >= 1; o >>= 1) { s += __shfl_xor(s, o); ss += __shfl_xor(ss, o); }
      const float mu = s * (1.f / 1024.f);
      const float var = fmaxf(ss * (1.f / 1024.f) - mu * mu, 0.f);
      if (ln == 0) { sMu[grp * 8 + rr] = mu; sRs[grp * 8 + rr] = rsqrtf(var + LN_EPS); }
    }
  }
  __syncthreads();
  {
    const int j = tid & 127, hf = tid >> 7;
    const float mu = sMu[j], rs = sRs[j];
    const float* lng = p.in[19 + 10 * l] + g * 256;
    const u16* src = PROJ + (size_t)(row0 + j) * NC + 5120 + g * 256;
#pragma unroll 1
    for (int oc = hf * 16; oc < hf * 16 + 16; ++oc) {
      const u32x4 v = *reinterpret_cast<const u32x4*>(src + oc * 8);
      const float4 g0 = *reinterpret_cast<const float4*>(lng + oc * 8), g1 = *reinterpret_cast<const float4*>(lng + oc * 8 + 4);
      const float gg[8] = {g0.x, g0.y, g0.z, g0.w, g1.x, g1.y, g1.z, g1.w};
#pragma unroll
      for (int k = 0; k < 4; ++k) {
        const float a = (bflo(v[k]) - mu) * rs * gg[2 * k], b = (bfhi(v[k]) - mu) * rs * gg[2 * k + 1];
        const u32 w = pk2(a, b);
        vnT[(oc * 8 + 2 * k) * 136 + j] = (u16)(w & 0xffffu);
        vnT[(oc * 8 + 2 * k + 1) * 136 + j] = (u16)(w >> 16);
      }
    }
  }
  __syncthreads();
  const u16* W = reinterpret_cast<const u16*>(p.ws + WS_SGUW) + (size_t)(l >> 1) * 65536 + (size_t)g * 16384;
  const float* bs = p.in[21 + 10 * l] + g * 128;
  u16* Y = reinterpret_cast<u16*>(p.ws + WS_H);
#pragma unroll 1
  for (int ih = 0; ih < 2; ++ih) {
    f32x4 acc[4][4];
#pragma unroll
    for (int a = 0; a < 4; ++a)
#pragma unroll
      for (int b = 0; b < 4; ++b) acc[a][b] = f32x4{0.f, 0.f, 0.f, 0.f};
#pragma unroll
    for (int ks = 0; ks < 4; ++ks) {
      bf16x8 af[4], bfr[4];
#pragma unroll
      for (int m = 0; m < 4; ++m) af[m] = ld8(W + (size_t)(ih * 64 + m * 16 + fr) * 128 + ks * 32 + fq * 8);
#pragma unroll
      for (int n = 0; n < 4; ++n) bfr[n] = ld8(vnT + (wid * 64 + n * 16 + fr) * 136 + ks * 32 + fq * 8);
#pragma unroll
      for (int m = 0; m < 4; ++m)
#pragma unroll
        for (int n = 0; n < 4; ++n) acc[m][n] = mfma16(bfr[n], af[m], acc[m][n]);
    }
#pragma unroll
    for (int m = 0; m < 4; ++m) {
      const int ii = ih * 64 + m * 16 + fr;
      const float bias = bs[ii];
      const size_t rb = (size_t)(row0 + ii) * NC;
#pragma unroll
      for (int n = 0; n < 4; ++n) {
        const int c = g * 256 + wid * 64 + n * 16 + 4 * fq;
        const u32x2 uw = *reinterpret_cast<const u32x2*>(PROJ + rb + 4096 + c);
        const u32x2 dw = *reinterpret_cast<const u32x2*>(PROJ + rb + 6144 + c);
        float y0 = bflo(uw[0]) * (acc[m][n][0] + bias) * silu(bflo(dw[0])), y1 = bfhi(uw[0]) * (acc[m][n][1] + bias) * silu(bfhi(dw[0]));
        float y2 = bflo(uw[1]) * (acc[m][n][2] + bias) * silu(bflo(dw[1])), y3 = bfhi(uw[1]) * (acc[m][n][3] + bias) * silu(bfhi(dw[1]));
        if (ZERO_MASK & 8) { y0 = y1 = y2 = y3 = 0.f; }
        *reinterpret_cast<u32x2*>(Y + (size_t)(row0 + ii) * 2048 + 1024 + c) = u32x2{pk2(y0, y1), pk2(y2, y3)};
      }
    }
  }
}

DI void phase_mix_odd(const Params& p, int l, unsigned char* lds) {
#pragma unroll 1
  for (int it = VBID; it < 1024; it += VGRID) { int bh, qb; heavy_map(it, bh, qb); na_item(p, l, true, bh, qb, lds); }
#pragma unroll 1
  for (int it = VBID; it < 512; it += VGRID) na_item(p, l, false, it >> 1, it & 1, lds);
#pragma unroll 1
  for (int it = VBID; it < 768; it += VGRID) sgu_item(p, l, it, lds);
}

#define XB_TMO      128
#define XB_XCNT(j)  (256  + 64 * (j))
#define XB_XSUB(j)  (1280 + 64 * (j))
#define XB_XGEN(j)  (2304 + 64 * (j))
#define XB_TOP      3328
#define XB_TOPGEN   3392
#define XCD_BAR_WORDS 3456
#define XB_SPIN_CAP (1u << 18)
#define LAS __attribute__((address_space(3)))
DI unsigned xb_ld(unsigned* p)              { return __hip_atomic_load(p, __ATOMIC_RELAXED, __HIP_MEMORY_SCOPE_AGENT); }
DI unsigned xb_add(unsigned* p, unsigned v) { return __hip_atomic_fetch_add(p, v, __ATOMIC_RELAXED, __HIP_MEMORY_SCOPE_AGENT); }
DI unsigned xb_xcc_id() { return (unsigned)__builtin_amdgcn_s_getreg((3 << 11) | 20) & 0xFu; }
#define XB_SPIN(cond, bar) do { unsigned _sp = 0; while (cond) { __builtin_amdgcn_s_sleep(1); \
    if ((++_sp & 255u) == 0u) { if (xb_ld(&(bar)[XB_TMO])) break; if (_sp > XB_SPIN_CAP) { atomicAdd(&(bar)[XB_TMO], 1u); break; } } } } while (0)
struct XcdBarrier { unsigned* bar; unsigned x; volatile LAS unsigned* st; };
DI XcdBarrier xcd_barrier_post(unsigned* bar, volatile LAS unsigned* st) {
  XcdBarrier b; b.bar = bar; b.x = xb_xcc_id(); b.st = st;
  if (threadIdx.x == 0) (void)xb_add(&bar[XB_XCNT(b.x)], 1u);
  return b;
}
DI void xcd_barrier_complete(unsigned* bar, unsigned x, unsigned& nloc, unsigned& nx) {
  const unsigned G = gridDim.x * gridDim.y * gridDim.z;
  unsigned sum, cnt, mine, sp = 0u;
  for (;;) {
    sum = 0u; cnt = 0u; mine = 0u;
#pragma unroll
    for (unsigned j = 0; j < 16; ++j) { const unsigned c = xb_ld(&bar[XB_XCNT(j)]); sum += c; cnt += (c > 0u) ? 1u : 0u; mine = (j == x) ? c : mine; }
    if (sum == G) break;
    __builtin_amdgcn_s_sleep(1);
    if ((++sp & 255u) == 0u) { if (xb_ld(&bar[XB_TMO])) break; if (sp > XB_SPIN_CAP) { atomicAdd(&bar[XB_TMO], 1u); break; } }
  }
  nloc = mine > 0u ? mine : 1u; nx = cnt > 0u ? cnt : 1u;
}
DI void xcd_barrier(const XcdBarrier& b) {
  asm volatile("s_waitcnt vmcnt(0)" ::: "memory");
  __syncthreads();
  if (threadIdx.x == 0) {
    unsigned* bar = b.bar;
    __builtin_amdgcn_s_waitcnt(0);
    unsigned nloc = b.st[0], nx = b.st[1];
    if (nloc == 0u) { xcd_barrier_complete(bar, b.x, nloc, nx); b.st[0] = nloc; b.st[1] = nx; }
    const unsigned old = xb_add(&bar[XB_XSUB(b.x)], 1u);
    const unsigned gen = old / nloc;
    if (old + 1u == (gen + 1u) * nloc) {
      __builtin_amdgcn_fence(__ATOMIC_RELEASE, "agent");
      asm volatile("s_waitcnt vmcnt(0)" ::: "memory");
      const unsigned og = xb_add(&bar[XB_TOP], 1u);
      const unsigned tg = og / nx;
      if (og + 1u == (tg + 1u) * nx) xb_add(&bar[XB_TOPGEN], 1u);
      else XB_SPIN(xb_ld(&bar[XB_TOPGEN]) == tg, bar);
      __builtin_amdgcn_fence(__ATOMIC_ACQUIRE, "agent");
      xb_add(&bar[XB_XGEN(b.x)], 1u);
      asm volatile("s_waitcnt vmcnt(0)" ::: "memory");
    } else {
      XB_SPIN(xb_ld(&bar[XB_XGEN(b.x)]) == gen, bar);
      __builtin_amdgcn_fence(__ATOMIC_ACQUIRE, "agent");
      asm volatile("s_waitcnt vmcnt(0)" ::: "memory");
    }
  }
  __syncthreads();
}

__global__ void __launch_bounds__(512, 2) fwd_megakernel(Params p) {
  extern __shared__ __attribute__((aligned(16))) unsigned char lds[];
  cg::grid_group grid = cg::this_grid();
  volatile LAS unsigned* xst = (volatile LAS unsigned*)(lds + LDS_BYTES - 16);
  if (threadIdx.x == 0) { xst[0] = 0u; xst[1] = 0u; }
  __syncthreads();
  const XcdBarrier xb = xcd_barrier_post(reinterpret_cast<unsigned*>(p.ws + WS_BAR), xst);
  for (int ph = p.ph_lo; ph < p.ph_hi; ++ph) {
    unsigned char* hl = lds + HALF_ID * HALF_LDS;
    if (ph == 0) phase_prep(p, hl);
    else if (ph == 1) phase_mod0(p);
    else {
      const int l = (ph - 2) >> 2, s = (ph - 2) & 3;
      if (s == 0) { if (l & 1) gemm_phase<G_IN_ODD>(p, l, lds); else gemm_phase<G_IN_EVEN>(p, l, lds); }
      else if (s == 1) { if (l & 1) phase_mix_odd(p, l, hl); else phase_mix_even(p, l, hl); }
      else if (s == 2) gemm_phase<G_OUT>(p, l, lds);
      else phase_ln(p, l);
    }
    if (ph + 1 < p.ph_hi) {
      if (ph == p.ph_lo) grid.sync();
      else xcd_barrier(xb);
    }
  }
}

extern "C" void kernel_launch(void* const* d_in, const int* in_sizes, int n_in, void* d_out, int out_size, void* d_ws, size_t ws_size,
                              hipStream_t stream) {
  static int grid_blocks = 0;
  if (grid_blocks == 0) {
    if (n_in != 52 || ws_size < WS_END) {
      fprintf(stderr, "kernel_launch: expected 52 inputs and >= %zu bytes of workspace; got %d, %zu\n", (size_t)WS_END, n_in, ws_size);
      grid_blocks = -1;
      return;
    }
    int dev = 0, cus = 0, per_cu = 0;
    hipGetDevice(&dev);
    hipDeviceGetAttribute(&cus, hipDeviceAttributeMultiprocessorCount, dev);
    hipFuncSetAttribute((const void*)fwd_megakernel, hipFuncAttributeMaxDynamicSharedMemorySize, LDS_BYTES);
    hipOccupancyMaxActiveBlocksPerMultiprocessor(&per_cu, (const void*)fwd_megakernel, 512, LDS_BYTES);
    (void)hipGetLastError();
    grid_blocks = cus;
  }
  if (grid_blocks < 0) return;
  Params p{};
  for (int i = 0; i < 52; ++i) p.in[i] = (const float*)d_in[i];
  p.out = (float*)d_out;
  p.ws = (unsigned char*)d_ws;
#if MULTI
  for (int ph = 0; ph < NPHASE; ++ph) {
    p.ph_lo = ph; p.ph_hi = ph + 1;
    hipLaunchKernelGGL(fwd_megakernel, dim3(grid_blocks), dim3(512), LDS_BYTES, stream, p);
  }
#else
  p.ph_lo = 0; p.ph_hi = NPHASE;
  if (hipMemsetAsync((char*)d_ws + WS_BAR, 0, XCD_BAR_WORDS * 4, stream) != hipSuccess) { fprintf(stderr, "kernel_launch: memset of barrier words failed\n"); return; }
  void* args[] = {&p};
  hipError_t e = hipLaunchCooperativeKernel((const void*)fwd_megakernel, dim3(grid_blocks), dim3(512), args, LDS_BYTES, stream);
  if (e != hipSuccess) fprintf(stderr, "cooperative launch failed: %s (grid %d)\n", hipGetErrorString(e), grid_blocks);
#endif
}
```

```cpp
#include <hip/hip_runtime.h>
#include <hip/hip_cooperative_groups.h>
#include <cstdio>
namespace cg = cooperative_groups;

#define DI __device__ __forceinline__
typedef unsigned short u16;
typedef unsigned int u32;
using bf16x8 = __attribute__((ext_vector_type(8))) short;
using f32x4 = __attribute__((ext_vector_type(4))) float;
using f32x16 = __attribute__((ext_vector_type(16))) float;
using u32x4 = __attribute__((ext_vector_type(4))) unsigned;
using u32x2 = __attribute__((ext_vector_type(2))) unsigned;
typedef __bf16 bf2_t __attribute__((ext_vector_type(2)));
typedef float f2_t __attribute__((ext_vector_type(2)));

#ifndef MULTI
#define MULTI 0
#endif
#ifndef REP0
#define REP0 1
#endif
#ifndef REP1
#define REP1 1
#endif
#ifndef ZERO_MASK
#define ZERO_MASK 0
#endif

constexpr int T_ALL = 24576, TP = 8192, DM = 2048;
constexpr float LOG2E = 1.4426950408889634f;
constexpr float ALPHA = 1.6817928305074290f;
constexpr float LN_EPS = 1e-5f;
constexpr int HALF_LDS = 76288;
constexpr int LDS_BYTES = 2 * HALF_LDS + 16;
constexpr int NPHASE = 18;

constexpr size_t SZ_WIN_E = (size_t)6144 * 2048 * 2, SZ_WIN_O = (size_t)7168 * 2048 * 2;
constexpr size_t WS_WINT = 0;
constexpr size_t WS_WOUTT = WS_WINT + 2 * SZ_WIN_E + 2 * SZ_WIN_O;
constexpr size_t WS_POOLWT = WS_WOUTT + (size_t)4 * 2048 * 2048 * 2;
constexpr size_t WS_SGUW = WS_POOLWT + (size_t)2 * 4 * 256 * 256 * 2;
constexpr size_t WS_CK = WS_SGUW + (size_t)2 * 4 * 128 * 128 * 2;
constexpr size_t WS_CVT = WS_CK + (size_t)4 * 4194304;
constexpr size_t WS_MOD = WS_CVT + (size_t)4 * 4194304;
constexpr size_t WS_ROPE = WS_MOD + (size_t)4 * 5 * 6144 * 4;
constexpr size_t WS_H = WS_ROPE + 8192;
constexpr size_t WS_PROJ = WS_H + (size_t)T_ALL * 2048 * 2;
constexpr size_t WS_VT = WS_PROJ + (size_t)T_ALL * 7168 * 2;
constexpr size_t WS_BAR = WS_VT + (size_t)T_ALL * 1024 * 2;
constexpr size_t WS_END = WS_BAR + 16384;

struct Params {
  const float* in[52];
  float* out;
  unsigned char* ws;
  int ph_lo, ph_hi;
};

DI size_t ws_wint(int l) { return WS_WINT + (size_t)(l >> 1) * (SZ_WIN_E + SZ_WIN_O) + ((l & 1) ? SZ_WIN_E : 0); }

DI u32 pk2(float a, float b) { f2_t v = {a, b}; bf2_t r = __builtin_convertvector(v, bf2_t); return __builtin_bit_cast(u32, r); }
DI float bflo(u32 w) { return __uint_as_float(w << 16); }
DI float bfhi(u32 w) { return __uint_as_float(w & 0xffff0000u); }
DI float bf1(u16 w) { return __uint_as_float(((u32)w) << 16); }
DI float ex2(float x) { return __builtin_amdgcn_exp2f(x); }
DI float silu(float x) { return x / (1.f + __expf(-x)); }
DI f32x4 mfma16(bf16x8 a, bf16x8 b, f32x4 c) { return __builtin_amdgcn_mfma_f32_16x16x32_bf16(a, b, c, 0, 0, 0); }
DI f32x16 mfma32(bf16x8 a, bf16x8 b, f32x16 c) { return __builtin_amdgcn_mfma_f32_32x32x16_bf16(a, b, c, 0, 0, 0); }
DI bf16x8 ld8(const u16* p) { return *reinterpret_cast<const bf16x8*>(p); }
DI int opq(int x) { asm volatile("" : "+v"(x)); return x; }
#define TIDX (opq((int)threadIdx.x) & 255)
#define TID8 (opq((int)threadIdx.x))
#define HALF_ID (opq((int)threadIdx.x) >> 8)
#define VBID ((int)((blockIdx.x & 7u) | ((unsigned)HALF_ID << 3) | ((blockIdx.x >> 3) << 4)))
#define VGRID ((int)gridDim.x * 2)

enum { G_IN_EVEN = 0, G_IN_ODD = 1, G_OUT = 2 };

namespace pg8 {
#define PG8_LAS __attribute__((address_space(3)))
typedef unsigned short bf16_t;
typedef short bf16x8 __attribute__((ext_vector_type(8)));
typedef float f32x4 __attribute__((ext_vector_type(4)));
typedef unsigned u32x4 __attribute__((ext_vector_type(4)));
constexpr int BM = 256, BK = 64, HALF = 128, HTB = HALF * BK * 2  , STAGE_BYTES = 8 * HTB, NXCD = 8, WGM = 8;

__host__ __device__ __forceinline__ int lds_byte(int r, int c) { const int st = (r >> 4) * 2 + (c >> 5), rr = r & 15, cc = c & 31, ob = rr * 64 + cc * 2; return st * 1024 + (ob ^ (((ob >> 9) & 1) << 5)); }
__host__ __device__ __forceinline__ void stage_rc(int b, int& R, int& C) { const int st = b / 1024, sb = b % 1024, swz = sb ^ (((sb >> 9) & 1) << 5); R = (st >> 1) * 16 + swz / 64; C = (st & 1) * 32 + (swz % 64) / 2; }
__host__ __device__ __forceinline__ int perm32(int rho) { const int n = rho >> 4, i = rho & 15; return 8 * (i >> 2) + 4 * n + (i & 3); }

struct Unit { int pm, pn; };
struct Gemm { const bf16_t* A; const bf16_t* Bt; int M, N, K; };

struct StaticOrder {
    int nM, nN, nwg, G, c;
    __host__ __device__ void init(int M, int N, int G_, int c_) { nM = M / BM; nN = N / BM; nwg = nM * nN; G = G_; c = c_; }
    __host__ __device__ bool next(int i, Unit& u) const {
        const long L = (long)i * G + c; if (L >= nwg) return false;
        int wgid = (int)L; { const int q = nwg / NXCD, r = nwg % NXCD, xcd = wgid % NXCD, off = wgid / NXCD; wgid = (xcd < r ? xcd * (q + 1) : r * (q + 1) + (xcd - r) * q) + off; }
        const int nig = WGM * nN, gid = wgid / nig, fm = gid * WGM, gsz = (nM - fm) < WGM ? (nM - fm) : WGM;
        u.pm = fm + ((wgid % nig) % gsz); u.pn = (wgid % nig) / gsz; return true;
    }
    __device__ __forceinline__ void a_ready(const Unit&) const {}
    __device__ __forceinline__ void done(const Unit&) const {}
};

template <class Epi, class Sched, bool STAMP = false>
__device__ __forceinline__ void gemm_phase(PG8_LAS unsigned char* lds, const Gemm g, const Sched& S, const Epi& E, unsigned long long* stamps) {
    const int tid = opq((int)threadIdx.x), wid = __builtin_amdgcn_readfirstlane(tid >> 6), lane = tid & 63, wr = wid >> 2, wc = wid & 3, fr = lane & 15, fq = lane >> 4;
    const int K = g.K, nt = K / BK;
    int ts_lo = 0, ts_hi = 0, nts = 0; const unsigned long long rt_entry = STAMP ? (unsigned long long)wall_clock64() : 0ull;
#define PG8_STAMP() do { if (STAMP && wid == 0 && nts < 64) { const unsigned long long _c = (unsigned long long)clock64(); \
        ts_lo = (lane == nts) ? (int)(unsigned)_c : ts_lo; ts_hi = (lane == nts) ? (int)(unsigned)(_c >> 32) : ts_hi; ++nts; } } while (0)
    PG8_STAMP();
    unsigned voffA[2], voffB[2];
#pragma unroll
    for (int i = 0; i < 2; ++i) { int R, C; stage_rc(tid * 16 + i * 8192, R, C); const int Rb = Epi::PERM ? ((R & ~31) + perm32(R & 31)) : R;
        voffA[i] = (unsigned)(R * K + C) * 2u; voffB[i] = (unsigned)(Rb * K + C) * 2u; }
    const size_t kstep = (size_t)(BK * 2);
    const size_t hstep = (size_t)HALF * K * 2;
    const size_t tstep = 2 * hstep;
    const unsigned ldsw = (unsigned)wid * 1024u;
    const int aoff = lds_byte(wr * 64 + fr, fq * 8), boff = lds_byte(wc * 32 + fr, fq * 8);
#define PG8_SA(b, h) (((b) * 2 + (h)) * HTB)
#define PG8_SB(b, h) ((4 + (b) * 2 + (h)) * HTB)
#define PG8_STAGE(bufoff, gbase, voff) do { _Pragma("unroll") for (int _i = 0; _i < 2; ++_i) \
        __builtin_amdgcn_global_load_lds((const unsigned*)((const char*)(gbase) + (voff)[_i]), (PG8_LAS unsigned*)(lds + (bufoff) + ldsw + _i * 8192), 16, 0, 0); } while (0)
#define PG8_LDA(dst, b, h) do { _Pragma("unroll") for (int m = 0; m < 4; ++m) _Pragma("unroll") for (int k = 0; k < 2; ++k) dst[m][k] = *(const PG8_LAS bf16x8*)(lds + PG8_SA(b, h) + aoff + m * 2048 + k * 1024); } while (0)
#define PG8_LDB(dst, b, h) do { _Pragma("unroll") for (int n = 0; n < 2; ++n) _Pragma("unroll") for (int k = 0; k < 2; ++k) dst[n][k] = *(const PG8_LAS bf16x8*)(lds + PG8_SB(b, h) + boff + n * 2048 + k * 1024); } while (0)
#define PG8_MMA(ai, bj, At, Bt) do { __builtin_amdgcn_s_setprio(1); _Pragma("unroll") for (int m = 0; m < 4; ++m) _Pragma("unroll") for (int n = 0; n < 2; ++n) _Pragma("unroll") for (int k = 0; k < 2; ++k) \
        acc[ai][bj][m][n] = __builtin_amdgcn_mfma_f32_16x16x32_bf16(Bt[n][k], At[m][k], acc[ai][bj][m][n], 0, 0, 0); __builtin_amdgcn_s_setprio(0); } while (0)
#define PG8_WAIT_V(n) asm volatile("s_waitcnt vmcnt(" #n ")" ::: "memory")
#define PG8_WAIT_L(n) asm volatile("s_waitcnt lgkmcnt(" #n ")" ::: "memory")
#define PG8_BAR __builtin_amdgcn_s_barrier()
#define PG8_SCHED __builtin_amdgcn_sched_barrier(0)
    Unit cur, nxt; int ui = 0;
    if (!S.next(0, cur)) return;
    f32x4 acc[2][2][4][2];
#pragma unroll
    for (int a = 0; a < 2; ++a)
#pragma unroll
        for (int b = 0; b < 2; ++b)
#pragma unroll
            for (int m = 0; m < 4; ++m)
#pragma unroll
                for (int n = 0; n < 2; ++n) acc[a][b][m][n] = (f32x4){0.f, 0.f, 0.f, 0.f};
    bf16x8 At[4][2], B0[2][2], B1[2][2];
    const char* cA = (const char*)g.A + (size_t)cur.pm * tstep; const char* cB = (const char*)g.Bt + (size_t)cur.pn * tstep;
    S.a_ready(cur);
    PG8_STAGE(PG8_SB(0, 0), cB, voffB); PG8_STAGE(PG8_SA(0, 0), cA, voffA); PG8_STAGE(PG8_SB(0, 1), cB + hstep, voffB); PG8_STAGE(PG8_SA(0, 1), cA + hstep, voffA);
    if (wr == 1) PG8_BAR;
    PG8_WAIT_V(4); PG8_BAR;
    PG8_STAGE(PG8_SB(1, 0), cB + kstep, voffB); PG8_STAGE(PG8_SA(1, 0), cA + kstep, voffA); PG8_STAGE(PG8_SB(1, 1), cB + hstep + kstep, voffB);
    PG8_WAIT_V(6); PG8_BAR;
    PG8_STAMP();
    for (;;) {
        const bool has_next = S.next(ui + 1, nxt);
        const char* nA = has_next ? (const char*)g.A + (size_t)nxt.pm * tstep : cA; const char* nB = has_next ? (const char*)g.Bt + (size_t)nxt.pn * tstep : cB;
        for (int t = 0; t < nt; t += 2) {
            const bool last = (t == nt - 2);
            const char* a1 = cA + (size_t)(t + 1) * kstep;
            const char* a2 = last ? nA : cA + (size_t)(t + 2) * kstep; const char* b2 = last ? nB : cB + (size_t)(t + 2) * kstep;
            const char* a3 = a2 + kstep; const char* b3 = b2 + kstep;
            if (last && has_next) S.a_ready(nxt);
            PG8_LDB(B0, 0, 0); PG8_SCHED; PG8_LDA(At, 0, 0); PG8_STAGE(PG8_SA(1, 1), a1 + hstep, voffA);
            PG8_WAIT_L(8); PG8_BAR; PG8_WAIT_L(0); PG8_MMA(0, 0, At, B0); PG8_BAR; PG8_SCHED;
            PG8_LDB(B1, 0, 1); PG8_STAGE(PG8_SB(0, 0), b2, voffB);
            PG8_BAR; PG8_WAIT_L(0); PG8_MMA(0, 1, At, B1); PG8_BAR;
            PG8_LDA(At, 0, 1); PG8_STAGE(PG8_SA(0, 0), a2, voffA);
            PG8_BAR; PG8_WAIT_L(0); PG8_MMA(1, 0, At, B0); PG8_BAR; PG8_SCHED;
            PG8_STAGE(PG8_SB(0, 1), b2 + hstep, voffB);
            PG8_WAIT_V(6); PG8_BAR; PG8_MMA(1, 1, At, B1); PG8_BAR;
            PG8_LDB(B0, 1, 0); PG8_SCHED; PG8_LDA(At, 1, 0); PG8_STAGE(PG8_SA(0, 1), a2 + hstep, voffA);
            PG8_WAIT_L(8); PG8_BAR; PG8_WAIT_L(0); PG8_MMA(0, 0, At, B0); PG8_BAR; PG8_SCHED;
            PG8_LDB(B1, 1, 1); PG8_STAGE(PG8_SB(1, 0), b3, voffB);
            PG8_BAR; PG8_WAIT_L(0); PG8_MMA(0, 1, At, B1); PG8_BAR;
            PG8_LDA(At, 1, 1); PG8_STAGE(PG8_SA(1, 0), a3, voffA);
            PG8_BAR; PG8_WAIT_L(0); PG8_MMA(1, 0, At, B0); PG8_BAR; PG8_SCHED;
            PG8_STAGE(PG8_SB(1, 1), b3 + hstep, voffB);
            PG8_WAIT_V(6); PG8_BAR; PG8_MMA(1, 1, At, B1); PG8_BAR;
        }
        PG8_STAMP();
        if constexpr (!Epi::AFTER_DRAIN) { E(acc, cur, wr, wc, fr, fq); S.done(cur); }
        PG8_STAMP();
        if (!has_next) break;
#pragma unroll
        for (int a = 0; a < 2; ++a)
#pragma unroll
            for (int b = 0; b < 2; ++b)
#pragma unroll
                for (int m = 0; m < 4; ++m)
#pragma unroll
                    for (int n = 0; n < 2; ++n) acc[a][b][m][n] = (f32x4){0.f, 0.f, 0.f, 0.f};
        cur = nxt; cA = nA; cB = nB; ++ui;
    }
    PG8_WAIT_V(0);
    if (wr == 0) PG8_BAR;
    PG8_BAR;
    if constexpr (Epi::AFTER_DRAIN) { E.fused(acc, cur, wr, wc, fr, fq, lds, wid, lane); S.done(cur); }
    PG8_STAMP();
    if (STAMP && wid == 0) { stamps[lane] = lane < nts ? (((unsigned long long)(unsigned)ts_hi << 32) | (unsigned)ts_lo) : 0ull;
        if (lane == 62) stamps[62] = rt_entry; if (lane == 63) stamps[63] = (unsigned long long)wall_clock64(); }
#undef PG8_STAMP
#undef PG8_SA
#undef PG8_SB
#undef PG8_STAGE
#undef PG8_LDA
#undef PG8_LDB
#undef PG8_MMA
#undef PG8_WAIT_V
#undef PG8_WAIT_L
#undef PG8_BAR
#undef PG8_SCHED
}
}

DI void tr_tile(const float* __restrict__ src, size_t ld_src, u16* __restrict__ dst, size_t ld_dst, float* sT) {
  const int tid = TIDX;
  const int r = tid >> 4, c4 = (tid & 15) * 4;
#pragma unroll
  for (int i = 0; i < 4; ++i) {
    float4 v = *reinterpret_cast<const float4*>(src + (size_t)(r + 16 * i) * ld_src + c4);
    float* d = sT + (r + 16 * i) * 65 + c4;
    d[0] = v.x; d[1] = v.y; d[2] = v.z; d[3] = v.w;
  }
  __syncthreads();
  const int n = tid >> 2, ks = (tid & 3) * 16;
  u32 w[8];
#pragma unroll
  for (int j = 0; j < 8; ++j) w[j] = pk2(sT[(ks + 2 * j) * 65 + n], sT[(ks + 2 * j + 1) * 65 + n]);
  u32x4* o = reinterpret_cast<u32x4*>(dst + (size_t)n * ld_dst + ks);
  o[0] = u32x4{w[0], w[1], w[2], w[3]};
  o[1] = u32x4{w[4], w[5], w[6], w[7]};
  __syncthreads();
}

DI void cvt8(const float* __restrict__ src, u16* __restrict__ dst) {
  float4 a = *reinterpret_cast<const float4*>(src);
  float4 b = *reinterpret_cast<const float4*>(src + 4);
  *reinterpret_cast<u32x4*>(dst) = u32x4{pk2(a.x, a.y), pk2(a.z, a.w), pk2(b.x, b.y), pk2(b.z, b.w)};
}

DI void mod_item(const Params& p, int i, unsigned char* lds) {
  const int tid = TIDX;
  const int l = i / 96, n0 = (i % 96) * 64;
  float* sS = reinterpret_cast<float*>(lds);
  float* red = sS + 5 * 2048;
  const float* c = p.in[10];
  const float* cctx = p.in[11];
  for (int e = tid; e < 5 * 2048; e += 256) {
    int v = e >> 11, k = e & 2047;
    float x = (v == 0) ? cctx[k] : c[(v - 1) * 2048 + k];
    sS[e] = silu(x);
  }
  __syncthreads();
  const int kk = tid >> 4, c4 = (tid & 15) * 4;
  const float* W = p.in[12 + 10 * l] + n0 + c4;
  f32x4 acc[5];
#pragma unroll
  for (int v = 0; v < 5; ++v) acc[v] = f32x4{0.f, 0.f, 0.f, 0.f};
#pragma unroll 8
  for (int k = kk; k < 2048; k += 16) {
    float4 w = *reinterpret_cast<const float4*>(W + (size_t)k * 6144);
#pragma unroll
    for (int v = 0; v < 5; ++v) {
      float s = sS[v * 2048 + k];
      acc[v][0] += s * w.x; acc[v][1] += s * w.y; acc[v][2] += s * w.z; acc[v][3] += s * w.w;
    }
  }
#pragma unroll
  for (int v = 0; v < 5; ++v)
#pragma unroll
    for (int q = 0; q < 4; ++q) red[(kk * 5 + v) * 64 + c4 + q] = acc[v][q];
  __syncthreads();
  for (int t2 = tid; t2 < 320; t2 += 256) {
    int v = t2 >> 6, n = t2 & 63;
    float s = 0.f;
#pragma unroll
    for (int k2 = 0; k2 < 16; ++k2) s += red[(k2 * 5 + v) * 64 + n];
    float* mod = reinterpret_cast<float*>(p.ws + WS_MOD);
    mod[(size_t)(l * 5 + v) * 6144 + n0 + n] = s + p.in[13 + 10 * l][n0 + n];
  }
  __syncthreads();
}

DI void phase_prep(const Params& p, unsigned char* lds) {
  constexpr int N_MOD = 384, N_TRWIN = 13312, N_TRWOUT = 4096, N_TRPOOL = 128, N_SGU = 64, N_CK = 4096, N_CV = 2048;
  constexpr int TOTAL = N_MOD + N_TRWIN + N_TRWOUT + N_TRPOOL + N_SGU + N_CK + N_CV + 1;
  const int tid = TIDX;
  float* sT = reinterpret_cast<float*>(lds);
  for (int it = VBID; it < TOTAL; it += VGRID) {
    int i = it;
    if (i < N_MOD) { mod_item(p, i, lds); continue; }
    i -= N_MOD;
    if (i < N_TRWIN) {
      int l, base;
      if (i < 3072) { l = 0; base = 0; } else if (i < 6656) { l = 1; base = 3072; } else if (i < 9728) { l = 2; base = 6656; } else { l = 3; base = 9728; }
      i -= base;
      const int N = (l & 1) ? 7168 : 6144, nN = N / 64;
      const int kt = i / nN, nt = i % nN;
      tr_tile(p.in[14 + 10 * l] + (size_t)kt * 64 * N + nt * 64, N,
              reinterpret_cast<u16*>(p.ws + ws_wint(l)) + (size_t)nt * 64 * 2048 + kt * 64, 2048, sT);
      continue;
    }
    i -= N_TRWIN;
    if (i < N_TRWOUT) {
      const int l = i >> 10, r = i & 1023, kt = r >> 5, nt = r & 31;
      tr_tile(p.in[15 + 10 * l] + (size_t)kt * 64 * 2048 + nt * 64, 2048,
              reinterpret_cast<u16*>(p.ws + WS_WOUTT) + (size_t)l * 2048 * 2048 + (size_t)nt * 64 * 2048 + kt * 64, 2048, sT);
      continue;
    }
    i -= N_TRWOUT;
    if (i < N_TRPOOL) {
      const int e = i >> 6, r = i & 63, g = r >> 4, t = r & 15, kt = t >> 2, nt = t & 3;
      tr_tile(p.in[18 + 20 * e] + (size_t)g * 65536 + kt * 64 * 256 + nt * 64, 256,
              reinterpret_cast<u16*>(p.ws + WS_POOLWT) + (size_t)e * 262144 + g * 65536 + nt * 64 * 256 + kt * 64, 256, sT);
      continue;
    }
    i -= N_TRPOOL;
    if (i < N_SGU) {
      const int e = i >> 5, ch = i & 31;
      const size_t off = (size_t)ch * 2048 + tid * 8;
      cvt8(p.in[30 + 20 * e] + off, reinterpret_cast<u16*>(p.ws + WS_SGUW) + (size_t)e * 65536 + off);
      continue;
    }
    i -= N_SGU;
    if (i < N_CK) {
      const int l = i >> 10, ch = i & 1023;
      const size_t off = (size_t)ch * 2048 + tid * 8;
      cvt8(p.in[2 + 2 * l] + off, reinterpret_cast<u16*>(p.ws + WS_CK) + (size_t)l * 2097152 + off);
      continue;
    }
    i -= N_CK;
    if (i < N_CV) {
      const int l = i >> 9, r = i & 511, bh = r >> 4, t = r & 15, kt = t >> 1, nt = t & 1;
      tr_tile(p.in[3 + 2 * l] + (size_t)bh * 65536 + kt * 64 * 128 + nt * 64, 128,
              reinterpret_cast<u16*>(p.ws + WS_CVT) + (size_t)l * 2097152 + (size_t)bh * 65536 + nt * 64 * 512 + kt * 64, 512, sT);
      continue;
    }
    {
      float* rc = reinterpret_cast<float*>(p.ws + WS_ROPE);
      for (int e = tid; e < 1024; e += 256) {
        int pos = e >> 4, fi = e & 15;
        float inv = 1.0f / powf(10000.0f, (float)(2 * fi) / 32.0f);
        float ang = (float)pos * inv;
        rc[e] = cosf(ang);
        rc[1024 + e] = sinf(ang);
      }
    }
  }
}

DI void phase_mod0(const Params& p) {
  const int tid = TIDX;
  const float* mod = reinterpret_cast<const float*>(p.ws + WS_MOD);
  u16* H = reinterpret_cast<u16*>(p.ws + WS_H);
  for (int it = VBID; it < T_ALL / 4; it += VGRID) {
#pragma unroll
    for (int rr = 0; rr < 4; ++rr) {
      const int row = it * 4 + rr;
      const int cond = row < TP ? 0 : 1 + ((row - TP) >> 12);
      const float* src = row < TP ? p.in[0] + (size_t)row * 2048 : p.in[1] + (size_t)(row - TP) * 2048;
      const int e = tid * 8;
      const float* sh = mod + (size_t)cond * 6144 + e;
      float4 a = *reinterpret_cast<const float4*>(src + e), b = *reinterpret_cast<const float4*>(src + e + 4);
      float4 s0 = *reinterpret_cast<const float4*>(sh), s1 = *reinterpret_cast<const float4*>(sh + 4);
      float4 c0 = *reinterpret_cast<const float4*>(sh + 2048), c1 = *reinterpret_cast<const float4*>(sh + 2052);
      u32x4 o = {pk2(a.x * (1.f + c0.x) + s0.x, a.y * (1.f + c0.y) + s0.y), pk2(a.z * (1.f + c0.z) + s0.z, a.w * (1.f + c0.w) + s0.w),
                 pk2(b.x * (1.f + c1.x) + s1.x, b.y * (1.f + c1.y) + s1.y), pk2(b.z * (1.f + c1.z) + s1.z, b.w * (1.f + c1.w) + s1.w)};
      *reinterpret_cast<u32x4*>(H + (size_t)row * 2048 + e) = o;
    }
  }
}


template <int MODE>
struct EpiIn {
  static constexpr bool PERM = false, AFTER_DRAIN = false;
  u16* PROJ; u16* VT; float* kout; float* vout; const float* ropeC; const float* ropeS;
  DI void operator()(const f32x4 (&acc)[2][2][4][2], const pg8::Unit& u, int wr, int wc, int fr, int fq) const {
    constexpr int NC = (MODE == G_IN_EVEN) ? 6144 : 7168;
    constexpr int SEC_Q = (MODE == G_IN_EVEN) ? 2 : 0, SEC_K = (MODE == G_IN_EVEN) ? 3 : 1, SEC_V = (MODE == G_IN_EVEN) ? 4 : 2;
    const int sec = u.pn >> 2;
    const bool prompt = u.pm < 32;
    const bool isq = sec == SEC_Q, isk = sec == SEC_K;
    const bool rope = (MODE == G_IN_EVEN) && (isq || isk) && !prompt;
    const float sc = isq ? ((MODE == G_IN_EVEN) ? 0.125f * LOG2E : 0.08838834764831845f * LOG2E) : 1.0f;
#pragma unroll
    for (int ai = 0; ai < 2; ++ai)
#pragma unroll
      for (int m = 0; m < 4; ++m) {
        const int row = u.pm * 256 + ai * 128 + wr * 64 + m * 16 + fr;
        int b, t;
        if (prompt) { b = row >> 8; t = row & 255; } else { const int rs = row - TP; b = rs >> 12; t = rs & 4095; }
#pragma unroll
        for (int bj = 0; bj < 2; ++bj) {
          const int hh = (u.pn & 3) * 2 + bj;
          const int d0 = wc * 32 + 4 * fq;
          if (sec == SEC_V) {
#pragma unroll
            for (int n = 0; n < 2; ++n) {
              const f32x4 v = acc[ai][bj][m][n];
              const int dv = d0 + 16 * n;
              const u32 w01 = pk2(v[0], v[1]), w23 = pk2(v[2], v[3]);
              if (prompt) {
                u16* vt = VT + ((size_t)((b * 8 + hh) * 128 + dv)) * 256 + t;
                vt[0] = (u16)(w01 & 0xffffu); vt[256] = (u16)(w01 >> 16); vt[512] = (u16)(w23 & 0xffffu); vt[768] = (u16)(w23 >> 16);
                *reinterpret_cast<float4*>(vout + ((size_t)((b * 8 + hh) * 256 + t)) * 128 + dv) = float4{v[0], v[1], v[2], v[3]};
              } else {
                u16* vt = VT + 8388608 + ((size_t)((b * 8 + hh) * 128 + dv)) * 4096 + t;
                vt[0] = (u16)(w01 & 0xffffu); vt[4096] = (u16)(w01 >> 16); vt[8192] = (u16)(w23 & 0xffffu); vt[12288] = (u16)(w23 >> 16);
              }
            }
          } else {
            f32x4 v0 = acc[ai][bj][m][0], v1 = acc[ai][bj][m][1];
            if (isk && prompt) {
              float* ko = kout + ((size_t)((b * 8 + hh) * 256 + t)) * 128 + d0;
              *reinterpret_cast<float4*>(ko) = float4{v0[0], v0[1], v0[2], v0[3]};
              *reinterpret_cast<float4*>(ko + 16) = float4{v1[0], v1[1], v1[2], v1[3]};
            }
            if (rope) {
              const int pos = (wc & 1) ? (t & 63) : (t >> 6);
              const float4 cs = *reinterpret_cast<const float4*>(ropeC + pos * 16 + 4 * fq);
              const float4 sn = *reinterpret_cast<const float4*>(ropeS + pos * 16 + 4 * fq);
              const float c4[4] = {cs.x, cs.y, cs.z, cs.w}, s4[4] = {sn.x, sn.y, sn.z, sn.w};
#pragma unroll
              for (int j = 0; j < 4; ++j) {
                const float x1 = v0[j], x2 = v1[j];
                v0[j] = x1 * c4[j] - x2 * s4[j];
                v1[j] = x1 * s4[j] + x2 * c4[j];
              }
            }
            u16* dst = PROJ + (size_t)row * NC + u.pn * 256 + bj * 128 + d0;
            *reinterpret_cast<u32x2*>(dst) = u32x2{pk2(v0[0] * sc, v0[1] * sc), pk2(v0[2] * sc, v0[3] * sc)};
            *reinterpret_cast<u32x2*>(dst + 16) = u32x2{pk2(v1[0] * sc, v1[1] * sc), pk2(v1[2] * sc, v1[3] * sc)};
          }
        }
      }
  }
};

struct EpiOut {
  static constexpr bool PERM = false, AFTER_DRAIN = false;
  float* X; const float* x0; const float* x1; const float* mod; int l;
  DI void operator()(const f32x4 (&acc)[2][2][4][2], const pg8::Unit& u, int wr, int wc, int fr, int fq) const {
    const bool prompt = u.pm < 32;
    const int cond = prompt ? 0 : 1 + ((u.pm * 256 - TP) >> 12);
    const float* gate = mod + (size_t)(l * 5 + cond) * 6144 + 4096;
#pragma unroll
    for (int bj = 0; bj < 2; ++bj)
#pragma unroll
      for (int n = 0; n < 2; ++n) {
        const int col = u.pn * 256 + bj * 128 + wc * 32 + 16 * n + 4 * fq;
        const float4 g4 = *reinterpret_cast<const float4*>(gate + col);
#pragma unroll
        for (int ai = 0; ai < 2; ++ai)
#pragma unroll
          for (int m = 0; m < 4; ++m) {
            const int row = u.pm * 256 + ai * 128 + wr * 64 + m * 16 + fr;
            float4 xo;
            if (l == 0) xo = prompt ? *reinterpret_cast<const float4*>(x0 + (size_t)row * 2048 + col)
                                    : *reinterpret_cast<const float4*>(x1 + (size_t)(row - TP) * 2048 + col);
            else xo = *reinterpret_cast<const float4*>(X + (size_t)row * 2048 + col);
            const f32x4 a = acc[ai][bj][m][n];
            float4 o;
            o.x = ALPHA * xo.x + g4.x * a[0]; o.y = ALPHA * xo.y + g4.y * a[1];
            o.z = ALPHA * xo.z + g4.z * a[2]; o.w = ALPHA * xo.w + g4.w * a[3];
            *reinterpret_cast<float4*>(X + (size_t)row * 2048 + col) = o;
          }
      }
  }
};

template <int MODE>
DI void gemm_phase(const Params& p, int l, unsigned char* lds) {
  constexpr int N = (MODE == G_OUT) ? 2048 : (MODE == G_IN_EVEN ? 6144 : 7168);
  pg8::Gemm g;
  g.A = reinterpret_cast<const u16*>(p.ws + WS_H);
  g.Bt = (MODE == G_OUT) ? reinterpret_cast<const u16*>(p.ws + WS_WOUTT) + (size_t)l * 2048 * 2048
                         : reinterpret_cast<const u16*>(p.ws + ws_wint(l));
  g.M = T_ALL; g.N = N; g.K = 2048;
  pg8::StaticOrder S;
  S.init(T_ALL, N, (int)gridDim.x, (int)blockIdx.x);
  PG8_LAS unsigned char* l3 = (PG8_LAS unsigned char*)lds;
  if constexpr (MODE == G_OUT) {
    EpiOut E;
    E.X = p.out; E.x0 = p.in[0]; E.x1 = p.in[1]; E.mod = reinterpret_cast<const float*>(p.ws + WS_MOD); E.l = l;
    pg8::gemm_phase<EpiOut, pg8::StaticOrder, false>(l3, g, S, E, nullptr);
  } else {
    EpiIn<MODE> E;
    E.PROJ = reinterpret_cast<u16*>(p.ws + WS_PROJ); E.VT = reinterpret_cast<u16*>(p.ws + WS_VT);
    E.kout = p.out + (size_t)T_ALL * 2048 + (size_t)(2 * l) * 8388608;
    E.vout = p.out + (size_t)T_ALL * 2048 + (size_t)(2 * l + 1) * 8388608;
    E.ropeC = reinterpret_cast<const float*>(p.ws + WS_ROPE); E.ropeS = E.ropeC + 1024;
    pg8::gemm_phase<EpiIn<MODE>, pg8::StaticOrder, false>(l3, g, S, E, nullptr);
  }
}

DI void phase_ln(const Params& p, int l) {
  const int tid_ = TIDX, lane = tid_ & 63, wid = tid_ >> 6;
  const float* g = p.in[16 + 10 * l];
  const float* bb = p.in[17 + 10 * l];
  const float* mod = reinterpret_cast<const float*>(p.ws + WS_MOD);
  u16* H = reinterpret_cast<u16*>(p.ws + WS_H);
  float* X = p.out;
  for (int it = VBID; it < T_ALL / 4; it += VGRID) {
    const int row = it * 4 + wid;
    float* xr = X + (size_t)row * 2048;
    float4 v[8];
    float s = 0.f;
#pragma unroll
    for (int i = 0; i < 8; ++i) {
      v[i] = *reinterpret_cast<const float4*>(xr + (i * 64 + lane) * 4);
      s += v[i].x + v[i].y + v[i].z + v[i].w;
    }
#pragma unroll
    for (int o = 32; o >= 1; o >>= 1) s += __shfl_xor(s, o);
    const float mu = s * (1.f / 2048.f);
    float ss = 0.f;
#pragma unroll
    for (int i = 0; i < 8; ++i) {
      float a = v[i].x - mu, b = v[i].y - mu, c = v[i].z - mu, d = v[i].w - mu;
      ss += a * a + b * b + c * c + d * d;
    }
#pragma unroll
    for (int o = 32; o >= 1; o >>= 1) ss += __shfl_xor(ss, o);
    const float rstd = rsqrtf(ss * (1.f / 2048.f) + LN_EPS);
    const int cond = row < TP ? 0 : 1 + ((row - TP) >> 12);
    const float* sh = mod + (size_t)((l + 1) * 5 + cond) * 6144;
#pragma unroll
    for (int i = 0; i < 8; ++i) {
      const int e = (i * 64 + lane) * 4;
      float4 gg = *reinterpret_cast<const float4*>(g + e), b4 = *reinterpret_cast<const float4*>(bb + e);
      float4 y;
      y.x = (v[i].x - mu) * rstd * gg.x + b4.x; y.y = (v[i].y - mu) * rstd * gg.y + b4.y;
      y.z = (v[i].z - mu) * rstd * gg.z + b4.z; y.w = (v[i].w - mu) * rstd * gg.w + b4.w;
      *reinterpret_cast<float4*>(xr + e) = y;
      if (l < 3) {
        float4 s0 = *reinterpret_cast<const float4*>(sh + e), c0 = *reinterpret_cast<const float4*>(sh + 2048 + e);
        u32x2 o = {pk2(y.x * (1.f + c0.x) + s0.x, y.y * (1.f + c0.y) + s0.y), pk2(y.z * (1.f + c0.z) + s0.z, y.w * (1.f + c0.w) + s0.w)};
        *reinterpret_cast<u32x2*>(H + (size_t)row * 2048 + e) = o;
      }
    }
  }
}

struct AttnSrc {
  const u16* k0; const u16* vt0; int ks0, vs0, n0;
  const u16* k1; const u16* vt1; int ks1, vs1, n1;
};

template <int DQK>
DI void attn_ldg(const AttnSrc& s, int j, u32x4 (&rk)[DQK / 64], u32x4 (&rv)[2]) {
  const u16* kb; const u16* vb; int ks, vs;
  if (j < s.n0) { kb = s.k0 + (size_t)j * 64 * s.ks0; vb = s.vt0 + j * 64; ks = s.ks0; vs = s.vs0; }
  else { const int jj = j - s.n0; kb = s.k1 + (size_t)jj * 64 * s.ks1; vb = s.vt1 + jj * 64; ks = s.ks1; vs = s.vs1; }
  constexpr int CPR = DQK / 8;
  const int tid = TID8;
#pragma unroll
  for (int i = 0; i < DQK / 64; ++i) {
    const int c = tid + 512 * i, row = c / CPR, kc = c % CPR;
    rk[i] = *reinterpret_cast<const u32x4*>(kb + (size_t)row * ks + kc * 8);
  }
#pragma unroll
  for (int i = 0; i < 2; ++i) {
    const int c = tid + 512 * i, row = c >> 3, kc = c & 7;
    rv[i] = *reinterpret_cast<const u32x4*>(vb + (size_t)row * vs + kc * 8);
  }
}
template <int DQK>
DI void attn_sts(u16* sK, u16* sVT, const u32x4 (&rk)[DQK / 64], const u32x4 (&rv)[2]) {
  constexpr int CPR = DQK / 8;
  const int tid = TID8;
#pragma unroll
  for (int i = 0; i < DQK / 64; ++i) {
    const int c = tid + 512 * i, row = c / CPR, kc = c % CPR;
    *reinterpret_cast<u32x4*>(sK + row * (DQK + 8) + kc * 8) = rk[i];
  }
#pragma unroll
  for (int i = 0; i < 2; ++i) {
    const int c = tid + 512 * i, row = c >> 3, kc = c & 7;
    *reinterpret_cast<u32x4*>(sVT + row * 72 + kc * 8) = rv[i];
  }
}

template <int DQK, bool NA>
DI void attn_run(const AttnSrc& src, const u16* qblk, int qstride, u16* sQ, u16* sK, u16* sVT, f32x16 (&O)[4], float& l_out,
                 int qr, int qc, int rsmin, const float* sBias) {
  const int tid = TID8, lane = tid & 63, wid = tid >> 6;
  const int r = lane & 31, h = lane >> 5;
  const int pr = (r & 0x13) | ((r & 4) << 1) | ((r & 8) >> 1);
  constexpr int CPR = DQK / 8, QS = DQK + 8;
  constexpr bool DB = false;
  __syncthreads();
  bf16x8 qf[DB ? DQK / 16 : 1];
  if constexpr (DB) {
#pragma unroll
    for (int ks = 0; ks < DQK / 16; ++ks) qf[ks] = ld8(qblk + (size_t)(wid * 32 + r) * qstride + ks * 16 + 8 * h);
  } else {
#pragma unroll
    for (int i = 0; i < DQK / 16; ++i) {
      const int c = tid + 512 * i, row = c / CPR, kc = c % CPR;
      *reinterpret_cast<u32x4*>(sQ + row * QS + kc * 8) = *reinterpret_cast<const u32x4*>(qblk + (size_t)row * qstride + kc * 8);
    }
  }
#pragma unroll
  for (int d = 0; d < 4; ++d)
#pragma unroll
    for (int i = 0; i < 16; ++i) O[d][i] = 0.f;
  float m = -1e30f, l = 0.f;
  const int nt = src.n0 + src.n1;
  const int rsq = min(max(qr - 4, 0), 56);
  const int cs = min(max(qc - 8, 0), 48);
  const u16* qw = sQ + (wid * 32 + r) * QS + 8 * h;
  u16* sK1 = sQ;
  u16* sVT1 = sQ + 64 * QS;
  u32x4 rk[DQK / 64], rv[2];
  attn_ldg<DQK>(src, 0, rk, rv);
  if constexpr (DB) {
    attn_sts<DQK>(sK, sVT, rk, rv);
    if (nt > 1) attn_ldg<DQK>(src, 1, rk, rv);
    __syncthreads();
  }
#pragma unroll 1
  for (int j = 0; j < nt; ++j) {
    const u16* kw;
    const u16* vw;
    if constexpr (DB) {
      const int cur = j & 1;
      if (j + 1 < nt) { if (cur) attn_sts<DQK>(sK, sVT, rk, rv); else attn_sts<DQK>(sK1, sVT1, rk, rv); }
      if (j + 2 < nt) attn_ldg<DQK>(src, j + 2, rk, rv);
      kw = (cur ? sK1 : sK) + pr * QS + 8 * h;
      vw = (cur ? sVT1 : sVT) + r * 72 + 8 * h;
    } else {
      constexpr bool PF = true;
      if (!PF && j > 0) attn_ldg<DQK>(src, j, rk, rv);
      if (j > 0) __syncthreads();
      attn_sts<DQK>(sK, sVT, rk, rv);
      __syncthreads();
      if (PF && j + 1 < nt) attn_ldg<DQK>(src, j + 1, rk, rv);
      kw = sK + pr * QS + 8 * h;
      vw = sVT + r * 72 + 8 * h;
    }
    __builtin_amdgcn_sched_barrier(0);
    bool active = true;
    int kr = 0;
    if (NA && j >= src.n0) { kr = rsmin + (j - src.n0); active = (kr >= rsq) && (kr < rsq + 8); }
    if (active) {
      f32x16 s[2];
      __builtin_amdgcn_s_setprio(1);
#pragma unroll
      for (int t = 0; t < 2; ++t) {
#pragma unroll
        for (int i = 0; i < 16; ++i) s[t][i] = 0.f;
#pragma unroll
        for (int ks = 0; ks < DQK / 16; ++ks) {
          bf16x8 a = ld8(kw + t * 32 * QS + ks * 16);
          bf16x8 q;
          if constexpr (DB) q = qf[ks]; else q = ld8(qw + ks * 16);
          s[t] = mfma32(a, q, s[t]);
        }
      }
      __builtin_amdgcn_s_setprio(0);
      if (NA && j >= src.n0) {
        const float* bp = sBias + (kr - qr + 7) * 31 + (8 * h - qc + 15);
        const int kb = 8 * h - cs;
#pragma unroll
        for (int t = 0; t < 2; ++t)
#pragma unroll
          for (int i = 0; i < 16; ++i) {
            const int ko = t * 32 + 16 * (i >> 3) + (i & 7);
            const bool ok = (unsigned)(ko + kb) < 16u;
            const float bv = bp[ko];
            s[t][i] = ok ? s[t][i] + bv : -1e30f;
          }
      }
      float mx = -1e30f;
#pragma unroll
      for (int t = 0; t < 2; ++t)
#pragma unroll
        for (int i = 0; i < 16; ++i) mx = fmaxf(mx, s[t][i]);
      mx = fmaxf(mx, __shfl_xor(mx, 32));
      if (__builtin_amdgcn_ballot_w64(mx > m + 8.0f) != 0ull) {
        const float mn = fmaxf(m, mx);
        const float alpha = ex2(m - mn);
        l *= alpha;
        m = mn;
#pragma unroll
        for (int d = 0; d < 4; ++d)
#pragma unroll
          for (int i = 0; i < 16; ++i) O[d][i] *= alpha;
      }
      float rsum = 0.f;
#pragma unroll
      for (int t = 0; t < 2; ++t)
#pragma unroll
        for (int i = 0; i < 16; ++i) { const float e = ex2(s[t][i] - m); s[t][i] = e; rsum += e; }
      rsum += __shfl_xor(rsum, 32);
      l += rsum;
      __builtin_amdgcn_s_setprio(1);
#pragma unroll
      for (int s4 = 0; s4 < 4; ++s4) {
        const int t = s4 >> 1, b0 = (s4 & 1) * 8;
        u32x4 w = {pk2(s[t][b0], s[t][b0 + 1]), pk2(s[t][b0 + 2], s[t][b0 + 3]), pk2(s[t][b0 + 4], s[t][b0 + 5]), pk2(s[t][b0 + 6], s[t][b0 + 7])};
        const bf16x8 pf = __builtin_bit_cast(bf16x8, w);
#pragma unroll
        for (int d = 0; d < 4; ++d) {
          bf16x8 a = ld8(vw + d * 32 * 72 + s4 * 16);
          O[d] = mfma32(a, pf, O[d]);
        }
      }
      __builtin_amdgcn_s_setprio(0);
    }
    if constexpr (DB) __syncthreads();
  }
  l_out = l;
}

DI void heavy_map(int it, int& bh, int& qb) { const int x = it & 7, rest = it >> 3; qb = rest & 15; bh = x + 8 * (rest >> 4); }

DI void diff_item(const Params& p, int l, bool sample, int bh, int qb, unsigned char* lds) {
  constexpr int NC = 6144;
  const int tid_ = TID8, lane = tid_ & 63, wid = tid_ >> 6, r = lane & 31, h = lane >> 5;
  const int b = bh >> 3, hd = bh & 7;
  u16* sQ = reinterpret_cast<u16*>(lds);
  u16* sK = sQ + 256 * 136;
  u16* sVT = sK + 64 * 136;
  const u16* PROJ = reinterpret_cast<const u16*>(p.ws + WS_PROJ);
  const u16* VT = reinterpret_cast<const u16*>(p.ws + WS_VT);
  const int seq0 = sample ? TP + b * 4096 : b * 256;
  const int token = seq0 + qb * 256 + wid * 32 + r;
  const float* dl = p.in[20 + 10 * l];
  float pa = dl[lane] * dl[64 + lane], pb = dl[128 + lane] * dl[192 + lane];
#pragma unroll
  for (int o = 32; o >= 1; o >>= 1) { pa += __shfl_xor(pa, o); pb += __shfl_xor(pb, o); }
  const float lam_init = 0.8f - 0.6f * __expf(-0.3f * (float)l);
  const float lam = __expf(pa) - __expf(pb) + lam_init;

  u32 o1p[32];
  f32x16 O[4];
  float lsum;
#pragma unroll
  for (int comp = 0; comp < 2; ++comp) {
    AttnSrc s;
    if (sample) {
      s.k0 = reinterpret_cast<const u16*>(p.ws + WS_CK) + (size_t)l * 2097152 + (size_t)bh * 65536 + comp * 64; s.ks0 = 128;
      s.vt0 = reinterpret_cast<const u16*>(p.ws + WS_CVT) + (size_t)l * 2097152 + (size_t)bh * 65536; s.vs0 = 512; s.n0 = 8;
      s.k1 = PROJ + (size_t)seq0 * NC + 3072 + hd * 128 + comp * 64; s.ks1 = NC;
      s.vt1 = VT + 8388608 + (size_t)bh * 128 * 4096; s.vs1 = 4096; s.n1 = 64;
    } else {
      s.k0 = nullptr; s.vt0 = nullptr; s.ks0 = 0; s.vs0 = 0; s.n0 = 0;
      s.k1 = PROJ + (size_t)seq0 * NC + 3072 + hd * 128 + comp * 64; s.ks1 = NC;
      s.vt1 = VT + (size_t)bh * 128 * 256; s.vs1 = 256; s.n1 = 4;
    }
    const u16* qblk = PROJ + (size_t)(seq0 + qb * 256) * NC + 2048 + hd * 128 + comp * 64;
    attn_run<64, false>(s, qblk, NC, sQ, sK, sVT, O, lsum, 0, 0, 0, nullptr);
    const float inv = 1.f / lsum;
    if (comp == 0) {
#pragma unroll
      for (int d = 0; d < 4; ++d)
#pragma unroll
        for (int i = 0; i < 8; ++i) o1p[d * 8 + i] = pk2(O[d][2 * i] * inv, O[d][2 * i + 1] * inv);
    } else {
      float ssq = 0.f;
#pragma unroll
      for (int d = 0; d < 4; ++d)
#pragma unroll
        for (int i = 0; i < 8; ++i) {
          const u32 w = o1p[d * 8 + i];
          const float a = bflo(w) - lam * O[d][2 * i] * inv, c = bfhi(w) - lam * O[d][2 * i + 1] * inv;
          O[d][2 * i] = a; O[d][2 * i + 1] = c;
          ssq += a * a + c * c;
        }
      ssq += __shfl_xor(ssq, 32);
      const float rn = rsqrtf(ssq * (1.f / 128.f) + LN_EPS) * (1.f - lam_init);
      const float* subln = p.in[21 + 10 * l];
      const u16* gp = PROJ + (size_t)token * NC + 5120 + hd * 128;
      u16* yp = reinterpret_cast<u16*>(p.ws + WS_H) + (size_t)token * 2048 + 1024 + hd * 128;
#pragma unroll
      for (int d = 0; d < 4; ++d)
#pragma unroll
        for (int q = 0; q < 4; ++q) {
          const int dv = d * 32 + 8 * q + 4 * h;
          const u32x2 gw = *reinterpret_cast<const u32x2*>(gp + dv);
          const float4 sl = *reinterpret_cast<const float4*>(subln + dv);
          const float y0 = O[d][4 * q] * rn * sl.x * silu(bflo(gw[0]));
          const float y1 = O[d][4 * q + 1] * rn * sl.y * silu(bfhi(gw[0]));
          const float y2 = O[d][4 * q + 2] * rn * sl.z * silu(bflo(gw[1]));
          const float y3 = O[d][4 * q + 3] * rn * sl.w * silu(bfhi(gw[1]));
          *reinterpret_cast<u32x2*>(yp + dv) = (ZERO_MASK & 2) ? u32x2{0u, 0u} : u32x2{pk2(y0, y1), pk2(y2, y3)};
        }
    }
  }
}

DI void pool_item(const Params& p, int l, int pi, unsigned char* lds) {
  constexpr int NC = 6144;
  const int tid = TIDX, lane = tid & 63, wid = tid >> 6, fr = lane & 15, fq = lane >> 4;
  const int tb = pi >> 2, g = pi & 3, row0 = tb * 64;
  const int L = row0 < TP ? 256 : 4096;
  const int t0 = row0 < TP ? (row0 & 255) : ((row0 - TP) & 4095);
  u16* sIn = reinterpret_cast<u16*>(lds);
  u16* sP = sIn + 80 * 264;
  const u16* PROJ = reinterpret_cast<const u16*>(p.ws + WS_PROJ);
  __syncthreads();
#pragma unroll
  for (int i = 0; i < 10; ++i) {
    const int c = tid + 256 * i, rr = c >> 5, oc = c & 31;
    const int t = t0 - 8 + rr;
    u32x4 v = {0u, 0u, 0u, 0u};
    if (t >= 0 && t < L) v = *reinterpret_cast<const u32x4*>(PROJ + (size_t)(row0 - 8 + rr) * NC + g * 256 + oc * 8);
    *reinterpret_cast<u32x4*>(sIn + rr * 264 + oc * 8) = v;
  }
  __syncthreads();
  {
    const int oc = tid & 31, seg = tid >> 5;
    const int half = 1 << g;
#pragma unroll 1
    for (int tt = 0; tt < 8; ++tt) {
      const int tl = seg * 8 + tt, t = t0 + tl;
      const int lo = max(t - half, 0), hi = min(t + half, L);
      float a[8];
#pragma unroll
      for (int k = 0; k < 8; ++k) a[k] = 0.f;
      for (int s = lo; s < hi; ++s) {
        const u32x4 v = *reinterpret_cast<const u32x4*>(sIn + (s - t0 + 8) * 264 + oc * 8);
#pragma unroll
        for (int k = 0; k < 4; ++k) { a[2 * k] += bflo(v[k]); a[2 * k + 1] += bfhi(v[k]); }
      }
      const float ic = 1.f / (float)(hi - lo);
      const u32x4 x = *reinterpret_cast<const u32x4*>(sIn + (tl + 8) * 264 + oc * 8);
      u32x4 o;
#pragma unroll
      for (int k = 0; k < 4; ++k) o[k] = pk2(a[2 * k] * ic - bflo(x[k]), a[2 * k + 1] * ic - bfhi(x[k]));
      *reinterpret_cast<u32x4*>(sP + tl * 264 + oc * 8) = o;
    }
  }
  __syncthreads();
  const u16* W = reinterpret_cast<const u16*>(p.ws + WS_POOLWT) + (size_t)(l >> 1) * 262144 + (size_t)g * 65536;
  f32x4 acc[4][4];
#pragma unroll
  for (int a = 0; a < 4; ++a)
#pragma unroll
    for (int b = 0; b < 4; ++b) acc[a][b] = f32x4{0.f, 0.f, 0.f, 0.f};
#pragma unroll 2
  for (int ks = 0; ks < 8; ++ks) {
    bf16x8 af[4], bfr[4];
#pragma unroll
    for (int m = 0; m < 4; ++m) af[m] = ld8(sP + (m * 16 + fr) * 264 + ks * 32 + fq * 8);
#pragma unroll
    for (int n = 0; n < 4; ++n) bfr[n] = ld8(W + (size_t)(wid * 64 + n * 16 + fr) * 256 + ks * 32 + fq * 8);
#pragma unroll
    for (int m = 0; m < 4; ++m)
#pragma unroll
      for (int n = 0; n < 4; ++n) acc[m][n] = mfma16(bfr[n], af[m], acc[m][n]);
  }
  const float* pscale = p.in[19 + 10 * l];
  u16* Y = reinterpret_cast<u16*>(p.ws + WS_H);
#pragma unroll
  for (int n = 0; n < 4; ++n) {
    const int col = g * 256 + wid * 64 + n * 16 + 4 * fq;
    const float4 sc = *reinterpret_cast<const float4*>(pscale + col);
#pragma unroll
    for (int m = 0; m < 4; ++m) {
      const int row = row0 + m * 16 + fr;
      const u32x2 gw = *reinterpret_cast<const u32x2*>(PROJ + (size_t)row * NC + 1024 + col);
      float y0 = acc[m][n][0] * sc.x * silu(bflo(gw[0])), y1 = acc[m][n][1] * sc.y * silu(bfhi(gw[0]));
      float y2 = acc[m][n][2] * sc.z * silu(bflo(gw[1])), y3 = acc[m][n][3] * sc.w * silu(bfhi(gw[1]));
      if (ZERO_MASK & 1) { y0 = y1 = y2 = y3 = 0.f; }
      *reinterpret_cast<u32x2*>(Y + (size_t)row * 2048 + col) = u32x2{pk2(y0, y1), pk2(y2, y3)};
    }
  }
}

DI void phase_mix_even(const Params& p, int l, unsigned char* lds, unsigned char* lds_all) {
#pragma unroll 1
  for (int it = blockIdx.x; it < 512; it += gridDim.x) { int bh, qb; heavy_map(it, bh, qb); diff_item(p, l, true, bh, qb, lds_all); }
#pragma unroll 1
  for (int it = blockIdx.x; it < 256; it += gridDim.x) diff_item(p, l, false, it, 0, lds_all);
#pragma unroll 1
  for (int it = VBID; it < 1536; it += VGRID) pool_item(p, l, it, lds);
}

DI void na_item(const Params& p, int l, bool sample, int bh, int qb, unsigned char* lds) {
  constexpr int NC = 7168;
  const int tid = TID8, lane = tid & 63, wid = tid >> 6, r = lane & 31, h = lane >> 5;
  const int b = bh >> 3, hd = bh & 7;
  u16* sQ = reinterpret_cast<u16*>(lds);
  u16* sK = sQ + 256 * 136;
  u16* sVT = sK + 64 * 136;
  float* sBias = reinterpret_cast<float*>(sVT + 128 * 72) + 64;
  const u16* PROJ = reinterpret_cast<const u16*>(p.ws + WS_PROJ);
  const u16* VT = reinterpret_cast<const u16*>(p.ws + WS_VT);
  const int seq0 = sample ? TP + b * 4096 : b * 256;
  const int token = seq0 + qb * 256 + wid * 32 + r;
  AttnSrc s;
  int qr = 0, qc = 0, rsmin = 0;
  f32x16 O[4];
  float lsum;
  const u16* qblk = PROJ + (size_t)(seq0 + qb * 256) * NC + hd * 128;
  if (sample) {
    __syncthreads();
    const float* rpb = p.in[18 + 10 * l] + hd * 465;
    for (int e = tid; e < 465; e += 512) sBias[e] = rpb[e] * LOG2E;
    const int r0 = qb * 4;
    qr = r0 + (wid >> 1); qc = (wid & 1) * 32 + r;
    rsmin = min(max(r0 - 4, 0), 56);
    const int rs1 = min(max(r0 - 1, 0), 56);
    s.k0 = reinterpret_cast<const u16*>(p.ws + WS_CK) + (size_t)l * 2097152 + (size_t)bh * 65536; s.ks0 = 128;
    s.vt0 = reinterpret_cast<const u16*>(p.ws + WS_CVT) + (size_t)l * 2097152 + (size_t)bh * 65536; s.vs0 = 512; s.n0 = 8;
    s.k1 = PROJ + (size_t)(seq0 + rsmin * 64) * NC + 1024 + hd * 128; s.ks1 = NC;
    s.vt1 = VT + 8388608 + (size_t)bh * 128 * 4096 + rsmin * 64; s.vs1 = 4096; s.n1 = rs1 + 8 - rsmin;
    attn_run<128, true>(s, qblk, NC, sQ, sK, sVT, O, lsum, qr, qc, rsmin, sBias);
  } else {
    s.k0 = nullptr; s.vt0 = nullptr; s.ks0 = 0; s.vs0 = 0; s.n0 = 0;
    s.k1 = PROJ + (size_t)seq0 * NC + 1024 + hd * 128; s.ks1 = NC;
    s.vt1 = VT + (size_t)bh * 128 * 256; s.vs1 = 256; s.n1 = 4;
    attn_run<128, false>(s, qblk, NC, sQ, sK, sVT, O, lsum, 0, 0, 0, nullptr);
  }
  const float inv = 1.f / lsum;
  const u16* gp = PROJ + (size_t)token * NC + 3072 + hd * 128;
  u16* yp = reinterpret_cast<u16*>(p.ws + WS_H) + (size_t)token * 2048 + hd * 128;
#pragma unroll
  for (int d = 0; d < 4; ++d)
#pragma unroll
    for (int q = 0; q < 4; ++q) {
      const int dv = d * 32 + 8 * q + 4 * h;
      const u32x2 gw = *reinterpret_cast<const u32x2*>(gp + dv);
      const float y0 = O[d][4 * q] * inv * silu(bflo(gw[0]));
      const float y1 = O[d][4 * q + 1] * inv * silu(bfhi(gw[0]));
      const float y2 = O[d][4 * q + 2] * inv * silu(bflo(gw[1]));
      const float y3 = O[d][4 * q + 3] * inv * silu(bfhi(gw[1]));
      *reinterpret_cast<u32x2*>(yp + dv) = (ZERO_MASK & 4) ? u32x2{0u, 0u} : u32x2{pk2(y0, y1), pk2(y2, y3)};
    }
}

DI void sgu_item(const Params& p, int l, int si, unsigned char* lds) {
  constexpr int NC = 7168;
  const int tid = TIDX, lane = tid & 63, wid = tid >> 6, fr = lane & 15, fq = lane >> 4;
  const int ch = si >> 2, g = si & 3, row0 = ch * 128;
  u16* vnT = reinterpret_cast<u16*>(lds);
  float* sMu = reinterpret_cast<float*>(vnT + 256 * 136);
  float* sRs = sMu + 128;
  const u16* PROJ = reinterpret_cast<const u16*>(p.ws + WS_PROJ);
  __syncthreads();
  {
    const int grp = tid >> 4, ln = tid & 15;
#pragma unroll 1
    for (int rr = 0; rr < 8; ++rr) {
      const u16* src = PROJ + (size_t)(row0 + grp * 8 + rr) * NC + 5120;
      float s = 0.f, ss = 0.f;
#pragma unroll
      for (int c8 = 0; c8 < 8; ++c8) {
        const u32x4 v = *reinterpret_cast<const u32x4*>(src + (ln + 16 * c8) * 8);
#pragma unroll
        for (int k = 0; k < 4; ++k) { const float a = bflo(v[k]), b = bfhi(v[k]); s += a + b; ss += a * a + b * b; }
      }
#pragma unroll
      for (int o = 8; o >= 1; o >>= 1) { s += __shfl_xor(s, o); ss += __shfl_xor(ss, o); }
      const float mu = s * (1.f / 1024.f);
      const float var = fmaxf(ss * (1.f / 1024.f) - mu * mu, 0.f);
      if (ln == 0) { sMu[grp * 8 + rr] = mu; sRs[grp * 8 + rr] = rsqrtf(var + LN_EPS); }
    }
  }
  __syncthreads();
  {
    const int j = tid & 127, hf = tid >> 7;
    const float mu = sMu[j], rs = sRs[j];
    const float* lng = p.in[19 + 10 * l] + g * 256;
    const u16* src = PROJ + (size_t)(row0 + j) * NC + 5120 + g * 256;
#pragma unroll 1
    for (int oc = hf * 16; oc < hf * 16 + 16; ++oc) {
      const u32x4 v = *reinterpret_cast<const u32x4*>(src + oc * 8);
      const float4 g0 = *reinterpret_cast<const float4*>(lng + oc * 8), g1 = *reinterpret_cast<const float4*>(lng + oc * 8 + 4);
      const float gg[8] = {g0.x, g0.y, g0.z, g0.w, g1.x, g1.y, g1.z, g1.w};
#pragma unroll
      for (int k = 0; k < 4; ++k) {
        const float a = (bflo(v[k]) - mu) * rs * gg[2 * k], b = (bfhi(v[k]) - mu) * rs * gg[2 * k + 1];
        const u32 w = pk2(a, b);
        vnT[(oc * 8 + 2 * k) * 136 + j] = (u16)(w & 0xffffu);
        vnT[(oc * 8 + 2 * k + 1) * 136 + j] = (u16)(w >> 16);
      }
    }
  }
  __syncthreads();
  const u16* W = reinterpret_cast<const u16*>(p.ws + WS_SGUW) + (size_t)(l >> 1) * 65536 + (size_t)g * 16384;
  const float* bs = p.in[21 + 10 * l] + g * 128;
  u16* Y = reinterpret_cast<u16*>(p.ws + WS_H);
#pragma unroll 1
  for (int ih = 0; ih < 2; ++ih) {
    f32x4 acc[4][4];
#pragma unroll
    for (int a = 0; a < 4; ++a)
#pragma unroll
      for (int b = 0; b < 4; ++b) acc[a][b] = f32x4{0.f, 0.f, 0.f, 0.f};
#pragma unroll
    for (int ks = 0; ks < 4; ++ks) {
      bf16x8 af[4], bfr[4];
#pragma unroll
      for (int m = 0; m < 4; ++m) af[m] = ld8(W + (size_t)(ih * 64 + m * 16 + fr) * 128 + ks * 32 + fq * 8);
#pragma unroll
      for (int n = 0; n < 4; ++n) bfr[n] = ld8(vnT + (wid * 64 + n * 16 + fr) * 136 + ks * 32 + fq * 8);
#pragma unroll
      for (int m = 0; m < 4; ++m)
#pragma unroll
        for (int n = 0; n < 4; ++n) acc[m][n] = mfma16(bfr[n], af[m], acc[m][n]);
    }
#pragma unroll
    for (int m = 0; m < 4; ++m) {
      const int ii = ih * 64 + m * 16 + fr;
      const float bias = bs[ii];
      const size_t rb = (size_t)(row0 + ii) * NC;
#pragma unroll
      for (int n = 0; n < 4; ++n) {
        const int c = g * 256 + wid * 64 + n * 16 + 4 * fq;
        const u32x2 uw = *reinterpret_cast<const u32x2*>(PROJ + rb + 4096 + c);
        const u32x2 dw = *reinterpret_cast<const u32x2*>(PROJ + rb + 6144 + c);
        float y0 = bflo(uw[0]) * (acc[m][n][0] + bias) * silu(bflo(dw[0])), y1 = bfhi(uw[0]) * (acc[m][n][1] + bias) * silu(bfhi(dw[0]));
        float y2 = bflo(uw[1]) * (acc[m][n][2] + bias) * silu(bflo(dw[1])), y3 = bfhi(uw[1]) * (acc[m][n][3] + bias) * silu(bfhi(dw[1]));
        if (ZERO_MASK & 8) { y0 = y1 = y2 = y3 = 0.f; }
        *reinterpret_cast<u32x2*>(Y + (size_t)(row0 + ii) * 2048 + 1024 + c) = u32x2{pk2(y0, y1), pk2(y2, y3)};
      }
    }
  }
}

DI void phase_mix_odd(const Params& p, int l, unsigned char* lds, unsigned char* lds_all) {
#pragma unroll 1
  for (int it = blockIdx.x; it < 512; it += gridDim.x) { int bh, qb; heavy_map(it, bh, qb); na_item(p, l, true, bh, qb, lds_all); }
#pragma unroll 1
  for (int it = blockIdx.x; it < 256; it += gridDim.x) na_item(p, l, false, it, 0, lds_all);
#pragma unroll 1
  for (int it = VBID; it < 768; it += VGRID) sgu_item(p, l, it, lds);
}

#define XB_TMO      128
#define XB_XCNT(j)  (256  + 64 * (j))
#define XB_XSUB(j)  (1280 + 64 * (j))
#define XB_XGEN(j)  (2304 + 64 * (j))
#define XB_TOP      3328
#define XB_TOPGEN   3392
#define XCD_BAR_WORDS 3456
#define XB_SPIN_CAP (1u << 18)
#define LAS __attribute__((address_space(3)))
DI unsigned xb_ld(unsigned* p)              { return __hip_atomic_load(p, __ATOMIC_RELAXED, __HIP_MEMORY_SCOPE_AGENT); }
DI unsigned xb_add(unsigned* p, unsigned v) { return __hip_atomic_fetch_add(p, v, __ATOMIC_RELAXED, __HIP_MEMORY_SCOPE_AGENT); }
DI unsigned xb_xcc_id() { return (unsigned)__builtin_amdgcn_s_getreg((3 << 11) | 20) & 0xFu; }
#define XB_SPIN(cond, bar) do { unsigned _sp = 0; while (cond) { __builtin_amdgcn_s_sleep(1); \
    if ((++_sp & 255u) == 0u) { if (xb_ld(&(bar)[XB_TMO])) break; if (_sp > XB_SPIN_CAP) { atomicAdd(&(bar)[XB_TMO], 1u); break; } } } } while (0)
struct XcdBarrier { unsigned* bar; unsigned x; volatile LAS unsigned* st; };
DI XcdBarrier xcd_barrier_post(unsigned* bar, volatile LAS unsigned* st) {
  XcdBarrier b; b.bar = bar; b.x = xb_xcc_id(); b.st = st;
  if (threadIdx.x == 0) (void)xb_add(&bar[XB_XCNT(b.x)], 1u);
  return b;
}
DI void xcd_barrier_complete(unsigned* bar, unsigned x, unsigned& nloc, unsigned& nx) {
  const unsigned G = gridDim.x * gridDim.y * gridDim.z;
  unsigned sum, cnt, mine, sp = 0u;
  for (;;) {
    sum = 0u; cnt = 0u; mine = 0u;
#pragma unroll
    for (unsigned j = 0; j < 16; ++j) { const unsigned c = xb_ld(&bar[XB_XCNT(j)]); sum += c; cnt += (c > 0u) ? 1u : 0u; mine = (j == x) ? c : mine; }
    if (sum == G) break;
    __builtin_amdgcn_s_sleep(1);
    if ((++sp & 255u) == 0u) { if (xb_ld(&bar[XB_TMO])) break; if (sp > XB_SPIN_CAP) { atomicAdd(&bar[XB_TMO], 1u); break; } }
  }
  nloc = mine > 0u ? mine : 1u; nx = cnt > 0u ? cnt : 1u;
}
DI void xcd_barrier(const XcdBarrier& b) {
  asm volatile("s_waitcnt vmcnt(0)" ::: "memory");
  __syncthreads();
  if (threadIdx.x == 0) {
    unsigned* bar = b.bar;
    __builtin_amdgcn_s_waitcnt(0);
    unsigned nloc = b.st[0], nx = b.st[1];
    if (nloc == 0u) { xcd_barrier_complete(bar, b.x, nloc, nx); b.st[0] = nloc; b.st[1] = nx; }
    const unsigned old = xb_add(&bar[XB_XSUB(b.x)], 1u);
    const unsigned gen = old / nloc;
    if (old + 1u == (gen + 1u) * nloc) {
      __builtin_amdgcn_fence(__ATOMIC_RELEASE, "agent");
      asm volatile("s_waitcnt vmcnt(0)" ::: "memory");
      const unsigned og = xb_add(&bar[XB_TOP], 1u);
      const unsigned tg = og / nx;
      if (og + 1u == (tg + 1u) * nx) xb_add(&bar[XB_TOPGEN], 1u);
      else XB_SPIN(xb_ld(&bar[XB_TOPGEN]) == tg, bar);
      __builtin_amdgcn_fence(__ATOMIC_ACQUIRE, "agent");
      xb_add(&bar[XB_XGEN(b.x)], 1u);
      asm volatile("s_waitcnt vmcnt(0)" ::: "memory");
    } else {
      XB_SPIN(xb_ld(&bar[XB_XGEN(b.x)]) == gen, bar);
      __builtin_amdgcn_fence(__ATOMIC_ACQUIRE, "agent");
      asm volatile("s_waitcnt vmcnt(0)" ::: "memory");
    }
  }
  __syncthreads();
}

__global__ void __launch_bounds__(512, 2) fwd_megakernel(Params p) {
  extern __shared__ __attribute__((aligned(16))) unsigned char lds[];
  cg::grid_group grid = cg::this_grid();
  volatile LAS unsigned* xst = (volatile LAS unsigned*)(lds + LDS_BYTES - 16);
  if (threadIdx.x == 0) { xst[0] = 0u; xst[1] = 0u; }
  __syncthreads();
  const XcdBarrier xb = xcd_barrier_post(reinterpret_cast<unsigned*>(p.ws + WS_BAR), xst);
  for (int ph = p.ph_lo; ph < p.ph_hi; ++ph) {
    unsigned char* hl = lds + HALF_ID * HALF_LDS;
    if (ph == 0) phase_prep(p, hl);
    else if (ph == 1) phase_mod0(p);
    else {
      const int l = (ph - 2) >> 2, s = (ph - 2) & 3;
      if (s == 0) { if (l & 1) gemm_phase<G_IN_ODD>(p, l, lds); else gemm_phase<G_IN_EVEN>(p, l, lds); }
      else if (s == 1) { if (l & 1) phase_mix_odd(p, l, hl, lds); else phase_mix_even(p, l, hl, lds); }
      else if (s == 2) gemm_phase<G_OUT>(p, l, lds);
      else phase_ln(p, l);
    }
    if (ph + 1 < p.ph_hi) {
      if (p.ph_lo < 0) grid.sync();
      xcd_barrier(xb);
    }
  }
}

extern "C" void kernel_launch(void* const* d_in, const int* in_sizes, int n_in, void* d_out, int out_size, void* d_ws, size_t ws_size,
                              hipStream_t stream) {
  static int grid_blocks = 0;
  if (grid_blocks == 0) {
    if (n_in != 52 || ws_size < WS_END) {
      fprintf(stderr, "kernel_launch: expected 52 inputs and >= %zu bytes of workspace; got %d, %zu\n", (size_t)WS_END, n_in, ws_size);
      grid_blocks = -1;
      return;
    }
    int dev = 0, cus = 0, per_cu = 0;
    hipGetDevice(&dev);
    hipDeviceGetAttribute(&cus, hipDeviceAttributeMultiprocessorCount, dev);
    hipFuncSetAttribute((const void*)fwd_megakernel, hipFuncAttributeMaxDynamicSharedMemorySize, LDS_BYTES);
    hipOccupancyMaxActiveBlocksPerMultiprocessor(&per_cu, (const void*)fwd_megakernel, 512, LDS_BYTES);
    (void)hipGetLastError();
    grid_blocks = cus;
  }
  if (grid_blocks < 0) return;
  Params p{};
  for (int i = 0; i < 52; ++i) p.in[i] = (const float*)d_in[i];
  p.out = (float*)d_out;
  p.ws = (unsigned char*)d_ws;
#if MULTI
  for (int ph = 0; ph < NPHASE; ++ph) {
    p.ph_lo = ph; p.ph_hi = ph + 1;
    hipLaunchKernelGGL(fwd_megakernel, dim3(grid_blocks), dim3(512), LDS_BYTES, stream, p);
  }
#else
  p.ph_lo = 0; p.ph_hi = NPHASE;
  if (hipMemsetAsync((char*)d_ws + WS_BAR, 0, XCD_BAR_WORDS * 4, stream) != hipSuccess) { fprintf(stderr, "kernel_launch: memset of barrier words failed\n"); return; }
  void* args[] = {&p};
  hipError_t e = hipLaunchCooperativeKernel((const void*)fwd_megakernel, dim3(grid_blocks), dim3(512), args, LDS_BYTES, stream);
  if (e != hipSuccess) fprintf(stderr, "cooperative launch failed: %s (grid %d)\n", hipGetErrorString(e), grid_blocks);
#endif
}
```

```cpp
#include <hip/hip_runtime.h>
#include <hip/hip_cooperative_groups.h>
#include <cstdio>
namespace cg = cooperative_groups;

#define DI __device__ __forceinline__
typedef unsigned short u16;
typedef unsigned int u32;
using bf16x8 = __attribute__((ext_vector_type(8))) short;
using f32x4 = __attribute__((ext_vector_type(4))) float;
using f32x16 = __attribute__((ext_vector_type(16))) float;
using u32x4 = __attribute__((ext_vector_type(4))) unsigned;
using u32x2 = __attribute__((ext_vector_type(2))) unsigned;
typedef __bf16 bf2_t __attribute__((ext_vector_type(2)));
typedef float f2_t __attribute__((ext_vector_type(2)));

#ifndef MULTI
#define MULTI 0
#endif
#ifndef REP0
#define REP0 1
#endif
#ifndef REP1
#define REP1 1
#endif
#ifndef ZERO_MASK
#define ZERO_MASK 0
#endif

constexpr int T_ALL = 24576, TP = 8192, DM = 2048;
constexpr float LOG2E = 1.4426950408889634f;
constexpr float ALPHA = 1.6817928305074290f;
constexpr float LN_EPS = 1e-5f;
constexpr int HALF_LDS = 76288;
constexpr int LDS_BYTES = 2 * HALF_LDS + 16;
constexpr int NPHASE = 18;

constexpr size_t SZ_WIN_E = (size_t)6144 * 2048 * 2, SZ_WIN_O = (size_t)7168 * 2048 * 2;
constexpr size_t WS_WINT = 0;
constexpr size_t WS_WOUTT = WS_WINT + 2 * SZ_WIN_E + 2 * SZ_WIN_O;
constexpr size_t WS_POOLWT = WS_WOUTT + (size_t)4 * 2048 * 2048 * 2;
constexpr size_t WS_SGUW = WS_POOLWT + (size_t)2 * 4 * 256 * 256 * 2;
constexpr size_t WS_CK = WS_SGUW + (size_t)2 * 4 * 128 * 128 * 2;
constexpr size_t WS_CVT = WS_CK + (size_t)4 * 4194304;
constexpr size_t WS_MOD = WS_CVT + (size_t)4 * 4194304;
constexpr size_t WS_ROPE = WS_MOD + (size_t)4 * 5 * 6144 * 4;
constexpr size_t WS_H = WS_ROPE + 8192;
constexpr size_t WS_PROJ = WS_H + (size_t)T_ALL * 2048 * 2;
constexpr size_t WS_VT = WS_PROJ + (size_t)T_ALL * 7168 * 2;
constexpr size_t WS_BAR = WS_VT + (size_t)T_ALL * 1024 * 2;
constexpr size_t WS_END = WS_BAR + 16384;

struct Params {
  const float* in[52];
  float* out;
  unsigned char* ws;
  int ph_lo, ph_hi;
};

DI size_t ws_wint(int l) { return WS_WINT + (size_t)(l >> 1) * (SZ_WIN_E + SZ_WIN_O) + ((l & 1) ? SZ_WIN_E : 0); }

DI u32 pk2(float a, float b) { f2_t v = {a, b}; bf2_t r = __builtin_convertvector(v, bf2_t); return __builtin_bit_cast(u32, r); }
DI float bflo(u32 w) { return __uint_as_float(w << 16); }
DI float bfhi(u32 w) { return __uint_as_float(w & 0xffff0000u); }
DI float bf1(u16 w) { return __uint_as_float(((u32)w) << 16); }
DI float ex2(float x) { return __builtin_amdgcn_exp2f(x); }
DI float silu(float x) { return x / (1.f + __expf(-x)); }
DI f32x4 mfma16(bf16x8 a, bf16x8 b, f32x4 c) { return __builtin_amdgcn_mfma_f32_16x16x32_bf16(a, b, c, 0, 0, 0); }
DI f32x16 mfma32(bf16x8 a, bf16x8 b, f32x16 c) { return __builtin_amdgcn_mfma_f32_32x32x16_bf16(a, b, c, 0, 0, 0); }
DI bf16x8 ld8(const u16* p) { return *reinterpret_cast<const bf16x8*>(p); }
DI int opq(int x) { asm volatile("" : "+v"(x)); return x; }
#define TIDX (opq((int)threadIdx.x) & 255)
#define TID8 (opq((int)threadIdx.x))
#define HALF_ID (opq((int)threadIdx.x) >> 8)
#define VBID ((int)((blockIdx.x & 7u) | ((unsigned)HALF_ID << 3) | ((blockIdx.x >> 3) << 4)))
#define VGRID ((int)gridDim.x * 2)

enum { G_IN_EVEN = 0, G_IN_ODD = 1, G_OUT = 2 };

namespace pg8 {
#define PG8_LAS __attribute__((address_space(3)))
typedef unsigned short bf16_t;
typedef short bf16x8 __attribute__((ext_vector_type(8)));
typedef float f32x4 __attribute__((ext_vector_type(4)));
typedef unsigned u32x4 __attribute__((ext_vector_type(4)));
constexpr int BM = 256, BK = 64, HALF = 128, HTB = HALF * BK * 2  , STAGE_BYTES = 8 * HTB, NXCD = 8, WGM = 8;

__host__ __device__ __forceinline__ int lds_byte(int r, int c) { const int st = (r >> 4) * 2 + (c >> 5), rr = r & 15, cc = c & 31, ob = rr * 64 + cc * 2; return st * 1024 + (ob ^ (((ob >> 9) & 1) << 5)); }
__host__ __device__ __forceinline__ void stage_rc(int b, int& R, int& C) { const int st = b / 1024, sb = b % 1024, swz = sb ^ (((sb >> 9) & 1) << 5); R = (st >> 1) * 16 + swz / 64; C = (st & 1) * 32 + (swz % 64) / 2; }
__host__ __device__ __forceinline__ int perm32(int rho) { const int n = rho >> 4, i = rho & 15; return 8 * (i >> 2) + 4 * n + (i & 3); }

struct Unit { int pm, pn; };
struct Gemm { const bf16_t* A; const bf16_t* Bt; int M, N, K; };

struct StaticOrder {
    int nM, nN, nwg, G, c;
    __host__ __device__ void init(int M, int N, int G_, int c_) { nM = M / BM; nN = N / BM; nwg = nM * nN; G = G_; c = c_; }
    __host__ __device__ bool next(int i, Unit& u) const {
        const long L = (long)i * G + c; if (L >= nwg) return false;
        int wgid = (int)L; { const int q = nwg / NXCD, r = nwg % NXCD, xcd = wgid % NXCD, off = wgid / NXCD; wgid = (xcd < r ? xcd * (q + 1) : r * (q + 1) + (xcd - r) * q) + off; }
        const int nig = WGM * nN, gid = wgid / nig, fm = gid * WGM, gsz = (nM - fm) < WGM ? (nM - fm) : WGM;
        u.pm = fm + ((wgid % nig) % gsz); u.pn = (wgid % nig) / gsz; return true;
    }
    __device__ __forceinline__ void a_ready(const Unit&) const {}
    __device__ __forceinline__ void done(const Unit&) const {}
};

template <class Epi, class Sched, bool STAMP = false>
__device__ __forceinline__ void gemm_phase(PG8_LAS unsigned char* lds, const Gemm g, const Sched& S, const Epi& E, unsigned long long* stamps) {
    const int tid = opq((int)threadIdx.x), wid = __builtin_amdgcn_readfirstlane(tid >> 6), lane = tid & 63, wr = wid >> 2, wc = wid & 3, fr = lane & 15, fq = lane >> 4;
    const int K = g.K, nt = K / BK;
    int ts_lo = 0, ts_hi = 0, nts = 0; const unsigned long long rt_entry = STAMP ? (unsigned long long)wall_clock64() : 0ull;
#define PG8_STAMP() do { if (STAMP && wid == 0 && nts < 64) { const unsigned long long _c = (unsigned long long)clock64(); \
        ts_lo = (lane == nts) ? (int)(unsigned)_c : ts_lo; ts_hi = (lane == nts) ? (int)(unsigned)(_c >> 32) : ts_hi; ++nts; } } while (0)
    PG8_STAMP();
    unsigned voffA[2], voffB[2];
#pragma unroll
    for (int i = 0; i < 2; ++i) { int R, C; stage_rc(tid * 16 + i * 8192, R, C); const int Rb = Epi::PERM ? ((R & ~31) + perm32(R & 31)) : R;
        voffA[i] = (unsigned)(R * K + C) * 2u; voffB[i] = (unsigned)(Rb * K + C) * 2u; }
    const size_t kstep = (size_t)(BK * 2);
    const size_t hstep = (size_t)HALF * K * 2;
    const size_t tstep = 2 * hstep;
    const unsigned ldsw = (unsigned)wid * 1024u;
    const int aoff = lds_byte(wr * 64 + fr, fq * 8), boff = lds_byte(wc * 32 + fr, fq * 8);
#define PG8_SA(b, h) (((b) * 2 + (h)) * HTB)
#define PG8_SB(b, h) ((4 + (b) * 2 + (h)) * HTB)
#define PG8_STAGE(bufoff, gbase, voff) do { _Pragma("unroll") for (int _i = 0; _i < 2; ++_i) \
        __builtin_amdgcn_global_load_lds((const unsigned*)((const char*)(gbase) + (voff)[_i]), (PG8_LAS unsigned*)(lds + (bufoff) + ldsw + _i * 8192), 16, 0, 0); } while (0)
#define PG8_LDA(dst, b, h) do { _Pragma("unroll") for (int m = 0; m < 4; ++m) _Pragma("unroll") for (int k = 0; k < 2; ++k) dst[m][k] = *(const PG8_LAS bf16x8*)(lds + PG8_SA(b, h) + aoff + m * 2048 + k * 1024); } while (0)
#define PG8_LDB(dst, b, h) do { _Pragma("unroll") for (int n = 0; n < 2; ++n) _Pragma("unroll") for (int k = 0; k < 2; ++k) dst[n][k] = *(const PG8_LAS bf16x8*)(lds + PG8_SB(b, h) + boff + n * 2048 + k * 1024); } while (0)
#define PG8_MMA(ai, bj, At, Bt) do { __builtin_amdgcn_s_setprio(1); _Pragma("unroll") for (int m = 0; m < 4; ++m) _Pragma("unroll") for (int n = 0; n < 2; ++n) _Pragma("unroll") for (int k = 0; k < 2; ++k) \
        acc[ai][bj][m][n] = __builtin_amdgcn_mfma_f32_16x16x32_bf16(Bt[n][k], At[m][k], acc[ai][bj][m][n], 0, 0, 0); __builtin_amdgcn_s_setprio(0); } while (0)
#define PG8_WAIT_V(n) asm volatile("s_waitcnt vmcnt(" #n ")" ::: "memory")
#define PG8_WAIT_L(n) asm volatile("s_waitcnt lgkmcnt(" #n ")" ::: "memory")
#define PG8_BAR __builtin_amdgcn_s_barrier()
#define PG8_SCHED __builtin_amdgcn_sched_barrier(0)
    Unit cur, nxt; int ui = 0;
    if (!S.next(0, cur)) return;
    f32x4 acc[2][2][4][2];
#pragma unroll
    for (int a = 0; a < 2; ++a)
#pragma unroll
        for (int b = 0; b < 2; ++b)
#pragma unroll
            for (int m = 0; m < 4; ++m)
#pragma unroll
                for (int n = 0; n < 2; ++n) acc[a][b][m][n] = (f32x4){0.f, 0.f, 0.f, 0.f};
    bf16x8 At[4][2], B0[2][2], B1[2][2];
    const char* cA = (const char*)g.A + (size_t)cur.pm * tstep; const char* cB = (const char*)g.Bt + (size_t)cur.pn * tstep;
    S.a_ready(cur);
    PG8_STAGE(PG8_SB(0, 0), cB, voffB); PG8_STAGE(PG8_SA(0, 0), cA, voffA); PG8_STAGE(PG8_SB(0, 1), cB + hstep, voffB); PG8_STAGE(PG8_SA(0, 1), cA + hstep, voffA);
    if (wr == 1) PG8_BAR;
    PG8_WAIT_V(4); PG8_BAR;
    PG8_STAGE(PG8_SB(1, 0), cB + kstep, voffB); PG8_STAGE(PG8_SA(1, 0), cA + kstep, voffA); PG8_STAGE(PG8_SB(1, 1), cB + hstep + kstep, voffB);
    PG8_WAIT_V(6); PG8_BAR;
    PG8_STAMP();
    for (;;) {
        const bool has_next = S.next(ui + 1, nxt);
        const char* nA = has_next ? (const char*)g.A + (size_t)nxt.pm * tstep : cA; const char* nB = has_next ? (const char*)g.Bt + (size_t)nxt.pn * tstep : cB;
        for (int t = 0; t < nt; t += 2) {
            const bool last = (t == nt - 2);
            const char* a1 = cA + (size_t)(t + 1) * kstep;
            const char* a2 = last ? nA : cA + (size_t)(t + 2) * kstep; const char* b2 = last ? nB : cB + (size_t)(t + 2) * kstep;
            const char* a3 = a2 + kstep; const char* b3 = b2 + kstep;
            if (last && has_next) S.a_ready(nxt);
            PG8_LDB(B0, 0, 0); PG8_SCHED; PG8_LDA(At, 0, 0); PG8_STAGE(PG8_SA(1, 1), a1 + hstep, voffA);
            PG8_WAIT_L(8); PG8_BAR; PG8_WAIT_L(0); PG8_MMA(0, 0, At, B0); PG8_BAR; PG8_SCHED;
            PG8_LDB(B1, 0, 1); PG8_STAGE(PG8_SB(0, 0), b2, voffB);
            PG8_BAR; PG8_WAIT_L(0); PG8_MMA(0, 1, At, B1); PG8_BAR;
            PG8_LDA(At, 0, 1); PG8_STAGE(PG8_SA(0, 0), a2, voffA);
            PG8_BAR; PG8_WAIT_L(0); PG8_MMA(1, 0, At, B0); PG8_BAR; PG8_SCHED;
            PG8_STAGE(PG8_SB(0, 1), b2 + hstep, voffB);
            PG8_WAIT_V(6); PG8_BAR; PG8_MMA(1, 1, At, B1); PG8_BAR;
            PG8_LDB(B0, 1, 0); PG8_SCHED; PG8_LDA(At, 1, 0); PG8_STAGE(PG8_SA(0, 1), a2 + hstep, voffA);
            PG8_WAIT_L(8); PG8_BAR; PG8_WAIT_L(0); PG8_MMA(0, 0, At, B0); PG8_BAR; PG8_SCHED;
            PG8_LDB(B1, 1, 1); PG8_STAGE(PG8_SB(1, 0), b3, voffB);
            PG8_BAR; PG8_WAIT_L(0); PG8_MMA(0, 1, At, B1); PG8_BAR;
            PG8_LDA(At, 1, 1); PG8_STAGE(PG8_SA(1, 0), a3, voffA);
            PG8_BAR; PG8_WAIT_L(0); PG8_MMA(1, 0, At, B0); PG8_BAR; PG8_SCHED;
            PG8_STAGE(PG8_SB(1, 1), b3 + hstep, voffB);
            PG8_WAIT_V(6); PG8_BAR; PG8_MMA(1, 1, At, B1); PG8_BAR;
        }
        PG8_STAMP();
        if constexpr (!Epi::AFTER_DRAIN) { E(acc, cur, wr, wc, fr, fq); S.done(cur); }
        PG8_STAMP();
        if (!has_next) break;
#pragma unroll
        for (int a = 0; a < 2; ++a)
#pragma unroll
            for (int b = 0; b < 2; ++b)
#pragma unroll
                for (int m = 0; m < 4; ++m)
#pragma unroll
                    for (int n = 0; n < 2; ++n) acc[a][b][m][n] = (f32x4){0.f, 0.f, 0.f, 0.f};
        cur = nxt; cA = nA; cB = nB; ++ui;
    }
    PG8_WAIT_V(0);
    if (wr == 0) PG8_BAR;
    PG8_BAR;
    if constexpr (Epi::AFTER_DRAIN) { E.fused(acc, cur, wr, wc, fr, fq, lds, wid, lane); S.done(cur); }
    PG8_STAMP();
    if (STAMP && wid == 0) { stamps[lane] = lane < nts ? (((unsigned long long)(unsigned)ts_hi << 32) | (unsigned)ts_lo) : 0ull;
        if (lane == 62) stamps[62] = rt_entry; if (lane == 63) stamps[63] = (unsigned long long)wall_clock64(); }
#undef PG8_STAMP
#undef PG8_SA
#undef PG8_SB
#undef PG8_STAGE
#undef PG8_LDA
#undef PG8_LDB
#undef PG8_MMA
#undef PG8_WAIT_V
#undef PG8_WAIT_L
#undef PG8_BAR
#undef PG8_SCHED
}
}

DI void tr_tile(const float* __restrict__ src, size_t ld_src, u16* __restrict__ dst, size_t ld_dst, float* sT) {
  const int tid = TIDX;
  const int r = tid >> 4, c4 = (tid & 15) * 4;
#pragma unroll
  for (int i = 0; i < 4; ++i) {
    float4 v = *reinterpret_cast<const float4*>(src + (size_t)(r + 16 * i) * ld_src + c4);
    float* d = sT + (r + 16 * i) * 65 + c4;
    d[0] = v.x; d[1] = v.y; d[2] = v.z; d[3] = v.w;
  }
  __syncthreads();
  const int n = tid >> 2, ks = (tid & 3) * 16;
  u32 w[8];
#pragma unroll
  for (int j = 0; j < 8; ++j) w[j] = pk2(sT[(ks + 2 * j) * 65 + n], sT[(ks + 2 * j + 1) * 65 + n]);
  u32x4* o = reinterpret_cast<u32x4*>(dst + (size_t)n * ld_dst + ks);
  o[0] = u32x4{w[0], w[1], w[2], w[3]};
  o[1] = u32x4{w[4], w[5], w[6], w[7]};
  __syncthreads();
}

DI void cvt8(const float* __restrict__ src, u16* __restrict__ dst) {
  float4 a = *reinterpret_cast<const float4*>(src);
  float4 b = *reinterpret_cast<const float4*>(src + 4);
  *reinterpret_cast<u32x4*>(dst) = u32x4{pk2(a.x, a.y), pk2(a.z, a.w), pk2(b.x, b.y), pk2(b.z, b.w)};
}

DI void mod_item(const Params& p, int i, unsigned char* lds) {
  const int tid = TIDX;
  const int l = i / 96, n0 = (i % 96) * 64;
  float* sS = reinterpret_cast<float*>(lds);
  float* red = sS + 5 * 2048;
  const float* c = p.in[10];
  const float* cctx = p.in[11];
  for (int e = tid; e < 5 * 2048; e += 256) {
    int v = e >> 11, k = e & 2047;
    float x = (v == 0) ? cctx[k] : c[(v - 1) * 2048 + k];
    sS[e] = silu(x);
  }
  __syncthreads();
  const int kk = tid >> 4, c4 = (tid & 15) * 4;
  const float* W = p.in[12 + 10 * l] + n0 + c4;
  f32x4 acc[5];
#pragma unroll
  for (int v = 0; v < 5; ++v) acc[v] = f32x4{0.f, 0.f, 0.f, 0.f};
#pragma unroll 8
  for (int k = kk; k < 2048; k += 16) {
    float4 w = *reinterpret_cast<const float4*>(W + (size_t)k * 6144);
#pragma unroll
    for (int v = 0; v < 5; ++v) {
      float s = sS[v * 2048 + k];
      acc[v][0] += s * w.x; acc[v][1] += s * w.y; acc[v][2] += s * w.z; acc[v][3] += s * w.w;
    }
  }
#pragma unroll
  for (int v = 0; v < 5; ++v)
#pragma unroll
    for (int q = 0; q < 4; ++q) red[(kk * 5 + v) * 64 + c4 + q] = acc[v][q];
  __syncthreads();
  for (int t2 = tid; t2 < 320; t2 += 256) {
    int v = t2 >> 6, n = t2 & 63;
    float s = 0.f;
#pragma unroll
    for (int k2 = 0; k2 < 16; ++k2) s += red[(k2 * 5 + v) * 64 + n];
    float* mod = reinterpret_cast<float*>(p.ws + WS_MOD);
    mod[(size_t)(l * 5 + v) * 6144 + n0 + n] = s + p.in[13 + 10 * l][n0 + n];
  }
  __syncthreads();
}

DI void phase_prep(const Params& p, unsigned char* lds) {
  constexpr int N_MOD = 384, N_TRWIN = 13312, N_TRWOUT = 4096, N_TRPOOL = 128, N_SGU = 64, N_CK = 4096, N_CV = 2048;
  constexpr int TOTAL = N_MOD + N_TRWIN + N_TRWOUT + N_TRPOOL + N_SGU + N_CK + N_CV + 1;
  const int tid = TIDX;
  float* sT = reinterpret_cast<float*>(lds);
  for (int it = VBID; it < TOTAL; it += VGRID) {
    int i = it;
    if (i < N_MOD) { mod_item(p, i, lds); continue; }
    i -= N_MOD;
    if (i < N_TRWIN) {
      int l, base;
      if (i < 3072) { l = 0; base = 0; } else if (i < 6656) { l = 1; base = 3072; } else if (i < 9728) { l = 2; base = 6656; } else { l = 3; base = 9728; }
      i -= base;
      const int N = (l & 1) ? 7168 : 6144, nN = N / 64;
      const int kt = i / nN, nt = i % nN;
      tr_tile(p.in[14 + 10 * l] + (size_t)kt * 64 * N + nt * 64, N,
              reinterpret_cast<u16*>(p.ws + ws_wint(l)) + (size_t)nt * 64 * 2048 + kt * 64, 2048, sT);
      continue;
    }
    i -= N_TRWIN;
    if (i < N_TRWOUT) {
      const int l = i >> 10, r = i & 1023, kt = r >> 5, nt = r & 31;
      tr_tile(p.in[15 + 10 * l] + (size_t)kt * 64 * 2048 + nt * 64, 2048,
              reinterpret_cast<u16*>(p.ws + WS_WOUTT) + (size_t)l * 2048 * 2048 + (size_t)nt * 64 * 2048 + kt * 64, 2048, sT);
      continue;
    }
    i -= N_TRWOUT;
    if (i < N_TRPOOL) {
      const int e = i >> 6, r = i & 63, g = r >> 4, t = r & 15, kt = t >> 2, nt = t & 3;
      tr_tile(p.in[18 + 20 * e] + (size_t)g * 65536 + kt * 64 * 256 + nt * 64, 256,
              reinterpret_cast<u16*>(p.ws + WS_POOLWT) + (size_t)e * 262144 + g * 65536 + nt * 64 * 256 + kt * 64, 256, sT);
      continue;
    }
    i -= N_TRPOOL;
    if (i < N_SGU) {
      const int e = i >> 5, ch = i & 31;
      const size_t off = (size_t)ch * 2048 + tid * 8;
      cvt8(p.in[30 + 20 * e] + off, reinterpret_cast<u16*>(p.ws + WS_SGUW) + (size_t)e * 65536 + off);
      continue;
    }
    i -= N_SGU;
    if (i < N_CK) {
      const int l = i >> 10, ch = i & 1023;
      const size_t off = (size_t)ch * 2048 + tid * 8;
      cvt8(p.in[2 + 2 * l] + off, reinterpret_cast<u16*>(p.ws + WS_CK) + (size_t)l * 2097152 + off);
      continue;
    }
    i -= N_CK;
    if (i < N_CV) {
      const int l = i >> 9, r = i & 511, bh = r >> 4, t = r & 15, kt = t >> 1, nt = t & 1;
      tr_tile(p.in[3 + 2 * l] + (size_t)bh * 65536 + kt * 64 * 128 + nt * 64, 128,
              reinterpret_cast<u16*>(p.ws + WS_CVT) + (size_t)l * 2097152 + (size_t)bh * 65536 + nt * 64 * 512 + kt * 64, 512, sT);
      continue;
    }
    {
      float* rc = reinterpret_cast<float*>(p.ws + WS_ROPE);
      for (int e = tid; e < 1024; e += 256) {
        int pos = e >> 4, fi = e & 15;
        float inv = 1.0f / powf(10000.0f, (float)(2 * fi) / 32.0f);
        float ang = (float)pos * inv;
        rc[e] = cosf(ang);
        rc[1024 + e] = sinf(ang);
      }
    }
  }
}

DI void phase_mod0(const Params& p) {
  const int tid = TIDX;
  const float* mod = reinterpret_cast<const float*>(p.ws + WS_MOD);
  u16* H = reinterpret_cast<u16*>(p.ws + WS_H);
  for (int it = VBID; it < T_ALL / 4; it += VGRID) {
#pragma unroll
    for (int rr = 0; rr < 4; ++rr) {
      const int row = it * 4 + rr;
      const int cond = row < TP ? 0 : 1 + ((row - TP) >> 12);
      const float* src = row < TP ? p.in[0] + (size_t)row * 2048 : p.in[1] + (size_t)(row - TP) * 2048;
      const int e = tid * 8;
      const float* sh = mod + (size_t)cond * 6144 + e;
      float4 a = *reinterpret_cast<const float4*>(src + e), b = *reinterpret_cast<const float4*>(src + e + 4);
      float4 s0 = *reinterpret_cast<const float4*>(sh), s1 = *reinterpret_cast<const float4*>(sh + 4);
      float4 c0 = *reinterpret_cast<const float4*>(sh + 2048), c1 = *reinterpret_cast<const float4*>(sh + 2052);
      u32x4 o = {pk2(a.x * (1.f + c0.x) + s0.x, a.y * (1.f + c0.y) + s0.y), pk2(a.z * (1.f + c0.z) + s0.z, a.w * (1.f + c0.w) + s0.w),
                 pk2(b.x * (1.f + c1.x) + s1.x, b.y * (1.f + c1.y) + s1.y), pk2(b.z * (1.f + c1.z) + s1.z, b.w * (1.f + c1.w) + s1.w)};
      *reinterpret_cast<u32x4*>(H + (size_t)row * 2048 + e) = o;
    }
  }
}


template <int MODE>
struct EpiIn {
  static constexpr bool PERM = false, AFTER_DRAIN = false;
  u16* PROJ; u16* VT; float* kout; float* vout; const float* ropeC; const float* ropeS;
  DI void operator()(const f32x4 (&acc)[2][2][4][2], const pg8::Unit& u, int wr, int wc, int fr, int fq) const {
    constexpr int NC = (MODE == G_IN_EVEN) ? 6144 : 7168;
    constexpr int SEC_Q = (MODE == G_IN_EVEN) ? 2 : 0, SEC_K = (MODE == G_IN_EVEN) ? 3 : 1, SEC_V = (MODE == G_IN_EVEN) ? 4 : 2;
    const int sec = u.pn >> 2;
    const bool prompt = u.pm < 32;
    const bool isq = sec == SEC_Q, isk = sec == SEC_K;
    const bool rope = (MODE == G_IN_EVEN) && (isq || isk) && !prompt;
    const float sc = isq ? ((MODE == G_IN_EVEN) ? 0.125f * LOG2E : 0.08838834764831845f * LOG2E) : 1.0f;
#pragma unroll
    for (int ai = 0; ai < 2; ++ai)
#pragma unroll
      for (int m = 0; m < 4; ++m) {
        const int row = u.pm * 256 + ai * 128 + wr * 64 + m * 16 + fr;
        int b, t;
        if (prompt) { b = row >> 8; t = row & 255; } else { const int rs = row - TP; b = rs >> 12; t = rs & 4095; }
#pragma unroll
        for (int bj = 0; bj < 2; ++bj) {
          const int hh = (u.pn & 3) * 2 + bj;
          const int d0 = wc * 32 + 4 * fq;
          if (sec == SEC_V) {
#pragma unroll
            for (int n = 0; n < 2; ++n) {
              const f32x4 v = acc[ai][bj][m][n];
              const int dv = d0 + 16 * n;
              const u32 w01 = pk2(v[0], v[1]), w23 = pk2(v[2], v[3]);
              if (prompt) {
                u16* vt = VT + ((size_t)((b * 8 + hh) * 128 + dv)) * 256 + t;
                vt[0] = (u16)(w01 & 0xffffu); vt[256] = (u16)(w01 >> 16); vt[512] = (u16)(w23 & 0xffffu); vt[768] = (u16)(w23 >> 16);
                *reinterpret_cast<float4*>(vout + ((size_t)((b * 8 + hh) * 256 + t)) * 128 + dv) = float4{v[0], v[1], v[2], v[3]};
              } else {
                u16* vt = VT + 8388608 + ((size_t)((b * 8 + hh) * 128 + dv)) * 4096 + t;
                vt[0] = (u16)(w01 & 0xffffu); vt[4096] = (u16)(w01 >> 16); vt[8192] = (u16)(w23 & 0xffffu); vt[12288] = (u16)(w23 >> 16);
              }
            }
          } else {
            f32x4 v0 = acc[ai][bj][m][0], v1 = acc[ai][bj][m][1];
            if (isk && prompt) {
              float* ko = kout + ((size_t)((b * 8 + hh) * 256 + t)) * 128 + d0;
              *reinterpret_cast<float4*>(ko) = float4{v0[0], v0[1], v0[2], v0[3]};
              *reinterpret_cast<float4*>(ko + 16) = float4{v1[0], v1[1], v1[2], v1[3]};
            }
            if (rope) {
              const int pos = (wc & 1) ? (t & 63) : (t >> 6);
              const float4 cs = *reinterpret_cast<const float4*>(ropeC + pos * 16 + 4 * fq);
              const float4 sn = *reinterpret_cast<const float4*>(ropeS + pos * 16 + 4 * fq);
              const float c4[4] = {cs.x, cs.y, cs.z, cs.w}, s4[4] = {sn.x, sn.y, sn.z, sn.w};
#pragma unroll
              for (int j = 0; j < 4; ++j) {
                const float x1 = v0[j], x2 = v1[j];
                v0[j] = x1 * c4[j] - x2 * s4[j];
                v1[j] = x1 * s4[j] + x2 * c4[j];
              }
            }
            u16* dst = PROJ + (size_t)row * NC + u.pn * 256 + bj * 128 + d0;
            *reinterpret_cast<u32x2*>(dst) = u32x2{pk2(v0[0] * sc, v0[1] * sc), pk2(v0[2] * sc, v0[3] * sc)};
            *reinterpret_cast<u32x2*>(dst + 16) = u32x2{pk2(v1[0] * sc, v1[1] * sc), pk2(v1[2] * sc, v1[3] * sc)};
          }
        }
      }
  }
};

struct EpiOut {
  static constexpr bool PERM = false, AFTER_DRAIN = false;
  float* X; const float* x0; const float* x1; const float* mod; int l;
  DI void operator()(const f32x4 (&acc)[2][2][4][2], const pg8::Unit& u, int wr, int wc, int fr, int fq) const {
    const bool prompt = u.pm < 32;
    const int cond = prompt ? 0 : 1 + ((u.pm * 256 - TP) >> 12);
    const float* gate = mod + (size_t)(l * 5 + cond) * 6144 + 4096;
#pragma unroll
    for (int bj = 0; bj < 2; ++bj)
#pragma unroll
      for (int n = 0; n < 2; ++n) {
        const int col = u.pn * 256 + bj * 128 + wc * 32 + 16 * n + 4 * fq;
        const float4 g4 = *reinterpret_cast<const float4*>(gate + col);
#pragma unroll
        for (int ai = 0; ai < 2; ++ai)
#pragma unroll
          for (int m = 0; m < 4; ++m) {
            const int row = u.pm * 256 + ai * 128 + wr * 64 + m * 16 + fr;
            float4 xo;
            if (l == 0) xo = prompt ? *reinterpret_cast<const float4*>(x0 + (size_t)row * 2048 + col)
                                    : *reinterpret_cast<const float4*>(x1 + (size_t)(row - TP) * 2048 + col);
            else xo = *reinterpret_cast<const float4*>(X + (size_t)row * 2048 + col);
            const f32x4 a = acc[ai][bj][m][n];
            float4 o;
            o.x = ALPHA * xo.x + g4.x * a[0]; o.y = ALPHA * xo.y + g4.y * a[1];
            o.z = ALPHA * xo.z + g4.z * a[2]; o.w = ALPHA * xo.w + g4.w * a[3];
            *reinterpret_cast<float4*>(X + (size_t)row * 2048 + col) = o;
          }
      }
  }
};

template <int MODE>
DI void gemm_phase(const Params& p, int l, unsigned char* lds) {
  constexpr int N = (MODE == G_OUT) ? 2048 : (MODE == G_IN_EVEN ? 6144 : 7168);
  pg8::Gemm g;
  g.A = reinterpret_cast<const u16*>(p.ws + WS_H);
  g.Bt = (MODE == G_OUT) ? reinterpret_cast<const u16*>(p.ws + WS_WOUTT) + (size_t)l * 2048 * 2048
                         : reinterpret_cast<const u16*>(p.ws + ws_wint(l));
  g.M = T_ALL; g.N = N; g.K = 2048;
  pg8::StaticOrder S;
  S.init(T_ALL, N, (int)gridDim.x, (int)blockIdx.x);
  PG8_LAS unsigned char* l3 = (PG8_LAS unsigned char*)lds;
  if constexpr (MODE == G_OUT) {
    EpiOut E;
    E.X = p.out; E.x0 = p.in[0]; E.x1 = p.in[1]; E.mod = reinterpret_cast<const float*>(p.ws + WS_MOD); E.l = l;
    pg8::gemm_phase<EpiOut, pg8::StaticOrder, false>(l3, g, S, E, nullptr);
  } else {
    EpiIn<MODE> E;
    E.PROJ = reinterpret_cast<u16*>(p.ws + WS_PROJ); E.VT = reinterpret_cast<u16*>(p.ws + WS_VT);
    E.kout = p.out + (size_t)T_ALL * 2048 + (size_t)(2 * l) * 8388608;
    E.vout = p.out + (size_t)T_ALL * 2048 + (size_t)(2 * l + 1) * 8388608;
    E.ropeC = reinterpret_cast<const float*>(p.ws + WS_ROPE); E.ropeS = E.ropeC + 1024;
    pg8::gemm_phase<EpiIn<MODE>, pg8::StaticOrder, false>(l3, g, S, E, nullptr);
  }
}

DI void phase_ln(const Params& p, int l) {
  const int tid_ = TIDX, lane = tid_ & 63, wid = tid_ >> 6;
  const float* g = p.in[16 + 10 * l];
  const float* bb = p.in[17 + 10 * l];
  const float* mod = reinterpret_cast<const float*>(p.ws + WS_MOD);
  u16* H = reinterpret_cast<u16*>(p.ws + WS_H);
  float* X = p.out;
  for (int it = VBID; it < T_ALL / 4; it += VGRID) {
    const int row = it * 4 + wid;
    float* xr = X + (size_t)row * 2048;
    float4 v[8];
    float s = 0.f;
#pragma unroll
    for (int i = 0; i < 8; ++i) {
      v[i] = *reinterpret_cast<const float4*>(xr + (i * 64 + lane) * 4);
      s += v[i].x + v[i].y + v[i].z + v[i].w;
    }
#pragma unroll
    for (int o = 32; o >= 1; o >>= 1) s += __shfl_xor(s, o);
    const float mu = s * (1.f / 2048.f);
    float ss = 0.f;
#pragma unroll
    for (int i = 0; i < 8; ++i) {
      float a = v[i].x - mu, b = v[i].y - mu, c = v[i].z - mu, d = v[i].w - mu;
      ss += a * a + b * b + c * c + d * d;
    }
#pragma unroll
    for (int o = 32; o >= 1; o >>= 1) ss += __shfl_xor(ss, o);
    const float rstd = rsqrtf(ss * (1.f / 2048.f) + LN_EPS);
    const int cond = row < TP ? 0 : 1 + ((row - TP) >> 12);
    const float* sh = mod + (size_t)((l + 1) * 5 + cond) * 6144;
#pragma unroll
    for (int i = 0; i < 8; ++i) {
      const int e = (i * 64 + lane) * 4;
      float4 gg = *reinterpret_cast<const float4*>(g + e), b4 = *reinterpret_cast<const float4*>(bb + e);
      float4 y;
      y.x = (v[i].x - mu) * rstd * gg.x + b4.x; y.y = (v[i].y - mu) * rstd * gg.y + b4.y;
      y.z = (v[i].z - mu) * rstd * gg.z + b4.z; y.w = (v[i].w - mu) * rstd * gg.w + b4.w;
      *reinterpret_cast<float4*>(xr + e) = y;
      if (l < 3) {
        float4 s0 = *reinterpret_cast<const float4*>(sh + e), c0 = *reinterpret_cast<const float4*>(sh + 2048 + e);
        u32x2 o = {pk2(y.x * (1.f + c0.x) + s0.x, y.y * (1.f + c0.y) + s0.y), pk2(y.z * (1.f + c0.z) + s0.z, y.w * (1.f + c0.w) + s0.w)};
        *reinterpret_cast<u32x2*>(H + (size_t)row * 2048 + e) = o;
      }
    }
  }
}

struct AttnSrc {
  const u16* k0; const u16* vt0; int ks0, vs0, n0;
  const u16* k1; const u16* vt1; int ks1, vs1, n1;
};

template <int DQK>
DI void attn_ldg(const AttnSrc& s, int j, u32x4 (&rk)[DQK / 64], u32x4 (&rv)[2]) {
  const u16* kb; const u16* vb; int ks, vs;
  if (j < s.n0) { kb = s.k0 + (size_t)j * 64 * s.ks0; vb = s.vt0 + j * 64; ks = s.ks0; vs = s.vs0; }
  else { const int jj = j - s.n0; kb = s.k1 + (size_t)jj * 64 * s.ks1; vb = s.vt1 + jj * 64; ks = s.ks1; vs = s.vs1; }
  constexpr int CPR = DQK / 8;
  const int tid = TID8;
#pragma unroll
  for (int i = 0; i < DQK / 64; ++i) {
    const int c = tid + 512 * i, row = c / CPR, kc = c % CPR;
    rk[i] = *reinterpret_cast<const u32x4*>(kb + (size_t)row * ks + kc * 8);
  }
#pragma unroll
  for (int i = 0; i < 2; ++i) {
    const int c = tid + 512 * i, row = c >> 3, kc = c & 7;
    rv[i] = *reinterpret_cast<const u32x4*>(vb + (size_t)row * vs + kc * 8);
  }
}
template <int DQK>
DI void attn_sts(u16* sK, u16* sVT, const u32x4 (&rk)[DQK / 64], const u32x4 (&rv)[2]) {
  constexpr int CPR = DQK / 8;
  const int tid = TID8;
#pragma unroll
  for (int i = 0; i < DQK / 64; ++i) {
    const int c = tid + 512 * i, row = c / CPR, kc = c % CPR;
    *reinterpret_cast<u32x4*>(sK + row * (DQK + 8) + kc * 8) = rk[i];
  }
#pragma unroll
  for (int i = 0; i < 2; ++i) {
    const int c = tid + 512 * i, row = c >> 3, kc = c & 7;
    *reinterpret_cast<u32x4*>(sVT + row * 72 + kc * 8) = rv[i];
  }
}

DI void attn_pv(const f32x16 (&s)[2], const u16* vw, f32x16 (&O)[4]) {
  __builtin_amdgcn_s_setprio(1);
#pragma unroll
  for (int s4 = 0; s4 < 4; ++s4) {
    const int t = s4 >> 1, b0 = (s4 & 1) * 8;
    u32x4 w = {pk2(s[t][b0], s[t][b0 + 1]), pk2(s[t][b0 + 2], s[t][b0 + 3]), pk2(s[t][b0 + 4], s[t][b0 + 5]), pk2(s[t][b0 + 6], s[t][b0 + 7])};
    const bf16x8 pf = __builtin_bit_cast(bf16x8, w);
#pragma unroll
    for (int d = 0; d < 4; ++d) {
      bf16x8 a = ld8(vw + d * 32 * 72 + s4 * 16);
      O[d] = mfma32(a, pf, O[d]);
    }
  }
  __builtin_amdgcn_s_setprio(0);
}

template <int DQK, bool NA>
DI void attn_run(const AttnSrc& src, const u16* qblk, int qstride, u16* sQ, u16* sK, u16* sVT, f32x16 (&O)[4], float& l_out,
                 int qr, int qc, int rsmin, const float* sBias) {
  const int tid = TID8, lane = tid & 63, wid = tid >> 6;
  const int r = lane & 31, h = lane >> 5;
  const int pr = (r & 0x13) | ((r & 4) << 1) | ((r & 8) >> 1);
  constexpr int CPR = DQK / 8, QS = DQK + 8;
  __syncthreads();
#pragma unroll
  for (int i = 0; i < DQK / 16; ++i) {
    const int c = tid + 512 * i, row = c / CPR, kc = c % CPR;
    *reinterpret_cast<u32x4*>(sQ + row * QS + kc * 8) = *reinterpret_cast<const u32x4*>(qblk + (size_t)row * qstride + kc * 8);
  }
#pragma unroll
  for (int d = 0; d < 4; ++d)
#pragma unroll
    for (int i = 0; i < 16; ++i) O[d][i] = 0.f;
  float m = -1e30f, l = 0.f;
  const int nt = src.n0 + src.n1;
  const int rsq = min(max(qr - 4, 0), 56);
  const int cs = min(max(qc - 8, 0), 48);
  const u16* qw = sQ + (wid * 32 + r) * QS + 8 * h;
  const u16* kw = sK + pr * QS + 8 * h;
  u16* sVT1 = sVT + 128 * 72 + 2048;
  const bool grpB = wid >= 4;
  bool pend = false;
  f32x16 s[2];
  u32x4 rk[DQK / 64], rv[2];
  attn_ldg<DQK>(src, 0, rk, rv);
#pragma unroll 1
  for (int j = 0; j < nt; ++j) {
    if (j > 0) __syncthreads();
    u16* vcur = (j & 1) ? sVT1 : sVT;
    attn_sts<DQK>(sK, vcur, rk, rv);
    __syncthreads();
    if (j + 1 < nt) attn_ldg<DQK>(src, j + 1, rk, rv);
    __builtin_amdgcn_sched_barrier(0);
    if (grpB && pend) { attn_pv(s, ((j & 1) ? sVT : sVT1) + r * 72 + 8 * h, O); pend = false; }
    bool active = true;
    int kr = 0;
    if (NA && j >= src.n0) { kr = rsmin + (j - src.n0); active = (kr >= rsq) && (kr < rsq + 8); }
    if (active) {
      __builtin_amdgcn_s_setprio(1);
#pragma unroll
      for (int t = 0; t < 2; ++t) {
#pragma unroll
        for (int i = 0; i < 16; ++i) s[t][i] = 0.f;
#pragma unroll
        for (int ks = 0; ks < DQK / 16; ++ks) {
          bf16x8 a = ld8(kw + t * 32 * QS + ks * 16);
          bf16x8 q = ld8(qw + ks * 16);
          s[t] = mfma32(a, q, s[t]);
        }
      }
      __builtin_amdgcn_s_setprio(0);
      if (NA && j >= src.n0) {
        const float* bp = sBias + (kr - qr + 7) * 31 + (8 * h - qc + 15);
        const int kb = 8 * h - cs;
#pragma unroll
        for (int t = 0; t < 2; ++t)
#pragma unroll
          for (int i = 0; i < 16; ++i) {
            const int ko = t * 32 + 16 * (i >> 3) + (i & 7);
            const bool ok = (unsigned)(ko + kb) < 16u;
            const float bv = bp[ko];
            s[t][i] = ok ? s[t][i] + bv : -1e30f;
          }
      }
      float mx = -1e30f;
#pragma unroll
      for (int t = 0; t < 2; ++t)
#pragma unroll
        for (int i = 0; i < 16; ++i) mx = fmaxf(mx, s[t][i]);
      mx = fmaxf(mx, __shfl_xor(mx, 32));
      if (__builtin_amdgcn_ballot_w64(mx > m + 8.0f) != 0ull) {
        const float mn = fmaxf(m, mx);
        const float alpha = ex2(m - mn);
        l *= alpha;
        m = mn;
#pragma unroll
        for (int d = 0; d < 4; ++d)
#pragma unroll
          for (int i = 0; i < 16; ++i) O[d][i] *= alpha;
      }
      float rsum = 0.f;
#pragma unroll
      for (int t = 0; t < 2; ++t)
#pragma unroll
        for (int i = 0; i < 16; ++i) { const float e = ex2(s[t][i] - m); s[t][i] = e; rsum += e; }
      rsum += __shfl_xor(rsum, 32);
      l += rsum;
      if (!grpB) attn_pv(s, vcur + r * 72 + 8 * h, O);
      else pend = true;
    }
  }
  if (grpB && pend) attn_pv(s, (((nt - 1) & 1) ? sVT1 : sVT) + r * 72 + 8 * h, O);
  l_out = l;
}

DI void heavy_map(int it, int& bh, int& qb) { const int x = it & 7, rest = it >> 3; qb = rest & 15; bh = x + 8 * (rest >> 4); }

DI void diff_item(const Params& p, int l, bool sample, int bh, int qb, unsigned char* lds) {
  constexpr int NC = 6144;
  const int tid_ = TID8, lane = tid_ & 63, wid = tid_ >> 6, r = lane & 31, h = lane >> 5;
  const int b = bh >> 3, hd = bh & 7;
  u16* sQ = reinterpret_cast<u16*>(lds);
  u16* sK = sQ + 256 * 136;
  u16* sVT = sK + 64 * 136;
  const u16* PROJ = reinterpret_cast<const u16*>(p.ws + WS_PROJ);
  const u16* VT = reinterpret_cast<const u16*>(p.ws + WS_VT);
  const int seq0 = sample ? TP + b * 4096 : b * 256;
  const int token = seq0 + qb * 256 + wid * 32 + r;
  const float* dl = p.in[20 + 10 * l];
  float pa = dl[lane] * dl[64 + lane], pb = dl[128 + lane] * dl[192 + lane];
#pragma unroll
  for (int o = 32; o >= 1; o >>= 1) { pa += __shfl_xor(pa, o); pb += __shfl_xor(pb, o); }
  const float lam_init = 0.8f - 0.6f * __expf(-0.3f * (float)l);
  const float lam = __expf(pa) - __expf(pb) + lam_init;

  u32 o1p[32];
  f32x16 O[4];
  float lsum;
#pragma unroll
  for (int comp = 0; comp < 2; ++comp) {
    AttnSrc s;
    if (sample) {
      s.k0 = reinterpret_cast<const u16*>(p.ws + WS_CK) + (size_t)l * 2097152 + (size_t)bh * 65536 + comp * 64; s.ks0 = 128;
      s.vt0 = reinterpret_cast<const u16*>(p.ws + WS_CVT) + (size_t)l * 2097152 + (size_t)bh * 65536; s.vs0 = 512; s.n0 = 8;
      s.k1 = PROJ + (size_t)seq0 * NC + 3072 + hd * 128 + comp * 64; s.ks1 = NC;
      s.vt1 = VT + 8388608 + (size_t)bh * 128 * 4096; s.vs1 = 4096; s.n1 = 64;
    } else {
      s.k0 = nullptr; s.vt0 = nullptr; s.ks0 = 0; s.vs0 = 0; s.n0 = 0;
      s.k1 = PROJ + (size_t)seq0 * NC + 3072 + hd * 128 + comp * 64; s.ks1 = NC;
      s.vt1 = VT + (size_t)bh * 128 * 256; s.vs1 = 256; s.n1 = 4;
    }
    const u16* qblk = PROJ + (size_t)(seq0 + qb * 256) * NC + 2048 + hd * 128 + comp * 64;
    attn_run<64, false>(s, qblk, NC, sQ, sK, sVT, O, lsum, 0, 0, 0, nullptr);
    const float inv = 1.f / lsum;
    if (comp == 0) {
#pragma unroll
      for (int d = 0; d < 4; ++d)
#pragma unroll
        for (int i = 0; i < 8; ++i) o1p[d * 8 + i] = pk2(O[d][2 * i] * inv, O[d][2 * i + 1] * inv);
    } else {
      float ssq = 0.f;
#pragma unroll
      for (int d = 0; d < 4; ++d)
#pragma unroll
        for (int i = 0; i < 8; ++i) {
          const u32 w = o1p[d * 8 + i];
          const float a = bflo(w) - lam * O[d][2 * i] * inv, c = bfhi(w) - lam * O[d][2 * i + 1] * inv;
          O[d][2 * i] = a; O[d][2 * i + 1] = c;
          ssq += a * a + c * c;
        }
      ssq += __shfl_xor(ssq, 32);
      const float rn = rsqrtf(ssq * (1.f / 128.f) + LN_EPS) * (1.f - lam_init);
      const float* subln = p.in[21 + 10 * l];
      const u16* gp = PROJ + (size_t)token * NC + 5120 + hd * 128;
      u16* yp = reinterpret_cast<u16*>(p.ws + WS_H) + (size_t)token * 2048 + 1024 + hd * 128;
#pragma unroll
      for (int d = 0; d < 4; ++d)
#pragma unroll
        for (int q = 0; q < 4; ++q) {
          const int dv = d * 32 + 8 * q + 4 * h;
          const u32x2 gw = *reinterpret_cast<const u32x2*>(gp + dv);
          const float4 sl = *reinterpret_cast<const float4*>(subln + dv);
          const float y0 = O[d][4 * q] * rn * sl.x * silu(bflo(gw[0]));
          const float y1 = O[d][4 * q + 1] * rn * sl.y * silu(bfhi(gw[0]));
          const float y2 = O[d][4 * q + 2] * rn * sl.z * silu(bflo(gw[1]));
          const float y3 = O[d][4 * q + 3] * rn * sl.w * silu(bfhi(gw[1]));
          *reinterpret_cast<u32x2*>(yp + dv) = (ZERO_MASK & 2) ? u32x2{0u, 0u} : u32x2{pk2(y0, y1), pk2(y2, y3)};
        }
    }
  }
}

DI void pool_item(const Params& p, int l, int pi, unsigned char* lds) {
  constexpr int NC = 6144;
  const int tid = TIDX, lane = tid & 63, wid = tid >> 6, fr = lane & 15, fq = lane >> 4;
  const int tb = pi >> 2, g = pi & 3, row0 = tb * 64;
  const int L = row0 < TP ? 256 : 4096;
  const int t0 = row0 < TP ? (row0 & 255) : ((row0 - TP) & 4095);
  u16* sIn = reinterpret_cast<u16*>(lds);
  u16* sP = sIn + 80 * 264;
  const u16* PROJ = reinterpret_cast<const u16*>(p.ws + WS_PROJ);
  __syncthreads();
#pragma unroll
  for (int i = 0; i < 10; ++i) {
    const int c = tid + 256 * i, rr = c >> 5, oc = c & 31;
    const int t = t0 - 8 + rr;
    u32x4 v = {0u, 0u, 0u, 0u};
    if (t >= 0 && t < L) v = *reinterpret_cast<const u32x4*>(PROJ + (size_t)(row0 - 8 + rr) * NC + g * 256 + oc * 8);
    *reinterpret_cast<u32x4*>(sIn + rr * 264 + oc * 8) = v;
  }
  __syncthreads();
  {
    const int oc = tid & 31, seg = tid >> 5;
    const int half = 1 << g;
#pragma unroll 1
    for (int tt = 0; tt < 8; ++tt) {
      const int tl = seg * 8 + tt, t = t0 + tl;
      const int lo = max(t - half, 0), hi = min(t + half, L);
      float a[8];
#pragma unroll
      for (int k = 0; k < 8; ++k) a[k] = 0.f;
      for (int s = lo; s < hi; ++s) {
        const u32x4 v = *reinterpret_cast<const u32x4*>(sIn + (s - t0 + 8) * 264 + oc * 8);
#pragma unroll
        for (int k = 0; k < 4; ++k) { a[2 * k] += bflo(v[k]); a[2 * k + 1] += bfhi(v[k]); }
      }
      const float ic = 1.f / (float)(hi - lo);
      const u32x4 x = *reinterpret_cast<const u32x4*>(sIn + (tl + 8) * 264 + oc * 8);
      u32x4 o;
#pragma unroll
      for (int k = 0; k < 4; ++k) o[k] = pk2(a[2 * k] * ic - bflo(x[k]), a[2 * k + 1] * ic - bfhi(x[k]));
      *reinterpret_cast<u32x4*>(sP + tl * 264 + oc * 8) = o;
    }
  }
  __syncthreads();
  const u16* W = reinterpret_cast<const u16*>(p.ws + WS_POOLWT) + (size_t)(l >> 1) * 262144 + (size_t)g * 65536;
  f32x4 acc[4][4];
#pragma unroll
  for (int a = 0; a < 4; ++a)
#pragma unroll
    for (int b = 0; b < 4; ++b) acc[a][b] = f32x4{0.f, 0.f, 0.f, 0.f};
#pragma unroll 2
  for (int ks = 0; ks < 8; ++ks) {
    bf16x8 af[4], bfr[4];
#pragma unroll
    for (int m = 0; m < 4; ++m) af[m] = ld8(sP + (m * 16 + fr) * 264 + ks * 32 + fq * 8);
#pragma unroll
    for (int n = 0; n < 4; ++n) bfr[n] = ld8(W + (size_t)(wid * 64 + n * 16 + fr) * 256 + ks * 32 + fq * 8);
#pragma unroll
    for (int m = 0; m < 4; ++m)
#pragma unroll
      for (int n = 0; n < 4; ++n) acc[m][n] = mfma16(bfr[n], af[m], acc[m][n]);
  }
  const float* pscale = p.in[19 + 10 * l];
  u16* Y = reinterpret_cast<u16*>(p.ws + WS_H);
#pragma unroll
  for (int n = 0; n < 4; ++n) {
    const int col = g * 256 + wid * 64 + n * 16 + 4 * fq;
    const float4 sc = *reinterpret_cast<const float4*>(pscale + col);
#pragma unroll
    for (int m = 0; m < 4; ++m) {
      const int row = row0 + m * 16 + fr;
      const u32x2 gw = *reinterpret_cast<const u32x2*>(PROJ + (size_t)row * NC + 1024 + col);
      float y0 = acc[m][n][0] * sc.x * silu(bflo(gw[0])), y1 = acc[m][n][1] * sc.y * silu(bfhi(gw[0]));
      float y2 = acc[m][n][2] * sc.z * silu(bflo(gw[1])), y3 = acc[m][n][3] * sc.w * silu(bfhi(gw[1]));
      if (ZERO_MASK & 1) { y0 = y1 = y2 = y3 = 0.f; }
      *reinterpret_cast<u32x2*>(Y + (size_t)row * 2048 + col) = u32x2{pk2(y0, y1), pk2(y2, y3)};
    }
  }
}

DI void phase_mix_even(const Params& p, int l, unsigned char* lds, unsigned char* lds_all) {
#pragma unroll 1
  for (int it = blockIdx.x; it < 512; it += gridDim.x) { int bh, qb; heavy_map(it, bh, qb); diff_item(p, l, true, bh, qb, lds_all); }
#pragma unroll 1
  for (int it = blockIdx.x; it < 256; it += gridDim.x) diff_item(p, l, false, it, 0, lds_all);
#pragma unroll 1
  for (int it = VBID; it < 1536; it += VGRID) pool_item(p, l, it, lds);
}

DI void na_item(const Params& p, int l, bool sample, int bh, int qb, unsigned char* lds) {
  constexpr int NC = 7168;
  const int tid = TID8, lane = tid & 63, wid = tid >> 6, r = lane & 31, h = lane >> 5;
  const int b = bh >> 3, hd = bh & 7;
  u16* sQ = reinterpret_cast<u16*>(lds);
  u16* sK = sQ + 256 * 136;
  u16* sVT = sK + 64 * 136;
  float* sBias = reinterpret_cast<float*>(sVT + 128 * 72) + 64;
  const u16* PROJ = reinterpret_cast<const u16*>(p.ws + WS_PROJ);
  const u16* VT = reinterpret_cast<const u16*>(p.ws + WS_VT);
  const int seq0 = sample ? TP + b * 4096 : b * 256;
  const int token = seq0 + qb * 256 + wid * 32 + r;
  AttnSrc s;
  int qr = 0, qc = 0, rsmin = 0;
  f32x16 O[4];
  float lsum;
  const u16* qblk = PROJ + (size_t)(seq0 + qb * 256) * NC + hd * 128;
  if (sample) {
    __syncthreads();
    const float* rpb = p.in[18 + 10 * l] + hd * 465;
    for (int e = tid; e < 465; e += 512) sBias[e] = rpb[e] * LOG2E;
    const int r0 = qb * 4;
    qr = r0 + (wid >> 1); qc = (wid & 1) * 32 + r;
    rsmin = min(max(r0 - 4, 0), 56);
    const int rs1 = min(max(r0 - 1, 0), 56);
    s.k0 = reinterpret_cast<const u16*>(p.ws + WS_CK) + (size_t)l * 2097152 + (size_t)bh * 65536; s.ks0 = 128;
    s.vt0 = reinterpret_cast<const u16*>(p.ws + WS_CVT) + (size_t)l * 2097152 + (size_t)bh * 65536; s.vs0 = 512; s.n0 = 8;
    s.k1 = PROJ + (size_t)(seq0 + rsmin * 64) * NC + 1024 + hd * 128; s.ks1 = NC;
    s.vt1 = VT + 8388608 + (size_t)bh * 128 * 4096 + rsmin * 64; s.vs1 = 4096; s.n1 = rs1 + 8 - rsmin;
    attn_run<128, true>(s, qblk, NC, sQ, sK, sVT, O, lsum, qr, qc, rsmin, sBias);
  } else {
    s.k0 = nullptr; s.vt0 = nullptr; s.ks0 = 0; s.vs0 = 0; s.n0 = 0;
    s.k1 = PROJ + (size_t)seq0 * NC + 1024 + hd * 128; s.ks1 = NC;
    s.vt1 = VT + (size_t)bh * 128 * 256; s.vs1 = 256; s.n1 = 4;
    attn_run<128, false>(s, qblk, NC, sQ, sK, sVT, O, lsum, 0, 0, 0, nullptr);
  }
  const float inv = 1.f / lsum;
  const u16* gp = PROJ + (size_t)token * NC + 3072 + hd * 128;
  u16* yp = reinterpret_cast<u16*>(p.ws + WS_H) + (size_t)token * 2048 + hd * 128;
#pragma unroll
  for (int d = 0; d < 4; ++d)
#pragma unroll
    for (int q = 0; q < 4; ++q) {
      const int dv = d * 32 + 8 * q + 4 * h;
      const u32x2 gw = *reinterpret_cast<const u32x2*>(gp + dv);
      const float y0 = O[d][4 * q] * inv * silu(bflo(gw[0]));
      const float y1 = O[d][4 * q + 1] * inv * silu(bfhi(gw[0]));
      const float y2 = O[d][4 * q + 2] * inv * silu(bflo(gw[1]));
      const float y3 = O[d][4 * q + 3] * inv * silu(bfhi(gw[1]));
      *reinterpret_cast<u32x2*>(yp + dv) = (ZERO_MASK & 4) ? u32x2{0u, 0u} : u32x2{pk2(y0, y1), pk2(y2, y3)};
    }
}

DI void sgu_item(const Params& p, int l, int si, unsigned char* lds) {
  constexpr int NC = 7168;
  const int tid = TIDX, lane = tid & 63, wid = tid >> 6, fr = lane & 15, fq = lane >> 4;
  const int ch = si >> 2, g = si & 3, row0 = ch * 128;
  u16* vnT = reinterpret_cast<u16*>(lds);
  float* sMu = reinterpret_cast<float*>(vnT + 256 * 136);
  float* sRs = sMu + 128;
  const u16* PROJ = reinterpret_cast<const u16*>(p.ws + WS_PROJ);
  __syncthreads();
  {
    const int grp = tid >> 4, ln = tid & 15;
#pragma unroll 1
    for (int rr = 0; rr < 8; ++rr) {
      const u16* src = PROJ + (size_t)(row0 + grp * 8 + rr) * NC + 5120;
      float s = 0.f, ss = 0.f;
#pragma unroll
      for (int c8 = 0; c8 < 8; ++c8) {
        const u32x4 v = *reinterpret_cast<const u32x4*>(src + (ln + 16 * c8) * 8);
#pragma unroll
        for (int k = 0; k < 4; ++k) { const float a = bflo(v[k]), b = bfhi(v[k]); s += a + b; ss += a * a + b * b; }
      }
#pragma unroll
      for (int o = 8; o >= 1; o >>= 1) { s += __shfl_xor(s, o); ss += __shfl_xor(ss, o); }
      const float mu = s * (1.f / 1024.f);
      const float var = fmaxf(ss * (1.f / 1024.f) - mu * mu, 0.f);
      if (ln == 0) { sMu[grp * 8 + rr] = mu; sRs[grp * 8 + rr] = rsqrtf(var + LN_EPS); }
    }
  }
  __syncthreads();
  {
    const int j = tid & 127, hf = tid >> 7;
    const float mu = sMu[j], rs = sRs[j];
    const float* lng = p.in[19 + 10 * l] + g * 256;
    const u16* src = PROJ + (size_t)(row0 + j) * NC + 5120 + g * 256;
#pragma unroll 1
    for (int oc = hf * 16; oc < hf * 16 + 16; ++oc) {
      const u32x4 v = *reinterpret_cast<const u32x4*>(src + oc * 8);
      const float4 g0 = *reinterpret_cast<const float4*>(lng + oc * 8), g1 = *reinterpret_cast<const float4*>(lng + oc * 8 + 4);
      const float gg[8] = {g0.x, g0.y, g0.z, g0.w, g1.x, g1.y, g1.z, g1.w};
#pragma unroll
      for (int k = 0; k < 4; ++k) {
        const float a = (bflo(v[k]) - mu) * rs * gg[2 * k], b = (bfhi(v[k]) - mu) * rs * gg[2 * k + 1];
        const u32 w = pk2(a, b);
        vnT[(oc * 8 + 2 * k) * 136 + j] = (u16)(w & 0xffffu);
        vnT[(oc * 8 + 2 * k + 1) * 136 + j] = (u16)(w >> 16);
      }
    }
  }
  __syncthreads();
  const u16* W = reinterpret_cast<const u16*>(p.ws + WS_SGUW) + (size_t)(l >> 1) * 65536 + (size_t)g * 16384;
  const float* bs = p.in[21 + 10 * l] + g * 128;
  u16* Y = reinterpret_cast<u16*>(p.ws + WS_H);
#pragma unroll 1
  for (int ih = 0; ih < 2; ++ih) {
    f32x4 acc[4][4];
#pragma unroll
    for (int a = 0; a < 4; ++a)
#pragma unroll
      for (int b = 0; b < 4; ++b) acc[a][b] = f32x4{0.f, 0.f, 0.f, 0.f};
#pragma unroll
    for (int ks = 0; ks < 4; ++ks) {
      bf16x8 af[4], bfr[4];
#pragma unroll
      for (int m = 0; m < 4; ++m) af[m] = ld8(W + (size_t)(ih * 64 + m * 16 + fr) * 128 + ks * 32 + fq * 8);
#pragma unroll
      for (int n = 0; n < 4; ++n) bfr[n] = ld8(vnT + (wid * 64 + n * 16 + fr) * 136 + ks * 32 + fq * 8);
#pragma unroll
      for (int m = 0; m < 4; ++m)
#pragma unroll
        for (int n = 0; n < 4; ++n) acc[m][n] = mfma16(bfr[n], af[m], acc[m][n]);
    }
#pragma unroll
    for (int m = 0; m < 4; ++m) {
      const int ii = ih * 64 + m * 16 + fr;
      const float bias = bs[ii];
      const size_t rb = (size_t)(row0 + ii) * NC;
#pragma unroll
      for (int n = 0; n < 4; ++n) {
        const int c = g * 256 + wid * 64 + n * 16 + 4 * fq;
        const u32x2 uw = *reinterpret_cast<const u32x2*>(PROJ + rb + 4096 + c);
        const u32x2 dw = *reinterpret_cast<const u32x2*>(PROJ + rb + 6144 + c);
        float y0 = bflo(uw[0]) * (acc[m][n][0] + bias) * silu(bflo(dw[0])), y1 = bfhi(uw[0]) * (acc[m][n][1] + bias) * silu(bfhi(dw[0]));
        float y2 = bflo(uw[1]) * (acc[m][n][2] + bias) * silu(bflo(dw[1])), y3 = bfhi(uw[1]) * (acc[m][n][3] + bias) * silu(bfhi(dw[1]));
        if (ZERO_MASK & 8) { y0 = y1 = y2 = y3 = 0.f; }
        *reinterpret_cast<u32x2*>(Y + (size_t)(row0 + ii) * 2048 + 1024 + c) = u32x2{pk2(y0, y1), pk2(y2, y3)};
      }
    }
  }
}

DI void phase_mix_odd(const Params& p, int l, unsigned char* lds, unsigned char* lds_all) {
#pragma unroll 1
  for (int it = blockIdx.x; it < 512; it += gridDim.x) { int bh, qb; heavy_map(it, bh, qb); na_item(p, l, true, bh, qb, lds_all); }
#pragma unroll 1
  for (int it = blockIdx.x; it < 256; it += gridDim.x) na_item(p, l, false, it, 0, lds_all);
#pragma unroll 1
  for (int it = VBID; it < 768; it += VGRID) sgu_item(p, l, it, lds);
}

#define XB_TMO      128
#define XB_XCNT(j)  (256  + 64 * (j))
#define XB_XSUB(j)  (1280 + 64 * (j))
#define XB_XGEN(j)  (2304 + 64 * (j))
#define XB_TOP      3328
#define XB_TOPGEN   3392
#define XCD_BAR_WORDS 3456
#define XB_SPIN_CAP (1u << 18)
#define LAS __attribute__((address_space(3)))
DI unsigned xb_ld(unsigned* p)              { return __hip_atomic_load(p, __ATOMIC_RELAXED, __HIP_MEMORY_SCOPE_AGENT); }
DI unsigned xb_add(unsigned* p, unsigned v) { return __hip_atomic_fetch_add(p, v, __ATOMIC_RELAXED, __HIP_MEMORY_SCOPE_AGENT); }
DI unsigned xb_xcc_id() { return (unsigned)__builtin_amdgcn_s_getreg((3 << 11) | 20) & 0xFu; }
#define XB_SPIN(cond, bar) do { unsigned _sp = 0; while (cond) { __builtin_amdgcn_s_sleep(1); \
    if ((++_sp & 255u) == 0u) { if (xb_ld(&(bar)[XB_TMO])) break; if (_sp > XB_SPIN_CAP) { atomicAdd(&(bar)[XB_TMO], 1u); break; } } } } while (0)
struct XcdBarrier { unsigned* bar; unsigned x; volatile LAS unsigned* st; };
DI XcdBarrier xcd_barrier_post(unsigned* bar, volatile LAS unsigned* st) {
  XcdBarrier b; b.bar = bar; b.x = xb_xcc_id(); b.st = st;
  if (threadIdx.x == 0) (void)xb_add(&bar[XB_XCNT(b.x)], 1u);
  return b;
}
DI void xcd_barrier_complete(unsigned* bar, unsigned x, unsigned& nloc, unsigned& nx) {
  const unsigned G = gridDim.x * gridDim.y * gridDim.z;
  unsigned sum, cnt, mine, sp = 0u;
  for (;;) {
    sum = 0u; cnt = 0u; mine = 0u;
#pragma unroll
    for (unsigned j = 0; j < 16; ++j) { const unsigned c = xb_ld(&bar[XB_XCNT(j)]); sum += c; cnt += (c > 0u) ? 1u : 0u; mine = (j == x) ? c : mine; }
    if (sum == G) break;
    __builtin_amdgcn_s_sleep(1);
    if ((++sp & 255u) == 0u) { if (xb_ld(&bar[XB_TMO])) break; if (sp > XB_SPIN_CAP) { atomicAdd(&bar[XB_TMO], 1u); break; } }
  }
  nloc = mine > 0u ? mine : 1u; nx = cnt > 0u ? cnt : 1u;
}
DI void xcd_barrier(const XcdBarrier& b) {
  asm volatile("s_waitcnt vmcnt(0)" ::: "memory");
  __syncthreads();
  if (threadIdx.x == 0) {
    unsigned* bar = b.bar;
    __builtin_amdgcn_s_waitcnt(0);
    unsigned nloc = b.st[0], nx = b.st[1];
    if (nloc == 0u) { xcd_barrier_complete(bar, b.x, nloc, nx); b.st[0] = nloc; b.st[1] = nx; }
    const unsigned old = xb_add(&bar[XB_XSUB(b.x)], 1u);
    const unsigned gen = old / nloc;
    if (old + 1u == (gen + 1u) * nloc) {
      __builtin_amdgcn_fence(__ATOMIC_RELEASE, "agent");
      asm volatile("s_waitcnt vmcnt(0)" ::: "memory");
      const unsigned og = xb_add(&bar[XB_TOP], 1u);
      const unsigned tg = og / nx;
      if (og + 1u == (tg + 1u) * nx) xb_add(&bar[XB_TOPGEN], 1u);
      else XB_SPIN(xb_ld(&bar[XB_TOPGEN]) == tg, bar);
      __builtin_amdgcn_fence(__ATOMIC_ACQUIRE, "agent");
      xb_add(&bar[XB_XGEN(b.x)], 1u);
      asm volatile("s_waitcnt vmcnt(0)" ::: "memory");
    } else {
      XB_SPIN(xb_ld(&bar[XB_XGEN(b.x)]) == gen, bar);
      __builtin_amdgcn_fence(__ATOMIC_ACQUIRE, "agent");
      asm volatile("s_waitcnt vmcnt(0)" ::: "memory");
    }
  }
  __syncthreads();
}

__global__ void __launch_bounds__(512, 2) fwd_megakernel(Params p) {
  extern __shared__ __attribute__((aligned(16))) unsigned char lds[];
  cg::grid_group grid = cg::this_grid();
  volatile LAS unsigned* xst = (volatile LAS unsigned*)(lds + LDS_BYTES - 16);
  if (threadIdx.x == 0) { xst[0] = 0u; xst[1] = 0u; }
  __syncthreads();
  const XcdBarrier xb = xcd_barrier_post(reinterpret_cast<unsigned*>(p.ws + WS_BAR), xst);
  for (int ph = p.ph_lo; ph < p.ph_hi; ++ph) {
    unsigned char* hl = lds + HALF_ID * HALF_LDS;
    if (ph == 0) phase_prep(p, hl);
    else if (ph == 1) phase_mod0(p);
    else {
      const int l = (ph - 2) >> 2, s = (ph - 2) & 3;
      if (s == 0) { if (l & 1) gemm_phase<G_IN_ODD>(p, l, lds); else gemm_phase<G_IN_EVEN>(p, l, lds); }
      else if (s == 1) { if (l & 1) phase_mix_odd(p, l, hl, lds); else phase_mix_even(p, l, hl, lds); }
      else if (s == 2) gemm_phase<G_OUT>(p, l, lds);
      else phase_ln(p, l);
    }
    if (ph + 1 < p.ph_hi) {
      if (p.ph_lo < 0) grid.sync();
      xcd_barrier(xb);
    }
  }
}

extern "C" void kernel_launch(void* const* d_in, const int* in_sizes, int n_in, void* d_out, int out_size, void* d_ws, size_t ws_size,
                              hipStream_t stream) {
  static int grid_blocks = 0;
  if (grid_blocks == 0) {
    if (n_in != 52 || ws_size < WS_END) {
      fprintf(stderr, "kernel_launch: expected 52 inputs and >= %zu bytes of workspace; got %d, %zu\n", (size_t)WS_END, n_in, ws_size);
      grid_blocks = -1;
      return;
    }
    int dev = 0, cus = 0, per_cu = 0;
    hipGetDevice(&dev);
    hipDeviceGetAttribute(&cus, hipDeviceAttributeMultiprocessorCount, dev);
    hipFuncSetAttribute((const void*)fwd_megakernel, hipFuncAttributeMaxDynamicSharedMemorySize, LDS_BYTES);
    hipOccupancyMaxActiveBlocksPerMultiprocessor(&per_cu, (const void*)fwd_megakernel, 512, LDS_BYTES);
    (void)hipGetLastError();
    grid_blocks = cus;
  }
  if (grid_blocks < 0) return;
  Params p{};
  for (int i = 0; i < 52; ++i) p.in[i] = (const float*)d_in[i];
  p.out = (float*)d_out;
  p.ws = (unsigned char*)d_ws;
#if MULTI
  for (int ph = 0; ph < NPHASE; ++ph) {
    p.ph_lo = ph; p.ph_hi = ph + 1;
    hipLaunchKernelGGL(fwd_megakernel, dim3(grid_blocks), dim3(512), LDS_BYTES, stream, p);
  }
#else
  p.ph_lo = 0; p.ph_hi = NPHASE;
  if (hipMemsetAsync((char*)d_ws + WS_BAR, 0, XCD_BAR_WORDS * 4, stream) != hipSuccess) { fprintf(stderr, "kernel_launch: memset of barrier words failed\n"); return; }
  void* args[] = {&p};
  hipError_t e = hipLaunchCooperativeKernel((const void*)fwd_megakernel, dim3(grid_blocks), dim3(512), args, LDS_BYTES, stream);
  if (e != hipSuccess) fprintf(stderr, "cooperative launch failed: %s (grid %d)\n", hipGetErrorString(e), grid_blocks);
#endif
}
```

```cpp
#include <hip/hip_runtime.h>
#include <hip/hip_cooperative_groups.h>
#include <cstdio>
namespace cg = cooperative_groups;

#define DI __device__ __forceinline__
typedef unsigned short u16;
typedef unsigned int u32;
using bf16x8 = __attribute__((ext_vector_type(8))) short;
using f32x4 = __attribute__((ext_vector_type(4))) float;
using f32x16 = __attribute__((ext_vector_type(16))) float;
using u32x4 = __attribute__((ext_vector_type(4))) unsigned;
using u32x2 = __attribute__((ext_vector_type(2))) unsigned;
typedef __bf16 bf2_t __attribute__((ext_vector_type(2)));
typedef float f2_t __attribute__((ext_vector_type(2)));

#ifndef MULTI
#define MULTI 0
#endif
#ifndef REP0
#define REP0 1
#endif
#ifndef REP1
#define REP1 1
#endif
#ifndef ZERO_MASK
#define ZERO_MASK 0
#endif

constexpr int T_ALL = 24576, TP = 8192, DM = 2048;
constexpr float LOG2E = 1.4426950408889634f;
constexpr float ALPHA = 1.6817928305074290f;
constexpr float LN_EPS = 1e-5f;
constexpr int HALF_LDS = 76288;
constexpr int LDS_BYTES = 2 * HALF_LDS + 16;
constexpr int NPHASE = 18;

constexpr size_t SZ_WIN_E = (size_t)6144 * 2048 * 2, SZ_WIN_O = (size_t)7168 * 2048 * 2;
constexpr size_t WS_WINT = 0;
constexpr size_t WS_WOUTT = WS_WINT + 2 * SZ_WIN_E + 2 * SZ_WIN_O;
constexpr size_t WS_POOLWT = WS_WOUTT + (size_t)4 * 2048 * 2048 * 2;
constexpr size_t WS_SGUW = WS_POOLWT + (size_t)2 * 4 * 256 * 256 * 2;
constexpr size_t WS_CK = WS_SGUW + (size_t)2 * 4 * 128 * 128 * 2;
constexpr size_t WS_CVT = WS_CK + (size_t)4 * 4194304;
constexpr size_t WS_MOD = WS_CVT + (size_t)4 * 4194304;
constexpr size_t WS_ROPE = WS_MOD + (size_t)4 * 5 * 6144 * 4;
constexpr size_t WS_H = WS_ROPE + 8192;
constexpr size_t WS_PROJ = WS_H + (size_t)T_ALL * 2048 * 2;
constexpr size_t WS_VT = WS_PROJ + (size_t)T_ALL * 7168 * 2;
constexpr size_t WS_BAR = WS_VT + (size_t)T_ALL * 1024 * 2;
constexpr size_t WS_END = WS_BAR + 16384;

struct Params {
  const float* in[52];
  float* out;
  unsigned char* ws;
  int ph_lo, ph_hi;
};

DI size_t ws_wint(int l) { return WS_WINT + (size_t)(l >> 1) * (SZ_WIN_E + SZ_WIN_O) + ((l & 1) ? SZ_WIN_E : 0); }

DI u32 pk2(float a, float b) { f2_t v = {a, b}; bf2_t r = __builtin_convertvector(v, bf2_t); return __builtin_bit_cast(u32, r); }
DI float bflo(u32 w) { return __uint_as_float(w << 16); }
DI float bfhi(u32 w) { return __uint_as_float(w & 0xffff0000u); }
DI float bf1(u16 w) { return __uint_as_float(((u32)w) << 16); }
DI float ex2(float x) { return __builtin_amdgcn_exp2f(x); }
DI float silu(float x) { return x / (1.f + __expf(-x)); }
DI f32x4 mfma16(bf16x8 a, bf16x8 b, f32x4 c) { return __builtin_amdgcn_mfma_f32_16x16x32_bf16(a, b, c, 0, 0, 0); }
DI f32x16 mfma32(bf16x8 a, bf16x8 b, f32x16 c) { return __builtin_amdgcn_mfma_f32_32x32x16_bf16(a, b, c, 0, 0, 0); }
DI bf16x8 ld8(const u16* p) { return *reinterpret_cast<const bf16x8*>(p); }
DI int opq(int x) { asm volatile("" : "+v"(x)); return x; }
#define TIDX (opq((int)threadIdx.x) & 255)
#define TID8 (opq((int)threadIdx.x))
#define HALF_ID (opq((int)threadIdx.x) >> 8)
#define VBID ((int)((blockIdx.x & 7u) | ((unsigned)HALF_ID << 3) | ((blockIdx.x >> 3) << 4)))
#define VGRID ((int)gridDim.x * 2)

enum { G_IN_EVEN = 0, G_IN_ODD = 1, G_OUT = 2 };

namespace pg8 {
#define PG8_LAS __attribute__((address_space(3)))
typedef unsigned short bf16_t;
typedef short bf16x8 __attribute__((ext_vector_type(8)));
typedef float f32x4 __attribute__((ext_vector_type(4)));
typedef unsigned u32x4 __attribute__((ext_vector_type(4)));
constexpr int BM = 256, BK = 64, HALF = 128, HTB = HALF * BK * 2  , STAGE_BYTES = 8 * HTB, NXCD = 8, WGM = 8;

__host__ __device__ __forceinline__ int lds_byte(int r, int c) { const int st = (r >> 4) * 2 + (c >> 5), rr = r & 15, cc = c & 31, ob = rr * 64 + cc * 2; return st * 1024 + (ob ^ (((ob >> 9) & 1) << 5)); }
__host__ __device__ __forceinline__ void stage_rc(int b, int& R, int& C) { const int st = b / 1024, sb = b % 1024, swz = sb ^ (((sb >> 9) & 1) << 5); R = (st >> 1) * 16 + swz / 64; C = (st & 1) * 32 + (swz % 64) / 2; }
__host__ __device__ __forceinline__ int perm32(int rho) { const int n = rho >> 4, i = rho & 15; return 8 * (i >> 2) + 4 * n + (i & 3); }

struct Unit { int pm, pn; };
struct Gemm { const bf16_t* A; const bf16_t* Bt; int M, N, K; };

struct StaticOrder {
    int nM, nN, nwg, G, c;
    __host__ __device__ void init(int M, int N, int G_, int c_) { nM = M / BM; nN = N / BM; nwg = nM * nN; G = G_; c = c_; }
    __host__ __device__ bool next(int i, Unit& u) const {
        const long L = (long)i * G + c; if (L >= nwg) return false;
        int wgid = (int)L; { const int q = nwg / NXCD, r = nwg % NXCD, xcd = wgid % NXCD, off = wgid / NXCD; wgid = (xcd < r ? xcd * (q + 1) : r * (q + 1) + (xcd - r) * q) + off; }
        const int nig = WGM * nN, gid = wgid / nig, fm = gid * WGM, gsz = (nM - fm) < WGM ? (nM - fm) : WGM;
        u.pm = fm + ((wgid % nig) % gsz); u.pn = (wgid % nig) / gsz; return true;
    }
    __device__ __forceinline__ void a_ready(const Unit&) const {}
    __device__ __forceinline__ void done(const Unit&) const {}
};

template <class Epi, class Sched, bool STAMP = false>
__device__ __forceinline__ void gemm_phase(PG8_LAS unsigned char* lds, const Gemm g, const Sched& S, const Epi& E, unsigned long long* stamps) {
    const int tid = opq((int)threadIdx.x), wid = __builtin_amdgcn_readfirstlane(tid >> 6), lane = tid & 63, wr = wid >> 2, wc = wid & 3, fr = lane & 15, fq = lane >> 4;
    const int K = g.K, nt = K / BK;
    int ts_lo = 0, ts_hi = 0, nts = 0; const unsigned long long rt_entry = STAMP ? (unsigned long long)wall_clock64() : 0ull;
#define PG8_STAMP() do { if (STAMP && wid == 0 && nts < 64) { const unsigned long long _c = (unsigned long long)clock64(); \
        ts_lo = (lane == nts) ? (int)(unsigned)_c : ts_lo; ts_hi = (lane == nts) ? (int)(unsigned)(_c >> 32) : ts_hi; ++nts; } } while (0)
    PG8_STAMP();
    unsigned voffA[2], voffB[2];
#pragma unroll
    for (int i = 0; i < 2; ++i) { int R, C; stage_rc(tid * 16 + i * 8192, R, C); const int Rb = Epi::PERM ? ((R & ~31) + perm32(R & 31)) : R;
        voffA[i] = (unsigned)(R * K + C) * 2u; voffB[i] = (unsigned)(Rb * K + C) * 2u; }
    const size_t kstep = (size_t)(BK * 2);
    const size_t hstep = (size_t)HALF * K * 2;
    const size_t tstep = 2 * hstep;
    const unsigned ldsw = (unsigned)wid * 1024u;
    const int aoff = lds_byte(wr * 64 + fr, fq * 8), boff = lds_byte(wc * 32 + fr, fq * 8);
#define PG8_SA(b, h) (((b) * 2 + (h)) * HTB)
#define PG8_SB(b, h) ((4 + (b) * 2 + (h)) * HTB)
#define PG8_STAGE(bufoff, gbase, voff) do { _Pragma("unroll") for (int _i = 0; _i < 2; ++_i) \
        __builtin_amdgcn_global_load_lds((const unsigned*)((const char*)(gbase) + (voff)[_i]), (PG8_LAS unsigned*)(lds + (bufoff) + ldsw + _i * 8192), 16, 0, 0); } while (0)
#define PG8_LDA(dst, b, h) do { _Pragma("unroll") for (int m = 0; m < 4; ++m) _Pragma("unroll") for (int k = 0; k < 2; ++k) dst[m][k] = *(const PG8_LAS bf16x8*)(lds + PG8_SA(b, h) + aoff + m * 2048 + k * 1024); } while (0)
#define PG8_LDB(dst, b, h) do { _Pragma("unroll") for (int n = 0; n < 2; ++n) _Pragma("unroll") for (int k = 0; k < 2; ++k) dst[n][k] = *(const PG8_LAS bf16x8*)(lds + PG8_SB(b, h) + boff + n * 2048 + k * 1024); } while (0)
#define PG8_MMA(ai, bj, At, Bt) do { __builtin_amdgcn_s_setprio(1); _Pragma("unroll") for (int m = 0; m < 4; ++m) _Pragma("unroll") for (int n = 0; n < 2; ++n) _Pragma("unroll") for (int k = 0; k < 2; ++k) \
        acc[ai][bj][m][n] = __builtin_amdgcn_mfma_f32_16x16x32_bf16(Bt[n][k], At[m][k], acc[ai][bj][m][n], 0, 0, 0); __builtin_amdgcn_s_setprio(0); } while (0)
#define PG8_WAIT_V(n) asm volatile("s_waitcnt vmcnt(" #n ")" ::: "memory")
#define PG8_WAIT_L(n) asm volatile("s_waitcnt lgkmcnt(" #n ")" ::: "memory")
#define PG8_BAR __builtin_amdgcn_s_barrier()
#define PG8_SCHED __builtin_amdgcn_sched_barrier(0)
    Unit cur, nxt; int ui = 0;
    if (!S.next(0, cur)) return;
    f32x4 acc[2][2][4][2];
#pragma unroll
    for (int a = 0; a < 2; ++a)
#pragma unroll
        for (int b = 0; b < 2; ++b)
#pragma unroll
            for (int m = 0; m < 4; ++m)
#pragma unroll
                for (int n = 0; n < 2; ++n) acc[a][b][m][n] = (f32x4){0.f, 0.f, 0.f, 0.f};
    bf16x8 At[4][2], B0[2][2], B1[2][2];
    const char* cA = (const char*)g.A + (size_t)cur.pm * tstep; const char* cB = (const char*)g.Bt + (size_t)cur.pn * tstep;
    S.a_ready(cur);
    PG8_STAGE(PG8_SB(0, 0), cB, voffB); PG8_STAGE(PG8_SA(0, 0), cA, voffA); PG8_STAGE(PG8_SB(0, 1), cB + hstep, voffB); PG8_STAGE(PG8_SA(0, 1), cA + hstep, voffA);
    if (wr == 1) PG8_BAR;
    PG8_WAIT_V(4); PG8_BAR;
    PG8_STAGE(PG8_SB(1, 0), cB + kstep, voffB); PG8_STAGE(PG8_SA(1, 0), cA + kstep, voffA); PG8_STAGE(PG8_SB(1, 1), cB + hstep + kstep, voffB);
    PG8_WAIT_V(6); PG8_BAR;
    PG8_STAMP();
    for (;;) {
        const bool has_next = S.next(ui + 1, nxt);
        const char* nA = has_next ? (const char*)g.A + (size_t)nxt.pm * tstep : cA; const char* nB = has_next ? (const char*)g.Bt + (size_t)nxt.pn * tstep : cB;
        for (int t = 0; t < nt; t += 2) {
            const bool last = (t == nt - 2);
            const char* a1 = cA + (size_t)(t + 1) * kstep;
            const char* a2 = last ? nA : cA + (size_t)(t + 2) * kstep; const char* b2 = last ? nB : cB + (size_t)(t + 2) * kstep;
            const char* a3 = a2 + kstep; const char* b3 = b2 + kstep;
            if (last && has_next) S.a_ready(nxt);
            PG8_LDB(B0, 0, 0); PG8_SCHED; PG8_LDA(At, 0, 0); PG8_STAGE(PG8_SA(1, 1), a1 + hstep, voffA);
            PG8_WAIT_L(8); PG8_BAR; PG8_WAIT_L(0); PG8_MMA(0, 0, At, B0); PG8_BAR; PG8_SCHED;
            PG8_LDB(B1, 0, 1); PG8_STAGE(PG8_SB(0, 0), b2, voffB);
            PG8_BAR; PG8_WAIT_L(0); PG8_MMA(0, 1, At, B1); PG8_BAR;
            PG8_LDA(At, 0, 1); PG8_STAGE(PG8_SA(0, 0), a2, voffA);
            PG8_BAR; PG8_WAIT_L(0); PG8_MMA(1, 0, At, B0); PG8_BAR; PG8_SCHED;
            PG8_STAGE(PG8_SB(0, 1), b2 + hstep, voffB);
            PG8_WAIT_V(6); PG8_BAR; PG8_MMA(1, 1, At, B1); PG8_BAR;
            PG8_LDB(B0, 1, 0); PG8_SCHED; PG8_LDA(At, 1, 0); PG8_STAGE(PG8_SA(0, 1), a2 + hstep, voffA);
            PG8_WAIT_L(8); PG8_BAR; PG8_WAIT_L(0); PG8_MMA(0, 0, At, B0); PG8_BAR; PG8_SCHED;
            PG8_LDB(B1, 1, 1); PG8_STAGE(PG8_SB(1, 0), b3, voffB);
            PG8_BAR; PG8_WAIT_L(0); PG8_MMA(0, 1, At, B1); PG8_BAR;
            PG8_LDA(At, 1, 1); PG8_STAGE(PG8_SA(1, 0), a3, voffA);
            PG8_BAR; PG8_WAIT_L(0); PG8_MMA(1, 0, At, B0); PG8_BAR; PG8_SCHED;
            PG8_STAGE(PG8_SB(1, 1), b3 + hstep, voffB);
            PG8_WAIT_V(6); PG8_BAR; PG8_MMA(1, 1, At, B1); PG8_BAR;
        }
        PG8_STAMP();
        if constexpr (!Epi::AFTER_DRAIN) { E(acc, cur, wr, wc, fr, fq); S.done(cur); }
        PG8_STAMP();
        if (!has_next) break;
#pragma unroll
        for (int a = 0; a < 2; ++a)
#pragma unroll
            for (int b = 0; b < 2; ++b)
#pragma unroll
                for (int m = 0; m < 4; ++m)
#pragma unroll
                    for (int n = 0; n < 2; ++n) acc[a][b][m][n] = (f32x4){0.f, 0.f, 0.f, 0.f};
        cur = nxt; cA = nA; cB = nB; ++ui;
    }
    PG8_WAIT_V(0);
    if (wr == 0) PG8_BAR;
    PG8_BAR;
    if constexpr (Epi::AFTER_DRAIN) { E.fused(acc, cur, wr, wc, fr, fq, lds, wid, lane); S.done(cur); }
    PG8_STAMP();
    if (STAMP && wid == 0) { stamps[lane] = lane < nts ? (((unsigned long long)(unsigned)ts_hi << 32) | (unsigned)ts_lo) : 0ull;
        if (lane == 62) stamps[62] = rt_entry; if (lane == 63) stamps[63] = (unsigned long long)wall_clock64(); }
#undef PG8_STAMP
#undef PG8_SA
#undef PG8_SB
#undef PG8_STAGE
#undef PG8_LDA
#undef PG8_LDB
#undef PG8_MMA
#undef PG8_WAIT_V
#undef PG8_WAIT_L
#undef PG8_BAR
#undef PG8_SCHED
}
}

DI void tr_tile(const float* __restrict__ src, size_t ld_src, u16* __restrict__ dst, size_t ld_dst, float* sT) {
  const int tid = TIDX;
  const int r = tid >> 4, c4 = (tid & 15) * 4;
#pragma unroll
  for (int i = 0; i < 4; ++i) {
    float4 v = *reinterpret_cast<const float4*>(src + (size_t)(r + 16 * i) * ld_src + c4);
    float* d = sT + (r + 16 * i) * 65 + c4;
    d[0] = v.x; d[1] = v.y; d[2] = v.z; d[3] = v.w;
  }
  __syncthreads();
  const int n = tid >> 2, ks = (tid & 3) * 16;
  u32 w[8];
#pragma unroll
  for (int j = 0; j < 8; ++j) w[j] = pk2(sT[(ks + 2 * j) * 65 + n], sT[(ks + 2 * j + 1) * 65 + n]);
  u32x4* o = reinterpret_cast<u32x4*>(dst + (size_t)n * ld_dst + ks);
  o[0] = u32x4{w[0], w[1], w[2], w[3]};
  o[1] = u32x4{w[4], w[5], w[6], w[7]};
  __syncthreads();
}

DI void cvt8(const float* __restrict__ src, u16* __restrict__ dst) {
  float4 a = *reinterpret_cast<const float4*>(src);
  float4 b = *reinterpret_cast<const float4*>(src + 4);
  *reinterpret_cast<u32x4*>(dst) = u32x4{pk2(a.x, a.y), pk2(a.z, a.w), pk2(b.x, b.y), pk2(b.z, b.w)};
}

DI void mod_item(const Params& p, int i, unsigned char* lds) {
  const int tid = TIDX;
  const int l = i / 96, n0 = (i % 96) * 64;
  float* sS = reinterpret_cast<float*>(lds);
  float* red = sS + 5 * 2048;
  const float* c = p.in[10];
  const float* cctx = p.in[11];
  for (int e = tid; e < 5 * 2048; e += 256) {
    int v = e >> 11, k = e & 2047;
    float x = (v == 0) ? cctx[k] : c[(v - 1) * 2048 + k];
    sS[e] = silu(x);
  }
  __syncthreads();
  const int kk = tid >> 4, c4 = (tid & 15) * 4;
  const float* W = p.in[12 + 10 * l] + n0 + c4;
  f32x4 acc[5];
#pragma unroll
  for (int v = 0; v < 5; ++v) acc[v] = f32x4{0.f, 0.f, 0.f, 0.f};
#pragma unroll 8
  for (int k = kk; k < 2048; k += 16) {
    float4 w = *reinterpret_cast<const float4*>(W + (size_t)k * 6144);
#pragma unroll
    for (int v = 0; v < 5; ++v) {
      float s = sS[v * 2048 + k];
      acc[v][0] += s * w.x; acc[v][1] += s * w.y; acc[v][2] += s * w.z; acc[v][3] += s * w.w;
    }
  }
#pragma unroll
  for (int v = 0; v < 5; ++v)
#pragma unroll
    for (int q = 0; q < 4; ++q) red[(kk * 5 + v) * 64 + c4 + q] = acc[v][q];
  __syncthreads();
  for (int t2 = tid; t2 < 320; t2 += 256) {
    int v = t2 >> 6, n = t2 & 63;
    float s = 0.f;
#pragma unroll
    for (int k2 = 0; k2 < 16; ++k2) s += red[(k2 * 5 + v) * 64 + n];
    float* mod = reinterpret_cast<float*>(p.ws + WS_MOD);
    mod[(size_t)(l * 5 + v) * 6144 + n0 + n] = s + p.in[13 + 10 * l][n0 + n];
  }
  __syncthreads();
}

DI void phase_prep(const Params& p, unsigned char* lds) {
  constexpr int N_MOD = 384, N_TRWIN = 13312, N_TRWOUT = 4096, N_TRPOOL = 128, N_SGU = 64, N_CK = 4096, N_CV = 2048;
  constexpr int TOTAL = N_MOD + N_TRWIN + N_TRWOUT + N_TRPOOL + N_SGU + N_CK + N_CV + 1;
  const int tid = TIDX;
  float* sT = reinterpret_cast<float*>(lds);
  for (int it = VBID; it < TOTAL; it += VGRID) {
    int i = it;
    if (i < N_MOD) { mod_item(p, i, lds); continue; }
    i -= N_MOD;
    if (i < N_TRWIN) {
      int l, base;
      if (i < 3072) { l = 0; base = 0; } else if (i < 6656) { l = 1; base = 3072; } else if (i < 9728) { l = 2; base = 6656; } else { l = 3; base = 9728; }
      i -= base;
      const int N = (l & 1) ? 7168 : 6144, nN = N / 64;
      const int kt = i / nN, nt = i % nN;
      tr_tile(p.in[14 + 10 * l] + (size_t)kt * 64 * N + nt * 64, N,
              reinterpret_cast<u16*>(p.ws + ws_wint(l)) + (size_t)nt * 64 * 2048 + kt * 64, 2048, sT);
      continue;
    }
    i -= N_TRWIN;
    if (i < N_TRWOUT) {
      const int l = i >> 10, r = i & 1023, kt = r >> 5, nt = r & 31;
      tr_tile(p.in[15 + 10 * l] + (size_t)kt * 64 * 2048 + nt * 64, 2048,
              reinterpret_cast<u16*>(p.ws + WS_WOUTT) + (size_t)l * 2048 * 2048 + (size_t)nt * 64 * 2048 + kt * 64, 2048, sT);
      continue;
    }
    i -= N_TRWOUT;
    if (i < N_TRPOOL) {
      const int e = i >> 6, r = i & 63, g = r >> 4, t = r & 15, kt = t >> 2, nt = t & 3;
      tr_tile(p.in[18 + 20 * e] + (size_t)g * 65536 + kt * 64 * 256 + nt * 64, 256,
              reinterpret_cast<u16*>(p.ws + WS_POOLWT) + (size_t)e * 262144 + g * 65536 + nt * 64 * 256 + kt * 64, 256, sT);
      continue;
    }
    i -= N_TRPOOL;
    if (i < N_SGU) {
      const int e = i >> 5, ch = i & 31;
      const size_t off = (size_t)ch * 2048 + tid * 8;
      cvt8(p.in[30 + 20 * e] + off, reinterpret_cast<u16*>(p.ws + WS_SGUW) + (size_t)e * 65536 + off);
      continue;
    }
    i -= N_SGU;
    if (i < N_CK) {
      const int l = i >> 10, ch = i & 1023;
      const size_t off = (size_t)ch * 2048 + tid * 8;
      cvt8(p.in[2 + 2 * l] + off, reinterpret_cast<u16*>(p.ws + WS_CK) + (size_t)l * 2097152 + off);
      continue;
    }
    i -= N_CK;
    if (i < N_CV) {
      const int l = i >> 9, r = i & 511, bh = r >> 4, t = r & 15, kt = t >> 1, nt = t & 1;
      tr_tile(p.in[3 + 2 * l] + (size_t)bh * 65536 + kt * 64 * 128 + nt * 64, 128,
              reinterpret_cast<u16*>(p.ws + WS_CVT) + (size_t)l * 2097152 + (size_t)bh * 65536 + nt * 64 * 512 + kt * 64, 512, sT);
      continue;
    }
    {
      float* rc = reinterpret_cast<float*>(p.ws + WS_ROPE);
      for (int e = tid; e < 1024; e += 256) {
        int pos = e >> 4, fi = e & 15;
        float inv = 1.0f / powf(10000.0f, (float)(2 * fi) / 32.0f);
        float ang = (float)pos * inv;
        rc[e] = cosf(ang);
        rc[1024 + e] = sinf(ang);
      }
    }
  }
}

DI void phase_mod0(const Params& p) {
  const int tid = TIDX;
  const float* mod = reinterpret_cast<const float*>(p.ws + WS_MOD);
  u16* H = reinterpret_cast<u16*>(p.ws + WS_H);
  for (int it = VBID; it < T_ALL / 4; it += VGRID) {
#pragma unroll
    for (int rr = 0; rr < 4; ++rr) {
      const int row = it * 4 + rr;
      const int cond = row < TP ? 0 : 1 + ((row - TP) >> 12);
      const float* src = row < TP ? p.in[0] + (size_t)row * 2048 : p.in[1] + (size_t)(row - TP) * 2048;
      const int e = tid * 8;
      const float* sh = mod + (size_t)cond * 6144 + e;
      float4 a = *reinterpret_cast<const float4*>(src + e), b = *reinterpret_cast<const float4*>(src + e + 4);
      float4 s0 = *reinterpret_cast<const float4*>(sh), s1 = *reinterpret_cast<const float4*>(sh + 4);
      float4 c0 = *reinterpret_cast<const float4*>(sh + 2048), c1 = *reinterpret_cast<const float4*>(sh + 2052);
      u32x4 o = {pk2(a.x * (1.f + c0.x) + s0.x, a.y * (1.f + c0.y) + s0.y), pk2(a.z * (1.f + c0.z) + s0.z, a.w * (1.f + c0.w) + s0.w),
                 pk2(b.x * (1.f + c1.x) + s1.x, b.y * (1.f + c1.y) + s1.y), pk2(b.z * (1.f + c1.z) + s1.z, b.w * (1.f + c1.w) + s1.w)};
      *reinterpret_cast<u32x4*>(H + (size_t)row * 2048 + e) = o;
    }
  }
}


template <int MODE>
struct EpiIn {
  static constexpr bool PERM = false, AFTER_DRAIN = false;
  u16* PROJ; u16* VT; float* kout; float* vout; const float* ropeC; const float* ropeS;
  DI void operator()(const f32x4 (&acc)[2][2][4][2], const pg8::Unit& u, int wr, int wc, int fr, int fq) const {
    constexpr int NC = (MODE == G_IN_EVEN) ? 6144 : 7168;
    constexpr int SEC_Q = (MODE == G_IN_EVEN) ? 2 : 0, SEC_K = (MODE == G_IN_EVEN) ? 3 : 1, SEC_V = (MODE == G_IN_EVEN) ? 4 : 2;
    const int sec = u.pn >> 2;
    const bool prompt = u.pm < 32;
    const bool isq = sec == SEC_Q, isk = sec == SEC_K;
    const bool rope = (MODE == G_IN_EVEN) && (isq || isk) && !prompt;
    const float sc = isq ? ((MODE == G_IN_EVEN) ? 0.125f * LOG2E : 0.08838834764831845f * LOG2E) : 1.0f;
#pragma unroll
    for (int ai = 0; ai < 2; ++ai)
#pragma unroll
      for (int m = 0; m < 4; ++m) {
        const int row = u.pm * 256 + ai * 128 + wr * 64 + m * 16 + fr;
        int b, t;
        if (prompt) { b = row >> 8; t = row & 255; } else { const int rs = row - TP; b = rs >> 12; t = rs & 4095; }
#pragma unroll
        for (int bj = 0; bj < 2; ++bj) {
          const int hh = (u.pn & 3) * 2 + bj;
          const int d0 = wc * 32 + 4 * fq;
          if (sec == SEC_V) {
#pragma unroll
            for (int n = 0; n < 2; ++n) {
              const f32x4 v = acc[ai][bj][m][n];
              const int dv = d0 + 16 * n;
              const u32 w01 = pk2(v[0], v[1]), w23 = pk2(v[2], v[3]);
              if (prompt) {
                u16* vt = VT + ((size_t)((b * 8 + hh) * 128 + dv)) * 256 + t;
                vt[0] = (u16)(w01 & 0xffffu); vt[256] = (u16)(w01 >> 16); vt[512] = (u16)(w23 & 0xffffu); vt[768] = (u16)(w23 >> 16);
                *reinterpret_cast<float4*>(vout + ((size_t)((b * 8 + hh) * 256 + t)) * 128 + dv) = float4{v[0], v[1], v[2], v[3]};
              } else {
                u16* vt = VT + 8388608 + ((size_t)((b * 8 + hh) * 128 + dv)) * 4096 + t;
                vt[0] = (u16)(w01 & 0xffffu); vt[4096] = (u16)(w01 >> 16); vt[8192] = (u16)(w23 & 0xffffu); vt[12288] = (u16)(w23 >> 16);
              }
            }
          } else {
            f32x4 v0 = acc[ai][bj][m][0], v1 = acc[ai][bj][m][1];
            if (isk && prompt) {
              float* ko = kout + ((size_t)((b * 8 + hh) * 256 + t)) * 128 + d0;
              *reinterpret_cast<float4*>(ko) = float4{v0[0], v0[1], v0[2], v0[3]};
              *reinterpret_cast<float4*>(ko + 16) = float4{v1[0], v1[1], v1[2], v1[3]};
            }
            if (rope) {
              const int pos = (wc & 1) ? (t & 63) : (t >> 6);
              const float4 cs = *reinterpret_cast<const float4*>(ropeC + pos * 16 + 4 * fq);
              const float4 sn = *reinterpret_cast<const float4*>(ropeS + pos * 16 + 4 * fq);
              const float c4[4] = {cs.x, cs.y, cs.z, cs.w}, s4[4] = {sn.x, sn.y, sn.z, sn.w};
#pragma unroll
              for (int j = 0; j < 4; ++j) {
                const float x1 = v0[j], x2 = v1[j];
                v0[j] = x1 * c4[j] - x2 * s4[j];
                v1[j] = x1 * s4[j] + x2 * c4[j];
              }
            }
            u16* dst = PROJ + (size_t)row * NC + u.pn * 256 + bj * 128 + d0;
            *reinterpret_cast<u32x2*>(dst) = u32x2{pk2(v0[0] * sc, v0[1] * sc), pk2(v0[2] * sc, v0[3] * sc)};
            *reinterpret_cast<u32x2*>(dst + 16) = u32x2{pk2(v1[0] * sc, v1[1] * sc), pk2(v1[2] * sc, v1[3] * sc)};
          }
        }
      }
  }
};

struct EpiOut {
  static constexpr bool PERM = false, AFTER_DRAIN = false;
  float* X; const float* x0; const float* x1; const float* mod; int l;
  DI void operator()(const f32x4 (&acc)[2][2][4][2], const pg8::Unit& u, int wr, int wc, int fr, int fq) const {
    const bool prompt = u.pm < 32;
    const int cond = prompt ? 0 : 1 + ((u.pm * 256 - TP) >> 12);
    const float* gate = mod + (size_t)(l * 5 + cond) * 6144 + 4096;
#pragma unroll
    for (int bj = 0; bj < 2; ++bj)
#pragma unroll
      for (int n = 0; n < 2; ++n) {
        const int col = u.pn * 256 + bj * 128 + wc * 32 + 16 * n + 4 * fq;
        const float4 g4 = *reinterpret_cast<const float4*>(gate + col);
#pragma unroll
        for (int ai = 0; ai < 2; ++ai)
#pragma unroll
          for (int m = 0; m < 4; ++m) {
            const int row = u.pm * 256 + ai * 128 + wr * 64 + m * 16 + fr;
            float4 xo;
            if (l == 0) xo = prompt ? *reinterpret_cast<const float4*>(x0 + (size_t)row * 2048 + col)
                                    : *reinterpret_cast<const float4*>(x1 + (size_t)(row - TP) * 2048 + col);
            else xo = *reinterpret_cast<const float4*>(X + (size_t)row * 2048 + col);
            const f32x4 a = acc[ai][bj][m][n];
            float4 o;
            o.x = ALPHA * xo.x + g4.x * a[0]; o.y = ALPHA * xo.y + g4.y * a[1];
            o.z = ALPHA * xo.z + g4.z * a[2]; o.w = ALPHA * xo.w + g4.w * a[3];
            *reinterpret_cast<float4*>(X + (size_t)row * 2048 + col) = o;
          }
      }
  }
};

template <int MODE>
DI void gemm_phase(const Params& p, int l, unsigned char* lds) {
  constexpr int N = (MODE == G_OUT) ? 2048 : (MODE == G_IN_EVEN ? 6144 : 7168);
  pg8::Gemm g;
  g.A = reinterpret_cast<const u16*>(p.ws + WS_H);
  g.Bt = (MODE == G_OUT) ? reinterpret_cast<const u16*>(p.ws + WS_WOUTT) + (size_t)l * 2048 * 2048
                         : reinterpret_cast<const u16*>(p.ws + ws_wint(l));
  g.M = T_ALL; g.N = N; g.K = 2048;
  pg8::StaticOrder S;
  S.init(T_ALL, N, (int)gridDim.x, (int)blockIdx.x);
  PG8_LAS unsigned char* l3 = (PG8_LAS unsigned char*)lds;
  if constexpr (MODE == G_OUT) {
    EpiOut E;
    E.X = p.out; E.x0 = p.in[0]; E.x1 = p.in[1]; E.mod = reinterpret_cast<const float*>(p.ws + WS_MOD); E.l = l;
    pg8::gemm_phase<EpiOut, pg8::StaticOrder, false>(l3, g, S, E, nullptr);
  } else {
    EpiIn<MODE> E;
    E.PROJ = reinterpret_cast<u16*>(p.ws + WS_PROJ); E.VT = reinterpret_cast<u16*>(p.ws + WS_VT);
    E.kout = p.out + (size_t)T_ALL * 2048 + (size_t)(2 * l) * 8388608;
    E.vout = p.out + (size_t)T_ALL * 2048 + (size_t)(2 * l + 1) * 8388608;
    E.ropeC = reinterpret_cast<const float*>(p.ws + WS_ROPE); E.ropeS = E.ropeC + 1024;
    pg8::gemm_phase<EpiIn<MODE>, pg8::StaticOrder, false>(l3, g, S, E, nullptr);
  }
}

DI void phase_ln(const Params& p, int l) {
  const int tid_ = TIDX, lane = tid_ & 63, wid = tid_ >> 6;
  const float* g = p.in[16 + 10 * l];
  const float* bb = p.in[17 + 10 * l];
  const float* mod = reinterpret_cast<const float*>(p.ws + WS_MOD);
  u16* H = reinterpret_cast<u16*>(p.ws + WS_H);
  float* X = p.out;
  for (int it = VBID; it < T_ALL / 4; it += VGRID) {
    const int row = it * 4 + wid;
    float* xr = X + (size_t)row * 2048;
    float4 v[8];
    float s = 0.f;
#pragma unroll
    for (int i = 0; i < 8; ++i) {
      v[i] = *reinterpret_cast<const float4*>(xr + (i * 64 + lane) * 4);
      s += v[i].x + v[i].y + v[i].z + v[i].w;
    }
#pragma unroll
    for (int o = 32; o >= 1; o >>= 1) s += __shfl_xor(s, o);
    const float mu = s * (1.f / 2048.f);
    float ss = 0.f;
#pragma unroll
    for (int i = 0; i < 8; ++i) {
      float a = v[i].x - mu, b = v[i].y - mu, c = v[i].z - mu, d = v[i].w - mu;
      ss += a * a + b * b + c * c + d * d;
    }
#pragma unroll
    for (int o = 32; o >= 1; o >>= 1) ss += __shfl_xor(ss, o);
    const float rstd = rsqrtf(ss * (1.f / 2048.f) + LN_EPS);
    const int cond = row < TP ? 0 : 1 + ((row - TP) >> 12);
    const float* sh = mod + (size_t)((l + 1) * 5 + cond) * 6144;
#pragma unroll
    for (int i = 0; i < 8; ++i) {
      const int e = (i * 64 + lane) * 4;
      float4 gg = *reinterpret_cast<const float4*>(g + e), b4 = *reinterpret_cast<const float4*>(bb + e);
      float4 y;
      y.x = (v[i].x - mu) * rstd * gg.x + b4.x; y.y = (v[i].y - mu) * rstd * gg.y + b4.y;
      y.z = (v[i].z - mu) * rstd * gg.z + b4.z; y.w = (v[i].w - mu) * rstd * gg.w + b4.w;
      *reinterpret_cast<float4*>(xr + e) = y;
      if (l < 3) {
        float4 s0 = *reinterpret_cast<const float4*>(sh + e), c0 = *reinterpret_cast<const float4*>(sh + 2048 + e);
        u32x2 o = {pk2(y.x * (1.f + c0.x) + s0.x, y.y * (1.f + c0.y) + s0.y), pk2(y.z * (1.f + c0.z) + s0.z, y.w * (1.f + c0.w) + s0.w)};
        *reinterpret_cast<u32x2*>(H + (size_t)row * 2048 + e) = o;
      }
    }
  }
}

struct AttnSrc {
  const u16* k0; const u16* vt0; int ks0, vs0, n0;
  const u16* k1; const u16* vt1; int ks1, vs1, n1;
};

template <int DQK>
DI void attn_ldg(const AttnSrc& s, int j, u32x4 (&rk)[DQK / 64], u32x4 (&rv)[2]) {
  const u16* kb; const u16* vb; int ks, vs;
  if (j < s.n0) { kb = s.k0 + (size_t)j * 64 * s.ks0; vb = s.vt0 + j * 64; ks = s.ks0; vs = s.vs0; }
  else { const int jj = j - s.n0; kb = s.k1 + (size_t)jj * 64 * s.ks1; vb = s.vt1 + jj * 64; ks = s.ks1; vs = s.vs1; }
  constexpr int CPR = DQK / 8;
  const int tid = TID8;
#pragma unroll
  for (int i = 0; i < DQK / 64; ++i) {
    const int c = tid + 512 * i, row = c / CPR, kc = c % CPR;
    rk[i] = *reinterpret_cast<const u32x4*>(kb + (size_t)row * ks + kc * 8);
  }
#pragma unroll
  for (int i = 0; i < 2; ++i) {
    const int c = tid + 512 * i, row = c >> 3, kc = c & 7;
    rv[i] = *reinterpret_cast<const u32x4*>(vb + (size_t)row * vs + kc * 8);
  }
}
template <int DQK>
DI void attn_sts(u16* sK, u16* sVT, const u32x4 (&rk)[DQK / 64], const u32x4 (&rv)[2]) {
  constexpr int CPR = DQK / 8;
  const int tid = TID8;
#pragma unroll
  for (int i = 0; i < DQK / 64; ++i) {
    const int c = tid + 512 * i, row = c / CPR, kc = c % CPR;
    *reinterpret_cast<u32x4*>(sK + row * (DQK + 8) + kc * 8) = rk[i];
  }
#pragma unroll
  for (int i = 0; i < 2; ++i) {
    const int c = tid + 512 * i, row = c >> 3, kc = c & 7;
    *reinterpret_cast<u32x4*>(sVT + row * 72 + kc * 8) = rv[i];
  }
}

DI void attn_pv(const f32x16 (&s)[2], const u16* vw, f32x16 (&O)[4]) {
  __builtin_amdgcn_s_setprio(1);
#pragma unroll
  for (int s4 = 0; s4 < 4; ++s4) {
    const int t = s4 >> 1, b0 = (s4 & 1) * 8;
    u32x4 w = {pk2(s[t][b0], s[t][b0 + 1]), pk2(s[t][b0 + 2], s[t][b0 + 3]), pk2(s[t][b0 + 4], s[t][b0 + 5]), pk2(s[t][b0 + 6], s[t][b0 + 7])};
    const bf16x8 pf = __builtin_bit_cast(bf16x8, w);
#pragma unroll
    for (int d = 0; d < 4; ++d) {
      bf16x8 a = ld8(vw + d * 32 * 72 + s4 * 16);
      O[d] = mfma32(a, pf, O[d]);
    }
  }
  __builtin_amdgcn_s_setprio(0);
}

template <int DQK, bool NA>
DI void attn_run(const AttnSrc& src, const u16* qblk, int qstride, u16* sQ, u16* sK, u16* sVT, f32x16 (&O)[4], float& l_out,
                 int qr, int qc, int rsmin, const float* sBias) {
  const int tid = TID8, lane = tid & 63, wid = tid >> 6;
  const int r = lane & 31, h = lane >> 5;
  const int pr = (r & 0x13) | ((r & 4) << 1) | ((r & 8) >> 1);
  constexpr int CPR = DQK / 8, QS = DQK + 8;
  __syncthreads();
  constexpr bool QREG = (DQK == 64);
  bf16x8 qf[QREG ? DQK / 16 : 1];
  if constexpr (QREG) {
#pragma unroll
    for (int ks = 0; ks < DQK / 16; ++ks) qf[ks] = ld8(qblk + (size_t)(wid * 32 + r) * qstride + ks * 16 + 8 * h);
  } else {
#pragma unroll
    for (int i = 0; i < DQK / 16; ++i) {
      const int c = tid + 512 * i, row = c / CPR, kc = c % CPR;
      *reinterpret_cast<u32x4*>(sQ + row * QS + kc * 8) = *reinterpret_cast<const u32x4*>(qblk + (size_t)row * qstride + kc * 8);
    }
  }
#pragma unroll
  for (int d = 0; d < 4; ++d)
#pragma unroll
    for (int i = 0; i < 16; ++i) O[d][i] = 0.f;
  float m = -1e30f, l = 0.f;
  const int nt = src.n0 + src.n1;
  const int rsq = min(max(qr - 4, 0), 56);
  const int cs = min(max(qc - 8, 0), 48);
  const u16* qw = sQ + (wid * 32 + r) * QS + 8 * h;
  const u16* kw = sK + pr * QS + 8 * h;
  u16* sVT1 = sVT + 128 * 72 + 2048;
  const bool grpB = wid >= 4;
  bool pend = false;
  f32x16 s[2];
  u32x4 rk[DQK / 64], rv[2];
  attn_ldg<DQK>(src, 0, rk, rv);
#pragma unroll 1
  for (int j = 0; j < nt; ++j) {
    if (j > 0) __syncthreads();
    u16* vcur = (j & 1) ? sVT1 : sVT;
    attn_sts<DQK>(sK, vcur, rk, rv);
    __syncthreads();
    if (j + 1 < nt) attn_ldg<DQK>(src, j + 1, rk, rv);
    __builtin_amdgcn_sched_barrier(0);
    if (grpB && pend) { attn_pv(s, ((j & 1) ? sVT : sVT1) + r * 72 + 8 * h, O); pend = false; }
    bool active = true;
    int kr = 0;
    if (NA && j >= src.n0) { kr = rsmin + (j - src.n0); active = (kr >= rsq) && (kr < rsq + 8); }
    if (active) {
      __builtin_amdgcn_s_setprio(1);
#pragma unroll
      for (int t = 0; t < 2; ++t) {
#pragma unroll
        for (int i = 0; i < 16; ++i) s[t][i] = 0.f;
#pragma unroll
        for (int ks = 0; ks < DQK / 16; ++ks) {
          bf16x8 a = ld8(kw + t * 32 * QS + ks * 16);
          bf16x8 q;
          if constexpr (QREG) q = qf[ks]; else q = ld8(qw + ks * 16);
          s[t] = mfma32(a, q, s[t]);
        }
      }
      __builtin_amdgcn_s_setprio(0);
      if (NA && j >= src.n0) {
        const float* bp = sBias + (kr - qr + 7) * 31 + (8 * h - qc + 15);
        const int kb = 8 * h - cs;
#pragma unroll
        for (int t = 0; t < 2; ++t)
#pragma unroll
          for (int i = 0; i < 16; ++i) {
            const int ko = t * 32 + 16 * (i >> 3) + (i & 7);
            const bool ok = (unsigned)(ko + kb) < 16u;
            const float bv = bp[ko];
            s[t][i] = ok ? s[t][i] + bv : -1e30f;
          }
      }
      float mx = -1e30f;
#pragma unroll
      for (int t = 0; t < 2; ++t)
#pragma unroll
        for (int i = 0; i < 16; ++i) mx = fmaxf(mx, s[t][i]);
      if (__builtin_amdgcn_ballot_w64(mx > m + 8.0f) != 0ull) {
        mx = fmaxf(mx, __shfl_xor(mx, 32));
        const float mn = fmaxf(m, mx);
        const float alpha = ex2(m - mn);
        l *= alpha;
        m = mn;
#pragma unroll
        for (int d = 0; d < 4; ++d)
#pragma unroll
          for (int i = 0; i < 16; ++i) O[d][i] *= alpha;
      }
      float rsum = 0.f;
#pragma unroll
      for (int t = 0; t < 2; ++t)
#pragma unroll
        for (int i = 0; i < 16; ++i) { const float e = ex2(s[t][i] - m); s[t][i] = e; rsum += e; }
      l += rsum;
      if (!grpB) attn_pv(s, vcur + r * 72 + 8 * h, O);
      else pend = true;
    }
  }
  if (grpB && pend) attn_pv(s, (((nt - 1) & 1) ? sVT1 : sVT) + r * 72 + 8 * h, O);
  l_out = l + __shfl_xor(l, 32);
}

DI void heavy_map(int it, int& bh, int& qb) { const int x = it & 7, rest = it >> 3; qb = rest & 15; bh = x + 8 * (rest >> 4); }

DI void diff_item(const Params& p, int l, bool sample, int bh, int qb, unsigned char* lds) {
  constexpr int NC = 6144;
  const int tid_ = TID8, lane = tid_ & 63, wid = tid_ >> 6, r = lane & 31, h = lane >> 5;
  const int b = bh >> 3, hd = bh & 7;
  u16* sQ = reinterpret_cast<u16*>(lds);
  u16* sK = sQ + 256 * 136;
  u16* sVT = sK + 64 * 136;
  const u16* PROJ = reinterpret_cast<const u16*>(p.ws + WS_PROJ);
  const u16* VT = reinterpret_cast<const u16*>(p.ws + WS_VT);
  const int seq0 = sample ? TP + b * 4096 : b * 256;
  const int token = seq0 + qb * 256 + wid * 32 + r;
  const float* dl = p.in[20 + 10 * l];
  float pa = dl[lane] * dl[64 + lane], pb = dl[128 + lane] * dl[192 + lane];
#pragma unroll
  for (int o = 32; o >= 1; o >>= 1) { pa += __shfl_xor(pa, o); pb += __shfl_xor(pb, o); }
  const float lam_init = 0.8f - 0.6f * __expf(-0.3f * (float)l);
  const float lam = __expf(pa) - __expf(pb) + lam_init;

  u32 o1p[32];
  f32x16 O[4];
  float lsum;
#pragma unroll
  for (int comp = 0; comp < 2; ++comp) {
    AttnSrc s;
    if (sample) {
      s.k0 = reinterpret_cast<const u16*>(p.ws + WS_CK) + (size_t)l * 2097152 + (size_t)bh * 65536 + comp * 64; s.ks0 = 128;
      s.vt0 = reinterpret_cast<const u16*>(p.ws + WS_CVT) + (size_t)l * 2097152 + (size_t)bh * 65536; s.vs0 = 512; s.n0 = 8;
      s.k1 = PROJ + (size_t)seq0 * NC + 3072 + hd * 128 + comp * 64; s.ks1 = NC;
      s.vt1 = VT + 8388608 + (size_t)bh * 128 * 4096; s.vs1 = 4096; s.n1 = 64;
    } else {
      s.k0 = nullptr; s.vt0 = nullptr; s.ks0 = 0; s.vs0 = 0; s.n0 = 0;
      s.k1 = PROJ + (size_t)seq0 * NC + 3072 + hd * 128 + comp * 64; s.ks1 = NC;
      s.vt1 = VT + (size_t)bh * 128 * 256; s.vs1 = 256; s.n1 = 4;
    }
    const u16* qblk = PROJ + (size_t)(seq0 + qb * 256) * NC + 2048 + hd * 128 + comp * 64;
    attn_run<64, false>(s, qblk, NC, sQ, sK, sVT, O, lsum, 0, 0, 0, nullptr);
    const float inv = 1.f / lsum;
    if (comp == 0) {
#pragma unroll
      for (int d = 0; d < 4; ++d)
#pragma unroll
        for (int i = 0; i < 8; ++i) o1p[d * 8 + i] = pk2(O[d][2 * i] * inv, O[d][2 * i + 1] * inv);
    } else {
      float ssq = 0.f;
#pragma unroll
      for (int d = 0; d < 4; ++d)
#pragma unroll
        for (int i = 0; i < 8; ++i) {
          const u32 w = o1p[d * 8 + i];
          const float a = bflo(w) - lam * O[d][2 * i] * inv, c = bfhi(w) - lam * O[d][2 * i + 1] * inv;
          O[d][2 * i] = a; O[d][2 * i + 1] = c;
          ssq += a * a + c * c;
        }
      ssq += __shfl_xor(ssq, 32);
      const float rn = rsqrtf(ssq * (1.f / 128.f) + LN_EPS) * (1.f - lam_init);
      const float* subln = p.in[21 + 10 * l];
      const u16* gp = PROJ + (size_t)token * NC + 5120 + hd * 128;
      u16* yp = reinterpret_cast<u16*>(p.ws + WS_H) + (size_t)token * 2048 + 1024 + hd * 128;
#pragma unroll
      for (int d = 0; d < 4; ++d)
#pragma unroll
        for (int q = 0; q < 4; ++q) {
          const int dv = d * 32 + 8 * q + 4 * h;
          const u32x2 gw = *reinterpret_cast<const u32x2*>(gp + dv);
          const float4 sl = *reinterpret_cast<const float4*>(subln + dv);
          const float y0 = O[d][4 * q] * rn * sl.x * silu(bflo(gw[0]));
          const float y1 = O[d][4 * q + 1] * rn * sl.y * silu(bfhi(gw[0]));
          const float y2 = O[d][4 * q + 2] * rn * sl.z * silu(bflo(gw[1]));
          const float y3 = O[d][4 * q + 3] * rn * sl.w * silu(bfhi(gw[1]));
          *reinterpret_cast<u32x2*>(yp + dv) = (ZERO_MASK & 2) ? u32x2{0u, 0u} : u32x2{pk2(y0, y1), pk2(y2, y3)};
        }
    }
  }
}

DI void pool_item(const Params& p, int l, int pi, unsigned char* lds) {
  constexpr int NC = 6144;
  const int tid = TIDX, lane = tid & 63, wid = tid >> 6, fr = lane & 15, fq = lane >> 4;
  const int tb = pi >> 2, g = pi & 3, row0 = tb * 64;
  const int L = row0 < TP ? 256 : 4096;
  const int t0 = row0 < TP ? (row0 & 255) : ((row0 - TP) & 4095);
  u16* sIn = reinterpret_cast<u16*>(lds);
  u16* sP = sIn + 80 * 264;
  const u16* PROJ = reinterpret_cast<const u16*>(p.ws + WS_PROJ);
  __syncthreads();
#pragma unroll
  for (int i = 0; i < 10; ++i) {
    const int c = tid + 256 * i, rr = c >> 5, oc = c & 31;
    const int t = t0 - 8 + rr;
    u32x4 v = {0u, 0u, 0u, 0u};
    if (t >= 0 && t < L) v = *reinterpret_cast<const u32x4*>(PROJ + (size_t)(row0 - 8 + rr) * NC + g * 256 + oc * 8);
    *reinterpret_cast<u32x4*>(sIn + rr * 264 + oc * 8) = v;
  }
  __syncthreads();
  {
    const int oc = tid & 31, seg = tid >> 5;
    const int half = 1 << g;
#pragma unroll 1
    for (int tt = 0; tt < 8; ++tt) {
      const int tl = seg * 8 + tt, t = t0 + tl;
      const int lo = max(t - half, 0), hi = min(t + half, L);
      float a[8];
#pragma unroll
      for (int k = 0; k < 8; ++k) a[k] = 0.f;
      for (int s = lo; s < hi; ++s) {
        const u32x4 v = *reinterpret_cast<const u32x4*>(sIn + (s - t0 + 8) * 264 + oc * 8);
#pragma unroll
        for (int k = 0; k < 4; ++k) { a[2 * k] += bflo(v[k]); a[2 * k + 1] += bfhi(v[k]); }
      }
      const float ic = 1.f / (float)(hi - lo);
      const u32x4 x = *reinterpret_cast<const u32x4*>(sIn + (tl + 8) * 264 + oc * 8);
      u32x4 o;
#pragma unroll
      for (int k = 0; k < 4; ++k) o[k] = pk2(a[2 * k] * ic - bflo(x[k]), a[2 * k + 1] * ic - bfhi(x[k]));
      *reinterpret_cast<u32x4*>(sP + tl * 264 + oc * 8) = o;
    }
  }
  __syncthreads();
  const u16* W = reinterpret_cast<const u16*>(p.ws + WS_POOLWT) + (size_t)(l >> 1) * 262144 + (size_t)g * 65536;
  f32x4 acc[4][4];
#pragma unroll
  for (int a = 0; a < 4; ++a)
#pragma unroll
    for (int b = 0; b < 4; ++b) acc[a][b] = f32x4{0.f, 0.f, 0.f, 0.f};
#pragma unroll 2
  for (int ks = 0; ks < 8; ++ks) {
    bf16x8 af[4], bfr[4];
#pragma unroll
    for (int m = 0; m < 4; ++m) af[m] = ld8(sP + (m * 16 + fr) * 264 + ks * 32 + fq * 8);
#pragma unroll
    for (int n = 0; n < 4; ++n) bfr[n] = ld8(W + (size_t)(wid * 64 + n * 16 + fr) * 256 + ks * 32 + fq * 8);
#pragma unroll
    for (int m = 0; m < 4; ++m)
#pragma unroll
      for (int n = 0; n < 4; ++n) acc[m][n] = mfma16(bfr[n], af[m], acc[m][n]);
  }
  const float* pscale = p.in[19 + 10 * l];
  u16* Y = reinterpret_cast<u16*>(p.ws + WS_H);
#pragma unroll
  for (int n = 0; n < 4; ++n) {
    const int col = g * 256 + wid * 64 + n * 16 + 4 * fq;
    const float4 sc = *reinterpret_cast<const float4*>(pscale + col);
#pragma unroll
    for (int m = 0; m < 4; ++m) {
      const int row = row0 + m * 16 + fr;
      const u32x2 gw = *reinterpret_cast<const u32x2*>(PROJ + (size_t)row * NC + 1024 + col);
      float y0 = acc[m][n][0] * sc.x * silu(bflo(gw[0])), y1 = acc[m][n][1] * sc.y * silu(bfhi(gw[0]));
      float y2 = acc[m][n][2] * sc.z * silu(bflo(gw[1])), y3 = acc[m][n][3] * sc.w * silu(bfhi(gw[1]));
      if (ZERO_MASK & 1) { y0 = y1 = y2 = y3 = 0.f; }
      *reinterpret_cast<u32x2*>(Y + (size_t)row * 2048 + col) = u32x2{pk2(y0, y1), pk2(y2, y3)};
    }
  }
}

DI void phase_mix_even(const Params& p, int l, unsigned char* lds, unsigned char* lds_all) {
#pragma unroll 1
  for (int it = blockIdx.x; it < 512; it += gridDim.x) { int bh, qb; heavy_map(it, bh, qb); diff_item(p, l, true, bh, qb, lds_all); }
#pragma unroll 1
  for (int it = blockIdx.x; it < 256; it += gridDim.x) diff_item(p, l, false, it, 0, lds_all);
#pragma unroll 1
  for (int it = VBID; it < 1536; it += VGRID) pool_item(p, l, it, lds);
}

DI void na_item(const Params& p, int l, bool sample, int bh, int qb, unsigned char* lds) {
  constexpr int NC = 7168;
  const int tid = TID8, lane = tid & 63, wid = tid >> 6, r = lane & 31, h = lane >> 5;
  const int b = bh >> 3, hd = bh & 7;
  u16* sQ = reinterpret_cast<u16*>(lds);
  u16* sK = sQ + 256 * 136;
  u16* sVT = sK + 64 * 136;
  float* sBias = reinterpret_cast<float*>(sVT + 128 * 72) + 64;
  const u16* PROJ = reinterpret_cast<const u16*>(p.ws + WS_PROJ);
  const u16* VT = reinterpret_cast<const u16*>(p.ws + WS_VT);
  const int seq0 = sample ? TP + b * 4096 : b * 256;
  const int token = seq0 + qb * 256 + wid * 32 + r;
  AttnSrc s;
  int qr = 0, qc = 0, rsmin = 0;
  f32x16 O[4];
  float lsum;
  const u16* qblk = PROJ + (size_t)(seq0 + qb * 256) * NC + hd * 128;
  if (sample) {
    __syncthreads();
    const float* rpb = p.in[18 + 10 * l] + hd * 465;
    for (int e = tid; e < 465; e += 512) sBias[e] = rpb[e] * LOG2E;
    const int r0 = qb * 4;
    qr = r0 + (wid >> 1); qc = (wid & 1) * 32 + r;
    rsmin = min(max(r0 - 4, 0), 56);
    const int rs1 = min(max(r0 - 1, 0), 56);
    s.k0 = reinterpret_cast<const u16*>(p.ws + WS_CK) + (size_t)l * 2097152 + (size_t)bh * 65536; s.ks0 = 128;
    s.vt0 = reinterpret_cast<const u16*>(p.ws + WS_CVT) + (size_t)l * 2097152 + (size_t)bh * 65536; s.vs0 = 512; s.n0 = 8;
    s.k1 = PROJ + (size_t)(seq0 + rsmin * 64) * NC + 1024 + hd * 128; s.ks1 = NC;
    s.vt1 = VT + 8388608 + (size_t)bh * 128 * 4096 + rsmin * 64; s.vs1 = 4096; s.n1 = rs1 + 8 - rsmin;
    attn_run<128, true>(s, qblk, NC, sQ, sK, sVT, O, lsum, qr, qc, rsmin, sBias);
  } else {
    s.k0 = nullptr; s.vt0 = nullptr; s.ks0 = 0; s.vs0 = 0; s.n0 = 0;
    s.k1 = PROJ + (size_t)seq0 * NC + 1024 + hd * 128; s.ks1 = NC;
    s.vt1 = VT + (size_t)bh * 128 * 256; s.vs1 = 256; s.n1 = 4;
    attn_run<128, false>(s, qblk, NC, sQ, sK, sVT, O, lsum, 0, 0, 0, nullptr);
  }
  const float inv = 1.f / lsum;
  const u16* gp = PROJ + (size_t)token * NC + 3072 + hd * 128;
  u16* yp = reinterpret_cast<u16*>(p.ws + WS_H) + (size_t)token * 2048 + hd * 128;
#pragma unroll
  for (int d = 0; d < 4; ++d)
#pragma unroll
    for (int q = 0; q < 4; ++q) {
      const int dv = d * 32 + 8 * q + 4 * h;
      const u32x2 gw = *reinterpret_cast<const u32x2*>(gp + dv);
      const float y0 = O[d][4 * q] * inv * silu(bflo(gw[0]));
      const float y1 = O[d][4 * q + 1] * inv * silu(bfhi(gw[0]));
      const float y2 = O[d][4 * q + 2] * inv * silu(bflo(gw[1]));
      const float y3 = O[d][4 * q + 3] * inv * silu(bfhi(gw[1]));
      *reinterpret_cast<u32x2*>(yp + dv) = (ZERO_MASK & 4) ? u32x2{0u, 0u} : u32x2{pk2(y0, y1), pk2(y2, y3)};
    }
}

DI void sgu_item(const Params& p, int l, int si, unsigned char* lds) {
  constexpr int NC = 7168;
  const int tid = TIDX, lane = tid & 63, wid = tid >> 6, fr = lane & 15, fq = lane >> 4;
  const int ch = si >> 2, g = si & 3, row0 = ch * 128;
  u16* vnT = reinterpret_cast<u16*>(lds);
  float* sMu = reinterpret_cast<float*>(vnT + 256 * 136);
  float* sRs = sMu + 128;
  const u16* PROJ = reinterpret_cast<const u16*>(p.ws + WS_PROJ);
  __syncthreads();
  {
    const int grp = tid >> 4, ln = tid & 15;
#pragma unroll 2
    for (int rr = 0; rr < 8; ++rr) {
      const u16* src = PROJ + (size_t)(row0 + grp * 8 + rr) * NC + 5120;
      float s = 0.f, ss = 0.f;
#pragma unroll
      for (int c8 = 0; c8 < 8; ++c8) {
        const u32x4 v = *reinterpret_cast<const u32x4*>(src + (ln + 16 * c8) * 8);
#pragma unroll
        for (int k = 0; k < 4; ++k) { const float a = bflo(v[k]), b = bfhi(v[k]); s += a + b; ss += a * a + b * b; }
      }
#pragma unroll
      for (int o = 8; o >= 1; o >>= 1) { s += __shfl_xor(s, o); ss += __shfl_xor(ss, o); }
      const float mu = s * (1.f / 1024.f);
      const float var = fmaxf(ss * (1.f / 1024.f) - mu * mu, 0.f);
      if (ln == 0) { sMu[grp * 8 + rr] = mu; sRs[grp * 8 + rr] = rsqrtf(var + LN_EPS); }
    }
  }
  __syncthreads();
  {
    const int j = tid & 127, hf = tid >> 7;
    const float mu = sMu[j], rs = sRs[j];
    const float* lng = p.in[19 + 10 * l] + g * 256;
    const u16* src = PROJ + (size_t)(row0 + j) * NC + 5120 + g * 256;
#pragma unroll 4
    for (int oc = hf * 16; oc < hf * 16 + 16; ++oc) {
      const u32x4 v = *reinterpret_cast<const u32x4*>(src + oc * 8);
      const float4 g0 = *reinterpret_cast<const float4*>(lng + oc * 8), g1 = *reinterpret_cast<const float4*>(lng + oc * 8 + 4);
      const float gg[8] = {g0.x, g0.y, g0.z, g0.w, g1.x, g1.y, g1.z, g1.w};
#pragma unroll
      for (int k = 0; k < 4; ++k) {
        const float a = (bflo(v[k]) - mu) * rs * gg[2 * k], b = (bfhi(v[k]) - mu) * rs * gg[2 * k + 1];
        const u32 w = pk2(a, b);
        vnT[(oc * 8 + 2 * k) * 136 + j] = (u16)(w & 0xffffu);
        vnT[(oc * 8 + 2 * k + 1) * 136 + j] = (u16)(w >> 16);
      }
    }
  }
  __syncthreads();
  const u16* W = reinterpret_cast<const u16*>(p.ws + WS_SGUW) + (size_t)(l >> 1) * 65536 + (size_t)g * 16384;
  const float* bs = p.in[21 + 10 * l] + g * 128;
  u16* Y = reinterpret_cast<u16*>(p.ws + WS_H);
#pragma unroll 1
  for (int ih = 0; ih < 2; ++ih) {
    f32x4 acc[4][4];
#pragma unroll
    for (int a = 0; a < 4; ++a)
#pragma unroll
      for (int b = 0; b < 4; ++b) acc[a][b] = f32x4{0.f, 0.f, 0.f, 0.f};
#pragma unroll
    for (int ks = 0; ks < 4; ++ks) {
      bf16x8 af[4], bfr[4];
#pragma unroll
      for (int m = 0; m < 4; ++m) af[m] = ld8(W + (size_t)(ih * 64 + m * 16 + fr) * 128 + ks * 32 + fq * 8);
#pragma unroll
      for (int n = 0; n < 4; ++n) bfr[n] = ld8(vnT + (wid * 64 + n * 16 + fr) * 136 + ks * 32 + fq * 8);
#pragma unroll
      for (int m = 0; m < 4; ++m)
#pragma unroll
        for (int n = 0; n < 4; ++n) acc[m][n] = mfma16(bfr[n], af[m], acc[m][n]);
    }
#pragma unroll
    for (int m = 0; m < 4; ++m) {
      const int ii = ih * 64 + m * 16 + fr;
      const float bias = bs[ii];
      const size_t rb = (size_t)(row0 + ii) * NC;
#pragma unroll
      for (int n = 0; n < 4; ++n) {
        const int c = g * 256 + wid * 64 + n * 16 + 4 * fq;
        const u32x2 uw = *reinterpret_cast<const u32x2*>(PROJ + rb + 4096 + c);
        const u32x2 dw = *reinterpret_cast<const u32x2*>(PROJ + rb + 6144 + c);
        float y0 = bflo(uw[0]) * (acc[m][n][0] + bias) * silu(bflo(dw[0])), y1 = bfhi(uw[0]) * (acc[m][n][1] + bias) * silu(bfhi(dw[0]));
        float y2 = bflo(uw[1]) * (acc[m][n][2] + bias) * silu(bflo(dw[1])), y3 = bfhi(uw[1]) * (acc[m][n][3] + bias) * silu(bfhi(dw[1]));
        if (ZERO_MASK & 8) { y0 = y1 = y2 = y3 = 0.f; }
        *reinterpret_cast<u32x2*>(Y + (size_t)(row0 + ii) * 2048 + 1024 + c) = u32x2{pk2(y0, y1), pk2(y2, y3)};
      }
    }
  }
}

DI void phase_mix_odd(const Params& p, int l, unsigned char* lds, unsigned char* lds_all) {
#pragma unroll 1
  for (int it = blockIdx.x; it < 512; it += gridDim.x) { int bh, qb; heavy_map(it, bh, qb); na_item(p, l, true, bh, qb, lds_all); }
#pragma unroll 1
  for (int it = blockIdx.x; it < 256; it += gridDim.x) na_item(p, l, false, it, 0, lds_all);
#pragma unroll 1
  for (int it = VBID; it < 768; it += VGRID) sgu_item(p, l, it, lds);
}

#define XB_TMO      128
#define XB_XCNT(j)  (256  + 64 * (j))
#define XB_XSUB(j)  (1280 + 64 * (j))
#define XB_XGEN(j)  (2304 + 64 * (j))
#define XB_TOP      3328
#define XB_TOPGEN   3392
#define XCD_BAR_WORDS 3456
#define XB_SPIN_CAP (1u << 18)
#define LAS __attribute__((address_space(3)))
DI unsigned xb_ld(unsigned* p)              { return __hip_atomic_load(p, __ATOMIC_RELAXED, __HIP_MEMORY_SCOPE_AGENT); }
DI unsigned xb_add(unsigned* p, unsigned v) { return __hip_atomic_fetch_add(p, v, __ATOMIC_RELAXED, __HIP_MEMORY_SCOPE_AGENT); }
DI unsigned xb_xcc_id() { return (unsigned)__builtin_amdgcn_s_getreg((3 << 11) | 20) & 0xFu; }
#define XB_SPIN(cond, bar) do { unsigned _sp = 0; while (cond) { __builtin_amdgcn_s_sleep(1); \
    if ((++_sp & 255u) == 0u) { if (xb_ld(&(bar)[XB_TMO])) break; if (_sp > XB_SPIN_CAP) { atomicAdd(&(bar)[XB_TMO], 1u); break; } } } } while (0)
struct XcdBarrier { unsigned* bar; unsigned x; volatile LAS unsigned* st; };
DI XcdBarrier xcd_barrier_post(unsigned* bar, volatile LAS unsigned* st) {
  XcdBarrier b; b.bar = bar; b.x = xb_xcc_id(); b.st = st;
  if (threadIdx.x == 0) (void)xb_add(&bar[XB_XCNT(b.x)], 1u);
  return b;
}
DI void xcd_barrier_complete(unsigned* bar, unsigned x, unsigned& nloc, unsigned& nx) {
  const unsigned G = gridDim.x * gridDim.y * gridDim.z;
  unsigned sum, cnt, mine, sp = 0u;
  for (;;) {
    sum = 0u; cnt = 0u; mine = 0u;
#pragma unroll
    for (unsigned j = 0; j < 16; ++j) { const unsigned c = xb_ld(&bar[XB_XCNT(j)]); sum += c; cnt += (c > 0u) ? 1u : 0u; mine = (j == x) ? c : mine; }
    if (sum == G) break;
    __builtin_amdgcn_s_sleep(1);
    if ((++sp & 255u) == 0u) { if (xb_ld(&bar[XB_TMO])) break; if (sp > XB_SPIN_CAP) { atomicAdd(&bar[XB_TMO], 1u); break; } }
  }
  nloc = mine > 0u ? mine : 1u; nx = cnt > 0u ? cnt : 1u;
}
DI void xcd_barrier(const XcdBarrier& b) {
  asm volatile("s_waitcnt vmcnt(0)" ::: "memory");
  __syncthreads();
  if (threadIdx.x == 0) {
    unsigned* bar = b.bar;
    __builtin_amdgcn_s_waitcnt(0);
    unsigned nloc = b.st[0], nx = b.st[1];
    if (nloc == 0u) { xcd_barrier_complete(bar, b.x, nloc, nx); b.st[0] = nloc; b.st[1] = nx; }
    const unsigned old = xb_add(&bar[XB_XSUB(b.x)], 1u);
    const unsigned gen = old / nloc;
    if (old + 1u == (gen + 1u) * nloc) {
      __builtin_amdgcn_fence(__ATOMIC_RELEASE, "agent");
      asm volatile("s_waitcnt vmcnt(0)" ::: "memory");
      const unsigned og = xb_add(&bar[XB_TOP], 1u);
      const unsigned tg = og / nx;
      if (og + 1u == (tg + 1u) * nx) xb_add(&bar[XB_TOPGEN], 1u);
      else XB_SPIN(xb_ld(&bar[XB_TOPGEN]) == tg, bar);
      __builtin_amdgcn_fence(__ATOMIC_ACQUIRE, "agent");
      xb_add(&bar[XB_XGEN(b.x)], 1u);
      asm volatile("s_waitcnt vmcnt(0)" ::: "memory");
    } else {
      XB_SPIN(xb_ld(&bar[XB_XGEN(b.x)]) == gen, bar);
      __builtin_amdgcn_fence(__ATOMIC_ACQUIRE, "agent");
      asm volatile("s_waitcnt vmcnt(0)" ::: "memory");
    }
  }
  __syncthreads();
}

__global__ void __launch_bounds__(512, 2) fwd_megakernel(Params p) {
  extern __shared__ __attribute__((aligned(16))) unsigned char lds[];
  cg::grid_group grid = cg::this_grid();
  volatile LAS unsigned* xst = (volatile LAS unsigned*)(lds + LDS_BYTES - 16);
  if (threadIdx.x == 0) { xst[0] = 0u; xst[1] = 0u; }
  __syncthreads();
  const XcdBarrier xb = xcd_barrier_post(reinterpret_cast<unsigned*>(p.ws + WS_BAR), xst);
  for (int ph = p.ph_lo; ph < p.ph_hi; ++ph) {
    unsigned char* hl = lds + HALF_ID * HALF_LDS;
    if (ph == 0) phase_prep(p, hl);
    else if (ph == 1) phase_mod0(p);
    else {
      const int l = (ph - 2) >> 2, s = (ph - 2) & 3;
      if (s == 0) { if (l & 1) gemm_phase<G_IN_ODD>(p, l, lds); else gemm_phase<G_IN_EVEN>(p, l, lds); }
      else if (s == 1) { if (l & 1) phase_mix_odd(p, l, hl, lds); else phase_mix_even(p, l, hl, lds); }
      else if (s == 2) gemm_phase<G_OUT>(p, l, lds);
      else phase_ln(p, l);
    }
    if (ph + 1 < p.ph_hi) {
      if (p.ph_lo < 0) grid.sync();
      xcd_barrier(xb);
    }
  }
}

extern "C" void kernel_launch(void* const* d_in, const int* in_sizes, int n_in, void* d_out, int out_size, void* d_ws, size_t ws_size,
                              hipStream_t stream) {
  static int grid_blocks = 0;
  if (grid_blocks == 0) {
    if (n_in != 52 || ws_size < WS_END) {
      fprintf(stderr, "kernel_launch: expected 52 inputs and >= %zu bytes of workspace; got %d, %zu\n", (size_t)WS_END, n_in, ws_size);
      grid_blocks = -1;
      return;
    }
    int dev = 0, cus = 0, per_cu = 0;
    hipGetDevice(&dev);
    hipDeviceGetAttribute(&cus, hipDeviceAttributeMultiprocessorCount, dev);
    hipFuncSetAttribute((const void*)fwd_megakernel, hipFuncAttributeMaxDynamicSharedMemorySize, LDS_BYTES);
    hipOccupancyMaxActiveBlocksPerMultiprocessor(&per_cu, (const void*)fwd_megakernel, 512, LDS_BYTES);
    (void)hipGetLastError();
    grid_blocks = cus;
  }
  if (grid_blocks < 0) return;
  Params p{};
  for (int i = 0; i < 52; ++i) p.in[i] = (const float*)d_in[i];
  p.out = (float*)d_out;
  p.ws = (unsigned char*)d_ws;
#if MULTI
  for (int ph = 0; ph < NPHASE; ++ph) {
    p.ph_lo = ph; p.ph_hi = ph + 1;
    hipLaunchKernelGGL(fwd_megakernel, dim3(grid_blocks), dim3(512), LDS_BYTES, stream, p);
  }
#else
  p.ph_lo = 0; p.ph_hi = NPHASE;
  if (hipMemsetAsync((char*)d_ws + WS_BAR, 0, XCD_BAR_WORDS * 4, stream) != hipSuccess) { fprintf(stderr, "kernel_launch: memset of barrier words failed\n"); return; }
  void* args[] = {&p};
  hipError_t e = hipLaunchCooperativeKernel((const void*)fwd_megakernel, dim3(grid_blocks), dim3(512), args, LDS_BYTES, stream);
  if (e != hipSuccess) fprintf(stderr, "cooperative launch failed: %s (grid %d)\n", hipGetErrorString(e), grid_blocks);
#endif
}
```

```cpp
#include <hip/hip_runtime.h>
#include <hip/hip_cooperative_groups.h>
#include <cstdio>
namespace cg = cooperative_groups;

#define DI __device__ __forceinline__
typedef unsigned short u16;
typedef unsigned int u32;
using bf16x8 = __attribute__((ext_vector_type(8))) short;
using f32x4 = __attribute__((ext_vector_type(4))) float;
using f32x16 = __attribute__((ext_vector_type(16))) float;
using u32x4 = __attribute__((ext_vector_type(4))) unsigned;
using u32x2 = __attribute__((ext_vector_type(2))) unsigned;
typedef __bf16 bf2_t __attribute__((ext_vector_type(2)));
typedef float f2_t __attribute__((ext_vector_type(2)));

#ifndef MULTI
#define MULTI 0
#endif
#ifndef REP0
#define REP0 1
#endif
#ifndef REP1
#define REP1 1
#endif
#ifndef ZERO_MASK
#define ZERO_MASK 0
#endif

constexpr int T_ALL = 24576, TP = 8192, DM = 2048;
constexpr float LOG2E = 1.4426950408889634f;
constexpr float ALPHA = 1.6817928305074290f;
constexpr float LN_EPS = 1e-5f;
constexpr int HALF_LDS = 76288;
constexpr int LDS_BYTES = 2 * HALF_LDS + 16;
constexpr int NPHASE = 18;

constexpr size_t SZ_WIN_E = (size_t)6144 * 2048 * 2, SZ_WIN_O = (size_t)7168 * 2048 * 2;
constexpr size_t WS_WINT = 0;
constexpr size_t WS_WOUTT = WS_WINT + 2 * SZ_WIN_E + 2 * SZ_WIN_O;
constexpr size_t WS_POOLWT = WS_WOUTT + (size_t)4 * 2048 * 2048 * 2;
constexpr size_t WS_SGUW = WS_POOLWT + (size_t)2 * 4 * 256 * 256 * 2;
constexpr size_t WS_CK = WS_SGUW + (size_t)2 * 4 * 128 * 128 * 2;
constexpr size_t WS_CVT = WS_CK + (size_t)4 * 4194304;
constexpr size_t WS_MOD = WS_CVT + (size_t)4 * 4194304;
constexpr size_t WS_ROPE = WS_MOD + (size_t)4 * 5 * 6144 * 4;
constexpr size_t WS_H = WS_ROPE + 8192;
constexpr size_t WS_PROJ = WS_H + (size_t)T_ALL * 2048 * 2;
constexpr size_t WS_VT = WS_PROJ + (size_t)T_ALL * 7168 * 2;
constexpr size_t WS_BAR = WS_VT + (size_t)T_ALL * 1024 * 2;
constexpr size_t WS_STATS = WS_BAR + 16384;
constexpr size_t WS_END = WS_STATS + (size_t)T_ALL * 8;

struct Params {
  const float* in[52];
  float* out;
  unsigned char* ws;
  int ph_lo, ph_hi;
};

DI size_t ws_wint(int l) { return WS_WINT + (size_t)(l >> 1) * (SZ_WIN_E + SZ_WIN_O) + ((l & 1) ? SZ_WIN_E : 0); }

DI u32 pk2(float a, float b) { f2_t v = {a, b}; bf2_t r = __builtin_convertvector(v, bf2_t); return __builtin_bit_cast(u32, r); }
DI float bflo(u32 w) { return __uint_as_float(w << 16); }
DI float bfhi(u32 w) { return __uint_as_float(w & 0xffff0000u); }
DI float bf1(u16 w) { return __uint_as_float(((u32)w) << 16); }
DI float ex2(float x) { return __builtin_amdgcn_exp2f(x); }
DI float silu(float x) { return x / (1.f + __expf(-x)); }
DI f32x4 mfma16(bf16x8 a, bf16x8 b, f32x4 c) { return __builtin_amdgcn_mfma_f32_16x16x32_bf16(a, b, c, 0, 0, 0); }
DI f32x16 mfma32(bf16x8 a, bf16x8 b, f32x16 c) { return __builtin_amdgcn_mfma_f32_32x32x16_bf16(a, b, c, 0, 0, 0); }
DI bf16x8 ld8(const u16* p) { return *reinterpret_cast<const bf16x8*>(p); }
DI int opq(int x) { asm volatile("" : "+v"(x)); return x; }
#define TIDX (opq((int)threadIdx.x) & 255)
#define TID8 (opq((int)threadIdx.x))
#define HALF_ID (opq((int)threadIdx.x) >> 8)
#define VBID ((int)((blockIdx.x & 7u) | ((unsigned)HALF_ID << 3) | ((blockIdx.x >> 3) << 4)))
#define VGRID ((int)gridDim.x * 2)

enum { G_IN_EVEN = 0, G_IN_ODD = 1, G_OUT = 2 };

namespace pg8 {
#define PG8_LAS __attribute__((address_space(3)))
typedef unsigned short bf16_t;
typedef short bf16x8 __attribute__((ext_vector_type(8)));
typedef float f32x4 __attribute__((ext_vector_type(4)));
typedef unsigned u32x4 __attribute__((ext_vector_type(4)));
constexpr int BM = 256, BK = 64, HALF = 128, HTB = HALF * BK * 2  , STAGE_BYTES = 8 * HTB, NXCD = 8, WGM = 8;

__host__ __device__ __forceinline__ int lds_byte(int r, int c) { const int st = (r >> 4) * 2 + (c >> 5), rr = r & 15, cc = c & 31, ob = rr * 64 + cc * 2; return st * 1024 + (ob ^ (((ob >> 9) & 1) << 5)); }
__host__ __device__ __forceinline__ void stage_rc(int b, int& R, int& C) { const int st = b / 1024, sb = b % 1024, swz = sb ^ (((sb >> 9) & 1) << 5); R = (st >> 1) * 16 + swz / 64; C = (st & 1) * 32 + (swz % 64) / 2; }
__host__ __device__ __forceinline__ int perm32(int rho) { const int n = rho >> 4, i = rho & 15; return 8 * (i >> 2) + 4 * n + (i & 3); }

struct Unit { int pm, pn; };
struct Gemm { const bf16_t* A; const bf16_t* Bt; int M, N, K; };

struct StaticOrder {
    int nM, nN, nwg, G, c;
    __host__ __device__ void init(int M, int N, int G_, int c_) { nM = M / BM; nN = N / BM; nwg = nM * nN; G = G_; c = c_; }
    __host__ __device__ bool next(int i, Unit& u) const {
        const long L = (long)i * G + c; if (L >= nwg) return false;
        int wgid = (int)L; { const int q = nwg / NXCD, r = nwg % NXCD, xcd = wgid % NXCD, off = wgid / NXCD; wgid = (xcd < r ? xcd * (q + 1) : r * (q + 1) + (xcd - r) * q) + off; }
        const int nig = WGM * nN, gid = wgid / nig, fm = gid * WGM, gsz = (nM - fm) < WGM ? (nM - fm) : WGM;
        u.pm = fm + ((wgid % nig) % gsz); u.pn = (wgid % nig) / gsz; return true;
    }
    __device__ __forceinline__ void a_ready(const Unit&) const {}
    __device__ __forceinline__ void done(const Unit&) const {}
};

template <class Epi, class Sched, bool STAMP = false>
__device__ __forceinline__ void gemm_phase(PG8_LAS unsigned char* lds, const Gemm g, const Sched& S, const Epi& E, unsigned long long* stamps) {
    const int tid = opq((int)threadIdx.x), wid = __builtin_amdgcn_readfirstlane(tid >> 6), lane = tid & 63, wr = wid >> 2, wc = wid & 3, fr = lane & 15, fq = lane >> 4;
    const int K = g.K, nt = K / BK;
    int ts_lo = 0, ts_hi = 0, nts = 0; const unsigned long long rt_entry = STAMP ? (unsigned long long)wall_clock64() : 0ull;
#define PG8_STAMP() do { if (STAMP && wid == 0 && nts < 64) { const unsigned long long _c = (unsigned long long)clock64(); \
        ts_lo = (lane == nts) ? (int)(unsigned)_c : ts_lo; ts_hi = (lane == nts) ? (int)(unsigned)(_c >> 32) : ts_hi; ++nts; } } while (0)
    PG8_STAMP();
    unsigned voffA[2], voffB[2];
#pragma unroll
    for (int i = 0; i < 2; ++i) { int R, C; stage_rc(tid * 16 + i * 8192, R, C); const int Rb = Epi::PERM ? ((R & ~31) + perm32(R & 31)) : R;
        voffA[i] = (unsigned)(R * K + C) * 2u; voffB[i] = (unsigned)(Rb * K + C) * 2u; }
    const size_t kstep = (size_t)(BK * 2);
    const size_t hstep = (size_t)HALF * K * 2;
    const size_t tstep = 2 * hstep;
    const unsigned ldsw = (unsigned)wid * 1024u;
    const int aoff = lds_byte(wr * 64 + fr, fq * 8), boff = lds_byte(wc * 32 + fr, fq * 8);
#define PG8_SA(b, h) (((b) * 2 + (h)) * HTB)
#define PG8_SB(b, h) ((4 + (b) * 2 + (h)) * HTB)
#define PG8_STAGE(bufoff, gbase, voff) do { _Pragma("unroll") for (int _i = 0; _i < 2; ++_i) \
        __builtin_amdgcn_global_load_lds((const unsigned*)((const char*)(gbase) + (voff)[_i]), (PG8_LAS unsigned*)(lds + (bufoff) + ldsw + _i * 8192), 16, 0, 0); } while (0)
#define PG8_LDA(dst, b, h) do { _Pragma("unroll") for (int m = 0; m < 4; ++m) _Pragma("unroll") for (int k = 0; k < 2; ++k) dst[m][k] = *(const PG8_LAS bf16x8*)(lds + PG8_SA(b, h) + aoff + m * 2048 + k * 1024); } while (0)
#define PG8_LDB(dst, b, h) do { _Pragma("unroll") for (int n = 0; n < 2; ++n) _Pragma("unroll") for (int k = 0; k < 2; ++k) dst[n][k] = *(const PG8_LAS bf16x8*)(lds + PG8_SB(b, h) + boff + n * 2048 + k * 1024); } while (0)
#define PG8_MMA(ai, bj, At, Bt) do { __builtin_amdgcn_s_setprio(1); _Pragma("unroll") for (int m = 0; m < 4; ++m) _Pragma("unroll") for (int n = 0; n < 2; ++n) _Pragma("unroll") for (int k = 0; k < 2; ++k) \
        acc[ai][bj][m][n] = __builtin_amdgcn_mfma_f32_16x16x32_bf16(Bt[n][k], At[m][k], acc[ai][bj][m][n], 0, 0, 0); __builtin_amdgcn_s_setprio(0); } while (0)
#define PG8_WAIT_V(n) asm volatile("s_waitcnt vmcnt(" #n ")" ::: "memory")
#define PG8_WAIT_L(n) asm volatile("s_waitcnt lgkmcnt(" #n ")" ::: "memory")
#define PG8_BAR __builtin_amdgcn_s_barrier()
#define PG8_SCHED __builtin_amdgcn_sched_barrier(0)
    Unit cur, nxt; int ui = 0;
    if (!S.next(0, cur)) return;
    f32x4 acc[2][2][4][2];
#pragma unroll
    for (int a = 0; a < 2; ++a)
#pragma unroll
        for (int b = 0; b < 2; ++b)
#pragma unroll
            for (int m = 0; m < 4; ++m)
#pragma unroll
                for (int n = 0; n < 2; ++n) acc[a][b][m][n] = (f32x4){0.f, 0.f, 0.f, 0.f};
    bf16x8 At[4][2], B0[2][2], B1[2][2];
    const char* cA = (const char*)g.A + (size_t)cur.pm * tstep; const char* cB = (const char*)g.Bt + (size_t)cur.pn * tstep;
    S.a_ready(cur);
    PG8_STAGE(PG8_SB(0, 0), cB, voffB); PG8_STAGE(PG8_SA(0, 0), cA, voffA); PG8_STAGE(PG8_SB(0, 1), cB + hstep, voffB); PG8_STAGE(PG8_SA(0, 1), cA + hstep, voffA);
    if (wr == 1) PG8_BAR;
    PG8_WAIT_V(4); PG8_BAR;
    PG8_STAGE(PG8_SB(1, 0), cB + kstep, voffB); PG8_STAGE(PG8_SA(1, 0), cA + kstep, voffA); PG8_STAGE(PG8_SB(1, 1), cB + hstep + kstep, voffB);
    PG8_WAIT_V(6); PG8_BAR;
    PG8_STAMP();
    for (;;) {
        const bool has_next = S.next(ui + 1, nxt);
        const char* nA = has_next ? (const char*)g.A + (size_t)nxt.pm * tstep : cA; const char* nB = has_next ? (const char*)g.Bt + (size_t)nxt.pn * tstep : cB;
        for (int t = 0; t < nt; t += 2) {
            const bool last = (t == nt - 2);
            const char* a1 = cA + (size_t)(t + 1) * kstep;
            const char* a2 = last ? nA : cA + (size_t)(t + 2) * kstep; const char* b2 = last ? nB : cB + (size_t)(t + 2) * kstep;
            const char* a3 = a2 + kstep; const char* b3 = b2 + kstep;
            if (last && has_next) S.a_ready(nxt);
            PG8_LDB(B0, 0, 0); PG8_SCHED; PG8_LDA(At, 0, 0); PG8_STAGE(PG8_SA(1, 1), a1 + hstep, voffA);
            PG8_WAIT_L(8); PG8_BAR; PG8_WAIT_L(0); PG8_MMA(0, 0, At, B0); PG8_BAR; PG8_SCHED;
            PG8_LDB(B1, 0, 1); PG8_STAGE(PG8_SB(0, 0), b2, voffB);
            PG8_BAR; PG8_WAIT_L(0); PG8_MMA(0, 1, At, B1); PG8_BAR;
            PG8_LDA(At, 0, 1); PG8_STAGE(PG8_SA(0, 0), a2, voffA);
            PG8_BAR; PG8_WAIT_L(0); PG8_MMA(1, 0, At, B0); PG8_BAR; PG8_SCHED;
            PG8_STAGE(PG8_SB(0, 1), b2 + hstep, voffB);
            PG8_WAIT_V(6); PG8_BAR; PG8_MMA(1, 1, At, B1); PG8_BAR;
            PG8_LDB(B0, 1, 0); PG8_SCHED; PG8_LDA(At, 1, 0); PG8_STAGE(PG8_SA(0, 1), a2 + hstep, voffA);
            PG8_WAIT_L(8); PG8_BAR; PG8_WAIT_L(0); PG8_MMA(0, 0, At, B0); PG8_BAR; PG8_SCHED;
            PG8_LDB(B1, 1, 1); PG8_STAGE(PG8_SB(1, 0), b3, voffB);
            PG8_BAR; PG8_WAIT_L(0); PG8_MMA(0, 1, At, B1); PG8_BAR;
            PG8_LDA(At, 1, 1); PG8_STAGE(PG8_SA(1, 0), a3, voffA);
            PG8_BAR; PG8_WAIT_L(0); PG8_MMA(1, 0, At, B0); PG8_BAR; PG8_SCHED;
            PG8_STAGE(PG8_SB(1, 1), b3 + hstep, voffB);
            PG8_WAIT_V(6); PG8_BAR; PG8_MMA(1, 1, At, B1); PG8_BAR;
        }
        PG8_STAMP();
        if constexpr (!Epi::AFTER_DRAIN) { E(acc, cur, wr, wc, fr, fq); S.done(cur); }
        PG8_STAMP();
        if (!has_next) break;
#pragma unroll
        for (int a = 0; a < 2; ++a)
#pragma unroll
            for (int b = 0; b < 2; ++b)
#pragma unroll
                for (int m = 0; m < 4; ++m)
#pragma unroll
                    for (int n = 0; n < 2; ++n) acc[a][b][m][n] = (f32x4){0.f, 0.f, 0.f, 0.f};
        cur = nxt; cA = nA; cB = nB; ++ui;
    }
    PG8_WAIT_V(0);
    if (wr == 0) PG8_BAR;
    PG8_BAR;
    if constexpr (Epi::AFTER_DRAIN) { E.fused(acc, cur, wr, wc, fr, fq, lds, wid, lane); S.done(cur); }
    PG8_STAMP();
    if (STAMP && wid == 0) { stamps[lane] = lane < nts ? (((unsigned long long)(unsigned)ts_hi << 32) | (unsigned)ts_lo) : 0ull;
        if (lane == 62) stamps[62] = rt_entry; if (lane == 63) stamps[63] = (unsigned long long)wall_clock64(); }
#undef PG8_STAMP
#undef PG8_SA
#undef PG8_SB
#undef PG8_STAGE
#undef PG8_LDA
#undef PG8_LDB
#undef PG8_MMA
#undef PG8_WAIT_V
#undef PG8_WAIT_L
#undef PG8_BAR
#undef PG8_SCHED
}
}

DI void tr_tile(const float* __restrict__ src, size_t ld_src, u16* __restrict__ dst, size_t ld_dst, float* sT) {
  const int tid = TIDX;
  const int r = tid >> 4, c4 = (tid & 15) * 4;
#pragma unroll
  for (int i = 0; i < 4; ++i) {
    float4 v = *reinterpret_cast<const float4*>(src + (size_t)(r + 16 * i) * ld_src + c4);
    float* d = sT + (r + 16 * i) * 65 + c4;
    d[0] = v.x; d[1] = v.y; d[2] = v.z; d[3] = v.w;
  }
  __syncthreads();
  const int n = tid >> 2, ks = (tid & 3) * 16;
  u32 w[8];
#pragma unroll
  for (int j = 0; j < 8; ++j) w[j] = pk2(sT[(ks + 2 * j) * 65 + n], sT[(ks + 2 * j + 1) * 65 + n]);
  u32x4* o = reinterpret_cast<u32x4*>(dst + (size_t)n * ld_dst + ks);
  o[0] = u32x4{w[0], w[1], w[2], w[3]};
  o[1] = u32x4{w[4], w[5], w[6], w[7]};
  __syncthreads();
}

DI void cvt8(const float* __restrict__ src, u16* __restrict__ dst) {
  float4 a = *reinterpret_cast<const float4*>(src);
  float4 b = *reinterpret_cast<const float4*>(src + 4);
  *reinterpret_cast<u32x4*>(dst) = u32x4{pk2(a.x, a.y), pk2(a.z, a.w), pk2(b.x, b.y), pk2(b.z, b.w)};
}

DI void mod_item(const Params& p, int i, unsigned char* lds) {
  const int tid = TIDX;
  const int l = i / 96, n0 = (i % 96) * 64;
  float* sS = reinterpret_cast<float*>(lds);
  float* red = sS + 5 * 2048;
  const float* c = p.in[10];
  const float* cctx = p.in[11];
  for (int e = tid; e < 5 * 2048; e += 256) {
    int v = e >> 11, k = e & 2047;
    float x = (v == 0) ? cctx[k] : c[(v - 1) * 2048 + k];
    sS[e] = silu(x);
  }
  __syncthreads();
  const int kk = tid >> 4, c4 = (tid & 15) * 4;
  const float* W = p.in[12 + 10 * l] + n0 + c4;
  f32x4 acc[5];
#pragma unroll
  for (int v = 0; v < 5; ++v) acc[v] = f32x4{0.f, 0.f, 0.f, 0.f};
#pragma unroll 8
  for (int k = kk; k < 2048; k += 16) {
    float4 w = *reinterpret_cast<const float4*>(W + (size_t)k * 6144);
#pragma unroll
    for (int v = 0; v < 5; ++v) {
      float s = sS[v * 2048 + k];
      acc[v][0] += s * w.x; acc[v][1] += s * w.y; acc[v][2] += s * w.z; acc[v][3] += s * w.w;
    }
  }
#pragma unroll
  for (int v = 0; v < 5; ++v)
#pragma unroll
    for (int q = 0; q < 4; ++q) red[(kk * 5 + v) * 64 + c4 + q] = acc[v][q];
  __syncthreads();
  for (int t2 = tid; t2 < 320; t2 += 256) {
    int v = t2 >> 6, n = t2 & 63;
    float s = 0.f;
#pragma unroll
    for (int k2 = 0; k2 < 16; ++k2) s += red[(k2 * 5 + v) * 64 + n];
    float* mod = reinterpret_cast<float*>(p.ws + WS_MOD);
    mod[(size_t)(l * 5 + v) * 6144 + n0 + n] = s + p.in[13 + 10 * l][n0 + n];
  }
  __syncthreads();
}

DI void phase_prep(const Params& p, unsigned char* lds) {
  constexpr int N_MOD = 384, N_TRWIN = 13312, N_TRWOUT = 4096, N_TRPOOL = 128, N_SGU = 64, N_CK = 4096, N_CV = 2048;
  constexpr int TOTAL = N_MOD + N_TRWIN + N_TRWOUT + N_TRPOOL + N_SGU + N_CK + N_CV + 1;
  const int tid = TIDX;
  float* sT = reinterpret_cast<float*>(lds);
  for (int it = VBID; it < TOTAL; it += VGRID) {
    int i = it;
    if (i < N_MOD) { mod_item(p, i, lds); continue; }
    i -= N_MOD;
    if (i < N_TRWIN) {
      int l, base;
      if (i < 3072) { l = 0; base = 0; } else if (i < 6656) { l = 1; base = 3072; } else if (i < 9728) { l = 2; base = 6656; } else { l = 3; base = 9728; }
      i -= base;
      const int N = (l & 1) ? 7168 : 6144, nN = N / 64;
      const int kt = i / nN, nt = i % nN;
      tr_tile(p.in[14 + 10 * l] + (size_t)kt * 64 * N + nt * 64, N,
              reinterpret_cast<u16*>(p.ws + ws_wint(l)) + (size_t)nt * 64 * 2048 + kt * 64, 2048, sT);
      continue;
    }
    i -= N_TRWIN;
    if (i < N_TRWOUT) {
      const int l = i >> 10, r = i & 1023, kt = r >> 5, nt = r & 31;
      tr_tile(p.in[15 + 10 * l] + (size_t)kt * 64 * 2048 + nt * 64, 2048,
              reinterpret_cast<u16*>(p.ws + WS_WOUTT) + (size_t)l * 2048 * 2048 + (size_t)nt * 64 * 2048 + kt * 64, 2048, sT);
      continue;
    }
    i -= N_TRWOUT;
    if (i < N_TRPOOL) {
      const int e = i >> 6, r = i & 63, g = r >> 4, t = r & 15, kt = t >> 2, nt = t & 3;
      tr_tile(p.in[18 + 20 * e] + (size_t)g * 65536 + kt * 64 * 256 + nt * 64, 256,
              reinterpret_cast<u16*>(p.ws + WS_POOLWT) + (size_t)e * 262144 + g * 65536 + nt * 64 * 256 + kt * 64, 256, sT);
      continue;
    }
    i -= N_TRPOOL;
    if (i < N_SGU) {
      const int e = i >> 5, ch = i & 31;
      const size_t off = (size_t)ch * 2048 + tid * 8;
      cvt8(p.in[30 + 20 * e] + off, reinterpret_cast<u16*>(p.ws + WS_SGUW) + (size_t)e * 65536 + off);
      continue;
    }
    i -= N_SGU;
    if (i < N_CK) {
      const int l = i >> 10, ch = i & 1023;
      const size_t off = (size_t)ch * 2048 + tid * 8;
      cvt8(p.in[2 + 2 * l] + off, reinterpret_cast<u16*>(p.ws + WS_CK) + (size_t)l * 2097152 + off);
      continue;
    }
    i -= N_CK;
    if (i < N_CV) {
      const int l = i >> 9, r = i & 511, bh = r >> 4, t = r & 15, kt = t >> 1, nt = t & 1;
      tr_tile(p.in[3 + 2 * l] + (size_t)bh * 65536 + kt * 64 * 128 + nt * 64, 128,
              reinterpret_cast<u16*>(p.ws + WS_CVT) + (size_t)l * 2097152 + (size_t)bh * 65536 + nt * 64 * 512 + kt * 64, 512, sT);
      continue;
    }
    {
      float* rc = reinterpret_cast<float*>(p.ws + WS_ROPE);
      for (int e = tid; e < 1024; e += 256) {
        int pos = e >> 4, fi = e & 15;
        float inv = 1.0f / powf(10000.0f, (float)(2 * fi) / 32.0f);
        float ang = (float)pos * inv;
        rc[e] = cosf(ang);
        rc[1024 + e] = sinf(ang);
      }
    }
  }
}

DI void phase_mod0(const Params& p) {
  const int tid = TIDX;
  const float* mod = reinterpret_cast<const float*>(p.ws + WS_MOD);
  u16* H = reinterpret_cast<u16*>(p.ws + WS_H);
  for (int it = VBID; it < T_ALL / 4; it += VGRID) {
#pragma unroll
    for (int rr = 0; rr < 4; ++rr) {
      const int row = it * 4 + rr;
      const int cond = row < TP ? 0 : 1 + ((row - TP) >> 12);
      const float* src = row < TP ? p.in[0] + (size_t)row * 2048 : p.in[1] + (size_t)(row - TP) * 2048;
      const int e = tid * 8;
      const float* sh = mod + (size_t)cond * 6144 + e;
      float4 a = *reinterpret_cast<const float4*>(src + e), b = *reinterpret_cast<const float4*>(src + e + 4);
      float4 s0 = *reinterpret_cast<const float4*>(sh), s1 = *reinterpret_cast<const float4*>(sh + 4);
      float4 c0 = *reinterpret_cast<const float4*>(sh + 2048), c1 = *reinterpret_cast<const float4*>(sh + 2052);
      u32x4 o = {pk2(a.x * (1.f + c0.x) + s0.x, a.y * (1.f + c0.y) + s0.y), pk2(a.z * (1.f + c0.z) + s0.z, a.w * (1.f + c0.w) + s0.w),
                 pk2(b.x * (1.f + c1.x) + s1.x, b.y * (1.f + c1.y) + s1.y), pk2(b.z * (1.f + c1.z) + s1.z, b.w * (1.f + c1.w) + s1.w)};
      *reinterpret_cast<u32x4*>(H + (size_t)row * 2048 + e) = o;
    }
  }
}


template <int MODE>
struct EpiIn {
  static constexpr bool PERM = false, AFTER_DRAIN = false;
  u16* PROJ; u16* VT; float* kout; float* vout; const float* ropeC; const float* ropeS;
  DI void operator()(const f32x4 (&acc)[2][2][4][2], const pg8::Unit& u, int wr, int wc, int fr, int fq) const {
    constexpr int NC = (MODE == G_IN_EVEN) ? 6144 : 7168;
    constexpr int SEC_Q = (MODE == G_IN_EVEN) ? 2 : 0, SEC_K = (MODE == G_IN_EVEN) ? 3 : 1, SEC_V = (MODE == G_IN_EVEN) ? 4 : 2;
    const int sec = u.pn >> 2;
    const bool prompt = u.pm < 32;
    const bool isq = sec == SEC_Q, isk = sec == SEC_K;
    const bool rope = (MODE == G_IN_EVEN) && (isq || isk) && !prompt;
    const float sc = isq ? ((MODE == G_IN_EVEN) ? 0.125f * LOG2E : 0.08838834764831845f * LOG2E) : 1.0f;
#pragma unroll
    for (int ai = 0; ai < 2; ++ai)
#pragma unroll
      for (int m = 0; m < 4; ++m) {
        const int row = u.pm * 256 + ai * 128 + wr * 64 + m * 16 + fr;
        int b, t;
        if (prompt) { b = row >> 8; t = row & 255; } else { const int rs = row - TP; b = rs >> 12; t = rs & 4095; }
#pragma unroll
        for (int bj = 0; bj < 2; ++bj) {
          const int hh = (u.pn & 3) * 2 + bj;
          const int d0 = wc * 32 + 4 * fq;
          if (sec == SEC_V) {
#pragma unroll
            for (int n = 0; n < 2; ++n) {
              const f32x4 v = acc[ai][bj][m][n];
              const int dv = d0 + 16 * n;
              const u32 w01 = pk2(v[0], v[1]), w23 = pk2(v[2], v[3]);
              if (prompt) {
                u16* vt = VT + ((size_t)((b * 8 + hh) * 128 + dv)) * 256 + t;
                vt[0] = (u16)(w01 & 0xffffu); vt[256] = (u16)(w01 >> 16); vt[512] = (u16)(w23 & 0xffffu); vt[768] = (u16)(w23 >> 16);
                *reinterpret_cast<float4*>(vout + ((size_t)((b * 8 + hh) * 256 + t)) * 128 + dv) = float4{v[0], v[1], v[2], v[3]};
              } else {
                u16* vt = VT + 8388608 + ((size_t)((b * 8 + hh) * 128 + dv)) * 4096 + t;
                vt[0] = (u16)(w01 & 0xffffu); vt[4096] = (u16)(w01 >> 16); vt[8192] = (u16)(w23 & 0xffffu); vt[12288] = (u16)(w23 >> 16);
              }
            }
          } else {
            f32x4 v0 = acc[ai][bj][m][0], v1 = acc[ai][bj][m][1];
            if (isk && prompt) {
              float* ko = kout + ((size_t)((b * 8 + hh) * 256 + t)) * 128 + d0;
              *reinterpret_cast<float4*>(ko) = float4{v0[0], v0[1], v0[2], v0[3]};
              *reinterpret_cast<float4*>(ko + 16) = float4{v1[0], v1[1], v1[2], v1[3]};
            }
            if (rope) {
              const int pos = (wc & 1) ? (t & 63) : (t >> 6);
              const float4 cs = *reinterpret_cast<const float4*>(ropeC + pos * 16 + 4 * fq);
              const float4 sn = *reinterpret_cast<const float4*>(ropeS + pos * 16 + 4 * fq);
              const float c4[4] = {cs.x, cs.y, cs.z, cs.w}, s4[4] = {sn.x, sn.y, sn.z, sn.w};
#pragma unroll
              for (int j = 0; j < 4; ++j) {
                const float x1 = v0[j], x2 = v1[j];
                v0[j] = x1 * c4[j] - x2 * s4[j];
                v1[j] = x1 * s4[j] + x2 * c4[j];
              }
            }
            u16* dst = PROJ + (size_t)row * NC + u.pn * 256 + bj * 128 + d0;
            *reinterpret_cast<u32x2*>(dst) = u32x2{pk2(v0[0] * sc, v0[1] * sc), pk2(v0[2] * sc, v0[3] * sc)};
            *reinterpret_cast<u32x2*>(dst + 16) = u32x2{pk2(v1[0] * sc, v1[1] * sc), pk2(v1[2] * sc, v1[3] * sc)};
          }
        }
      }
  }
};

struct EpiOut {
  static constexpr bool PERM = false, AFTER_DRAIN = false;
  float* X; const float* x0; const float* x1; const float* mod; const float* lng; const float* lnb; const float2* stats; int l;
  DI void operator()(const f32x4 (&acc)[2][2][4][2], const pg8::Unit& u, int wr, int wc, int fr, int fq) const {
    const bool prompt = u.pm < 32;
    const int cond = prompt ? 0 : 1 + ((u.pm * 256 - TP) >> 12);
    const float* gate = mod + (size_t)(l * 5 + cond) * 6144 + 4096;
#pragma unroll
    for (int bj = 0; bj < 2; ++bj)
#pragma unroll
      for (int n = 0; n < 2; ++n) {
        const int col = u.pn * 256 + bj * 128 + wc * 32 + 16 * n + 4 * fq;
        const float4 g4 = *reinterpret_cast<const float4*>(gate + col);
        float4 lg = float4{1.f, 1.f, 1.f, 1.f}, lb = float4{0.f, 0.f, 0.f, 0.f};
        if (l != 0) { lg = *reinterpret_cast<const float4*>(lng + col); lb = *reinterpret_cast<const float4*>(lnb + col); }
#pragma unroll
        for (int ai = 0; ai < 2; ++ai)
#pragma unroll
          for (int m = 0; m < 4; ++m) {
            const int row = u.pm * 256 + ai * 128 + wr * 64 + m * 16 + fr;
            float4 xo;
            if (l == 0) xo = prompt ? *reinterpret_cast<const float4*>(x0 + (size_t)row * 2048 + col)
                                    : *reinterpret_cast<const float4*>(x1 + (size_t)(row - TP) * 2048 + col);
            else {
              const float4 z = *reinterpret_cast<const float4*>(X + (size_t)row * 2048 + col);
              const float2 st = stats[row];
              xo.x = (z.x - st.x) * st.y * lg.x + lb.x; xo.y = (z.y - st.x) * st.y * lg.y + lb.y;
              xo.z = (z.z - st.x) * st.y * lg.z + lb.z; xo.w = (z.w - st.x) * st.y * lg.w + lb.w;
            }
            const f32x4 a = acc[ai][bj][m][n];
            float4 o;
            o.x = ALPHA * xo.x + g4.x * a[0]; o.y = ALPHA * xo.y + g4.y * a[1];
            o.z = ALPHA * xo.z + g4.z * a[2]; o.w = ALPHA * xo.w + g4.w * a[3];
            *reinterpret_cast<float4*>(X + (size_t)row * 2048 + col) = o;
          }
      }
  }
};

template <int MODE>
DI void gemm_phase(const Params& p, int l, unsigned char* lds) {
  constexpr int N = (MODE == G_OUT) ? 2048 : (MODE == G_IN_EVEN ? 6144 : 7168);
  pg8::Gemm g;
  g.A = reinterpret_cast<const u16*>(p.ws + WS_H);
  g.Bt = (MODE == G_OUT) ? reinterpret_cast<const u16*>(p.ws + WS_WOUTT) + (size_t)l * 2048 * 2048
                         : reinterpret_cast<const u16*>(p.ws + ws_wint(l));
  g.M = T_ALL; g.N = N; g.K = 2048;
  pg8::StaticOrder S;
  S.init(T_ALL, N, (int)gridDim.x, (int)blockIdx.x);
  PG8_LAS unsigned char* l3 = (PG8_LAS unsigned char*)lds;
  if constexpr (MODE == G_OUT) {
    EpiOut E;
    E.X = p.out; E.x0 = p.in[0]; E.x1 = p.in[1]; E.mod = reinterpret_cast<const float*>(p.ws + WS_MOD); E.l = l;
    E.lng = p.in[16 + 10 * (l > 0 ? l - 1 : 0)]; E.lnb = p.in[17 + 10 * (l > 0 ? l - 1 : 0)];
    E.stats = reinterpret_cast<const float2*>(p.ws + WS_STATS);
    pg8::gemm_phase<EpiOut, pg8::StaticOrder, false>(l3, g, S, E, nullptr);
  } else {
    EpiIn<MODE> E;
    E.PROJ = reinterpret_cast<u16*>(p.ws + WS_PROJ); E.VT = reinterpret_cast<u16*>(p.ws + WS_VT);
    E.kout = p.out + (size_t)T_ALL * 2048 + (size_t)(2 * l) * 8388608;
    E.vout = p.out + (size_t)T_ALL * 2048 + (size_t)(2 * l + 1) * 8388608;
    E.ropeC = reinterpret_cast<const float*>(p.ws + WS_ROPE); E.ropeS = E.ropeC + 1024;
    pg8::gemm_phase<EpiIn<MODE>, pg8::StaticOrder, false>(l3, g, S, E, nullptr);
  }
}

DI void phase_ln(const Params& p, int l) {
  const int tid_ = TIDX, lane = tid_ & 63, wid = tid_ >> 6;
  const float* g = p.in[16 + 10 * l];
  const float* bb = p.in[17 + 10 * l];
  const float* mod = reinterpret_cast<const float*>(p.ws + WS_MOD);
  u16* H = reinterpret_cast<u16*>(p.ws + WS_H);
  float* X = p.out;
  for (int it = VBID; it < T_ALL / 4; it += VGRID) {
    const int row = it * 4 + wid;
    float* xr = X + (size_t)row * 2048;
    float4 v[8];
    float s = 0.f;
#pragma unroll
    for (int i = 0; i < 8; ++i) {
      v[i] = *reinterpret_cast<const float4*>(xr + (i * 64 + lane) * 4);
      s += v[i].x + v[i].y + v[i].z + v[i].w;
    }
#pragma unroll
    for (int o = 32; o >= 1; o >>= 1) s += __shfl_xor(s, o);
    const float mu = s * (1.f / 2048.f);
    float ss = 0.f;
#pragma unroll
    for (int i = 0; i < 8; ++i) {
      float a = v[i].x - mu, b = v[i].y - mu, c = v[i].z - mu, d = v[i].w - mu;
      ss += a * a + b * b + c * c + d * d;
    }
#pragma unroll
    for (int o = 32; o >= 1; o >>= 1) ss += __shfl_xor(ss, o);
    const float rstd = rsqrtf(ss * (1.f / 2048.f) + LN_EPS);
    if (lane == 0) *reinterpret_cast<float2*>(p.ws + WS_STATS + (size_t)row * 8) = float2{mu, rstd};
    const int cond = row < TP ? 0 : 1 + ((row - TP) >> 12);
    const float* sh = mod + (size_t)((l + 1) * 5 + cond) * 6144;
#pragma unroll
    for (int i = 0; i < 8; ++i) {
      const int e = (i * 64 + lane) * 4;
      float4 gg = *reinterpret_cast<const float4*>(g + e), b4 = *reinterpret_cast<const float4*>(bb + e);
      float4 y;
      y.x = (v[i].x - mu) * rstd * gg.x + b4.x; y.y = (v[i].y - mu) * rstd * gg.y + b4.y;
      y.z = (v[i].z - mu) * rstd * gg.z + b4.z; y.w = (v[i].w - mu) * rstd * gg.w + b4.w;
      if (l == 3) *reinterpret_cast<float4*>(xr + e) = y;
      if (l < 3) {
        float4 s0 = *reinterpret_cast<const float4*>(sh + e), c0 = *reinterpret_cast<const float4*>(sh + 2048 + e);
        u32x2 o = {pk2(y.x * (1.f + c0.x) + s0.x, y.y * (1.f + c0.y) + s0.y), pk2(y.z * (1.f + c0.z) + s0.z, y.w * (1.f + c0.w) + s0.w)};
        *reinterpret_cast<u32x2*>(H + (size_t)row * 2048 + e) = o;
      }
    }
  }
}

struct AttnSrc {
  const u16* k0; const u16* vt0; int ks0, vs0, n0;
  const u16* k1; const u16* vt1; int ks1, vs1, n1;
};

template <int DQK>
DI void attn_ldg(const AttnSrc& s, int j, u32x4 (&rk)[DQK / 64], u32x4 (&rv)[2]) {
  const u16* kb; const u16* vb; int ks, vs;
  if (j < s.n0) { kb = s.k0 + (size_t)j * 64 * s.ks0; vb = s.vt0 + j * 64; ks = s.ks0; vs = s.vs0; }
  else { const int jj = j - s.n0; kb = s.k1 + (size_t)jj * 64 * s.ks1; vb = s.vt1 + jj * 64; ks = s.ks1; vs = s.vs1; }
  constexpr int CPR = DQK / 8;
  const int tid = TID8;
#pragma unroll
  for (int i = 0; i < DQK / 64; ++i) {
    const int c = tid + 512 * i, row = c / CPR, kc = c % CPR;
    rk[i] = *reinterpret_cast<const u32x4*>(kb + (size_t)row * ks + kc * 8);
  }
#pragma unroll
  for (int i = 0; i < 2; ++i) {
    const int c = tid + 512 * i, row = c >> 3, kc = c & 7;
    rv[i] = *reinterpret_cast<const u32x4*>(vb + (size_t)row * vs + kc * 8);
  }
}
template <int DQK>
DI void attn_sts(u16* sK, u16* sVT, const u32x4 (&rk)[DQK / 64], const u32x4 (&rv)[2]) {
  constexpr int CPR = DQK / 8;
  const int tid = TID8;
#pragma unroll
  for (int i = 0; i < DQK / 64; ++i) {
    const int c = tid + 512 * i, row = c / CPR, kc = c % CPR;
    *reinterpret_cast<u32x4*>(sK + row * (DQK + 8) + kc * 8) = rk[i];
  }
#pragma unroll
  for (int i = 0; i < 2; ++i) {
    const int c = tid + 512 * i, row = c >> 3, kc = c & 7;
    *reinterpret_cast<u32x4*>(sVT + row * 72 + kc * 8) = rv[i];
  }
}

DI void attn_pv(const f32x16 (&s)[2], const u16* vw, f32x16 (&O)[4]) {
  __builtin_amdgcn_s_setprio(1);
#pragma unroll
  for (int s4 = 0; s4 < 4; ++s4) {
    const int t = s4 >> 1, b0 = (s4 & 1) * 8;
    u32x4 w = {pk2(s[t][b0], s[t][b0 + 1]), pk2(s[t][b0 + 2], s[t][b0 + 3]), pk2(s[t][b0 + 4], s[t][b0 + 5]), pk2(s[t][b0 + 6], s[t][b0 + 7])};
    const bf16x8 pf = __builtin_bit_cast(bf16x8, w);
#pragma unroll
    for (int d = 0; d < 4; ++d) {
      bf16x8 a = ld8(vw + d * 32 * 72 + s4 * 16);
      O[d] = mfma32(a, pf, O[d]);
    }
  }
  __builtin_amdgcn_s_setprio(0);
}

template <int DQK, bool NA>
DI void attn_run(const AttnSrc& src, const u16* qblk, int qstride, u16* sQ, u16* sK, u16* sVT, f32x16 (&O)[4], float& l_out,
                 int qr, int qc, int rsmin, const float* sBias) {
  const int tid = TID8, lane = tid & 63, wid = tid >> 6;
  const int r = lane & 31, h = lane >> 5;
  const int pr = (r & 0x13) | ((r & 4) << 1) | ((r & 8) >> 1);
  constexpr int CPR = DQK / 8, QS = DQK + 8;
  __syncthreads();
  constexpr bool QREG = (DQK == 64);
  bf16x8 qf[QREG ? DQK / 16 : 1];
  if constexpr (QREG) {
#pragma unroll
    for (int ks = 0; ks < DQK / 16; ++ks) qf[ks] = ld8(qblk + (size_t)(wid * 32 + r) * qstride + ks * 16 + 8 * h);
  } else {
#pragma unroll
    for (int i = 0; i < DQK / 16; ++i) {
      const int c = tid + 512 * i, row = c / CPR, kc = c % CPR;
      *reinterpret_cast<u32x4*>(sQ + row * QS + kc * 8) = *reinterpret_cast<const u32x4*>(qblk + (size_t)row * qstride + kc * 8);
    }
  }
#pragma unroll
  for (int d = 0; d < 4; ++d)
#pragma unroll
    for (int i = 0; i < 16; ++i) O[d][i] = 0.f;
  float m = -1e30f, l = 0.f;
  const int nt = src.n0 + src.n1;
  const int rsq = min(max(qr - 4, 0), 56);
  const int cs = min(max(qc - 8, 0), 48);
  const u16* qw = sQ + (wid * 32 + r) * QS + 8 * h;
  const u16* kw = sK + pr * QS + 8 * h;
  u16* sVT1 = sVT + 128 * 72 + 2048;
  const bool grpB = wid >= 4;
  bool pend = false;
  f32x16 s[2];
  u32x4 rk[DQK / 64], rv[2];
  attn_ldg<DQK>(src, 0, rk, rv);
#pragma unroll 1
  for (int j = 0; j < nt; ++j) {
    if (j > 0) __syncthreads();
    u16* vcur = (j & 1) ? sVT1 : sVT;
    attn_sts<DQK>(sK, vcur, rk, rv);
    __syncthreads();
    if (j + 1 < nt) attn_ldg<DQK>(src, j + 1, rk, rv);
    __builtin_amdgcn_sched_barrier(0);
    if (grpB && pend) { attn_pv(s, ((j & 1) ? sVT : sVT1) + r * 72 + 8 * h, O); pend = false; }
    bool active = true;
    int kr = 0;
    if (NA && j >= src.n0) { kr = rsmin + (j - src.n0); active = (kr >= rsq) && (kr < rsq + 8); }
    if (active) {
      __builtin_amdgcn_s_setprio(1);
#pragma unroll
      for (int t = 0; t < 2; ++t) {
#pragma unroll
        for (int i = 0; i < 16; ++i) s[t][i] = 0.f;
#pragma unroll
        for (int ks = 0; ks < DQK / 16; ++ks) {
          bf16x8 a = ld8(kw + t * 32 * QS + ks * 16);
          bf16x8 q;
          if constexpr (QREG) q = qf[ks]; else q = ld8(qw + ks * 16);
          s[t] = mfma32(a, q, s[t]);
        }
      }
      __builtin_amdgcn_s_setprio(0);
      if (NA && j >= src.n0) {
        const float* bp = sBias + (kr - qr + 7) * 31 + (8 * h - qc + 15);
        const int kb = 8 * h - cs;
#pragma unroll
        for (int t = 0; t < 2; ++t)
#pragma unroll
          for (int i = 0; i < 16; ++i) {
            const int ko = t * 32 + 16 * (i >> 3) + (i & 7);
            const bool ok = (unsigned)(ko + kb) < 16u;
            const float bv = bp[ko];
            s[t][i] = ok ? s[t][i] + bv : -1e30f;
          }
      }
      float mx = -1e30f;
#pragma unroll
      for (int t = 0; t < 2; ++t)
#pragma unroll
        for (int i = 0; i < 16; ++i) mx = fmaxf(mx, s[t][i]);
      if (__builtin_amdgcn_ballot_w64(mx > m + 8.0f) != 0ull) {
        mx = fmaxf(mx, __shfl_xor(mx, 32));
        const float mn = fmaxf(m, mx);
        const float alpha = ex2(m - mn);
        l *= alpha;
        m = mn;
#pragma unroll
        for (int d = 0; d < 4; ++d)
#pragma unroll
          for (int i = 0; i < 16; ++i) O[d][i] *= alpha;
      }
      float rsum = 0.f;
#pragma unroll
      for (int t = 0; t < 2; ++t)
#pragma unroll
        for (int i = 0; i < 16; ++i) { const float e = ex2(s[t][i] - m); s[t][i] = e; rsum += e; }
      l += rsum;
      if (!grpB) attn_pv(s, vcur + r * 72 + 8 * h, O);
      else pend = true;
    }
  }
  if (grpB && pend) attn_pv(s, (((nt - 1) & 1) ? sVT1 : sVT) + r * 72 + 8 * h, O);
  l_out = l + __shfl_xor(l, 32);
}

DI void heavy_map(int it, int& bh, int& qb) { const int x = it & 7, rest = it >> 3; qb = rest & 15; bh = x + 8 * (rest >> 4); }

DI void diff_item(const Params& p, int l, bool sample, int bh, int qb, unsigned char* lds) {
  constexpr int NC = 6144;
  const int tid_ = TID8, lane = tid_ & 63, wid = tid_ >> 6, r = lane & 31, h = lane >> 5;
  const int b = bh >> 3, hd = bh & 7;
  u16* sQ = reinterpret_cast<u16*>(lds);
  u16* sK = sQ + 256 * 136;
  u16* sVT = sK + 64 * 136;
  const u16* PROJ = reinterpret_cast<const u16*>(p.ws + WS_PROJ);
  const u16* VT = reinterpret_cast<const u16*>(p.ws + WS_VT);
  const int seq0 = sample ? TP + b * 4096 : b * 256;
  const int token = seq0 + qb * 256 + wid * 32 + r;
  const float* dl = p.in[20 + 10 * l];
  float pa = dl[lane] * dl[64 + lane], pb = dl[128 + lane] * dl[192 + lane];
#pragma unroll
  for (int o = 32; o >= 1; o >>= 1) { pa += __shfl_xor(pa, o); pb += __shfl_xor(pb, o); }
  const float lam_init = 0.8f - 0.6f * __expf(-0.3f * (float)l);
  const float lam = __expf(pa) - __expf(pb) + lam_init;

  u32 o1p[32];
  f32x16 O[4];
  float lsum;
#pragma unroll
  for (int comp = 0; comp < 2; ++comp) {
    AttnSrc s;
    if (sample) {
      s.k0 = reinterpret_cast<const u16*>(p.ws + WS_CK) + (size_t)l * 2097152 + (size_t)bh * 65536 + comp * 64; s.ks0 = 128;
      s.vt0 = reinterpret_cast<const u16*>(p.ws + WS_CVT) + (size_t)l * 2097152 + (size_t)bh * 65536; s.vs0 = 512; s.n0 = 8;
      s.k1 = PROJ + (size_t)seq0 * NC + 3072 + hd * 128 + comp * 64; s.ks1 = NC;
      s.vt1 = VT + 8388608 + (size_t)bh * 128 * 4096; s.vs1 = 4096; s.n1 = 64;
    } else {
      s.k0 = nullptr; s.vt0 = nullptr; s.ks0 = 0; s.vs0 = 0; s.n0 = 0;
      s.k1 = PROJ + (size_t)seq0 * NC + 3072 + hd * 128 + comp * 64; s.ks1 = NC;
      s.vt1 = VT + (size_t)bh * 128 * 256; s.vs1 = 256; s.n1 = 4;
    }
    const u16* qblk = PROJ + (size_t)(seq0 + qb * 256) * NC + 2048 + hd * 128 + comp * 64;
    attn_run<64, false>(s, qblk, NC, sQ, sK, sVT, O, lsum, 0, 0, 0, nullptr);
    const float inv = 1.f / lsum;
    if (comp == 0) {
#pragma unroll
      for (int d = 0; d < 4; ++d)
#pragma unroll
        for (int i = 0; i < 8; ++i) o1p[d * 8 + i] = pk2(O[d][2 * i] * inv, O[d][2 * i + 1] * inv);
    } else {
      float ssq = 0.f;
#pragma unroll
      for (int d = 0; d < 4; ++d)
#pragma unroll
        for (int i = 0; i < 8; ++i) {
          const u32 w = o1p[d * 8 + i];
          const float a = bflo(w) - lam * O[d][2 * i] * inv, c = bfhi(w) - lam * O[d][2 * i + 1] * inv;
          O[d][2 * i] = a; O[d][2 * i + 1] = c;
          ssq += a * a + c * c;
        }
      ssq += __shfl_xor(ssq, 32);
      const float rn = rsqrtf(ssq * (1.f / 128.f) + LN_EPS) * (1.f - lam_init);
      const float* subln = p.in[21 + 10 * l];
      const u16* gp = PROJ + (size_t)token * NC + 5120 + hd * 128;
      u16* yp = reinterpret_cast<u16*>(p.ws + WS_H) + (size_t)token * 2048 + 1024 + hd * 128;
#pragma unroll
      for (int d = 0; d < 4; ++d)
#pragma unroll
        for (int q = 0; q < 4; ++q) {
          const int dv = d * 32 + 8 * q + 4 * h;
          const u32x2 gw = *reinterpret_cast<const u32x2*>(gp + dv);
          const float4 sl = *reinterpret_cast<const float4*>(subln + dv);
          const float y0 = O[d][4 * q] * rn * sl.x * silu(bflo(gw[0]));
          const float y1 = O[d][4 * q + 1] * rn * sl.y * silu(bfhi(gw[0]));
          const float y2 = O[d][4 * q + 2] * rn * sl.z * silu(bflo(gw[1]));
          const float y3 = O[d][4 * q + 3] * rn * sl.w * silu(bfhi(gw[1]));
          *reinterpret_cast<u32x2*>(yp + dv) = (ZERO_MASK & 2) ? u32x2{0u, 0u} : u32x2{pk2(y0, y1), pk2(y2, y3)};
        }
    }
  }
}

DI void pool_item(const Params& p, int l, int pi, unsigned char* lds) {
  constexpr int NC = 6144;
  const int tid = TIDX, lane = tid & 63, wid = tid >> 6, fr = lane & 15, fq = lane >> 4;
  const int tb = pi >> 2, g = pi & 3, row0 = tb * 64;
  const int L = row0 < TP ? 256 : 4096;
  const int t0 = row0 < TP ? (row0 & 255) : ((row0 - TP) & 4095);
  u16* sIn = reinterpret_cast<u16*>(lds);
  u16* sP = sIn + 80 * 264;
  const u16* PROJ = reinterpret_cast<const u16*>(p.ws + WS_PROJ);
  __syncthreads();
#pragma unroll
  for (int i = 0; i < 10; ++i) {
    const int c = tid + 256 * i, rr = c >> 5, oc = c & 31;
    const int t = t0 - 8 + rr;
    u32x4 v = {0u, 0u, 0u, 0u};
    if (t >= 0 && t < L) v = *reinterpret_cast<const u32x4*>(PROJ + (size_t)(row0 - 8 + rr) * NC + g * 256 + oc * 8);
    *reinterpret_cast<u32x4*>(sIn + rr * 264 + oc * 8) = v;
  }
  __syncthreads();
  {
    const int oc = tid & 31, seg = tid >> 5;
    const int half = 1 << g;
#pragma unroll 1
    for (int tt = 0; tt < 8; ++tt) {
      const int tl = seg * 8 + tt, t = t0 + tl;
      const int lo = max(t - half, 0), hi = min(t + half, L);
      float a[8];
#pragma unroll
      for (int k = 0; k < 8; ++k) a[k] = 0.f;
      for (int s = lo; s < hi; ++s) {
        const u32x4 v = *reinterpret_cast<const u32x4*>(sIn + (s - t0 + 8) * 264 + oc * 8);
#pragma unroll
        for (int k = 0; k < 4; ++k) { a[2 * k] += bflo(v[k]); a[2 * k + 1] += bfhi(v[k]); }
      }
      const float ic = 1.f / (float)(hi - lo);
      const u32x4 x = *reinterpret_cast<const u32x4*>(sIn + (tl + 8) * 264 + oc * 8);
      u32x4 o;
#pragma unroll
      for (int k = 0; k < 4; ++k) o[k] = pk2(a[2 * k] * ic - bflo(x[k]), a[2 * k + 1] * ic - bfhi(x[k]));
      *reinterpret_cast<u32x4*>(sP + tl * 264 + oc * 8) = o;
    }
  }
  __syncthreads();
  const u16* W = reinterpret_cast<const u16*>(p.ws + WS_POOLWT) + (size_t)(l >> 1) * 262144 + (size_t)g * 65536;
  f32x4 acc[4][4];
#pragma unroll
  for (int a = 0; a < 4; ++a)
#pragma unroll
    for (int b = 0; b < 4; ++b) acc[a][b] = f32x4{0.f, 0.f, 0.f, 0.f};
#pragma unroll 2
  for (int ks = 0; ks < 8; ++ks) {
    bf16x8 af[4], bfr[4];
#pragma unroll
    for (int m = 0; m < 4; ++m) af[m] = ld8(sP + (m * 16 + fr) * 264 + ks * 32 + fq * 8);
#pragma unroll
    for (int n = 0; n < 4; ++n) bfr[n] = ld8(W + (size_t)(wid * 64 + n * 16 + fr) * 256 + ks * 32 + fq * 8);
#pragma unroll
    for (int m = 0; m < 4; ++m)
#pragma unroll
      for (int n = 0; n < 4; ++n) acc[m][n] = mfma16(bfr[n], af[m], acc[m][n]);
  }
  const float* pscale = p.in[19 + 10 * l];
  u16* Y = reinterpret_cast<u16*>(p.ws + WS_H);
#pragma unroll
  for (int n = 0; n < 4; ++n) {
    const int col = g * 256 + wid * 64 + n * 16 + 4 * fq;
    const float4 sc = *reinterpret_cast<const float4*>(pscale + col);
#pragma unroll
    for (int m = 0; m < 4; ++m) {
      const int row = row0 + m * 16 + fr;
      const u32x2 gw = *reinterpret_cast<const u32x2*>(PROJ + (size_t)row * NC + 1024 + col);
      float y0 = acc[m][n][0] * sc.x * silu(bflo(gw[0])), y1 = acc[m][n][1] * sc.y * silu(bfhi(gw[0]));
      float y2 = acc[m][n][2] * sc.z * silu(bflo(gw[1])), y3 = acc[m][n][3] * sc.w * silu(bfhi(gw[1]));
      if (ZERO_MASK & 1) { y0 = y1 = y2 = y3 = 0.f; }
      *reinterpret_cast<u32x2*>(Y + (size_t)row * 2048 + col) = u32x2{pk2(y0, y1), pk2(y2, y3)};
    }
  }
}

DI void phase_mix_even(const Params& p, int l, unsigned char* lds, unsigned char* lds_all) {
#pragma unroll 1
  for (int it = blockIdx.x; it < 512; it += gridDim.x) { int bh, qb; heavy_map(it, bh, qb); diff_item(p, l, true, bh, qb, lds_all); }
#pragma unroll 1
  for (int it = blockIdx.x; it < 256; it += gridDim.x) diff_item(p, l, false, it, 0, lds_all);
#pragma unroll 1
  for (int it = VBID; it < 1536; it += VGRID) pool_item(p, l, it, lds);
}

DI void na_item(const Params& p, int l, bool sample, int bh, int qb, unsigned char* lds) {
  constexpr int NC = 7168;
  const int tid = TID8, lane = tid & 63, wid = tid >> 6, r = lane & 31, h = lane >> 5;
  const int b = bh >> 3, hd = bh & 7;
  u16* sQ = reinterpret_cast<u16*>(lds);
  u16* sK = sQ + 256 * 136;
  u16* sVT = sK + 64 * 136;
  float* sBias = reinterpret_cast<float*>(sVT + 128 * 72) + 64;
  const u16* PROJ = reinterpret_cast<const u16*>(p.ws + WS_PROJ);
  const u16* VT = reinterpret_cast<const u16*>(p.ws + WS_VT);
  const int seq0 = sample ? TP + b * 4096 : b * 256;
  const int token = seq0 + qb * 256 + wid * 32 + r;
  AttnSrc s;
  int qr = 0, qc = 0, rsmin = 0;
  f32x16 O[4];
  float lsum;
  const u16* qblk = PROJ + (size_t)(seq0 + qb * 256) * NC + hd * 128;
  if (sample) {
    __syncthreads();
    const float* rpb = p.in[18 + 10 * l] + hd * 465;
    for (int e = tid; e < 465; e += 512) sBias[e] = rpb[e] * LOG2E;
    const int r0 = qb * 4;
    qr = r0 + (wid >> 1); qc = (wid & 1) * 32 + r;
    rsmin = min(max(r0 - 4, 0), 56);
    const int rs1 = min(max(r0 - 1, 0), 56);
    s.k0 = reinterpret_cast<const u16*>(p.ws + WS_CK) + (size_t)l * 2097152 + (size_t)bh * 65536; s.ks0 = 128;
    s.vt0 = reinterpret_cast<const u16*>(p.ws + WS_CVT) + (size_t)l * 2097152 + (size_t)bh * 65536; s.vs0 = 512; s.n0 = 8;
    s.k1 = PROJ + (size_t)(seq0 + rsmin * 64) * NC + 1024 + hd * 128; s.ks1 = NC;
    s.vt1 = VT + 8388608 + (size_t)bh * 128 * 4096 + rsmin * 64; s.vs1 = 4096; s.n1 = rs1 + 8 - rsmin;
    attn_run<128, true>(s, qblk, NC, sQ, sK, sVT, O, lsum, qr, qc, rsmin, sBias);
  } else {
    s.k0 = nullptr; s.vt0 = nullptr; s.ks0 = 0; s.vs0 = 0; s.n0 = 0;
    s.k1 = PROJ + (size_t)seq0 * NC + 1024 + hd * 128; s.ks1 = NC;
    s.vt1 = VT + (size_t)bh * 128 * 256; s.vs1 = 256; s.n1 = 4;
    attn_run<128, false>(s, qblk, NC, sQ, sK, sVT, O, lsum, 0, 0, 0, nullptr);
  }
  const float inv = 1.f / lsum;
  const u16* gp = PROJ + (size_t)token * NC + 3072 + hd * 128;
  u16* yp = reinterpret_cast<u16*>(p.ws + WS_H) + (size_t)token * 2048 + hd * 128;
#pragma unroll
  for (int d = 0; d < 4; ++d)
#pragma unroll
    for (int q = 0; q < 4; ++q) {
      const int dv = d * 32 + 8 * q + 4 * h;
      const u32x2 gw = *reinterpret_cast<const u32x2*>(gp + dv);
      const float y0 = O[d][4 * q] * inv * silu(bflo(gw[0]));
      const float y1 = O[d][4 * q + 1] * inv * silu(bfhi(gw[0]));
      const float y2 = O[d][4 * q + 2] * inv * silu(bflo(gw[1]));
      const float y3 = O[d][4 * q + 3] * inv * silu(bfhi(gw[1]));
      *reinterpret_cast<u32x2*>(yp + dv) = (ZERO_MASK & 4) ? u32x2{0u, 0u} : u32x2{pk2(y0, y1), pk2(y2, y3)};
    }
}

DI void sgu_item(const Params& p, int l, int si, unsigned char* lds) {
  constexpr int NC = 7168;
  const int tid = TIDX, lane = tid & 63, wid = tid >> 6, fr = lane & 15, fq = lane >> 4;
  const int ch = si >> 2, g = si & 3, row0 = ch * 128;
  u16* vnT = reinterpret_cast<u16*>(lds);
  float* sMu = reinterpret_cast<float*>(vnT + 256 * 136);
  float* sRs = sMu + 128;
  const u16* PROJ = reinterpret_cast<const u16*>(p.ws + WS_PROJ);
  __syncthreads();
  {
    const int grp = tid >> 4, ln = tid & 15;
#pragma unroll 2
    for (int rr = 0; rr < 8; ++rr) {
      const u16* src = PROJ + (size_t)(row0 + grp * 8 + rr) * NC + 5120;
      float s = 0.f, ss = 0.f;
#pragma unroll
      for (int c8 = 0; c8 < 8; ++c8) {
        const u32x4 v = *reinterpret_cast<const u32x4*>(src + (ln + 16 * c8) * 8);
#pragma unroll
        for (int k = 0; k < 4; ++k) { const float a = bflo(v[k]), b = bfhi(v[k]); s += a + b; ss += a * a + b * b; }
      }
#pragma unroll
      for (int o = 8; o >= 1; o >>= 1) { s += __shfl_xor(s, o); ss += __shfl_xor(ss, o); }
      const float mu = s * (1.f / 1024.f);
      const float var = fmaxf(ss * (1.f / 1024.f) - mu * mu, 0.f);
      if (ln == 0) { sMu[grp * 8 + rr] = mu; sRs[grp * 8 + rr] = rsqrtf(var + LN_EPS); }
    }
  }
  __syncthreads();
  {
    const int j = tid & 127, hf = tid >> 7;
    const float mu = sMu[j], rs = sRs[j];
    const float* lng = p.in[19 + 10 * l] + g * 256;
    const u16* src = PROJ + (size_t)(row0 + j) * NC + 5120 + g * 256;
#pragma unroll 4
    for (int oc = hf * 16; oc < hf * 16 + 16; ++oc) {
      const u32x4 v = *reinterpret_cast<const u32x4*>(src + oc * 8);
      const float4 g0 = *reinterpret_cast<const float4*>(lng + oc * 8), g1 = *reinterpret_cast<const float4*>(lng + oc * 8 + 4);
      const float gg[8] = {g0.x, g0.y, g0.z, g0.w, g1.x, g1.y, g1.z, g1.w};
#pragma unroll
      for (int k = 0; k < 4; ++k) {
        const float a = (bflo(v[k]) - mu) * rs * gg[2 * k], b = (bfhi(v[k]) - mu) * rs * gg[2 * k + 1];
        const u32 w = pk2(a, b);
        vnT[(oc * 8 + 2 * k) * 136 + j] = (u16)(w & 0xffffu);
        vnT[(oc * 8 + 2 * k + 1) * 136 + j] = (u16)(w >> 16);
      }
    }
  }
  __syncthreads();
  const u16* W = reinterpret_cast<const u16*>(p.ws + WS_SGUW) + (size_t)(l >> 1) * 65536 + (size_t)g * 16384;
  const float* bs = p.in[21 + 10 * l] + g * 128;
  u16* Y = reinterpret_cast<u16*>(p.ws + WS_H);
#pragma unroll 1
  for (int ih = 0; ih < 2; ++ih) {
    f32x4 acc[4][4];
#pragma unroll
    for (int a = 0; a < 4; ++a)
#pragma unroll
      for (int b = 0; b < 4; ++b) acc[a][b] = f32x4{0.f, 0.f, 0.f, 0.f};
#pragma unroll
    for (int ks = 0; ks < 4; ++ks) {
      bf16x8 af[4], bfr[4];
#pragma unroll
      for (int m = 0; m < 4; ++m) af[m] = ld8(W + (size_t)(ih * 64 + m * 16 + fr) * 128 + ks * 32 + fq * 8);
#pragma unroll
      for (int n = 0; n < 4; ++n) bfr[n] = ld8(vnT + (wid * 64 + n * 16 + fr) * 136 + ks * 32 + fq * 8);
#pragma unroll
      for (int m = 0; m < 4; ++m)
#pragma unroll
        for (int n = 0; n < 4; ++n) acc[m][n] = mfma16(bfr[n], af[m], acc[m][n]);
    }
#pragma unroll
    for (int m = 0; m < 4; ++m) {
      const int ii = ih * 64 + m * 16 + fr;
      const float bias = bs[ii];
      const size_t rb = (size_t)(row0 + ii) * NC;
#pragma unroll
      for (int n = 0; n < 4; ++n) {
        const int c = g * 256 + wid * 64 + n * 16 + 4 * fq;
        const u32x2 uw = *reinterpret_cast<const u32x2*>(PROJ + rb + 4096 + c);
        const u32x2 dw = *reinterpret_cast<const u32x2*>(PROJ + rb + 6144 + c);
        float y0 = bflo(uw[0]) * (acc[m][n][0] + bias) * silu(bflo(dw[0])), y1 = bfhi(uw[0]) * (acc[m][n][1] + bias) * silu(bfhi(dw[0]));
        float y2 = bflo(uw[1]) * (acc[m][n][2] + bias) * silu(bflo(dw[1])), y3 = bfhi(uw[1]) * (acc[m][n][3] + bias) * silu(bfhi(dw[1]));
        if (ZERO_MASK & 8) { y0 = y1 = y2 = y3 = 0.f; }
        *reinterpret_cast<u32x2*>(Y + (size_t)(row0 + ii) * 2048 + 1024 + c) = u32x2{pk2(y0, y1), pk2(y2, y3)};
      }
    }
  }
}

DI void phase_mix_odd(const Params& p, int l, unsigned char* lds, unsigned char* lds_all) {
#pragma unroll 1
  for (int it = blockIdx.x; it < 512; it += gridDim.x) { int bh, qb; heavy_map(it, bh, qb); na_item(p, l, true, bh, qb, lds_all); }
#pragma unroll 1
  for (int it = blockIdx.x; it < 256; it += gridDim.x) na_item(p, l, false, it, 0, lds_all);
#pragma unroll 1
  for (int it = VBID; it < 768; it += VGRID) sgu_item(p, l, it, lds);
}

#define XB_TMO      128
#define XB_XCNT(j)  (256  + 64 * (j))
#define XB_XSUB(j)  (1280 + 64 * (j))
#define XB_XGEN(j)  (2304 + 64 * (j))
#define XB_TOP      3328
#define XB_TOPGEN   3392
#define XCD_BAR_WORDS 3456
#define XB_SPIN_CAP (1u << 18)
#define LAS __attribute__((address_space(3)))
DI unsigned xb_ld(unsigned* p)              { return __hip_atomic_load(p, __ATOMIC_RELAXED, __HIP_MEMORY_SCOPE_AGENT); }
DI unsigned xb_add(unsigned* p, unsigned v) { return __hip_atomic_fetch_add(p, v, __ATOMIC_RELAXED, __HIP_MEMORY_SCOPE_AGENT); }
DI unsigned xb_xcc_id() { return (unsigned)__builtin_amdgcn_s_getreg((3 << 11) | 20) & 0xFu; }
#define XB_SPIN(cond, bar) do { unsigned _sp = 0; while (cond) { __builtin_amdgcn_s_sleep(1); \
    if ((++_sp & 255u) == 0u) { if (xb_ld(&(bar)[XB_TMO])) break; if (_sp > XB_SPIN_CAP) { atomicAdd(&(bar)[XB_TMO], 1u); break; } } } } while (0)
struct XcdBarrier { unsigned* bar; unsigned x; volatile LAS unsigned* st; };
DI XcdBarrier xcd_barrier_post(unsigned* bar, volatile LAS unsigned* st) {
  XcdBarrier b; b.bar = bar; b.x = xb_xcc_id(); b.st = st;
  if (threadIdx.x == 0) (void)xb_add(&bar[XB_XCNT(b.x)], 1u);
  return b;
}
DI void xcd_barrier_complete(unsigned* bar, unsigned x, unsigned& nloc, unsigned& nx) {
  const unsigned G = gridDim.x * gridDim.y * gridDim.z;
  unsigned sum, cnt, mine, sp = 0u;
  for (;;) {
    sum = 0u; cnt = 0u; mine = 0u;
#pragma unroll
    for (unsigned j = 0; j < 16; ++j) { const unsigned c = xb_ld(&bar[XB_XCNT(j)]); sum += c; cnt += (c > 0u) ? 1u : 0u; mine = (j == x) ? c : mine; }
    if (sum == G) break;
    __builtin_amdgcn_s_sleep(1);
    if ((++sp & 255u) == 0u) { if (xb_ld(&bar[XB_TMO])) break; if (sp > XB_SPIN_CAP) { atomicAdd(&bar[XB_TMO], 1u); break; } }
  }
  nloc = mine > 0u ? mine : 1u; nx = cnt > 0u ? cnt : 1u;
}
DI void xcd_barrier(const XcdBarrier& b) {
  asm volatile("s_waitcnt vmcnt(0)" ::: "memory");
  __syncthreads();
  if (threadIdx.x == 0) {
    unsigned* bar = b.bar;
    __builtin_amdgcn_s_waitcnt(0);
    unsigned nloc = b.st[0], nx = b.st[1];
    if (nloc == 0u) { xcd_barrier_complete(bar, b.x, nloc, nx); b.st[0] = nloc; b.st[1] = nx; }
    const unsigned old = xb_add(&bar[XB_XSUB(b.x)], 1u);
    const unsigned gen = old / nloc;
    if (old + 1u == (gen + 1u) * nloc) {
      __builtin_amdgcn_fence(__ATOMIC_RELEASE, "agent");
      asm volatile("s_waitcnt vmcnt(0)" ::: "memory");
      const unsigned og = xb_add(&bar[XB_TOP], 1u);
      const unsigned tg = og / nx;
      if (og + 1u == (tg + 1u) * nx) xb_add(&bar[XB_TOPGEN], 1u);
      else XB_SPIN(xb_ld(&bar[XB_TOPGEN]) == tg, bar);
      __builtin_amdgcn_fence(__ATOMIC_ACQUIRE, "agent");
      xb_add(&bar[XB_XGEN(b.x)], 1u);
      asm volatile("s_waitcnt vmcnt(0)" ::: "memory");
    } else {
      XB_SPIN(xb_ld(&bar[XB_XGEN(b.x)]) == gen, bar);
      __builtin_amdgcn_fence(__ATOMIC_ACQUIRE, "agent");
      asm volatile("s_waitcnt vmcnt(0)" ::: "memory");
    }
  }
  __syncthreads();
}

__global__ void __launch_bounds__(512, 2) fwd_megakernel(Params p) {
  extern __shared__ __attribute__((aligned(16))) unsigned char lds[];
  cg::grid_group grid = cg::this_grid();
  volatile LAS unsigned* xst = (volatile LAS unsigned*)(lds + LDS_BYTES - 16);
  if (threadIdx.x == 0) { xst[0] = 0u; xst[1] = 0u; }
  __syncthreads();
  const XcdBarrier xb = xcd_barrier_post(reinterpret_cast<unsigned*>(p.ws + WS_BAR), xst);
  for (int ph = p.ph_lo; ph < p.ph_hi; ++ph) {
    unsigned char* hl = lds + HALF_ID * HALF_LDS;
    if (ph == 0) phase_prep(p, hl);
    else if (ph == 1) phase_mod0(p);
    else {
      const int l = (ph - 2) >> 2, s = (ph - 2) & 3;
      if (s == 0) { if (l & 1) gemm_phase<G_IN_ODD>(p, l, lds); else gemm_phase<G_IN_EVEN>(p, l, lds); }
      else if (s == 1) { if (l & 1) phase_mix_odd(p, l, hl, lds); else phase_mix_even(p, l, hl, lds); }
      else if (s == 2) gemm_phase<G_OUT>(p, l, lds);
      else phase_ln(p, l);
    }
    if (ph + 1 < p.ph_hi) {
      if (p.ph_lo < 0) grid.sync();
      xcd_barrier(xb);
    }
  }
}

extern "C" void kernel_launch(void* const* d_in, const int* in_sizes, int n_in, void* d_out, int out_size, void* d_ws, size_t ws_size,
                              hipStream_t stream) {
  static int grid_blocks = 0;
  if (grid_blocks == 0) {
    if (n_in != 52 || ws_size < WS_END) {
      fprintf(stderr, "kernel_launch: expected 52 inputs and >= %zu bytes of workspace; got %d, %zu\n", (size_t)WS_END, n_in, ws_size);
      grid_blocks = -1;
      return;
    }
    int dev = 0, cus = 0, per_cu = 0;
    hipGetDevice(&dev);
    hipDeviceGetAttribute(&cus, hipDeviceAttributeMultiprocessorCount, dev);
    hipFuncSetAttribute((const void*)fwd_megakernel, hipFuncAttributeMaxDynamicSharedMemorySize, LDS_BYTES);
    hipOccupancyMaxActiveBlocksPerMultiprocessor(&per_cu, (const void*)fwd_megakernel, 512, LDS_BYTES);
    (void)hipGetLastError();
    grid_blocks = cus;
  }
  if (grid_blocks < 0) return;
  Params p{};
  for (int i = 0; i < 52; ++i) p.in[i] = (const float*)d_in[i];
  p.out = (float*)d_out;
  p.ws = (unsigned char*)d_ws;
#if MULTI
  for (int ph = 0; ph < NPHASE; ++ph) {
    p.ph_lo = ph; p.ph_hi = ph + 1;
    hipLaunchKernelGGL(fwd_megakernel, dim3(grid_blocks), dim3(512), LDS_BYTES, stream, p);
  }
#else
  p.ph_lo = 0; p.ph_hi = NPHASE;
  if (hipMemsetAsync((char*)d_ws + WS_BAR, 0, XCD_BAR_WORDS * 4, stream) != hipSuccess) { fprintf(stderr, "kernel_launch: memset of barrier words failed\n"); return; }
  void* args[] = {&p};
  hipError_t e = hipLaunchCooperativeKernel((const void*)fwd_megakernel, dim3(grid_blocks), dim3(512), args, LDS_BYTES, stream);
  if (e != hipSuccess) fprintf(stderr, "cooperative launch failed: %s (grid %d)\n", hipGetErrorString(e), grid_blocks);
#endif
}
```

```cpp
#include <hip/hip_runtime.h>
#include <hip/hip_cooperative_groups.h>
#include <cstdio>
namespace cg = cooperative_groups;

#define DI __device__ __forceinline__
typedef unsigned short u16;
typedef unsigned int u32;
using bf16x8 = __attribute__((ext_vector_type(8))) short;
using f32x4 = __attribute__((ext_vector_type(4))) float;
using f32x16 = __attribute__((ext_vector_type(16))) float;
using u32x4 = __attribute__((ext_vector_type(4))) unsigned;
using u32x2 = __attribute__((ext_vector_type(2))) unsigned;
typedef __bf16 bf2_t __attribute__((ext_vector_type(2)));
typedef float f2_t __attribute__((ext_vector_type(2)));

#ifndef MULTI
#define MULTI 0
#endif
#ifndef REP0
#define REP0 1
#endif
#ifndef REP1
#define REP1 1
#endif
#ifndef ZERO_MASK
#define ZERO_MASK 0
#endif

constexpr int T_ALL = 24576, TP = 8192, DM = 2048;
constexpr float LOG2E = 1.4426950408889634f;
constexpr float ALPHA = 1.6817928305074290f;
constexpr float LN_EPS = 1e-5f;
constexpr int HALF_LDS = 76288;
constexpr int LDS_BYTES = 2 * HALF_LDS + 16;
constexpr int NPHASE = 18;

constexpr size_t SZ_WIN_E = (size_t)6144 * 2048 * 2, SZ_WIN_O = (size_t)7168 * 2048 * 2;
constexpr size_t WS_WINT = 0;
constexpr size_t WS_WOUTT = WS_WINT + 2 * SZ_WIN_E + 2 * SZ_WIN_O;
constexpr size_t WS_POOLWT = WS_WOUTT + (size_t)4 * 2048 * 2048 * 2;
constexpr size_t WS_SGUW = WS_POOLWT + (size_t)2 * 4 * 256 * 256 * 2;
constexpr size_t WS_CK = WS_SGUW + (size_t)2 * 4 * 128 * 128 * 2;
constexpr size_t WS_CVT = WS_CK + (size_t)4 * 4194304;
constexpr size_t WS_MOD = WS_CVT + (size_t)4 * 4194304;
constexpr size_t WS_ROPE = WS_MOD + (size_t)4 * 5 * 6144 * 4;
constexpr size_t WS_H = WS_ROPE + 8192;
constexpr size_t WS_PROJ = WS_H + (size_t)T_ALL * 2048 * 2;
constexpr size_t WS_VT = WS_PROJ + (size_t)T_ALL * 7168 * 2;
constexpr size_t WS_BAR = WS_VT + (size_t)T_ALL * 1024 * 2;
constexpr size_t WS_END = WS_BAR + 16384;

struct Params {
  const float* in[52];
  float* out;
  unsigned char* ws;
  int ph_lo, ph_hi;
};

DI size_t ws_wint(int l) { return WS_WINT + (size_t)(l >> 1) * (SZ_WIN_E + SZ_WIN_O) + ((l & 1) ? SZ_WIN_E : 0); }

DI u32 pk2(float a, float b) { f2_t v = {a, b}; bf2_t r = __builtin_convertvector(v, bf2_t); return __builtin_bit_cast(u32, r); }
DI float bflo(u32 w) { return __uint_as_float(w << 16); }
DI float bfhi(u32 w) { return __uint_as_float(w & 0xffff0000u); }
DI float bf1(u16 w) { return __uint_as_float(((u32)w) << 16); }
DI float ex2(float x) { return __builtin_amdgcn_exp2f(x); }
DI float silu(float x) { return x / (1.f + __expf(-x)); }
DI f32x4 mfma16(bf16x8 a, bf16x8 b, f32x4 c) { return __builtin_amdgcn_mfma_f32_16x16x32_bf16(a, b, c, 0, 0, 0); }
DI f32x16 mfma32(bf16x8 a, bf16x8 b, f32x16 c) { return __builtin_amdgcn_mfma_f32_32x32x16_bf16(a, b, c, 0, 0, 0); }
DI bf16x8 ld8(const u16* p) { return *reinterpret_cast<const bf16x8*>(p); }
DI int opq(int x) { asm volatile("" : "+v"(x)); return x; }
#define TIDX (opq((int)threadIdx.x) & 255)
#define TID8 (opq((int)threadIdx.x))
#define HALF_ID (opq((int)threadIdx.x) >> 8)
#define VBID ((int)((blockIdx.x & 7u) | ((unsigned)HALF_ID << 3) | ((blockIdx.x >> 3) << 4)))
#define VGRID ((int)gridDim.x * 2)

enum { G_IN_EVEN = 0, G_IN_ODD = 1, G_OUT = 2 };

namespace pg8 {
#define PG8_LAS __attribute__((address_space(3)))
typedef unsigned short bf16_t;
typedef short bf16x8 __attribute__((ext_vector_type(8)));
typedef float f32x4 __attribute__((ext_vector_type(4)));
typedef unsigned u32x4 __attribute__((ext_vector_type(4)));
constexpr int BM = 256, BK = 64, HALF = 128, HTB = HALF * BK * 2  , STAGE_BYTES = 8 * HTB, NXCD = 8, WGM = 8;

__host__ __device__ __forceinline__ int lds_byte(int r, int c) { const int st = (r >> 4) * 2 + (c >> 5), rr = r & 15, cc = c & 31, ob = rr * 64 + cc * 2; return st * 1024 + (ob ^ (((ob >> 9) & 1) << 5)); }
__host__ __device__ __forceinline__ void stage_rc(int b, int& R, int& C) { const int st = b / 1024, sb = b % 1024, swz = sb ^ (((sb >> 9) & 1) << 5); R = (st >> 1) * 16 + swz / 64; C = (st & 1) * 32 + (swz % 64) / 2; }
__host__ __device__ __forceinline__ int perm32(int rho) { const int n = rho >> 4, i = rho & 15; return 8 * (i >> 2) + 4 * n + (i & 3); }

struct Unit { int pm, pn; };
struct Gemm { const bf16_t* A; const bf16_t* Bt; int M, N, K; };

struct StaticOrder {
    int nM, nN, nwg, G, c;
    __host__ __device__ void init(int M, int N, int G_, int c_) { nM = M / BM; nN = N / BM; nwg = nM * nN; G = G_; c = c_; }
    __host__ __device__ bool next(int i, Unit& u) const {
        const long L = (long)i * G + c; if (L >= nwg) return false;
        int wgid = (int)L; { const int q = nwg / NXCD, r = nwg % NXCD, xcd = wgid % NXCD, off = wgid / NXCD; wgid = (xcd < r ? xcd * (q + 1) : r * (q + 1) + (xcd - r) * q) + off; }
        const int nig = WGM * nN, gid = wgid / nig, fm = gid * WGM, gsz = (nM - fm) < WGM ? (nM - fm) : WGM;
        u.pm = fm + ((wgid % nig) % gsz); u.pn = (wgid % nig) / gsz; return true;
    }
    __device__ __forceinline__ void a_ready(const Unit&) const {}
    __device__ __forceinline__ void done(const Unit&) const {}
};

template <class Epi, class Sched, bool STAMP = false>
__device__ __forceinline__ void gemm_phase(PG8_LAS unsigned char* lds, const Gemm g, const Sched& S, const Epi& E, unsigned long long* stamps) {
    const int tid = opq((int)threadIdx.x), wid = __builtin_amdgcn_readfirstlane(tid >> 6), lane = tid & 63, wr = wid >> 2, wc = wid & 3, fr = lane & 15, fq = lane >> 4;
    const int K = g.K, nt = K / BK;
    int ts_lo = 0, ts_hi = 0, nts = 0; const unsigned long long rt_entry = STAMP ? (unsigned long long)wall_clock64() : 0ull;
#define PG8_STAMP() do { if (STAMP && wid == 0 && nts < 64) { const unsigned long long _c = (unsigned long long)clock64(); \
        ts_lo = (lane == nts) ? (int)(unsigned)_c : ts_lo; ts_hi = (lane == nts) ? (int)(unsigned)(_c >> 32) : ts_hi; ++nts; } } while (0)
    PG8_STAMP();
    unsigned voffA[2], voffB[2];
#pragma unroll
    for (int i = 0; i < 2; ++i) { int R, C; stage_rc(tid * 16 + i * 8192, R, C); const int Rb = Epi::PERM ? ((R & ~31) + perm32(R & 31)) : R;
        voffA[i] = (unsigned)(R * K + C) * 2u; voffB[i] = (unsigned)(Rb * K + C) * 2u; }
    const size_t kstep = (size_t)(BK * 2);
    const size_t hstep = (size_t)HALF * K * 2;
    const size_t tstep = 2 * hstep;
    const unsigned ldsw = (unsigned)wid * 1024u;
    const int aoff = lds_byte(wr * 64 + fr, fq * 8), boff = lds_byte(wc * 32 + fr, fq * 8);
#define PG8_SA(b, h) (((b) * 2 + (h)) * HTB)
#define PG8_SB(b, h) ((4 + (b) * 2 + (h)) * HTB)
#define PG8_STAGE(bufoff, gbase, voff) do { _Pragma("unroll") for (int _i = 0; _i < 2; ++_i) \
        __builtin_amdgcn_global_load_lds((const unsigned*)((const char*)(gbase) + (voff)[_i]), (PG8_LAS unsigned*)(lds + (bufoff) + ldsw + _i * 8192), 16, 0, 0); } while (0)
#define PG8_LDA(dst, b, h) do { _Pragma("unroll") for (int m = 0; m < 4; ++m) _Pragma("unroll") for (int k = 0; k < 2; ++k) dst[m][k] = *(const PG8_LAS bf16x8*)(lds + PG8_SA(b, h) + aoff + m * 2048 + k * 1024); } while (0)
#define PG8_LDB(dst, b, h) do { _Pragma("unroll") for (int n = 0; n < 2; ++n) _Pragma("unroll") for (int k = 0; k < 2; ++k) dst[n][k] = *(const PG8_LAS bf16x8*)(lds + PG8_SB(b, h) + boff + n * 2048 + k * 1024); } while (0)
#define PG8_MMA(ai, bj, At, Bt) do { __builtin_amdgcn_s_setprio(1); _Pragma("unroll") for (int m = 0; m < 4; ++m) _Pragma("unroll") for (int n = 0; n < 2; ++n) _Pragma("unroll") for (int k = 0; k < 2; ++k) \
        acc[ai][bj][m][n] = __builtin_amdgcn_mfma_f32_16x16x32_bf16(Bt[n][k], At[m][k], acc[ai][bj][m][n], 0, 0, 0); __builtin_amdgcn_s_setprio(0); } while (0)
#define PG8_WAIT_V(n) asm volatile("s_waitcnt vmcnt(" #n ")" ::: "memory")
#define PG8_WAIT_L(n) asm volatile("s_waitcnt lgkmcnt(" #n ")" ::: "memory")
#define PG8_BAR __builtin_amdgcn_s_barrier()
#define PG8_SCHED __builtin_amdgcn_sched_barrier(0)
    Unit cur, nxt; int ui = 0;
    if (!S.next(0, cur)) return;
    f32x4 acc[2][2][4][2];
#pragma unroll
    for (int a = 0; a < 2; ++a)
#pragma unroll
        for (int b = 0; b < 2; ++b)
#pragma unroll
            for (int m = 0; m < 4; ++m)
#pragma unroll
                for (int n = 0; n < 2; ++n) acc[a][b][m][n] = (f32x4){0.f, 0.f, 0.f, 0.f};
    bf16x8 At[4][2], B0[2][2], B1[2][2];
    const char* cA = (const char*)g.A + (size_t)cur.pm * tstep; const char* cB = (const char*)g.Bt + (size_t)cur.pn * tstep;
    S.a_ready(cur);
    PG8_STAGE(PG8_SB(0, 0), cB, voffB); PG8_STAGE(PG8_SA(0, 0), cA, voffA); PG8_STAGE(PG8_SB(0, 1), cB + hstep, voffB); PG8_STAGE(PG8_SA(0, 1), cA + hstep, voffA);
    if (wr == 1) PG8_BAR;
    PG8_WAIT_V(4); PG8_BAR;
    PG8_STAGE(PG8_SB(1, 0), cB + kstep, voffB); PG8_STAGE(PG8_SA(1, 0), cA + kstep, voffA); PG8_STAGE(PG8_SB(1, 1), cB + hstep + kstep, voffB);
    PG8_WAIT_V(6); PG8_BAR;
    PG8_STAMP();
    for (;;) {
        const bool has_next = S.next(ui + 1, nxt);
        const char* nA = has_next ? (const char*)g.A + (size_t)nxt.pm * tstep : cA; const char* nB = has_next ? (const char*)g.Bt + (size_t)nxt.pn * tstep : cB;
        for (int t = 0; t < nt; t += 2) {
            const bool last = (t == nt - 2);
            const char* a1 = cA + (size_t)(t + 1) * kstep;
            const char* a2 = last ? nA : cA + (size_t)(t + 2) * kstep; const char* b2 = last ? nB : cB + (size_t)(t + 2) * kstep;
            const char* a3 = a2 + kstep; const char* b3 = b2 + kstep;
            if (last && has_next) S.a_ready(nxt);
            PG8_LDB(B0, 0, 0); PG8_SCHED; PG8_LDA(At, 0, 0); PG8_STAGE(PG8_SA(1, 1), a1 + hstep, voffA);
            PG8_WAIT_L(8); PG8_BAR; PG8_WAIT_L(0); PG8_MMA(0, 0, At, B0); PG8_BAR; PG8_SCHED;
            PG8_LDB(B1, 0, 1); PG8_STAGE(PG8_SB(0, 0), b2, voffB);
            PG8_BAR; PG8_WAIT_L(0); PG8_MMA(0, 1, At, B1); PG8_BAR;
            PG8_LDA(At, 0, 1); PG8_STAGE(PG8_SA(0, 0), a2, voffA);
            PG8_BAR; PG8_WAIT_L(0); PG8_MMA(1, 0, At, B0); PG8_BAR; PG8_SCHED;
            PG8_STAGE(PG8_SB(0, 1), b2 + hstep, voffB);
            PG8_WAIT_V(6); PG8_BAR; PG8_MMA(1, 1, At, B1); PG8_BAR;
            PG8_LDB(B0, 1, 0); PG8_SCHED; PG8_LDA(At, 1, 0); PG8_STAGE(PG8_SA(0, 1), a2 + hstep, voffA);
            PG8_WAIT_L(8); PG8_BAR; PG8_WAIT_L(0); PG8_MMA(0, 0, At, B0); PG8_BAR; PG8_SCHED;
            PG8_LDB(B1, 1, 1); PG8_STAGE(PG8_SB(1, 0), b3, voffB);
            PG8_BAR; PG8_WAIT_L(0); PG8_MMA(0, 1, At, B1); PG8_BAR;
            PG8_LDA(At, 1, 1); PG8_STAGE(PG8_SA(1, 0), a3, voffA);
            PG8_BAR; PG8_WAIT_L(0); PG8_MMA(1, 0, At, B0); PG8_BAR; PG8_SCHED;
            PG8_STAGE(PG8_SB(1, 1), b3 + hstep, voffB);
            PG8_WAIT_V(6); PG8_BAR; PG8_MMA(1, 1, At, B1); PG8_BAR;
        }
        PG8_STAMP();
        if constexpr (!Epi::AFTER_DRAIN) { E(acc, cur, wr, wc, fr, fq); S.done(cur); }
        PG8_STAMP();
        if (!has_next) break;
#pragma unroll
        for (int a = 0; a < 2; ++a)
#pragma unroll
            for (int b = 0; b < 2; ++b)
#pragma unroll
                for (int m = 0; m < 4; ++m)
#pragma unroll
                    for (int n = 0; n < 2; ++n) acc[a][b][m][n] = (f32x4){0.f, 0.f, 0.f, 0.f};
        cur = nxt; cA = nA; cB = nB; ++ui;
    }
    PG8_WAIT_V(0);
    if (wr == 0) PG8_BAR;
    PG8_BAR;
    if constexpr (Epi::AFTER_DRAIN) { E.fused(acc, cur, wr, wc, fr, fq, lds, wid, lane); S.done(cur); }
    PG8_STAMP();
    if (STAMP && wid == 0) { stamps[lane] = lane < nts ? (((unsigned long long)(unsigned)ts_hi << 32) | (unsigned)ts_lo) : 0ull;
        if (lane == 62) stamps[62] = rt_entry; if (lane == 63) stamps[63] = (unsigned long long)wall_clock64(); }
#undef PG8_STAMP
#undef PG8_SA
#undef PG8_SB
#undef PG8_STAGE
#undef PG8_LDA
#undef PG8_LDB
#undef PG8_MMA
#undef PG8_WAIT_V
#undef PG8_WAIT_L
#undef PG8_BAR
#undef PG8_SCHED
}
}

DI void tr_tile(const float* __restrict__ src, size_t ld_src, u16* __restrict__ dst, size_t ld_dst, float* sT) {
  const int tid = TIDX;
  const int r = tid >> 4, c4 = (tid & 15) * 4;
#pragma unroll
  for (int i = 0; i < 4; ++i) {
    float4 v = *reinterpret_cast<const float4*>(src + (size_t)(r + 16 * i) * ld_src + c4);
    float* d = sT + (r + 16 * i) * 65 + c4;
    d[0] = v.x; d[1] = v.y; d[2] = v.z; d[3] = v.w;
  }
  __syncthreads();
  const int n = tid >> 2, ks = (tid & 3) * 16;
  u32 w[8];
#pragma unroll
  for (int j = 0; j < 8; ++j) w[j] = pk2(sT[(ks + 2 * j) * 65 + n], sT[(ks + 2 * j + 1) * 65 + n]);
  u32x4* o = reinterpret_cast<u32x4*>(dst + (size_t)n * ld_dst + ks);
  o[0] = u32x4{w[0], w[1], w[2], w[3]};
  o[1] = u32x4{w[4], w[5], w[6], w[7]};
  __syncthreads();
}

DI void cvt8(const float* __restrict__ src, u16* __restrict__ dst) {
  float4 a = *reinterpret_cast<const float4*>(src);
  float4 b = *reinterpret_cast<const float4*>(src + 4);
  *reinterpret_cast<u32x4*>(dst) = u32x4{pk2(a.x, a.y), pk2(a.z, a.w), pk2(b.x, b.y), pk2(b.z, b.w)};
}

DI void mod_item(const Params& p, int i, unsigned char* lds) {
  const int tid = TIDX;
  const int l = i / 96, n0 = (i % 96) * 64;
  float* sS = reinterpret_cast<float*>(lds);
  float* red = sS + 5 * 2048;
  const float* c = p.in[10];
  const float* cctx = p.in[11];
  for (int e = tid; e < 5 * 2048; e += 256) {
    int v = e >> 11, k = e & 2047;
    float x = (v == 0) ? cctx[k] : c[(v - 1) * 2048 + k];
    sS[e] = silu(x);
  }
  __syncthreads();
  const int kk = tid >> 4, c4 = (tid & 15) * 4;
  const float* W = p.in[12 + 10 * l] + n0 + c4;
  f32x4 acc[5];
#pragma unroll
  for (int v = 0; v < 5; ++v) acc[v] = f32x4{0.f, 0.f, 0.f, 0.f};
#pragma unroll 8
  for (int k = kk; k < 2048; k += 16) {
    float4 w = *reinterpret_cast<const float4*>(W + (size_t)k * 6144);
#pragma unroll
    for (int v = 0; v < 5; ++v) {
      float s = sS[v * 2048 + k];
      acc[v][0] += s * w.x; acc[v][1] += s * w.y; acc[v][2] += s * w.z; acc[v][3] += s * w.w;
    }
  }
#pragma unroll
  for (int v = 0; v < 5; ++v)
#pragma unroll
    for (int q = 0; q < 4; ++q) red[(kk * 5 + v) * 64 + c4 + q] = acc[v][q];
  __syncthreads();
  for (int t2 = tid; t2 < 320; t2 += 256) {
    int v = t2 >> 6, n = t2 & 63;
    float s = 0.f;
#pragma unroll
    for (int k2 = 0; k2 < 16; ++k2) s += red[(k2 * 5 + v) * 64 + n];
    float* mod = reinterpret_cast<float*>(p.ws + WS_MOD);
    mod[(size_t)(l * 5 + v) * 6144 + n0 + n] = s + p.in[13 + 10 * l][n0 + n];
  }
  __syncthreads();
}

DI void phase_prep(const Params& p, unsigned char* lds) {
  constexpr int N_MOD = 384, N_TRWIN = 13312, N_TRWOUT = 4096, N_TRPOOL = 128, N_SGU = 64, N_CK = 4096, N_CV = 2048;
  constexpr int TOTAL = N_MOD + N_TRWIN + N_TRWOUT + N_TRPOOL + N_SGU + N_CK + N_CV + 1;
  const int tid = TIDX;
  float* sT = reinterpret_cast<float*>(lds);
  for (int it = VBID; it < TOTAL; it += VGRID) {
    int i = it;
    if (i < N_MOD) { mod_item(p, i, lds); continue; }
    i -= N_MOD;
    if (i < N_TRWIN) {
      int l, base;
      if (i < 3072) { l = 0; base = 0; } else if (i < 6656) { l = 1; base = 3072; } else if (i < 9728) { l = 2; base = 6656; } else { l = 3; base = 9728; }
      i -= base;
      const int N = (l & 1) ? 7168 : 6144, nN = N / 64;
      const int kt = i / nN, nt = i % nN;
      tr_tile(p.in[14 + 10 * l] + (size_t)kt * 64 * N + nt * 64, N,
              reinterpret_cast<u16*>(p.ws + ws_wint(l)) + (size_t)nt * 64 * 2048 + kt * 64, 2048, sT);
      continue;
    }
    i -= N_TRWIN;
    if (i < N_TRWOUT) {
      const int l = i >> 10, r = i & 1023, kt = r >> 5, nt = r & 31;
      tr_tile(p.in[15 + 10 * l] + (size_t)kt * 64 * 2048 + nt * 64, 2048,
              reinterpret_cast<u16*>(p.ws + WS_WOUTT) + (size_t)l * 2048 * 2048 + (size_t)nt * 64 * 2048 + kt * 64, 2048, sT);
      continue;
    }
    i -= N_TRWOUT;
    if (i < N_TRPOOL) {
      const int e = i >> 6, r = i & 63, g = r >> 4, t = r & 15, kt = t >> 2, nt = t & 3;
      tr_tile(p.in[18 + 20 * e] + (size_t)g * 65536 + kt * 64 * 256 + nt * 64, 256,
              reinterpret_cast<u16*>(p.ws + WS_POOLWT) + (size_t)e * 262144 + g * 65536 + nt * 64 * 256 + kt * 64, 256, sT);
      continue;
    }
    i -= N_TRPOOL;
    if (i < N_SGU) {
      const int e = i >> 5, ch = i & 31;
      const size_t off = (size_t)ch * 2048 + tid * 8;
      cvt8(p.in[30 + 20 * e] + off, reinterpret_cast<u16*>(p.ws + WS_SGUW) + (size_t)e * 65536 + off);
      continue;
    }
    i -= N_SGU;
    if (i < N_CK) {
      const int l = i >> 10, ch = i & 1023;
      const size_t off = (size_t)ch * 2048 + tid * 8;
      cvt8(p.in[2 + 2 * l] + off, reinterpret_cast<u16*>(p.ws + WS_CK) + (size_t)l * 2097152 + off);
      continue;
    }
    i -= N_CK;
    if (i < N_CV) {
      const int l = i >> 9, r = i & 511, bh = r >> 4, t = r & 15, kt = t >> 1, nt = t & 1;
      tr_tile(p.in[3 + 2 * l] + (size_t)bh * 65536 + kt * 64 * 128 + nt * 64, 128,
              reinterpret_cast<u16*>(p.ws + WS_CVT) + (size_t)l * 2097152 + (size_t)bh * 65536 + nt * 64 * 512 + kt * 64, 512, sT);
      continue;
    }
    {
      float* rc = reinterpret_cast<float*>(p.ws + WS_ROPE);
      for (int e = tid; e < 1024; e += 256) {
        int pos = e >> 4, fi = e & 15;
        float inv = 1.0f / powf(10000.0f, (float)(2 * fi) / 32.0f);
        float ang = (float)pos * inv;
        rc[e] = cosf(ang);
        rc[1024 + e] = sinf(ang);
      }
    }
  }
}

DI void phase_mod0(const Params& p) {
  const int tid = TIDX;
  const float* mod = reinterpret_cast<const float*>(p.ws + WS_MOD);
  u16* H = reinterpret_cast<u16*>(p.ws + WS_H);
  for (int it = VBID; it < T_ALL / 4; it += VGRID) {
#pragma unroll
    for (int rr = 0; rr < 4; ++rr) {
      const int row = it * 4 + rr;
      const int cond = row < TP ? 0 : 1 + ((row - TP) >> 12);
      const float* src = row < TP ? p.in[0] + (size_t)row * 2048 : p.in[1] + (size_t)(row - TP) * 2048;
      const int e = tid * 8;
      const float* sh = mod + (size_t)cond * 6144 + e;
      float4 a = *reinterpret_cast<const float4*>(src + e), b = *reinterpret_cast<const float4*>(src + e + 4);
      float4 s0 = *reinterpret_cast<const float4*>(sh), s1 = *reinterpret_cast<const float4*>(sh + 4);
      float4 c0 = *reinterpret_cast<const float4*>(sh + 2048), c1 = *reinterpret_cast<const float4*>(sh + 2052);
      u32x4 o = {pk2(a.x * (1.f + c0.x) + s0.x, a.y * (1.f + c0.y) + s0.y), pk2(a.z * (1.f + c0.z) + s0.z, a.w * (1.f + c0.w) + s0.w),
                 pk2(b.x * (1.f + c1.x) + s1.x, b.y * (1.f + c1.y) + s1.y), pk2(b.z * (1.f + c1.z) + s1.z, b.w * (1.f + c1.w) + s1.w)};
      *reinterpret_cast<u32x4*>(H + (size_t)row * 2048 + e) = o;
    }
  }
}


template <int MODE>
struct EpiIn {
  static constexpr bool PERM = false, AFTER_DRAIN = false;
  u16* PROJ; u16* VT; float* kout; float* vout; const float* ropeC; const float* ropeS;
  DI void operator()(const f32x4 (&acc)[2][2][4][2], const pg8::Unit& u, int wr, int wc, int fr, int fq) const {
    constexpr int NC = (MODE == G_IN_EVEN) ? 6144 : 7168;
    constexpr int SEC_Q = (MODE == G_IN_EVEN) ? 2 : 0, SEC_K = (MODE == G_IN_EVEN) ? 3 : 1, SEC_V = (MODE == G_IN_EVEN) ? 4 : 2;
    const int sec = u.pn >> 2;
    const bool prompt = u.pm < 32;
    const bool isq = sec == SEC_Q, isk = sec == SEC_K;
    const bool rope = (MODE == G_IN_EVEN) && (isq || isk) && !prompt;
    const float sc = isq ? ((MODE == G_IN_EVEN) ? 0.125f * LOG2E : 0.08838834764831845f * LOG2E) : 1.0f;
#pragma unroll
    for (int ai = 0; ai < 2; ++ai)
#pragma unroll
      for (int m = 0; m < 4; ++m) {
        const int row = u.pm * 256 + ai * 128 + wr * 64 + m * 16 + fr;
        int b, t;
        if (prompt) { b = row >> 8; t = row & 255; } else { const int rs = row - TP; b = rs >> 12; t = rs & 4095; }
#pragma unroll
        for (int bj = 0; bj < 2; ++bj) {
          const int hh = (u.pn & 3) * 2 + bj;
          const int d0 = wc * 32 + 4 * fq;
          if (sec == SEC_V) {
#pragma unroll
            for (int n = 0; n < 2; ++n) {
              const f32x4 v = acc[ai][bj][m][n];
              const int dv = d0 + 16 * n;
              const u32 w01 = pk2(v[0], v[1]), w23 = pk2(v[2], v[3]);
              if (prompt) {
                u16* vt = VT + ((size_t)((b * 8 + hh) * 128 + dv)) * 256 + t;
                vt[0] = (u16)(w01 & 0xffffu); vt[256] = (u16)(w01 >> 16); vt[512] = (u16)(w23 & 0xffffu); vt[768] = (u16)(w23 >> 16);
                *reinterpret_cast<float4*>(vout + ((size_t)((b * 8 + hh) * 256 + t)) * 128 + dv) = float4{v[0], v[1], v[2], v[3]};
              } else {
                u16* vt = VT + 8388608 + ((size_t)((b * 8 + hh) * 128 + dv)) * 4096 + t;
                vt[0] = (u16)(w01 & 0xffffu); vt[4096] = (u16)(w01 >> 16); vt[8192] = (u16)(w23 & 0xffffu); vt[12288] = (u16)(w23 >> 16);
              }
            }
          } else {
            f32x4 v0 = acc[ai][bj][m][0], v1 = acc[ai][bj][m][1];
            if (isk && prompt) {
              float* ko = kout + ((size_t)((b * 8 + hh) * 256 + t)) * 128 + d0;
              *reinterpret_cast<float4*>(ko) = float4{v0[0], v0[1], v0[2], v0[3]};
              *reinterpret_cast<float4*>(ko + 16) = float4{v1[0], v1[1], v1[2], v1[3]};
            }
            if (rope) {
              const int pos = (wc & 1) ? (t & 63) : (t >> 6);
              const float4 cs = *reinterpret_cast<const float4*>(ropeC + pos * 16 + 4 * fq);
              const float4 sn = *reinterpret_cast<const float4*>(ropeS + pos * 16 + 4 * fq);
              const float c4[4] = {cs.x, cs.y, cs.z, cs.w}, s4[4] = {sn.x, sn.y, sn.z, sn.w};
#pragma unroll
              for (int j = 0; j < 4; ++j) {
                const float x1 = v0[j], x2 = v1[j];
                v0[j] = x1 * c4[j] - x2 * s4[j];
                v1[j] = x1 * s4[j] + x2 * c4[j];
              }
            }
            u16* dst = PROJ + (size_t)row * NC + u.pn * 256 + bj * 128 + d0;
            *reinterpret_cast<u32x2*>(dst) = u32x2{pk2(v0[0] * sc, v0[1] * sc), pk2(v0[2] * sc, v0[3] * sc)};
            *reinterpret_cast<u32x2*>(dst + 16) = u32x2{pk2(v1[0] * sc, v1[1] * sc), pk2(v1[2] * sc, v1[3] * sc)};
          }
        }
      }
  }
};

struct EpiOut {
  static constexpr bool PERM = false, AFTER_DRAIN = false;
  float* X; const float* x0; const float* x1; const float* mod; int l;
  DI void operator()(const f32x4 (&acc)[2][2][4][2], const pg8::Unit& u, int wr, int wc, int fr, int fq) const {
    const bool prompt = u.pm < 32;
    const int cond = prompt ? 0 : 1 + ((u.pm * 256 - TP) >> 12);
    const float* gate = mod + (size_t)(l * 5 + cond) * 6144 + 4096;
#pragma unroll
    for (int bj = 0; bj < 2; ++bj)
#pragma unroll
      for (int n = 0; n < 2; ++n) {
        const int col = u.pn * 256 + bj * 128 + wc * 32 + 16 * n + 4 * fq;
        const float4 g4 = *reinterpret_cast<const float4*>(gate + col);
#pragma unroll
        for (int ai = 0; ai < 2; ++ai)
#pragma unroll
          for (int m = 0; m < 4; ++m) {
            const int row = u.pm * 256 + ai * 128 + wr * 64 + m * 16 + fr;
            float4 xo;
            if (l == 0) xo = prompt ? *reinterpret_cast<const float4*>(x0 + (size_t)row * 2048 + col)
                                    : *reinterpret_cast<const float4*>(x1 + (size_t)(row - TP) * 2048 + col);
            else xo = *reinterpret_cast<const float4*>(X + (size_t)row * 2048 + col);
            const f32x4 a = acc[ai][bj][m][n];
            float4 o;
            o.x = ALPHA * xo.x + g4.x * a[0]; o.y = ALPHA * xo.y + g4.y * a[1];
            o.z = ALPHA * xo.z + g4.z * a[2]; o.w = ALPHA * xo.w + g4.w * a[3];
            *reinterpret_cast<float4*>(X + (size_t)row * 2048 + col) = o;
          }
      }
  }
};

template <int MODE>
DI void gemm_phase(const Params& p, int l, unsigned char* lds) {
  constexpr int N = (MODE == G_OUT) ? 2048 : (MODE == G_IN_EVEN ? 6144 : 7168);
  pg8::Gemm g;
  g.A = reinterpret_cast<const u16*>(p.ws + WS_H);
  g.Bt = (MODE == G_OUT) ? reinterpret_cast<const u16*>(p.ws + WS_WOUTT) + (size_t)l * 2048 * 2048
                         : reinterpret_cast<const u16*>(p.ws + ws_wint(l));
  g.M = T_ALL; g.N = N; g.K = 2048;
  pg8::StaticOrder S;
  S.init(T_ALL, N, (int)gridDim.x, (int)blockIdx.x);
  PG8_LAS unsigned char* l3 = (PG8_LAS unsigned char*)lds;
  if constexpr (MODE == G_OUT) {
    EpiOut E;
    E.X = p.out; E.x0 = p.in[0]; E.x1 = p.in[1]; E.mod = reinterpret_cast<const float*>(p.ws + WS_MOD); E.l = l;
    pg8::gemm_phase<EpiOut, pg8::StaticOrder, false>(l3, g, S, E, nullptr);
  } else {
    EpiIn<MODE> E;
    E.PROJ = reinterpret_cast<u16*>(p.ws + WS_PROJ); E.VT = reinterpret_cast<u16*>(p.ws + WS_VT);
    E.kout = p.out + (size_t)T_ALL * 2048 + (size_t)(2 * l) * 8388608;
    E.vout = p.out + (size_t)T_ALL * 2048 + (size_t)(2 * l + 1) * 8388608;
    E.ropeC = reinterpret_cast<const float*>(p.ws + WS_ROPE); E.ropeS = E.ropeC + 1024;
    pg8::gemm_phase<EpiIn<MODE>, pg8::StaticOrder, false>(l3, g, S, E, nullptr);
  }
}

DI void phase_ln(const Params& p, int l) {
  const int tid_ = TIDX, lane = tid_ & 63, wid = tid_ >> 6;
  const float* g = p.in[16 + 10 * l];
  const float* bb = p.in[17 + 10 * l];
  const float* mod = reinterpret_cast<const float*>(p.ws + WS_MOD);
  u16* H = reinterpret_cast<u16*>(p.ws + WS_H);
  float* X = p.out;
  for (int it = VBID; it < T_ALL / 4; it += VGRID) {
    const int row = it * 4 + wid;
    float* xr = X + (size_t)row * 2048;
    float4 v[8];
    float s = 0.f;
#pragma unroll
    for (int i = 0; i < 8; ++i) {
      v[i] = *reinterpret_cast<const float4*>(xr + (i * 64 + lane) * 4);
      s += v[i].x + v[i].y + v[i].z + v[i].w;
    }
#pragma unroll
    for (int o = 32; o >= 1; o >>= 1) s += __shfl_xor(s, o);
    const float mu = s * (1.f / 2048.f);
    float ss = 0.f;
#pragma unroll
    for (int i = 0; i < 8; ++i) {
      float a = v[i].x - mu, b = v[i].y - mu, c = v[i].z - mu, d = v[i].w - mu;
      ss += a * a + b * b + c * c + d * d;
    }
#pragma unroll
    for (int o = 32; o >= 1; o >>= 1) ss += __shfl_xor(ss, o);
    const float rstd = rsqrtf(ss * (1.f / 2048.f) + LN_EPS);
    const int cond = row < TP ? 0 : 1 + ((row - TP) >> 12);
    const float* sh = mod + (size_t)((l + 1) * 5 + cond) * 6144;
#pragma unroll
    for (int i = 0; i < 8; ++i) {
      const int e = (i * 64 + lane) * 4;
      float4 gg = *reinterpret_cast<const float4*>(g + e), b4 = *reinterpret_cast<const float4*>(bb + e);
      float4 y;
      y.x = (v[i].x - mu) * rstd * gg.x + b4.x; y.y = (v[i].y - mu) * rstd * gg.y + b4.y;
      y.z = (v[i].z - mu) * rstd * gg.z + b4.z; y.w = (v[i].w - mu) * rstd * gg.w + b4.w;
      *reinterpret_cast<float4*>(xr + e) = y;
      if (l < 3) {
        float4 s0 = *reinterpret_cast<const float4*>(sh + e), c0 = *reinterpret_cast<const float4*>(sh + 2048 + e);
        u32x2 o = {pk2(y.x * (1.f + c0.x) + s0.x, y.y * (1.f + c0.y) + s0.y), pk2(y.z * (1.f + c0.z) + s0.z, y.w * (1.f + c0.w) + s0.w)};
        *reinterpret_cast<u32x2*>(H + (size_t)row * 2048 + e) = o;
      }
    }
  }
}

struct AttnSrc {
  const u16* k0; const u16* vt0; int ks0, vs0, n0;
  const u16* k1; const u16* vt1; int ks1, vs1, n1;
};

template <int DQK>
DI void attn_ldg(const AttnSrc& s, int j, u32x4 (&rk)[DQK / 64], u32x4 (&rv)[2]) {
  const u16* kb; const u16* vb; int ks, vs;
  if (j < s.n0) { kb = s.k0 + (size_t)j * 64 * s.ks0; vb = s.vt0 + j * 64; ks = s.ks0; vs = s.vs0; }
  else { const int jj = j - s.n0; kb = s.k1 + (size_t)jj * 64 * s.ks1; vb = s.vt1 + jj * 64; ks = s.ks1; vs = s.vs1; }
  constexpr int CPR = DQK / 8;
  const int tid = TID8;
#pragma unroll
  for (int i = 0; i < DQK / 64; ++i) {
    const int c = tid + 512 * i, row = c / CPR, kc = c % CPR;
    rk[i] = *reinterpret_cast<const u32x4*>(kb + (size_t)row * ks + kc * 8);
  }
#pragma unroll
  for (int i = 0; i < 2; ++i) {
    const int c = tid + 512 * i, row = c >> 3, kc = c & 7;
    rv[i] = *reinterpret_cast<const u32x4*>(vb + (size_t)row * vs + kc * 8);
  }
}
template <int DQK>
DI void attn_sts(u16* sK, u16* sVT, const u32x4 (&rk)[DQK / 64], const u32x4 (&rv)[2]) {
  constexpr int CPR = DQK / 8;
  const int tid = TID8;
#pragma unroll
  for (int i = 0; i < DQK / 64; ++i) {
    const int c = tid + 512 * i, row = c / CPR, kc = c % CPR;
    *reinterpret_cast<u32x4*>(sK + row * (DQK + 8) + kc * 8) = rk[i];
  }
#pragma unroll
  for (int i = 0; i < 2; ++i) {
    const int c = tid + 512 * i, row = c >> 3, kc = c & 7;
    *reinterpret_cast<u32x4*>(sVT + row * 72 + kc * 8) = rv[i];
  }
}

DI void attn_pv(const f32x16 (&s)[2], const u16* vw, f32x16 (&O)[4]) {
  __builtin_amdgcn_s_setprio(1);
#pragma unroll
  for (int s4 = 0; s4 < 4; ++s4) {
    const int t = s4 >> 1, b0 = (s4 & 1) * 8;
    u32x4 w = {pk2(s[t][b0], s[t][b0 + 1]), pk2(s[t][b0 + 2], s[t][b0 + 3]), pk2(s[t][b0 + 4], s[t][b0 + 5]), pk2(s[t][b0 + 6], s[t][b0 + 7])};
    const bf16x8 pf = __builtin_bit_cast(bf16x8, w);
#pragma unroll
    for (int d = 0; d < 4; ++d) {
      bf16x8 a = ld8(vw + d * 32 * 72 + s4 * 16);
      O[d] = mfma32(a, pf, O[d]);
    }
  }
  __builtin_amdgcn_s_setprio(0);
}

template <int DQK, bool NA>
DI void attn_run(const AttnSrc& src, const u16* qblk, int qstride, u16* sQ, u16* sK, u16* sVT, f32x16 (&O)[4], float& l_out,
                 int qr, int qc, int rsmin, const float* sBias) {
  const int tid = TID8, lane = tid & 63, wid = tid >> 6;
  const int r = lane & 31, h = lane >> 5;
  const int pr = (r & 0x13) | ((r & 4) << 1) | ((r & 8) >> 1);
  constexpr int CPR = DQK / 8, QS = DQK + 8;
  __syncthreads();
  constexpr bool QREG = (DQK == 64);
  bf16x8 qf[QREG ? DQK / 16 : 1];
  if constexpr (QREG) {
#pragma unroll
    for (int ks = 0; ks < DQK / 16; ++ks) qf[ks] = ld8(qblk + (size_t)(wid * 32 + r) * qstride + ks * 16 + 8 * h);
  } else {
#pragma unroll
    for (int i = 0; i < DQK / 16; ++i) {
      const int c = tid + 512 * i, row = c / CPR, kc = c % CPR;
      *reinterpret_cast<u32x4*>(sQ + row * QS + kc * 8) = *reinterpret_cast<const u32x4*>(qblk + (size_t)row * qstride + kc * 8);
    }
  }
#pragma unroll
  for (int d = 0; d < 4; ++d)
#pragma unroll
    for (int i = 0; i < 16; ++i) O[d][i] = 0.f;
  float m = -1e30f, l = 0.f;
  const int nt = src.n0 + src.n1;
  const int rsq = min(max(qr - 4, 0), 56);
  const int cs = min(max(qc - 8, 0), 48);
  const u16* qw = sQ + (wid * 32 + r) * QS + 8 * h;
  const u16* kw = sK + pr * QS + 8 * h;
  u16* sVT1 = sVT + 128 * 72 + 2048;
  const bool grpB = wid >= 4;
  bool pend = false;
  f32x16 s[2];
  u32x4 rk[DQK / 64], rv[2];
  attn_ldg<DQK>(src, 0, rk, rv);
#pragma unroll 1
  for (int j = 0; j < nt; ++j) {
    if (j > 0) __syncthreads();
    u16* vcur = (j & 1) ? sVT1 : sVT;
    attn_sts<DQK>(sK, vcur, rk, rv);
    __syncthreads();
    if (j + 1 < nt) attn_ldg<DQK>(src, j + 1, rk, rv);
    __builtin_amdgcn_sched_barrier(0);
    if (grpB && pend) { attn_pv(s, ((j & 1) ? sVT : sVT1) + r * 72 + 8 * h, O); pend = false; }
    bool active = true;
    int kr = 0;
    if (NA && j >= src.n0) { kr = rsmin + (j - src.n0); active = (kr >= rsq) && (kr < rsq + 8); }
    if (active) {
      __builtin_amdgcn_s_setprio(1);
#pragma unroll
      for (int t = 0; t < 2; ++t) {
#pragma unroll
        for (int i = 0; i < 16; ++i) s[t][i] = 0.f;
#pragma unroll
        for (int ks = 0; ks < DQK / 16; ++ks) {
          bf16x8 a = ld8(kw + t * 32 * QS + ks * 16);
          bf16x8 q;
          if constexpr (QREG) q = qf[ks]; else q = ld8(qw + ks * 16);
          s[t] = mfma32(a, q, s[t]);
        }
      }
      __builtin_amdgcn_s_setprio(0);
      if (NA && j >= src.n0) {
        const float* bp = sBias + (kr - qr + 7) * 31 + (8 * h - qc + 15);
        const int kb = 8 * h - cs;
#pragma unroll
        for (int t = 0; t < 2; ++t)
#pragma unroll
          for (int i = 0; i < 16; ++i) {
            const int ko = t * 32 + 16 * (i >> 3) + (i & 7);
            const bool ok = (unsigned)(ko + kb) < 16u;
            const float bv = bp[ko];
            s[t][i] = ok ? s[t][i] + bv : -1e30f;
          }
      }
      float mx = -1e30f;
#pragma unroll
      for (int t = 0; t < 2; ++t)
#pragma unroll
        for (int i = 0; i < 16; ++i) mx = fmaxf(mx, s[t][i]);
      if (__builtin_amdgcn_ballot_w64(mx > m + 8.0f) != 0ull) {
        mx = fmaxf(mx, __shfl_xor(mx, 32));
        const float mn = fmaxf(m, mx);
        const float alpha = ex2(m - mn);
        l *= alpha;
        m = mn;
#pragma unroll
        for (int d = 0; d < 4; ++d)
#pragma unroll
          for (int i = 0; i < 16; ++i) O[d][i] *= alpha;
      }
      float rsum = 0.f;
#pragma unroll
      for (int t = 0; t < 2; ++t)
#pragma unroll
        for (int i = 0; i < 16; ++i) { const float e = ex2(s[t][i] - m); s[t][i] = e; rsum += e; }
      l += rsum;
      if (!grpB) attn_pv(s, vcur + r * 72 + 8 * h, O);
      else pend = true;
    }
  }
  if (grpB && pend) attn_pv(s, (((nt - 1) & 1) ? sVT1 : sVT) + r * 72 + 8 * h, O);
  l_out = l + __shfl_xor(l, 32);
}

DI void heavy_map(int it, int& bh, int& qb) { const int x = it & 7, rest = it >> 3; qb = rest & 15; bh = x + 8 * (rest >> 4); }

DI void diff_item(const Params& p, int l, bool sample, int bh, int qb, unsigned char* lds) {
  constexpr int NC = 6144;
  const int tid_ = TID8, lane = tid_ & 63, wid = tid_ >> 6, r = lane & 31, h = lane >> 5;
  const int b = bh >> 3, hd = bh & 7;
  u16* sQ = reinterpret_cast<u16*>(lds);
  u16* sK = sQ + 256 * 136;
  u16* sVT = sK + 64 * 136;
  const u16* PROJ = reinterpret_cast<const u16*>(p.ws + WS_PROJ);
  const u16* VT = reinterpret_cast<const u16*>(p.ws + WS_VT);
  const int seq0 = sample ? TP + b * 4096 : b * 256;
  const int token = seq0 + qb * 256 + wid * 32 + r;
  const float* dl = p.in[20 + 10 * l];
  float pa = dl[lane] * dl[64 + lane], pb = dl[128 + lane] * dl[192 + lane];
#pragma unroll
  for (int o = 32; o >= 1; o >>= 1) { pa += __shfl_xor(pa, o); pb += __shfl_xor(pb, o); }
  const float lam_init = 0.8f - 0.6f * __expf(-0.3f * (float)l);
  const float lam = __expf(pa) - __expf(pb) + lam_init;

  u32 o1p[32];
  f32x16 O[4];
  float lsum;
#pragma unroll
  for (int comp = 0; comp < 2; ++comp) {
    AttnSrc s;
    if (sample) {
      s.k0 = reinterpret_cast<const u16*>(p.ws + WS_CK) + (size_t)l * 2097152 + (size_t)bh * 65536 + comp * 64; s.ks0 = 128;
      s.vt0 = reinterpret_cast<const u16*>(p.ws + WS_CVT) + (size_t)l * 2097152 + (size_t)bh * 65536; s.vs0 = 512; s.n0 = 8;
      s.k1 = PROJ + (size_t)seq0 * NC + 3072 + hd * 128 + comp * 64; s.ks1 = NC;
      s.vt1 = VT + 8388608 + (size_t)bh * 128 * 4096; s.vs1 = 4096; s.n1 = 64;
    } else {
      s.k0 = nullptr; s.vt0 = nullptr; s.ks0 = 0; s.vs0 = 0; s.n0 = 0;
      s.k1 = PROJ + (size_t)seq0 * NC + 3072 + hd * 128 + comp * 64; s.ks1 = NC;
      s.vt1 = VT + (size_t)bh * 128 * 256; s.vs1 = 256; s.n1 = 4;
    }
    const u16* qblk = PROJ + (size_t)(seq0 + qb * 256) * NC + 2048 + hd * 128 + comp * 64;
    attn_run<64, false>(s, qblk, NC, sQ, sK, sVT, O, lsum, 0, 0, 0, nullptr);
    const float inv = 1.f / lsum;
    if (comp == 0) {
#pragma unroll
      for (int d = 0; d < 4; ++d)
#pragma unroll
        for (int i = 0; i < 8; ++i) o1p[d * 8 + i] = pk2(O[d][2 * i] * inv, O[d][2 * i + 1] * inv);
    } else {
      float ssq = 0.f;
#pragma unroll
      for (int d = 0; d < 4; ++d)
#pragma unroll
        for (int i = 0; i < 8; ++i) {
          const u32 w = o1p[d * 8 + i];
          const float a = bflo(w) - lam * O[d][2 * i] * inv, c = bfhi(w) - lam * O[d][2 * i + 1] * inv;
          O[d][2 * i] = a; O[d][2 * i + 1] = c;
          ssq += a * a + c * c;
        }
      ssq += __shfl_xor(ssq, 32);
      const float rn = rsqrtf(ssq * (1.f / 128.f) + LN_EPS) * (1.f - lam_init);
      const float* subln = p.in[21 + 10 * l];
      const u16* gp = PROJ + (size_t)token * NC + 5120 + hd * 128;
      u16* yp = reinterpret_cast<u16*>(p.ws + WS_H) + (size_t)token * 2048 + 1024 + hd * 128;
#pragma unroll
      for (int d = 0; d < 4; ++d)
#pragma unroll
        for (int q = 0; q < 4; ++q) {
          const int dv = d * 32 + 8 * q + 4 * h;
          const u32x2 gw = *reinterpret_cast<const u32x2*>(gp + dv);
          const float4 sl = *reinterpret_cast<const float4*>(subln + dv);
          const float y0 = O[d][4 * q] * rn * sl.x * silu(bflo(gw[0]));
          const float y1 = O[d][4 * q + 1] * rn * sl.y * silu(bfhi(gw[0]));
          const float y2 = O[d][4 * q + 2] * rn * sl.z * silu(bflo(gw[1]));
          const float y3 = O[d][4 * q + 3] * rn * sl.w * silu(bfhi(gw[1]));
          *reinterpret_cast<u32x2*>(yp + dv) = (ZERO_MASK & 2) ? u32x2{0u, 0u} : u32x2{pk2(y0, y1), pk2(y2, y3)};
        }
    }
  }
}

template <int H>
DI void pool_window(const u16* sIn, u16* sP, int oc, int seg, int t0, int L) {
  const int tl0 = seg * 8;
  const u16* base = sIn + (tl0 + 8 - H) * 264 + oc * 8;
  float a[8];
#pragma unroll
  for (int k = 0; k < 8; ++k) a[k] = 0.f;
#pragma unroll
  for (int o = 0; o < 2 * H; ++o) {
    const u32x4 v = *reinterpret_cast<const u32x4*>(base + o * 264);
#pragma unroll
    for (int k = 0; k < 4; ++k) { a[2 * k] += bflo(v[k]); a[2 * k + 1] += bfhi(v[k]); }
  }
#pragma unroll
  for (int tt = 0; tt < 8; ++tt) {
    const int t = t0 + tl0 + tt;
    const int lo = max(t - H, 0), hi = min(t + H, L);
    const float ic = 1.f / (float)(hi - lo);
    const u32x4 x = *reinterpret_cast<const u32x4*>(sIn + (tl0 + tt + 8) * 264 + oc * 8);
    u32x4 o;
#pragma unroll
    for (int k = 0; k < 4; ++k) o[k] = pk2(a[2 * k] * ic - bflo(x[k]), a[2 * k + 1] * ic - bfhi(x[k]));
    *reinterpret_cast<u32x4*>(sP + (tl0 + tt) * 264 + oc * 8) = o;
    if (tt < 7) {
      const u32x4 vin = *reinterpret_cast<const u32x4*>(base + (2 * H + tt) * 264);
      const u32x4 vout = *reinterpret_cast<const u32x4*>(base + tt * 264);
#pragma unroll
      for (int k = 0; k < 4; ++k) { a[2 * k] += bflo(vin[k]) - bflo(vout[k]); a[2 * k + 1] += bfhi(vin[k]) - bfhi(vout[k]); }
    }
  }
}

DI void pool_item(const Params& p, int l, int pi, unsigned char* lds) {
  constexpr int NC = 6144;
  const int tid = TIDX, lane = tid & 63, wid = tid >> 6, fr = lane & 15, fq = lane >> 4;
  const int tb = pi >> 2, g = pi & 3, row0 = tb * 64;
  const int L = row0 < TP ? 256 : 4096;
  const int t0 = row0 < TP ? (row0 & 255) : ((row0 - TP) & 4095);
  u16* sIn = reinterpret_cast<u16*>(lds);
  u16* sP = sIn + 80 * 264;
  const u16* PROJ = reinterpret_cast<const u16*>(p.ws + WS_PROJ);
  __syncthreads();
#pragma unroll
  for (int i = 0; i < 10; ++i) {
    const int c = tid + 256 * i, rr = c >> 5, oc = c & 31;
    const int t = t0 - 8 + rr;
    u32x4 v = {0u, 0u, 0u, 0u};
    if (t >= 0 && t < L) v = *reinterpret_cast<const u32x4*>(PROJ + (size_t)(row0 - 8 + rr) * NC + g * 256 + oc * 8);
    *reinterpret_cast<u32x4*>(sIn + rr * 264 + oc * 8) = v;
  }
  __syncthreads();
  {
    const int oc = tid & 31, seg = tid >> 5;
    switch (g) {
      case 0: pool_window<1>(sIn, sP, oc, seg, t0, L); break;
      case 1: pool_window<2>(sIn, sP, oc, seg, t0, L); break;
      case 2: pool_window<4>(sIn, sP, oc, seg, t0, L); break;
      default: pool_window<8>(sIn, sP, oc, seg, t0, L); break;
    }
  }
  __syncthreads();
  const u16* W = reinterpret_cast<const u16*>(p.ws + WS_POOLWT) + (size_t)(l >> 1) * 262144 + (size_t)g * 65536;
  f32x4 acc[4][4];
#pragma unroll
  for (int a = 0; a < 4; ++a)
#pragma unroll
    for (int b = 0; b < 4; ++b) acc[a][b] = f32x4{0.f, 0.f, 0.f, 0.f};
#pragma unroll 4
  for (int ks = 0; ks < 8; ++ks) {
    bf16x8 af[4], bfr[4];
#pragma unroll
    for (int m = 0; m < 4; ++m) af[m] = ld8(sP + (m * 16 + fr) * 264 + ks * 32 + fq * 8);
#pragma unroll
    for (int n = 0; n < 4; ++n) bfr[n] = ld8(W + (size_t)(wid * 64 + n * 16 + fr) * 256 + ks * 32 + fq * 8);
#pragma unroll
    for (int m = 0; m < 4; ++m)
#pragma unroll
      for (int n = 0; n < 4; ++n) acc[m][n] = mfma16(bfr[n], af[m], acc[m][n]);
  }
  const float* pscale = p.in[19 + 10 * l];
  u16* Y = reinterpret_cast<u16*>(p.ws + WS_H);
#pragma unroll
  for (int n = 0; n < 4; ++n) {
    const int col = g * 256 + wid * 64 + n * 16 + 4 * fq;
    const float4 sc = *reinterpret_cast<const float4*>(pscale + col);
#pragma unroll
    for (int m = 0; m < 4; ++m) {
      const int row = row0 + m * 16 + fr;
      const u32x2 gw = *reinterpret_cast<const u32x2*>(PROJ + (size_t)row * NC + 1024 + col);
      float y0 = acc[m][n][0] * sc.x * silu(bflo(gw[0])), y1 = acc[m][n][1] * sc.y * silu(bfhi(gw[0]));
      float y2 = acc[m][n][2] * sc.z * silu(bflo(gw[1])), y3 = acc[m][n][3] * sc.w * silu(bfhi(gw[1]));
      if (ZERO_MASK & 1) { y0 = y1 = y2 = y3 = 0.f; }
      *reinterpret_cast<u32x2*>(Y + (size_t)row * 2048 + col) = u32x2{pk2(y0, y1), pk2(y2, y3)};
    }
  }
}

DI void phase_mix_even(const Params& p, int l, unsigned char* lds, unsigned char* lds_all) {
#pragma unroll 1
  for (int it = blockIdx.x; it < 512; it += gridDim.x) { int bh, qb; heavy_map(it, bh, qb); diff_item(p, l, true, bh, qb, lds_all); }
#pragma unroll 1
  for (int it = blockIdx.x; it < 256; it += gridDim.x) diff_item(p, l, false, it, 0, lds_all);
#pragma unroll 1
  for (int it = VBID; it < 1536; it += VGRID) pool_item(p, l, it, lds);
}

DI void na_item(const Params& p, int l, bool sample, int bh, int qb, unsigned char* lds) {
  constexpr int NC = 7168;
  const int tid = TID8, lane = tid & 63, wid = tid >> 6, r = lane & 31, h = lane >> 5;
  const int b = bh >> 3, hd = bh & 7;
  u16* sQ = reinterpret_cast<u16*>(lds);
  u16* sK = sQ + 256 * 136;
  u16* sVT = sK + 64 * 136;
  float* sBias = reinterpret_cast<float*>(sVT + 128 * 72) + 64;
  const u16* PROJ = reinterpret_cast<const u16*>(p.ws + WS_PROJ);
  const u16* VT = reinterpret_cast<const u16*>(p.ws + WS_VT);
  const int seq0 = sample ? TP + b * 4096 : b * 256;
  const int token = seq0 + qb * 256 + wid * 32 + r;
  AttnSrc s;
  int qr = 0, qc = 0, rsmin = 0;
  f32x16 O[4];
  float lsum;
  const u16* qblk = PROJ + (size_t)(seq0 + qb * 256) * NC + hd * 128;
  if (sample) {
    __syncthreads();
    const float* rpb = p.in[18 + 10 * l] + hd * 465;
    for (int e = tid; e < 465; e += 512) sBias[e] = rpb[e] * LOG2E;
    const int r0 = qb * 4;
    qr = r0 + (wid >> 1); qc = (wid & 1) * 32 + r;
    rsmin = min(max(r0 - 4, 0), 56);
    const int rs1 = min(max(r0 - 1, 0), 56);
    s.k0 = reinterpret_cast<const u16*>(p.ws + WS_CK) + (size_t)l * 2097152 + (size_t)bh * 65536; s.ks0 = 128;
    s.vt0 = reinterpret_cast<const u16*>(p.ws + WS_CVT) + (size_t)l * 2097152 + (size_t)bh * 65536; s.vs0 = 512; s.n0 = 8;
    s.k1 = PROJ + (size_t)(seq0 + rsmin * 64) * NC + 1024 + hd * 128; s.ks1 = NC;
    s.vt1 = VT + 8388608 + (size_t)bh * 128 * 4096 + rsmin * 64; s.vs1 = 4096; s.n1 = rs1 + 8 - rsmin;
    attn_run<128, true>(s, qblk, NC, sQ, sK, sVT, O, lsum, qr, qc, rsmin, sBias);
  } else {
    s.k0 = nullptr; s.vt0 = nullptr; s.ks0 = 0; s.vs0 = 0; s.n0 = 0;
    s.k1 = PROJ + (size_t)seq0 * NC + 1024 + hd * 128; s.ks1 = NC;
    s.vt1 = VT + (size_t)bh * 128 * 256; s.vs1 = 256; s.n1 = 4;
    attn_run<128, false>(s, qblk, NC, sQ, sK, sVT, O, lsum, 0, 0, 0, nullptr);
  }
  const float inv = 1.f / lsum;
  const u16* gp = PROJ + (size_t)token * NC + 3072 + hd * 128;
  u16* yp = reinterpret_cast<u16*>(p.ws + WS_H) + (size_t)token * 2048 + hd * 128;
#pragma unroll
  for (int d = 0; d < 4; ++d)
#pragma unroll
    for (int q = 0; q < 4; ++q) {
      const int dv = d * 32 + 8 * q + 4 * h;
      const u32x2 gw = *reinterpret_cast<const u32x2*>(gp + dv);
      const float y0 = O[d][4 * q] * inv * silu(bflo(gw[0]));
      const float y1 = O[d][4 * q + 1] * inv * silu(bfhi(gw[0]));
      const float y2 = O[d][4 * q + 2] * inv * silu(bflo(gw[1]));
      const float y3 = O[d][4 * q + 3] * inv * silu(bfhi(gw[1]));
      *reinterpret_cast<u32x2*>(yp + dv) = (ZERO_MASK & 4) ? u32x2{0u, 0u} : u32x2{pk2(y0, y1), pk2(y2, y3)};
    }
}

DI void sgu_item(const Params& p, int l, int si, unsigned char* lds) {
  constexpr int NC = 7168;
  const int tid = TIDX, lane = tid & 63, wid = tid >> 6, fr = lane & 15, fq = lane >> 4;
  const int ch = si >> 2, g = si & 3, row0 = ch * 128;
  u16* vnT = reinterpret_cast<u16*>(lds);
  float* sMu = reinterpret_cast<float*>(vnT + 256 * 136);
  float* sRs = sMu + 128;
  const u16* PROJ = reinterpret_cast<const u16*>(p.ws + WS_PROJ);
  __syncthreads();
  {
    const int grp = tid >> 4, ln = tid & 15;
#pragma unroll 2
    for (int rr = 0; rr < 8; ++rr) {
      const u16* src = PROJ + (size_t)(row0 + grp * 8 + rr) * NC + 5120;
      float s = 0.f, ss = 0.f;
#pragma unroll
      for (int c8 = 0; c8 < 8; ++c8) {
        const u32x4 v = *reinterpret_cast<const u32x4*>(src + (ln + 16 * c8) * 8);
#pragma unroll
        for (int k = 0; k < 4; ++k) { const float a = bflo(v[k]), b = bfhi(v[k]); s += a + b; ss += a * a + b * b; }
      }
#pragma unroll
      for (int o = 8; o >= 1; o >>= 1) { s += __shfl_xor(s, o); ss += __shfl_xor(ss, o); }
      const float mu = s * (1.f / 1024.f);
      const float var = fmaxf(ss * (1.f / 1024.f) - mu * mu, 0.f);
      if (ln == 0) { sMu[grp * 8 + rr] = mu; sRs[grp * 8 + rr] = rsqrtf(var + LN_EPS); }
    }
  }
  __syncthreads();
  {
    const int j = tid & 127, hf = tid >> 7;
    const float mu = sMu[j], rs = sRs[j];
    const float* lng = p.in[19 + 10 * l] + g * 256;
    const u16* src = PROJ + (size_t)(row0 + j) * NC + 5120 + g * 256;
#pragma unroll 8
    for (int oc = hf * 16; oc < hf * 16 + 16; ++oc) {
      const u32x4 v = *reinterpret_cast<const u32x4*>(src + oc * 8);
      const float4 g0 = *reinterpret_cast<const float4*>(lng + oc * 8), g1 = *reinterpret_cast<const float4*>(lng + oc * 8 + 4);
      const float gg[8] = {g0.x, g0.y, g0.z, g0.w, g1.x, g1.y, g1.z, g1.w};
#pragma unroll
      for (int k = 0; k < 4; ++k) {
        const float a = (bflo(v[k]) - mu) * rs * gg[2 * k], b = (bfhi(v[k]) - mu) * rs * gg[2 * k + 1];
        const u32 w = pk2(a, b);
        vnT[(oc * 8 + 2 * k) * 136 + j] = (u16)(w & 0xffffu);
        vnT[(oc * 8 + 2 * k + 1) * 136 + j] = (u16)(w >> 16);
      }
    }
  }
  __syncthreads();
  const u16* W = reinterpret_cast<const u16*>(p.ws + WS_SGUW) + (size_t)(l >> 1) * 65536 + (size_t)g * 16384;
  const float* bs = p.in[21 + 10 * l] + g * 128;
  u16* Y = reinterpret_cast<u16*>(p.ws + WS_H);
#pragma unroll 1
  for (int ih = 0; ih < 2; ++ih) {
    f32x4 acc[4][4];
#pragma unroll
    for (int a = 0; a < 4; ++a)
#pragma unroll
      for (int b = 0; b < 4; ++b) acc[a][b] = f32x4{0.f, 0.f, 0.f, 0.f};
#pragma unroll
    for (int ks = 0; ks < 4; ++ks) {
      bf16x8 af[4], bfr[4];
#pragma unroll
      for (int m = 0; m < 4; ++m) af[m] = ld8(W + (size_t)(ih * 64 + m * 16 + fr) * 128 + ks * 32 + fq * 8);
#pragma unroll
      for (int n = 0; n < 4; ++n) bfr[n] = ld8(vnT + (wid * 64 + n * 16 + fr) * 136 + ks * 32 + fq * 8);
#pragma unroll
      for (int m = 0; m < 4; ++m)
#pragma unroll
        for (int n = 0; n < 4; ++n) acc[m][n] = mfma16(bfr[n], af[m], acc[m][n]);
    }
#pragma unroll
    for (int m = 0; m < 4; ++m) {
      const int ii = ih * 64 + m * 16 + fr;
      const float bias = bs[ii];
      const size_t rb = (size_t)(row0 + ii) * NC;
#pragma unroll
      for (int n = 0; n < 4; ++n) {
        const int c = g * 256 + wid * 64 + n * 16 + 4 * fq;
        const u32x2 uw = *reinterpret_cast<const u32x2*>(PROJ + rb + 4096 + c);
        const u32x2 dw = *reinterpret_cast<const u32x2*>(PROJ + rb + 6144 + c);
        float y0 = bflo(uw[0]) * (acc[m][n][0] + bias) * silu(bflo(dw[0])), y1 = bfhi(uw[0]) * (acc[m][n][1] + bias) * silu(bfhi(dw[0]));
        float y2 = bflo(uw[1]) * (acc[m][n][2] + bias) * silu(bflo(dw[1])), y3 = bfhi(uw[1]) * (acc[m][n][3] + bias) * silu(bfhi(dw[1]));
        if (ZERO_MASK & 8) { y0 = y1 = y2 = y3 = 0.f; }
        *reinterpret_cast<u32x2*>(Y + (size_t)(row0 + ii) * 2048 + 1024 + c) = u32x2{pk2(y0, y1), pk2(y2, y3)};
      }
    }
  }
}

DI void phase_mix_odd(const Params& p, int l, unsigned char* lds, unsigned char* lds_all) {
#pragma unroll 1
  for (int it = blockIdx.x; it < 512; it += gridDim.x) { int bh, qb; heavy_map(it, bh, qb); na_item(p, l, true, bh, qb, lds_all); }
#pragma unroll 1
  for (int it = blockIdx.x; it < 256; it += gridDim.x) na_item(p, l, false, it, 0, lds_all);
#pragma unroll 1
  for (int it = VBID; it < 768; it += VGRID) sgu_item(p, l, it, lds);
}

#define XB_TMO      128
#define XB_XCNT(j)  (256  + 64 * (j))
#define XB_XSUB(j)  (1280 + 64 * (j))
#define XB_XGEN(j)  (2304 + 64 * (j))
#define XB_TOP      3328
#define XB_TOPGEN   3392
#define XCD_BAR_WORDS 3456
#define XB_SPIN_CAP (1u << 18)
#define LAS __attribute__((address_space(3)))
DI unsigned xb_ld(unsigned* p)              { return __hip_atomic_load(p, __ATOMIC_RELAXED, __HIP_MEMORY_SCOPE_AGENT); }
DI unsigned xb_add(unsigned* p, unsigned v) { return __hip_atomic_fetch_add(p, v, __ATOMIC_RELAXED, __HIP_MEMORY_SCOPE_AGENT); }
DI unsigned xb_xcc_id() { return (unsigned)__builtin_amdgcn_s_getreg((3 << 11) | 20) & 0xFu; }
#define XB_SPIN(cond, bar) do { unsigned _sp = 0; while (cond) { __builtin_amdgcn_s_sleep(1); \
    if ((++_sp & 255u) == 0u) { if (xb_ld(&(bar)[XB_TMO])) break; if (_sp > XB_SPIN_CAP) { atomicAdd(&(bar)[XB_TMO], 1u); break; } } } } while (0)
struct XcdBarrier { unsigned* bar; unsigned x; volatile LAS unsigned* st; };
DI XcdBarrier xcd_barrier_post(unsigned* bar, volatile LAS unsigned* st) {
  XcdBarrier b; b.bar = bar; b.x = xb_xcc_id(); b.st = st;
  if (threadIdx.x == 0) (void)xb_add(&bar[XB_XCNT(b.x)], 1u);
  return b;
}
DI void xcd_barrier_complete(unsigned* bar, unsigned x, unsigned& nloc, unsigned& nx) {
  const unsigned G = gridDim.x * gridDim.y * gridDim.z;
  unsigned sum, cnt, mine, sp = 0u;
  for (;;) {
    sum = 0u; cnt = 0u; mine = 0u;
#pragma unroll
    for (unsigned j = 0; j < 16; ++j) { const unsigned c = xb_ld(&bar[XB_XCNT(j)]); sum += c; cnt += (c > 0u) ? 1u : 0u; mine = (j == x) ? c : mine; }
    if (sum == G) break;
    __builtin_amdgcn_s_sleep(1);
    if ((++sp & 255u) == 0u) { if (xb_ld(&bar[XB_TMO])) break; if (sp > XB_SPIN_CAP) { atomicAdd(&bar[XB_TMO], 1u); break; } }
  }
  nloc = mine > 0u ? mine : 1u; nx = cnt > 0u ? cnt : 1u;
}
DI void xcd_barrier(const XcdBarrier& b) {
  asm volatile("s_waitcnt vmcnt(0)" ::: "memory");
  __syncthreads();
  if (threadIdx.x == 0) {
    unsigned* bar = b.bar;
    __builtin_amdgcn_s_waitcnt(0);
    unsigned nloc = b.st[0], nx = b.st[1];
    if (nloc == 0u) { xcd_barrier_complete(bar, b.x, nloc, nx); b.st[0] = nloc; b.st[1] = nx; }
    const unsigned old = xb_add(&bar[XB_XSUB(b.x)], 1u);
    const unsigned gen = old / nloc;
    if (old + 1u == (gen + 1u) * nloc) {
      __builtin_amdgcn_fence(__ATOMIC_RELEASE, "agent");
      asm volatile("s_waitcnt vmcnt(0)" ::: "memory");
      const unsigned og = xb_add(&bar[XB_TOP], 1u);
      const unsigned tg = og / nx;
      if (og + 1u == (tg + 1u) * nx) xb_add(&bar[XB_TOPGEN], 1u);
      else XB_SPIN(xb_ld(&bar[XB_TOPGEN]) == tg, bar);
      __builtin_amdgcn_fence(__ATOMIC_ACQUIRE, "agent");
      xb_add(&bar[XB_XGEN(b.x)], 1u);
      asm volatile("s_waitcnt vmcnt(0)" ::: "memory");
    } else {
      XB_SPIN(xb_ld(&bar[XB_XGEN(b.x)]) == gen, bar);
      __builtin_amdgcn_fence(__ATOMIC_ACQUIRE, "agent");
      asm volatile("s_waitcnt vmcnt(0)" ::: "memory");
    }
  }
  __syncthreads();
}

__global__ void __launch_bounds__(512, 2) fwd_megakernel(Params p) {
  extern __shared__ __attribute__((aligned(16))) unsigned char lds[];
  cg::grid_group grid = cg::this_grid();
  volatile LAS unsigned* xst = (volatile LAS unsigned*)(lds + LDS_BYTES - 16);
  if (threadIdx.x == 0) { xst[0] = 0u; xst[1] = 0u; }
  __syncthreads();
  const XcdBarrier xb = xcd_barrier_post(reinterpret_cast<unsigned*>(p.ws + WS_BAR), xst);
  for (int ph = p.ph_lo; ph < p.ph_hi; ++ph) {
    unsigned char* hl = lds + HALF_ID * HALF_LDS;
    if (ph == 0) phase_prep(p, hl);
    else if (ph == 1) phase_mod0(p);
    else {
      const int l = (ph - 2) >> 2, s = (ph - 2) & 3;
      if (s == 0) { if (l & 1) gemm_phase<G_IN_ODD>(p, l, lds); else gemm_phase<G_IN_EVEN>(p, l, lds); }
      else if (s == 1) { if (l & 1) phase_mix_odd(p, l, hl, lds); else phase_mix_even(p, l, hl, lds); }
      else if (s == 2) gemm_phase<G_OUT>(p, l, lds);
      else phase_ln(p, l);
    }
    if (ph + 1 < p.ph_hi) {
      if (p.ph_lo < 0) grid.sync();
      xcd_barrier(xb);
    }
  }
}

extern "C" void kernel_launch(void* const* d_in, const int* in_sizes, int n_in, void* d_out, int out_size, void* d_ws, size_t ws_size,
                              hipStream_t stream) {
  static int grid_blocks = 0;
  if (grid_blocks == 0) {
    if (n_in != 52 || ws_size < WS_END) {
      fprintf(stderr, "kernel_launch: expected 52 inputs and >= %zu bytes of workspace; got %d, %zu\n", (size_t)WS_END, n_in, ws_size);
      grid_blocks = -1;
      return;
    }
    int dev = 0, cus = 0, per_cu = 0;
    hipGetDevice(&dev);
    hipDeviceGetAttribute(&cus, hipDeviceAttributeMultiprocessorCount, dev);
    hipFuncSetAttribute((const void*)fwd_megakernel, hipFuncAttributeMaxDynamicSharedMemorySize, LDS_BYTES);
    hipOccupancyMaxActiveBlocksPerMultiprocessor(&per_cu, (const void*)fwd_megakernel, 512, LDS_BYTES);
    (void)hipGetLastError();
    grid_blocks = cus;
  }
  if (grid_blocks < 0) return;
  Params p{};
  for (int i = 0; i < 52; ++i) p.in[i] = (const float*)d_in[i];
  p.out = (float*)d_out;
  p.ws = (unsigned char*)d_ws;
#if MULTI
  for (int ph = 0; ph < NPHASE; ++ph) {
    p.ph_lo = ph; p.ph_hi = ph + 1;
    hipLaunchKernelGGL(fwd_megakernel, dim3(grid_blocks), dim3(512), LDS_BYTES, stream, p);
  }
#else
  p.ph_lo = 0; p.ph_hi = NPHASE;
  if (hipMemsetAsync((char*)d_ws + WS_BAR, 0, XCD_BAR_WORDS * 4, stream) != hipSuccess) { fprintf(stderr, "kernel_launch: memset of barrier words failed\n"); return; }
  void* args[] = {&p};
  hipError_t e = hipLaunchCooperativeKernel((const void*)fwd_megakernel, dim3(grid_blocks), dim3(512), args, LDS_BYTES, stream);
  if (e != hipSuccess) fprintf(stderr, "cooperative launch failed: %s (grid %d)\n", hipGetErrorString(e), grid_blocks);
#endif
}
```

```cpp
#include <hip/hip_runtime.h>
#include <hip/hip_cooperative_groups.h>
#include <cstdio>
namespace cg = cooperative_groups;

#define DI __device__ __forceinline__
typedef unsigned short u16;
typedef unsigned int u32;
using bf16x8 = __attribute__((ext_vector_type(8))) short;
using f32x4 = __attribute__((ext_vector_type(4))) float;
using f32x16 = __attribute__((ext_vector_type(16))) float;
using u32x4 = __attribute__((ext_vector_type(4))) unsigned;
using u32x2 = __attribute__((ext_vector_type(2))) unsigned;
typedef __bf16 bf2_t __attribute__((ext_vector_type(2)));
typedef float f2_t __attribute__((ext_vector_type(2)));

#ifndef MULTI
#define MULTI 0
#endif
#ifndef REP0
#define REP0 1
#endif
#ifndef REP1
#define REP1 1
#endif
#ifndef ZERO_MASK
#define ZERO_MASK 0
#endif

constexpr int T_ALL = 24576, TP = 8192, DM = 2048;
constexpr float LOG2E = 1.4426950408889634f;
constexpr float ALPHA = 1.6817928305074290f;
constexpr float LN_EPS = 1e-5f;
constexpr int HALF_LDS = 76288;
constexpr int LDS_BYTES = 2 * HALF_LDS + 16;
constexpr int NPHASE = 18;

constexpr size_t SZ_WIN_E = (size_t)6144 * 2048 * 2, SZ_WIN_O = (size_t)7168 * 2048 * 2;
constexpr size_t WS_WINT = 0;
constexpr size_t WS_WOUTT = WS_WINT + 2 * SZ_WIN_E + 2 * SZ_WIN_O;
constexpr size_t WS_POOLWT = WS_WOUTT + (size_t)4 * 2048 * 2048 * 2;
constexpr size_t WS_SGUW = WS_POOLWT + (size_t)2 * 4 * 256 * 256 * 2;
constexpr size_t WS_CK = WS_SGUW + (size_t)2 * 4 * 128 * 128 * 2;
constexpr size_t WS_CVT = WS_CK + (size_t)4 * 4194304;
constexpr size_t WS_MOD = WS_CVT + (size_t)4 * 4194304;
constexpr size_t WS_ROPE = WS_MOD + (size_t)4 * 5 * 6144 * 4;
constexpr size_t WS_H = WS_ROPE + 8192;
constexpr size_t WS_PROJ = WS_H + (size_t)T_ALL * 2048 * 2;
constexpr size_t WS_VT = WS_PROJ + (size_t)T_ALL * 7168 * 2;
constexpr size_t WS_BAR = WS_VT + (size_t)T_ALL * 1024 * 2;
constexpr size_t WS_END = WS_BAR + 16384;

struct Params {
  const float* in[52];
  float* out;
  unsigned char* ws;
  int ph_lo, ph_hi;
};

DI size_t ws_wint(int l) { return WS_WINT + (size_t)(l >> 1) * (SZ_WIN_E + SZ_WIN_O) + ((l & 1) ? SZ_WIN_E : 0); }

DI u32 pk2(float a, float b) { f2_t v = {a, b}; bf2_t r = __builtin_convertvector(v, bf2_t); return __builtin_bit_cast(u32, r); }
DI float bflo(u32 w) { return __uint_as_float(w << 16); }
DI float bfhi(u32 w) { return __uint_as_float(w & 0xffff0000u); }
DI float bf1(u16 w) { return __uint_as_float(((u32)w) << 16); }
DI float ex2(float x) { return __builtin_amdgcn_exp2f(x); }
DI float silu(float x) { return x / (1.f + __expf(-x)); }
DI f32x4 mfma16(bf16x8 a, bf16x8 b, f32x4 c) { return __builtin_amdgcn_mfma_f32_16x16x32_bf16(a, b, c, 0, 0, 0); }
DI f32x16 mfma32(bf16x8 a, bf16x8 b, f32x16 c) { return __builtin_amdgcn_mfma_f32_32x32x16_bf16(a, b, c, 0, 0, 0); }
DI bf16x8 ld8(const u16* p) { return *reinterpret_cast<const bf16x8*>(p); }
DI int opq(int x) { asm volatile("" : "+v"(x)); return x; }
#define TIDX (opq((int)threadIdx.x) & 255)
#define TID8 (opq((int)threadIdx.x))
#define HALF_ID (opq((int)threadIdx.x) >> 8)
#define VBID ((int)((blockIdx.x & 7u) | ((unsigned)HALF_ID << 3) | ((blockIdx.x >> 3) << 4)))
#define VGRID ((int)gridDim.x * 2)

enum { G_IN_EVEN = 0, G_IN_ODD = 1, G_OUT = 2 };

namespace pg8 {
#define PG8_LAS __attribute__((address_space(3)))
typedef unsigned short bf16_t;
typedef short bf16x8 __attribute__((ext_vector_type(8)));
typedef float f32x4 __attribute__((ext_vector_type(4)));
typedef unsigned u32x4 __attribute__((ext_vector_type(4)));
constexpr int BM = 256, BK = 64, HALF = 128, HTB = HALF * BK * 2  , STAGE_BYTES = 8 * HTB, NXCD = 8, WGM = 8;

__host__ __device__ __forceinline__ int lds_byte(int r, int c) { const int st = (r >> 4) * 2 + (c >> 5), rr = r & 15, cc = c & 31, ob = rr * 64 + cc * 2; return st * 1024 + (ob ^ (((ob >> 9) & 1) << 5)); }
__host__ __device__ __forceinline__ void stage_rc(int b, int& R, int& C) { const int st = b / 1024, sb = b % 1024, swz = sb ^ (((sb >> 9) & 1) << 5); R = (st >> 1) * 16 + swz / 64; C = (st & 1) * 32 + (swz % 64) / 2; }
__host__ __device__ __forceinline__ int perm32(int rho) { const int n = rho >> 4, i = rho & 15; return 8 * (i >> 2) + 4 * n + (i & 3); }

struct Unit { int pm, pn; };
struct Gemm { const bf16_t* A; const bf16_t* Bt; int M, N, K; };

struct StaticOrder {
    int nM, nN, nwg, G, c;
    __host__ __device__ void init(int M, int N, int G_, int c_) { nM = M / BM; nN = N / BM; nwg = nM * nN; G = G_; c = c_; }
    __host__ __device__ bool next(int i, Unit& u) const {
        const long L = (long)i * G + c; if (L >= nwg) return false;
        int wgid = (int)L; { const int q = nwg / NXCD, r = nwg % NXCD, xcd = wgid % NXCD, off = wgid / NXCD; wgid = (xcd < r ? xcd * (q + 1) : r * (q + 1) + (xcd - r) * q) + off; }
        const int nig = WGM * nN, gid = wgid / nig, fm = gid * WGM, gsz = (nM - fm) < WGM ? (nM - fm) : WGM;
        u.pm = fm + ((wgid % nig) % gsz); u.pn = (wgid % nig) / gsz; return true;
    }
    __device__ __forceinline__ void a_ready(const Unit&) const {}
    __device__ __forceinline__ void done(const Unit&) const {}
};

template <class Epi, class Sched, bool STAMP = false>
__device__ __forceinline__ void gemm_phase(PG8_LAS unsigned char* lds, const Gemm g, const Sched& S, const Epi& E, unsigned long long* stamps) {
    const int tid = opq((int)threadIdx.x), wid = __builtin_amdgcn_readfirstlane(tid >> 6), lane = tid & 63, wr = wid >> 2, wc = wid & 3, fr = lane & 15, fq = lane >> 4;
    const int K = g.K, nt = K / BK;
    int ts_lo = 0, ts_hi = 0, nts = 0; const unsigned long long rt_entry = STAMP ? (unsigned long long)wall_clock64() : 0ull;
#define PG8_STAMP() do { if (STAMP && wid == 0 && nts < 64) { const unsigned long long _c = (unsigned long long)clock64(); \
        ts_lo = (lane == nts) ? (int)(unsigned)_c : ts_lo; ts_hi = (lane == nts) ? (int)(unsigned)(_c >> 32) : ts_hi; ++nts; } } while (0)
    PG8_STAMP();
    unsigned voffA[2], voffB[2];
#pragma unroll
    for (int i = 0; i < 2; ++i) { int R, C; stage_rc(tid * 16 + i * 8192, R, C); const int Rb = Epi::PERM ? ((R & ~31) + perm32(R & 31)) : R;
        voffA[i] = (unsigned)(R * K + C) * 2u; voffB[i] = (unsigned)(Rb * K + C) * 2u; }
    const size_t kstep = (size_t)(BK * 2);
    const size_t hstep = (size_t)HALF * K * 2;
    const size_t tstep = 2 * hstep;
    const unsigned ldsw = (unsigned)wid * 1024u;
    const int aoff = lds_byte(wr * 64 + fr, fq * 8), boff = lds_byte(wc * 32 + fr, fq * 8);
#define PG8_SA(b, h) (((b) * 2 + (h)) * HTB)
#define PG8_SB(b, h) ((4 + (b) * 2 + (h)) * HTB)
#define PG8_STAGE(bufoff, gbase, voff) do { _Pragma("unroll") for (int _i = 0; _i < 2; ++_i) \
        __builtin_amdgcn_global_load_lds((const unsigned*)((const char*)(gbase) + (voff)[_i]), (PG8_LAS unsigned*)(lds + (bufoff) + ldsw + _i * 8192), 16, 0, 0); } while (0)
#define PG8_LDA(dst, b, h) do { _Pragma("unroll") for (int m = 0; m < 4; ++m) _Pragma("unroll") for (int k = 0; k < 2; ++k) dst[m][k] = *(const PG8_LAS bf16x8*)(lds + PG8_SA(b, h) + aoff + m * 2048 + k * 1024); } while (0)
#define PG8_LDB(dst, b, h) do { _Pragma("unroll") for (int n = 0; n < 2; ++n) _Pragma("unroll") for (int k = 0; k < 2; ++k) dst[n][k] = *(const PG8_LAS bf16x8*)(lds + PG8_SB(b, h) + boff + n * 2048 + k * 1024); } while (0)
#define PG8_MMA(ai, bj, At, Bt) do { __builtin_amdgcn_s_setprio(1); _Pragma("unroll") for (int m = 0; m < 4; ++m) _Pragma("unroll") for (int n = 0; n < 2; ++n) _Pragma("unroll") for (int k = 0; k < 2; ++k) \
        acc[ai][bj][m][n] = __builtin_amdgcn_mfma_f32_16x16x32_bf16(Bt[n][k], At[m][k], acc[ai][bj][m][n], 0, 0, 0); __builtin_amdgcn_s_setprio(0); } while (0)
#define PG8_WAIT_V(n) asm volatile("s_waitcnt vmcnt(" #n ")" ::: "memory")
#define PG8_WAIT_L(n) asm volatile("s_waitcnt lgkmcnt(" #n ")" ::: "memory")
#define PG8_BAR __builtin_amdgcn_s_barrier()
#define PG8_SCHED __builtin_amdgcn_sched_barrier(0)
    Unit cur, nxt; int ui = 0;
    if (!S.next(0, cur)) return;
    f32x4 acc[2][2][4][2];
#pragma unroll
    for (int a = 0; a < 2; ++a)
#pragma unroll
        for (int b = 0; b < 2; ++b)
#pragma unroll
            for (int m = 0; m < 4; ++m)
#pragma unroll
                for (int n = 0; n < 2; ++n) acc[a][b][m][n] = (f32x4){0.f, 0.f, 0.f, 0.f};
    bf16x8 At[4][2], B0[2][2], B1[2][2];
    const char* cA = (const char*)g.A + (size_t)cur.pm * tstep; const char* cB = (const char*)g.Bt + (size_t)cur.pn * tstep;
    S.a_ready(cur);
    PG8_STAGE(PG8_SB(0, 0), cB, voffB); PG8_STAGE(PG8_SA(0, 0), cA, voffA); PG8_STAGE(PG8_SB(0, 1), cB + hstep, voffB); PG8_STAGE(PG8_SA(0, 1), cA + hstep, voffA);
    if (wr == 1) PG8_BAR;
    PG8_WAIT_V(4); PG8_BAR;
    PG8_STAGE(PG8_SB(1, 0), cB + kstep, voffB); PG8_STAGE(PG8_SA(1, 0), cA + kstep, voffA); PG8_STAGE(PG8_SB(1, 1), cB + hstep + kstep, voffB);
    PG8_WAIT_V(6); PG8_BAR;
    PG8_STAMP();
    for (;;) {
        const bool has_next = S.next(ui + 1, nxt);
        const char* nA = has_next ? (const char*)g.A + (size_t)nxt.pm * tstep : cA; const char* nB = has_next ? (const char*)g.Bt + (size_t)nxt.pn * tstep : cB;
        for (int t = 0; t < nt; t += 2) {
            const bool last = (t == nt - 2);
            const char* a1 = cA + (size_t)(t + 1) * kstep;
            const char* a2 = last ? nA : cA + (size_t)(t + 2) * kstep; const char* b2 = last ? nB : cB + (size_t)(t + 2) * kstep;
            const char* a3 = a2 + kstep; const char* b3 = b2 + kstep;
            if (last && has_next) S.a_ready(nxt);
            PG8_LDB(B0, 0, 0); PG8_SCHED; PG8_LDA(At, 0, 0); PG8_STAGE(PG8_SA(1, 1), a1 + hstep, voffA);
            PG8_WAIT_L(8); PG8_BAR; PG8_WAIT_L(0); PG8_MMA(0, 0, At, B0); PG8_BAR; PG8_SCHED;
            PG8_LDB(B1, 0, 1); PG8_STAGE(PG8_SB(0, 0), b2, voffB);
            PG8_BAR; PG8_WAIT_L(0); PG8_MMA(0, 1, At, B1); PG8_BAR;
            PG8_LDA(At, 0, 1); PG8_STAGE(PG8_SA(0, 0), a2, voffA);
            PG8_BAR; PG8_WAIT_L(0); PG8_MMA(1, 0, At, B0); PG8_BAR; PG8_SCHED;
            PG8_STAGE(PG8_SB(0, 1), b2 + hstep, voffB);
            PG8_WAIT_V(6); PG8_BAR; PG8_MMA(1, 1, At, B1); PG8_BAR;
            PG8_LDB(B0, 1, 0); PG8_SCHED; PG8_LDA(At, 1, 0); PG8_STAGE(PG8_SA(0, 1), a2 + hstep, voffA);
            PG8_WAIT_L(8); PG8_BAR; PG8_WAIT_L(0); PG8_MMA(0, 0, At, B0); PG8_BAR; PG8_SCHED;
            PG8_LDB(B1, 1, 1); PG8_STAGE(PG8_SB(1, 0), b3, voffB);
            PG8_BAR; PG8_WAIT_L(0); PG8_MMA(0, 1, At, B1); PG8_BAR;
            PG8_LDA(At, 1, 1); PG8_STAGE(PG8_SA(1, 0), a3, voffA);
            PG8_BAR; PG8_WAIT_L(0); PG8_MMA(1, 0, At, B0); PG8_BAR; PG8_SCHED;
            PG8_STAGE(PG8_SB(1, 1), b3 + hstep, voffB);
            PG8_WAIT_V(6); PG8_BAR; PG8_MMA(1, 1, At, B1); PG8_BAR;
        }
        PG8_STAMP();
        if constexpr (!Epi::AFTER_DRAIN) { E(acc, cur, wr, wc, fr, fq); S.done(cur); }
        PG8_STAMP();
        if (!has_next) break;
#pragma unroll
        for (int a = 0; a < 2; ++a)
#pragma unroll
            for (int b = 0; b < 2; ++b)
#pragma unroll
                for (int m = 0; m < 4; ++m)
#pragma unroll
                    for (int n = 0; n < 2; ++n) acc[a][b][m][n] = (f32x4){0.f, 0.f, 0.f, 0.f};
        cur = nxt; cA = nA; cB = nB; ++ui;
    }
    PG8_WAIT_V(0);
    if (wr == 0) PG8_BAR;
    PG8_BAR;
    if constexpr (Epi::AFTER_DRAIN) { E.fused(acc, cur, wr, wc, fr, fq, lds, wid, lane); S.done(cur); }
    PG8_STAMP();
    if (STAMP && wid == 0) { stamps[lane] = lane < nts ? (((unsigned long long)(unsigned)ts_hi << 32) | (unsigned)ts_lo) : 0ull;
        if (lane == 62) stamps[62] = rt_entry; if (lane == 63) stamps[63] = (unsigned long long)wall_clock64(); }
#undef PG8_STAMP
#undef PG8_SA
#undef PG8_SB
#undef PG8_STAGE
#undef PG8_LDA
#undef PG8_LDB
#undef PG8_MMA
#undef PG8_WAIT_V
#undef PG8_WAIT_L
#undef PG8_BAR
#undef PG8_SCHED
}
}

DI void tr_tile(const float* __restrict__ src, size_t ld_src, u16* __restrict__ dst, size_t ld_dst, float* sT) {
  const int tid = TIDX;
  const int r = tid >> 4, c4 = (tid & 15) * 4;
#pragma unroll
  for (int i = 0; i < 4; ++i) {
    float4 v = *reinterpret_cast<const float4*>(src + (size_t)(r + 16 * i) * ld_src + c4);
    float* d = sT + (r + 16 * i) * 65 + c4;
    d[0] = v.x; d[1] = v.y; d[2] = v.z; d[3] = v.w;
  }
  __syncthreads();
  const int n = tid >> 2, ks = (tid & 3) * 16;
  u32 w[8];
#pragma unroll
  for (int j = 0; j < 8; ++j) w[j] = pk2(sT[(ks + 2 * j) * 65 + n], sT[(ks + 2 * j + 1) * 65 + n]);
  u32x4* o = reinterpret_cast<u32x4*>(dst + (size_t)n * ld_dst + ks);
  o[0] = u32x4{w[0], w[1], w[2], w[3]};
  o[1] = u32x4{w[4], w[5], w[6], w[7]};
  __syncthreads();
}

DI void cvt8(const float* __restrict__ src, u16* __restrict__ dst) {
  float4 a = *reinterpret_cast<const float4*>(src);
  float4 b = *reinterpret_cast<const float4*>(src + 4);
  *reinterpret_cast<u32x4*>(dst) = u32x4{pk2(a.x, a.y), pk2(a.z, a.w), pk2(b.x, b.y), pk2(b.z, b.w)};
}

DI void mod_item(const Params& p, int i, unsigned char* lds) {
  const int tid = TIDX;
  const int l = i / 96, n0 = (i % 96) * 64;
  float* sS = reinterpret_cast<float*>(lds);
  float* red = sS + 5 * 2048;
  const float* c = p.in[10];
  const float* cctx = p.in[11];
  for (int e = tid; e < 5 * 2048; e += 256) {
    int v = e >> 11, k = e & 2047;
    float x = (v == 0) ? cctx[k] : c[(v - 1) * 2048 + k];
    sS[e] = silu(x);
  }
  __syncthreads();
  const int kk = tid >> 4, c4 = (tid & 15) * 4;
  const float* W = p.in[12 + 10 * l] + n0 + c4;
  f32x4 acc[5];
#pragma unroll
  for (int v = 0; v < 5; ++v) acc[v] = f32x4{0.f, 0.f, 0.f, 0.f};
#pragma unroll 8
  for (int k = kk; k < 2048; k += 16) {
    float4 w = *reinterpret_cast<const float4*>(W + (size_t)k * 6144);
#pragma unroll
    for (int v = 0; v < 5; ++v) {
      float s = sS[v * 2048 + k];
      acc[v][0] += s * w.x; acc[v][1] += s * w.y; acc[v][2] += s * w.z; acc[v][3] += s * w.w;
    }
  }
#pragma unroll
  for (int v = 0; v < 5; ++v)
#pragma unroll
    for (int q = 0; q < 4; ++q) red[(kk * 5 + v) * 64 + c4 + q] = acc[v][q];
  __syncthreads();
  for (int t2 = tid; t2 < 320; t2 += 256) {
    int v = t2 >> 6, n = t2 & 63;
    float s = 0.f;
#pragma unroll
    for (int k2 = 0; k2 < 16; ++k2) s += red[(k2 * 5 + v) * 64 + n];
    float* mod = reinterpret_cast<float*>(p.ws + WS_MOD);
    mod[(size_t)(l * 5 + v) * 6144 + n0 + n] = s + p.in[13 + 10 * l][n0 + n];
  }
  __syncthreads();
}

DI void phase_prep(const Params& p, unsigned char* lds) {
  constexpr int N_MOD = 384, N_TRWIN = 13312, N_TRWOUT = 4096, N_TRPOOL = 128, N_SGU = 64, N_CK = 4096, N_CV = 2048;
  constexpr int TOTAL = N_MOD + N_TRWIN + N_TRWOUT + N_TRPOOL + N_SGU + N_CK + N_CV + 1;
  const int tid = TIDX;
  float* sT = reinterpret_cast<float*>(lds);
  for (int it = VBID; it < TOTAL; it += VGRID) {
    int i = it;
    if (i < N_MOD) { mod_item(p, i, lds); continue; }
    i -= N_MOD;
    if (i < N_TRWIN) {
      int l, base;
      if (i < 3072) { l = 0; base = 0; } else if (i < 6656) { l = 1; base = 3072; } else if (i < 9728) { l = 2; base = 6656; } else { l = 3; base = 9728; }
      i -= base;
      const int N = (l & 1) ? 7168 : 6144, nN = N / 64;
      const int kt = i / nN, nt = i % nN;
      tr_tile(p.in[14 + 10 * l] + (size_t)kt * 64 * N + nt * 64, N,
              reinterpret_cast<u16*>(p.ws + ws_wint(l)) + (size_t)nt * 64 * 2048 + kt * 64, 2048, sT);
      continue;
    }
    i -= N_TRWIN;
    if (i < N_TRWOUT) {
      const int l = i >> 10, r = i & 1023, kt = r >> 5, nt = r & 31;
      tr_tile(p.in[15 + 10 * l] + (size_t)kt * 64 * 2048 + nt * 64, 2048,
              reinterpret_cast<u16*>(p.ws + WS_WOUTT) + (size_t)l * 2048 * 2048 + (size_t)nt * 64 * 2048 + kt * 64, 2048, sT);
      continue;
    }
    i -= N_TRWOUT;
    if (i < N_TRPOOL) {
      const int e = i >> 6, r = i & 63, g = r >> 4, t = r & 15, kt = t >> 2, nt = t & 3;
      tr_tile(p.in[18 + 20 * e] + (size_t)g * 65536 + kt * 64 * 256 + nt * 64, 256,
              reinterpret_cast<u16*>(p.ws + WS_POOLWT) + (size_t)e * 262144 + g * 65536 + nt * 64 * 256 + kt * 64, 256, sT);
      continue;
    }
    i -= N_TRPOOL;
    if (i < N_SGU) {
      const int e = i >> 5, ch = i & 31;
      const size_t off = (size_t)ch * 2048 + tid * 8;
      cvt8(p.in[30 + 20 * e] + off, reinterpret_cast<u16*>(p.ws + WS_SGUW) + (size_t)e * 65536 + off);
      continue;
    }
    i -= N_SGU;
    if (i < N_CK) {
      const int l = i >> 10, ch = i & 1023;
      const size_t off = (size_t)ch * 2048 + tid * 8;
      cvt8(p.in[2 + 2 * l] + off, reinterpret_cast<u16*>(p.ws + WS_CK) + (size_t)l * 2097152 + off);
      continue;
    }
    i -= N_CK;
    if (i < N_CV) {
      const int l = i >> 9, r = i & 511, bh = r >> 4, t = r & 15, kt = t >> 1, nt = t & 1;
      tr_tile(p.in[3 + 2 * l] + (size_t)bh * 65536 + kt * 64 * 128 + nt * 64, 128,
              reinterpret_cast<u16*>(p.ws + WS_CVT) + (size_t)l * 2097152 + (size_t)bh * 65536 + nt * 64 * 512 + kt * 64, 512, sT);
      continue;
    }
    {
      float* rc = reinterpret_cast<float*>(p.ws + WS_ROPE);
      for (int e = tid; e < 1024; e += 256) {
        int pos = e >> 4, fi = e & 15;
        float inv = 1.0f / powf(10000.0f, (float)(2 * fi) / 32.0f);
        float ang = (float)pos * inv;
        rc[e] = cosf(ang);
        rc[1024 + e] = sinf(ang);
      }
    }
  }
}

DI void phase_mod0(const Params& p) {
  const int tid = TIDX;
  const float* mod = reinterpret_cast<const float*>(p.ws + WS_MOD);
  u16* H = reinterpret_cast<u16*>(p.ws + WS_H);
  for (int it = VBID; it < T_ALL / 4; it += VGRID) {
#pragma unroll
    for (int rr = 0; rr < 4; ++rr) {
      const int row = it * 4 + rr;
      const int cond = row < TP ? 0 : 1 + ((row - TP) >> 12);
      const float* src = row < TP ? p.in[0] + (size_t)row * 2048 : p.in[1] + (size_t)(row - TP) * 2048;
      const int e = tid * 8;
      const float* sh = mod + (size_t)cond * 6144 + e;
      float4 a = *reinterpret_cast<const float4*>(src + e), b = *reinterpret_cast<const float4*>(src + e + 4);
      float4 s0 = *reinterpret_cast<const float4*>(sh), s1 = *reinterpret_cast<const float4*>(sh + 4);
      float4 c0 = *reinterpret_cast<const float4*>(sh + 2048), c1 = *reinterpret_cast<const float4*>(sh + 2052);
      u32x4 o = {pk2(a.x * (1.f + c0.x) + s0.x, a.y * (1.f + c0.y) + s0.y), pk2(a.z * (1.f + c0.z) + s0.z, a.w * (1.f + c0.w) + s0.w),
                 pk2(b.x * (1.f + c1.x) + s1.x, b.y * (1.f + c1.y) + s1.y), pk2(b.z * (1.f + c1.z) + s1.z, b.w * (1.f + c1.w) + s1.w)};
      *reinterpret_cast<u32x4*>(H + (size_t)row * 2048 + e) = o;
    }
  }
}


template <int MODE>
struct EpiIn {
  static constexpr bool PERM = false, AFTER_DRAIN = false;
  u16* PROJ; u16* VT; float* kout; float* vout; const float* ropeC; const float* ropeS;
  DI void operator()(const f32x4 (&acc)[2][2][4][2], const pg8::Unit& u, int wr, int wc, int fr, int fq) const {
    constexpr int NC = (MODE == G_IN_EVEN) ? 6144 : 7168;
    constexpr int SEC_Q = (MODE == G_IN_EVEN) ? 2 : 0, SEC_K = (MODE == G_IN_EVEN) ? 3 : 1, SEC_V = (MODE == G_IN_EVEN) ? 4 : 2;
    const int sec = u.pn >> 2;
    const bool prompt = u.pm < 32;
    const bool isq = sec == SEC_Q, isk = sec == SEC_K;
    const bool rope = (MODE == G_IN_EVEN) && (isq || isk) && !prompt;
    const float sc = isq ? ((MODE == G_IN_EVEN) ? 0.125f * LOG2E : 0.08838834764831845f * LOG2E) : 1.0f;
#pragma unroll
    for (int ai = 0; ai < 2; ++ai)
#pragma unroll
      for (int m = 0; m < 4; ++m) {
        const int row = u.pm * 256 + ai * 128 + wr * 64 + m * 16 + fr;
        int b, t;
        if (prompt) { b = row >> 8; t = row & 255; } else { const int rs = row - TP; b = rs >> 12; t = rs & 4095; }
#pragma unroll
        for (int bj = 0; bj < 2; ++bj) {
          const int hh = (u.pn & 3) * 2 + bj;
          const int d0 = wc * 32 + 4 * fq;
          if (sec == SEC_V) {
#pragma unroll
            for (int n = 0; n < 2; ++n) {
              const f32x4 v = acc[ai][bj][m][n];
              const int dv = d0 + 16 * n;
              const u32 w01 = pk2(v[0], v[1]), w23 = pk2(v[2], v[3]);
              if (prompt) {
                u16* vt = VT + ((size_t)((b * 8 + hh) * 128 + dv)) * 256 + t;
                vt[0] = (u16)(w01 & 0xffffu); vt[256] = (u16)(w01 >> 16); vt[512] = (u16)(w23 & 0xffffu); vt[768] = (u16)(w23 >> 16);
                *reinterpret_cast<float4*>(vout + ((size_t)((b * 8 + hh) * 256 + t)) * 128 + dv) = float4{v[0], v[1], v[2], v[3]};
              } else {
                u16* vt = VT + 8388608 + ((size_t)((b * 8 + hh) * 128 + dv)) * 4096 + t;
                vt[0] = (u16)(w01 & 0xffffu); vt[4096] = (u16)(w01 >> 16); vt[8192] = (u16)(w23 & 0xffffu); vt[12288] = (u16)(w23 >> 16);
              }
            }
          } else {
            f32x4 v0 = acc[ai][bj][m][0], v1 = acc[ai][bj][m][1];
            if (isk && prompt) {
              float* ko = kout + ((size_t)((b * 8 + hh) * 256 + t)) * 128 + d0;
              *reinterpret_cast<float4*>(ko) = float4{v0[0], v0[1], v0[2], v0[3]};
              *reinterpret_cast<float4*>(ko + 16) = float4{v1[0], v1[1], v1[2], v1[3]};
            }
            if (rope) {
              const int pos = (wc & 1) ? (t & 63) : (t >> 6);
              const float4 cs = *reinterpret_cast<const float4*>(ropeC + pos * 16 + 4 * fq);
              const float4 sn = *reinterpret_cast<const float4*>(ropeS + pos * 16 + 4 * fq);
              const float c4[4] = {cs.x, cs.y, cs.z, cs.w}, s4[4] = {sn.x, sn.y, sn.z, sn.w};
#pragma unroll
              for (int j = 0; j < 4; ++j) {
                const float x1 = v0[j], x2 = v1[j];
                v0[j] = x1 * c4[j] - x2 * s4[j];
                v1[j] = x1 * s4[j] + x2 * c4[j];
              }
            }
            u16* dst = PROJ + (size_t)row * NC + u.pn * 256 + bj * 128 + d0;
            *reinterpret_cast<u32x2*>(dst) = u32x2{pk2(v0[0] * sc, v0[1] * sc), pk2(v0[2] * sc, v0[3] * sc)};
            *reinterpret_cast<u32x2*>(dst + 16) = u32x2{pk2(v1[0] * sc, v1[1] * sc), pk2(v1[2] * sc, v1[3] * sc)};
          }
        }
      }
  }
};

struct EpiOut {
  static constexpr bool PERM = false, AFTER_DRAIN = false;
  float* X; const float* x0; const float* x1; const float* mod; int l;
  DI void operator()(const f32x4 (&acc)[2][2][4][2], const pg8::Unit& u, int wr, int wc, int fr, int fq) const {
    const bool prompt = u.pm < 32;
    const int cond = prompt ? 0 : 1 + ((u.pm * 256 - TP) >> 12);
    const float* gate = mod + (size_t)(l * 5 + cond) * 6144 + 4096;
#pragma unroll
    for (int bj = 0; bj < 2; ++bj)
#pragma unroll
      for (int n = 0; n < 2; ++n) {
        const int col = u.pn * 256 + bj * 128 + wc * 32 + 16 * n + 4 * fq;
        const float4 g4 = *reinterpret_cast<const float4*>(gate + col);
#pragma unroll
        for (int ai = 0; ai < 2; ++ai)
#pragma unroll
          for (int m = 0; m < 4; ++m) {
            const int row = u.pm * 256 + ai * 128 + wr * 64 + m * 16 + fr;
            float4 xo;
            if (l == 0) xo = prompt ? *reinterpret_cast<const float4*>(x0 + (size_t)row * 2048 + col)
                                    : *reinterpret_cast<const float4*>(x1 + (size_t)(row - TP) * 2048 + col);
            else xo = *reinterpret_cast<const float4*>(X + (size_t)row * 2048 + col);
            const f32x4 a = acc[ai][bj][m][n];
            float4 o;
            o.x = ALPHA * xo.x + g4.x * a[0]; o.y = ALPHA * xo.y + g4.y * a[1];
            o.z = ALPHA * xo.z + g4.z * a[2]; o.w = ALPHA * xo.w + g4.w * a[3];
            *reinterpret_cast<float4*>(X + (size_t)row * 2048 + col) = o;
          }
      }
  }
};

template <int MODE>
DI void gemm_phase(const Params& p, int l, unsigned char* lds) {
  constexpr int N = (MODE == G_OUT) ? 2048 : (MODE == G_IN_EVEN ? 6144 : 7168);
  pg8::Gemm g;
  g.A = reinterpret_cast<const u16*>(p.ws + WS_H);
  g.Bt = (MODE == G_OUT) ? reinterpret_cast<const u16*>(p.ws + WS_WOUTT) + (size_t)l * 2048 * 2048
                         : reinterpret_cast<const u16*>(p.ws + ws_wint(l));
  g.M = T_ALL; g.N = N; g.K = 2048;
  pg8::StaticOrder S;
  S.init(T_ALL, N, (int)gridDim.x, (int)blockIdx.x);
  PG8_LAS unsigned char* l3 = (PG8_LAS unsigned char*)lds;
  if constexpr (MODE == G_OUT) {
    EpiOut E;
    E.X = p.out; E.x0 = p.in[0]; E.x1 = p.in[1]; E.mod = reinterpret_cast<const float*>(p.ws + WS_MOD); E.l = l;
    pg8::gemm_phase<EpiOut, pg8::StaticOrder, false>(l3, g, S, E, nullptr);
  } else {
    EpiIn<MODE> E;
    E.PROJ = reinterpret_cast<u16*>(p.ws + WS_PROJ); E.VT = reinterpret_cast<u16*>(p.ws + WS_VT);
    E.kout = p.out + (size_t)T_ALL * 2048 + (size_t)(2 * l) * 8388608;
    E.vout = p.out + (size_t)T_ALL * 2048 + (size_t)(2 * l + 1) * 8388608;
    E.ropeC = reinterpret_cast<const float*>(p.ws + WS_ROPE); E.ropeS = E.ropeC + 1024;
    pg8::gemm_phase<EpiIn<MODE>, pg8::StaticOrder, false>(l3, g, S, E, nullptr);
  }
}

DI void phase_ln(const Params& p, int l) {
  const int tid_ = TIDX, lane = tid_ & 63, wid = tid_ >> 6;
  const float* g = p.in[16 + 10 * l];
  const float* bb = p.in[17 + 10 * l];
  const float* mod = reinterpret_cast<const float*>(p.ws + WS_MOD);
  u16* H = reinterpret_cast<u16*>(p.ws + WS_H);
  float* X = p.out;
  for (int it = VBID; it < T_ALL / 4; it += VGRID) {
    const int row = it * 4 + wid;
    float* xr = X + (size_t)row * 2048;
    float4 v[8];
    float s = 0.f;
#pragma unroll
    for (int i = 0; i < 8; ++i) {
      v[i] = *reinterpret_cast<const float4*>(xr + (i * 64 + lane) * 4);
      s += v[i].x + v[i].y + v[i].z + v[i].w;
    }
#pragma unroll
    for (int o = 32; o >= 1; o >>= 1) s += __shfl_xor(s, o);
    const float mu = s * (1.f / 2048.f);
    float ss = 0.f;
#pragma unroll
    for (int i = 0; i < 8; ++i) {
      float a = v[i].x - mu, b = v[i].y - mu, c = v[i].z - mu, d = v[i].w - mu;
      ss += a * a + b * b + c * c + d * d;
    }
#pragma unroll
    for (int o = 32; o >= 1; o >>= 1) ss += __shfl_xor(ss, o);
    const float rstd = rsqrtf(ss * (1.f / 2048.f) + LN_EPS);
    const int cond = row < TP ? 0 : 1 + ((row - TP) >> 12);
    const float* sh = mod + (size_t)((l + 1) * 5 + cond) * 6144;
#pragma unroll
    for (int i = 0; i < 8; ++i) {
      const int e = (i * 64 + lane) * 4;
      float4 gg = *reinterpret_cast<const float4*>(g + e), b4 = *reinterpret_cast<const float4*>(bb + e);
      float4 y;
      y.x = (v[i].x - mu) * rstd * gg.x + b4.x; y.y = (v[i].y - mu) * rstd * gg.y + b4.y;
      y.z = (v[i].z - mu) * rstd * gg.z + b4.z; y.w = (v[i].w - mu) * rstd * gg.w + b4.w;
      *reinterpret_cast<float4*>(xr + e) = y;
      if (l < 3) {
        float4 s0 = *reinterpret_cast<const float4*>(sh + e), c0 = *reinterpret_cast<const float4*>(sh + 2048 + e);
        u32x2 o = {pk2(y.x * (1.f + c0.x) + s0.x, y.y * (1.f + c0.y) + s0.y), pk2(y.z * (1.f + c0.z) + s0.z, y.w * (1.f + c0.w) + s0.w)};
        *reinterpret_cast<u32x2*>(H + (size_t)row * 2048 + e) = o;
      }
    }
  }
}

struct AttnSrc {
  const u16* k0; const u16* vt0; int ks0, vs0, n0;
  const u16* k1; const u16* vt1; int ks1, vs1, n1;
};

template <int DQK>
DI void attn_ldg(const AttnSrc& s, int j, u32x4 (&rk)[DQK / 64], u32x4 (&rv)[2]) {
  const u16* kb; const u16* vb; int ks, vs;
  if (j < s.n0) { kb = s.k0 + (size_t)j * 64 * s.ks0; vb = s.vt0 + j * 64; ks = s.ks0; vs = s.vs0; }
  else { const int jj = j - s.n0; kb = s.k1 + (size_t)jj * 64 * s.ks1; vb = s.vt1 + jj * 64; ks = s.ks1; vs = s.vs1; }
  constexpr int CPR = DQK / 8;
  const int tid = TID8;
#pragma unroll
  for (int i = 0; i < DQK / 64; ++i) {
    const int c = tid + 512 * i, row = c / CPR, kc = c % CPR;
    rk[i] = *reinterpret_cast<const u32x4*>(kb + (size_t)row * ks + kc * 8);
  }
#pragma unroll
  for (int i = 0; i < 2; ++i) {
    const int c = tid + 512 * i, row = c >> 3, kc = c & 7;
    rv[i] = *reinterpret_cast<const u32x4*>(vb + (size_t)row * vs + kc * 8);
  }
}
template <int DQK>
DI void attn_sts(u16* sK, u16* sVT, const u32x4 (&rk)[DQK / 64], const u32x4 (&rv)[2]) {
  constexpr int CPR = DQK / 8;
  const int tid = TID8;
#pragma unroll
  for (int i = 0; i < DQK / 64; ++i) {
    const int c = tid + 512 * i, row = c / CPR, kc = c % CPR;
    *reinterpret_cast<u32x4*>(sK + row * (DQK + 8) + kc * 8) = rk[i];
  }
#pragma unroll
  for (int i = 0; i < 2; ++i) {
    const int c = tid + 512 * i, row = c >> 3, kc = c & 7;
    *reinterpret_cast<u32x4*>(sVT + row * 72 + kc * 8) = rv[i];
  }
}

DI void attn_pv(const f32x16 (&s)[2], const u16* vw, f32x16 (&O)[4]) {
  __builtin_amdgcn_s_setprio(1);
#pragma unroll
  for (int s4 = 0; s4 < 4; ++s4) {
    const int t = s4 >> 1, b0 = (s4 & 1) * 8;
    u32x4 w = {pk2(s[t][b0], s[t][b0 + 1]), pk2(s[t][b0 + 2], s[t][b0 + 3]), pk2(s[t][b0 + 4], s[t][b0 + 5]), pk2(s[t][b0 + 6], s[t][b0 + 7])};
    const bf16x8 pf = __builtin_bit_cast(bf16x8, w);
#pragma unroll
    for (int d = 0; d < 4; ++d) {
      bf16x8 a = ld8(vw + d * 32 * 72 + s4 * 16);
      O[d] = mfma32(a, pf, O[d]);
    }
  }
  __builtin_amdgcn_s_setprio(0);
}

template <int DQK, bool NA>
DI void attn_run(const AttnSrc& src, const u16* qblk, int qstride, u16* sQ, u16* sK, u16* sVT, f32x16 (&O)[4], float& l_out,
                 int qr, int qc, int rsmin, const float* sBias) {
  const int tid = TID8, lane = tid & 63, wid = tid >> 6;
  const int r = lane & 31, h = lane >> 5;
  const int pr = (r & 0x13) | ((r & 4) << 1) | ((r & 8) >> 1);
  constexpr int CPR = DQK / 8, QS = DQK + 8;
  __syncthreads();
  constexpr bool QREG = (DQK == 64);
  bf16x8 qf[QREG ? DQK / 16 : 1];
  if constexpr (QREG) {
#pragma unroll
    for (int ks = 0; ks < DQK / 16; ++ks) qf[ks] = ld8(qblk + (size_t)(wid * 32 + r) * qstride + ks * 16 + 8 * h);
  } else {
#pragma unroll
    for (int i = 0; i < DQK / 16; ++i) {
      const int c = tid + 512 * i, row = c / CPR, kc = c % CPR;
      *reinterpret_cast<u32x4*>(sQ + row * QS + kc * 8) = *reinterpret_cast<const u32x4*>(qblk + (size_t)row * qstride + kc * 8);
    }
  }
#pragma unroll
  for (int d = 0; d < 4; ++d)
#pragma unroll
    for (int i = 0; i < 16; ++i) O[d][i] = 0.f;
  float m = -1e30f, l = 0.f;
  const int nt = src.n0 + src.n1;
  const int rsq = min(max(qr - 4, 0), 56);
  const int cs = min(max(qc - 8, 0), 48);
  const u16* qw = sQ + (wid * 32 + r) * QS + 8 * h;
  u16* sVT1 = sVT + 128 * 72 + 2048;
  const bool grpB = wid >= 4;
  bool pend = false;
  f32x16 s[2];
  u32x4 rk[DQK / 64], rv[2];
  attn_ldg<DQK>(src, 0, rk, rv);
  constexpr bool SB = QREG;
  u16* sKb1 = sQ + 16384;
  int vi = 0;
  if constexpr (SB) {
    attn_sts<DQK>(sK, sVT, rk, rv);
    if (nt > 1) attn_ldg<DQK>(src, 1, rk, rv);
    __syncthreads();
  }
#pragma unroll 1
  for (int j = 0; j < nt; ++j) {
    const u16* kw;
    u16* vcur;
    const u16* vprev;
    if constexpr (SB) {
      u16* vnext = (vi == 0) ? sVT1 : ((vi == 1) ? sQ : sVT);
      vcur = (vi == 0) ? sVT : ((vi == 1) ? sVT1 : sQ);
      vprev = (vi == 0) ? sQ : ((vi == 1) ? sVT : sVT1);
      if (j + 1 < nt) attn_sts<DQK>((j & 1) ? sK : sKb1, vnext, rk, rv);
      if (j + 2 < nt) attn_ldg<DQK>(src, j + 2, rk, rv);
      kw = ((j & 1) ? sKb1 : sK) + pr * QS + 8 * h;
      vi = (vi == 2) ? 0 : vi + 1;
    } else {
      if (j > 0) __syncthreads();
      vcur = (j & 1) ? sVT1 : sVT;
      vprev = (j & 1) ? sVT : sVT1;
      attn_sts<DQK>(sK, vcur, rk, rv);
      __syncthreads();
      if (j + 1 < nt) attn_ldg<DQK>(src, j + 1, rk, rv);
      kw = sK + pr * QS + 8 * h;
    }
    __builtin_amdgcn_sched_barrier(0);
    if (grpB && pend) { attn_pv(s, vprev + r * 72 + 8 * h, O); pend = false; }
    bool active = true;
    int kr = 0;
    if (NA && j >= src.n0) { kr = rsmin + (j - src.n0); active = (kr >= rsq) && (kr < rsq + 8); }
    if (active) {
      __builtin_amdgcn_s_setprio(1);
#pragma unroll
      for (int t = 0; t < 2; ++t) {
#pragma unroll
        for (int i = 0; i < 16; ++i) s[t][i] = 0.f;
#pragma unroll
        for (int ks = 0; ks < DQK / 16; ++ks) {
          bf16x8 a = ld8(kw + t * 32 * QS + ks * 16);
          bf16x8 q;
          if constexpr (QREG) q = qf[ks]; else q = ld8(qw + ks * 16);
          s[t] = mfma32(a, q, s[t]);
        }
      }
      __builtin_amdgcn_s_setprio(0);
      if (NA && j >= src.n0) {
        const float* bp = sBias + (kr - qr + 7) * 31 + (8 * h - qc + 15);
        const int kb = 8 * h - cs;
#pragma unroll
        for (int t = 0; t < 2; ++t)
#pragma unroll
          for (int i = 0; i < 16; ++i) {
            const int ko = t * 32 + 16 * (i >> 3) + (i & 7);
            const bool ok = (unsigned)(ko + kb) < 16u;
            const float bv = bp[ko];
            s[t][i] = ok ? s[t][i] + bv : -1e30f;
          }
      }
      float mx = -1e30f;
#pragma unroll
      for (int t = 0; t < 2; ++t)
#pragma unroll
        for (int i = 0; i < 16; ++i) mx = fmaxf(mx, s[t][i]);
      if (__builtin_amdgcn_ballot_w64(mx > m + 8.0f) != 0ull) {
        mx = fmaxf(mx, __shfl_xor(mx, 32));
        const float mn = fmaxf(m, mx);
        const float alpha = ex2(m - mn);
        l *= alpha;
        m = mn;
#pragma unroll
        for (int d = 0; d < 4; ++d)
#pragma unroll
          for (int i = 0; i < 16; ++i) O[d][i] *= alpha;
      }
      float rsum = 0.f;
#pragma unroll
      for (int t = 0; t < 2; ++t)
#pragma unroll
        for (int i = 0; i < 16; ++i) { const float e = ex2(s[t][i] - m); s[t][i] = e; rsum += e; }
      l += rsum;
      if (!grpB) attn_pv(s, vcur + r * 72 + 8 * h, O);
      else pend = true;
    }
    if constexpr (SB) __syncthreads();
  }
  if (grpB && pend) {
    const u16* vlast;
    if constexpr (SB) vlast = (vi == 1) ? sVT : ((vi == 2) ? sVT1 : sQ);
    else vlast = ((nt - 1) & 1) ? sVT1 : sVT;
    attn_pv(s, vlast + r * 72 + 8 * h, O);
  }
  l_out = l + __shfl_xor(l, 32);
}

DI void heavy_map(int it, int& bh, int& qb) { const int x = it & 7, rest = it >> 3; qb = rest & 15; bh = x + 8 * (rest >> 4); }

DI void diff_item(const Params& p, int l, bool sample, int bh, int qb, unsigned char* lds) {
  constexpr int NC = 6144;
  const int tid_ = TID8, lane = tid_ & 63, wid = tid_ >> 6, r = lane & 31, h = lane >> 5;
  const int b = bh >> 3, hd = bh & 7;
  u16* sQ = reinterpret_cast<u16*>(lds);
  u16* sK = sQ + 256 * 136;
  u16* sVT = sK + 64 * 136;
  const u16* PROJ = reinterpret_cast<const u16*>(p.ws + WS_PROJ);
  const u16* VT = reinterpret_cast<const u16*>(p.ws + WS_VT);
  const int seq0 = sample ? TP + b * 4096 : b * 256;
  const int token = seq0 + qb * 256 + wid * 32 + r;
  const float* dl = p.in[20 + 10 * l];
  float pa = dl[lane] * dl[64 + lane], pb = dl[128 + lane] * dl[192 + lane];
#pragma unroll
  for (int o = 32; o >= 1; o >>= 1) { pa += __shfl_xor(pa, o); pb += __shfl_xor(pb, o); }
  const float lam_init = 0.8f - 0.6f * __expf(-0.3f * (float)l);
  const float lam = __expf(pa) - __expf(pb) + lam_init;

  u32 o1p[32];
  f32x16 O[4];
  float lsum;
#pragma unroll
  for (int comp = 0; comp < 2; ++comp) {
    AttnSrc s;
    if (sample) {
      s.k0 = reinterpret_cast<const u16*>(p.ws + WS_CK) + (size_t)l * 2097152 + (size_t)bh * 65536 + comp * 64; s.ks0 = 128;
      s.vt0 = reinterpret_cast<const u16*>(p.ws + WS_CVT) + (size_t)l * 2097152 + (size_t)bh * 65536; s.vs0 = 512; s.n0 = 8;
      s.k1 = PROJ + (size_t)seq0 * NC + 3072 + hd * 128 + comp * 64; s.ks1 = NC;
      s.vt1 = VT + 8388608 + (size_t)bh * 128 * 4096; s.vs1 = 4096; s.n1 = 64;
    } else {
      s.k0 = nullptr; s.vt0 = nullptr; s.ks0 = 0; s.vs0 = 0; s.n0 = 0;
      s.k1 = PROJ + (size_t)seq0 * NC + 3072 + hd * 128 + comp * 64; s.ks1 = NC;
      s.vt1 = VT + (size_t)bh * 128 * 256; s.vs1 = 256; s.n1 = 4;
    }
    const u16* qblk = PROJ + (size_t)(seq0 + qb * 256) * NC + 2048 + hd * 128 + comp * 64;
    attn_run<64, false>(s, qblk, NC, sQ, sK, sVT, O, lsum, 0, 0, 0, nullptr);
    const float inv = 1.f / lsum;
    if (comp == 0) {
#pragma unroll
      for (int d = 0; d < 4; ++d)
#pragma unroll
        for (int i = 0; i < 8; ++i) o1p[d * 8 + i] = pk2(O[d][2 * i] * inv, O[d][2 * i + 1] * inv);
    } else {
      float ssq = 0.f;
#pragma unroll
      for (int d = 0; d < 4; ++d)
#pragma unroll
        for (int i = 0; i < 8; ++i) {
          const u32 w = o1p[d * 8 + i];
          const float a = bflo(w) - lam * O[d][2 * i] * inv, c = bfhi(w) - lam * O[d][2 * i + 1] * inv;
          O[d][2 * i] = a; O[d][2 * i + 1] = c;
          ssq += a * a + c * c;
        }
      ssq += __shfl_xor(ssq, 32);
      const float rn = rsqrtf(ssq * (1.f / 128.f) + LN_EPS) * (1.f - lam_init);
      const float* subln = p.in[21 + 10 * l];
      const u16* gp = PROJ + (size_t)token * NC + 5120 + hd * 128;
      u16* yp = reinterpret_cast<u16*>(p.ws + WS_H) + (size_t)token * 2048 + 1024 + hd * 128;
#pragma unroll
      for (int d = 0; d < 4; ++d)
#pragma unroll
        for (int q = 0; q < 4; ++q) {
          const int dv = d * 32 + 8 * q + 4 * h;
          const u32x2 gw = *reinterpret_cast<const u32x2*>(gp + dv);
          const float4 sl = *reinterpret_cast<const float4*>(subln + dv);
          const float y0 = O[d][4 * q] * rn * sl.x * silu(bflo(gw[0]));
          const float y1 = O[d][4 * q + 1] * rn * sl.y * silu(bfhi(gw[0]));
          const float y2 = O[d][4 * q + 2] * rn * sl.z * silu(bflo(gw[1]));
          const float y3 = O[d][4 * q + 3] * rn * sl.w * silu(bfhi(gw[1]));
          *reinterpret_cast<u32x2*>(yp + dv) = (ZERO_MASK & 2) ? u32x2{0u, 0u} : u32x2{pk2(y0, y1), pk2(y2, y3)};
        }
    }
  }
}

template <int H>
DI void pool_window(const u16* sIn, u16* sP, int oc, int seg, int t0, int L) {
  const int tl0 = seg * 8;
  const u16* base = sIn + (tl0 + 8 - H) * 264 + oc * 8;
  float a[8];
#pragma unroll
  for (int k = 0; k < 8; ++k) a[k] = 0.f;
#pragma unroll
  for (int o = 0; o < 2 * H; ++o) {
    const u32x4 v = *reinterpret_cast<const u32x4*>(base + o * 264);
#pragma unroll
    for (int k = 0; k < 4; ++k) { a[2 * k] += bflo(v[k]); a[2 * k + 1] += bfhi(v[k]); }
  }
#pragma unroll
  for (int tt = 0; tt < 8; ++tt) {
    const int t = t0 + tl0 + tt;
    const int lo = max(t - H, 0), hi = min(t + H, L);
    const float ic = 1.f / (float)(hi - lo);
    const u32x4 x = *reinterpret_cast<const u32x4*>(sIn + (tl0 + tt + 8) * 264 + oc * 8);
    u32x4 o;
#pragma unroll
    for (int k = 0; k < 4; ++k) o[k] = pk2(a[2 * k] * ic - bflo(x[k]), a[2 * k + 1] * ic - bfhi(x[k]));
    *reinterpret_cast<u32x4*>(sP + (tl0 + tt) * 264 + oc * 8) = o;
    if (tt < 7) {
      const u32x4 vin = *reinterpret_cast<const u32x4*>(base + (2 * H + tt) * 264);
      const u32x4 vout = *reinterpret_cast<const u32x4*>(base + tt * 264);
#pragma unroll
      for (int k = 0; k < 4; ++k) { a[2 * k] += bflo(vin[k]) - bflo(vout[k]); a[2 * k + 1] += bfhi(vin[k]) - bfhi(vout[k]); }
    }
  }
}

DI void pool_item(const Params& p, int l, int pi, unsigned char* lds) {
  constexpr int NC = 6144;
  const int tid = TIDX, lane = tid & 63, wid = tid >> 6, fr = lane & 15, fq = lane >> 4;
  const int tb = pi >> 2, g = pi & 3, row0 = tb * 64;
  const int L = row0 < TP ? 256 : 4096;
  const int t0 = row0 < TP ? (row0 & 255) : ((row0 - TP) & 4095);
  u16* sIn = reinterpret_cast<u16*>(lds);
  u16* sP = sIn + 80 * 264;
  const u16* PROJ = reinterpret_cast<const u16*>(p.ws + WS_PROJ);
  __syncthreads();
#pragma unroll
  for (int i = 0; i < 10; ++i) {
    const int c = tid + 256 * i, rr = c >> 5, oc = c & 31;
    const int t = t0 - 8 + rr;
    u32x4 v = {0u, 0u, 0u, 0u};
    if (t >= 0 && t < L) v = *reinterpret_cast<const u32x4*>(PROJ + (size_t)(row0 - 8 + rr) * NC + g * 256 + oc * 8);
    *reinterpret_cast<u32x4*>(sIn + rr * 264 + oc * 8) = v;
  }
  __syncthreads();
  {
    const int oc = tid & 31, seg = tid >> 5;
    switch (g) {
      case 0: pool_window<1>(sIn, sP, oc, seg, t0, L); break;
      case 1: pool_window<2>(sIn, sP, oc, seg, t0, L); break;
      case 2: pool_window<4>(sIn, sP, oc, seg, t0, L); break;
      default: pool_window<8>(sIn, sP, oc, seg, t0, L); break;
    }
  }
  __syncthreads();
  const u16* W = reinterpret_cast<const u16*>(p.ws + WS_POOLWT) + (size_t)(l >> 1) * 262144 + (size_t)g * 65536;
  f32x4 acc[4][4];
#pragma unroll
  for (int a = 0; a < 4; ++a)
#pragma unroll
    for (int b = 0; b < 4; ++b) acc[a][b] = f32x4{0.f, 0.f, 0.f, 0.f};
#pragma unroll 4
  for (int ks = 0; ks < 8; ++ks) {
    bf16x8 af[4], bfr[4];
#pragma unroll
    for (int m = 0; m < 4; ++m) af[m] = ld8(sP + (m * 16 + fr) * 264 + ks * 32 + fq * 8);
#pragma unroll
    for (int n = 0; n < 4; ++n) bfr[n] = ld8(W + (size_t)(wid * 64 + n * 16 + fr) * 256 + ks * 32 + fq * 8);
#pragma unroll
    for (int m = 0; m < 4; ++m)
#pragma unroll
      for (int n = 0; n < 4; ++n) acc[m][n] = mfma16(bfr[n], af[m], acc[m][n]);
  }
  const float* pscale = p.in[19 + 10 * l];
  u16* Y = reinterpret_cast<u16*>(p.ws + WS_H);
#pragma unroll
  for (int n = 0; n < 4; ++n) {
    const int col = g * 256 + wid * 64 + n * 16 + 4 * fq;
    const float4 sc = *reinterpret_cast<const float4*>(pscale + col);
#pragma unroll
    for (int m = 0; m < 4; ++m) {
      const int row = row0 + m * 16 + fr;
      const u32x2 gw = *reinterpret_cast<const u32x2*>(PROJ + (size_t)row * NC + 1024 + col);
      float y0 = acc[m][n][0] * sc.x * silu(bflo(gw[0])), y1 = acc[m][n][1] * sc.y * silu(bfhi(gw[0]));
      float y2 = acc[m][n][2] * sc.z * silu(bflo(gw[1])), y3 = acc[m][n][3] * sc.w * silu(bfhi(gw[1]));
      if (ZERO_MASK & 1) { y0 = y1 = y2 = y3 = 0.f; }
      *reinterpret_cast<u32x2*>(Y + (size_t)row * 2048 + col) = u32x2{pk2(y0, y1), pk2(y2, y3)};
    }
  }
}

DI void phase_mix_even(const Params& p, int l, unsigned char* lds, unsigned char* lds_all) {
#pragma unroll 1
  for (int it = blockIdx.x; it < 512; it += gridDim.x) { int bh, qb; heavy_map(it, bh, qb); diff_item(p, l, true, bh, qb, lds_all); }
#pragma unroll 1
  for (int it = blockIdx.x; it < 256; it += gridDim.x) diff_item(p, l, false, it, 0, lds_all);
#pragma unroll 1
  for (int it = VBID; it < 1536; it += VGRID) pool_item(p, l, it, lds);
}

DI void na_item(const Params& p, int l, bool sample, int bh, int qb, unsigned char* lds) {
  constexpr int NC = 7168;
  const int tid = TID8, lane = tid & 63, wid = tid >> 6, r = lane & 31, h = lane >> 5;
  const int b = bh >> 3, hd = bh & 7;
  u16* sQ = reinterpret_cast<u16*>(lds);
  u16* sK = sQ + 256 * 136;
  u16* sVT = sK + 64 * 136;
  float* sBias = reinterpret_cast<float*>(sVT + 128 * 72) + 64;
  const u16* PROJ = reinterpret_cast<const u16*>(p.ws + WS_PROJ);
  const u16* VT = reinterpret_cast<const u16*>(p.ws + WS_VT);
  const int seq0 = sample ? TP + b * 4096 : b * 256;
  const int token = seq0 + qb * 256 + wid * 32 + r;
  AttnSrc s;
  int qr = 0, qc = 0, rsmin = 0;
  f32x16 O[4];
  float lsum;
  const u16* qblk = PROJ + (size_t)(seq0 + qb * 256) * NC + hd * 128;
  if (sample) {
    __syncthreads();
    const float* rpb = p.in[18 + 10 * l] + hd * 465;
    for (int e = tid; e < 465; e += 512) sBias[e] = rpb[e] * LOG2E;
    const int r0 = qb * 4;
    qr = r0 + (wid >> 1); qc = (wid & 1) * 32 + r;
    rsmin = min(max(r0 - 4, 0), 56);
    const int rs1 = min(max(r0 - 1, 0), 56);
    s.k0 = reinterpret_cast<const u16*>(p.ws + WS_CK) + (size_t)l * 2097152 + (size_t)bh * 65536; s.ks0 = 128;
    s.vt0 = reinterpret_cast<const u16*>(p.ws + WS_CVT) + (size_t)l * 2097152 + (size_t)bh * 65536; s.vs0 = 512; s.n0 = 8;
    s.k1 = PROJ + (size_t)(seq0 + rsmin * 64) * NC + 1024 + hd * 128; s.ks1 = NC;
    s.vt1 = VT + 8388608 + (size_t)bh * 128 * 4096 + rsmin * 64; s.vs1 = 4096; s.n1 = rs1 + 8 - rsmin;
    attn_run<128, true>(s, qblk, NC, sQ, sK, sVT, O, lsum, qr, qc, rsmin, sBias);
  } else {
    s.k0 = nullptr; s.vt0 = nullptr; s.ks0 = 0; s.vs0 = 0; s.n0 = 0;
    s.k1 = PROJ + (size_t)seq0 * NC + 1024 + hd * 128; s.ks1 = NC;
    s.vt1 = VT + (size_t)bh * 128 * 256; s.vs1 = 256; s.n1 = 4;
    attn_run<128, false>(s, qblk, NC, sQ, sK, sVT, O, lsum, 0, 0, 0, nullptr);
  }
  const float inv = 1.f / lsum;
  const u16* gp = PROJ + (size_t)token * NC + 3072 + hd * 128;
  u16* yp = reinterpret_cast<u16*>(p.ws + WS_H) + (size_t)token * 2048 + hd * 128;
#pragma unroll
  for (int d = 0; d < 4; ++d)
#pragma unroll
    for (int q = 0; q < 4; ++q) {
      const int dv = d * 32 + 8 * q + 4 * h;
      const u32x2 gw = *reinterpret_cast<const u32x2*>(gp + dv);
      const float y0 = O[d][4 * q] * inv * silu(bflo(gw[0]));
      const float y1 = O[d][4 * q + 1] * inv * silu(bfhi(gw[0]));
      const float y2 = O[d][4 * q + 2] * inv * silu(bflo(gw[1]));
      const float y3 = O[d][4 * q + 3] * inv * silu(bfhi(gw[1]));
      *reinterpret_cast<u32x2*>(yp + dv) = (ZERO_MASK & 4) ? u32x2{0u, 0u} : u32x2{pk2(y0, y1), pk2(y2, y3)};
    }
}

DI void sgu_item(const Params& p, int l, int si, unsigned char* lds) {
  constexpr int NC = 7168;
  const int tid = TIDX, lane = tid & 63, wid = tid >> 6, fr = lane & 15, fq = lane >> 4;
  const int ch = si >> 2, g = si & 3, row0 = ch * 128;
  u16* vnT = reinterpret_cast<u16*>(lds);
  float* sMu = reinterpret_cast<float*>(vnT + 256 * 136);
  float* sRs = sMu + 128;
  const u16* PROJ = reinterpret_cast<const u16*>(p.ws + WS_PROJ);
  __syncthreads();
  {
    const int grp = tid >> 4, ln = tid & 15;
#pragma unroll 2
    for (int rr = 0; rr < 8; ++rr) {
      const u16* src = PROJ + (size_t)(row0 + grp * 8 + rr) * NC + 5120;
      float s = 0.f, ss = 0.f;
#pragma unroll
      for (int c8 = 0; c8 < 8; ++c8) {
        const u32x4 v = *reinterpret_cast<const u32x4*>(src + (ln + 16 * c8) * 8);
#pragma unroll
        for (int k = 0; k < 4; ++k) { const float a = bflo(v[k]), b = bfhi(v[k]); s += a + b; ss += a * a + b * b; }
      }
#pragma unroll
      for (int o = 8; o >= 1; o >>= 1) { s += __shfl_xor(s, o); ss += __shfl_xor(ss, o); }
      const float mu = s * (1.f / 1024.f);
      const float var = fmaxf(ss * (1.f / 1024.f) - mu * mu, 0.f);
      if (ln == 0) { sMu[grp * 8 + rr] = mu; sRs[grp * 8 + rr] = rsqrtf(var + LN_EPS); }
    }
  }
  __syncthreads();
  {
    const int j = tid & 127, hf = tid >> 7;
    const float mu = sMu[j], rs = sRs[j];
    const float* lng = p.in[19 + 10 * l] + g * 256;
    const u16* src = PROJ + (size_t)(row0 + j) * NC + 5120 + g * 256;
#pragma unroll 8
    for (int oc = hf * 16; oc < hf * 16 + 16; ++oc) {
      const u32x4 v = *reinterpret_cast<const u32x4*>(src + oc * 8);
      const float4 g0 = *reinterpret_cast<const float4*>(lng + oc * 8), g1 = *reinterpret_cast<const float4*>(lng + oc * 8 + 4);
      const float gg[8] = {g0.x, g0.y, g0.z, g0.w, g1.x, g1.y, g1.z, g1.w};
#pragma unroll
      for (int k = 0; k < 4; ++k) {
        const float a = (bflo(v[k]) - mu) * rs * gg[2 * k], b = (bfhi(v[k]) - mu) * rs * gg[2 * k + 1];
        const u32 w = pk2(a, b);
        vnT[(oc * 8 + 2 * k) * 136 + j] = (u16)(w & 0xffffu);
        vnT[(oc * 8 + 2 * k + 1) * 136 + j] = (u16)(w >> 16);
      }
    }
  }
  __syncthreads();
  const u16* W = reinterpret_cast<const u16*>(p.ws + WS_SGUW) + (size_t)(l >> 1) * 65536 + (size_t)g * 16384;
  const float* bs = p.in[21 + 10 * l] + g * 128;
  u16* Y = reinterpret_cast<u16*>(p.ws + WS_H);
#pragma unroll 1
  for (int ih = 0; ih < 2; ++ih) {
    f32x4 acc[4][4];
#pragma unroll
    for (int a = 0; a < 4; ++a)
#pragma unroll
      for (int b = 0; b < 4; ++b) acc[a][b] = f32x4{0.f, 0.f, 0.f, 0.f};
#pragma unroll
    for (int ks = 0; ks < 4; ++ks) {
      bf16x8 af[4], bfr[4];
#pragma unroll
      for (int m = 0; m < 4; ++m) af[m] = ld8(W + (size_t)(ih * 64 + m * 16 + fr) * 128 + ks * 32 + fq * 8);
#pragma unroll
      for (int n = 0; n < 4; ++n) bfr[n] = ld8(vnT + (wid * 64 + n * 16 + fr) * 136 + ks * 32 + fq * 8);
#pragma unroll
      for (int m = 0; m < 4; ++m)
#pragma unroll
        for (int n = 0; n < 4; ++n) acc[m][n] = mfma16(bfr[n], af[m], acc[m][n]);
    }
#pragma unroll
    for (int m = 0; m < 4; ++m) {
      const int ii = ih * 64 + m * 16 + fr;
      const float bias = bs[ii];
      const size_t rb = (size_t)(row0 + ii) * NC;
#pragma unroll
      for (int n = 0; n < 4; ++n) {
        const int c = g * 256 + wid * 64 + n * 16 + 4 * fq;
        const u32x2 uw = *reinterpret_cast<const u32x2*>(PROJ + rb + 4096 + c);
        const u32x2 dw = *reinterpret_cast<const u32x2*>(PROJ + rb + 6144 + c);
        float y0 = bflo(uw[0]) * (acc[m][n][0] + bias) * silu(bflo(dw[0])), y1 = bfhi(uw[0]) * (acc[m][n][1] + bias) * silu(bfhi(dw[0]));
        float y2 = bflo(uw[1]) * (acc[m][n][2] + bias) * silu(bflo(dw[1])), y3 = bfhi(uw[1]) * (acc[m][n][3] + bias) * silu(bfhi(dw[1]));
        if (ZERO_MASK & 8) { y0 = y1 = y2 = y3 = 0.f; }
        *reinterpret_cast<u32x2*>(Y + (size_t)(row0 + ii) * 2048 + 1024 + c) = u32x2{pk2(y0, y1), pk2(y2, y3)};
      }
    }
  }
}

DI void phase_mix_odd(const Params& p, int l, unsigned char* lds, unsigned char* lds_all) {
#pragma unroll 1
  for (int it = blockIdx.x; it < 512; it += gridDim.x) { int bh, qb; heavy_map(it, bh, qb); na_item(p, l, true, bh, qb, lds_all); }
#pragma unroll 1
  for (int it = blockIdx.x; it < 256; it += gridDim.x) na_item(p, l, false, it, 0, lds_all);
#pragma unroll 1
  for (int it = VBID; it < 768; it += VGRID) sgu_item(p, l, it, lds);
}

#define XB_TMO      128
#define XB_XCNT(j)  (256  + 64 * (j))
#define XB_XSUB(j)  (1280 + 64 * (j))
#define XB_XGEN(j)  (2304 + 64 * (j))
#define XB_TOP      3328
#define XB_TOPGEN   3392
#define XCD_BAR_WORDS 3456
#define XB_SPIN_CAP (1u << 18)
#define LAS __attribute__((address_space(3)))
DI unsigned xb_ld(unsigned* p)              { return __hip_atomic_load(p, __ATOMIC_RELAXED, __HIP_MEMORY_SCOPE_AGENT); }
DI unsigned xb_add(unsigned* p, unsigned v) { return __hip_atomic_fetch_add(p, v, __ATOMIC_RELAXED, __HIP_MEMORY_SCOPE_AGENT); }
DI unsigned xb_xcc_id() { return (unsigned)__builtin_amdgcn_s_getreg((3 << 11) | 20) & 0xFu; }
#define XB_SPIN(cond, bar) do { unsigned _sp = 0; while (cond) { __builtin_amdgcn_s_sleep(1); \
    if ((++_sp & 255u) == 0u) { if (xb_ld(&(bar)[XB_TMO])) break; if (_sp > XB_SPIN_CAP) { atomicAdd(&(bar)[XB_TMO], 1u); break; } } } } while (0)
struct XcdBarrier { unsigned* bar; unsigned x; volatile LAS unsigned* st; };
DI XcdBarrier xcd_barrier_post(unsigned* bar, volatile LAS unsigned* st) {
  XcdBarrier b; b.bar = bar; b.x = xb_xcc_id(); b.st = st;
  if (threadIdx.x == 0) (void)xb_add(&bar[XB_XCNT(b.x)], 1u);
  return b;
}
DI void xcd_barrier_complete(unsigned* bar, unsigned x, unsigned& nloc, unsigned& nx) {
  const unsigned G = gridDim.x * gridDim.y * gridDim.z;
  unsigned sum, cnt, mine, sp = 0u;
  for (;;) {
    sum = 0u; cnt = 0u; mine = 0u;
#pragma unroll
    for (unsigned j = 0; j < 16; ++j) { const unsigned c = xb_ld(&bar[XB_XCNT(j)]); sum += c; cnt += (c > 0u) ? 1u : 0u; mine = (j == x) ? c : mine; }
    if (sum == G) break;
    __builtin_amdgcn_s_sleep(1);
    if ((++sp & 255u) == 0u) { if (xb_ld(&bar[XB_TMO])) break; if (sp > XB_SPIN_CAP) { atomicAdd(&bar[XB_TMO], 1u); break; } }
  }
  nloc = mine > 0u ? mine : 1u; nx = cnt > 0u ? cnt : 1u;
}
DI void xcd_barrier(const XcdBarrier& b) {
  asm volatile("s_waitcnt vmcnt(0)" ::: "memory");
  __syncthreads();
  if (threadIdx.x == 0) {
    unsigned* bar = b.bar;
    __builtin_amdgcn_s_waitcnt(0);
    unsigned nloc = b.st[0], nx = b.st[1];
    if (nloc == 0u) { xcd_barrier_complete(bar, b.x, nloc, nx); b.st[0] = nloc; b.st[1] = nx; }
    const unsigned old = xb_add(&bar[XB_XSUB(b.x)], 1u);
    const unsigned gen = old / nloc;
    if (old + 1u == (gen + 1u) * nloc) {
      __builtin_amdgcn_fence(__ATOMIC_RELEASE, "agent");
      asm volatile("s_waitcnt vmcnt(0)" ::: "memory");
      const unsigned og = xb_add(&bar[XB_TOP], 1u);
      const unsigned tg = og / nx;
      if (og + 1u == (tg + 1u) * nx) xb_add(&bar[XB_TOPGEN], 1u);
      else XB_SPIN(xb_ld(&bar[XB_TOPGEN]) == tg, bar);
      __builtin_amdgcn_fence(__ATOMIC_ACQUIRE, "agent");
      xb_add(&bar[XB_XGEN(b.x)], 1u);
      asm volatile("s_waitcnt vmcnt(0)" ::: "memory");
    } else {
      XB_SPIN(xb_ld(&bar[XB_XGEN(b.x)]) == gen, bar);
      __builtin_amdgcn_fence(__ATOMIC_ACQUIRE, "agent");
      asm volatile("s_waitcnt vmcnt(0)" ::: "memory");
    }
  }
  __syncthreads();
}

__global__ void __launch_bounds__(512, 2) fwd_megakernel(Params p) {
  extern __shared__ __attribute__((aligned(16))) unsigned char lds[];
  cg::grid_group grid = cg::this_grid();
  volatile LAS unsigned* xst = (volatile LAS unsigned*)(lds + LDS_BYTES - 16);
  if (threadIdx.x == 0) { xst[0] = 0u; xst[1] = 0u; }
  __syncthreads();
  const XcdBarrier xb = xcd_barrier_post(reinterpret_cast<unsigned*>(p.ws + WS_BAR), xst);
  for (int ph = p.ph_lo; ph < p.ph_hi; ++ph) {
    unsigned char* hl = lds + HALF_ID * HALF_LDS;
    if (ph == 0) phase_prep(p, hl);
    else if (ph == 1) phase_mod0(p);
    else {
      const int l = (ph - 2) >> 2, s = (ph - 2) & 3;
      if (s == 0) { if (l & 1) gemm_phase<G_IN_ODD>(p, l, lds); else gemm_phase<G_IN_EVEN>(p, l, lds); }
      else if (s == 1) { if (l & 1) phase_mix_odd(p, l, hl, lds); else phase_mix_even(p, l, hl, lds); }
      else if (s == 2) gemm_phase<G_OUT>(p, l, lds);
      else phase_ln(p, l);
    }
    if (ph + 1 < p.ph_hi) {
      if (p.ph_lo < 0) grid.sync();
      xcd_barrier(xb);
    }
  }
}

extern "C" void kernel_launch(void* const* d_in, const int* in_sizes, int n_in, void* d_out, int out_size, void* d_ws, size_t ws_size,
                              hipStream_t stream) {
  static int grid_blocks = 0;
  if (grid_blocks == 0) {
    if (n_in != 52 || ws_size < WS_END) {
      fprintf(stderr, "kernel_launch: expected 52 inputs and >= %zu bytes of workspace; got %d, %zu\n", (size_t)WS_END, n_in, ws_size);
      grid_blocks = -1;
      return;
    }
    int dev = 0, cus = 0, per_cu = 0;
    hipGetDevice(&dev);
    hipDeviceGetAttribute(&cus, hipDeviceAttributeMultiprocessorCount, dev);
    hipFuncSetAttribute((const void*)fwd_megakernel, hipFuncAttributeMaxDynamicSharedMemorySize, LDS_BYTES);
    hipOccupancyMaxActiveBlocksPerMultiprocessor(&per_cu, (const void*)fwd_megakernel, 512, LDS_BYTES);
    (void)hipGetLastError();
    grid_blocks = cus;
  }
  if (grid_blocks < 0) return;
  Params p{};
  for (int i = 0; i < 52; ++i) p.in[i] = (const float*)d_in[i];
  p.out = (float*)d_out;
  p.ws = (unsigned char*)d_ws;
#if MULTI
  for (int ph = 0; ph < NPHASE; ++ph) {
    p.ph_lo = ph; p.ph_hi = ph + 1;
    hipLaunchKernelGGL(fwd_megakernel, dim3(grid_blocks), dim3(512), LDS_BYTES, stream, p);
  }
#else
  p.ph_lo = 0; p.ph_hi = NPHASE;
  if (hipMemsetAsync((char*)d_ws + WS_BAR, 0, XCD_BAR_WORDS * 4, stream) != hipSuccess) { fprintf(stderr, "kernel_launch: memset of barrier words failed\n"); return; }
  void* args[] = {&p};
  hipError_t e = hipLaunchCooperativeKernel((const void*)fwd_megakernel, dim3(grid_blocks), dim3(512), args, LDS_BYTES, stream);
  if (e != hipSuccess) fprintf(stderr, "cooperative launch failed: %s (grid %d)\n", hipGetErrorString(e), grid_blocks);
#endif
}
```

```cpp
#include <hip/hip_runtime.h>
#include <hip/hip_cooperative_groups.h>
#include <cstdio>
namespace cg = cooperative_groups;

#define DI __device__ __forceinline__
typedef unsigned short u16;
typedef unsigned int u32;
using bf16x8 = __attribute__((ext_vector_type(8))) short;
using f32x4 = __attribute__((ext_vector_type(4))) float;
using f32x16 = __attribute__((ext_vector_type(16))) float;
using u32x4 = __attribute__((ext_vector_type(4))) unsigned;
using u32x2 = __attribute__((ext_vector_type(2))) unsigned;
typedef __bf16 bf2_t __attribute__((ext_vector_type(2)));
typedef float f2_t __attribute__((ext_vector_type(2)));

#ifndef MULTI
#define MULTI 0
#endif
#ifndef REP0
#define REP0 1
#endif
#ifndef REP1
#define REP1 1
#endif
#ifndef ZERO_MASK
#define ZERO_MASK 0
#endif

constexpr int T_ALL = 24576, TP = 8192, DM = 2048;
constexpr float LOG2E = 1.4426950408889634f;
constexpr float ALPHA = 1.6817928305074290f;
constexpr float LN_EPS = 1e-5f;
constexpr int HALF_LDS = 76288;
constexpr int LDS_BYTES = 2 * HALF_LDS + 16;
constexpr int NPHASE = 18;

constexpr size_t SZ_WIN_E = (size_t)6144 * 2048 * 2, SZ_WIN_O = (size_t)7168 * 2048 * 2;
constexpr size_t WS_WINT = 0;
constexpr size_t WS_WOUTT = WS_WINT + 2 * SZ_WIN_E + 2 * SZ_WIN_O;
constexpr size_t WS_POOLWT = WS_WOUTT + (size_t)4 * 2048 * 2048 * 2;
constexpr size_t WS_SGUW = WS_POOLWT + (size_t)2 * 4 * 256 * 256 * 2;
constexpr size_t WS_CK = WS_SGUW + (size_t)2 * 4 * 128 * 128 * 2;
constexpr size_t WS_CVT = WS_CK + (size_t)4 * 4194304;
constexpr size_t WS_MOD = WS_CVT + (size_t)4 * 4194304;
constexpr size_t WS_ROPE = WS_MOD + (size_t)4 * 5 * 6144 * 4;
constexpr size_t WS_H = WS_ROPE + 8192;
constexpr size_t WS_PROJ = WS_H + (size_t)T_ALL * 2048 * 2;
constexpr size_t WS_VT = WS_PROJ + (size_t)T_ALL * 7168 * 2;
constexpr size_t WS_BAR = WS_VT + (size_t)T_ALL * 1024 * 2;
constexpr size_t WS_STATS = WS_BAR + 16384;
constexpr size_t WS_END = WS_STATS + (size_t)T_ALL * 8;

struct Params {
  const float* in[52];
  float* out;
  unsigned char* ws;
  int ph_lo, ph_hi;
};

DI size_t ws_wint(int l) { return WS_WINT + (size_t)(l >> 1) * (SZ_WIN_E + SZ_WIN_O) + ((l & 1) ? SZ_WIN_E : 0); }

DI u32 pk2(float a, float b) { f2_t v = {a, b}; bf2_t r = __builtin_convertvector(v, bf2_t); return __builtin_bit_cast(u32, r); }
DI float bflo(u32 w) { return __uint_as_float(w << 16); }
DI float bfhi(u32 w) { return __uint_as_float(w & 0xffff0000u); }
DI float bf1(u16 w) { return __uint_as_float(((u32)w) << 16); }
DI float ex2(float x) { return __builtin_amdgcn_exp2f(x); }
DI float silu(float x) { return x / (1.f + __expf(-x)); }
DI f32x4 mfma16(bf16x8 a, bf16x8 b, f32x4 c) { return __builtin_amdgcn_mfma_f32_16x16x32_bf16(a, b, c, 0, 0, 0); }
DI f32x16 mfma32(bf16x8 a, bf16x8 b, f32x16 c) { return __builtin_amdgcn_mfma_f32_32x32x16_bf16(a, b, c, 0, 0, 0); }
DI bf16x8 ld8(const u16* p) { return *reinterpret_cast<const bf16x8*>(p); }
DI int opq(int x) { asm volatile("" : "+v"(x)); return x; }
#define TIDX (opq((int)threadIdx.x) & 255)
#define TID8 (opq((int)threadIdx.x))
#define HALF_ID (opq((int)threadIdx.x) >> 8)
#define VBID ((int)((blockIdx.x & 7u) | ((unsigned)HALF_ID << 3) | ((blockIdx.x >> 3) << 4)))
#define VGRID ((int)gridDim.x * 2)

enum { G_IN_EVEN = 0, G_IN_ODD = 1, G_OUT = 2 };

namespace pg8 {
#define PG8_LAS __attribute__((address_space(3)))
typedef unsigned short bf16_t;
typedef short bf16x8 __attribute__((ext_vector_type(8)));
typedef float f32x4 __attribute__((ext_vector_type(4)));
typedef unsigned u32x4 __attribute__((ext_vector_type(4)));
constexpr int BM = 256, BK = 64, HALF = 128, HTB = HALF * BK * 2  , STAGE_BYTES = 8 * HTB, NXCD = 8, WGM = 8;

__host__ __device__ __forceinline__ int lds_byte(int r, int c) { const int st = (r >> 4) * 2 + (c >> 5), rr = r & 15, cc = c & 31, ob = rr * 64 + cc * 2; return st * 1024 + (ob ^ (((ob >> 9) & 1) << 5)); }
__host__ __device__ __forceinline__ void stage_rc(int b, int& R, int& C) { const int st = b / 1024, sb = b % 1024, swz = sb ^ (((sb >> 9) & 1) << 5); R = (st >> 1) * 16 + swz / 64; C = (st & 1) * 32 + (swz % 64) / 2; }
__host__ __device__ __forceinline__ int perm32(int rho) { const int n = rho >> 4, i = rho & 15; return 8 * (i >> 2) + 4 * n + (i & 3); }

struct Unit { int pm, pn; };
struct Gemm { const bf16_t* A; const bf16_t* Bt; int M, N, K; };

struct StaticOrder {
    int nM, nN, nwg, G, c;
    __host__ __device__ void init(int M, int N, int G_, int c_) { nM = M / BM; nN = N / BM; nwg = nM * nN; G = G_; c = c_; }
    __host__ __device__ bool next(int i, Unit& u) const {
        const long L = (long)i * G + c; if (L >= nwg) return false;
        int wgid = (int)L; { const int q = nwg / NXCD, r = nwg % NXCD, xcd = wgid % NXCD, off = wgid / NXCD; wgid = (xcd < r ? xcd * (q + 1) : r * (q + 1) + (xcd - r) * q) + off; }
        const int nig = WGM * nN, gid = wgid / nig, fm = gid * WGM, gsz = (nM - fm) < WGM ? (nM - fm) : WGM;
        u.pm = fm + ((wgid % nig) % gsz); u.pn = (wgid % nig) / gsz; return true;
    }
    __device__ __forceinline__ void a_ready(const Unit&) const {}
    __device__ __forceinline__ void done(const Unit&) const {}
};

template <class Epi, class Sched, bool STAMP = false>
__device__ __forceinline__ void gemm_phase(PG8_LAS unsigned char* lds, const Gemm g, const Sched& S, const Epi& E, unsigned long long* stamps) {
    const int tid = opq((int)threadIdx.x), wid = __builtin_amdgcn_readfirstlane(tid >> 6), lane = tid & 63, wr = wid >> 2, wc = wid & 3, fr = lane & 15, fq = lane >> 4;
    const int K = g.K, nt = K / BK;
    int ts_lo = 0, ts_hi = 0, nts = 0; const unsigned long long rt_entry = STAMP ? (unsigned long long)wall_clock64() : 0ull;
#define PG8_STAMP() do { if (STAMP && wid == 0 && nts < 64) { const unsigned long long _c = (unsigned long long)clock64(); \
        ts_lo = (lane == nts) ? (int)(unsigned)_c : ts_lo; ts_hi = (lane == nts) ? (int)(unsigned)(_c >> 32) : ts_hi; ++nts; } } while (0)
    PG8_STAMP();
    unsigned voffA[2], voffB[2];
#pragma unroll
    for (int i = 0; i < 2; ++i) { int R, C; stage_rc(tid * 16 + i * 8192, R, C); const int Rb = Epi::PERM ? ((R & ~31) + perm32(R & 31)) : R;
        voffA[i] = (unsigned)(R * K + C) * 2u; voffB[i] = (unsigned)(Rb * K + C) * 2u; }
    const size_t kstep = (size_t)(BK * 2);
    const size_t hstep = (size_t)HALF * K * 2;
    const size_t tstep = 2 * hstep;
    const unsigned ldsw = (unsigned)wid * 1024u;
    const int aoff = lds_byte(wr * 64 + fr, fq * 8), boff = lds_byte(wc * 32 + fr, fq * 8);
#define PG8_SA(b, h) (((b) * 2 + (h)) * HTB)
#define PG8_SB(b, h) ((4 + (b) * 2 + (h)) * HTB)
#define PG8_STAGE(bufoff, gbase, voff) do { _Pragma("unroll") for (int _i = 0; _i < 2; ++_i) \
        __builtin_amdgcn_global_load_lds((const unsigned*)((const char*)(gbase) + (voff)[_i]), (PG8_LAS unsigned*)(lds + (bufoff) + ldsw + _i * 8192), 16, 0, 0); } while (0)
#define PG8_LDA(dst, b, h) do { _Pragma("unroll") for (int m = 0; m < 4; ++m) _Pragma("unroll") for (int k = 0; k < 2; ++k) dst[m][k] = *(const PG8_LAS bf16x8*)(lds + PG8_SA(b, h) + aoff + m * 2048 + k * 1024); } while (0)
#define PG8_LDB(dst, b, h) do { _Pragma("unroll") for (int n = 0; n < 2; ++n) _Pragma("unroll") for (int k = 0; k < 2; ++k) dst[n][k] = *(const PG8_LAS bf16x8*)(lds + PG8_SB(b, h) + boff + n * 2048 + k * 1024); } while (0)
#define PG8_MMA(ai, bj, At, Bt) do { __builtin_amdgcn_s_setprio(1); _Pragma("unroll") for (int m = 0; m < 4; ++m) _Pragma("unroll") for (int n = 0; n < 2; ++n) _Pragma("unroll") for (int k = 0; k < 2; ++k) \
        acc[ai][bj][m][n] = __builtin_amdgcn_mfma_f32_16x16x32_bf16(Bt[n][k], At[m][k], acc[ai][bj][m][n], 0, 0, 0); __builtin_amdgcn_s_setprio(0); } while (0)
#define PG8_WAIT_V(n) asm volatile("s_waitcnt vmcnt(" #n ")" ::: "memory")
#define PG8_WAIT_L(n) asm volatile("s_waitcnt lgkmcnt(" #n ")" ::: "memory")
#define PG8_BAR __builtin_amdgcn_s_barrier()
#define PG8_SCHED __builtin_amdgcn_sched_barrier(0)
    Unit cur, nxt; int ui = 0;
    if (!S.next(0, cur)) return;
    f32x4 acc[2][2][4][2];
#pragma unroll
    for (int a = 0; a < 2; ++a)
#pragma unroll
        for (int b = 0; b < 2; ++b)
#pragma unroll
            for (int m = 0; m < 4; ++m)
#pragma unroll
                for (int n = 0; n < 2; ++n) acc[a][b][m][n] = (f32x4){0.f, 0.f, 0.f, 0.f};
    bf16x8 At[4][2], B0[2][2], B1[2][2];
    const char* cA = (const char*)g.A + (size_t)cur.pm * tstep; const char* cB = (const char*)g.Bt + (size_t)cur.pn * tstep;
    S.a_ready(cur);
    PG8_STAGE(PG8_SB(0, 0), cB, voffB); PG8_STAGE(PG8_SA(0, 0), cA, voffA); PG8_STAGE(PG8_SB(0, 1), cB + hstep, voffB); PG8_STAGE(PG8_SA(0, 1), cA + hstep, voffA);
    if (wr == 1) PG8_BAR;
    PG8_WAIT_V(4); PG8_BAR;
    PG8_STAGE(PG8_SB(1, 0), cB + kstep, voffB); PG8_STAGE(PG8_SA(1, 0), cA + kstep, voffA); PG8_STAGE(PG8_SB(1, 1), cB + hstep + kstep, voffB);
    PG8_WAIT_V(6); PG8_BAR;
    PG8_STAMP();
    for (;;) {
        const bool has_next = S.next(ui + 1, nxt);
        const char* nA = has_next ? (const char*)g.A + (size_t)nxt.pm * tstep : cA; const char* nB = has_next ? (const char*)g.Bt + (size_t)nxt.pn * tstep : cB;
        for (int t = 0; t < nt; t += 2) {
            const bool last = (t == nt - 2);
            const char* a1 = cA + (size_t)(t + 1) * kstep;
            const char* a2 = last ? nA : cA + (size_t)(t + 2) * kstep; const char* b2 = last ? nB : cB + (size_t)(t + 2) * kstep;
            const char* a3 = a2 + kstep; const char* b3 = b2 + kstep;
            if (last && has_next) S.a_ready(nxt);
            PG8_LDB(B0, 0, 0); PG8_SCHED; PG8_LDA(At, 0, 0); PG8_STAGE(PG8_SA(1, 1), a1 + hstep, voffA);
            PG8_WAIT_L(8); PG8_BAR; PG8_WAIT_L(0); PG8_MMA(0, 0, At, B0); PG8_BAR; PG8_SCHED;
            PG8_LDB(B1, 0, 1); PG8_STAGE(PG8_SB(0, 0), b2, voffB);
            PG8_BAR; PG8_WAIT_L(0); PG8_MMA(0, 1, At, B1); PG8_BAR;
            PG8_LDA(At, 0, 1); PG8_STAGE(PG8_SA(0, 0), a2, voffA);
            PG8_BAR; PG8_WAIT_L(0); PG8_MMA(1, 0, At, B0); PG8_BAR; PG8_SCHED;
            PG8_STAGE(PG8_SB(0, 1), b2 + hstep, voffB);
            PG8_WAIT_V(6); PG8_BAR; PG8_MMA(1, 1, At, B1); PG8_BAR;
            PG8_LDB(B0, 1, 0); PG8_SCHED; PG8_LDA(At, 1, 0); PG8_STAGE(PG8_SA(0, 1), a2 + hstep, voffA);
            PG8_WAIT_L(8); PG8_BAR; PG8_WAIT_L(0); PG8_MMA(0, 0, At, B0); PG8_BAR; PG8_SCHED;
            PG8_LDB(B1, 1, 1); PG8_STAGE(PG8_SB(1, 0), b3, voffB);
            PG8_BAR; PG8_WAIT_L(0); PG8_MMA(0, 1, At, B1); PG8_BAR;
            PG8_LDA(At, 1, 1); PG8_STAGE(PG8_SA(1, 0), a3, voffA);
            PG8_BAR; PG8_WAIT_L(0); PG8_MMA(1, 0, At, B0); PG8_BAR; PG8_SCHED;
            PG8_STAGE(PG8_SB(1, 1), b3 + hstep, voffB);
            PG8_WAIT_V(6); PG8_BAR; PG8_MMA(1, 1, At, B1); PG8_BAR;
        }
        PG8_STAMP();
        if constexpr (!Epi::AFTER_DRAIN) { E(acc, cur, wr, wc, fr, fq); S.done(cur); }
        PG8_STAMP();
        if (!has_next) break;
#pragma unroll
        for (int a = 0; a < 2; ++a)
#pragma unroll
            for (int b = 0; b < 2; ++b)
#pragma unroll
                for (int m = 0; m < 4; ++m)
#pragma unroll
                    for (int n = 0; n < 2; ++n) acc[a][b][m][n] = (f32x4){0.f, 0.f, 0.f, 0.f};
        cur = nxt; cA = nA; cB = nB; ++ui;
    }
    PG8_WAIT_V(0);
    if (wr == 0) PG8_BAR;
    PG8_BAR;
    if constexpr (Epi::AFTER_DRAIN) { E.fused(acc, cur, wr, wc, fr, fq, lds, wid, lane); S.done(cur); }
    PG8_STAMP();
    if (STAMP && wid == 0) { stamps[lane] = lane < nts ? (((unsigned long long)(unsigned)ts_hi << 32) | (unsigned)ts_lo) : 0ull;
        if (lane == 62) stamps[62] = rt_entry; if (lane == 63) stamps[63] = (unsigned long long)wall_clock64(); }
#undef PG8_STAMP
#undef PG8_SA
#undef PG8_SB
#undef PG8_STAGE
#undef PG8_LDA
#undef PG8_LDB
#undef PG8_MMA
#undef PG8_WAIT_V
#undef PG8_WAIT_L
#undef PG8_BAR
#undef PG8_SCHED
}
}

DI void tr_tile(const float* __restrict__ src, size_t ld_src, u16* __restrict__ dst, size_t ld_dst, float* sT) {
  const int tid = TIDX;
  const int r = tid >> 4, c4 = (tid & 15) * 4;
#pragma unroll
  for (int i = 0; i < 4; ++i) {
    float4 v = *reinterpret_cast<const float4*>(src + (size_t)(r + 16 * i) * ld_src + c4);
    float* d = sT + (r + 16 * i) * 65 + c4;
    d[0] = v.x; d[1] = v.y; d[2] = v.z; d[3] = v.w;
  }
  __syncthreads();
  const int n = tid >> 2, ks = (tid & 3) * 16;
  u32 w[8];
#pragma unroll
  for (int j = 0; j < 8; ++j) w[j] = pk2(sT[(ks + 2 * j) * 65 + n], sT[(ks + 2 * j + 1) * 65 + n]);
  u32x4* o = reinterpret_cast<u32x4*>(dst + (size_t)n * ld_dst + ks);
  o[0] = u32x4{w[0], w[1], w[2], w[3]};
  o[1] = u32x4{w[4], w[5], w[6], w[7]};
  __syncthreads();
}

DI void cvt8(const float* __restrict__ src, u16* __restrict__ dst) {
  float4 a = *reinterpret_cast<const float4*>(src);
  float4 b = *reinterpret_cast<const float4*>(src + 4);
  *reinterpret_cast<u32x4*>(dst) = u32x4{pk2(a.x, a.y), pk2(a.z, a.w), pk2(b.x, b.y), pk2(b.z, b.w)};
}

DI void mod_item(const Params& p, int i, unsigned char* lds) {
  const int tid = TIDX;
  const int l = i / 96, n0 = (i % 96) * 64;
  float* sS = reinterpret_cast<float*>(lds);
  float* red = sS + 5 * 2048;
  const float* c = p.in[10];
  const float* cctx = p.in[11];
  for (int e = tid; e < 5 * 2048; e += 256) {
    int v = e >> 11, k = e & 2047;
    float x = (v == 0) ? cctx[k] : c[(v - 1) * 2048 + k];
    sS[e] = silu(x);
  }
  __syncthreads();
  const int kk = tid >> 4, c4 = (tid & 15) * 4;
  const float* W = p.in[12 + 10 * l] + n0 + c4;
  f32x4 acc[5];
#pragma unroll
  for (int v = 0; v < 5; ++v) acc[v] = f32x4{0.f, 0.f, 0.f, 0.f};
#pragma unroll 8
  for (int k = kk; k < 2048; k += 16) {
    float4 w = *reinterpret_cast<const float4*>(W + (size_t)k * 6144);
#pragma unroll
    for (int v = 0; v < 5; ++v) {
      float s = sS[v * 2048 + k];
      acc[v][0] += s * w.x; acc[v][1] += s * w.y; acc[v][2] += s * w.z; acc[v][3] += s * w.w;
    }
  }
#pragma unroll
  for (int v = 0; v < 5; ++v)
#pragma unroll
    for (int q = 0; q < 4; ++q) red[(kk * 5 + v) * 64 + c4 + q] = acc[v][q];
  __syncthreads();
  for (int t2 = tid; t2 < 320; t2 += 256) {
    int v = t2 >> 6, n = t2 & 63;
    float s = 0.f;
#pragma unroll
    for (int k2 = 0; k2 < 16; ++k2) s += red[(k2 * 5 + v) * 64 + n];
    float* mod = reinterpret_cast<float*>(p.ws + WS_MOD);
    mod[(size_t)(l * 5 + v) * 6144 + n0 + n] = s + p.in[13 + 10 * l][n0 + n];
  }
  __syncthreads();
}

DI void phase_prep(const Params& p, unsigned char* lds) {
  constexpr int N_MOD = 384, N_TRWIN = 13312, N_TRWOUT = 4096, N_TRPOOL = 128, N_SGU = 64, N_CK = 4096, N_CV = 2048;
  constexpr int TOTAL = N_MOD + N_TRWIN + N_TRWOUT + N_TRPOOL + N_SGU + N_CK + N_CV + 1;
  const int tid = TIDX;
  float* sT = reinterpret_cast<float*>(lds);
  for (int it = VBID; it < TOTAL; it += VGRID) {
    int i = it;
    if (i < N_MOD) { mod_item(p, i, lds); continue; }
    i -= N_MOD;
    if (i < N_TRWIN) {
      int l, base;
      if (i < 3072) { l = 0; base = 0; } else if (i < 6656) { l = 1; base = 3072; } else if (i < 9728) { l = 2; base = 6656; } else { l = 3; base = 9728; }
      i -= base;
      const int N = (l & 1) ? 7168 : 6144, nN = N / 64;
      const int kt = i / nN, nt = i % nN;
      tr_tile(p.in[14 + 10 * l] + (size_t)kt * 64 * N + nt * 64, N,
              reinterpret_cast<u16*>(p.ws + ws_wint(l)) + (size_t)nt * 64 * 2048 + kt * 64, 2048, sT);
      continue;
    }
    i -= N_TRWIN;
    if (i < N_TRWOUT) {
      const int l = i >> 10, r = i & 1023, kt = r >> 5, nt = r & 31;
      tr_tile(p.in[15 + 10 * l] + (size_t)kt * 64 * 2048 + nt * 64, 2048,
              reinterpret_cast<u16*>(p.ws + WS_WOUTT) + (size_t)l * 2048 * 2048 + (size_t)nt * 64 * 2048 + kt * 64, 2048, sT);
      continue;
    }
    i -= N_TRWOUT;
    if (i < N_TRPOOL) {
      const int e = i >> 6, r = i & 63, g = r >> 4, t = r & 15, kt = t >> 2, nt = t & 3;
      tr_tile(p.in[18 + 20 * e] + (size_t)g * 65536 + kt * 64 * 256 + nt * 64, 256,
              reinterpret_cast<u16*>(p.ws + WS_POOLWT) + (size_t)e * 262144 + g * 65536 + nt * 64 * 256 + kt * 64, 256, sT);
      continue;
    }
    i -= N_TRPOOL;
    if (i < N_SGU) {
      const int e = i >> 5, ch = i & 31;
      const size_t off = (size_t)ch * 2048 + tid * 8;
      cvt8(p.in[30 + 20 * e] + off, reinterpret_cast<u16*>(p.ws + WS_SGUW) + (size_t)e * 65536 + off);
      continue;
    }
    i -= N_SGU;
    if (i < N_CK) {
      const int l = i >> 10, ch = i & 1023;
      const size_t off = (size_t)ch * 2048 + tid * 8;
      cvt8(p.in[2 + 2 * l] + off, reinterpret_cast<u16*>(p.ws + WS_CK) + (size_t)l * 2097152 + off);
      continue;
    }
    i -= N_CK;
    if (i < N_CV) {
      const int l = i >> 9, r = i & 511, bh = r >> 4, t = r & 15, kt = t >> 1, nt = t & 1;
      tr_tile(p.in[3 + 2 * l] + (size_t)bh * 65536 + kt * 64 * 128 + nt * 64, 128,
              reinterpret_cast<u16*>(p.ws + WS_CVT) + (size_t)l * 2097152 + (size_t)bh * 65536 + nt * 64 * 512 + kt * 64, 512, sT);
      continue;
    }
    {
      float* rc = reinterpret_cast<float*>(p.ws + WS_ROPE);
      for (int e = tid; e < 1024; e += 256) {
        int pos = e >> 4, fi = e & 15;
        float inv = 1.0f / powf(10000.0f, (float)(2 * fi) / 32.0f);
        float ang = (float)pos * inv;
        rc[e] = cosf(ang);
        rc[1024 + e] = sinf(ang);
      }
    }
  }
}

DI void phase_mod0(const Params& p) {
  const int tid = TIDX;
  const float* mod = reinterpret_cast<const float*>(p.ws + WS_MOD);
  u16* H = reinterpret_cast<u16*>(p.ws + WS_H);
  for (int it = VBID; it < T_ALL / 4; it += VGRID) {
#pragma unroll
    for (int rr = 0; rr < 4; ++rr) {
      const int row = it * 4 + rr;
      const int cond = row < TP ? 0 : 1 + ((row - TP) >> 12);
      const float* src = row < TP ? p.in[0] + (size_t)row * 2048 : p.in[1] + (size_t)(row - TP) * 2048;
      const int e = tid * 8;
      const float* sh = mod + (size_t)cond * 6144 + e;
      float4 a = *reinterpret_cast<const float4*>(src + e), b = *reinterpret_cast<const float4*>(src + e + 4);
      float4 s0 = *reinterpret_cast<const float4*>(sh), s1 = *reinterpret_cast<const float4*>(sh + 4);
      float4 c0 = *reinterpret_cast<const float4*>(sh + 2048), c1 = *reinterpret_cast<const float4*>(sh + 2052);
      u32x4 o = {pk2(a.x * (1.f + c0.x) + s0.x, a.y * (1.f + c0.y) + s0.y), pk2(a.z * (1.f + c0.z) + s0.z, a.w * (1.f + c0.w) + s0.w),
                 pk2(b.x * (1.f + c1.x) + s1.x, b.y * (1.f + c1.y) + s1.y), pk2(b.z * (1.f + c1.z) + s1.z, b.w * (1.f + c1.w) + s1.w)};
      *reinterpret_cast<u32x4*>(H + (size_t)row * 2048 + e) = o;
    }
  }
}


template <int MODE>
struct EpiIn {
  static constexpr bool PERM = false, AFTER_DRAIN = false;
  u16* PROJ; u16* VT; float* kout; float* vout; const float* ropeC; const float* ropeS;
  DI void operator()(const f32x4 (&acc)[2][2][4][2], const pg8::Unit& u, int wr, int wc, int fr, int fq) const {
    constexpr int NC = (MODE == G_IN_EVEN) ? 6144 : 7168;
    constexpr int SEC_Q = (MODE == G_IN_EVEN) ? 2 : 0, SEC_K = (MODE == G_IN_EVEN) ? 3 : 1, SEC_V = (MODE == G_IN_EVEN) ? 4 : 2;
    const int sec = u.pn >> 2;
    const bool prompt = u.pm < 32;
    const bool isq = sec == SEC_Q, isk = sec == SEC_K;
    const bool rope = (MODE == G_IN_EVEN) && (isq || isk) && !prompt;
    const float sc = isq ? ((MODE == G_IN_EVEN) ? 0.125f * LOG2E : 0.08838834764831845f * LOG2E) : 1.0f;
#pragma unroll
    for (int ai = 0; ai < 2; ++ai)
#pragma unroll
      for (int m = 0; m < 4; ++m) {
        const int row = u.pm * 256 + ai * 128 + wr * 64 + m * 16 + fr;
        int b, t;
        if (prompt) { b = row >> 8; t = row & 255; } else { const int rs = row - TP; b = rs >> 12; t = rs & 4095; }
#pragma unroll
        for (int bj = 0; bj < 2; ++bj) {
          const int hh = (u.pn & 3) * 2 + bj;
          const int d0 = wc * 32 + 4 * fq;
          if (sec == SEC_V) {
#pragma unroll
            for (int n = 0; n < 2; ++n) {
              const f32x4 v = acc[ai][bj][m][n];
              const int dv = d0 + 16 * n;
              const u32 w01 = pk2(v[0], v[1]), w23 = pk2(v[2], v[3]);
              if (prompt) {
                u16* vt = VT + ((size_t)((b * 8 + hh) * 128 + dv)) * 256 + t;
                vt[0] = (u16)(w01 & 0xffffu); vt[256] = (u16)(w01 >> 16); vt[512] = (u16)(w23 & 0xffffu); vt[768] = (u16)(w23 >> 16);
                *reinterpret_cast<float4*>(vout + ((size_t)((b * 8 + hh) * 256 + t)) * 128 + dv) = float4{v[0], v[1], v[2], v[3]};
              } else {
                u16* vt = VT + 8388608 + ((size_t)((b * 8 + hh) * 128 + dv)) * 4096 + t;
                vt[0] = (u16)(w01 & 0xffffu); vt[4096] = (u16)(w01 >> 16); vt[8192] = (u16)(w23 & 0xffffu); vt[12288] = (u16)(w23 >> 16);
              }
            }
          } else {
            f32x4 v0 = acc[ai][bj][m][0], v1 = acc[ai][bj][m][1];
            if (isk && prompt) {
              float* ko = kout + ((size_t)((b * 8 + hh) * 256 + t)) * 128 + d0;
              *reinterpret_cast<float4*>(ko) = float4{v0[0], v0[1], v0[2], v0[3]};
              *reinterpret_cast<float4*>(ko + 16) = float4{v1[0], v1[1], v1[2], v1[3]};
            }
            if (rope) {
              const int pos = (wc & 1) ? (t & 63) : (t >> 6);
              const float4 cs = *reinterpret_cast<const float4*>(ropeC + pos * 16 + 4 * fq);
              const float4 sn = *reinterpret_cast<const float4*>(ropeS + pos * 16 + 4 * fq);
              const float c4[4] = {cs.x, cs.y, cs.z, cs.w}, s4[4] = {sn.x, sn.y, sn.z, sn.w};
#pragma unroll
              for (int j = 0; j < 4; ++j) {
                const float x1 = v0[j], x2 = v1[j];
                v0[j] = x1 * c4[j] - x2 * s4[j];
                v1[j] = x1 * s4[j] + x2 * c4[j];
              }
            }
            u16* dst = PROJ + (size_t)row * NC + u.pn * 256 + bj * 128 + d0;
            *reinterpret_cast<u32x2*>(dst) = u32x2{pk2(v0[0] * sc, v0[1] * sc), pk2(v0[2] * sc, v0[3] * sc)};
            *reinterpret_cast<u32x2*>(dst + 16) = u32x2{pk2(v1[0] * sc, v1[1] * sc), pk2(v1[2] * sc, v1[3] * sc)};
          }
        }
      }
  }
};

struct EpiOut {
  static constexpr bool PERM = false, AFTER_DRAIN = false;
  float* X; const float* x0; const float* x1; const float* mod; const float* lng; const float* lnb; const float2* stats; int l;
  DI void operator()(const f32x4 (&acc)[2][2][4][2], const pg8::Unit& u, int wr, int wc, int fr, int fq) const {
    const bool prompt = u.pm < 32;
    const int cond = prompt ? 0 : 1 + ((u.pm * 256 - TP) >> 12);
    const float* gate = mod + (size_t)(l * 5 + cond) * 6144 + 4096;
    const int col0 = u.pn * 256 + wc * 32 + 4 * fq;
#pragma unroll
    for (int ai = 0; ai < 2; ++ai)
#pragma unroll
      for (int m = 0; m < 4; ++m) {
        const int row = u.pm * 256 + ai * 128 + wr * 64 + m * 16 + fr;
        float2 st = float2{0.f, 1.f};
        if (l != 0) st = stats[row];
#pragma unroll
        for (int bj = 0; bj < 2; ++bj)
#pragma unroll
          for (int n = 0; n < 2; ++n) {
            const int col = col0 + bj * 128 + 16 * n;
            const float4 g4 = *reinterpret_cast<const float4*>(gate + col);
            float4 xo;
            if (l == 0) {
              xo = prompt ? *reinterpret_cast<const float4*>(x0 + (size_t)row * 2048 + col)
                          : *reinterpret_cast<const float4*>(x1 + (size_t)(row - TP) * 2048 + col);
            } else {
              const float4 z = *reinterpret_cast<const float4*>(X + (size_t)row * 2048 + col);
              const float4 lg = *reinterpret_cast<const float4*>(lng + col), lb = *reinterpret_cast<const float4*>(lnb + col);
              xo.x = (z.x - st.x) * st.y * lg.x + lb.x; xo.y = (z.y - st.x) * st.y * lg.y + lb.y;
              xo.z = (z.z - st.x) * st.y * lg.z + lb.z; xo.w = (z.w - st.x) * st.y * lg.w + lb.w;
            }
            const f32x4 a = acc[ai][bj][m][n];
            float4 o;
            o.x = ALPHA * xo.x + g4.x * a[0]; o.y = ALPHA * xo.y + g4.y * a[1];
            o.z = ALPHA * xo.z + g4.z * a[2]; o.w = ALPHA * xo.w + g4.w * a[3];
            *reinterpret_cast<float4*>(X + (size_t)row * 2048 + col) = o;
          }
      }
  }
};

template <int MODE>
DI void gemm_phase(const Params& p, int l, unsigned char* lds) {
  constexpr int N = (MODE == G_OUT) ? 2048 : (MODE == G_IN_EVEN ? 6144 : 7168);
  pg8::Gemm g;
  g.A = reinterpret_cast<const u16*>(p.ws + WS_H);
  g.Bt = (MODE == G_OUT) ? reinterpret_cast<const u16*>(p.ws + WS_WOUTT) + (size_t)l * 2048 * 2048
                         : reinterpret_cast<const u16*>(p.ws + ws_wint(l));
  g.M = T_ALL; g.N = N; g.K = 2048;
  pg8::StaticOrder S;
  S.init(T_ALL, N, (int)gridDim.x, (int)blockIdx.x);
  PG8_LAS unsigned char* l3 = (PG8_LAS unsigned char*)lds;
  if constexpr (MODE == G_OUT) {
    EpiOut E;
    E.X = p.out; E.x0 = p.in[0]; E.x1 = p.in[1]; E.mod = reinterpret_cast<const float*>(p.ws + WS_MOD); E.l = l;
    E.lng = p.in[16 + 10 * (l > 0 ? l - 1 : 0)]; E.lnb = p.in[17 + 10 * (l > 0 ? l - 1 : 0)];
    E.stats = reinterpret_cast<const float2*>(p.ws + WS_STATS);
    pg8::gemm_phase<EpiOut, pg8::StaticOrder, false>(l3, g, S, E, nullptr);
  } else {
    EpiIn<MODE> E;
    E.PROJ = reinterpret_cast<u16*>(p.ws + WS_PROJ); E.VT = reinterpret_cast<u16*>(p.ws + WS_VT);
    E.kout = p.out + (size_t)T_ALL * 2048 + (size_t)(2 * l) * 8388608;
    E.vout = p.out + (size_t)T_ALL * 2048 + (size_t)(2 * l + 1) * 8388608;
    E.ropeC = reinterpret_cast<const float*>(p.ws + WS_ROPE); E.ropeS = E.ropeC + 1024;
    pg8::gemm_phase<EpiIn<MODE>, pg8::StaticOrder, false>(l3, g, S, E, nullptr);
  }
}

DI void phase_ln(const Params& p, int l) {
  const int tid_ = TIDX, lane = tid_ & 63, wid = tid_ >> 6;
  const float* g = p.in[16 + 10 * l];
  const float* bb = p.in[17 + 10 * l];
  const float* mod = reinterpret_cast<const float*>(p.ws + WS_MOD);
  u16* H = reinterpret_cast<u16*>(p.ws + WS_H);
  float* X = p.out;
  for (int it = VBID; it < T_ALL / 4; it += VGRID) {
    const int row = it * 4 + wid;
    float* xr = X + (size_t)row * 2048;
    float4 v[8];
    float s = 0.f;
#pragma unroll
    for (int i = 0; i < 8; ++i) {
      v[i] = *reinterpret_cast<const float4*>(xr + (i * 64 + lane) * 4);
      s += v[i].x + v[i].y + v[i].z + v[i].w;
    }
#pragma unroll
    for (int o = 32; o >= 1; o >>= 1) s += __shfl_xor(s, o);
    const float mu = s * (1.f / 2048.f);
    float ss = 0.f;
#pragma unroll
    for (int i = 0; i < 8; ++i) {
      float a = v[i].x - mu, b = v[i].y - mu, c = v[i].z - mu, d = v[i].w - mu;
      ss += a * a + b * b + c * c + d * d;
    }
#pragma unroll
    for (int o = 32; o >= 1; o >>= 1) ss += __shfl_xor(ss, o);
    const float rstd = rsqrtf(ss * (1.f / 2048.f) + LN_EPS);
    if (lane == 0) *reinterpret_cast<float2*>(p.ws + WS_STATS + (size_t)row * 8) = float2{mu, rstd};
    const int cond = row < TP ? 0 : 1 + ((row - TP) >> 12);
    const float* sh = mod + (size_t)((l + 1) * 5 + cond) * 6144;
#pragma unroll
    for (int i = 0; i < 8; ++i) {
      const int e = (i * 64 + lane) * 4;
      float4 gg = *reinterpret_cast<const float4*>(g + e), b4 = *reinterpret_cast<const float4*>(bb + e);
      float4 y;
      y.x = (v[i].x - mu) * rstd * gg.x + b4.x; y.y = (v[i].y - mu) * rstd * gg.y + b4.y;
      y.z = (v[i].z - mu) * rstd * gg.z + b4.z; y.w = (v[i].w - mu) * rstd * gg.w + b4.w;
      if (l == 3) *reinterpret_cast<float4*>(xr + e) = y;
      if (l < 3) {
        float4 s0 = *reinterpret_cast<const float4*>(sh + e), c0 = *reinterpret_cast<const float4*>(sh + 2048 + e);
        u32x2 o = {pk2(y.x * (1.f + c0.x) + s0.x, y.y * (1.f + c0.y) + s0.y), pk2(y.z * (1.f + c0.z) + s0.z, y.w * (1.f + c0.w) + s0.w)};
        *reinterpret_cast<u32x2*>(H + (size_t)row * 2048 + e) = o;
      }
    }
  }
}

struct AttnSrc {
  const u16* k0; const u16* vt0; int ks0, vs0, n0;
  const u16* k1; const u16* vt1; int ks1, vs1, n1;
};

template <int DQK>
DI void attn_ldg(const AttnSrc& s, int j, u32x4 (&rk)[DQK / 64], u32x4 (&rv)[2]) {
  const u16* kb; const u16* vb; int ks, vs;
  if (j < s.n0) { kb = s.k0 + (size_t)j * 64 * s.ks0; vb = s.vt0 + j * 64; ks = s.ks0; vs = s.vs0; }
  else { const int jj = j - s.n0; kb = s.k1 + (size_t)jj * 64 * s.ks1; vb = s.vt1 + jj * 64; ks = s.ks1; vs = s.vs1; }
  constexpr int CPR = DQK / 8;
  const int tid = TID8;
#pragma unroll
  for (int i = 0; i < DQK / 64; ++i) {
    const int c = tid + 512 * i, row = c / CPR, kc = c % CPR;
    rk[i] = *reinterpret_cast<const u32x4*>(kb + (size_t)row * ks + kc * 8);
  }
#pragma unroll
  for (int i = 0; i < 2; ++i) {
    const int c = tid + 512 * i, row = c >> 3, kc = c & 7;
    rv[i] = *reinterpret_cast<const u32x4*>(vb + (size_t)row * vs + kc * 8);
  }
}
template <int DQK>
DI void attn_sts(u16* sK, u16* sVT, const u32x4 (&rk)[DQK / 64], const u32x4 (&rv)[2]) {
  constexpr int CPR = DQK / 8;
  const int tid = TID8;
#pragma unroll
  for (int i = 0; i < DQK / 64; ++i) {
    const int c = tid + 512 * i, row = c / CPR, kc = c % CPR;
    *reinterpret_cast<u32x4*>(sK + row * (DQK + 8) + kc * 8) = rk[i];
  }
#pragma unroll
  for (int i = 0; i < 2; ++i) {
    const int c = tid + 512 * i, row = c >> 3, kc = c & 7;
    *reinterpret_cast<u32x4*>(sVT + row * 72 + kc * 8) = rv[i];
  }
}

DI void attn_pv(const f32x16 (&s)[2], const u16* vw, f32x16 (&O)[4]) {
  __builtin_amdgcn_s_setprio(1);
#pragma unroll
  for (int s4 = 0; s4 < 4; ++s4) {
    const int t = s4 >> 1, b0 = (s4 & 1) * 8;
    u32x4 w = {pk2(s[t][b0], s[t][b0 + 1]), pk2(s[t][b0 + 2], s[t][b0 + 3]), pk2(s[t][b0 + 4], s[t][b0 + 5]), pk2(s[t][b0 + 6], s[t][b0 + 7])};
    const bf16x8 pf = __builtin_bit_cast(bf16x8, w);
#pragma unroll
    for (int d = 0; d < 4; ++d) {
      bf16x8 a = ld8(vw + d * 32 * 72 + s4 * 16);
      O[d] = mfma32(a, pf, O[d]);
    }
  }
  __builtin_amdgcn_s_setprio(0);
}

template <int DQK, bool NA>
DI void attn_run(const AttnSrc& src, const u16* qblk, int qstride, u16* sQ, u16* sK, u16* sVT, f32x16 (&O)[4], float& l_out,
                 int qr, int qc, int rsmin, const float* sBias) {
  const int tid = TID8, lane = tid & 63, wid = tid >> 6;
  const int r = lane & 31, h = lane >> 5;
  const int pr = (r & 0x13) | ((r & 4) << 1) | ((r & 8) >> 1);
  constexpr int CPR = DQK / 8, QS = DQK + 8;
  __syncthreads();
  constexpr bool QREG = (DQK == 64);
  bf16x8 qf[QREG ? DQK / 16 : 1];
  if constexpr (QREG) {
#pragma unroll
    for (int ks = 0; ks < DQK / 16; ++ks) qf[ks] = ld8(qblk + (size_t)(wid * 32 + r) * qstride + ks * 16 + 8 * h);
  } else {
#pragma unroll
    for (int i = 0; i < DQK / 16; ++i) {
      const int c = tid + 512 * i, row = c / CPR, kc = c % CPR;
      *reinterpret_cast<u32x4*>(sQ + row * QS + kc * 8) = *reinterpret_cast<const u32x4*>(qblk + (size_t)row * qstride + kc * 8);
    }
  }
#pragma unroll
  for (int d = 0; d < 4; ++d)
#pragma unroll
    for (int i = 0; i < 16; ++i) O[d][i] = 0.f;
  float m = -1e30f, l = 0.f;
  const int nt = src.n0 + src.n1;
  const int rsq = min(max(qr - 4, 0), 56);
  const int cs = min(max(qc - 8, 0), 48);
  const u16* qw = sQ + (wid * 32 + r) * QS + 8 * h;
  u16* sVT1 = sVT + 128 * 72 + 2048;
  const bool grpB = wid >= 4;
  bool pend = false;
  f32x16 s[2];
  u32x4 rk[DQK / 64], rv[2];
  attn_ldg<DQK>(src, 0, rk, rv);
  constexpr bool SB = QREG;
  u16* sKb1 = sQ + 16384;
  int vi = 0;
  if constexpr (SB) {
    attn_sts<DQK>(sK, sVT, rk, rv);
    if (nt > 1) attn_ldg<DQK>(src, 1, rk, rv);
    __syncthreads();
  }
#pragma unroll 1
  for (int j = 0; j < nt; ++j) {
    const u16* kw;
    u16* vcur;
    const u16* vprev;
    if constexpr (SB) {
      u16* vnext = (vi == 0) ? sVT1 : ((vi == 1) ? sQ : sVT);
      vcur = (vi == 0) ? sVT : ((vi == 1) ? sVT1 : sQ);
      vprev = (vi == 0) ? sQ : ((vi == 1) ? sVT : sVT1);
      if (j + 1 < nt) attn_sts<DQK>((j & 1) ? sK : sKb1, vnext, rk, rv);
      if (j + 2 < nt) attn_ldg<DQK>(src, j + 2, rk, rv);
      kw = ((j & 1) ? sKb1 : sK) + pr * QS + 8 * h;
      vi = (vi == 2) ? 0 : vi + 1;
    } else {
      if (j > 0) __syncthreads();
      vcur = (j & 1) ? sVT1 : sVT;
      vprev = (j & 1) ? sVT : sVT1;
      attn_sts<DQK>(sK, vcur, rk, rv);
      __syncthreads();
      if (j + 1 < nt) attn_ldg<DQK>(src, j + 1, rk, rv);
      kw = sK + pr * QS + 8 * h;
    }
    __builtin_amdgcn_sched_barrier(0);
    if (grpB && pend) { attn_pv(s, vprev + r * 72 + 8 * h, O); pend = false; }
    bool active = true;
    int kr = 0;
    if (NA && j >= src.n0) { kr = rsmin + (j - src.n0); active = (kr >= rsq) && (kr < rsq + 8); }
    if (active) {
      __builtin_amdgcn_s_setprio(1);
#pragma unroll
      for (int t = 0; t < 2; ++t) {
#pragma unroll
        for (int i = 0; i < 16; ++i) s[t][i] = 0.f;
#pragma unroll
        for (int ks = 0; ks < DQK / 16; ++ks) {
          bf16x8 a = ld8(kw + t * 32 * QS + ks * 16);
          bf16x8 q;
          if constexpr (QREG) q = qf[ks]; else q = ld8(qw + ks * 16);
          s[t] = mfma32(a, q, s[t]);
        }
      }
      __builtin_amdgcn_s_setprio(0);
      if (NA && j >= src.n0) {
        const float* bp = sBias + (kr - qr + 7) * 31 + (8 * h - qc + 15);
        const int kb = 8 * h - cs;
#pragma unroll
        for (int t = 0; t < 2; ++t)
#pragma unroll
          for (int i = 0; i < 16; ++i) {
            const int ko = t * 32 + 16 * (i >> 3) + (i & 7);
            const bool ok = (unsigned)(ko + kb) < 16u;
            const float bv = bp[ko];
            s[t][i] = ok ? s[t][i] + bv : -1e30f;
          }
      }
      float mx = -1e30f;
#pragma unroll
      for (int t = 0; t < 2; ++t)
#pragma unroll
        for (int i = 0; i < 16; ++i) mx = fmaxf(mx, s[t][i]);
      if (__builtin_amdgcn_ballot_w64(mx > m + 8.0f) != 0ull) {
        mx = fmaxf(mx, __shfl_xor(mx, 32));
        const float mn = fmaxf(m, mx);
        const float alpha = ex2(m - mn);
        l *= alpha;
        m = mn;
#pragma unroll
        for (int d = 0; d < 4; ++d)
#pragma unroll
          for (int i = 0; i < 16; ++i) O[d][i] *= alpha;
      }
      float rsum = 0.f;
#pragma unroll
      for (int t = 0; t < 2; ++t)
#pragma unroll
        for (int i = 0; i < 16; ++i) { const float e = ex2(s[t][i] - m); s[t][i] = e; rsum += e; }
      l += rsum;
      if (!grpB) attn_pv(s, vcur + r * 72 + 8 * h, O);
      else pend = true;
    }
    if constexpr (SB) __syncthreads();
  }
  if (grpB && pend) {
    const u16* vlast;
    if constexpr (SB) vlast = (vi == 1) ? sVT : ((vi == 2) ? sVT1 : sQ);
    else vlast = ((nt - 1) & 1) ? sVT1 : sVT;
    attn_pv(s, vlast + r * 72 + 8 * h, O);
  }
  l_out = l + __shfl_xor(l, 32);
}

DI void heavy_map(int it, int& bh, int& qb) { const int x = it & 7, rest = it >> 3; qb = rest & 15; bh = x + 8 * (rest >> 4); }

DI void diff_item(const Params& p, int l, bool sample, int bh, int qb, unsigned char* lds) {
  constexpr int NC = 6144;
  const int tid_ = TID8, lane = tid_ & 63, wid = tid_ >> 6, r = lane & 31, h = lane >> 5;
  const int b = bh >> 3, hd = bh & 7;
  u16* sQ = reinterpret_cast<u16*>(lds);
  u16* sK = sQ + 256 * 136;
  u16* sVT = sK + 64 * 136;
  const u16* PROJ = reinterpret_cast<const u16*>(p.ws + WS_PROJ);
  const u16* VT = reinterpret_cast<const u16*>(p.ws + WS_VT);
  const int seq0 = sample ? TP + b * 4096 : b * 256;
  const int token = seq0 + qb * 256 + wid * 32 + r;
  const float* dl = p.in[20 + 10 * l];
  float pa = dl[lane] * dl[64 + lane], pb = dl[128 + lane] * dl[192 + lane];
#pragma unroll
  for (int o = 32; o >= 1; o >>= 1) { pa += __shfl_xor(pa, o); pb += __shfl_xor(pb, o); }
  const float lam_init = 0.8f - 0.6f * __expf(-0.3f * (float)l);
  const float lam = __expf(pa) - __expf(pb) + lam_init;

  u32 o1p[32];
  f32x16 O[4];
  float lsum;
#pragma unroll
  for (int comp = 0; comp < 2; ++comp) {
    AttnSrc s;
    if (sample) {
      s.k0 = reinterpret_cast<const u16*>(p.ws + WS_CK) + (size_t)l * 2097152 + (size_t)bh * 65536 + comp * 64; s.ks0 = 128;
      s.vt0 = reinterpret_cast<const u16*>(p.ws + WS_CVT) + (size_t)l * 2097152 + (size_t)bh * 65536; s.vs0 = 512; s.n0 = 8;
      s.k1 = PROJ + (size_t)seq0 * NC + 3072 + hd * 128 + comp * 64; s.ks1 = NC;
      s.vt1 = VT + 8388608 + (size_t)bh * 128 * 4096; s.vs1 = 4096; s.n1 = 64;
    } else {
      s.k0 = nullptr; s.vt0 = nullptr; s.ks0 = 0; s.vs0 = 0; s.n0 = 0;
      s.k1 = PROJ + (size_t)seq0 * NC + 3072 + hd * 128 + comp * 64; s.ks1 = NC;
      s.vt1 = VT + (size_t)bh * 128 * 256; s.vs1 = 256; s.n1 = 4;
    }
    const u16* qblk = PROJ + (size_t)(seq0 + qb * 256) * NC + 2048 + hd * 128 + comp * 64;
    attn_run<64, false>(s, qblk, NC, sQ, sK, sVT, O, lsum, 0, 0, 0, nullptr);
    const float inv = 1.f / lsum;
    if (comp == 0) {
#pragma unroll
      for (int d = 0; d < 4; ++d)
#pragma unroll
        for (int i = 0; i < 8; ++i) o1p[d * 8 + i] = pk2(O[d][2 * i] * inv, O[d][2 * i + 1] * inv);
    } else {
      float ssq = 0.f;
#pragma unroll
      for (int d = 0; d < 4; ++d)
#pragma unroll
        for (int i = 0; i < 8; ++i) {
          const u32 w = o1p[d * 8 + i];
          const float a = bflo(w) - lam * O[d][2 * i] * inv, c = bfhi(w) - lam * O[d][2 * i + 1] * inv;
          O[d][2 * i] = a; O[d][2 * i + 1] = c;
          ssq += a * a + c * c;
        }
      ssq += __shfl_xor(ssq, 32);
      const float rn = rsqrtf(ssq * (1.f / 128.f) + LN_EPS) * (1.f - lam_init);
      const float* subln = p.in[21 + 10 * l];
      const u16* gp = PROJ + (size_t)token * NC + 5120 + hd * 128;
      u16* yp = reinterpret_cast<u16*>(p.ws + WS_H) + (size_t)token * 2048 + 1024 + hd * 128;
#pragma unroll
      for (int d = 0; d < 4; ++d)
#pragma unroll
        for (int q = 0; q < 4; ++q) {
          const int dv = d * 32 + 8 * q + 4 * h;
          const u32x2 gw = *reinterpret_cast<const u32x2*>(gp + dv);
          const float4 sl = *reinterpret_cast<const float4*>(subln + dv);
          const float y0 = O[d][4 * q] * rn * sl.x * silu(bflo(gw[0]));
          const float y1 = O[d][4 * q + 1] * rn * sl.y * silu(bfhi(gw[0]));
          const float y2 = O[d][4 * q + 2] * rn * sl.z * silu(bflo(gw[1]));
          const float y3 = O[d][4 * q + 3] * rn * sl.w * silu(bfhi(gw[1]));
          *reinterpret_cast<u32x2*>(yp + dv) = (ZERO_MASK & 2) ? u32x2{0u, 0u} : u32x2{pk2(y0, y1), pk2(y2, y3)};
        }
    }
  }
}

template <int H>
DI void pool_window(const u16* sIn, u16* sP, int oc, int seg, int t0, int L) {
  const int tl0 = seg * 8;
  const u16* base = sIn + (tl0 + 8 - H) * 264 + oc * 8;
  float a[8];
#pragma unroll
  for (int k = 0; k < 8; ++k) a[k] = 0.f;
#pragma unroll
  for (int o = 0; o < 2 * H; ++o) {
    const u32x4 v = *reinterpret_cast<const u32x4*>(base + o * 264);
#pragma unroll
    for (int k = 0; k < 4; ++k) { a[2 * k] += bflo(v[k]); a[2 * k + 1] += bfhi(v[k]); }
  }
#pragma unroll
  for (int tt = 0; tt < 8; ++tt) {
    const int t = t0 + tl0 + tt;
    const int lo = max(t - H, 0), hi = min(t + H, L);
    const float ic = 1.f / (float)(hi - lo);
    const u32x4 x = *reinterpret_cast<const u32x4*>(sIn + (tl0 + tt + 8) * 264 + oc * 8);
    u32x4 o;
#pragma unroll
    for (int k = 0; k < 4; ++k) o[k] = pk2(a[2 * k] * ic - bflo(x[k]), a[2 * k + 1] * ic - bfhi(x[k]));
    *reinterpret_cast<u32x4*>(sP + (tl0 + tt) * 264 + oc * 8) = o;
    if (tt < 7) {
      const u32x4 vin = *reinterpret_cast<const u32x4*>(base + (2 * H + tt) * 264);
      const u32x4 vout = *reinterpret_cast<const u32x4*>(base + tt * 264);
#pragma unroll
      for (int k = 0; k < 4; ++k) { a[2 * k] += bflo(vin[k]) - bflo(vout[k]); a[2 * k + 1] += bfhi(vin[k]) - bfhi(vout[k]); }
    }
  }
}

DI void pool_item(const Params& p, int l, int pi, unsigned char* lds) {
  constexpr int NC = 6144;
  const int tid = TIDX, lane = tid & 63, wid = tid >> 6, fr = lane & 15, fq = lane >> 4;
  const int tb = pi >> 2, g = pi & 3, row0 = tb * 64;
  const int L = row0 < TP ? 256 : 4096;
  const int t0 = row0 < TP ? (row0 & 255) : ((row0 - TP) & 4095);
  u16* sIn = reinterpret_cast<u16*>(lds);
  u16* sP = sIn + 80 * 264;
  const u16* PROJ = reinterpret_cast<const u16*>(p.ws + WS_PROJ);
  __syncthreads();
#pragma unroll
  for (int i = 0; i < 10; ++i) {
    const int c = tid + 256 * i, rr = c >> 5, oc = c & 31;
    const int t = t0 - 8 + rr;
    u32x4 v = {0u, 0u, 0u, 0u};
    if (t >= 0 && t < L) v = *reinterpret_cast<const u32x4*>(PROJ + (size_t)(row0 - 8 + rr) * NC + g * 256 + oc * 8);
    *reinterpret_cast<u32x4*>(sIn + rr * 264 + oc * 8) = v;
  }
  __syncthreads();
  {
    const int oc = tid & 31, seg = tid >> 5;
    switch (g) {
      case 0: pool_window<1>(sIn, sP, oc, seg, t0, L); break;
      case 1: pool_window<2>(sIn, sP, oc, seg, t0, L); break;
      case 2: pool_window<4>(sIn, sP, oc, seg, t0, L); break;
      default: pool_window<8>(sIn, sP, oc, seg, t0, L); break;
    }
  }
  __syncthreads();
  const u16* W = reinterpret_cast<const u16*>(p.ws + WS_POOLWT) + (size_t)(l >> 1) * 262144 + (size_t)g * 65536;
  f32x4 acc[4][4];
#pragma unroll
  for (int a = 0; a < 4; ++a)
#pragma unroll
    for (int b = 0; b < 4; ++b) acc[a][b] = f32x4{0.f, 0.f, 0.f, 0.f};
#pragma unroll 4
  for (int ks = 0; ks < 8; ++ks) {
    bf16x8 af[4], bfr[4];
#pragma unroll
    for (int m = 0; m < 4; ++m) af[m] = ld8(sP + (m * 16 + fr) * 264 + ks * 32 + fq * 8);
#pragma unroll
    for (int n = 0; n < 4; ++n) bfr[n] = ld8(W + (size_t)(wid * 64 + n * 16 + fr) * 256 + ks * 32 + fq * 8);
#pragma unroll
    for (int m = 0; m < 4; ++m)
#pragma unroll
      for (int n = 0; n < 4; ++n) acc[m][n] = mfma16(bfr[n], af[m], acc[m][n]);
  }
  const float* pscale = p.in[19 + 10 * l];
  u16* Y = reinterpret_cast<u16*>(p.ws + WS_H);
#pragma unroll
  for (int n = 0; n < 4; ++n) {
    const int col = g * 256 + wid * 64 + n * 16 + 4 * fq;
    const float4 sc = *reinterpret_cast<const float4*>(pscale + col);
#pragma unroll
    for (int m = 0; m < 4; ++m) {
      const int row = row0 + m * 16 + fr;
      const u32x2 gw = *reinterpret_cast<const u32x2*>(PROJ + (size_t)row * NC + 1024 + col);
      float y0 = acc[m][n][0] * sc.x * silu(bflo(gw[0])), y1 = acc[m][n][1] * sc.y * silu(bfhi(gw[0]));
      float y2 = acc[m][n][2] * sc.z * silu(bflo(gw[1])), y3 = acc[m][n][3] * sc.w * silu(bfhi(gw[1]));
      if (ZERO_MASK & 1) { y0 = y1 = y2 = y3 = 0.f; }
      *reinterpret_cast<u32x2*>(Y + (size_t)row * 2048 + col) = u32x2{pk2(y0, y1), pk2(y2, y3)};
    }
  }
}

DI void phase_mix_even(const Params& p, int l, unsigned char* lds, unsigned char* lds_all) {
#pragma unroll 1
  for (int it = blockIdx.x; it < 512; it += gridDim.x) { int bh, qb; heavy_map(it, bh, qb); diff_item(p, l, true, bh, qb, lds_all); }
#pragma unroll 1
  for (int it = blockIdx.x; it < 256; it += gridDim.x) diff_item(p, l, false, it, 0, lds_all);
#pragma unroll 1
  for (int it = VBID; it < 1536; it += VGRID) pool_item(p, l, it, lds);
}

DI void na_item(const Params& p, int l, bool sample, int bh, int qb, unsigned char* lds) {
  constexpr int NC = 7168;
  const int tid = TID8, lane = tid & 63, wid = tid >> 6, r = lane & 31, h = lane >> 5;
  const int b = bh >> 3, hd = bh & 7;
  u16* sQ = reinterpret_cast<u16*>(lds);
  u16* sK = sQ + 256 * 136;
  u16* sVT = sK + 64 * 136;
  float* sBias = reinterpret_cast<float*>(sVT + 128 * 72) + 64;
  const u16* PROJ = reinterpret_cast<const u16*>(p.ws + WS_PROJ);
  const u16* VT = reinterpret_cast<const u16*>(p.ws + WS_VT);
  const int seq0 = sample ? TP + b * 4096 : b * 256;
  const int token = seq0 + qb * 256 + wid * 32 + r;
  AttnSrc s;
  int qr = 0, qc = 0, rsmin = 0;
  f32x16 O[4];
  float lsum;
  const u16* qblk = PROJ + (size_t)(seq0 + qb * 256) * NC + hd * 128;
  if (sample) {
    __syncthreads();
    const float* rpb = p.in[18 + 10 * l] + hd * 465;
    for (int e = tid; e < 465; e += 512) sBias[e] = rpb[e] * LOG2E;
    const int r0 = qb * 4;
    qr = r0 + (wid >> 1); qc = (wid & 1) * 32 + r;
    rsmin = min(max(r0 - 4, 0), 56);
    const int rs1 = min(max(r0 - 1, 0), 56);
    s.k0 = reinterpret_cast<const u16*>(p.ws + WS_CK) + (size_t)l * 2097152 + (size_t)bh * 65536; s.ks0 = 128;
    s.vt0 = reinterpret_cast<const u16*>(p.ws + WS_CVT) + (size_t)l * 2097152 + (size_t)bh * 65536; s.vs0 = 512; s.n0 = 8;
    s.k1 = PROJ + (size_t)(seq0 + rsmin * 64) * NC + 1024 + hd * 128; s.ks1 = NC;
    s.vt1 = VT + 8388608 + (size_t)bh * 128 * 4096 + rsmin * 64; s.vs1 = 4096; s.n1 = rs1 + 8 - rsmin;
    attn_run<128, true>(s, qblk, NC, sQ, sK, sVT, O, lsum, qr, qc, rsmin, sBias);
  } else {
    s.k0 = nullptr; s.vt0 = nullptr; s.ks0 = 0; s.vs0 = 0; s.n0 = 0;
    s.k1 = PROJ + (size_t)seq0 * NC + 1024 + hd * 128; s.ks1 = NC;
    s.vt1 = VT + (size_t)bh * 128 * 256; s.vs1 = 256; s.n1 = 4;
    attn_run<128, false>(s, qblk, NC, sQ, sK, sVT, O, lsum, 0, 0, 0, nullptr);
  }
  const float inv = 1.f / lsum;
  const u16* gp = PROJ + (size_t)token * NC + 3072 + hd * 128;
  u16* yp = reinterpret_cast<u16*>(p.ws + WS_H) + (size_t)token * 2048 + hd * 128;
#pragma unroll
  for (int d = 0; d < 4; ++d)
#pragma unroll
    for (int q = 0; q < 4; ++q) {
      const int dv = d * 32 + 8 * q + 4 * h;
      const u32x2 gw = *reinterpret_cast<const u32x2*>(gp + dv);
      const float y0 = O[d][4 * q] * inv * silu(bflo(gw[0]));
      const float y1 = O[d][4 * q + 1] * inv * silu(bfhi(gw[0]));
      const float y2 = O[d][4 * q + 2] * inv * silu(bflo(gw[1]));
      const float y3 = O[d][4 * q + 3] * inv * silu(bfhi(gw[1]));
      *reinterpret_cast<u32x2*>(yp + dv) = (ZERO_MASK & 4) ? u32x2{0u, 0u} : u32x2{pk2(y0, y1), pk2(y2, y3)};
    }
}

DI void sgu_item(const Params& p, int l, int si, unsigned char* lds) {
  constexpr int NC = 7168;
  const int tid = TIDX, lane = tid & 63, wid = tid >> 6, fr = lane & 15, fq = lane >> 4;
  const int ch = si >> 2, g = si & 3, row0 = ch * 128;
  u16* vnT = reinterpret_cast<u16*>(lds);
  float* sMu = reinterpret_cast<float*>(vnT + 256 * 136);
  float* sRs = sMu + 128;
  const u16* PROJ = reinterpret_cast<const u16*>(p.ws + WS_PROJ);
  __syncthreads();
  {
    const int grp = tid >> 4, ln = tid & 15;
#pragma unroll 2
    for (int rr = 0; rr < 8; ++rr) {
      const u16* src = PROJ + (size_t)(row0 + grp * 8 + rr) * NC + 5120;
      float s = 0.f, ss = 0.f;
#pragma unroll
      for (int c8 = 0; c8 < 8; ++c8) {
        const u32x4 v = *reinterpret_cast<const u32x4*>(src + (ln + 16 * c8) * 8);
#pragma unroll
        for (int k = 0; k < 4; ++k) { const float a = bflo(v[k]), b = bfhi(v[k]); s += a + b; ss += a * a + b * b; }
      }
#pragma unroll
      for (int o = 8; o >= 1; o >>= 1) { s += __shfl_xor(s, o); ss += __shfl_xor(ss, o); }
      const float mu = s * (1.f / 1024.f);
      const float var = fmaxf(ss * (1.f / 1024.f) - mu * mu, 0.f);
      if (ln == 0) { sMu[grp * 8 + rr] = mu; sRs[grp * 8 + rr] = rsqrtf(var + LN_EPS); }
    }
  }
  __syncthreads();
  {
    const int j = tid & 127, hf = tid >> 7;
    const float mu = sMu[j], rs = sRs[j];
    const float* lng = p.in[19 + 10 * l] + g * 256;
    const u16* src = PROJ + (size_t)(row0 + j) * NC + 5120 + g * 256;
#pragma unroll 8
    for (int oc = hf * 16; oc < hf * 16 + 16; ++oc) {
      const u32x4 v = *reinterpret_cast<const u32x4*>(src + oc * 8);
      const float4 g0 = *reinterpret_cast<const float4*>(lng + oc * 8), g1 = *reinterpret_cast<const float4*>(lng + oc * 8 + 4);
      const float gg[8] = {g0.x, g0.y, g0.z, g0.w, g1.x, g1.y, g1.z, g1.w};
#pragma unroll
      for (int k = 0; k < 4; ++k) {
        const float a = (bflo(v[k]) - mu) * rs * gg[2 * k], b = (bfhi(v[k]) - mu) * rs * gg[2 * k + 1];
        const u32 w = pk2(a, b);
        vnT[(oc * 8 + 2 * k) * 136 + j] = (u16)(w & 0xffffu);
        vnT[(oc * 8 + 2 * k + 1) * 136 + j] = (u16)(w >> 16);
      }
    }
  }
  __syncthreads();
  const u16* W = reinterpret_cast<const u16*>(p.ws + WS_SGUW) + (size_t)(l >> 1) * 65536 + (size_t)g * 16384;
  const float* bs = p.in[21 + 10 * l] + g * 128;
  u16* Y = reinterpret_cast<u16*>(p.ws + WS_H);
#pragma unroll 1
  for (int ih = 0; ih < 2; ++ih) {
    f32x4 acc[4][4];
#pragma unroll
    for (int a = 0; a < 4; ++a)
#pragma unroll
      for (int b = 0; b < 4; ++b) acc[a][b] = f32x4{0.f, 0.f, 0.f, 0.f};
#pragma unroll
    for (int ks = 0; ks < 4; ++ks) {
      bf16x8 af[4], bfr[4];
#pragma unroll
      for (int m = 0; m < 4; ++m) af[m] = ld8(W + (size_t)(ih * 64 + m * 16 + fr) * 128 + ks * 32 + fq * 8);
#pragma unroll
      for (int n = 0; n < 4; ++n) bfr[n] = ld8(vnT + (wid * 64 + n * 16 + fr) * 136 + ks * 32 + fq * 8);
#pragma unroll
      for (int m = 0; m < 4; ++m)
#pragma unroll
        for (int n = 0; n < 4; ++n) acc[m][n] = mfma16(bfr[n], af[m], acc[m][n]);
    }
#pragma unroll
    for (int m = 0; m < 4; ++m) {
      const int ii = ih * 64 + m * 16 + fr;
      const float bias = bs[ii];
      const size_t rb = (size_t)(row0 + ii) * NC;
#pragma unroll
      for (int n = 0; n < 4; ++n) {
        const int c = g * 256 + wid * 64 + n * 16 + 4 * fq;
        const u32x2 uw = *reinterpret_cast<const u32x2*>(PROJ + rb + 4096 + c);
        const u32x2 dw = *reinterpret_cast<const u32x2*>(PROJ + rb + 6144 + c);
        float y0 = bflo(uw[0]) * (acc[m][n][0] + bias) * silu(bflo(dw[0])), y1 = bfhi(uw[0]) * (acc[m][n][1] + bias) * silu(bfhi(dw[0]));
        float y2 = bflo(uw[1]) * (acc[m][n][2] + bias) * silu(bflo(dw[1])), y3 = bfhi(uw[1]) * (acc[m][n][3] + bias) * silu(bfhi(dw[1]));
        if (ZERO_MASK & 8) { y0 = y1 = y2 = y3 = 0.f; }
        *reinterpret_cast<u32x2*>(Y + (size_t)(row0 + ii) * 2048 + 1024 + c) = u32x2{pk2(y0, y1), pk2(y2, y3)};
      }
    }
  }
}

DI void phase_mix_odd(const Params& p, int l, unsigned char* lds, unsigned char* lds_all) {
#pragma unroll 1
  for (int it = blockIdx.x; it < 512; it += gridDim.x) { int bh, qb; heavy_map(it, bh, qb); na_item(p, l, true, bh, qb, lds_all); }
#pragma unroll 1
  for (int it = blockIdx.x; it < 256; it += gridDim.x) na_item(p, l, false, it, 0, lds_all);
#pragma unroll 1
  for (int it = VBID; it < 768; it += VGRID) sgu_item(p, l, it, lds);
}

#define XB_TMO      128
#define XB_XCNT(j)  (256  + 64 * (j))
#define XB_XSUB(j)  (1280 + 64 * (j))
#define XB_XGEN(j)  (2304 + 64 * (j))
#define XB_TOP      3328
#define XB_TOPGEN   3392
#define XCD_BAR_WORDS 3456
#define XB_SPIN_CAP (1u << 18)
#define LAS __attribute__((address_space(3)))
DI unsigned xb_ld(unsigned* p)              { return __hip_atomic_load(p, __ATOMIC_RELAXED, __HIP_MEMORY_SCOPE_AGENT); }
DI unsigned xb_add(unsigned* p, unsigned v) { return __hip_atomic_fetch_add(p, v, __ATOMIC_RELAXED, __HIP_MEMORY_SCOPE_AGENT); }
DI unsigned xb_xcc_id() { return (unsigned)__builtin_amdgcn_s_getreg((3 << 11) | 20) & 0xFu; }
#define XB_SPIN(cond, bar) do { unsigned _sp = 0; while (cond) { __builtin_amdgcn_s_sleep(1); \
    if ((++_sp & 255u) == 0u) { if (xb_ld(&(bar)[XB_TMO])) break; if (_sp > XB_SPIN_CAP) { atomicAdd(&(bar)[XB_TMO], 1u); break; } } } } while (0)
struct XcdBarrier { unsigned* bar; unsigned x; volatile LAS unsigned* st; };
DI XcdBarrier xcd_barrier_post(unsigned* bar, volatile LAS unsigned* st) {
  XcdBarrier b; b.bar = bar; b.x = xb_xcc_id(); b.st = st;
  if (threadIdx.x == 0) (void)xb_add(&bar[XB_XCNT(b.x)], 1u);
  return b;
}
DI void xcd_barrier_complete(unsigned* bar, unsigned x, unsigned& nloc, unsigned& nx) {
  const unsigned G = gridDim.x * gridDim.y * gridDim.z;
  unsigned sum, cnt, mine, sp = 0u;
  for (;;) {
    sum = 0u; cnt = 0u; mine = 0u;
#pragma unroll
    for (unsigned j = 0; j < 16; ++j) { const unsigned c = xb_ld(&bar[XB_XCNT(j)]); sum += c; cnt += (c > 0u) ? 1u : 0u; mine = (j == x) ? c : mine; }
    if (sum == G) break;
    __builtin_amdgcn_s_sleep(1);
    if ((++sp & 255u) == 0u) { if (xb_ld(&bar[XB_TMO])) break; if (sp > XB_SPIN_CAP) { atomicAdd(&bar[XB_TMO], 1u); break; } }
  }
  nloc = mine > 0u ? mine : 1u; nx = cnt > 0u ? cnt : 1u;
}
DI void xcd_barrier(const XcdBarrier& b) {
  asm volatile("s_waitcnt vmcnt(0)" ::: "memory");
  __syncthreads();
  if (threadIdx.x == 0) {
    unsigned* bar = b.bar;
    __builtin_amdgcn_s_waitcnt(0);
    unsigned nloc = b.st[0], nx = b.st[1];
    if (nloc == 0u) { xcd_barrier_complete(bar, b.x, nloc, nx); b.st[0] = nloc; b.st[1] = nx; }
    const unsigned old = xb_add(&bar[XB_XSUB(b.x)], 1u);
    const unsigned gen = old / nloc;
    if (old + 1u == (gen + 1u) * nloc) {
      __builtin_amdgcn_fence(__ATOMIC_RELEASE, "agent");
      asm volatile("s_waitcnt vmcnt(0)" ::: "memory");
      const unsigned og = xb_add(&bar[XB_TOP], 1u);
      const unsigned tg = og / nx;
      if (og + 1u == (tg + 1u) * nx) xb_add(&bar[XB_TOPGEN], 1u);
      else XB_SPIN(xb_ld(&bar[XB_TOPGEN]) == tg, bar);
      __builtin_amdgcn_fence(__ATOMIC_ACQUIRE, "agent");
      xb_add(&bar[XB_XGEN(b.x)], 1u);
      asm volatile("s_waitcnt vmcnt(0)" ::: "memory");
    } else {
      XB_SPIN(xb_ld(&bar[XB_XGEN(b.x)]) == gen, bar);
      __builtin_amdgcn_fence(__ATOMIC_ACQUIRE, "agent");
      asm volatile("s_waitcnt vmcnt(0)" ::: "memory");
    }
  }
  __syncthreads();
}

__global__ void __launch_bounds__(512, 2) fwd_megakernel(Params p) {
  extern __shared__ __attribute__((aligned(16))) unsigned char lds[];
  cg::grid_group grid = cg::this_grid();
  volatile LAS unsigned* xst = (volatile LAS unsigned*)(lds + LDS_BYTES - 16);
  if (threadIdx.x == 0) { xst[0] = 0u; xst[1] = 0u; }
  __syncthreads();
  const XcdBarrier xb = xcd_barrier_post(reinterpret_cast<unsigned*>(p.ws + WS_BAR), xst);
  for (int ph = p.ph_lo; ph < p.ph_hi; ++ph) {
    unsigned char* hl = lds + HALF_ID * HALF_LDS;
    if (ph == 0) phase_prep(p, hl);
    else if (ph == 1) phase_mod0(p);
    else {
      const int l = (ph - 2) >> 2, s = (ph - 2) & 3;
      if (s == 0) { if (l & 1) gemm_phase<G_IN_ODD>(p, l, lds); else gemm_phase<G_IN_EVEN>(p, l, lds); }
      else if (s == 1) { if (l & 1) phase_mix_odd(p, l, hl, lds); else phase_mix_even(p, l, hl, lds); }
      else if (s == 2) gemm_phase<G_OUT>(p, l, lds);
      else phase_ln(p, l);
    }
    if (ph + 1 < p.ph_hi) {
      if (p.ph_lo < 0) grid.sync();
      xcd_barrier(xb);
    }
  }
}

extern "C" void kernel_launch(void* const* d_in, const int* in_sizes, int n_in, void* d_out, int out_size, void* d_ws, size_t ws_size,
                              hipStream_t stream) {
  static int grid_blocks = 0;
  if (grid_blocks == 0) {
    if (n_in != 52 || ws_size < WS_END) {
      fprintf(stderr, "kernel_launch: expected 52 inputs and >= %zu bytes of workspace; got %d, %zu\n", (size_t)WS_END, n_in, ws_size);
      grid_blocks = -1;
      return;
    }
    int dev = 0, cus = 0, per_cu = 0;
    hipGetDevice(&dev);
    hipDeviceGetAttribute(&cus, hipDeviceAttributeMultiprocessorCount, dev);
    hipFuncSetAttribute((const void*)fwd_megakernel, hipFuncAttributeMaxDynamicSharedMemorySize, LDS_BYTES);
    hipOccupancyMaxActiveBlocksPerMultiprocessor(&per_cu, (const void*)fwd_megakernel, 512, LDS_BYTES);
    (void)hipGetLastError();
    grid_blocks = cus;
  }
  if (grid_blocks < 0) return;
  Params p{};
  for (int i = 0; i < 52; ++i) p.in[i] = (const float*)d_in[i];
  p.out = (float*)d_out;
  p.ws = (unsigned char*)d_ws;
#if MULTI
  for (int ph = 0; ph < NPHASE; ++ph) {
    p.ph_lo = ph; p.ph_hi = ph + 1;
    hipLaunchKernelGGL(fwd_megakernel, dim3(grid_blocks), dim3(512), LDS_BYTES, stream, p);
  }
#else
  p.ph_lo = 0; p.ph_hi = NPHASE;
  if (hipMemsetAsync((char*)d_ws + WS_BAR, 0, XCD_BAR_WORDS * 4, stream) != hipSuccess) { fprintf(stderr, "kernel_launch: memset of barrier words failed\n"); return; }
  void* args[] = {&p};
  hipError_t e = hipLaunchCooperativeKernel((const void*)fwd_megakernel, dim3(grid_blocks), dim3(512), args, LDS_BYTES, stream);
  if (e != hipSuccess) fprintf(stderr, "cooperative launch failed: %s (grid %d)\n", hipGetErrorString(e), grid_blocks);
#endif
}
```

```cpp
#include <hip/hip_runtime.h>
#include <hip/hip_cooperative_groups.h>
#include <cstdio>
namespace cg = cooperative_groups;

#define DI __device__ __forceinline__
typedef unsigned short u16;
typedef unsigned int u32;
using bf16x8 = __attribute__((ext_vector_type(8))) short;
using f32x4 = __attribute__((ext_vector_type(4))) float;
using f32x16 = __attribute__((ext_vector_type(16))) float;
using u32x4 = __attribute__((ext_vector_type(4))) unsigned;
using u32x2 = __attribute__((ext_vector_type(2))) unsigned;
typedef __bf16 bf2_t __attribute__((ext_vector_type(2)));
typedef float f2_t __attribute__((ext_vector_type(2)));

#ifndef MULTI
#define MULTI 0
#endif
#ifndef REP0
#define REP0 1
#endif
#ifndef REP1
#define REP1 1
#endif
#ifndef ZERO_MASK
#define ZERO_MASK 0
#endif

constexpr int T_ALL = 24576, TP = 8192, DM = 2048;
constexpr float LOG2E = 1.4426950408889634f;
constexpr float ALPHA = 1.6817928305074290f;
constexpr float LN_EPS = 1e-5f;
constexpr int HALF_LDS = 76288;
constexpr int LDS_BYTES = 2 * HALF_LDS + 16;
constexpr int NPHASE = 18;

constexpr size_t SZ_WIN_E = (size_t)6144 * 2048 * 2, SZ_WIN_O = (size_t)7168 * 2048 * 2;
constexpr size_t WS_WINT = 0;
constexpr size_t WS_WOUTT = WS_WINT + 2 * SZ_WIN_E + 2 * SZ_WIN_O;
constexpr size_t WS_POOLWT = WS_WOUTT + (size_t)4 * 2048 * 2048 * 2;
constexpr size_t WS_SGUW = WS_POOLWT + (size_t)2 * 4 * 256 * 256 * 2;
constexpr size_t WS_CK = WS_SGUW + (size_t)2 * 4 * 128 * 128 * 2;
constexpr size_t WS_CVT = WS_CK + (size_t)4 * 4194304;
constexpr size_t WS_MOD = WS_CVT + (size_t)4 * 4194304;
constexpr size_t WS_ROPE = WS_MOD + (size_t)4 * 5 * 6144 * 4;
constexpr size_t WS_H = WS_ROPE + 8192;
constexpr size_t WS_PROJ = WS_H + (size_t)T_ALL * 2048 * 2;
constexpr size_t WS_VT = WS_PROJ + (size_t)T_ALL * 7168 * 2;
constexpr size_t WS_BAR = WS_VT + (size_t)T_ALL * 1024 * 2;
constexpr size_t WS_STATS = WS_BAR + 16384;
constexpr size_t WS_END = WS_STATS + (size_t)T_ALL * 8;

struct Params {
  const float* in[52];
  float* out;
  unsigned char* ws;
  int ph_lo, ph_hi;
};

DI size_t ws_wint(int l) { return WS_WINT + (size_t)(l >> 1) * (SZ_WIN_E + SZ_WIN_O) + ((l & 1) ? SZ_WIN_E : 0); }

DI u32 pk2(float a, float b) { f2_t v = {a, b}; bf2_t r = __builtin_convertvector(v, bf2_t); return __builtin_bit_cast(u32, r); }
DI float bflo(u32 w) { return __uint_as_float(w << 16); }
DI float bfhi(u32 w) { return __uint_as_float(w & 0xffff0000u); }
DI float bf1(u16 w) { return __uint_as_float(((u32)w) << 16); }
DI float ex2(float x) { return __builtin_amdgcn_exp2f(x); }
DI float silu(float x) { return x / (1.f + __expf(-x)); }
DI f32x4 mfma16(bf16x8 a, bf16x8 b, f32x4 c) { return __builtin_amdgcn_mfma_f32_16x16x32_bf16(a, b, c, 0, 0, 0); }
DI f32x16 mfma32(bf16x8 a, bf16x8 b, f32x16 c) { return __builtin_amdgcn_mfma_f32_32x32x16_bf16(a, b, c, 0, 0, 0); }
DI bf16x8 ld8(const u16* p) { return *reinterpret_cast<const bf16x8*>(p); }
DI int opq(int x) { asm volatile("" : "+v"(x)); return x; }
#define TIDX (opq((int)threadIdx.x) & 255)
#define TID8 (opq((int)threadIdx.x))
#define HALF_ID (opq((int)threadIdx.x) >> 8)
#define VBID ((int)((blockIdx.x & 7u) | ((unsigned)HALF_ID << 3) | ((blockIdx.x >> 3) << 4)))
#define VGRID ((int)gridDim.x * 2)

enum { G_IN_EVEN = 0, G_IN_ODD = 1, G_OUT = 2 };

namespace pg8 {
#define PG8_LAS __attribute__((address_space(3)))
typedef unsigned short bf16_t;
typedef short bf16x8 __attribute__((ext_vector_type(8)));
typedef float f32x4 __attribute__((ext_vector_type(4)));
typedef unsigned u32x4 __attribute__((ext_vector_type(4)));
constexpr int BM = 256, BK = 64, HALF = 128, HTB = HALF * BK * 2  , STAGE_BYTES = 8 * HTB, NXCD = 8, WGM = 8;

__host__ __device__ __forceinline__ int lds_byte(int r, int c) { const int st = (r >> 4) * 2 + (c >> 5), rr = r & 15, cc = c & 31, ob = rr * 64 + cc * 2; return st * 1024 + (ob ^ (((ob >> 9) & 1) << 5)); }
__host__ __device__ __forceinline__ void stage_rc(int b, int& R, int& C) { const int st = b / 1024, sb = b % 1024, swz = sb ^ (((sb >> 9) & 1) << 5); R = (st >> 1) * 16 + swz / 64; C = (st & 1) * 32 + (swz % 64) / 2; }
__host__ __device__ __forceinline__ int perm32(int rho) { const int n = rho >> 4, i = rho & 15; return 8 * (i >> 2) + 4 * n + (i & 3); }

struct Unit { int pm, pn; };
struct Gemm { const bf16_t* A; const bf16_t* Bt; int M, N, K; };

struct StaticOrder {
    int nM, nN, nwg, G, c;
    __host__ __device__ void init(int M, int N, int G_, int c_) { nM = M / BM; nN = N / BM; nwg = nM * nN; G = G_; c = c_; }
    __host__ __device__ bool next(int i, Unit& u) const {
        const long L = (long)i * G + c; if (L >= nwg) return false;
        int wgid = (int)L; { const int q = nwg / NXCD, r = nwg % NXCD, xcd = wgid % NXCD, off = wgid / NXCD; wgid = (xcd < r ? xcd * (q + 1) : r * (q + 1) + (xcd - r) * q) + off; }
        const int nig = WGM * nN, gid = wgid / nig, fm = gid * WGM, gsz = (nM - fm) < WGM ? (nM - fm) : WGM;
        u.pm = fm + ((wgid % nig) % gsz); u.pn = (wgid % nig) / gsz; return true;
    }
    __device__ __forceinline__ void a_ready(const Unit&) const {}
    __device__ __forceinline__ void done(const Unit&) const {}
};

template <class Epi, class Sched, bool STAMP = false>
__device__ __forceinline__ void gemm_phase(PG8_LAS unsigned char* lds, const Gemm g, const Sched& S, const Epi& E, unsigned long long* stamps) {
    const int tid = opq((int)threadIdx.x), wid = __builtin_amdgcn_readfirstlane(tid >> 6), lane = tid & 63, wr = wid >> 2, wc = wid & 3, fr = lane & 15, fq = lane >> 4;
    const int K = g.K, nt = K / BK;
    int ts_lo = 0, ts_hi = 0, nts = 0; const unsigned long long rt_entry = STAMP ? (unsigned long long)wall_clock64() : 0ull;
#define PG8_STAMP() do { if (STAMP && wid == 0 && nts < 64) { const unsigned long long _c = (unsigned long long)clock64(); \
        ts_lo = (lane == nts) ? (int)(unsigned)_c : ts_lo; ts_hi = (lane == nts) ? (int)(unsigned)(_c >> 32) : ts_hi; ++nts; } } while (0)
    PG8_STAMP();
    unsigned voffA[2], voffB[2];
#pragma unroll
    for (int i = 0; i < 2; ++i) { int R, C; stage_rc(tid * 16 + i * 8192, R, C); const int Rb = Epi::PERM ? ((R & ~31) + perm32(R & 31)) : R;
        voffA[i] = (unsigned)(R * K + C) * 2u; voffB[i] = (unsigned)(Rb * K + C) * 2u; }
    const size_t kstep = (size_t)(BK * 2);
    const size_t hstep = (size_t)HALF * K * 2;
    const size_t tstep = 2 * hstep;
    const unsigned ldsw = (unsigned)wid * 1024u;
    const int aoff = lds_byte(wr * 64 + fr, fq * 8), boff = lds_byte(wc * 32 + fr, fq * 8);
#define PG8_SA(b, h) (((b) * 2 + (h)) * HTB)
#define PG8_SB(b, h) ((4 + (b) * 2 + (h)) * HTB)
#define PG8_STAGE(bufoff, gbase, voff) do { _Pragma("unroll") for (int _i = 0; _i < 2; ++_i) \
        __builtin_amdgcn_global_load_lds((const unsigned*)((const char*)(gbase) + (voff)[_i]), (PG8_LAS unsigned*)(lds + (bufoff) + ldsw + _i * 8192), 16, 0, 0); } while (0)
#define PG8_LDA(dst, b, h) do { _Pragma("unroll") for (int m = 0; m < 4; ++m) _Pragma("unroll") for (int k = 0; k < 2; ++k) dst[m][k] = *(const PG8_LAS bf16x8*)(lds + PG8_SA(b, h) + aoff + m * 2048 + k * 1024); } while (0)
#define PG8_LDB(dst, b, h) do { _Pragma("unroll") for (int n = 0; n < 2; ++n) _Pragma("unroll") for (int k = 0; k < 2; ++k) dst[n][k] = *(const PG8_LAS bf16x8*)(lds + PG8_SB(b, h) + boff + n * 2048 + k * 1024); } while (0)
#define PG8_MMA(ai, bj, At, Bt) do { __builtin_amdgcn_s_setprio(1); _Pragma("unroll") for (int m = 0; m < 4; ++m) _Pragma("unroll") for (int n = 0; n < 2; ++n) _Pragma("unroll") for (int k = 0; k < 2; ++k) \
        acc[ai][bj][m][n] = __builtin_amdgcn_mfma_f32_16x16x32_bf16(Bt[n][k], At[m][k], acc[ai][bj][m][n], 0, 0, 0); __builtin_amdgcn_s_setprio(0); } while (0)
#define PG8_WAIT_V(n) asm volatile("s_waitcnt vmcnt(" #n ")" ::: "memory")
#define PG8_WAIT_L(n) asm volatile("s_waitcnt lgkmcnt(" #n ")" ::: "memory")
#define PG8_BAR __builtin_amdgcn_s_barrier()
#define PG8_SCHED __builtin_amdgcn_sched_barrier(0)
    Unit cur, nxt; int ui = 0;
    if (!S.next(0, cur)) return;
    f32x4 acc[2][2][4][2];
#pragma unroll
    for (int a = 0; a < 2; ++a)
#pragma unroll
        for (int b = 0; b < 2; ++b)
#pragma unroll
            for (int m = 0; m < 4; ++m)
#pragma unroll
                for (int n = 0; n < 2; ++n) acc[a][b][m][n] = (f32x4){0.f, 0.f, 0.f, 0.f};
    bf16x8 At[4][2], B0[2][2], B1[2][2];
    const char* cA = (const char*)g.A + (size_t)cur.pm * tstep; const char* cB = (const char*)g.Bt + (size_t)cur.pn * tstep;
    S.a_ready(cur);
    PG8_STAGE(PG8_SB(0, 0), cB, voffB); PG8_STAGE(PG8_SA(0, 0), cA, voffA); PG8_STAGE(PG8_SB(0, 1), cB + hstep, voffB); PG8_STAGE(PG8_SA(0, 1), cA + hstep, voffA);
    if (wr == 1) PG8_BAR;
    PG8_WAIT_V(4); PG8_BAR;
    PG8_STAGE(PG8_SB(1, 0), cB + kstep, voffB); PG8_STAGE(PG8_SA(1, 0), cA + kstep, voffA); PG8_STAGE(PG8_SB(1, 1), cB + hstep + kstep, voffB);
    PG8_WAIT_V(6); PG8_BAR;
    PG8_STAMP();
    for (;;) {
        const bool has_next = S.next(ui + 1, nxt);
        const char* nA = has_next ? (const char*)g.A + (size_t)nxt.pm * tstep : cA; const char* nB = has_next ? (const char*)g.Bt + (size_t)nxt.pn * tstep : cB;
        for (int t = 0; t < nt; t += 2) {
            const bool last = (t == nt - 2);
            const char* a1 = cA + (size_t)(t + 1) * kstep;
            const char* a2 = last ? nA : cA + (size_t)(t + 2) * kstep; const char* b2 = last ? nB : cB + (size_t)(t + 2) * kstep;
            const char* a3 = a2 + kstep; const char* b3 = b2 + kstep;
            if (last && has_next) S.a_ready(nxt);
            PG8_LDB(B0, 0, 0); PG8_SCHED; PG8_LDA(At, 0, 0); PG8_STAGE(PG8_SA(1, 1), a1 + hstep, voffA);
            PG8_WAIT_L(8); PG8_BAR; PG8_WAIT_L(0); PG8_MMA(0, 0, At, B0); PG8_BAR; PG8_SCHED;
            PG8_LDB(B1, 0, 1); PG8_STAGE(PG8_SB(0, 0), b2, voffB);
            PG8_BAR; PG8_WAIT_L(0); PG8_MMA(0, 1, At, B1); PG8_BAR;
            PG8_LDA(At, 0, 1); PG8_STAGE(PG8_SA(0, 0), a2, voffA);
            PG8_BAR; PG8_WAIT_L(0); PG8_MMA(1, 0, At, B0); PG8_BAR; PG8_SCHED;
            PG8_STAGE(PG8_SB(0, 1), b2 + hstep, voffB);
            PG8_WAIT_V(6); PG8_BAR; PG8_MMA(1, 1, At, B1); PG8_BAR;
            PG8_LDB(B0, 1, 0); PG8_SCHED; PG8_LDA(At, 1, 0); PG8_STAGE(PG8_SA(0, 1), a2 + hstep, voffA);
            PG8_WAIT_L(8); PG8_BAR; PG8_WAIT_L(0); PG8_MMA(0, 0, At, B0); PG8_BAR; PG8_SCHED;
            PG8_LDB(B1, 1, 1); PG8_STAGE(PG8_SB(1, 0), b3, voffB);
            PG8_BAR; PG8_WAIT_L(0); PG8_MMA(0, 1, At, B1); PG8_BAR;
            PG8_LDA(At, 1, 1); PG8_STAGE(PG8_SA(1, 0), a3, voffA);
            PG8_BAR; PG8_WAIT_L(0); PG8_MMA(1, 0, At, B0); PG8_BAR; PG8_SCHED;
            PG8_STAGE(PG8_SB(1, 1), b3 + hstep, voffB);
            PG8_WAIT_V(6); PG8_BAR; PG8_MMA(1, 1, At, B1); PG8_BAR;
        }
        PG8_STAMP();
        if constexpr (!Epi::AFTER_DRAIN) { E(acc, cur, wr, wc, fr, fq); S.done(cur); }
        PG8_STAMP();
        if (!has_next) break;
#pragma unroll
        for (int a = 0; a < 2; ++a)
#pragma unroll
            for (int b = 0; b < 2; ++b)
#pragma unroll
                for (int m = 0; m < 4; ++m)
#pragma unroll
                    for (int n = 0; n < 2; ++n) acc[a][b][m][n] = (f32x4){0.f, 0.f, 0.f, 0.f};
        cur = nxt; cA = nA; cB = nB; ++ui;
    }
    PG8_WAIT_V(0);
    if (wr == 0) PG8_BAR;
    PG8_BAR;
    if constexpr (Epi::AFTER_DRAIN) { E.fused(acc, cur, wr, wc, fr, fq, lds, wid, lane); S.done(cur); }
    PG8_STAMP();
    if (STAMP && wid == 0) { stamps[lane] = lane < nts ? (((unsigned long long)(unsigned)ts_hi << 32) | (unsigned)ts_lo) : 0ull;
        if (lane == 62) stamps[62] = rt_entry; if (lane == 63) stamps[63] = (unsigned long long)wall_clock64(); }
#undef PG8_STAMP
#undef PG8_SA
#undef PG8_SB
#undef PG8_STAGE
#undef PG8_LDA
#undef PG8_LDB
#undef PG8_MMA
#undef PG8_WAIT_V
#undef PG8_WAIT_L
#undef PG8_BAR
#undef PG8_SCHED
}
}

DI void tr_tile(const float* __restrict__ src, size_t ld_src, u16* __restrict__ dst, size_t ld_dst, float* sT) {
  const int tid = TIDX;
  const int r = tid >> 4, c4 = (tid & 15) * 4;
#pragma unroll
  for (int i = 0; i < 4; ++i) {
    float4 v = *reinterpret_cast<const float4*>(src + (size_t)(r + 16 * i) * ld_src + c4);
    float* d = sT + (r + 16 * i) * 65 + c4;
    d[0] = v.x; d[1] = v.y; d[2] = v.z; d[3] = v.w;
  }
  __syncthreads();
  const int n = tid >> 2, ks = (tid & 3) * 16;
  u32 w[8];
#pragma unroll
  for (int j = 0; j < 8; ++j) w[j] = pk2(sT[(ks + 2 * j) * 65 + n], sT[(ks + 2 * j + 1) * 65 + n]);
  u32x4* o = reinterpret_cast<u32x4*>(dst + (size_t)n * ld_dst + ks);
  o[0] = u32x4{w[0], w[1], w[2], w[3]};
  o[1] = u32x4{w[4], w[5], w[6], w[7]};
  __syncthreads();
}

DI void cvt8(const float* __restrict__ src, u16* __restrict__ dst) {
  float4 a = *reinterpret_cast<const float4*>(src);
  float4 b = *reinterpret_cast<const float4*>(src + 4);
  *reinterpret_cast<u32x4*>(dst) = u32x4{pk2(a.x, a.y), pk2(a.z, a.w), pk2(b.x, b.y), pk2(b.z, b.w)};
}

DI void mod_item(const Params& p, int i, unsigned char* lds) {
  const int tid = TIDX;
  const int l = i / 96, n0 = (i % 96) * 64;
  float* sS = reinterpret_cast<float*>(lds);
  float* red = sS + 5 * 2048;
  const float* c = p.in[10];
  const float* cctx = p.in[11];
  for (int e = tid; e < 5 * 2048; e += 256) {
    int v = e >> 11, k = e & 2047;
    float x = (v == 0) ? cctx[k] : c[(v - 1) * 2048 + k];
    sS[e] = silu(x);
  }
  __syncthreads();
  const int kk = tid >> 4, c4 = (tid & 15) * 4;
  const float* W = p.in[12 + 10 * l] + n0 + c4;
  f32x4 acc[5];
#pragma unroll
  for (int v = 0; v < 5; ++v) acc[v] = f32x4{0.f, 0.f, 0.f, 0.f};
#pragma unroll 8
  for (int k = kk; k < 2048; k += 16) {
    float4 w = *reinterpret_cast<const float4*>(W + (size_t)k * 6144);
#pragma unroll
    for (int v = 0; v < 5; ++v) {
      float s = sS[v * 2048 + k];
      acc[v][0] += s * w.x; acc[v][1] += s * w.y; acc[v][2] += s * w.z; acc[v][3] += s * w.w;
    }
  }
#pragma unroll
  for (int v = 0; v < 5; ++v)
#pragma unroll
    for (int q = 0; q < 4; ++q) red[(kk * 5 + v) * 64 + c4 + q] = acc[v][q];
  __syncthreads();
  for (int t2 = tid; t2 < 320; t2 += 256) {
    int v = t2 >> 6, n = t2 & 63;
    float s = 0.f;
#pragma unroll
    for (int k2 = 0; k2 < 16; ++k2) s += red[(k2 * 5 + v) * 64 + n];
    float* mod = reinterpret_cast<float*>(p.ws + WS_MOD);
    mod[(size_t)(l * 5 + v) * 6144 + n0 + n] = s + p.in[13 + 10 * l][n0 + n];
  }
  __syncthreads();
}

DI void phase_prep(const Params& p, unsigned char* lds) {
  constexpr int N_MOD = 384, N_TRWIN = 13312, N_TRWOUT = 4096, N_TRPOOL = 128, N_SGU = 64, N_CK = 4096, N_CV = 2048;
  constexpr int TOTAL = N_MOD + N_TRWIN + N_TRWOUT + N_TRPOOL + N_SGU + N_CK + N_CV + 1;
  const int tid = TIDX;
  float* sT = reinterpret_cast<float*>(lds);
  for (int it = VBID; it < TOTAL; it += VGRID) {
    int i = it;
    if (i < N_MOD) { mod_item(p, i, lds); continue; }
    i -= N_MOD;
    if (i < N_TRWIN) {
      int l, base;
      if (i < 3072) { l = 0; base = 0; } else if (i < 6656) { l = 1; base = 3072; } else if (i < 9728) { l = 2; base = 6656; } else { l = 3; base = 9728; }
      i -= base;
      const int N = (l & 1) ? 7168 : 6144, nN = N / 64;
      const int kt = i / nN, nt = i % nN;
      tr_tile(p.in[14 + 10 * l] + (size_t)kt * 64 * N + nt * 64, N,
              reinterpret_cast<u16*>(p.ws + ws_wint(l)) + (size_t)nt * 64 * 2048 + kt * 64, 2048, sT);
      continue;
    }
    i -= N_TRWIN;
    if (i < N_TRWOUT) {
      const int l = i >> 10, r = i & 1023, kt = r >> 5, nt = r & 31;
      tr_tile(p.in[15 + 10 * l] + (size_t)kt * 64 * 2048 + nt * 64, 2048,
              reinterpret_cast<u16*>(p.ws + WS_WOUTT) + (size_t)l * 2048 * 2048 + (size_t)nt * 64 * 2048 + kt * 64, 2048, sT);
      continue;
    }
    i -= N_TRWOUT;
    if (i < N_TRPOOL) {
      const int e = i >> 6, r = i & 63, g = r >> 4, t = r & 15, kt = t >> 2, nt = t & 3;
      tr_tile(p.in[18 + 20 * e] + (size_t)g * 65536 + kt * 64 * 256 + nt * 64, 256,
              reinterpret_cast<u16*>(p.ws + WS_POOLWT) + (size_t)e * 262144 + g * 65536 + nt * 64 * 256 + kt * 64, 256, sT);
      continue;
    }
    i -= N_TRPOOL;
    if (i < N_SGU) {
      const int e = i >> 5, ch = i & 31;
      const size_t off = (size_t)ch * 2048 + tid * 8;
      cvt8(p.in[30 + 20 * e] + off, reinterpret_cast<u16*>(p.ws + WS_SGUW) + (size_t)e * 65536 + off);
      continue;
    }
    i -= N_SGU;
    if (i < N_CK) {
      const int l = i >> 10, ch = i & 1023;
      const size_t off = (size_t)ch * 2048 + tid * 8;
      cvt8(p.in[2 + 2 * l] + off, reinterpret_cast<u16*>(p.ws + WS_CK) + (size_t)l * 2097152 + off);
      continue;
    }
    i -= N_CK;
    if (i < N_CV) {
      const int l = i >> 9, r = i & 511, bh = r >> 4, t = r & 15, kt = t >> 1, nt = t & 1;
      tr_tile(p.in[3 + 2 * l] + (size_t)bh * 65536 + kt * 64 * 128 + nt * 64, 128,
              reinterpret_cast<u16*>(p.ws + WS_CVT) + (size_t)l * 2097152 + (size_t)bh * 65536 + nt * 64 * 512 + kt * 64, 512, sT);
      continue;
    }
    {
      float* rc = reinterpret_cast<float*>(p.ws + WS_ROPE);
      for (int e = tid; e < 1024; e += 256) {
        int pos = e >> 4, fi = e & 15;
        float inv = 1.0f / powf(10000.0f, (float)(2 * fi) / 32.0f);
        float ang = (float)pos * inv;
        rc[e] = cosf(ang);
        rc[1024 + e] = sinf(ang);
      }
    }
  }
}

DI void phase_mod0(const Params& p) {
  const int tid = TIDX;
  const float* mod = reinterpret_cast<const float*>(p.ws + WS_MOD);
  u16* H = reinterpret_cast<u16*>(p.ws + WS_H);
  for (int it = VBID; it < T_ALL / 4; it += VGRID) {
#pragma unroll
    for (int rr = 0; rr < 4; ++rr) {
      const int row = it * 4 + rr;
      const int cond = row < TP ? 0 : 1 + ((row - TP) >> 12);
      const float* src = row < TP ? p.in[0] + (size_t)row * 2048 : p.in[1] + (size_t)(row - TP) * 2048;
      const int e = tid * 8;
      const float* sh = mod + (size_t)cond * 6144 + e;
      float4 a = *reinterpret_cast<const float4*>(src + e), b = *reinterpret_cast<const float4*>(src + e + 4);
      float4 s0 = *reinterpret_cast<const float4*>(sh), s1 = *reinterpret_cast<const float4*>(sh + 4);
      float4 c0 = *reinterpret_cast<const float4*>(sh + 2048), c1 = *reinterpret_cast<const float4*>(sh + 2052);
      u32x4 o = {pk2(a.x * (1.f + c0.x) + s0.x, a.y * (1.f + c0.y) + s0.y), pk2(a.z * (1.f + c0.z) + s0.z, a.w * (1.f + c0.w) + s0.w),
                 pk2(b.x * (1.f + c1.x) + s1.x, b.y * (1.f + c1.y) + s1.y), pk2(b.z * (1.f + c1.z) + s1.z, b.w * (1.f + c1.w) + s1.w)};
      *reinterpret_cast<u32x4*>(H + (size_t)row * 2048 + e) = o;
    }
  }
}


template <int MODE>
struct EpiIn {
  static constexpr bool PERM = false, AFTER_DRAIN = false;
  u16* PROJ; u16* VT; float* kout; float* vout; const float* ropeC; const float* ropeS;
  DI void operator()(const f32x4 (&acc)[2][2][4][2], const pg8::Unit& u, int wr, int wc, int fr, int fq) const {
    constexpr int NC = (MODE == G_IN_EVEN) ? 6144 : 7168;
    constexpr int SEC_Q = (MODE == G_IN_EVEN) ? 2 : 0, SEC_K = (MODE == G_IN_EVEN) ? 3 : 1, SEC_V = (MODE == G_IN_EVEN) ? 4 : 2;
    const int sec = u.pn >> 2;
    const bool prompt = u.pm < 32;
    const bool isq = sec == SEC_Q, isk = sec == SEC_K;
    const bool rope = (MODE == G_IN_EVEN) && (isq || isk) && !prompt;
    const float sc = isq ? ((MODE == G_IN_EVEN) ? 0.125f * LOG2E : 0.08838834764831845f * LOG2E) : 1.0f;
#pragma unroll
    for (int ai = 0; ai < 2; ++ai)
#pragma unroll
      for (int m = 0; m < 4; ++m) {
        const int row = u.pm * 256 + ai * 128 + wr * 64 + m * 16 + fr;
        int b, t;
        if (prompt) { b = row >> 8; t = row & 255; } else { const int rs = row - TP; b = rs >> 12; t = rs & 4095; }
#pragma unroll
        for (int bj = 0; bj < 2; ++bj) {
          const int hh = (u.pn & 3) * 2 + bj;
          const int d0 = wc * 32 + 4 * fq;
          if (sec == SEC_V) {
#pragma unroll
            for (int n = 0; n < 2; ++n) {
              const f32x4 v = acc[ai][bj][m][n];
              const int dv = d0 + 16 * n;
              const u32 w01 = pk2(v[0], v[1]), w23 = pk2(v[2], v[3]);
              if (prompt) {
                u16* vt = VT + ((size_t)((b * 8 + hh) * 128 + dv)) * 256 + t;
                vt[0] = (u16)(w01 & 0xffffu); vt[256] = (u16)(w01 >> 16); vt[512] = (u16)(w23 & 0xffffu); vt[768] = (u16)(w23 >> 16);
                *reinterpret_cast<float4*>(vout + ((size_t)((b * 8 + hh) * 256 + t)) * 128 + dv) = float4{v[0], v[1], v[2], v[3]};
              } else {
                u16* vt = VT + 8388608 + ((size_t)((b * 8 + hh) * 128 + dv)) * 4096 + t;
                vt[0] = (u16)(w01 & 0xffffu); vt[4096] = (u16)(w01 >> 16); vt[8192] = (u16)(w23 & 0xffffu); vt[12288] = (u16)(w23 >> 16);
              }
            }
          } else {
            f32x4 v0 = acc[ai][bj][m][0], v1 = acc[ai][bj][m][1];
            if (isk && prompt) {
              float* ko = kout + ((size_t)((b * 8 + hh) * 256 + t)) * 128 + d0;
              *reinterpret_cast<float4*>(ko) = float4{v0[0], v0[1], v0[2], v0[3]};
              *reinterpret_cast<float4*>(ko + 16) = float4{v1[0], v1[1], v1[2], v1[3]};
            }
            if (rope) {
              const int pos = (wc & 1) ? (t & 63) : (t >> 6);
              const float4 cs = *reinterpret_cast<const float4*>(ropeC + pos * 16 + 4 * fq);
              const float4 sn = *reinterpret_cast<const float4*>(ropeS + pos * 16 + 4 * fq);
              const float c4[4] = {cs.x, cs.y, cs.z, cs.w}, s4[4] = {sn.x, sn.y, sn.z, sn.w};
#pragma unroll
              for (int j = 0; j < 4; ++j) {
                const float x1 = v0[j], x2 = v1[j];
                v0[j] = x1 * c4[j] - x2 * s4[j];
                v1[j] = x1 * s4[j] + x2 * c4[j];
              }
            }
            u16* dst = PROJ + (size_t)row * NC + u.pn * 256 + bj * 128 + d0;
            *reinterpret_cast<u32x2*>(dst) = u32x2{pk2(v0[0] * sc, v0[1] * sc), pk2(v0[2] * sc, v0[3] * sc)};
            *reinterpret_cast<u32x2*>(dst + 16) = u32x2{pk2(v1[0] * sc, v1[1] * sc), pk2(v1[2] * sc, v1[3] * sc)};
          }
        }
      }
  }
};

struct EpiOut {
  static constexpr bool PERM = false, AFTER_DRAIN = false;
  float* X; const float* x0; const float* x1; const float* mod; const float* lng; const float* lnb; const float2* stats; int l;
  DI void operator()(const f32x4 (&acc)[2][2][4][2], const pg8::Unit& u, int wr, int wc, int fr, int fq) const {
    const bool prompt = u.pm < 32;
    const int cond = prompt ? 0 : 1 + ((u.pm * 256 - TP) >> 12);
    const float* gate = mod + (size_t)(l * 5 + cond) * 6144 + 4096;
    const int col0 = u.pn * 256 + wc * 32 + 4 * fq;
#pragma unroll
    for (int ai = 0; ai < 2; ++ai)
#pragma unroll
      for (int m = 0; m < 4; ++m) {
        const int row = u.pm * 256 + ai * 128 + wr * 64 + m * 16 + fr;
        float2 st = float2{0.f, 1.f};
        if (l != 0) st = stats[row];
#pragma unroll
        for (int bj = 0; bj < 2; ++bj)
#pragma unroll
          for (int n = 0; n < 2; ++n) {
            const int col = col0 + bj * 128 + 16 * n;
            const float4 g4 = *reinterpret_cast<const float4*>(gate + col);
            float4 xo;
            if (l == 0) {
              xo = prompt ? *reinterpret_cast<const float4*>(x0 + (size_t)row * 2048 + col)
                          : *reinterpret_cast<const float4*>(x1 + (size_t)(row - TP) * 2048 + col);
            } else {
              const u32x2 zw = *reinterpret_cast<const u32x2*>(reinterpret_cast<const u16*>(X) + (size_t)row * 4096 + col);
              const float4 z = float4{bflo(zw[0]), bfhi(zw[0]), bflo(zw[1]), bfhi(zw[1])};
              const float4 lg = *reinterpret_cast<const float4*>(lng + col), lb = *reinterpret_cast<const float4*>(lnb + col);
              xo.x = (z.x - st.x) * st.y * lg.x + lb.x; xo.y = (z.y - st.x) * st.y * lg.y + lb.y;
              xo.z = (z.z - st.x) * st.y * lg.z + lb.z; xo.w = (z.w - st.x) * st.y * lg.w + lb.w;
            }
            const f32x4 a = acc[ai][bj][m][n];
            float4 o;
            o.x = ALPHA * xo.x + g4.x * a[0]; o.y = ALPHA * xo.y + g4.y * a[1];
            o.z = ALPHA * xo.z + g4.z * a[2]; o.w = ALPHA * xo.w + g4.w * a[3];
            *reinterpret_cast<u32x2*>(reinterpret_cast<u16*>(X) + (size_t)row * 4096 + col) = u32x2{pk2(o.x, o.y), pk2(o.z, o.w)};
          }
      }
  }
};

template <int MODE>
DI void gemm_phase(const Params& p, int l, unsigned char* lds) {
  constexpr int N = (MODE == G_OUT) ? 2048 : (MODE == G_IN_EVEN ? 6144 : 7168);
  pg8::Gemm g;
  g.A = reinterpret_cast<const u16*>(p.ws + WS_H);
  g.Bt = (MODE == G_OUT) ? reinterpret_cast<const u16*>(p.ws + WS_WOUTT) + (size_t)l * 2048 * 2048
                         : reinterpret_cast<const u16*>(p.ws + ws_wint(l));
  g.M = T_ALL; g.N = N; g.K = 2048;
  pg8::StaticOrder S;
  S.init(T_ALL, N, (int)gridDim.x, (int)blockIdx.x);
  PG8_LAS unsigned char* l3 = (PG8_LAS unsigned char*)lds;
  if constexpr (MODE == G_OUT) {
    EpiOut E;
    E.X = p.out; E.x0 = p.in[0]; E.x1 = p.in[1]; E.mod = reinterpret_cast<const float*>(p.ws + WS_MOD); E.l = l;
    E.lng = p.in[16 + 10 * (l > 0 ? l - 1 : 0)]; E.lnb = p.in[17 + 10 * (l > 0 ? l - 1 : 0)];
    E.stats = reinterpret_cast<const float2*>(p.ws + WS_STATS);
    pg8::gemm_phase<EpiOut, pg8::StaticOrder, false>(l3, g, S, E, nullptr);
  } else {
    EpiIn<MODE> E;
    E.PROJ = reinterpret_cast<u16*>(p.ws + WS_PROJ); E.VT = reinterpret_cast<u16*>(p.ws + WS_VT);
    E.kout = p.out + (size_t)T_ALL * 2048 + (size_t)(2 * l) * 8388608;
    E.vout = p.out + (size_t)T_ALL * 2048 + (size_t)(2 * l + 1) * 8388608;
    E.ropeC = reinterpret_cast<const float*>(p.ws + WS_ROPE); E.ropeS = E.ropeC + 1024;
    pg8::gemm_phase<EpiIn<MODE>, pg8::StaticOrder, false>(l3, g, S, E, nullptr);
  }
}

DI void phase_ln(const Params& p, int l) {
  const int tid_ = TIDX, lane = tid_ & 63, wid = tid_ >> 6;
  const float* g = p.in[16 + 10 * l];
  const float* bb = p.in[17 + 10 * l];
  const float* mod = reinterpret_cast<const float*>(p.ws + WS_MOD);
  u16* H = reinterpret_cast<u16*>(p.ws + WS_H);
  float* X = p.out;
  for (int it = VBID; it < T_ALL / 4; it += VGRID) {
    const int row = it * 4 + wid;
    float* xr = X + (size_t)row * 2048;
    const u16* zr = reinterpret_cast<const u16*>(xr);
    float4 v[8];
    float s = 0.f;
#pragma unroll
    for (int i = 0; i < 8; ++i) {
      const u32x2 w = *reinterpret_cast<const u32x2*>(zr + (i * 64 + lane) * 4);
      v[i] = float4{bflo(w[0]), bfhi(w[0]), bflo(w[1]), bfhi(w[1])};
      s += v[i].x + v[i].y + v[i].z + v[i].w;
    }
#pragma unroll
    for (int o = 32; o >= 1; o >>= 1) s += __shfl_xor(s, o);
    const float mu = s * (1.f / 2048.f);
    float ss = 0.f;
#pragma unroll
    for (int i = 0; i < 8; ++i) {
      float a = v[i].x - mu, b = v[i].y - mu, c = v[i].z - mu, d = v[i].w - mu;
      ss += a * a + b * b + c * c + d * d;
    }
#pragma unroll
    for (int o = 32; o >= 1; o >>= 1) ss += __shfl_xor(ss, o);
    const float rstd = rsqrtf(ss * (1.f / 2048.f) + LN_EPS);
    if (lane == 0) *reinterpret_cast<float2*>(p.ws + WS_STATS + (size_t)row * 8) = float2{mu, rstd};
    const int cond = row < TP ? 0 : 1 + ((row - TP) >> 12);
    const float* sh = mod + (size_t)((l + 1) * 5 + cond) * 6144;
#pragma unroll
    for (int i = 0; i < 8; ++i) {
      const int e = (i * 64 + lane) * 4;
      float4 gg = *reinterpret_cast<const float4*>(g + e), b4 = *reinterpret_cast<const float4*>(bb + e);
      float4 y;
      y.x = (v[i].x - mu) * rstd * gg.x + b4.x; y.y = (v[i].y - mu) * rstd * gg.y + b4.y;
      y.z = (v[i].z - mu) * rstd * gg.z + b4.z; y.w = (v[i].w - mu) * rstd * gg.w + b4.w;
      if (l == 3) *reinterpret_cast<float4*>(xr + e) = y;
      if (l < 3) {
        float4 s0 = *reinterpret_cast<const float4*>(sh + e), c0 = *reinterpret_cast<const float4*>(sh + 2048 + e);
        u32x2 o = {pk2(y.x * (1.f + c0.x) + s0.x, y.y * (1.f + c0.y) + s0.y), pk2(y.z * (1.f + c0.z) + s0.z, y.w * (1.f + c0.w) + s0.w)};
        *reinterpret_cast<u32x2*>(H + (size_t)row * 2048 + e) = o;
      }
    }
  }
}

struct AttnSrc {
  const u16* k0; const u16* vt0; int ks0, vs0, n0;
  const u16* k1; const u16* vt1; int ks1, vs1, n1;
};

template <int DQK>
DI void attn_ldg(const AttnSrc& s, int j, u32x4 (&rk)[DQK / 64], u32x4 (&rv)[2]) {
  const u16* kb; const u16* vb; int ks, vs;
  if (j < s.n0) { kb = s.k0 + (size_t)j * 64 * s.ks0; vb = s.vt0 + j * 64; ks = s.ks0; vs = s.vs0; }
  else { const int jj = j - s.n0; kb = s.k1 + (size_t)jj * 64 * s.ks1; vb = s.vt1 + jj * 64; ks = s.ks1; vs = s.vs1; }
  constexpr int CPR = DQK / 8;
  const int tid = TID8;
#pragma unroll
  for (int i = 0; i < DQK / 64; ++i) {
    const int c = tid + 512 * i, row = c / CPR, kc = c % CPR;
    rk[i] = *reinterpret_cast<const u32x4*>(kb + (size_t)row * ks + kc * 8);
  }
#pragma unroll
  for (int i = 0; i < 2; ++i) {
    const int c = tid + 512 * i, row = c >> 3, kc = c & 7;
    rv[i] = *reinterpret_cast<const u32x4*>(vb + (size_t)row * vs + kc * 8);
  }
}
template <int DQK>
DI void attn_sts(u16* sK, u16* sVT, const u32x4 (&rk)[DQK / 64], const u32x4 (&rv)[2]) {
  constexpr int CPR = DQK / 8;
  const int tid = TID8;
#pragma unroll
  for (int i = 0; i < DQK / 64; ++i) {
    const int c = tid + 512 * i, row = c / CPR, kc = c % CPR;
    *reinterpret_cast<u32x4*>(sK + row * (DQK + 8) + kc * 8) = rk[i];
  }
#pragma unroll
  for (int i = 0; i < 2; ++i) {
    const int c = tid + 512 * i, row = c >> 3, kc = c & 7;
    *reinterpret_cast<u32x4*>(sVT + row * 72 + kc * 8) = rv[i];
  }
}

DI void attn_pv(const f32x16 (&s)[2], const u16* vw, f32x16 (&O)[4]) {
  __builtin_amdgcn_s_setprio(1);
#pragma unroll
  for (int s4 = 0; s4 < 4; ++s4) {
    const int t = s4 >> 1, b0 = (s4 & 1) * 8;
    u32x4 w = {pk2(s[t][b0], s[t][b0 + 1]), pk2(s[t][b0 + 2], s[t][b0 + 3]), pk2(s[t][b0 + 4], s[t][b0 + 5]), pk2(s[t][b0 + 6], s[t][b0 + 7])};
    const bf16x8 pf = __builtin_bit_cast(bf16x8, w);
#pragma unroll
    for (int d = 0; d < 4; ++d) {
      bf16x8 a = ld8(vw + d * 32 * 72 + s4 * 16);
      O[d] = mfma32(a, pf, O[d]);
    }
  }
  __builtin_amdgcn_s_setprio(0);
}

template <int DQK, bool NA>
DI void attn_run(const AttnSrc& src, const u16* qblk, int qstride, u16* sQ, u16* sK, u16* sVT, f32x16 (&O)[4], float& l_out,
                 int qr, int qc, int rsmin, const float* sBias) {
  const int tid = TID8, lane = tid & 63, wid = tid >> 6;
  const int r = lane & 31, h = lane >> 5;
  const int pr = (r & 0x13) | ((r & 4) << 1) | ((r & 8) >> 1);
  constexpr int CPR = DQK / 8, QS = DQK + 8;
  __syncthreads();
  constexpr bool QREG = (DQK == 64);
  bf16x8 qf[QREG ? DQK / 16 : 1];
  if constexpr (QREG) {
#pragma unroll
    for (int ks = 0; ks < DQK / 16; ++ks) qf[ks] = ld8(qblk + (size_t)(wid * 32 + r) * qstride + ks * 16 + 8 * h);
  } else {
#pragma unroll
    for (int i = 0; i < DQK / 16; ++i) {
      const int c = tid + 512 * i, row = c / CPR, kc = c % CPR;
      *reinterpret_cast<u32x4*>(sQ + row * QS + kc * 8) = *reinterpret_cast<const u32x4*>(qblk + (size_t)row * qstride + kc * 8);
    }
  }
#pragma unroll
  for (int d = 0; d < 4; ++d)
#pragma unroll
    for (int i = 0; i < 16; ++i) O[d][i] = 0.f;
  float m = -1e30f, l = 0.f;
  const int nt = src.n0 + src.n1;
  const int rsq = min(max(qr - 4, 0), 56);
  const int cs = min(max(qc - 8, 0), 48);
  const u16* qw = sQ + (wid * 32 + r) * QS + 8 * h;
  u16* sVT1 = sVT + 128 * 72 + 2048;
  const bool grpB = wid >= 4;
  bool pend = false;
  f32x16 s[2];
  u32x4 rk[DQK / 64], rv[2];
  attn_ldg<DQK>(src, 0, rk, rv);
  constexpr bool SB = QREG;
  u16* sKb1 = sQ + 16384;
  int vi = 0;
  if constexpr (SB) {
    attn_sts<DQK>(sK, sVT, rk, rv);
    if (nt > 1) attn_ldg<DQK>(src, 1, rk, rv);
    __syncthreads();
  }
#pragma unroll 1
  for (int j = 0; j < nt; ++j) {
    const u16* kw;
    u16* vcur;
    const u16* vprev;
    if constexpr (SB) {
      u16* vnext = (vi == 0) ? sVT1 : ((vi == 1) ? sQ : sVT);
      vcur = (vi == 0) ? sVT : ((vi == 1) ? sVT1 : sQ);
      vprev = (vi == 0) ? sQ : ((vi == 1) ? sVT : sVT1);
      if (j + 1 < nt) attn_sts<DQK>((j & 1) ? sK : sKb1, vnext, rk, rv);
      if (j + 2 < nt) attn_ldg<DQK>(src, j + 2, rk, rv);
      kw = ((j & 1) ? sKb1 : sK) + pr * QS + 8 * h;
      vi = (vi == 2) ? 0 : vi + 1;
    } else {
      if (j > 0) __syncthreads();
      vcur = (j & 1) ? sVT1 : sVT;
      vprev = (j & 1) ? sVT : sVT1;
      attn_sts<DQK>(sK, vcur, rk, rv);
      __syncthreads();
      if (j + 1 < nt) attn_ldg<DQK>(src, j + 1, rk, rv);
      kw = sK + pr * QS + 8 * h;
    }
    __builtin_amdgcn_sched_barrier(0);
    if (grpB && pend) { attn_pv(s, vprev + r * 72 + 8 * h, O); pend = false; }
    bool active = true;
    int kr = 0;
    if (NA && j >= src.n0) { kr = rsmin + (j - src.n0); active = (kr >= rsq) && (kr < rsq + 8); }
    if (active) {
      __builtin_amdgcn_s_setprio(1);
#pragma unroll
      for (int t = 0; t < 2; ++t) {
#pragma unroll
        for (int i = 0; i < 16; ++i) s[t][i] = 0.f;
#pragma unroll
        for (int ks = 0; ks < DQK / 16; ++ks) {
          bf16x8 a = ld8(kw + t * 32 * QS + ks * 16);
          bf16x8 q;
          if constexpr (QREG) q = qf[ks]; else q = ld8(qw + ks * 16);
          s[t] = mfma32(a, q, s[t]);
        }
      }
      __builtin_amdgcn_s_setprio(0);
      if (NA && j >= src.n0) {
        const float* bp = sBias + (kr - qr + 7) * 31 + (8 * h - qc + 15);
        const int kb = 8 * h - cs;
#pragma unroll
        for (int t = 0; t < 2; ++t)
#pragma unroll
          for (int i = 0; i < 16; ++i) {
            const int ko = t * 32 + 16 * (i >> 3) + (i & 7);
            const bool ok = (unsigned)(ko + kb) < 16u;
            const float bv = bp[ko];
            s[t][i] = ok ? s[t][i] + bv : -1e30f;
          }
      }
      float mx = -1e30f;
#pragma unroll
      for (int t = 0; t < 2; ++t)
#pragma unroll
        for (int i = 0; i < 16; ++i) mx = fmaxf(mx, s[t][i]);
      if (__builtin_amdgcn_ballot_w64(mx > m + 8.0f) != 0ull) {
        mx = fmaxf(mx, __shfl_xor(mx, 32));
        const float mn = fmaxf(m, mx);
        const float alpha = ex2(m - mn);
        l *= alpha;
        m = mn;
#pragma unroll
        for (int d = 0; d < 4; ++d)
#pragma unroll
          for (int i = 0; i < 16; ++i) O[d][i] *= alpha;
      }
      float rsum = 0.f;
#pragma unroll
      for (int t = 0; t < 2; ++t)
#pragma unroll
        for (int i = 0; i < 16; ++i) { const float e = ex2(s[t][i] - m); s[t][i] = e; rsum += e; }
      l += rsum;
      if (!grpB) attn_pv(s, vcur + r * 72 + 8 * h, O);
      else pend = true;
    }
    if constexpr (SB) __syncthreads();
  }
  if (grpB && pend) {
    const u16* vlast;
    if constexpr (SB) vlast = (vi == 1) ? sVT : ((vi == 2) ? sVT1 : sQ);
    else vlast = ((nt - 1) & 1) ? sVT1 : sVT;
    attn_pv(s, vlast + r * 72 + 8 * h, O);
  }
  l_out = l + __shfl_xor(l, 32);
}

DI void heavy_map(int it, int& bh, int& qb) { const int x = it & 7, rest = it >> 3; qb = rest & 15; bh = x + 8 * (rest >> 4); }

DI void diff_item(const Params& p, int l, bool sample, int bh, int qb, unsigned char* lds) {
  constexpr int NC = 6144;
  const int tid_ = TID8, lane = tid_ & 63, wid = tid_ >> 6, r = lane & 31, h = lane >> 5;
  const int b = bh >> 3, hd = bh & 7;
  u16* sQ = reinterpret_cast<u16*>(lds);
  u16* sK = sQ + 256 * 136;
  u16* sVT = sK + 64 * 136;
  const u16* PROJ = reinterpret_cast<const u16*>(p.ws + WS_PROJ);
  const u16* VT = reinterpret_cast<const u16*>(p.ws + WS_VT);
  const int seq0 = sample ? TP + b * 4096 : b * 256;
  const int token = seq0 + qb * 256 + wid * 32 + r;
  const float* dl = p.in[20 + 10 * l];
  float pa = dl[lane] * dl[64 + lane], pb = dl[128 + lane] * dl[192 + lane];
#pragma unroll
  for (int o = 32; o >= 1; o >>= 1) { pa += __shfl_xor(pa, o); pb += __shfl_xor(pb, o); }
  const float lam_init = 0.8f - 0.6f * __expf(-0.3f * (float)l);
  const float lam = __expf(pa) - __expf(pb) + lam_init;

  u32 o1p[32];
  f32x16 O[4];
  float lsum;
#pragma unroll
  for (int comp = 0; comp < 2; ++comp) {
    AttnSrc s;
    if (sample) {
      s.k0 = reinterpret_cast<const u16*>(p.ws + WS_CK) + (size_t)l * 2097152 + (size_t)bh * 65536 + comp * 64; s.ks0 = 128;
      s.vt0 = reinterpret_cast<const u16*>(p.ws + WS_CVT) + (size_t)l * 2097152 + (size_t)bh * 65536; s.vs0 = 512; s.n0 = 8;
      s.k1 = PROJ + (size_t)seq0 * NC + 3072 + hd * 128 + comp * 64; s.ks1 = NC;
      s.vt1 = VT + 8388608 + (size_t)bh * 128 * 4096; s.vs1 = 4096; s.n1 = 64;
    } else {
      s.k0 = nullptr; s.vt0 = nullptr; s.ks0 = 0; s.vs0 = 0; s.n0 = 0;
      s.k1 = PROJ + (size_t)seq0 * NC + 3072 + hd * 128 + comp * 64; s.ks1 = NC;
      s.vt1 = VT + (size_t)bh * 128 * 256; s.vs1 = 256; s.n1 = 4;
    }
    const u16* qblk = PROJ + (size_t)(seq0 + qb * 256) * NC + 2048 + hd * 128 + comp * 64;
    attn_run<64, false>(s, qblk, NC, sQ, sK, sVT, O, lsum, 0, 0, 0, nullptr);
    const float inv = 1.f / lsum;
    if (comp == 0) {
#pragma unroll
      for (int d = 0; d < 4; ++d)
#pragma unroll
        for (int i = 0; i < 8; ++i) o1p[d * 8 + i] = pk2(O[d][2 * i] * inv, O[d][2 * i + 1] * inv);
    } else {
      float ssq = 0.f;
#pragma unroll
      for (int d = 0; d < 4; ++d)
#pragma unroll
        for (int i = 0; i < 8; ++i) {
          const u32 w = o1p[d * 8 + i];
          const float a = bflo(w) - lam * O[d][2 * i] * inv, c = bfhi(w) - lam * O[d][2 * i + 1] * inv;
          O[d][2 * i] = a; O[d][2 * i + 1] = c;
          ssq += a * a + c * c;
        }
      ssq += __shfl_xor(ssq, 32);
      const float rn = rsqrtf(ssq * (1.f / 128.f) + LN_EPS) * (1.f - lam_init);
      const float* subln = p.in[21 + 10 * l];
      const u16* gp = PROJ + (size_t)token * NC + 5120 + hd * 128;
      u16* yp = reinterpret_cast<u16*>(p.ws + WS_H) + (size_t)token * 2048 + 1024 + hd * 128;
#pragma unroll
      for (int d = 0; d < 4; ++d)
#pragma unroll
        for (int q = 0; q < 4; ++q) {
          const int dv = d * 32 + 8 * q + 4 * h;
          const u32x2 gw = *reinterpret_cast<const u32x2*>(gp + dv);
          const float4 sl = *reinterpret_cast<const float4*>(subln + dv);
          const float y0 = O[d][4 * q] * rn * sl.x * silu(bflo(gw[0]));
          const float y1 = O[d][4 * q + 1] * rn * sl.y * silu(bfhi(gw[0]));
          const float y2 = O[d][4 * q + 2] * rn * sl.z * silu(bflo(gw[1]));
          const float y3 = O[d][4 * q + 3] * rn * sl.w * silu(bfhi(gw[1]));
          *reinterpret_cast<u32x2*>(yp + dv) = (ZERO_MASK & 2) ? u32x2{0u, 0u} : u32x2{pk2(y0, y1), pk2(y2, y3)};
        }
    }
  }
}

template <int H>
DI void pool_window(const u16* sIn, u16* sP, int oc, int seg, int t0, int L) {
  const int tl0 = seg * 8;
  const u16* base = sIn + (tl0 + 8 - H) * 264 + oc * 8;
  float a[8];
#pragma unroll
  for (int k = 0; k < 8; ++k) a[k] = 0.f;
#pragma unroll
  for (int o = 0; o < 2 * H; ++o) {
    const u32x4 v = *reinterpret_cast<const u32x4*>(base + o * 264);
#pragma unroll
    for (int k = 0; k < 4; ++k) { a[2 * k] += bflo(v[k]); a[2 * k + 1] += bfhi(v[k]); }
  }
#pragma unroll
  for (int tt = 0; tt < 8; ++tt) {
    const int t = t0 + tl0 + tt;
    const int lo = max(t - H, 0), hi = min(t + H, L);
    const float ic = 1.f / (float)(hi - lo);
    const u32x4 x = *reinterpret_cast<const u32x4*>(sIn + (tl0 + tt + 8) * 264 + oc * 8);
    u32x4 o;
#pragma unroll
    for (int k = 0; k < 4; ++k) o[k] = pk2(a[2 * k] * ic - bflo(x[k]), a[2 * k + 1] * ic - bfhi(x[k]));
    *reinterpret_cast<u32x4*>(sP + (tl0 + tt) * 264 + oc * 8) = o;
    if (tt < 7) {
      const u32x4 vin = *reinterpret_cast<const u32x4*>(base + (2 * H + tt) * 264);
      const u32x4 vout = *reinterpret_cast<const u32x4*>(base + tt * 264);
#pragma unroll
      for (int k = 0; k < 4; ++k) { a[2 * k] += bflo(vin[k]) - bflo(vout[k]); a[2 * k + 1] += bfhi(vin[k]) - bfhi(vout[k]); }
    }
  }
}

DI void pool_item(const Params& p, int l, int pi, unsigned char* lds) {
  constexpr int NC = 6144;
  const int tid = TIDX, lane = tid & 63, wid = tid >> 6, fr = lane & 15, fq = lane >> 4;
  const int tb = pi >> 2, g = pi & 3, row0 = tb * 64;
  const int L = row0 < TP ? 256 : 4096;
  const int t0 = row0 < TP ? (row0 & 255) : ((row0 - TP) & 4095);
  u16* sIn = reinterpret_cast<u16*>(lds);
  u16* sP = sIn + 80 * 264;
  const u16* PROJ = reinterpret_cast<const u16*>(p.ws + WS_PROJ);
  __syncthreads();
#pragma unroll
  for (int i = 0; i < 10; ++i) {
    const int c = tid + 256 * i, rr = c >> 5, oc = c & 31;
    const int t = t0 - 8 + rr;
    u32x4 v = {0u, 0u, 0u, 0u};
    if (t >= 0 && t < L) v = *reinterpret_cast<const u32x4*>(PROJ + (size_t)(row0 - 8 + rr) * NC + g * 256 + oc * 8);
    *reinterpret_cast<u32x4*>(sIn + rr * 264 + oc * 8) = v;
  }
  __syncthreads();
  {
    const int oc = tid & 31, seg = tid >> 5;
    switch (g) {
      case 0: pool_window<1>(sIn, sP, oc, seg, t0, L); break;
      case 1: pool_window<2>(sIn, sP, oc, seg, t0, L); break;
      case 2: pool_window<4>(sIn, sP, oc, seg, t0, L); break;
      default: pool_window<8>(sIn, sP, oc, seg, t0, L); break;
    }
  }
  __syncthreads();
  const u16* W = reinterpret_cast<const u16*>(p.ws + WS_POOLWT) + (size_t)(l >> 1) * 262144 + (size_t)g * 65536;
  f32x4 acc[4][4];
#pragma unroll
  for (int a = 0; a < 4; ++a)
#pragma unroll
    for (int b = 0; b < 4; ++b) acc[a][b] = f32x4{0.f, 0.f, 0.f, 0.f};
#pragma unroll 4
  for (int ks = 0; ks < 8; ++ks) {
    bf16x8 af[4], bfr[4];
#pragma unroll
    for (int m = 0; m < 4; ++m) af[m] = ld8(sP + (m * 16 + fr) * 264 + ks * 32 + fq * 8);
#pragma unroll
    for (int n = 0; n < 4; ++n) bfr[n] = ld8(W + (size_t)(wid * 64 + n * 16 + fr) * 256 + ks * 32 + fq * 8);
#pragma unroll
    for (int m = 0; m < 4; ++m)
#pragma unroll
      for (int n = 0; n < 4; ++n) acc[m][n] = mfma16(bfr[n], af[m], acc[m][n]);
  }
  const float* pscale = p.in[19 + 10 * l];
  u16* Y = reinterpret_cast<u16*>(p.ws + WS_H);
#pragma unroll
  for (int n = 0; n < 4; ++n) {
    const int col = g * 256 + wid * 64 + n * 16 + 4 * fq;
    const float4 sc = *reinterpret_cast<const float4*>(pscale + col);
#pragma unroll
    for (int m = 0; m < 4; ++m) {
      const int row = row0 + m * 16 + fr;
      const u32x2 gw = *reinterpret_cast<const u32x2*>(PROJ + (size_t)row * NC + 1024 + col);
      float y0 = acc[m][n][0] * sc.x * silu(bflo(gw[0])), y1 = acc[m][n][1] * sc.y * silu(bfhi(gw[0]));
      float y2 = acc[m][n][2] * sc.z * silu(bflo(gw[1])), y3 = acc[m][n][3] * sc.w * silu(bfhi(gw[1]));
      if (ZERO_MASK & 1) { y0 = y1 = y2 = y3 = 0.f; }
      *reinterpret_cast<u32x2*>(Y + (size_t)row * 2048 + col) = u32x2{pk2(y0, y1), pk2(y2, y3)};
    }
  }
}

DI void phase_mix_even(const Params& p, int l, unsigned char* lds, unsigned char* lds_all) {
#pragma unroll 1
  for (int it = blockIdx.x; it < 512; it += gridDim.x) { int bh, qb; heavy_map(it, bh, qb); diff_item(p, l, true, bh, qb, lds_all); }
#pragma unroll 1
  for (int it = blockIdx.x; it < 256; it += gridDim.x) diff_item(p, l, false, it, 0, lds_all);
#pragma unroll 1
  for (int it = VBID; it < 1536; it += VGRID) pool_item(p, l, it, lds);
}

DI void na_item(const Params& p, int l, bool sample, int bh, int qb, unsigned char* lds) {
  constexpr int NC = 7168;
  const int tid = TID8, lane = tid & 63, wid = tid >> 6, r = lane & 31, h = lane >> 5;
  const int b = bh >> 3, hd = bh & 7;
  u16* sQ = reinterpret_cast<u16*>(lds);
  u16* sK = sQ + 256 * 136;
  u16* sVT = sK + 64 * 136;
  float* sBias = reinterpret_cast<float*>(sVT + 128 * 72) + 64;
  const u16* PROJ = reinterpret_cast<const u16*>(p.ws + WS_PROJ);
  const u16* VT = reinterpret_cast<const u16*>(p.ws + WS_VT);
  const int seq0 = sample ? TP + b * 4096 : b * 256;
  const int token = seq0 + qb * 256 + wid * 32 + r;
  AttnSrc s;
  int qr = 0, qc = 0, rsmin = 0;
  f32x16 O[4];
  float lsum;
  const u16* qblk = PROJ + (size_t)(seq0 + qb * 256) * NC + hd * 128;
  if (sample) {
    __syncthreads();
    const float* rpb = p.in[18 + 10 * l] + hd * 465;
    for (int e = tid; e < 465; e += 512) sBias[e] = rpb[e] * LOG2E;
    const int r0 = qb * 4;
    qr = r0 + (wid >> 1); qc = (wid & 1) * 32 + r;
    rsmin = min(max(r0 - 4, 0), 56);
    const int rs1 = min(max(r0 - 1, 0), 56);
    s.k0 = reinterpret_cast<const u16*>(p.ws + WS_CK) + (size_t)l * 2097152 + (size_t)bh * 65536; s.ks0 = 128;
    s.vt0 = reinterpret_cast<const u16*>(p.ws + WS_CVT) + (size_t)l * 2097152 + (size_t)bh * 65536; s.vs0 = 512; s.n0 = 8;
    s.k1 = PROJ + (size_t)(seq0 + rsmin * 64) * NC + 1024 + hd * 128; s.ks1 = NC;
    s.vt1 = VT + 8388608 + (size_t)bh * 128 * 4096 + rsmin * 64; s.vs1 = 4096; s.n1 = rs1 + 8 - rsmin;
    attn_run<128, true>(s, qblk, NC, sQ, sK, sVT, O, lsum, qr, qc, rsmin, sBias);
  } else {
    s.k0 = nullptr; s.vt0 = nullptr; s.ks0 = 0; s.vs0 = 0; s.n0 = 0;
    s.k1 = PROJ + (size_t)seq0 * NC + 1024 + hd * 128; s.ks1 = NC;
    s.vt1 = VT + (size_t)bh * 128 * 256; s.vs1 = 256; s.n1 = 4;
    attn_run<128, false>(s, qblk, NC, sQ, sK, sVT, O, lsum, 0, 0, 0, nullptr);
  }
  const float inv = 1.f / lsum;
  const u16* gp = PROJ + (size_t)token * NC + 3072 + hd * 128;
  u16* yp = reinterpret_cast<u16*>(p.ws + WS_H) + (size_t)token * 2048 + hd * 128;
#pragma unroll
  for (int d = 0; d < 4; ++d)
#pragma unroll
    for (int q = 0; q < 4; ++q) {
      const int dv = d * 32 + 8 * q + 4 * h;
      const u32x2 gw = *reinterpret_cast<const u32x2*>(gp + dv);
      const float y0 = O[d][4 * q] * inv * silu(bflo(gw[0]));
      const float y1 = O[d][4 * q + 1] * inv * silu(bfhi(gw[0]));
      const float y2 = O[d][4 * q + 2] * inv * silu(bflo(gw[1]));
      const float y3 = O[d][4 * q + 3] * inv * silu(bfhi(gw[1]));
      *reinterpret_cast<u32x2*>(yp + dv) = (ZERO_MASK & 4) ? u32x2{0u, 0u} : u32x2{pk2(y0, y1), pk2(y2, y3)};
    }
}

DI void sgu_item(const Params& p, int l, int si, unsigned char* lds) {
  constexpr int NC = 7168;
  const int tid = TIDX, lane = tid & 63, wid = tid >> 6, fr = lane & 15, fq = lane >> 4;
  const int ch = si >> 2, g = si & 3, row0 = ch * 128;
  u16* vnT = reinterpret_cast<u16*>(lds);
  float* sMu = reinterpret_cast<float*>(vnT + 256 * 136);
  float* sRs = sMu + 128;
  const u16* PROJ = reinterpret_cast<const u16*>(p.ws + WS_PROJ);
  __syncthreads();
  {
    const int grp = tid >> 4, ln = tid & 15;
#pragma unroll 2
    for (int rr = 0; rr < 8; ++rr) {
      const u16* src = PROJ + (size_t)(row0 + grp * 8 + rr) * NC + 5120;
      float s = 0.f, ss = 0.f;
#pragma unroll
      for (int c8 = 0; c8 < 8; ++c8) {
        const u32x4 v = *reinterpret_cast<const u32x4*>(src + (ln + 16 * c8) * 8);
#pragma unroll
        for (int k = 0; k < 4; ++k) { const float a = bflo(v[k]), b = bfhi(v[k]); s += a + b; ss += a * a + b * b; }
      }
#pragma unroll
      for (int o = 8; o >= 1; o >>= 1) { s += __shfl_xor(s, o); ss += __shfl_xor(ss, o); }
      const float mu = s * (1.f / 1024.f);
      const float var = fmaxf(ss * (1.f / 1024.f) - mu * mu, 0.f);
      if (ln == 0) { sMu[grp * 8 + rr] = mu; sRs[grp * 8 + rr] = rsqrtf(var + LN_EPS); }
    }
  }
  __syncthreads();
  {
    const int j = tid & 127, hf = tid >> 7;
    const float mu = sMu[j], rs = sRs[j];
    const float* lng = p.in[19 + 10 * l] + g * 256;
    const u16* src = PROJ + (size_t)(row0 + j) * NC + 5120 + g * 256;
#pragma unroll 8
    for (int oc = hf * 16; oc < hf * 16 + 16; ++oc) {
      const u32x4 v = *reinterpret_cast<const u32x4*>(src + oc * 8);
      const float4 g0 = *reinterpret_cast<const float4*>(lng + oc * 8), g1 = *reinterpret_cast<const float4*>(lng + oc * 8 + 4);
      const float gg[8] = {g0.x, g0.y, g0.z, g0.w, g1.x, g1.y, g1.z, g1.w};
#pragma unroll
      for (int k = 0; k < 4; ++k) {
        const float a = (bflo(v[k]) - mu) * rs * gg[2 * k], b = (bfhi(v[k]) - mu) * rs * gg[2 * k + 1];
        const u32 w = pk2(a, b);
        vnT[(oc * 8 + 2 * k) * 136 + j] = (u16)(w & 0xffffu);
        vnT[(oc * 8 + 2 * k + 1) * 136 + j] = (u16)(w >> 16);
      }
    }
  }
  __syncthreads();
  const u16* W = reinterpret_cast<const u16*>(p.ws + WS_SGUW) + (size_t)(l >> 1) * 65536 + (size_t)g * 16384;
  const float* bs = p.in[21 + 10 * l] + g * 128;
  u16* Y = reinterpret_cast<u16*>(p.ws + WS_H);
#pragma unroll 1
  for (int ih = 0; ih < 2; ++ih) {
    f32x4 acc[4][4];
#pragma unroll
    for (int a = 0; a < 4; ++a)
#pragma unroll
      for (int b = 0; b < 4; ++b) acc[a][b] = f32x4{0.f, 0.f, 0.f, 0.f};
#pragma unroll
    for (int ks = 0; ks < 4; ++ks) {
      bf16x8 af[4], bfr[4];
#pragma unroll
      for (int m = 0; m < 4; ++m) af[m] = ld8(W + (size_t)(ih * 64 + m * 16 + fr) * 128 + ks * 32 + fq * 8);
#pragma unroll
      for (int n = 0; n < 4; ++n) bfr[n] = ld8(vnT + (wid * 64 + n * 16 + fr) * 136 + ks * 32 + fq * 8);
#pragma unroll
      for (int m = 0; m < 4; ++m)
#pragma unroll
        for (int n = 0; n < 4; ++n) acc[m][n] = mfma16(bfr[n], af[m], acc[m][n]);
    }
#pragma unroll
    for (int m = 0; m < 4; ++m) {
      const int ii = ih * 64 + m * 16 + fr;
      const float bias = bs[ii];
      const size_t rb = (size_t)(row0 + ii) * NC;
#pragma unroll
      for (int n = 0; n < 4; ++n) {
        const int c = g * 256 + wid * 64 + n * 16 + 4 * fq;
        const u32x2 uw = *reinterpret_cast<const u32x2*>(PROJ + rb + 4096 + c);
        const u32x2 dw = *reinterpret_cast<const u32x2*>(PROJ + rb + 6144 + c);
        float y0 = bflo(uw[0]) * (acc[m][n][0] + bias) * silu(bflo(dw[0])), y1 = bfhi(uw[0]) * (acc[m][n][1] + bias) * silu(bfhi(dw[0]));
        float y2 = bflo(uw[1]) * (acc[m][n][2] + bias) * silu(bflo(dw[1])), y3 = bfhi(uw[1]) * (acc[m][n][3] + bias) * silu(bfhi(dw[1]));
        if (ZERO_MASK & 8) { y0 = y1 = y2 = y3 = 0.f; }
        *reinterpret_cast<u32x2*>(Y + (size_t)(row0 + ii) * 2048 + 1024 + c) = u32x2{pk2(y0, y1), pk2(y2, y3)};
      }
    }
  }
}

DI void phase_mix_odd(const Params& p, int l, unsigned char* lds, unsigned char* lds_all) {
#pragma unroll 1
  for (int it = blockIdx.x; it < 512; it += gridDim.x) { int bh, qb; heavy_map(it, bh, qb); na_item(p, l, true, bh, qb, lds_all); }
#pragma unroll 1
  for (int it = blockIdx.x; it < 256; it += gridDim.x) na_item(p, l, false, it, 0, lds_all);
#pragma unroll 1
  for (int it = VBID; it < 768; it += VGRID) sgu_item(p, l, it, lds);
}

#define XB_TMO      128
#define XB_XCNT(j)  (256  + 64 * (j))
#define XB_XSUB(j)  (1280 + 64 * (j))
#define XB_XGEN(j)  (2304 + 64 * (j))
#define XB_TOP      3328
#define XB_TOPGEN   3392
#define XCD_BAR_WORDS 3456
#define XB_SPIN_CAP (1u << 18)
#define LAS __attribute__((address_space(3)))
DI unsigned xb_ld(unsigned* p)              { return __hip_atomic_load(p, __ATOMIC_RELAXED, __HIP_MEMORY_SCOPE_AGENT); }
DI unsigned xb_add(unsigned* p, unsigned v) { return __hip_atomic_fetch_add(p, v, __ATOMIC_RELAXED, __HIP_MEMORY_SCOPE_AGENT); }
DI unsigned xb_xcc_id() { return (unsigned)__builtin_amdgcn_s_getreg((3 << 11) | 20) & 0xFu; }
#define XB_SPIN(cond, bar) do { unsigned _sp = 0; while (cond) { __builtin_amdgcn_s_sleep(1); \
    if ((++_sp & 255u) == 0u) { if (xb_ld(&(bar)[XB_TMO])) break; if (_sp > XB_SPIN_CAP) { atomicAdd(&(bar)[XB_TMO], 1u); break; } } } } while (0)
struct XcdBarrier { unsigned* bar; unsigned x; volatile LAS unsigned* st; };
DI XcdBarrier xcd_barrier_post(unsigned* bar, volatile LAS unsigned* st) {
  XcdBarrier b; b.bar = bar; b.x = xb_xcc_id(); b.st = st;
  if (threadIdx.x == 0) (void)xb_add(&bar[XB_XCNT(b.x)], 1u);
  return b;
}
DI void xcd_barrier_complete(unsigned* bar, unsigned x, unsigned& nloc, unsigned& nx) {
  const unsigned G = gridDim.x * gridDim.y * gridDim.z;
  unsigned sum, cnt, mine, sp = 0u;
  for (;;) {
    sum = 0u; cnt = 0u; mine = 0u;
#pragma unroll
    for (unsigned j = 0; j < 16; ++j) { const unsigned c = xb_ld(&bar[XB_XCNT(j)]); sum += c; cnt += (c > 0u) ? 1u : 0u; mine = (j == x) ? c : mine; }
    if (sum == G) break;
    __builtin_amdgcn_s_sleep(1);
    if ((++sp & 255u) == 0u) { if (xb_ld(&bar[XB_TMO])) break; if (sp > XB_SPIN_CAP) { atomicAdd(&bar[XB_TMO], 1u); break; } }
  }
  nloc = mine > 0u ? mine : 1u; nx = cnt > 0u ? cnt : 1u;
}
DI void xcd_barrier(const XcdBarrier& b) {
  asm volatile("s_waitcnt vmcnt(0)" ::: "memory");
  __syncthreads();
  if (threadIdx.x == 0) {
    unsigned* bar = b.bar;
    __builtin_amdgcn_s_waitcnt(0);
    unsigned nloc = b.st[0], nx = b.st[1];
    if (nloc == 0u) { xcd_barrier_complete(bar, b.x, nloc, nx); b.st[0] = nloc; b.st[1] = nx; }
    const unsigned old = xb_add(&bar[XB_XSUB(b.x)], 1u);
    const unsigned gen = old / nloc;
    if (old + 1u == (gen + 1u) * nloc) {
      __builtin_amdgcn_fence(__ATOMIC_RELEASE, "agent");
      asm volatile("s_waitcnt vmcnt(0)" ::: "memory");
      const unsigned og = xb_add(&bar[XB_TOP], 1u);
      const unsigned tg = og / nx;
      if (og + 1u == (tg + 1u) * nx) xb_add(&bar[XB_TOPGEN], 1u);
      else XB_SPIN(xb_ld(&bar[XB_TOPGEN]) == tg, bar);
      __builtin_amdgcn_fence(__ATOMIC_ACQUIRE, "agent");
      xb_add(&bar[XB_XGEN(b.x)], 1u);
      asm volatile("s_waitcnt vmcnt(0)" ::: "memory");
    } else {
      XB_SPIN(xb_ld(&bar[XB_XGEN(b.x)]) == gen, bar);
      __builtin_amdgcn_fence(__ATOMIC_ACQUIRE, "agent");
      asm volatile("s_waitcnt vmcnt(0)" ::: "memory");
    }
  }
  __syncthreads();
}

__global__ void __launch_bounds__(512, 2) fwd_megakernel(Params p) {
  extern __shared__ __attribute__((aligned(16))) unsigned char lds[];
  cg::grid_group grid = cg::this_grid();
  volatile LAS unsigned* xst = (volatile LAS unsigned*)(lds + LDS_BYTES - 16);
  if (threadIdx.x == 0) { xst[0] = 0u; xst[1] = 0u; }
  __syncthreads();
  const XcdBarrier xb = xcd_barrier_post(reinterpret_cast<unsigned*>(p.ws + WS_BAR), xst);
  for (int ph = p.ph_lo; ph < p.ph_hi; ++ph) {
    unsigned char* hl = lds + HALF_ID * HALF_LDS;
    if (ph == 0) phase_prep(p, hl);
    else if (ph == 1) phase_mod0(p);
    else {
      const int l = (ph - 2) >> 2, s = (ph - 2) & 3;
      if (s == 0) { if (l & 1) gemm_phase<G_IN_ODD>(p, l, lds); else gemm_phase<G_IN_EVEN>(p, l, lds); }
      else if (s == 1) { if (l & 1) phase_mix_odd(p, l, hl, lds); else phase_mix_even(p, l, hl, lds); }
      else if (s == 2) gemm_phase<G_OUT>(p, l, lds);
      else phase_ln(p, l);
    }
    if (ph + 1 < p.ph_hi) {
      if (p.ph_lo < 0) grid.sync();
      xcd_barrier(xb);
    }
  }
}

extern "C" void kernel_launch(void* const* d_in, const int* in_sizes, int n_in, void* d_out, int out_size, void* d_ws, size_t ws_size,
                              hipStream_t stream) {
  static int grid_blocks = 0;
  if (grid_blocks == 0) {
    if (n_in != 52 || ws_size < WS_END) {
      fprintf(stderr, "kernel_launch: expected 52 inputs and >= %zu bytes of workspace; got %d, %zu\n", (size_t)WS_END, n_in, ws_size);
      grid_blocks = -1;
      return;
    }
    int dev = 0, cus = 0, per_cu = 0;
    hipGetDevice(&dev);
    hipDeviceGetAttribute(&cus, hipDeviceAttributeMultiprocessorCount, dev);
    hipFuncSetAttribute((const void*)fwd_megakernel, hipFuncAttributeMaxDynamicSharedMemorySize, LDS_BYTES);
    hipOccupancyMaxActiveBlocksPerMultiprocessor(&per_cu, (const void*)fwd_megakernel, 512, LDS_BYTES);
    (void)hipGetLastError();
    grid_blocks = cus;
  }
  if (grid_blocks < 0) return;
  Params p{};
  for (int i = 0; i < 52; ++i) p.in[i] = (const float*)d_in[i];
  p.out = (float*)d_out;
  p.ws = (unsigned char*)d_ws;
#if MULTI
  for (int ph = 0; ph < NPHASE; ++ph) {
    p.ph_lo = ph; p.ph_hi = ph + 1;
    hipLaunchKernelGGL(fwd_megakernel, dim3(grid_blocks), dim3(512), LDS_BYTES, stream, p);
  }
#else
  p.ph_lo = 0; p.ph_hi = NPHASE;
  if (hipMemsetAsync((char*)d_ws + WS_BAR, 0, XCD_BAR_WORDS * 4, stream) != hipSuccess) { fprintf(stderr, "kernel_launch: memset of barrier words failed\n"); return; }
  void* args[] = {&p};
  hipError_t e = hipLaunchCooperativeKernel((const void*)fwd_megakernel, dim3(grid_blocks), dim3(512), args, LDS_BYTES, stream);
  if (e != hipSuccess) fprintf(stderr, "cooperative launch failed: %s (grid %d)\n", hipGetErrorString(e), grid_blocks);
#endif
}
```

```cpp
#include <hip/hip_runtime.h>
#include <hip/hip_cooperative_groups.h>
#include <cstdio>
namespace cg = cooperative_groups;

#define DI __device__ __forceinline__
typedef unsigned short u16;
typedef unsigned int u32;
using bf16x8 = __attribute__((ext_vector_type(8))) short;
using f32x4 = __attribute__((ext_vector_type(4))) float;
using f32x16 = __attribute__((ext_vector_type(16))) float;
using u32x4 = __attribute__((ext_vector_type(4))) unsigned;
using u32x2 = __attribute__((ext_vector_type(2))) unsigned;
typedef __bf16 bf2_t __attribute__((ext_vector_type(2)));
typedef float f2_t __attribute__((ext_vector_type(2)));

#ifndef MULTI
#define MULTI 0
#endif
#ifndef REP0
#define REP0 1
#endif
#ifndef REP1
#define REP1 1
#endif
#ifndef ZERO_MASK
#define ZERO_MASK 0
#endif

constexpr int T_ALL = 24576, TP = 8192, DM = 2048;
constexpr float LOG2E = 1.4426950408889634f;
constexpr float ALPHA = 1.6817928305074290f;
constexpr float LN_EPS = 1e-5f;
constexpr int HALF_LDS = 76288;
constexpr int LDS_BYTES = 2 * HALF_LDS + 16;
constexpr int NPHASE = 18;

constexpr size_t SZ_WIN_E = (size_t)6144 * 2048 * 2, SZ_WIN_O = (size_t)7168 * 2048 * 2;
constexpr size_t WS_WINT = 0;
constexpr size_t WS_WOUTT = WS_WINT + 2 * SZ_WIN_E + 2 * SZ_WIN_O;
constexpr size_t WS_POOLWT = WS_WOUTT + (size_t)4 * 2048 * 2048 * 2;
constexpr size_t WS_SGUW = WS_POOLWT + (size_t)2 * 4 * 256 * 256 * 2;
constexpr size_t WS_CK = WS_SGUW + (size_t)2 * 4 * 128 * 128 * 2;
constexpr size_t WS_CVT = WS_CK + (size_t)4 * 4194304;
constexpr size_t WS_MOD = WS_CVT + (size_t)4 * 4194304;
constexpr size_t WS_ROPE = WS_MOD + (size_t)4 * 5 * 6144 * 4;
constexpr size_t WS_H = WS_ROPE + 8192;
constexpr size_t WS_PROJ = WS_H + (size_t)T_ALL * 2048 * 2;
constexpr size_t WS_VT = WS_PROJ + (size_t)T_ALL * 7168 * 2;
constexpr size_t WS_BAR = WS_VT + (size_t)T_ALL * 1024 * 2;
constexpr size_t WS_STATS = WS_BAR + 16384;
constexpr size_t WS_END = WS_STATS + (size_t)T_ALL * 8;

struct Params {
  const float* in[52];
  float* out;
  unsigned char* ws;
  int ph_lo, ph_hi;
};

DI size_t ws_wint(int l) { return WS_WINT + (size_t)(l >> 1) * (SZ_WIN_E + SZ_WIN_O) + ((l & 1) ? SZ_WIN_E : 0); }

DI u32 pk2(float a, float b) { f2_t v = {a, b}; bf2_t r = __builtin_convertvector(v, bf2_t); return __builtin_bit_cast(u32, r); }
DI float bflo(u32 w) { return __uint_as_float(w << 16); }
DI float bfhi(u32 w) { return __uint_as_float(w & 0xffff0000u); }
DI float bf1(u16 w) { return __uint_as_float(((u32)w) << 16); }
DI float ex2(float x) { return __builtin_amdgcn_exp2f(x); }
DI float silu(float x) { return x / (1.f + __expf(-x)); }
DI f32x4 mfma16(bf16x8 a, bf16x8 b, f32x4 c) { return __builtin_amdgcn_mfma_f32_16x16x32_bf16(a, b, c, 0, 0, 0); }
DI f32x16 mfma32(bf16x8 a, bf16x8 b, f32x16 c) { return __builtin_amdgcn_mfma_f32_32x32x16_bf16(a, b, c, 0, 0, 0); }
DI bf16x8 ld8(const u16* p) { return *reinterpret_cast<const bf16x8*>(p); }
DI int opq(int x) { asm volatile("" : "+v"(x)); return x; }
#define TIDX (opq((int)threadIdx.x) & 255)
#define TID8 (opq((int)threadIdx.x))
#define HALF_ID (opq((int)threadIdx.x) >> 8)
#define VBID ((int)((blockIdx.x & 7u) | ((unsigned)HALF_ID << 3) | ((blockIdx.x >> 3) << 4)))
#define VGRID ((int)gridDim.x * 2)

enum { G_IN_EVEN = 0, G_IN_ODD = 1, G_OUT = 2 };

namespace pg8 {
#define PG8_LAS __attribute__((address_space(3)))
typedef unsigned short bf16_t;
typedef short bf16x8 __attribute__((ext_vector_type(8)));
typedef float f32x4 __attribute__((ext_vector_type(4)));
typedef unsigned u32x4 __attribute__((ext_vector_type(4)));
constexpr int BM = 256, BK = 64, HALF = 128, HTB = HALF * BK * 2  , STAGE_BYTES = 8 * HTB, NXCD = 8, WGM = 8;

__host__ __device__ __forceinline__ int lds_byte(int r, int c) { const int st = (r >> 4) * 2 + (c >> 5), rr = r & 15, cc = c & 31, ob = rr * 64 + cc * 2; return st * 1024 + (ob ^ (((ob >> 9) & 1) << 5)); }
__host__ __device__ __forceinline__ void stage_rc(int b, int& R, int& C) { const int st = b / 1024, sb = b % 1024, swz = sb ^ (((sb >> 9) & 1) << 5); R = (st >> 1) * 16 + swz / 64; C = (st & 1) * 32 + (swz % 64) / 2; }
__host__ __device__ __forceinline__ int perm32(int rho) { const int n = rho >> 4, i = rho & 15; return 8 * (i >> 2) + 4 * n + (i & 3); }

struct Unit { int pm, pn; };
struct Gemm { const bf16_t* A; const bf16_t* Bt; int M, N, K; };

struct StaticOrder {
    int nM, nN, nwg, G, c;
    __host__ __device__ void init(int M, int N, int G_, int c_) { nM = M / BM; nN = N / BM; nwg = nM * nN; G = G_; c = c_; }
    __host__ __device__ bool next(int i, Unit& u) const {
        const long L = (long)i * G + c; if (L >= nwg) return false;
        int wgid = (int)L; { const int q = nwg / NXCD, r = nwg % NXCD, xcd = wgid % NXCD, off = wgid / NXCD; wgid = (xcd < r ? xcd * (q + 1) : r * (q + 1) + (xcd - r) * q) + off; }
        const int nig = WGM * nN, gid = wgid / nig, fm = gid * WGM, gsz = (nM - fm) < WGM ? (nM - fm) : WGM;
        u.pm = fm + ((wgid % nig) % gsz); u.pn = (wgid % nig) / gsz; return true;
    }
    __device__ __forceinline__ void a_ready(const Unit&) const {}
    __device__ __forceinline__ void done(const Unit&) const {}
};

template <class Epi, class Sched, bool STAMP = false>
__device__ __forceinline__ void gemm_phase(PG8_LAS unsigned char* lds, const Gemm g, const Sched& S, const Epi& E, unsigned long long* stamps) {
    const int tid = opq((int)threadIdx.x), wid = __builtin_amdgcn_readfirstlane(tid >> 6), lane = tid & 63, wr = wid >> 2, wc = wid & 3, fr = lane & 15, fq = lane >> 4;
    const int K = g.K, nt = K / BK;
    int ts_lo = 0, ts_hi = 0, nts = 0; const unsigned long long rt_entry = STAMP ? (unsigned long long)wall_clock64() : 0ull;
#define PG8_STAMP() do { if (STAMP && wid == 0 && nts < 64) { const unsigned long long _c = (unsigned long long)clock64(); \
        ts_lo = (lane == nts) ? (int)(unsigned)_c : ts_lo; ts_hi = (lane == nts) ? (int)(unsigned)(_c >> 32) : ts_hi; ++nts; } } while (0)
    PG8_STAMP();
    unsigned voffA[2], voffB[2];
#pragma unroll
    for (int i = 0; i < 2; ++i) { int R, C; stage_rc(tid * 16 + i * 8192, R, C); const int Rb = Epi::PERM ? ((R & ~31) + perm32(R & 31)) : R;
        voffA[i] = (unsigned)(R * K + C) * 2u; voffB[i] = (unsigned)(Rb * K + C) * 2u; }
    const size_t kstep = (size_t)(BK * 2);
    const size_t hstep = (size_t)HALF * K * 2;
    const size_t tstep = 2 * hstep;
    const unsigned ldsw = (unsigned)wid * 1024u;
    const int aoff = lds_byte(wr * 64 + fr, fq * 8), boff = lds_byte(wc * 32 + fr, fq * 8);
#define PG8_SA(b, h) (((b) * 2 + (h)) * HTB)
#define PG8_SB(b, h) ((4 + (b) * 2 + (h)) * HTB)
#define PG8_STAGE(bufoff, gbase, voff) do { _Pragma("unroll") for (int _i = 0; _i < 2; ++_i) \
        __builtin_amdgcn_global_load_lds((const unsigned*)((const char*)(gbase) + (voff)[_i]), (PG8_LAS unsigned*)(lds + (bufoff) + ldsw + _i * 8192), 16, 0, 0); } while (0)
#define PG8_LDA(dst, b, h) do { _Pragma("unroll") for (int m = 0; m < 4; ++m) _Pragma("unroll") for (int k = 0; k < 2; ++k) dst[m][k] = *(const PG8_LAS bf16x8*)(lds + PG8_SA(b, h) + aoff + m * 2048 + k * 1024); } while (0)
#define PG8_LDB(dst, b, h) do { _Pragma("unroll") for (int n = 0; n < 2; ++n) _Pragma("unroll") for (int k = 0; k < 2; ++k) dst[n][k] = *(const PG8_LAS bf16x8*)(lds + PG8_SB(b, h) + boff + n * 2048 + k * 1024); } while (0)
#define PG8_MMA(ai, bj, At, Bt) do { __builtin_amdgcn_s_setprio(1); _Pragma("unroll") for (int m = 0; m < 4; ++m) _Pragma("unroll") for (int n = 0; n < 2; ++n) _Pragma("unroll") for (int k = 0; k < 2; ++k) \
        acc[ai][bj][m][n] = __builtin_amdgcn_mfma_f32_16x16x32_bf16(Bt[n][k], At[m][k], acc[ai][bj][m][n], 0, 0, 0); __builtin_amdgcn_s_setprio(0); } while (0)
#define PG8_WAIT_V(n) asm volatile("s_waitcnt vmcnt(" #n ")" ::: "memory")
#define PG8_WAIT_L(n) asm volatile("s_waitcnt lgkmcnt(" #n ")" ::: "memory")
#define PG8_BAR __builtin_amdgcn_s_barrier()
#define PG8_SCHED __builtin_amdgcn_sched_barrier(0)
    Unit cur, nxt; int ui = 0;
    if (!S.next(0, cur)) return;
    f32x4 acc[2][2][4][2];
#pragma unroll
    for (int a = 0; a < 2; ++a)
#pragma unroll
        for (int b = 0; b < 2; ++b)
#pragma unroll
            for (int m = 0; m < 4; ++m)
#pragma unroll
                for (int n = 0; n < 2; ++n) acc[a][b][m][n] = (f32x4){0.f, 0.f, 0.f, 0.f};
    bf16x8 At[4][2], B0[2][2], B1[2][2];
    const char* cA = (const char*)g.A + (size_t)cur.pm * tstep; const char* cB = (const char*)g.Bt + (size_t)cur.pn * tstep;
    S.a_ready(cur);
    PG8_STAGE(PG8_SB(0, 0), cB, voffB); PG8_STAGE(PG8_SA(0, 0), cA, voffA); PG8_STAGE(PG8_SB(0, 1), cB + hstep, voffB); PG8_STAGE(PG8_SA(0, 1), cA + hstep, voffA);
    if (wr == 1) PG8_BAR;
    PG8_WAIT_V(4); PG8_BAR;
    PG8_STAGE(PG8_SB(1, 0), cB + kstep, voffB); PG8_STAGE(PG8_SA(1, 0), cA + kstep, voffA); PG8_STAGE(PG8_SB(1, 1), cB + hstep + kstep, voffB);
    PG8_WAIT_V(6); PG8_BAR;
    PG8_STAMP();
    for (;;) {
        const bool has_next = S.next(ui + 1, nxt);
        const char* nA = has_next ? (const char*)g.A + (size_t)nxt.pm * tstep : cA; const char* nB = has_next ? (const char*)g.Bt + (size_t)nxt.pn * tstep : cB;
        for (int t = 0; t < nt; t += 2) {
            const bool last = (t == nt - 2);
            const char* a1 = cA + (size_t)(t + 1) * kstep;
            const char* a2 = last ? nA : cA + (size_t)(t + 2) * kstep; const char* b2 = last ? nB : cB + (size_t)(t + 2) * kstep;
            const char* a3 = a2 + kstep; const char* b3 = b2 + kstep;
            if (last && has_next) S.a_ready(nxt);
            PG8_LDB(B0, 0, 0); PG8_SCHED; PG8_LDA(At, 0, 0); PG8_STAGE(PG8_SA(1, 1), a1 + hstep, voffA);
            PG8_WAIT_L(8); PG8_BAR; PG8_WAIT_L(0); PG8_MMA(0, 0, At, B0); PG8_BAR; PG8_SCHED;
            PG8_LDB(B1, 0, 1); PG8_STAGE(PG8_SB(0, 0), b2, voffB);
            PG8_BAR; PG8_WAIT_L(0); PG8_MMA(0, 1, At, B1); PG8_BAR;
            PG8_LDA(At, 0, 1); PG8_STAGE(PG8_SA(0, 0), a2, voffA);
            PG8_BAR; PG8_WAIT_L(0); PG8_MMA(1, 0, At, B0); PG8_BAR; PG8_SCHED;
            PG8_STAGE(PG8_SB(0, 1), b2 + hstep, voffB);
            PG8_WAIT_V(6); PG8_BAR; PG8_MMA(1, 1, At, B1); PG8_BAR;
            PG8_LDB(B0, 1, 0); PG8_SCHED; PG8_LDA(At, 1, 0); PG8_STAGE(PG8_SA(0, 1), a2 + hstep, voffA);
            PG8_WAIT_L(8); PG8_BAR; PG8_WAIT_L(0); PG8_MMA(0, 0, At, B0); PG8_BAR; PG8_SCHED;
            PG8_LDB(B1, 1, 1); PG8_STAGE(PG8_SB(1, 0), b3, voffB);
            PG8_BAR; PG8_WAIT_L(0); PG8_MMA(0, 1, At, B1); PG8_BAR;
            PG8_LDA(At, 1, 1); PG8_STAGE(PG8_SA(1, 0), a3, voffA);
            PG8_BAR; PG8_WAIT_L(0); PG8_MMA(1, 0, At, B0); PG8_BAR; PG8_SCHED;
            PG8_STAGE(PG8_SB(1, 1), b3 + hstep, voffB);
            PG8_WAIT_V(6); PG8_BAR; PG8_MMA(1, 1, At, B1); PG8_BAR;
        }
        PG8_STAMP();
        if constexpr (!Epi::AFTER_DRAIN) { E(acc, cur, wr, wc, fr, fq); S.done(cur); }
        PG8_STAMP();
        if (!has_next) break;
#pragma unroll
        for (int a = 0; a < 2; ++a)
#pragma unroll
            for (int b = 0; b < 2; ++b)
#pragma unroll
                for (int m = 0; m < 4; ++m)
#pragma unroll
                    for (int n = 0; n < 2; ++n) acc[a][b][m][n] = (f32x4){0.f, 0.f, 0.f, 0.f};
        cur = nxt; cA = nA; cB = nB; ++ui;
    }
    PG8_WAIT_V(0);
    if (wr == 0) PG8_BAR;
    PG8_BAR;
    if constexpr (Epi::AFTER_DRAIN) { E.fused(acc, cur, wr, wc, fr, fq, lds, wid, lane); S.done(cur); }
    PG8_STAMP();
    if (STAMP && wid == 0) { stamps[lane] = lane < nts ? (((unsigned long long)(unsigned)ts_hi << 32) | (unsigned)ts_lo) : 0ull;
        if (lane == 62) stamps[62] = rt_entry; if (lane == 63) stamps[63] = (unsigned long long)wall_clock64(); }
#undef PG8_STAMP
#undef PG8_SA
#undef PG8_SB
#undef PG8_STAGE
#undef PG8_LDA
#undef PG8_LDB
#undef PG8_MMA
#undef PG8_WAIT_V
#undef PG8_WAIT_L
#undef PG8_BAR
#undef PG8_SCHED
}
}

DI void tr_tile(const float* __restrict__ src, size_t ld_src, u16* __restrict__ dst, size_t ld_dst, float* sT) {
  const int tid = TIDX;
  const int r = tid >> 4, c4 = (tid & 15) * 4;
#pragma unroll
  for (int i = 0; i < 4; ++i) {
    float4 v = *reinterpret_cast<const float4*>(src + (size_t)(r + 16 * i) * ld_src + c4);
    float* d = sT + (r + 16 * i) * 65 + c4;
    d[0] = v.x; d[1] = v.y; d[2] = v.z; d[3] = v.w;
  }
  __syncthreads();
  const int n = tid >> 2, ks = (tid & 3) * 16;
  u32 w[8];
#pragma unroll
  for (int j = 0; j < 8; ++j) w[j] = pk2(sT[(ks + 2 * j) * 65 + n], sT[(ks + 2 * j + 1) * 65 + n]);
  u32x4* o = reinterpret_cast<u32x4*>(dst + (size_t)n * ld_dst + ks);
  o[0] = u32x4{w[0], w[1], w[2], w[3]};
  o[1] = u32x4{w[4], w[5], w[6], w[7]};
  __syncthreads();
}

DI void cvt8(const float* __restrict__ src, u16* __restrict__ dst) {
  float4 a = *reinterpret_cast<const float4*>(src);
  float4 b = *reinterpret_cast<const float4*>(src + 4);
  *reinterpret_cast<u32x4*>(dst) = u32x4{pk2(a.x, a.y), pk2(a.z, a.w), pk2(b.x, b.y), pk2(b.z, b.w)};
}

DI void mod_item(const Params& p, int i, unsigned char* lds) {
  const int tid = TIDX;
  const int l = i / 96, n0 = (i % 96) * 64;
  float* sS = reinterpret_cast<float*>(lds);
  float* red = sS + 5 * 2048;
  const float* c = p.in[10];
  const float* cctx = p.in[11];
  for (int e = tid; e < 5 * 2048; e += 256) {
    int v = e >> 11, k = e & 2047;
    float x = (v == 0) ? cctx[k] : c[(v - 1) * 2048 + k];
    sS[e] = silu(x);
  }
  __syncthreads();
  const int kk = tid >> 4, c4 = (tid & 15) * 4;
  const float* W = p.in[12 + 10 * l] + n0 + c4;
  f32x4 acc[5];
#pragma unroll
  for (int v = 0; v < 5; ++v) acc[v] = f32x4{0.f, 0.f, 0.f, 0.f};
#pragma unroll 8
  for (int k = kk; k < 2048; k += 16) {
    float4 w = *reinterpret_cast<const float4*>(W + (size_t)k * 6144);
#pragma unroll
    for (int v = 0; v < 5; ++v) {
      float s = sS[v * 2048 + k];
      acc[v][0] += s * w.x; acc[v][1] += s * w.y; acc[v][2] += s * w.z; acc[v][3] += s * w.w;
    }
  }
#pragma unroll
  for (int v = 0; v < 5; ++v)
#pragma unroll
    for (int q = 0; q < 4; ++q) red[(kk * 5 + v) * 64 + c4 + q] = acc[v][q];
  __syncthreads();
  for (int t2 = tid; t2 < 320; t2 += 256) {
    int v = t2 >> 6, n = t2 & 63;
    float s = 0.f;
#pragma unroll
    for (int k2 = 0; k2 < 16; ++k2) s += red[(k2 * 5 + v) * 64 + n];
    float* mod = reinterpret_cast<float*>(p.ws + WS_MOD);
    mod[(size_t)(l * 5 + v) * 6144 + n0 + n] = s + p.in[13 + 10 * l][n0 + n];
  }
  __syncthreads();
}

DI void phase_prep(const Params& p, unsigned char* lds) {
  constexpr int N_MOD = 384, N_TRWIN = 13312, N_TRWOUT = 4096, N_TRPOOL = 128, N_SGU = 64, N_CK = 4096, N_CV = 2048;
  constexpr int TOTAL = N_MOD + N_TRWIN + N_TRWOUT + N_TRPOOL + N_SGU + N_CK + N_CV + 1;
  const int tid = TIDX;
  float* sT = reinterpret_cast<float*>(lds);
  for (int it = VBID; it < TOTAL; it += VGRID) {
    int i = it;
    if (i < N_MOD) { mod_item(p, i, lds); continue; }
    i -= N_MOD;
    if (i < N_TRWIN) {
      int l, base;
      if (i < 3072) { l = 0; base = 0; } else if (i < 6656) { l = 1; base = 3072; } else if (i < 9728) { l = 2; base = 6656; } else { l = 3; base = 9728; }
      i -= base;
      const int N = (l & 1) ? 7168 : 6144, nN = N / 64;
      const int kt = i / nN, nt = i % nN;
      tr_tile(p.in[14 + 10 * l] + (size_t)kt * 64 * N + nt * 64, N,
              reinterpret_cast<u16*>(p.ws + ws_wint(l)) + (size_t)nt * 64 * 2048 + kt * 64, 2048, sT);
      continue;
    }
    i -= N_TRWIN;
    if (i < N_TRWOUT) {
      const int l = i >> 10, r = i & 1023, kt = r >> 5, nt = r & 31;
      tr_tile(p.in[15 + 10 * l] + (size_t)kt * 64 * 2048 + nt * 64, 2048,
              reinterpret_cast<u16*>(p.ws + WS_WOUTT) + (size_t)l * 2048 * 2048 + (size_t)nt * 64 * 2048 + kt * 64, 2048, sT);
      continue;
    }
    i -= N_TRWOUT;
    if (i < N_TRPOOL) {
      const int e = i >> 6, r = i & 63, g = r >> 4, t = r & 15, kt = t >> 2, nt = t & 3;
      tr_tile(p.in[18 + 20 * e] + (size_t)g * 65536 + kt * 64 * 256 + nt * 64, 256,
              reinterpret_cast<u16*>(p.ws + WS_POOLWT) + (size_t)e * 262144 + g * 65536 + nt * 64 * 256 + kt * 64, 256, sT);
      continue;
    }
    i -= N_TRPOOL;
    if (i < N_SGU) {
      const int e = i >> 5, ch = i & 31;
      const size_t off = (size_t)ch * 2048 + tid * 8;
      cvt8(p.in[30 + 20 * e] + off, reinterpret_cast<u16*>(p.ws + WS_SGUW) + (size_t)e * 65536 + off);
      continue;
    }
    i -= N_SGU;
    if (i < N_CK) {
      const int l = i >> 10, ch = i & 1023;
      const size_t off = (size_t)ch * 2048 + tid * 8;
      cvt8(p.in[2 + 2 * l] + off, reinterpret_cast<u16*>(p.ws + WS_CK) + (size_t)l * 2097152 + off);
      continue;
    }
    i -= N_CK;
    if (i < N_CV) {
      const int l = i >> 9, r = i & 511, bh = r >> 4, t = r & 15, kt = t >> 1, nt = t & 1;
      tr_tile(p.in[3 + 2 * l] + (size_t)bh * 65536 + kt * 64 * 128 + nt * 64, 128,
              reinterpret_cast<u16*>(p.ws + WS_CVT) + (size_t)l * 2097152 + (size_t)bh * 65536 + nt * 64 * 512 + kt * 64, 512, sT);
      continue;
    }
    {
      float* rc = reinterpret_cast<float*>(p.ws + WS_ROPE);
      for (int e = tid; e < 1024; e += 256) {
        int pos = e >> 4, fi = e & 15;
        float inv = 1.0f / powf(10000.0f, (float)(2 * fi) / 32.0f);
        float ang = (float)pos * inv;
        rc[e] = cosf(ang);
        rc[1024 + e] = sinf(ang);
      }
    }
  }
}

DI void phase_mod0(const Params& p) {
  const int tid = TIDX;
  const float* mod = reinterpret_cast<const float*>(p.ws + WS_MOD);
  u16* H = reinterpret_cast<u16*>(p.ws + WS_H);
  for (int it = VBID; it < T_ALL / 4; it += VGRID) {
#pragma unroll
    for (int rr = 0; rr < 4; ++rr) {
      const int row = it * 4 + rr;
      const int cond = row < TP ? 0 : 1 + ((row - TP) >> 12);
      const float* src = row < TP ? p.in[0] + (size_t)row * 2048 : p.in[1] + (size_t)(row - TP) * 2048;
      const int e = tid * 8;
      const float* sh = mod + (size_t)cond * 6144 + e;
      float4 a = *reinterpret_cast<const float4*>(src + e), b = *reinterpret_cast<const float4*>(src + e + 4);
      float4 s0 = *reinterpret_cast<const float4*>(sh), s1 = *reinterpret_cast<const float4*>(sh + 4);
      float4 c0 = *reinterpret_cast<const float4*>(sh + 2048), c1 = *reinterpret_cast<const float4*>(sh + 2052);
      u32x4 o = {pk2(a.x * (1.f + c0.x) + s0.x, a.y * (1.f + c0.y) + s0.y), pk2(a.z * (1.f + c0.z) + s0.z, a.w * (1.f + c0.w) + s0.w),
                 pk2(b.x * (1.f + c1.x) + s1.x, b.y * (1.f + c1.y) + s1.y), pk2(b.z * (1.f + c1.z) + s1.z, b.w * (1.f + c1.w) + s1.w)};
      *reinterpret_cast<u32x4*>(H + (size_t)row * 2048 + e) = o;
    }
  }
}


template <int MODE>
struct EpiIn {
  static constexpr bool PERM = false, AFTER_DRAIN = false;
  u16* PROJ; u16* VT; float* kout; float* vout; const float* ropeC; const float* ropeS;
  DI void operator()(const f32x4 (&acc)[2][2][4][2], const pg8::Unit& u, int wr, int wc, int fr, int fq) const {
    constexpr int NC = (MODE == G_IN_EVEN) ? 6144 : 7168;
    constexpr int SEC_Q = (MODE == G_IN_EVEN) ? 2 : 0, SEC_K = (MODE == G_IN_EVEN) ? 3 : 1, SEC_V = (MODE == G_IN_EVEN) ? 4 : 2;
    const int sec = u.pn >> 2;
    const bool prompt = u.pm < 32;
    const bool isq = sec == SEC_Q, isk = sec == SEC_K;
    const bool rope = (MODE == G_IN_EVEN) && (isq || isk) && !prompt;
    const float sc = isq ? ((MODE == G_IN_EVEN) ? 0.125f * LOG2E : 0.08838834764831845f * LOG2E) : 1.0f;
#pragma unroll
    for (int ai = 0; ai < 2; ++ai)
#pragma unroll
      for (int m = 0; m < 4; ++m) {
        const int row = u.pm * 256 + ai * 128 + wr * 64 + m * 16 + fr;
        int b, t;
        if (prompt) { b = row >> 8; t = row & 255; } else { const int rs = row - TP; b = rs >> 12; t = rs & 4095; }
#pragma unroll
        for (int bj = 0; bj < 2; ++bj) {
          const int hh = (u.pn & 3) * 2 + bj;
          const int d0 = wc * 32 + 4 * fq;
          if (sec == SEC_V) {
#pragma unroll
            for (int n = 0; n < 2; ++n) {
              const f32x4 v = acc[ai][bj][m][n];
              const int dv = d0 + 16 * n;
              const u32 w01 = pk2(v[0], v[1]), w23 = pk2(v[2], v[3]);
              if (prompt) {
                u16* vt = VT + ((size_t)((b * 8 + hh) * 128 + dv)) * 256 + t;
                vt[0] = (u16)(w01 & 0xffffu); vt[256] = (u16)(w01 >> 16); vt[512] = (u16)(w23 & 0xffffu); vt[768] = (u16)(w23 >> 16);
                *reinterpret_cast<float4*>(vout + ((size_t)((b * 8 + hh) * 256 + t)) * 128 + dv) = float4{v[0], v[1], v[2], v[3]};
              } else {
                u16* vt = VT + 8388608 + ((size_t)((b * 8 + hh) * 128 + dv)) * 4096 + t;
                vt[0] = (u16)(w01 & 0xffffu); vt[4096] = (u16)(w01 >> 16); vt[8192] = (u16)(w23 & 0xffffu); vt[12288] = (u16)(w23 >> 16);
              }
            }
          } else {
            f32x4 v0 = acc[ai][bj][m][0], v1 = acc[ai][bj][m][1];
            if (isk && prompt) {
              float* ko = kout + ((size_t)((b * 8 + hh) * 256 + t)) * 128 + d0;
              *reinterpret_cast<float4*>(ko) = float4{v0[0], v0[1], v0[2], v0[3]};
              *reinterpret_cast<float4*>(ko + 16) = float4{v1[0], v1[1], v1[2], v1[3]};
            }
            if (rope) {
              const int pos = (wc & 1) ? (t & 63) : (t >> 6);
              const float4 cs = *reinterpret_cast<const float4*>(ropeC + pos * 16 + 4 * fq);
              const float4 sn = *reinterpret_cast<const float4*>(ropeS + pos * 16 + 4 * fq);
              const float c4[4] = {cs.x, cs.y, cs.z, cs.w}, s4[4] = {sn.x, sn.y, sn.z, sn.w};
#pragma unroll
              for (int j = 0; j < 4; ++j) {
                const float x1 = v0[j], x2 = v1[j];
                v0[j] = x1 * c4[j] - x2 * s4[j];
                v1[j] = x1 * s4[j] + x2 * c4[j];
              }
            }
            u16* dst = PROJ + (size_t)row * NC + u.pn * 256 + bj * 128 + d0;
            *reinterpret_cast<u32x2*>(dst) = u32x2{pk2(v0[0] * sc, v0[1] * sc), pk2(v0[2] * sc, v0[3] * sc)};
            *reinterpret_cast<u32x2*>(dst + 16) = u32x2{pk2(v1[0] * sc, v1[1] * sc), pk2(v1[2] * sc, v1[3] * sc)};
          }
        }
      }
  }
};

struct EpiOut {
  static constexpr bool PERM = false, AFTER_DRAIN = false;
  float* X; const float* x0; const float* x1; const float* mod; const float* lng; const float* lnb; const float2* stats; int l;
  DI void operator()(const f32x4 (&acc)[2][2][4][2], const pg8::Unit& u, int wr, int wc, int fr, int fq) const {
    const bool prompt = u.pm < 32;
    const int cond = prompt ? 0 : 1 + ((u.pm * 256 - TP) >> 12);
    const float* gate = mod + (size_t)(l * 5 + cond) * 6144 + 4096;
    const int col0 = u.pn * 256 + wc * 32 + 4 * fq;
    const int row0 = u.pm * 256 + wr * 64 + fr;
    u16* Xb = reinterpret_cast<u16*>(X);
    if (l != 0) {
      u32x2 zr[2][4][2][2];
      float2 st[2][4];
#pragma unroll
      for (int ai = 0; ai < 2; ++ai)
#pragma unroll
        for (int m = 0; m < 4; ++m) {
          const int row = row0 + ai * 128 + m * 16;
          st[ai][m] = stats[row];
#pragma unroll
          for (int bj = 0; bj < 2; ++bj)
#pragma unroll
            for (int n = 0; n < 2; ++n) zr[ai][m][bj][n] = *reinterpret_cast<const u32x2*>(Xb + (size_t)row * 4096 + col0 + bj * 128 + 16 * n);
        }
#pragma unroll
      for (int bj = 0; bj < 2; ++bj)
#pragma unroll
        for (int n = 0; n < 2; ++n) {
          const int col = col0 + bj * 128 + 16 * n;
          const float4 g4 = *reinterpret_cast<const float4*>(gate + col);
          const float4 lg = *reinterpret_cast<const float4*>(lng + col), lb = *reinterpret_cast<const float4*>(lnb + col);
#pragma unroll
          for (int ai = 0; ai < 2; ++ai)
#pragma unroll
            for (int m = 0; m < 4; ++m) {
              const int row = row0 + ai * 128 + m * 16;
              const u32x2 zw = zr[ai][m][bj][n];
              const float mu = st[ai][m].x, rs = st[ai][m].y;
              const float x_0 = (bflo(zw[0]) - mu) * rs * lg.x + lb.x, x_1 = (bfhi(zw[0]) - mu) * rs * lg.y + lb.y;
              const float x_2 = (bflo(zw[1]) - mu) * rs * lg.z + lb.z, x_3 = (bfhi(zw[1]) - mu) * rs * lg.w + lb.w;
              const f32x4 a = acc[ai][bj][m][n];
              *reinterpret_cast<u32x2*>(Xb + (size_t)row * 4096 + col) =
                  u32x2{pk2(ALPHA * x_0 + g4.x * a[0], ALPHA * x_1 + g4.y * a[1]), pk2(ALPHA * x_2 + g4.z * a[2], ALPHA * x_3 + g4.w * a[3])};
            }
        }
    } else {
#pragma unroll
      for (int bj = 0; bj < 2; ++bj)
#pragma unroll
        for (int n = 0; n < 2; ++n) {
          const int col = col0 + bj * 128 + 16 * n;
          const float4 g4 = *reinterpret_cast<const float4*>(gate + col);
#pragma unroll
          for (int ai = 0; ai < 2; ++ai)
#pragma unroll
            for (int m = 0; m < 4; ++m) {
              const int row = row0 + ai * 128 + m * 16;
              const float4 xo = prompt ? *reinterpret_cast<const float4*>(x0 + (size_t)row * 2048 + col)
                                       : *reinterpret_cast<const float4*>(x1 + (size_t)(row - TP) * 2048 + col);
              const f32x4 a = acc[ai][bj][m][n];
              *reinterpret_cast<u32x2*>(Xb + (size_t)row * 4096 + col) =
                  u32x2{pk2(ALPHA * xo.x + g4.x * a[0], ALPHA * xo.y + g4.y * a[1]), pk2(ALPHA * xo.z + g4.z * a[2], ALPHA * xo.w + g4.w * a[3])};
            }
        }
    }
  }
};

template <int MODE>
DI void gemm_phase(const Params& p, int l, unsigned char* lds) {
  constexpr int N = (MODE == G_OUT) ? 2048 : (MODE == G_IN_EVEN ? 6144 : 7168);
  pg8::Gemm g;
  g.A = reinterpret_cast<const u16*>(p.ws + WS_H);
  g.Bt = (MODE == G_OUT) ? reinterpret_cast<const u16*>(p.ws + WS_WOUTT) + (size_t)l * 2048 * 2048
                         : reinterpret_cast<const u16*>(p.ws + ws_wint(l));
  g.M = T_ALL; g.N = N; g.K = 2048;
  pg8::StaticOrder S;
  S.init(T_ALL, N, (int)gridDim.x, (int)blockIdx.x);
  PG8_LAS unsigned char* l3 = (PG8_LAS unsigned char*)lds;
  if constexpr (MODE == G_OUT) {
    EpiOut E;
    E.X = p.out; E.x0 = p.in[0]; E.x1 = p.in[1]; E.mod = reinterpret_cast<const float*>(p.ws + WS_MOD); E.l = l;
    E.lng = p.in[16 + 10 * (l > 0 ? l - 1 : 0)]; E.lnb = p.in[17 + 10 * (l > 0 ? l - 1 : 0)];
    E.stats = reinterpret_cast<const float2*>(p.ws + WS_STATS);
    pg8::gemm_phase<EpiOut, pg8::StaticOrder, false>(l3, g, S, E, nullptr);
  } else {
    EpiIn<MODE> E;
    E.PROJ = reinterpret_cast<u16*>(p.ws + WS_PROJ); E.VT = reinterpret_cast<u16*>(p.ws + WS_VT);
    E.kout = p.out + (size_t)T_ALL * 2048 + (size_t)(2 * l) * 8388608;
    E.vout = p.out + (size_t)T_ALL * 2048 + (size_t)(2 * l + 1) * 8388608;
    E.ropeC = reinterpret_cast<const float*>(p.ws + WS_ROPE); E.ropeS = E.ropeC + 1024;
    pg8::gemm_phase<EpiIn<MODE>, pg8::StaticOrder, false>(l3, g, S, E, nullptr);
  }
}

DI void phase_ln(const Params& p, int l) {
  const int tid_ = TIDX, lane = tid_ & 63, wid = tid_ >> 6;
  const float* g = p.in[16 + 10 * l];
  const float* bb = p.in[17 + 10 * l];
  const float* mod = reinterpret_cast<const float*>(p.ws + WS_MOD);
  u16* H = reinterpret_cast<u16*>(p.ws + WS_H);
  float* X = p.out;
  for (int it = VBID; it < T_ALL / 4; it += VGRID) {
    const int row = it * 4 + wid;
    float* xr = X + (size_t)row * 2048;
    const u16* zr = reinterpret_cast<const u16*>(xr);
    float4 v[8];
    float s = 0.f;
#pragma unroll
    for (int i = 0; i < 8; ++i) {
      const u32x2 w = *reinterpret_cast<const u32x2*>(zr + (i * 64 + lane) * 4);
      v[i] = float4{bflo(w[0]), bfhi(w[0]), bflo(w[1]), bfhi(w[1])};
      s += v[i].x + v[i].y + v[i].z + v[i].w;
    }
#pragma unroll
    for (int o = 32; o >= 1; o >>= 1) s += __shfl_xor(s, o);
    const float mu = s * (1.f / 2048.f);
    float ss = 0.f;
#pragma unroll
    for (int i = 0; i < 8; ++i) {
      float a = v[i].x - mu, b = v[i].y - mu, c = v[i].z - mu, d = v[i].w - mu;
      ss += a * a + b * b + c * c + d * d;
    }
#pragma unroll
    for (int o = 32; o >= 1; o >>= 1) ss += __shfl_xor(ss, o);
    const float rstd = rsqrtf(ss * (1.f / 2048.f) + LN_EPS);
    if (lane == 0) *reinterpret_cast<float2*>(p.ws + WS_STATS + (size_t)row * 8) = float2{mu, rstd};
    const int cond = row < TP ? 0 : 1 + ((row - TP) >> 12);
    const float* sh = mod + (size_t)((l + 1) * 5 + cond) * 6144;
#pragma unroll
    for (int i = 0; i < 8; ++i) {
      const int e = (i * 64 + lane) * 4;
      float4 gg = *reinterpret_cast<const float4*>(g + e), b4 = *reinterpret_cast<const float4*>(bb + e);
      float4 y;
      y.x = (v[i].x - mu) * rstd * gg.x + b4.x; y.y = (v[i].y - mu) * rstd * gg.y + b4.y;
      y.z = (v[i].z - mu) * rstd * gg.z + b4.z; y.w = (v[i].w - mu) * rstd * gg.w + b4.w;
      if (l == 3) *reinterpret_cast<float4*>(xr + e) = y;
      if (l < 3) {
        float4 s0 = *reinterpret_cast<const float4*>(sh + e), c0 = *reinterpret_cast<const float4*>(sh + 2048 + e);
        u32x2 o = {pk2(y.x * (1.f + c0.x) + s0.x, y.y * (1.f + c0.y) + s0.y), pk2(y.z * (1.f + c0.z) + s0.z, y.w * (1.f + c0.w) + s0.w)};
        *reinterpret_cast<u32x2*>(H + (size_t)row * 2048 + e) = o;
      }
    }
  }
}

struct AttnSrc {
  const u16* k0; const u16* vt0; int ks0, vs0, n0;
  const u16* k1; const u16* vt1; int ks1, vs1, n1;
};

template <int DQK>
DI void attn_ldg(const AttnSrc& s, int j, u32x4 (&rk)[DQK / 64], u32x4 (&rv)[2]) {
  const u16* kb; const u16* vb; int ks, vs;
  if (j < s.n0) { kb = s.k0 + (size_t)j * 64 * s.ks0; vb = s.vt0 + j * 64; ks = s.ks0; vs = s.vs0; }
  else { const int jj = j - s.n0; kb = s.k1 + (size_t)jj * 64 * s.ks1; vb = s.vt1 + jj * 64; ks = s.ks1; vs = s.vs1; }
  constexpr int CPR = DQK / 8;
  const int tid = TID8;
#pragma unroll
  for (int i = 0; i < DQK / 64; ++i) {
    const int c = tid + 512 * i, row = c / CPR, kc = c % CPR;
    rk[i] = *reinterpret_cast<const u32x4*>(kb + (size_t)row * ks + kc * 8);
  }
#pragma unroll
  for (int i = 0; i < 2; ++i) {
    const int c = tid + 512 * i, row = c >> 3, kc = c & 7;
    rv[i] = *reinterpret_cast<const u32x4*>(vb + (size_t)row * vs + kc * 8);
  }
}
template <int DQK>
DI void attn_sts(u16* sK, u16* sVT, const u32x4 (&rk)[DQK / 64], const u32x4 (&rv)[2]) {
  constexpr int CPR = DQK / 8;
  const int tid = TID8;
#pragma unroll
  for (int i = 0; i < DQK / 64; ++i) {
    const int c = tid + 512 * i, row = c / CPR, kc = c % CPR;
    *reinterpret_cast<u32x4*>(sK + row * (DQK + 8) + kc * 8) = rk[i];
  }
#pragma unroll
  for (int i = 0; i < 2; ++i) {
    const int c = tid + 512 * i, row = c >> 3, kc = c & 7;
    *reinterpret_cast<u32x4*>(sVT + row * 72 + kc * 8) = rv[i];
  }
}

DI void attn_pv(const f32x16 (&s)[2], const u16* vw, f32x16 (&O)[4]) {
  __builtin_amdgcn_s_setprio(1);
#pragma unroll
  for (int s4 = 0; s4 < 4; ++s4) {
    const int t = s4 >> 1, b0 = (s4 & 1) * 8;
    u32x4 w = {pk2(s[t][b0], s[t][b0 + 1]), pk2(s[t][b0 + 2], s[t][b0 + 3]), pk2(s[t][b0 + 4], s[t][b0 + 5]), pk2(s[t][b0 + 6], s[t][b0 + 7])};
    const bf16x8 pf = __builtin_bit_cast(bf16x8, w);
#pragma unroll
    for (int d = 0; d < 4; ++d) {
      bf16x8 a = ld8(vw + d * 32 * 72 + s4 * 16);
      O[d] = mfma32(a, pf, O[d]);
    }
  }
  __builtin_amdgcn_s_setprio(0);
}

template <int DQK, bool NA>
DI void attn_run(const AttnSrc& src, const u16* qblk, int qstride, u16* sQ, u16* sK, u16* sVT, f32x16 (&O)[4], float& l_out,
                 int qr, int qc, int rsmin, const float* sBias) {
  const int tid = TID8, lane = tid & 63, wid = tid >> 6;
  const int r = lane & 31, h = lane >> 5;
  const int pr = (r & 0x13) | ((r & 4) << 1) | ((r & 8) >> 1);
  constexpr int CPR = DQK / 8, QS = DQK + 8;
  __syncthreads();
  constexpr bool QREG = (DQK == 64);
  bf16x8 qf[QREG ? DQK / 16 : 1];
  if constexpr (QREG) {
#pragma unroll
    for (int ks = 0; ks < DQK / 16; ++ks) qf[ks] = ld8(qblk + (size_t)(wid * 32 + r) * qstride + ks * 16 + 8 * h);
  } else {
#pragma unroll
    for (int i = 0; i < DQK / 16; ++i) {
      const int c = tid + 512 * i, row = c / CPR, kc = c % CPR;
      *reinterpret_cast<u32x4*>(sQ + row * QS + kc * 8) = *reinterpret_cast<const u32x4*>(qblk + (size_t)row * qstride + kc * 8);
    }
  }
#pragma unroll
  for (int d = 0; d < 4; ++d)
#pragma unroll
    for (int i = 0; i < 16; ++i) O[d][i] = 0.f;
  float m = -1e30f, l = 0.f;
  const int nt = src.n0 + src.n1;
  const int rsq = min(max(qr - 4, 0), 56);
  const int cs = min(max(qc - 8, 0), 48);
  const u16* qw = sQ + (wid * 32 + r) * QS + 8 * h;
  u16* sVT1 = sVT + 128 * 72 + 2048;
  const bool grpB = wid >= 4;
  bool pend = false;
  f32x16 s[2];
  u32x4 rk[DQK / 64], rv[2];
  attn_ldg<DQK>(src, 0, rk, rv);
  constexpr bool SB = QREG;
  u16* sKb1 = sQ + 16384;
  int vi = 0;
  if constexpr (SB) {
    attn_sts<DQK>(sK, sVT, rk, rv);
    if (nt > 1) attn_ldg<DQK>(src, 1, rk, rv);
    __syncthreads();
  }
#pragma unroll 1
  for (int j = 0; j < nt; ++j) {
    const u16* kw;
    u16* vcur;
    const u16* vprev;
    if constexpr (SB) {
      u16* vnext = (vi == 0) ? sVT1 : ((vi == 1) ? sQ : sVT);
      vcur = (vi == 0) ? sVT : ((vi == 1) ? sVT1 : sQ);
      vprev = (vi == 0) ? sQ : ((vi == 1) ? sVT : sVT1);
      if (j + 1 < nt) attn_sts<DQK>((j & 1) ? sK : sKb1, vnext, rk, rv);
      if (j + 2 < nt) attn_ldg<DQK>(src, j + 2, rk, rv);
      kw = ((j & 1) ? sKb1 : sK) + pr * QS + 8 * h;
      vi = (vi == 2) ? 0 : vi + 1;
    } else {
      if (j > 0) __syncthreads();
      vcur = (j & 1) ? sVT1 : sVT;
      vprev = (j & 1) ? sVT : sVT1;
      attn_sts<DQK>(sK, vcur, rk, rv);
      __syncthreads();
      if (j + 1 < nt) attn_ldg<DQK>(src, j + 1, rk, rv);
      kw = sK + pr * QS + 8 * h;
    }
    __builtin_amdgcn_sched_barrier(0);
    if (grpB && pend) { attn_pv(s, vprev + r * 72 + 8 * h, O); pend = false; }
    bool active = true;
    int kr = 0;
    if (NA && j >= src.n0) { kr = rsmin + (j - src.n0); active = (kr >= rsq) && (kr < rsq + 8); }
    if (active) {
      __builtin_amdgcn_s_setprio(1);
#pragma unroll
      for (int t = 0; t < 2; ++t) {
#pragma unroll
        for (int i = 0; i < 16; ++i) s[t][i] = 0.f;
#pragma unroll
        for (int ks = 0; ks < DQK / 16; ++ks) {
          bf16x8 a = ld8(kw + t * 32 * QS + ks * 16);
          bf16x8 q;
          if constexpr (QREG) q = qf[ks]; else q = ld8(qw + ks * 16);
          s[t] = mfma32(a, q, s[t]);
        }
      }
      __builtin_amdgcn_s_setprio(0);
      if (NA && j >= src.n0) {
        const float* bp = sBias + (kr - qr + 7) * 31 + (8 * h - qc + 15);
        const int kb = 8 * h - cs;
#pragma unroll
        for (int t = 0; t < 2; ++t)
#pragma unroll
          for (int i = 0; i < 16; ++i) {
            const int ko = t * 32 + 16 * (i >> 3) + (i & 7);
            const bool ok = (unsigned)(ko + kb) < 16u;
            const float bv = bp[ko];
            s[t][i] = ok ? s[t][i] + bv : -1e30f;
          }
      }
      float mx = -1e30f;
#pragma unroll
      for (int t = 0; t < 2; ++t)
#pragma unroll
        for (int i = 0; i < 16; ++i) mx = fmaxf(mx, s[t][i]);
      if (__builtin_amdgcn_ballot_w64(mx > m + 8.0f) != 0ull) {
        mx = fmaxf(mx, __shfl_xor(mx, 32));
        const float mn = fmaxf(m, mx);
        const float alpha = ex2(m - mn);
        l *= alpha;
        m = mn;
#pragma unroll
        for (int d = 0; d < 4; ++d)
#pragma unroll
          for (int i = 0; i < 16; ++i) O[d][i] *= alpha;
      }
      float rsum = 0.f;
#pragma unroll
      for (int t = 0; t < 2; ++t)
#pragma unroll
        for (int i = 0; i < 16; ++i) { const float e = ex2(s[t][i] - m); s[t][i] = e; rsum += e; }
      l += rsum;
      if (!grpB) attn_pv(s, vcur + r * 72 + 8 * h, O);
      else pend = true;
    }
    if constexpr (SB) __syncthreads();
  }
  if (grpB && pend) {
    const u16* vlast;
    if constexpr (SB) vlast = (vi == 1) ? sVT : ((vi == 2) ? sVT1 : sQ);
    else vlast = ((nt - 1) & 1) ? sVT1 : sVT;
    attn_pv(s, vlast + r * 72 + 8 * h, O);
  }
  l_out = l + __shfl_xor(l, 32);
}

DI void heavy_map(int it, int& bh, int& qb) { const int x = it & 7, rest = it >> 3; qb = rest & 15; bh = x + 8 * (rest >> 4); }

DI void diff_item(const Params& p, int l, bool sample, int bh, int qb, unsigned char* lds) {
  constexpr int NC = 6144;
  const int tid_ = TID8, lane = tid_ & 63, wid = tid_ >> 6, r = lane & 31, h = lane >> 5;
  const int b = bh >> 3, hd = bh & 7;
  u16* sQ = reinterpret_cast<u16*>(lds);
  u16* sK = sQ + 256 * 136;
  u16* sVT = sK + 64 * 136;
  const u16* PROJ = reinterpret_cast<const u16*>(p.ws + WS_PROJ);
  const u16* VT = reinterpret_cast<const u16*>(p.ws + WS_VT);
  const int seq0 = sample ? TP + b * 4096 : b * 256;
  const int token = seq0 + qb * 256 + wid * 32 + r;
  const float* dl = p.in[20 + 10 * l];
  float pa = dl[lane] * dl[64 + lane], pb = dl[128 + lane] * dl[192 + lane];
#pragma unroll
  for (int o = 32; o >= 1; o >>= 1) { pa += __shfl_xor(pa, o); pb += __shfl_xor(pb, o); }
  const float lam_init = 0.8f - 0.6f * __expf(-0.3f * (float)l);
  const float lam = __expf(pa) - __expf(pb) + lam_init;

  u32 o1p[32];
  f32x16 O[4];
  float lsum;
#pragma unroll
  for (int comp = 0; comp < 2; ++comp) {
    AttnSrc s;
    if (sample) {
      s.k0 = reinterpret_cast<const u16*>(p.ws + WS_CK) + (size_t)l * 2097152 + (size_t)bh * 65536 + comp * 64; s.ks0 = 128;
      s.vt0 = reinterpret_cast<const u16*>(p.ws + WS_CVT) + (size_t)l * 2097152 + (size_t)bh * 65536; s.vs0 = 512; s.n0 = 8;
      s.k1 = PROJ + (size_t)seq0 * NC + 3072 + hd * 128 + comp * 64; s.ks1 = NC;
      s.vt1 = VT + 8388608 + (size_t)bh * 128 * 4096; s.vs1 = 4096; s.n1 = 64;
    } else {
      s.k0 = nullptr; s.vt0 = nullptr; s.ks0 = 0; s.vs0 = 0; s.n0 = 0;
      s.k1 = PROJ + (size_t)seq0 * NC + 3072 + hd * 128 + comp * 64; s.ks1 = NC;
      s.vt1 = VT + (size_t)bh * 128 * 256; s.vs1 = 256; s.n1 = 4;
    }
    const u16* qblk = PROJ + (size_t)(seq0 + qb * 256) * NC + 2048 + hd * 128 + comp * 64;
    attn_run<64, false>(s, qblk, NC, sQ, sK, sVT, O, lsum, 0, 0, 0, nullptr);
    const float inv = 1.f / lsum;
    if (comp == 0) {
#pragma unroll
      for (int d = 0; d < 4; ++d)
#pragma unroll
        for (int i = 0; i < 8; ++i) o1p[d * 8 + i] = pk2(O[d][2 * i] * inv, O[d][2 * i + 1] * inv);
    } else {
      float ssq = 0.f;
#pragma unroll
      for (int d = 0; d < 4; ++d)
#pragma unroll
        for (int i = 0; i < 8; ++i) {
          const u32 w = o1p[d * 8 + i];
          const float a = bflo(w) - lam * O[d][2 * i] * inv, c = bfhi(w) - lam * O[d][2 * i + 1] * inv;
          O[d][2 * i] = a; O[d][2 * i + 1] = c;
          ssq += a * a + c * c;
        }
      ssq += __shfl_xor(ssq, 32);
      const float rn = rsqrtf(ssq * (1.f / 128.f) + LN_EPS) * (1.f - lam_init);
      const float* subln = p.in[21 + 10 * l];
      const u16* gp = PROJ + (size_t)token * NC + 5120 + hd * 128;
      u16* yp = reinterpret_cast<u16*>(p.ws + WS_H) + (size_t)token * 2048 + 1024 + hd * 128;
#pragma unroll
      for (int d = 0; d < 4; ++d)
#pragma unroll
        for (int q = 0; q < 4; ++q) {
          const int dv = d * 32 + 8 * q + 4 * h;
          const u32x2 gw = *reinterpret_cast<const u32x2*>(gp + dv);
          const float4 sl = *reinterpret_cast<const float4*>(subln + dv);
          const float y0 = O[d][4 * q] * rn * sl.x * silu(bflo(gw[0]));
          const float y1 = O[d][4 * q + 1] * rn * sl.y * silu(bfhi(gw[0]));
          const float y2 = O[d][4 * q + 2] * rn * sl.z * silu(bflo(gw[1]));
          const float y3 = O[d][4 * q + 3] * rn * sl.w * silu(bfhi(gw[1]));
          *reinterpret_cast<u32x2*>(yp + dv) = (ZERO_MASK & 2) ? u32x2{0u, 0u} : u32x2{pk2(y0, y1), pk2(y2, y3)};
        }
    }
  }
}

template <int H>
DI void pool_window(const u16* sIn, u16* sP, int oc, int seg, int t0, int L) {
  const int tl0 = seg * 8;
  const u16* base = sIn + (tl0 + 8 - H) * 264 + oc * 8;
  float a[8];
#pragma unroll
  for (int k = 0; k < 8; ++k) a[k] = 0.f;
#pragma unroll
  for (int o = 0; o < 2 * H; ++o) {
    const u32x4 v = *reinterpret_cast<const u32x4*>(base + o * 264);
#pragma unroll
    for (int k = 0; k < 4; ++k) { a[2 * k] += bflo(v[k]); a[2 * k + 1] += bfhi(v[k]); }
  }
#pragma unroll
  for (int tt = 0; tt < 8; ++tt) {
    const int t = t0 + tl0 + tt;
    const int lo = max(t - H, 0), hi = min(t + H, L);
    const float ic = 1.f / (float)(hi - lo);
    const u32x4 x = *reinterpret_cast<const u32x4*>(sIn + (tl0 + tt + 8) * 264 + oc * 8);
    u32x4 o;
#pragma unroll
    for (int k = 0; k < 4; ++k) o[k] = pk2(a[2 * k] * ic - bflo(x[k]), a[2 * k + 1] * ic - bfhi(x[k]));
    *reinterpret_cast<u32x4*>(sP + (tl0 + tt) * 264 + oc * 8) = o;
    if (tt < 7) {
      const u32x4 vin = *reinterpret_cast<const u32x4*>(base + (2 * H + tt) * 264);
      const u32x4 vout = *reinterpret_cast<const u32x4*>(base + tt * 264);
#pragma unroll
      for (int k = 0; k < 4; ++k) { a[2 * k] += bflo(vin[k]) - bflo(vout[k]); a[2 * k + 1] += bfhi(vin[k]) - bfhi(vout[k]); }
    }
  }
}

DI void pool_item(const Params& p, int l, int pi, unsigned char* lds) {
  constexpr int NC = 6144;
  const int tid = TIDX, lane = tid & 63, wid = tid >> 6, fr = lane & 15, fq = lane >> 4;
  const int tb = pi >> 2, g = pi & 3, row0 = tb * 64;
  const int L = row0 < TP ? 256 : 4096;
  const int t0 = row0 < TP ? (row0 & 255) : ((row0 - TP) & 4095);
  u16* sIn = reinterpret_cast<u16*>(lds);
  u16* sP = sIn + 80 * 264;
  const u16* PROJ = reinterpret_cast<const u16*>(p.ws + WS_PROJ);
  __syncthreads();
#pragma unroll
  for (int i = 0; i < 10; ++i) {
    const int c = tid + 256 * i, rr = c >> 5, oc = c & 31;
    const int t = t0 - 8 + rr;
    u32x4 v = {0u, 0u, 0u, 0u};
    if (t >= 0 && t < L) v = *reinterpret_cast<const u32x4*>(PROJ + (size_t)(row0 - 8 + rr) * NC + g * 256 + oc * 8);
    *reinterpret_cast<u32x4*>(sIn + rr * 264 + oc * 8) = v;
  }
  __syncthreads();
  {
    const int oc = tid & 31, seg = tid >> 5;
    switch (g) {
      case 0: pool_window<1>(sIn, sP, oc, seg, t0, L); break;
      case 1: pool_window<2>(sIn, sP, oc, seg, t0, L); break;
      case 2: pool_window<4>(sIn, sP, oc, seg, t0, L); break;
      default: pool_window<8>(sIn, sP, oc, seg, t0, L); break;
    }
  }
  __syncthreads();
  const u16* W = reinterpret_cast<const u16*>(p.ws + WS_POOLWT) + (size_t)(l >> 1) * 262144 + (size_t)g * 65536;
  f32x4 acc[4][4];
#pragma unroll
  for (int a = 0; a < 4; ++a)
#pragma unroll
    for (int b = 0; b < 4; ++b) acc[a][b] = f32x4{0.f, 0.f, 0.f, 0.f};
#pragma unroll 4
  for (int ks = 0; ks < 8; ++ks) {
    bf16x8 af[4], bfr[4];
#pragma unroll
    for (int m = 0; m < 4; ++m) af[m] = ld8(sP + (m * 16 + fr) * 264 + ks * 32 + fq * 8);
#pragma unroll
    for (int n = 0; n < 4; ++n) bfr[n] = ld8(W + (size_t)(wid * 64 + n * 16 + fr) * 256 + ks * 32 + fq * 8);
#pragma unroll
    for (int m = 0; m < 4; ++m)
#pragma unroll
      for (int n = 0; n < 4; ++n) acc[m][n] = mfma16(bfr[n], af[m], acc[m][n]);
  }
  const float* pscale = p.in[19 + 10 * l];
  u16* Y = reinterpret_cast<u16*>(p.ws + WS_H);
#pragma unroll
  for (int n = 0; n < 4; ++n) {
    const int col = g * 256 + wid * 64 + n * 16 + 4 * fq;
    const float4 sc = *reinterpret_cast<const float4*>(pscale + col);
#pragma unroll
    for (int m = 0; m < 4; ++m) {
      const int row = row0 + m * 16 + fr;
      const u32x2 gw = *reinterpret_cast<const u32x2*>(PROJ + (size_t)row * NC + 1024 + col);
      float y0 = acc[m][n][0] * sc.x * silu(bflo(gw[0])), y1 = acc[m][n][1] * sc.y * silu(bfhi(gw[0]));
      float y2 = acc[m][n][2] * sc.z * silu(bflo(gw[1])), y3 = acc[m][n][3] * sc.w * silu(bfhi(gw[1]));
      if (ZERO_MASK & 1) { y0 = y1 = y2 = y3 = 0.f; }
      *reinterpret_cast<u32x2*>(Y + (size_t)row * 2048 + col) = u32x2{pk2(y0, y1), pk2(y2, y3)};
    }
  }
}

DI void phase_mix_even(const Params& p, int l, unsigned char* lds, unsigned char* lds_all) {
#pragma unroll 1
  for (int it = blockIdx.x; it < 512; it += gridDim.x) { int bh, qb; heavy_map(it, bh, qb); diff_item(p, l, true, bh, qb, lds_all); }
#pragma unroll 1
  for (int it = blockIdx.x; it < 256; it += gridDim.x) diff_item(p, l, false, it, 0, lds_all);
#pragma unroll 1
  for (int it = VBID; it < 1536; it += VGRID) pool_item(p, l, it, lds);
}

DI void na_item(const Params& p, int l, bool sample, int bh, int qb, unsigned char* lds) {
  constexpr int NC = 7168;
  const int tid = TID8, lane = tid & 63, wid = tid >> 6, r = lane & 31, h = lane >> 5;
  const int b = bh >> 3, hd = bh & 7;
  u16* sQ = reinterpret_cast<u16*>(lds);
  u16* sK = sQ + 256 * 136;
  u16* sVT = sK + 64 * 136;
  float* sBias = reinterpret_cast<float*>(sVT + 128 * 72) + 64;
  const u16* PROJ = reinterpret_cast<const u16*>(p.ws + WS_PROJ);
  const u16* VT = reinterpret_cast<const u16*>(p.ws + WS_VT);
  const int seq0 = sample ? TP + b * 4096 : b * 256;
  const int token = seq0 + qb * 256 + wid * 32 + r;
  AttnSrc s;
  int qr = 0, qc = 0, rsmin = 0;
  f32x16 O[4];
  float lsum;
  const u16* qblk = PROJ + (size_t)(seq0 + qb * 256) * NC + hd * 128;
  if (sample) {
    __syncthreads();
    const float* rpb = p.in[18 + 10 * l] + hd * 465;
    for (int e = tid; e < 465; e += 512) sBias[e] = rpb[e] * LOG2E;
    const int r0 = qb * 4;
    qr = r0 + (wid >> 1); qc = (wid & 1) * 32 + r;
    rsmin = min(max(r0 - 4, 0), 56);
    const int rs1 = min(max(r0 - 1, 0), 56);
    s.k0 = reinterpret_cast<const u16*>(p.ws + WS_CK) + (size_t)l * 2097152 + (size_t)bh * 65536; s.ks0 = 128;
    s.vt0 = reinterpret_cast<const u16*>(p.ws + WS_CVT) + (size_t)l * 2097152 + (size_t)bh * 65536; s.vs0 = 512; s.n0 = 8;
    s.k1 = PROJ + (size_t)(seq0 + rsmin * 64) * NC + 1024 + hd * 128; s.ks1 = NC;
    s.vt1 = VT + 8388608 + (size_t)bh * 128 * 4096 + rsmin * 64; s.vs1 = 4096; s.n1 = rs1 + 8 - rsmin;
    attn_run<128, true>(s, qblk, NC, sQ, sK, sVT, O, lsum, qr, qc, rsmin, sBias);
  } else {
    s.k0 = nullptr; s.vt0 = nullptr; s.ks0 = 0; s.vs0 = 0; s.n0 = 0;
    s.k1 = PROJ + (size_t)seq0 * NC + 1024 + hd * 128; s.ks1 = NC;
    s.vt1 = VT + (size_t)bh * 128 * 256; s.vs1 = 256; s.n1 = 4;
    attn_run<128, false>(s, qblk, NC, sQ, sK, sVT, O, lsum, 0, 0, 0, nullptr);
  }
  const float inv = 1.f / lsum;
  const u16* gp = PROJ + (size_t)token * NC + 3072 + hd * 128;
  u16* yp = reinterpret_cast<u16*>(p.ws + WS_H) + (size_t)token * 2048 + hd * 128;
#pragma unroll
  for (int d = 0; d < 4; ++d)
#pragma unroll
    for (int q = 0; q < 4; ++q) {
      const int dv = d * 32 + 8 * q + 4 * h;
      const u32x2 gw = *reinterpret_cast<const u32x2*>(gp + dv);
      const float y0 = O[d][4 * q] * inv * silu(bflo(gw[0]));
      const float y1 = O[d][4 * q + 1] * inv * silu(bfhi(gw[0]));
      const float y2 = O[d][4 * q + 2] * inv * silu(bflo(gw[1]));
      const float y3 = O[d][4 * q + 3] * inv * silu(bfhi(gw[1]));
      *reinterpret_cast<u32x2*>(yp + dv) = (ZERO_MASK & 4) ? u32x2{0u, 0u} : u32x2{pk2(y0, y1), pk2(y2, y3)};
    }
}

DI void sgu_item(const Params& p, int l, int si, unsigned char* lds) {
  constexpr int NC = 7168;
  const int tid = TIDX, lane = tid & 63, wid = tid >> 6, fr = lane & 15, fq = lane >> 4;
  const int ch = si >> 2, g = si & 3, row0 = ch * 128;
  u16* vnT = reinterpret_cast<u16*>(lds);
  float* sMu = reinterpret_cast<float*>(vnT + 256 * 136);
  float* sRs = sMu + 128;
  const u16* PROJ = reinterpret_cast<const u16*>(p.ws + WS_PROJ);
  __syncthreads();
  {
    const int grp = tid >> 4, ln = tid & 15;
#pragma unroll 2
    for (int rr = 0; rr < 8; ++rr) {
      const u16* src = PROJ + (size_t)(row0 + grp * 8 + rr) * NC + 5120;
      float s = 0.f, ss = 0.f;
#pragma unroll
      for (int c8 = 0; c8 < 8; ++c8) {
        const u32x4 v = *reinterpret_cast<const u32x4*>(src + (ln + 16 * c8) * 8);
#pragma unroll
        for (int k = 0; k < 4; ++k) { const float a = bflo(v[k]), b = bfhi(v[k]); s += a + b; ss += a * a + b * b; }
      }
#pragma unroll
      for (int o = 8; o >= 1; o >>= 1) { s += __shfl_xor(s, o); ss += __shfl_xor(ss, o); }
      const float mu = s * (1.f / 1024.f);
      const float var = fmaxf(ss * (1.f / 1024.f) - mu * mu, 0.f);
      if (ln == 0) { sMu[grp * 8 + rr] = mu; sRs[grp * 8 + rr] = rsqrtf(var + LN_EPS); }
    }
  }
  __syncthreads();
  {
    const int j = tid & 127, hf = tid >> 7;
    const float mu = sMu[j], rs = sRs[j];
    const float* lng = p.in[19 + 10 * l] + g * 256;
    const u16* src = PROJ + (size_t)(row0 + j) * NC + 5120 + g * 256;
#pragma unroll 8
    for (int oc = hf * 16; oc < hf * 16 + 16; ++oc) {
      const u32x4 v = *reinterpret_cast<const u32x4*>(src + oc * 8);
      const float4 g0 = *reinterpret_cast<const float4*>(lng + oc * 8), g1 = *reinterpret_cast<const float4*>(lng + oc * 8 + 4);
      const float gg[8] = {g0.x, g0.y, g0.z, g0.w, g1.x, g1.y, g1.z, g1.w};
#pragma unroll
      for (int k = 0; k < 4; ++k) {
        const float a = (bflo(v[k]) - mu) * rs * gg[2 * k], b = (bfhi(v[k]) - mu) * rs * gg[2 * k + 1];
        const u32 w = pk2(a, b);
        vnT[(oc * 8 + 2 * k) * 136 + j] = (u16)(w & 0xffffu);
        vnT[(oc * 8 + 2 * k + 1) * 136 + j] = (u16)(w >> 16);
      }
    }
  }
  __syncthreads();
  const u16* W = reinterpret_cast<const u16*>(p.ws + WS_SGUW) + (size_t)(l >> 1) * 65536 + (size_t)g * 16384;
  const float* bs = p.in[21 + 10 * l] + g * 128;
  u16* Y = reinterpret_cast<u16*>(p.ws + WS_H);
#pragma unroll 1
  for (int ih = 0; ih < 2; ++ih) {
    f32x4 acc[4][4];
#pragma unroll
    for (int a = 0; a < 4; ++a)
#pragma unroll
      for (int b = 0; b < 4; ++b) acc[a][b] = f32x4{0.f, 0.f, 0.f, 0.f};
#pragma unroll
    for (int ks = 0; ks < 4; ++ks) {
      bf16x8 af[4], bfr[4];
#pragma unroll
      for (int m = 0; m < 4; ++m) af[m] = ld8(W + (size_t)(ih * 64 + m * 16 + fr) * 128 + ks * 32 + fq * 8);
#pragma unroll
      for (int n = 0; n < 4; ++n) bfr[n] = ld8(vnT + (wid * 64 + n * 16 + fr) * 136 + ks * 32 + fq * 8);
#pragma unroll
      for (int m = 0; m < 4; ++m)
#pragma unroll
        for (int n = 0; n < 4; ++n) acc[m][n] = mfma16(bfr[n], af[m], acc[m][n]);
    }
#pragma unroll
    for (int m = 0; m < 4; ++m) {
      const int ii = ih * 64 + m * 16 + fr;
      const float bias = bs[ii];
      const size_t rb = (size_t)(row0 + ii) * NC;
#pragma unroll
      for (int n = 0; n < 4; ++n) {
        const int c = g * 256 + wid * 64 + n * 16 + 4 * fq;
        const u32x2 uw = *reinterpret_cast<const u32x2*>(PROJ + rb + 4096 + c);
        const u32x2 dw = *reinterpret_cast<const u32x2*>(PROJ + rb + 6144 + c);
        float y0 = bflo(uw[0]) * (acc[m][n][0] + bias) * silu(bflo(dw[0])), y1 = bfhi(uw[0]) * (acc[m][n][1] + bias) * silu(bfhi(dw[0]));
        float y2 = bflo(uw[1]) * (acc[m][n][2] + bias) * silu(bflo(dw[1])), y3 = bfhi(uw[1]) * (acc[m][n][3] + bias) * silu(bfhi(dw[1]));
        if (ZERO_MASK & 8) { y0 = y1 = y2 = y3 = 0.f; }
        *reinterpret_cast<u32x2*>(Y + (size_t)(row0 + ii) * 2048 + 1024 + c) = u32x2{pk2(y0, y1), pk2(y2, y3)};
      }
    }
  }
}

DI void phase_mix_odd(const Params& p, int l, unsigned char* lds, unsigned char* lds_all) {
#pragma unroll 1
  for (int it = blockIdx.x; it < 512; it += gridDim.x) { int bh, qb; heavy_map(it, bh, qb); na_item(p, l, true, bh, qb, lds_all); }
#pragma unroll 1
  for (int it = blockIdx.x; it < 256; it += gridDim.x) na_item(p, l, false, it, 0, lds_all);
#pragma unroll 1
  for (int it = VBID; it < 768; it += VGRID) sgu_item(p, l, it, lds);
}

#define XB_TMO      128
#define XB_XCNT(j)  (256  + 64 * (j))
#define XB_XSUB(j)  (1280 + 64 * (j))
#define XB_XGEN(j)  (2304 + 64 * (j))
#define XB_TOP      3328
#define XB_TOPGEN   3392
#define XCD_BAR_WORDS 3456
#define XB_SPIN_CAP (1u << 18)
#define LAS __attribute__((address_space(3)))
DI unsigned xb_ld(unsigned* p)              { return __hip_atomic_load(p, __ATOMIC_RELAXED, __HIP_MEMORY_SCOPE_AGENT); }
DI unsigned xb_add(unsigned* p, unsigned v) { return __hip_atomic_fetch_add(p, v, __ATOMIC_RELAXED, __HIP_MEMORY_SCOPE_AGENT); }
DI unsigned xb_xcc_id() { return (unsigned)__builtin_amdgcn_s_getreg((3 << 11) | 20) & 0xFu; }
#define XB_SPIN(cond, bar) do { unsigned _sp = 0; while (cond) { __builtin_amdgcn_s_sleep(1); \
    if ((++_sp & 255u) == 0u) { if (xb_ld(&(bar)[XB_TMO])) break; if (_sp > XB_SPIN_CAP) { atomicAdd(&(bar)[XB_TMO], 1u); break; } } } } while (0)
struct XcdBarrier { unsigned* bar; unsigned x; volatile LAS unsigned* st; };
DI XcdBarrier xcd_barrier_post(unsigned* bar, volatile LAS unsigned* st) {
  XcdBarrier b; b.bar = bar; b.x = xb_xcc_id(); b.st = st;
  if (threadIdx.x == 0) (void)xb_add(&bar[XB_XCNT(b.x)], 1u);
  return b;
}
DI void xcd_barrier_complete(unsigned* bar, unsigned x, unsigned& nloc, unsigned& nx) {
  const unsigned G = gridDim.x * gridDim.y * gridDim.z;
  unsigned sum, cnt, mine, sp = 0u;
  for (;;) {
    sum = 0u; cnt = 0u; mine = 0u;
#pragma unroll
    for (unsigned j = 0; j < 16; ++j) { const unsigned c = xb_ld(&bar[XB_XCNT(j)]); sum += c; cnt += (c > 0u) ? 1u : 0u; mine = (j == x) ? c : mine; }
    if (sum == G) break;
    __builtin_amdgcn_s_sleep(1);
    if ((++sp & 255u) == 0u) { if (xb_ld(&bar[XB_TMO])) break; if (sp > XB_SPIN_CAP) { atomicAdd(&bar[XB_TMO], 1u); break; } }
  }
  nloc = mine > 0u ? mine : 1u; nx = cnt > 0u ? cnt : 1u;
}
DI void xcd_barrier(const XcdBarrier& b) {
  asm volatile("s_waitcnt vmcnt(0)" ::: "memory");
  __syncthreads();
  if (threadIdx.x == 0) {
    unsigned* bar = b.bar;
    __builtin_amdgcn_s_waitcnt(0);
    unsigned nloc = b.st[0], nx = b.st[1];
    if (nloc == 0u) { xcd_barrier_complete(bar, b.x, nloc, nx); b.st[0] = nloc; b.st[1] = nx; }
    const unsigned old = xb_add(&bar[XB_XSUB(b.x)], 1u);
    const unsigned gen = old / nloc;
    if (old + 1u == (gen + 1u) * nloc) {
      __builtin_amdgcn_fence(__ATOMIC_RELEASE, "agent");
      asm volatile("s_waitcnt vmcnt(0)" ::: "memory");
      const unsigned og = xb_add(&bar[XB_TOP], 1u);
      const unsigned tg = og / nx;
      if (og + 1u == (tg + 1u) * nx) xb_add(&bar[XB_TOPGEN], 1u);
      else XB_SPIN(xb_ld(&bar[XB_TOPGEN]) == tg, bar);
      __builtin_amdgcn_fence(__ATOMIC_ACQUIRE, "agent");
      xb_add(&bar[XB_XGEN(b.x)], 1u);
      asm volatile("s_waitcnt vmcnt(0)" ::: "memory");
    } else {
      XB_SPIN(xb_ld(&bar[XB_XGEN(b.x)]) == gen, bar);
      __builtin_amdgcn_fence(__ATOMIC_ACQUIRE, "agent");
      asm volatile("s_waitcnt vmcnt(0)" ::: "memory");
    }
  }
  __syncthreads();
}

__global__ void __launch_bounds__(512, 2) fwd_megakernel(Params p) {
  extern __shared__ __attribute__((aligned(16))) unsigned char lds[];
  cg::grid_group grid = cg::this_grid();
  volatile LAS unsigned* xst = (volatile LAS unsigned*)(lds + LDS_BYTES - 16);
  if (threadIdx.x == 0) { xst[0] = 0u; xst[1] = 0u; }
  __syncthreads();
  const XcdBarrier xb = xcd_barrier_post(reinterpret_cast<unsigned*>(p.ws + WS_BAR), xst);
  for (int ph = p.ph_lo; ph < p.ph_hi; ++ph) {
    unsigned char* hl = lds + HALF_ID * HALF_LDS;
    if (ph == 0) phase_prep(p, hl);
    else if (ph == 1) phase_mod0(p);
    else {
      const int l = (ph - 2) >> 2, s = (ph - 2) & 3;
      if (s == 0) { if (l & 1) gemm_phase<G_IN_ODD>(p, l, lds); else gemm_phase<G_IN_EVEN>(p, l, lds); }
      else if (s == 1) { if (l & 1) phase_mix_odd(p, l, hl, lds); else phase_mix_even(p, l, hl, lds); }
      else if (s == 2) gemm_phase<G_OUT>(p, l, lds);
      else phase_ln(p, l);
    }
    if (ph + 1 < p.ph_hi) {
      if (p.ph_lo < 0) grid.sync();
      xcd_barrier(xb);
    }
  }
}

extern "C" void kernel_launch(void* const* d_in, const int* in_sizes, int n_in, void* d_out, int out_size, void* d_ws, size_t ws_size,
                              hipStream_t stream) {
  static int grid_blocks = 0;
  if (grid_blocks == 0) {
    if (n_in != 52 || ws_size < WS_END) {
      fprintf(stderr, "kernel_launch: expected 52 inputs and >= %zu bytes of workspace; got %d, %zu\n", (size_t)WS_END, n_in, ws_size);
      grid_blocks = -1;
      return;
    }
    int dev = 0, cus = 0, per_cu = 0;
    hipGetDevice(&dev);
    hipDeviceGetAttribute(&cus, hipDeviceAttributeMultiprocessorCount, dev);
    hipFuncSetAttribute((const void*)fwd_megakernel, hipFuncAttributeMaxDynamicSharedMemorySize, LDS_BYTES);
    hipOccupancyMaxActiveBlocksPerMultiprocessor(&per_cu, (const void*)fwd_megakernel, 512, LDS_BYTES);
    (void)hipGetLastError();
    grid_blocks = cus;
  }
  if (grid_blocks < 0) return;
  Params p{};
  for (int i = 0; i < 52; ++i) p.in[i] = (const float*)d_in[i];
  p.out = (float*)d_out;
  p.ws = (unsigned char*)d_ws;
#if MULTI
  for (int ph = 0; ph < NPHASE; ++ph) {
    p.ph_lo = ph; p.ph_hi = ph + 1;
    hipLaunchKernelGGL(fwd_megakernel, dim3(grid_blocks), dim3(512), LDS_BYTES, stream, p);
  }
#else
  p.ph_lo = 0; p.ph_hi = NPHASE;
  if (hipMemsetAsync((char*)d_ws + WS_BAR, 0, XCD_BAR_WORDS * 4, stream) != hipSuccess) { fprintf(stderr, "kernel_launch: memset of barrier words failed\n"); return; }
  void* args[] = {&p};
  hipError_t e = hipLaunchCooperativeKernel((const void*)fwd_megakernel, dim3(grid_blocks), dim3(512), args, LDS_BYTES, stream);
  if (e != hipSuccess) fprintf(stderr, "cooperative launch failed: %s (grid %d)\n", hipGetErrorString(e), grid_blocks);
#endif
}
```

```cpp
#include <hip/hip_runtime.h>
#include <hip/hip_cooperative_groups.h>
#include <cstdio>
namespace cg = cooperative_groups;

#define DI __device__ __forceinline__
typedef unsigned short u16;
typedef unsigned int u32;
using bf16x8 = __attribute__((ext_vector_type(8))) short;
using f32x4 = __attribute__((ext_vector_type(4))) float;
using f32x16 = __attribute__((ext_vector_type(16))) float;
using u32x4 = __attribute__((ext_vector_type(4))) unsigned;
using u32x2 = __attribute__((ext_vector_type(2))) unsigned;
typedef __bf16 bf2_t __attribute__((ext_vector_type(2)));
typedef float f2_t __attribute__((ext_vector_type(2)));

#ifndef MULTI
#define MULTI 0
#endif
#ifndef REP0
#define REP0 1
#endif
#ifndef REP1
#define REP1 1
#endif
#ifndef ZERO_MASK
#define ZERO_MASK 0
#endif

constexpr int T_ALL = 24576, TP = 8192, DM = 2048;
constexpr float LOG2E = 1.4426950408889634f;
constexpr float ALPHA = 1.6817928305074290f;
constexpr float LN_EPS = 1e-5f;
constexpr int HALF_LDS = 76288;
constexpr int LDS_BYTES = 2 * HALF_LDS + 16;
constexpr int NPHASE = 18;

constexpr size_t SZ_WIN_E = (size_t)6144 * 2048 * 2, SZ_WIN_O = (size_t)7168 * 2048 * 2;
constexpr size_t WS_WINT = 0;
constexpr size_t WS_WOUTT = WS_WINT + 2 * SZ_WIN_E + 2 * SZ_WIN_O;
constexpr size_t WS_POOLWT = WS_WOUTT + (size_t)4 * 2048 * 2048 * 2;
constexpr size_t WS_SGUW = WS_POOLWT + (size_t)2 * 4 * 256 * 256 * 2;
constexpr size_t WS_CK = WS_SGUW + (size_t)2 * 4 * 128 * 128 * 2;
constexpr size_t WS_CVT = WS_CK + (size_t)4 * 4194304;
constexpr size_t WS_MOD = WS_CVT + (size_t)4 * 4194304;
constexpr size_t WS_ROPE = WS_MOD + (size_t)4 * 5 * 6144 * 4;
constexpr size_t WS_H = WS_ROPE + 8192;
constexpr size_t WS_PROJ = WS_H + (size_t)T_ALL * 2048 * 2;
constexpr size_t WS_VT = WS_PROJ + (size_t)T_ALL * 7168 * 2;
constexpr size_t WS_BAR = WS_VT + (size_t)T_ALL * 1024 * 2;
constexpr size_t WS_STATS = WS_BAR + 16384;
constexpr size_t WS_END = WS_STATS + (size_t)T_ALL * 8;

struct Params {
  const float* in[52];
  float* out;
  unsigned char* ws;
  int ph_lo, ph_hi;
};

DI size_t ws_wint(int l) { return WS_WINT + (size_t)(l >> 1) * (SZ_WIN_E + SZ_WIN_O) + ((l & 1) ? SZ_WIN_E : 0); }

DI u32 pk2(float a, float b) { f2_t v = {a, b}; bf2_t r = __builtin_convertvector(v, bf2_t); return __builtin_bit_cast(u32, r); }
DI float bflo(u32 w) { return __uint_as_float(w << 16); }
DI float bfhi(u32 w) { return __uint_as_float(w & 0xffff0000u); }
DI float bf1(u16 w) { return __uint_as_float(((u32)w) << 16); }
DI float ex2(float x) { return __builtin_amdgcn_exp2f(x); }
DI float silu(float x) { return x / (1.f + __expf(-x)); }
DI f32x4 mfma16(bf16x8 a, bf16x8 b, f32x4 c) { return __builtin_amdgcn_mfma_f32_16x16x32_bf16(a, b, c, 0, 0, 0); }
DI f32x16 mfma32(bf16x8 a, bf16x8 b, f32x16 c) { return __builtin_amdgcn_mfma_f32_32x32x16_bf16(a, b, c, 0, 0, 0); }
DI bf16x8 ld8(const u16* p) { return *reinterpret_cast<const bf16x8*>(p); }
DI int opq(int x) { asm volatile("" : "+v"(x)); return x; }
#define TIDX (opq((int)threadIdx.x) & 255)
#define TID8 (opq((int)threadIdx.x))
#define HALF_ID (opq((int)threadIdx.x) >> 8)
#define VBID ((int)((blockIdx.x & 7u) | ((unsigned)HALF_ID << 3) | ((blockIdx.x >> 3) << 4)))
#define VGRID ((int)gridDim.x * 2)

enum { G_IN_EVEN = 0, G_IN_ODD = 1, G_OUT = 2 };

namespace pg8 {
#define PG8_LAS __attribute__((address_space(3)))
typedef unsigned short bf16_t;
typedef short bf16x8 __attribute__((ext_vector_type(8)));
typedef float f32x4 __attribute__((ext_vector_type(4)));
typedef unsigned u32x4 __attribute__((ext_vector_type(4)));
constexpr int BM = 256, BK = 64, HALF = 128, HTB = HALF * BK * 2  , STAGE_BYTES = 8 * HTB, NXCD = 8, WGM = 8;

__host__ __device__ __forceinline__ int lds_byte(int r, int c) { const int st = (r >> 4) * 2 + (c >> 5), rr = r & 15, cc = c & 31, ob = rr * 64 + cc * 2; return st * 1024 + (ob ^ (((ob >> 9) & 1) << 5)); }
__host__ __device__ __forceinline__ void stage_rc(int b, int& R, int& C) { const int st = b / 1024, sb = b % 1024, swz = sb ^ (((sb >> 9) & 1) << 5); R = (st >> 1) * 16 + swz / 64; C = (st & 1) * 32 + (swz % 64) / 2; }
__host__ __device__ __forceinline__ int perm32(int rho) { const int n = rho >> 4, i = rho & 15; return 8 * (i >> 2) + 4 * n + (i & 3); }

struct Unit { int pm, pn; };
struct Gemm { const bf16_t* A; const bf16_t* Bt; int M, N, K; };

struct StaticOrder {
    int nM, nN, nwg, G, c;
    __host__ __device__ void init(int M, int N, int G_, int c_) { nM = M / BM; nN = N / BM; nwg = nM * nN; G = G_; c = c_; }
    __host__ __device__ bool next(int i, Unit& u) const {
        const long L = (long)i * G + c; if (L >= nwg) return false;
        int wgid = (int)L; { const int q = nwg / NXCD, r = nwg % NXCD, xcd = wgid % NXCD, off = wgid / NXCD; wgid = (xcd < r ? xcd * (q + 1) : r * (q + 1) + (xcd - r) * q) + off; }
        const int nig = WGM * nN, gid = wgid / nig, fm = gid * WGM, gsz = (nM - fm) < WGM ? (nM - fm) : WGM;
        u.pm = fm + ((wgid % nig) % gsz); u.pn = (wgid % nig) / gsz; return true;
    }
    __device__ __forceinline__ void a_ready(const Unit&) const {}
    __device__ __forceinline__ void done(const Unit&) const {}
};

template <class Epi, class Sched, bool STAMP = false>
__device__ __forceinline__ void gemm_phase(PG8_LAS unsigned char* lds, const Gemm g, const Sched& S, const Epi& E, unsigned long long* stamps) {
    const int tid = opq((int)threadIdx.x), wid = __builtin_amdgcn_readfirstlane(tid >> 6), lane = tid & 63, wr = wid >> 2, wc = wid & 3, fr = lane & 15, fq = lane >> 4;
    const int K = g.K, nt = K / BK;
    int ts_lo = 0, ts_hi = 0, nts = 0; const unsigned long long rt_entry = STAMP ? (unsigned long long)wall_clock64() : 0ull;
#define PG8_STAMP() do { if (STAMP && wid == 0 && nts < 64) { const unsigned long long _c = (unsigned long long)clock64(); \
        ts_lo = (lane == nts) ? (int)(unsigned)_c : ts_lo; ts_hi = (lane == nts) ? (int)(unsigned)(_c >> 32) : ts_hi; ++nts; } } while (0)
    PG8_STAMP();
    unsigned voffA[2], voffB[2];
#pragma unroll
    for (int i = 0; i < 2; ++i) { int R, C; stage_rc(tid * 16 + i * 8192, R, C); const int Rb = Epi::PERM ? ((R & ~31) + perm32(R & 31)) : R;
        voffA[i] = (unsigned)(R * K + C) * 2u; voffB[i] = (unsigned)(Rb * K + C) * 2u; }
    const size_t kstep = (size_t)(BK * 2);
    const size_t hstep = (size_t)HALF * K * 2;
    const size_t tstep = 2 * hstep;
    const unsigned ldsw = (unsigned)wid * 1024u;
    const int aoff = lds_byte(wr * 64 + fr, fq * 8), boff = lds_byte(wc * 32 + fr, fq * 8);
#define PG8_SA(b, h) (((b) * 2 + (h)) * HTB)
#define PG8_SB(b, h) ((4 + (b) * 2 + (h)) * HTB)
#define PG8_STAGE(bufoff, gbase, voff) do { _Pragma("unroll") for (int _i = 0; _i < 2; ++_i) \
        __builtin_amdgcn_global_load_lds((const unsigned*)((const char*)(gbase) + (voff)[_i]), (PG8_LAS unsigned*)(lds + (bufoff) + ldsw + _i * 8192), 16, 0, 0); } while (0)
#define PG8_LDA(dst, b, h) do { _Pragma("unroll") for (int m = 0; m < 4; ++m) _Pragma("unroll") for (int k = 0; k < 2; ++k) dst[m][k] = *(const PG8_LAS bf16x8*)(lds + PG8_SA(b, h) + aoff + m * 2048 + k * 1024); } while (0)
#define PG8_LDB(dst, b, h) do { _Pragma("unroll") for (int n = 0; n < 2; ++n) _Pragma("unroll") for (int k = 0; k < 2; ++k) dst[n][k] = *(const PG8_LAS bf16x8*)(lds + PG8_SB(b, h) + boff + n * 2048 + k * 1024); } while (0)
#define PG8_MMA(ai, bj, At, Bt) do { __builtin_amdgcn_s_setprio(1); _Pragma("unroll") for (int m = 0; m < 4; ++m) _Pragma("unroll") for (int n = 0; n < 2; ++n) _Pragma("unroll") for (int k = 0; k < 2; ++k) \
        acc[ai][bj][m][n] = __builtin_amdgcn_mfma_f32_16x16x32_bf16(Bt[n][k], At[m][k], acc[ai][bj][m][n], 0, 0, 0); __builtin_amdgcn_s_setprio(0); } while (0)
#define PG8_WAIT_V(n) asm volatile("s_waitcnt vmcnt(" #n ")" ::: "memory")
#define PG8_WAIT_L(n) asm volatile("s_waitcnt lgkmcnt(" #n ")" ::: "memory")
#define PG8_BAR __builtin_amdgcn_s_barrier()
#define PG8_SCHED __builtin_amdgcn_sched_barrier(0)
    Unit cur, nxt; int ui = 0;
    if (!S.next(0, cur)) return;
    f32x4 acc[2][2][4][2];
#pragma unroll
    for (int a = 0; a < 2; ++a)
#pragma unroll
        for (int b = 0; b < 2; ++b)
#pragma unroll
            for (int m = 0; m < 4; ++m)
#pragma unroll
                for (int n = 0; n < 2; ++n) acc[a][b][m][n] = (f32x4){0.f, 0.f, 0.f, 0.f};
    bf16x8 At[4][2], B0[2][2], B1[2][2];
    const char* cA = (const char*)g.A + (size_t)cur.pm * tstep; const char* cB = (const char*)g.Bt + (size_t)cur.pn * tstep;
    S.a_ready(cur);
    PG8_STAGE(PG8_SB(0, 0), cB, voffB); PG8_STAGE(PG8_SA(0, 0), cA, voffA); PG8_STAGE(PG8_SB(0, 1), cB + hstep, voffB); PG8_STAGE(PG8_SA(0, 1), cA + hstep, voffA);
    if (wr == 1) PG8_BAR;
    PG8_WAIT_V(4); PG8_BAR;
    PG8_STAGE(PG8_SB(1, 0), cB + kstep, voffB); PG8_STAGE(PG8_SA(1, 0), cA + kstep, voffA); PG8_STAGE(PG8_SB(1, 1), cB + hstep + kstep, voffB);
    PG8_WAIT_V(6); PG8_BAR;
    PG8_STAMP();
    for (;;) {
        const bool has_next = S.next(ui + 1, nxt);
        const char* nA = has_next ? (const char*)g.A + (size_t)nxt.pm * tstep : cA; const char* nB = has_next ? (const char*)g.Bt + (size_t)nxt.pn * tstep : cB;
        for (int t = 0; t < nt; t += 2) {
            const bool last = (t == nt - 2);
            const char* a1 = cA + (size_t)(t + 1) * kstep;
            const char* a2 = last ? nA : cA + (size_t)(t + 2) * kstep; const char* b2 = last ? nB : cB + (size_t)(t + 2) * kstep;
            const char* a3 = a2 + kstep; const char* b3 = b2 + kstep;
            if (last && has_next) S.a_ready(nxt);
            PG8_LDB(B0, 0, 0); PG8_SCHED; PG8_LDA(At, 0, 0); PG8_STAGE(PG8_SA(1, 1), a1 + hstep, voffA);
            PG8_WAIT_L(8); PG8_BAR; PG8_WAIT_L(0); PG8_MMA(0, 0, At, B0); PG8_BAR; PG8_SCHED;
            PG8_LDB(B1, 0, 1); PG8_STAGE(PG8_SB(0, 0), b2, voffB);
            PG8_BAR; PG8_WAIT_L(0); PG8_MMA(0, 1, At, B1); PG8_BAR;
            PG8_LDA(At, 0, 1); PG8_STAGE(PG8_SA(0, 0), a2, voffA);
            PG8_BAR; PG8_WAIT_L(0); PG8_MMA(1, 0, At, B0); PG8_BAR; PG8_SCHED;
            PG8_STAGE(PG8_SB(0, 1), b2 + hstep, voffB);
            PG8_WAIT_V(6); PG8_BAR; PG8_MMA(1, 1, At, B1); PG8_BAR;
            PG8_LDB(B0, 1, 0); PG8_SCHED; PG8_LDA(At, 1, 0); PG8_STAGE(PG8_SA(0, 1), a2 + hstep, voffA);
            PG8_WAIT_L(8); PG8_BAR; PG8_WAIT_L(0); PG8_MMA(0, 0, At, B0); PG8_BAR; PG8_SCHED;
            PG8_LDB(B1, 1, 1); PG8_STAGE(PG8_SB(1, 0), b3, voffB);
            PG8_BAR; PG8_WAIT_L(0); PG8_MMA(0, 1, At, B1); PG8_BAR;
            PG8_LDA(At, 1, 1); PG8_STAGE(PG8_SA(1, 0), a3, voffA);
            PG8_BAR; PG8_WAIT_L(0); PG8_MMA(1, 0, At, B0); PG8_BAR; PG8_SCHED;
            PG8_STAGE(PG8_SB(1, 1), b3 + hstep, voffB);
            PG8_WAIT_V(6); PG8_BAR; PG8_MMA(1, 1, At, B1); PG8_BAR;
        }
        PG8_STAMP();
        if constexpr (!Epi::AFTER_DRAIN) { E(acc, cur, wr, wc, fr, fq); S.done(cur); }
        PG8_STAMP();
        if (!has_next) break;
#pragma unroll
        for (int a = 0; a < 2; ++a)
#pragma unroll
            for (int b = 0; b < 2; ++b)
#pragma unroll
                for (int m = 0; m < 4; ++m)
#pragma unroll
                    for (int n = 0; n < 2; ++n) acc[a][b][m][n] = (f32x4){0.f, 0.f, 0.f, 0.f};
        cur = nxt; cA = nA; cB = nB; ++ui;
    }
    PG8_WAIT_V(0);
    if (wr == 0) PG8_BAR;
    PG8_BAR;
    if constexpr (Epi::AFTER_DRAIN) { E.fused(acc, cur, wr, wc, fr, fq, lds, wid, lane); S.done(cur); }
    PG8_STAMP();
    if (STAMP && wid == 0) { stamps[lane] = lane < nts ? (((unsigned long long)(unsigned)ts_hi << 32) | (unsigned)ts_lo) : 0ull;
        if (lane == 62) stamps[62] = rt_entry; if (lane == 63) stamps[63] = (unsigned long long)wall_clock64(); }
#undef PG8_STAMP
#undef PG8_SA
#undef PG8_SB
#undef PG8_STAGE
#undef PG8_LDA
#undef PG8_LDB
#undef PG8_MMA
#undef PG8_WAIT_V
#undef PG8_WAIT_L
#undef PG8_BAR
#undef PG8_SCHED
}
}

DI void tr_tile(const float* __restrict__ src, size_t ld_src, u16* __restrict__ dst, size_t ld_dst, float* sT) {
  const int tid = TIDX;
  const int r = tid >> 4, c4 = (tid & 15) * 4;
#pragma unroll
  for (int i = 0; i < 4; ++i) {
    float4 v = *reinterpret_cast<const float4*>(src + (size_t)(r + 16 * i) * ld_src + c4);
    float* d = sT + (r + 16 * i) * 65 + c4;
    d[0] = v.x; d[1] = v.y; d[2] = v.z; d[3] = v.w;
  }
  __syncthreads();
  const int n = tid >> 2, ks = (tid & 3) * 16;
  u32 w[8];
#pragma unroll
  for (int j = 0; j < 8; ++j) w[j] = pk2(sT[(ks + 2 * j) * 65 + n], sT[(ks + 2 * j + 1) * 65 + n]);
  u32x4* o = reinterpret_cast<u32x4*>(dst + (size_t)n * ld_dst + ks);
  o[0] = u32x4{w[0], w[1], w[2], w[3]};
  o[1] = u32x4{w[4], w[5], w[6], w[7]};
  __syncthreads();
}

DI void cvt8(const float* __restrict__ src, u16* __restrict__ dst) {
  float4 a = *reinterpret_cast<const float4*>(src);
  float4 b = *reinterpret_cast<const float4*>(src + 4);
  *reinterpret_cast<u32x4*>(dst) = u32x4{pk2(a.x, a.y), pk2(a.z, a.w), pk2(b.x, b.y), pk2(b.z, b.w)};
}

DI void mod_item(const Params& p, int i, unsigned char* lds) {
  const int tid = TIDX;
  const int l = i / 96, n0 = (i % 96) * 64;
  float* sS = reinterpret_cast<float*>(lds);
  float* red = sS + 5 * 2048;
  const float* c = p.in[10];
  const float* cctx = p.in[11];
  for (int e = tid; e < 5 * 2048; e += 256) {
    int v = e >> 11, k = e & 2047;
    float x = (v == 0) ? cctx[k] : c[(v - 1) * 2048 + k];
    sS[e] = silu(x);
  }
  __syncthreads();
  const int kk = tid >> 4, c4 = (tid & 15) * 4;
  const float* W = p.in[12 + 10 * l] + n0 + c4;
  f32x4 acc[5];
#pragma unroll
  for (int v = 0; v < 5; ++v) acc[v] = f32x4{0.f, 0.f, 0.f, 0.f};
#pragma unroll 8
  for (int k = kk; k < 2048; k += 16) {
    float4 w = *reinterpret_cast<const float4*>(W + (size_t)k * 6144);
#pragma unroll
    for (int v = 0; v < 5; ++v) {
      float s = sS[v * 2048 + k];
      acc[v][0] += s * w.x; acc[v][1] += s * w.y; acc[v][2] += s * w.z; acc[v][3] += s * w.w;
    }
  }
#pragma unroll
  for (int v = 0; v < 5; ++v)
#pragma unroll
    for (int q = 0; q < 4; ++q) red[(kk * 5 + v) * 64 + c4 + q] = acc[v][q];
  __syncthreads();
  for (int t2 = tid; t2 < 320; t2 += 256) {
    int v = t2 >> 6, n = t2 & 63;
    float s = 0.f;
#pragma unroll
    for (int k2 = 0; k2 < 16; ++k2) s += red[(k2 * 5 + v) * 64 + n];
    float* mod = reinterpret_cast<float*>(p.ws + WS_MOD);
    mod[(size_t)(l * 5 + v) * 6144 + n0 + n] = s + p.in[13 + 10 * l][n0 + n];
  }
  __syncthreads();
}

DI void phase_prep(const Params& p, unsigned char* lds) {
  constexpr int N_MOD = 384, N_TRWIN = 13312, N_TRWOUT = 4096, N_TRPOOL = 128, N_SGU = 64, N_CK = 4096, N_CV = 2048;
  constexpr int TOTAL = N_MOD + N_TRWIN + N_TRWOUT + N_TRPOOL + N_SGU + N_CK + N_CV + 1;
  const int tid = TIDX;
  float* sT = reinterpret_cast<float*>(lds);
  for (int it = VBID; it < TOTAL; it += VGRID) {
    int i = it;
    if (i < N_MOD) { mod_item(p, i, lds); continue; }
    i -= N_MOD;
    if (i < N_TRWIN) {
      int l, base;
      if (i < 3072) { l = 0; base = 0; } else if (i < 6656) { l = 1; base = 3072; } else if (i < 9728) { l = 2; base = 6656; } else { l = 3; base = 9728; }
      i -= base;
      const int N = (l & 1) ? 7168 : 6144, nN = N / 64;
      const int kt = i / nN, nt = i % nN;
      tr_tile(p.in[14 + 10 * l] + (size_t)kt * 64 * N + nt * 64, N,
              reinterpret_cast<u16*>(p.ws + ws_wint(l)) + (size_t)nt * 64 * 2048 + kt * 64, 2048, sT);
      continue;
    }
    i -= N_TRWIN;
    if (i < N_TRWOUT) {
      const int l = i >> 10, r = i & 1023, kt = r >> 5, nt = r & 31;
      tr_tile(p.in[15 + 10 * l] + (size_t)kt * 64 * 2048 + nt * 64, 2048,
              reinterpret_cast<u16*>(p.ws + WS_WOUTT) + (size_t)l * 2048 * 2048 + (size_t)nt * 64 * 2048 + kt * 64, 2048, sT);
      continue;
    }
    i -= N_TRWOUT;
    if (i < N_TRPOOL) {
      const int e = i >> 6, r = i & 63, g = r >> 4, t = r & 15, kt = t >> 2, nt = t & 3;
      tr_tile(p.in[18 + 20 * e] + (size_t)g * 65536 + kt * 64 * 256 + nt * 64, 256,
              reinterpret_cast<u16*>(p.ws + WS_POOLWT) + (size_t)e * 262144 + g * 65536 + nt * 64 * 256 + kt * 64, 256, sT);
      continue;
    }
    i -= N_TRPOOL;
    if (i < N_SGU) {
      const int e = i >> 5, ch = i & 31;
      const size_t off = (size_t)ch * 2048 + tid * 8;
      cvt8(p.in[30 + 20 * e] + off, reinterpret_cast<u16*>(p.ws + WS_SGUW) + (size_t)e * 65536 + off);
      continue;
    }
    i -= N_SGU;
    if (i < N_CK) {
      const int l = i >> 10, ch = i & 1023;
      const size_t off = (size_t)ch * 2048 + tid * 8;
      cvt8(p.in[2 + 2 * l] + off, reinterpret_cast<u16*>(p.ws + WS_CK) + (size_t)l * 2097152 + off);
      continue;
    }
    i -= N_CK;
    if (i < N_CV) {
      const int l = i >> 9, r = i & 511, bh = r >> 4, t = r & 15, kt = t >> 1, nt = t & 1;
      tr_tile(p.in[3 + 2 * l] + (size_t)bh * 65536 + kt * 64 * 128 + nt * 64, 128,
              reinterpret_cast<u16*>(p.ws + WS_CVT) + (size_t)l * 2097152 + (size_t)bh * 65536 + nt * 64 * 512 + kt * 64, 512, sT);
      continue;
    }
    {
      float* rc = reinterpret_cast<float*>(p.ws + WS_ROPE);
      for (int e = tid; e < 1024; e += 256) {
        int pos = e >> 4, fi = e & 15;
        float inv = 1.0f / powf(10000.0f, (float)(2 * fi) / 32.0f);
        float ang = (float)pos * inv;
        rc[e] = cosf(ang);
        rc[1024 + e] = sinf(ang);
      }
    }
  }
}

DI void phase_mod0(const Params& p) {
  const int tid = TIDX;
  const float* mod = reinterpret_cast<const float*>(p.ws + WS_MOD);
  u16* H = reinterpret_cast<u16*>(p.ws + WS_H);
  for (int it = VBID; it < T_ALL / 4; it += VGRID) {
#pragma unroll
    for (int rr = 0; rr < 4; ++rr) {
      const int row = it * 4 + rr;
      const int cond = row < TP ? 0 : 1 + ((row - TP) >> 12);
      const float* src = row < TP ? p.in[0] + (size_t)row * 2048 : p.in[1] + (size_t)(row - TP) * 2048;
      const int e = tid * 8;
      const float* sh = mod + (size_t)cond * 6144 + e;
      float4 a = *reinterpret_cast<const float4*>(src + e), b = *reinterpret_cast<const float4*>(src + e + 4);
      float4 s0 = *reinterpret_cast<const float4*>(sh), s1 = *reinterpret_cast<const float4*>(sh + 4);
      float4 c0 = *reinterpret_cast<const float4*>(sh + 2048), c1 = *reinterpret_cast<const float4*>(sh + 2052);
      u32x4 o = {pk2(a.x * (1.f + c0.x) + s0.x, a.y * (1.f + c0.y) + s0.y), pk2(a.z * (1.f + c0.z) + s0.z, a.w * (1.f + c0.w) + s0.w),
                 pk2(b.x * (1.f + c1.x) + s1.x, b.y * (1.f + c1.y) + s1.y), pk2(b.z * (1.f + c1.z) + s1.z, b.w * (1.f + c1.w) + s1.w)};
      *reinterpret_cast<u32x4*>(H + (size_t)row * 2048 + e) = o;
    }
  }
}


template <int MODE>
struct EpiIn {
  static constexpr bool PERM = false, AFTER_DRAIN = false;
  u16* PROJ; u16* VT; float* kout; float* vout; const float* ropeC; const float* ropeS;
  DI void operator()(const f32x4 (&acc)[2][2][4][2], const pg8::Unit& u, int wr, int wc, int fr, int fq) const {
    constexpr int NC = (MODE == G_IN_EVEN) ? 6144 : 7168;
    constexpr int SEC_Q = (MODE == G_IN_EVEN) ? 2 : 0, SEC_K = (MODE == G_IN_EVEN) ? 3 : 1, SEC_V = (MODE == G_IN_EVEN) ? 4 : 2;
    const int sec = u.pn >> 2;
    const bool prompt = u.pm < 32;
    const bool isq = sec == SEC_Q, isk = sec == SEC_K;
    const bool rope = (MODE == G_IN_EVEN) && (isq || isk) && !prompt;
    const float sc = isq ? ((MODE == G_IN_EVEN) ? 0.125f * LOG2E : 0.08838834764831845f * LOG2E) : 1.0f;
#pragma unroll
    for (int ai = 0; ai < 2; ++ai)
#pragma unroll
      for (int m = 0; m < 4; ++m) {
        const int row = u.pm * 256 + ai * 128 + wr * 64 + m * 16 + fr;
        int b, t;
        if (prompt) { b = row >> 8; t = row & 255; } else { const int rs = row - TP; b = rs >> 12; t = rs & 4095; }
#pragma unroll
        for (int bj = 0; bj < 2; ++bj) {
          const int hh = (u.pn & 3) * 2 + bj;
          const int d0 = wc * 32 + 4 * fq;
          if (sec == SEC_V) {
#pragma unroll
            for (int n = 0; n < 2; ++n) {
              const f32x4 v = acc[ai][bj][m][n];
              const int dv = d0 + 16 * n;
              const u32 w01 = pk2(v[0], v[1]), w23 = pk2(v[2], v[3]);
              if (prompt) {
                u16* vt = VT + ((size_t)((b * 8 + hh) * 128 + dv)) * 256 + t;
                vt[0] = (u16)(w01 & 0xffffu); vt[256] = (u16)(w01 >> 16); vt[512] = (u16)(w23 & 0xffffu); vt[768] = (u16)(w23 >> 16);
                *reinterpret_cast<float4*>(vout + ((size_t)((b * 8 + hh) * 256 + t)) * 128 + dv) = float4{v[0], v[1], v[2], v[3]};
              } else {
                u16* vt = VT + 8388608 + ((size_t)((b * 8 + hh) * 128 + dv)) * 4096 + t;
                vt[0] = (u16)(w01 & 0xffffu); vt[4096] = (u16)(w01 >> 16); vt[8192] = (u16)(w23 & 0xffffu); vt[12288] = (u16)(w23 >> 16);
              }
            }
          } else {
            f32x4 v0 = acc[ai][bj][m][0], v1 = acc[ai][bj][m][1];
            if (isk && prompt) {
              float* ko = kout + ((size_t)((b * 8 + hh) * 256 + t)) * 128 + d0;
              *reinterpret_cast<float4*>(ko) = float4{v0[0], v0[1], v0[2], v0[3]};
              *reinterpret_cast<float4*>(ko + 16) = float4{v1[0], v1[1], v1[2], v1[3]};
            }
            if (rope) {
              const int pos = (wc & 1) ? (t & 63) : (t >> 6);
              const float4 cs = *reinterpret_cast<const float4*>(ropeC + pos * 16 + 4 * fq);
              const float4 sn = *reinterpret_cast<const float4*>(ropeS + pos * 16 + 4 * fq);
              const float c4[4] = {cs.x, cs.y, cs.z, cs.w}, s4[4] = {sn.x, sn.y, sn.z, sn.w};
#pragma unroll
              for (int j = 0; j < 4; ++j) {
                const float x1 = v0[j], x2 = v1[j];
                v0[j] = x1 * c4[j] - x2 * s4[j];
                v1[j] = x1 * s4[j] + x2 * c4[j];
              }
            }
            u16* dst = PROJ + (size_t)row * NC + u.pn * 256 + bj * 128 + d0;
            *reinterpret_cast<u32x2*>(dst) = u32x2{pk2(v0[0] * sc, v0[1] * sc), pk2(v0[2] * sc, v0[3] * sc)};
            *reinterpret_cast<u32x2*>(dst + 16) = u32x2{pk2(v1[0] * sc, v1[1] * sc), pk2(v1[2] * sc, v1[3] * sc)};
          }
        }
      }
  }
};

struct EpiOut {
  static constexpr bool PERM = false, AFTER_DRAIN = false;
  float* X; const float* x0; const float* x1; const float* mod; const float* lng; const float* lnb; const float2* stats; int l;
  DI void operator()(const f32x4 (&acc)[2][2][4][2], const pg8::Unit& u, int wr, int wc, int fr, int fq) const {
    const bool prompt = u.pm < 32;
    const int cond = prompt ? 0 : 1 + ((u.pm * 256 - TP) >> 12);
    const float* gate = mod + (size_t)(l * 5 + cond) * 6144 + 4096;
    const int col0 = u.pn * 256 + wc * 32 + 4 * fq;
    const int row0 = u.pm * 256 + wr * 64 + fr;
    u16* Xb = reinterpret_cast<u16*>(X);
    if (l != 0) {
      u32x2 zr[2][4][2][2];
      float2 st[2][4];
#pragma unroll
      for (int ai = 0; ai < 2; ++ai)
#pragma unroll
        for (int m = 0; m < 4; ++m) {
          const int row = row0 + ai * 128 + m * 16;
          st[ai][m] = stats[row];
#pragma unroll
          for (int bj = 0; bj < 2; ++bj)
#pragma unroll
            for (int n = 0; n < 2; ++n) zr[ai][m][bj][n] = *reinterpret_cast<const u32x2*>(Xb + (size_t)row * 4096 + col0 + bj * 128 + 16 * n);
        }
#pragma unroll
      for (int bj = 0; bj < 2; ++bj)
#pragma unroll
        for (int n = 0; n < 2; ++n) {
          const int col = col0 + bj * 128 + 16 * n;
          const float4 g4 = *reinterpret_cast<const float4*>(gate + col);
          const float4 lg = *reinterpret_cast<const float4*>(lng + col), lb = *reinterpret_cast<const float4*>(lnb + col);
#pragma unroll
          for (int ai = 0; ai < 2; ++ai)
#pragma unroll
            for (int m = 0; m < 4; ++m) {
              const int row = row0 + ai * 128 + m * 16;
              const u32x2 zw = zr[ai][m][bj][n];
              const float mu = st[ai][m].x, rs = st[ai][m].y;
              const float x_0 = (bflo(zw[0]) - mu) * rs * lg.x + lb.x, x_1 = (bfhi(zw[0]) - mu) * rs * lg.y + lb.y;
              const float x_2 = (bflo(zw[1]) - mu) * rs * lg.z + lb.z, x_3 = (bfhi(zw[1]) - mu) * rs * lg.w + lb.w;
              const f32x4 a = acc[ai][bj][m][n];
              *reinterpret_cast<u32x2*>(Xb + (size_t)row * 4096 + col) =
                  u32x2{pk2(ALPHA * x_0 + g4.x * a[0], ALPHA * x_1 + g4.y * a[1]), pk2(ALPHA * x_2 + g4.z * a[2], ALPHA * x_3 + g4.w * a[3])};
            }
        }
    } else {
#pragma unroll
      for (int bj = 0; bj < 2; ++bj)
#pragma unroll
        for (int n = 0; n < 2; ++n) {
          const int col = col0 + bj * 128 + 16 * n;
          const float4 g4 = *reinterpret_cast<const float4*>(gate + col);
#pragma unroll
          for (int ai = 0; ai < 2; ++ai)
#pragma unroll
            for (int m = 0; m < 4; ++m) {
              const int row = row0 + ai * 128 + m * 16;
              const float4 xo = prompt ? *reinterpret_cast<const float4*>(x0 + (size_t)row * 2048 + col)
                                       : *reinterpret_cast<const float4*>(x1 + (size_t)(row - TP) * 2048 + col);
              const f32x4 a = acc[ai][bj][m][n];
              *reinterpret_cast<u32x2*>(Xb + (size_t)row * 4096 + col) =
                  u32x2{pk2(ALPHA * xo.x + g4.x * a[0], ALPHA * xo.y + g4.y * a[1]), pk2(ALPHA * xo.z + g4.z * a[2], ALPHA * xo.w + g4.w * a[3])};
            }
        }
    }
  }
};

template <int MODE>
DI void gemm_phase(const Params& p, int l, unsigned char* lds) {
  constexpr int N = (MODE == G_OUT) ? 2048 : (MODE == G_IN_EVEN ? 6144 : 7168);
  pg8::Gemm g;
  g.A = reinterpret_cast<const u16*>(p.ws + WS_H);
  g.Bt = (MODE == G_OUT) ? reinterpret_cast<const u16*>(p.ws + WS_WOUTT) + (size_t)l * 2048 * 2048
                         : reinterpret_cast<const u16*>(p.ws + ws_wint(l));
  g.M = T_ALL; g.N = N; g.K = 2048;
  pg8::StaticOrder S;
  S.init(T_ALL, N, (int)gridDim.x, (int)blockIdx.x);
  PG8_LAS unsigned char* l3 = (PG8_LAS unsigned char*)lds;
  if constexpr (MODE == G_OUT) {
    EpiOut E;
    E.X = p.out; E.x0 = p.in[0]; E.x1 = p.in[1]; E.mod = reinterpret_cast<const float*>(p.ws + WS_MOD); E.l = l;
    E.lng = p.in[16 + 10 * (l > 0 ? l - 1 : 0)]; E.lnb = p.in[17 + 10 * (l > 0 ? l - 1 : 0)];
    E.stats = reinterpret_cast<const float2*>(p.ws + WS_STATS);
    pg8::gemm_phase<EpiOut, pg8::StaticOrder, false>(l3, g, S, E, nullptr);
  } else {
    EpiIn<MODE> E;
    E.PROJ = reinterpret_cast<u16*>(p.ws + WS_PROJ); E.VT = reinterpret_cast<u16*>(p.ws + WS_VT);
    E.kout = p.out + (size_t)T_ALL * 2048 + (size_t)(2 * l) * 8388608;
    E.vout = p.out + (size_t)T_ALL * 2048 + (size_t)(2 * l + 1) * 8388608;
    E.ropeC = reinterpret_cast<const float*>(p.ws + WS_ROPE); E.ropeS = E.ropeC + 1024;
    pg8::gemm_phase<EpiIn<MODE>, pg8::StaticOrder, false>(l3, g, S, E, nullptr);
  }
}

DI void phase_ln(const Params& p, int l) {
  const int tid_ = TIDX, lane = tid_ & 63, wid = tid_ >> 6;
  const float* g = p.in[16 + 10 * l];
  const float* bb = p.in[17 + 10 * l];
  const float* mod = reinterpret_cast<const float*>(p.ws + WS_MOD);
  u16* H = reinterpret_cast<u16*>(p.ws + WS_H);
  float* X = p.out;
  for (int it = VBID; it < T_ALL / 4; it += VGRID) {
    const int row = it * 4 + wid;
    float* xr = X + (size_t)row * 2048;
    const u16* zr = reinterpret_cast<const u16*>(xr);
    float4 v[8];
    float s = 0.f;
#pragma unroll
    for (int i = 0; i < 8; ++i) {
      const u32x2 w = *reinterpret_cast<const u32x2*>(zr + (i * 64 + lane) * 4);
      v[i] = float4{bflo(w[0]), bfhi(w[0]), bflo(w[1]), bfhi(w[1])};
      s += v[i].x + v[i].y + v[i].z + v[i].w;
    }
#pragma unroll
    for (int o = 32; o >= 1; o >>= 1) s += __shfl_xor(s, o);
    const float mu = s * (1.f / 2048.f);
    float ss = 0.f;
#pragma unroll
    for (int i = 0; i < 8; ++i) {
      float a = v[i].x - mu, b = v[i].y - mu, c = v[i].z - mu, d = v[i].w - mu;
      ss += a * a + b * b + c * c + d * d;
    }
#pragma unroll
    for (int o = 32; o >= 1; o >>= 1) ss += __shfl_xor(ss, o);
    const float rstd = rsqrtf(ss * (1.f / 2048.f) + LN_EPS);
    if (lane == 0) *reinterpret_cast<float2*>(p.ws + WS_STATS + (size_t)row * 8) = float2{mu, rstd};
    const int cond = row < TP ? 0 : 1 + ((row - TP) >> 12);
    const float* sh = mod + (size_t)((l + 1) * 5 + cond) * 6144;
#pragma unroll
    for (int i = 0; i < 8; ++i) {
      const int e = (i * 64 + lane) * 4;
      float4 gg = *reinterpret_cast<const float4*>(g + e), b4 = *reinterpret_cast<const float4*>(bb + e);
      float4 y;
      y.x = (v[i].x - mu) * rstd * gg.x + b4.x; y.y = (v[i].y - mu) * rstd * gg.y + b4.y;
      y.z = (v[i].z - mu) * rstd * gg.z + b4.z; y.w = (v[i].w - mu) * rstd * gg.w + b4.w;
      if (l == 3) *reinterpret_cast<float4*>(xr + e) = y;
      if (l < 3) {
        float4 s0 = *reinterpret_cast<const float4*>(sh + e), c0 = *reinterpret_cast<const float4*>(sh + 2048 + e);
        u32x2 o = {pk2(y.x * (1.f + c0.x) + s0.x, y.y * (1.f + c0.y) + s0.y), pk2(y.z * (1.f + c0.z) + s0.z, y.w * (1.f + c0.w) + s0.w)};
        *reinterpret_cast<u32x2*>(H + (size_t)row * 2048 + e) = o;
      }
    }
  }
}

struct AttnSrc {
  const u16* k0; const u16* vt0; int ks0, vs0, n0;
  const u16* k1; const u16* vt1; int ks1, vs1, n1;
};

template <int DQK>
DI void attn_ldg(const AttnSrc& s, int j, u32x4 (&rk)[DQK / 64], u32x4 (&rv)[2]) {
  const u16* kb; const u16* vb; int ks, vs;
  if (j < s.n0) { kb = s.k0 + (size_t)j * 64 * s.ks0; vb = s.vt0 + j * 64; ks = s.ks0; vs = s.vs0; }
  else { const int jj = j - s.n0; kb = s.k1 + (size_t)jj * 64 * s.ks1; vb = s.vt1 + jj * 64; ks = s.ks1; vs = s.vs1; }
  constexpr int CPR = DQK / 8;
  const int tid = TID8;
#pragma unroll
  for (int i = 0; i < DQK / 64; ++i) {
    const int c = tid + 512 * i, row = c / CPR, kc = c % CPR;
    rk[i] = *reinterpret_cast<const u32x4*>(kb + (size_t)row * ks + kc * 8);
  }
#pragma unroll
  for (int i = 0; i < 2; ++i) {
    const int c = tid + 512 * i, row = c >> 3, kc = c & 7;
    rv[i] = *reinterpret_cast<const u32x4*>(vb + (size_t)row * vs + kc * 8);
  }
}
template <int DQK>
DI void attn_sts(u16* sK, u16* sVT, const u32x4 (&rk)[DQK / 64], const u32x4 (&rv)[2]) {
  constexpr int CPR = DQK / 8;
  const int tid = TID8;
#pragma unroll
  for (int i = 0; i < DQK / 64; ++i) {
    const int c = tid + 512 * i, row = c / CPR, kc = c % CPR;
    *reinterpret_cast<u32x4*>(sK + row * (DQK + 8) + kc * 8) = rk[i];
  }
#pragma unroll
  for (int i = 0; i < 2; ++i) {
    const int c = tid + 512 * i, row = c >> 3, kc = c & 7;
    *reinterpret_cast<u32x4*>(sVT + row * 72 + kc * 8) = rv[i];
  }
}

DI void attn_pv(const f32x16 (&s)[2], const u16* vw, f32x16 (&O)[4]) {
  __builtin_amdgcn_s_setprio(1);
#pragma unroll
  for (int s4 = 0; s4 < 4; ++s4) {
    const int t = s4 >> 1, b0 = (s4 & 1) * 8;
    u32x4 w = {pk2(s[t][b0], s[t][b0 + 1]), pk2(s[t][b0 + 2], s[t][b0 + 3]), pk2(s[t][b0 + 4], s[t][b0 + 5]), pk2(s[t][b0 + 6], s[t][b0 + 7])};
    const bf16x8 pf = __builtin_bit_cast(bf16x8, w);
#pragma unroll
    for (int d = 0; d < 4; ++d) {
      bf16x8 a = ld8(vw + d * 32 * 72 + s4 * 16);
      O[d] = mfma32(a, pf, O[d]);
    }
  }
  __builtin_amdgcn_s_setprio(0);
}

template <int DQK, bool NA>
DI void attn_run(const AttnSrc& src, const u16* qblk, int qstride, u16* sQ, u16* sK, u16* sVT, f32x16 (&O)[4], float& l_out,
                 int qr, int qc, int rsmin, const float* sBias) {
  const int tid = TID8, lane = tid & 63, wid = tid >> 6;
  const int r = lane & 31, h = lane >> 5;
  const int pr = (r & 0x13) | ((r & 4) << 1) | ((r & 8) >> 1);
  constexpr int CPR = DQK / 8, QS = DQK + 8;
  __syncthreads();
  constexpr bool QREG = (DQK == 64);
  bf16x8 qf[QREG ? DQK / 16 : 1];
  if constexpr (QREG) {
#pragma unroll
    for (int ks = 0; ks < DQK / 16; ++ks) qf[ks] = ld8(qblk + (size_t)(wid * 32 + r) * qstride + ks * 16 + 8 * h);
  } else {
#pragma unroll
    for (int i = 0; i < DQK / 16; ++i) {
      const int c = tid + 512 * i, row = c / CPR, kc = c % CPR;
      *reinterpret_cast<u32x4*>(sQ + row * QS + kc * 8) = *reinterpret_cast<const u32x4*>(qblk + (size_t)row * qstride + kc * 8);
    }
  }
#pragma unroll
  for (int d = 0; d < 4; ++d)
#pragma unroll
    for (int i = 0; i < 16; ++i) O[d][i] = 0.f;
  float m = -1e30f, l = 0.f;
  const int nt = src.n0 + src.n1;
  const int rsq = min(max(qr - 4, 0), 56);
  const int cs = min(max(qc - 8, 0), 48);
  const u16* qw = sQ + (wid * 32 + r) * QS + 8 * h;
  u16* sVT1 = sVT + 128 * 72 + 2048;
  const bool grpB = wid >= 4;
  bool pend = false;
  f32x16 s[2];
  u32x4 rk[DQK / 64], rv[2];
  attn_ldg<DQK>(src, 0, rk, rv);
  constexpr bool SB = QREG;
  u16* sKb1 = sQ + 16384;
  int vi = 0;
  if constexpr (SB) {
    attn_sts<DQK>(sK, sVT, rk, rv);
    if (nt > 1) attn_ldg<DQK>(src, 1, rk, rv);
    __syncthreads();
  }
#pragma unroll 1
  for (int j = 0; j < nt; ++j) {
    const u16* kw;
    u16* vcur;
    const u16* vprev;
    if constexpr (SB) {
      u16* vnext = (vi == 0) ? sVT1 : ((vi == 1) ? sQ : sVT);
      vcur = (vi == 0) ? sVT : ((vi == 1) ? sVT1 : sQ);
      vprev = (vi == 0) ? sQ : ((vi == 1) ? sVT : sVT1);
      if (j + 1 < nt) attn_sts<DQK>((j & 1) ? sK : sKb1, vnext, rk, rv);
      if (j + 2 < nt) attn_ldg<DQK>(src, j + 2, rk, rv);
      kw = ((j & 1) ? sKb1 : sK) + pr * QS + 8 * h;
      vi = (vi == 2) ? 0 : vi + 1;
    } else {
      if (j > 0) __syncthreads();
      vcur = (j & 1) ? sVT1 : sVT;
      vprev = (j & 1) ? sVT : sVT1;
      attn_sts<DQK>(sK, vcur, rk, rv);
      __syncthreads();
      if (j + 1 < nt) attn_ldg<DQK>(src, j + 1, rk, rv);
      kw = sK + pr * QS + 8 * h;
    }
    __builtin_amdgcn_sched_barrier(0);
    if (grpB && pend) { attn_pv(s, vprev + r * 72 + 8 * h, O); pend = false; }
    bool active = true;
    int kr = 0;
    if (NA && j >= src.n0) { kr = rsmin + (j - src.n0); active = (kr >= rsq) && (kr < rsq + 8); }
    if (active) {
      __builtin_amdgcn_s_setprio(1);
#pragma unroll
      for (int t = 0; t < 2; ++t) {
#pragma unroll
        for (int i = 0; i < 16; ++i) s[t][i] = 0.f;
#pragma unroll
        for (int ks = 0; ks < DQK / 16; ++ks) {
          bf16x8 a = ld8(kw + t * 32 * QS + ks * 16);
          bf16x8 q;
          if constexpr (QREG) q = qf[ks]; else q = ld8(qw + ks * 16);
          s[t] = mfma32(a, q, s[t]);
        }
      }
      __builtin_amdgcn_s_setprio(0);
      if (NA && j >= src.n0) {
        const float* bp = sBias + (kr - qr + 7) * 31 + (8 * h - qc + 15);
        const int kb = 8 * h - cs;
#pragma unroll
        for (int t = 0; t < 2; ++t)
#pragma unroll
          for (int i = 0; i < 16; ++i) {
            const int ko = t * 32 + 16 * (i >> 3) + (i & 7);
            const bool ok = (unsigned)(ko + kb) < 16u;
            const float bv = bp[ko];
            s[t][i] = ok ? s[t][i] + bv : -1e30f;
          }
      }
      float mx = -1e30f;
#pragma unroll
      for (int t = 0; t < 2; ++t)
#pragma unroll
        for (int i = 0; i < 16; ++i) mx = fmaxf(mx, s[t][i]);
      if (__builtin_amdgcn_ballot_w64(mx > m + 8.0f) != 0ull) {
        mx = fmaxf(mx, __shfl_xor(mx, 32));
        const float mn = fmaxf(m, mx);
        const float alpha = ex2(m - mn);
        l *= alpha;
        m = mn;
#pragma unroll
        for (int d = 0; d < 4; ++d)
#pragma unroll
          for (int i = 0; i < 16; ++i) O[d][i] *= alpha;
      }
      float rsum = 0.f;
#pragma unroll
      for (int t = 0; t < 2; ++t)
#pragma unroll
        for (int i = 0; i < 16; ++i) { const float e = ex2(s[t][i] - m); s[t][i] = e; rsum += e; }
      l += rsum;
      if (!grpB) attn_pv(s, vcur + r * 72 + 8 * h, O);
      else pend = true;
    }
    if constexpr (SB) __syncthreads();
  }
  if (grpB && pend) {
    const u16* vlast;
    if constexpr (SB) vlast = (vi == 1) ? sVT : ((vi == 2) ? sVT1 : sQ);
    else vlast = ((nt - 1) & 1) ? sVT1 : sVT;
    attn_pv(s, vlast + r * 72 + 8 * h, O);
  }
  l_out = l + __shfl_xor(l, 32);
}

DI void heavy_map(int it, int& bh, int& qb) { const int x = it & 7, rest = it >> 3; qb = rest & 15; bh = x + 8 * (rest >> 4); }

DI void diff_item(const Params& p, int l, bool sample, int bh, int qb, unsigned char* lds) {
  constexpr int NC = 6144;
  const int tid_ = TID8, lane = tid_ & 63, wid = tid_ >> 6, r = lane & 31, h = lane >> 5;
  const int b = bh >> 3, hd = bh & 7;
  u16* sQ = reinterpret_cast<u16*>(lds);
  u16* sK = sQ + 256 * 136;
  u16* sVT = sK + 64 * 136;
  const u16* PROJ = reinterpret_cast<const u16*>(p.ws + WS_PROJ);
  const u16* VT = reinterpret_cast<const u16*>(p.ws + WS_VT);
  const int seq0 = sample ? TP + b * 4096 : b * 256;
  const int token = seq0 + qb * 256 + wid * 32 + r;
  const float* dl = p.in[20 + 10 * l];
  float pa = dl[lane] * dl[64 + lane], pb = dl[128 + lane] * dl[192 + lane];
#pragma unroll
  for (int o = 32; o >= 1; o >>= 1) { pa += __shfl_xor(pa, o); pb += __shfl_xor(pb, o); }
  const float lam_init = 0.8f - 0.6f * __expf(-0.3f * (float)l);
  const float lam = __expf(pa) - __expf(pb) + lam_init;

  u32 o1p[32];
  f32x16 O[4];
  float lsum;
#pragma unroll
  for (int comp = 0; comp < 2; ++comp) {
    AttnSrc s;
    if (sample) {
      s.k0 = reinterpret_cast<const u16*>(p.ws + WS_CK) + (size_t)l * 2097152 + (size_t)bh * 65536 + comp * 64; s.ks0 = 128;
      s.vt0 = reinterpret_cast<const u16*>(p.ws + WS_CVT) + (size_t)l * 2097152 + (size_t)bh * 65536; s.vs0 = 512; s.n0 = 8;
      s.k1 = PROJ + (size_t)seq0 * NC + 3072 + hd * 128 + comp * 64; s.ks1 = NC;
      s.vt1 = VT + 8388608 + (size_t)bh * 128 * 4096; s.vs1 = 4096; s.n1 = 64;
    } else {
      s.k0 = nullptr; s.vt0 = nullptr; s.ks0 = 0; s.vs0 = 0; s.n0 = 0;
      s.k1 = PROJ + (size_t)seq0 * NC + 3072 + hd * 128 + comp * 64; s.ks1 = NC;
      s.vt1 = VT + (size_t)bh * 128 * 256; s.vs1 = 256; s.n1 = 4;
    }
    const u16* qblk = PROJ + (size_t)(seq0 + qb * 256) * NC + 2048 + hd * 128 + comp * 64;
    attn_run<64, false>(s, qblk, NC, sQ, sK, sVT, O, lsum, 0, 0, 0, nullptr);
    const float inv = 1.f / lsum;
    if (comp == 0) {
#pragma unroll
      for (int d = 0; d < 4; ++d)
#pragma unroll
        for (int i = 0; i < 8; ++i) o1p[d * 8 + i] = pk2(O[d][2 * i] * inv, O[d][2 * i + 1] * inv);
    } else {
      float ssq = 0.f;
#pragma unroll
      for (int d = 0; d < 4; ++d)
#pragma unroll
        for (int i = 0; i < 8; ++i) {
          const u32 w = o1p[d * 8 + i];
          const float a = bflo(w) - lam * O[d][2 * i] * inv, c = bfhi(w) - lam * O[d][2 * i + 1] * inv;
          O[d][2 * i] = a; O[d][2 * i + 1] = c;
          ssq += a * a + c * c;
        }
      ssq += __shfl_xor(ssq, 32);
      const float rn = rsqrtf(ssq * (1.f / 128.f) + LN_EPS) * (1.f - lam_init);
      const float* subln = p.in[21 + 10 * l];
      const u16* gp = PROJ + (size_t)token * NC + 5120 + hd * 128;
      u16* yp = reinterpret_cast<u16*>(p.ws + WS_H) + (size_t)token * 2048 + 1024 + hd * 128;
#pragma unroll
      for (int d = 0; d < 4; ++d)
#pragma unroll
        for (int q = 0; q < 4; ++q) {
          const int dv = d * 32 + 8 * q + 4 * h;
          const u32x2 gw = *reinterpret_cast<const u32x2*>(gp + dv);
          const float4 sl = *reinterpret_cast<const float4*>(subln + dv);
          const float y0 = O[d][4 * q] * rn * sl.x * silu(bflo(gw[0]));
          const float y1 = O[d][4 * q + 1] * rn * sl.y * silu(bfhi(gw[0]));
          const float y2 = O[d][4 * q + 2] * rn * sl.z * silu(bflo(gw[1]));
          const float y3 = O[d][4 * q + 3] * rn * sl.w * silu(bfhi(gw[1]));
          *reinterpret_cast<u32x2*>(yp + dv) = (ZERO_MASK & 2) ? u32x2{0u, 0u} : u32x2{pk2(y0, y1), pk2(y2, y3)};
        }
    }
  }
}

template <int H>
DI void pool_window(const u16* sIn, u16* sP, int oc, int seg, int t0, int L) {
  const int tl0 = seg * 8;
  const u16* base = sIn + (tl0 + 8 - H) * 264 + oc * 8;
  float a[8];
#pragma unroll
  for (int k = 0; k < 8; ++k) a[k] = 0.f;
#pragma unroll
  for (int o = 0; o < 2 * H; ++o) {
    const u32x4 v = *reinterpret_cast<const u32x4*>(base + o * 264);
#pragma unroll
    for (int k = 0; k < 4; ++k) { a[2 * k] += bflo(v[k]); a[2 * k + 1] += bfhi(v[k]); }
  }
#pragma unroll
  for (int tt = 0; tt < 8; ++tt) {
    const int t = t0 + tl0 + tt;
    const int lo = max(t - H, 0), hi = min(t + H, L);
    const float ic = 1.f / (float)(hi - lo);
    const u32x4 x = *reinterpret_cast<const u32x4*>(sIn + (tl0 + tt + 8) * 264 + oc * 8);
    u32x4 o;
#pragma unroll
    for (int k = 0; k < 4; ++k) o[k] = pk2(a[2 * k] * ic - bflo(x[k]), a[2 * k + 1] * ic - bfhi(x[k]));
    *reinterpret_cast<u32x4*>(sP + (tl0 + tt) * 264 + oc * 8) = o;
    if (tt < 7) {
      const u32x4 vin = *reinterpret_cast<const u32x4*>(base + (2 * H + tt) * 264);
      const u32x4 vout = *reinterpret_cast<const u32x4*>(base + tt * 264);
#pragma unroll
      for (int k = 0; k < 4; ++k) { a[2 * k] += bflo(vin[k]) - bflo(vout[k]); a[2 * k + 1] += bfhi(vin[k]) - bfhi(vout[k]); }
    }
  }
}

DI void pool_item(const Params& p, int l, int pi, unsigned char* lds) {
  constexpr int NC = 6144;
  const int tid = TIDX, lane = tid & 63, wid = tid >> 6, fr = lane & 15, fq = lane >> 4;
  const int tb = pi >> 2, g = pi & 3, row0 = tb * 64;
  const int L = row0 < TP ? 256 : 4096;
  const int t0 = row0 < TP ? (row0 & 255) : ((row0 - TP) & 4095);
  u16* sIn = reinterpret_cast<u16*>(lds);
  u16* sP = sIn + 80 * 264;
  const u16* PROJ = reinterpret_cast<const u16*>(p.ws + WS_PROJ);
  __syncthreads();
#pragma unroll
  for (int i = 0; i < 10; ++i) {
    const int c = tid + 256 * i, rr = c >> 5, oc = c & 31;
    const int t = t0 - 8 + rr;
    u32x4 v = {0u, 0u, 0u, 0u};
    if (t >= 0 && t < L) v = *reinterpret_cast<const u32x4*>(PROJ + (size_t)(row0 - 8 + rr) * NC + g * 256 + oc * 8);
    *reinterpret_cast<u32x4*>(sIn + rr * 264 + oc * 8) = v;
  }
  __syncthreads();
  {
    const int oc = tid & 31, seg = tid >> 5;
    switch (g) {
      case 0: pool_window<1>(sIn, sP, oc, seg, t0, L); break;
      case 1: pool_window<2>(sIn, sP, oc, seg, t0, L); break;
      case 2: pool_window<4>(sIn, sP, oc, seg, t0, L); break;
      default: pool_window<8>(sIn, sP, oc, seg, t0, L); break;
    }
  }
  __syncthreads();
  const u16* W = reinterpret_cast<const u16*>(p.ws + WS_POOLWT) + (size_t)(l >> 1) * 262144 + (size_t)g * 65536;
  u32x2 gpre[4][4];
#pragma unroll
  for (int n = 0; n < 4; ++n)
#pragma unroll
    for (int m = 0; m < 4; ++m)
      gpre[n][m] = *reinterpret_cast<const u32x2*>(PROJ + (size_t)(row0 + m * 16 + fr) * NC + 1024 + g * 256 + wid * 64 + n * 16 + 4 * fq);
  f32x4 acc[4][4];
#pragma unroll
  for (int a = 0; a < 4; ++a)
#pragma unroll
    for (int b = 0; b < 4; ++b) acc[a][b] = f32x4{0.f, 0.f, 0.f, 0.f};
#pragma unroll 4
  for (int ks = 0; ks < 8; ++ks) {
    bf16x8 af[4], bfr[4];
#pragma unroll
    for (int m = 0; m < 4; ++m) af[m] = ld8(sP + (m * 16 + fr) * 264 + ks * 32 + fq * 8);
#pragma unroll
    for (int n = 0; n < 4; ++n) bfr[n] = ld8(W + (size_t)(wid * 64 + n * 16 + fr) * 256 + ks * 32 + fq * 8);
#pragma unroll
    for (int m = 0; m < 4; ++m)
#pragma unroll
      for (int n = 0; n < 4; ++n) acc[m][n] = mfma16(bfr[n], af[m], acc[m][n]);
  }
  const float* pscale = p.in[19 + 10 * l];
  u16* Y = reinterpret_cast<u16*>(p.ws + WS_H);
#pragma unroll
  for (int n = 0; n < 4; ++n) {
    const int col = g * 256 + wid * 64 + n * 16 + 4 * fq;
    const float4 sc = *reinterpret_cast<const float4*>(pscale + col);
#pragma unroll
    for (int m = 0; m < 4; ++m) {
      const int row = row0 + m * 16 + fr;
      const u32x2 gw = gpre[n][m];
      float y0 = acc[m][n][0] * sc.x * silu(bflo(gw[0])), y1 = acc[m][n][1] * sc.y * silu(bfhi(gw[0]));
      float y2 = acc[m][n][2] * sc.z * silu(bflo(gw[1])), y3 = acc[m][n][3] * sc.w * silu(bfhi(gw[1]));
      if (ZERO_MASK & 1) { y0 = y1 = y2 = y3 = 0.f; }
      *reinterpret_cast<u32x2*>(Y + (size_t)row * 2048 + col) = u32x2{pk2(y0, y1), pk2(y2, y3)};
    }
  }
}

DI void phase_mix_even(const Params& p, int l, unsigned char* lds, unsigned char* lds_all) {
#pragma unroll 1
  for (int it = blockIdx.x; it < 512; it += gridDim.x) { int bh, qb; heavy_map(it, bh, qb); diff_item(p, l, true, bh, qb, lds_all); }
#pragma unroll 1
  for (int it = blockIdx.x; it < 256; it += gridDim.x) diff_item(p, l, false, it, 0, lds_all);
#pragma unroll 1
  for (int it = VBID; it < 1536; it += VGRID) pool_item(p, l, it, lds);
}

DI void na_item(const Params& p, int l, bool sample, int bh, int qb, unsigned char* lds) {
  constexpr int NC = 7168;
  const int tid = TID8, lane = tid & 63, wid = tid >> 6, r = lane & 31, h = lane >> 5;
  const int b = bh >> 3, hd = bh & 7;
  u16* sQ = reinterpret_cast<u16*>(lds);
  u16* sK = sQ + 256 * 136;
  u16* sVT = sK + 64 * 136;
  float* sBias = reinterpret_cast<float*>(sVT + 128 * 72) + 64;
  const u16* PROJ = reinterpret_cast<const u16*>(p.ws + WS_PROJ);
  const u16* VT = reinterpret_cast<const u16*>(p.ws + WS_VT);
  const int seq0 = sample ? TP + b * 4096 : b * 256;
  const int token = seq0 + qb * 256 + wid * 32 + r;
  AttnSrc s;
  int qr = 0, qc = 0, rsmin = 0;
  f32x16 O[4];
  float lsum;
  const u16* qblk = PROJ + (size_t)(seq0 + qb * 256) * NC + hd * 128;
  if (sample) {
    __syncthreads();
    const float* rpb = p.in[18 + 10 * l] + hd * 465;
    for (int e = tid; e < 465; e += 512) sBias[e] = rpb[e] * LOG2E;
    const int r0 = qb * 4;
    qr = r0 + (wid >> 1); qc = (wid & 1) * 32 + r;
    rsmin = min(max(r0 - 4, 0), 56);
    const int rs1 = min(max(r0 - 1, 0), 56);
    s.k0 = reinterpret_cast<const u16*>(p.ws + WS_CK) + (size_t)l * 2097152 + (size_t)bh * 65536; s.ks0 = 128;
    s.vt0 = reinterpret_cast<const u16*>(p.ws + WS_CVT) + (size_t)l * 2097152 + (size_t)bh * 65536; s.vs0 = 512; s.n0 = 8;
    s.k1 = PROJ + (size_t)(seq0 + rsmin * 64) * NC + 1024 + hd * 128; s.ks1 = NC;
    s.vt1 = VT + 8388608 + (size_t)bh * 128 * 4096 + rsmin * 64; s.vs1 = 4096; s.n1 = rs1 + 8 - rsmin;
    attn_run<128, true>(s, qblk, NC, sQ, sK, sVT, O, lsum, qr, qc, rsmin, sBias);
  } else {
    s.k0 = nullptr; s.vt0 = nullptr; s.ks0 = 0; s.vs0 = 0; s.n0 = 0;
    s.k1 = PROJ + (size_t)seq0 * NC + 1024 + hd * 128; s.ks1 = NC;
    s.vt1 = VT + (size_t)bh * 128 * 256; s.vs1 = 256; s.n1 = 4;
    attn_run<128, false>(s, qblk, NC, sQ, sK, sVT, O, lsum, 0, 0, 0, nullptr);
  }
  const float inv = 1.f / lsum;
  const u16* gp = PROJ + (size_t)token * NC + 3072 + hd * 128;
  u16* yp = reinterpret_cast<u16*>(p.ws + WS_H) + (size_t)token * 2048 + hd * 128;
#pragma unroll
  for (int d = 0; d < 4; ++d)
#pragma unroll
    for (int q = 0; q < 4; ++q) {
      const int dv = d * 32 + 8 * q + 4 * h;
      const u32x2 gw = *reinterpret_cast<const u32x2*>(gp + dv);
      const float y0 = O[d][4 * q] * inv * silu(bflo(gw[0]));
      const float y1 = O[d][4 * q + 1] * inv * silu(bfhi(gw[0]));
      const float y2 = O[d][4 * q + 2] * inv * silu(bflo(gw[1]));
      const float y3 = O[d][4 * q + 3] * inv * silu(bfhi(gw[1]));
      *reinterpret_cast<u32x2*>(yp + dv) = (ZERO_MASK & 4) ? u32x2{0u, 0u} : u32x2{pk2(y0, y1), pk2(y2, y3)};
    }
}

DI void sgu_item(const Params& p, int l, int si, unsigned char* lds) {
  constexpr int NC = 7168;
  const int tid = TIDX, lane = tid & 63, wid = tid >> 6, fr = lane & 15, fq = lane >> 4;
  const int ch = si >> 2, g = si & 3, row0 = ch * 128;
  u16* vnT = reinterpret_cast<u16*>(lds);
  float* sMu = reinterpret_cast<float*>(vnT + 256 * 136);
  float* sRs = sMu + 128;
  const u16* PROJ = reinterpret_cast<const u16*>(p.ws + WS_PROJ);
  __syncthreads();
  {
    const int grp = tid >> 4, ln = tid & 15;
#pragma unroll 2
    for (int rr = 0; rr < 8; ++rr) {
      const u16* src = PROJ + (size_t)(row0 + grp * 8 + rr) * NC + 5120;
      float s = 0.f, ss = 0.f;
#pragma unroll
      for (int c8 = 0; c8 < 8; ++c8) {
        const u32x4 v = *reinterpret_cast<const u32x4*>(src + (ln + 16 * c8) * 8);
#pragma unroll
        for (int k = 0; k < 4; ++k) { const float a = bflo(v[k]), b = bfhi(v[k]); s += a + b; ss += a * a + b * b; }
      }
#pragma unroll
      for (int o = 8; o >= 1; o >>= 1) { s += __shfl_xor(s, o); ss += __shfl_xor(ss, o); }
      const float mu = s * (1.f / 1024.f);
      const float var = fmaxf(ss * (1.f / 1024.f) - mu * mu, 0.f);
      if (ln == 0) { sMu[grp * 8 + rr] = mu; sRs[grp * 8 + rr] = rsqrtf(var + LN_EPS); }
    }
  }
  __syncthreads();
  {
    const int j = tid & 127, hf = tid >> 7;
    const float mu = sMu[j], rs = sRs[j];
    const float* lng = p.in[19 + 10 * l] + g * 256;
    const u16* src = PROJ + (size_t)(row0 + j) * NC + 5120 + g * 256;
#pragma unroll 8
    for (int oc = hf * 16; oc < hf * 16 + 16; ++oc) {
      const u32x4 v = *reinterpret_cast<const u32x4*>(src + oc * 8);
      const float4 g0 = *reinterpret_cast<const float4*>(lng + oc * 8), g1 = *reinterpret_cast<const float4*>(lng + oc * 8 + 4);
      const float gg[8] = {g0.x, g0.y, g0.z, g0.w, g1.x, g1.y, g1.z, g1.w};
#pragma unroll
      for (int k = 0; k < 4; ++k) {
        const float a = (bflo(v[k]) - mu) * rs * gg[2 * k], b = (bfhi(v[k]) - mu) * rs * gg[2 * k + 1];
        const u32 w = pk2(a, b);
        vnT[(oc * 8 + 2 * k) * 136 + j] = (u16)(w & 0xffffu);
        vnT[(oc * 8 + 2 * k + 1) * 136 + j] = (u16)(w >> 16);
      }
    }
  }
  __syncthreads();
  const u16* W = reinterpret_cast<const u16*>(p.ws + WS_SGUW) + (size_t)(l >> 1) * 65536 + (size_t)g * 16384;
  const float* bs = p.in[21 + 10 * l] + g * 128;
  u16* Y = reinterpret_cast<u16*>(p.ws + WS_H);
#pragma unroll 1
  for (int ih = 0; ih < 2; ++ih) {
    f32x4 acc[4][4];
#pragma unroll
    for (int a = 0; a < 4; ++a)
#pragma unroll
      for (int b = 0; b < 4; ++b) acc[a][b] = f32x4{0.f, 0.f, 0.f, 0.f};
#pragma unroll
    for (int ks = 0; ks < 4; ++ks) {
      bf16x8 af[4], bfr[4];
#pragma unroll
      for (int m = 0; m < 4; ++m) af[m] = ld8(W + (size_t)(ih * 64 + m * 16 + fr) * 128 + ks * 32 + fq * 8);
#pragma unroll
      for (int n = 0; n < 4; ++n) bfr[n] = ld8(vnT + (wid * 64 + n * 16 + fr) * 136 + ks * 32 + fq * 8);
#pragma unroll
      for (int m = 0; m < 4; ++m)
#pragma unroll
        for (int n = 0; n < 4; ++n) acc[m][n] = mfma16(bfr[n], af[m], acc[m][n]);
    }
#pragma unroll
    for (int m = 0; m < 4; ++m) {
      const int ii = ih * 64 + m * 16 + fr;
      const float bias = bs[ii];
      const size_t rb = (size_t)(row0 + ii) * NC;
#pragma unroll
      for (int n = 0; n < 4; ++n) {
        const int c = g * 256 + wid * 64 + n * 16 + 4 * fq;
        const u32x2 uw = *reinterpret_cast<const u32x2*>(PROJ + rb + 4096 + c);
        const u32x2 dw = *reinterpret_cast<const u32x2*>(PROJ + rb + 6144 + c);
        float y0 = bflo(uw[0]) * (acc[m][n][0] + bias) * silu(bflo(dw[0])), y1 = bfhi(uw[0]) * (acc[m][n][1] + bias) * silu(bfhi(dw[0]));
        float y2 = bflo(uw[1]) * (acc[m][n][2] + bias) * silu(bflo(dw[1])), y3 = bfhi(uw[1]) * (acc[m][n][3] + bias) * silu(bfhi(dw[1]));
        if (ZERO_MASK & 8) { y0 = y1 = y2 = y3 = 0.f; }
        *reinterpret_cast<u32x2*>(Y + (size_t)(row0 + ii) * 2048 + 1024 + c) = u32x2{pk2(y0, y1), pk2(y2, y3)};
      }
    }
  }
}

DI void phase_mix_odd(const Params& p, int l, unsigned char* lds, unsigned char* lds_all) {
#pragma unroll 1
  for (int it = blockIdx.x; it < 512; it += gridDim.x) { int bh, qb; heavy_map(it, bh, qb); na_item(p, l, true, bh, qb, lds_all); }
#pragma unroll 1
  for (int it = blockIdx.x; it < 256; it += gridDim.x) na_item(p, l, false, it, 0, lds_all);
#pragma unroll 1
  for (int it = VBID; it < 768; it += VGRID) sgu_item(p, l, it, lds);
}

#define XB_TMO      128
#define XB_XCNT(j)  (256  + 64 * (j))
#define XB_XSUB(j)  (1280 + 64 * (j))
#define XB_XGEN(j)  (2304 + 64 * (j))
#define XB_TOP      3328
#define XB_TOPGEN   3392
#define XCD_BAR_WORDS 3456
#define XB_SPIN_CAP (1u << 18)
#define LAS __attribute__((address_space(3)))
DI unsigned xb_ld(unsigned* p)              { return __hip_atomic_load(p, __ATOMIC_RELAXED, __HIP_MEMORY_SCOPE_AGENT); }
DI unsigned xb_add(unsigned* p, unsigned v) { return __hip_atomic_fetch_add(p, v, __ATOMIC_RELAXED, __HIP_MEMORY_SCOPE_AGENT); }
DI unsigned xb_xcc_id() { return (unsigned)__builtin_amdgcn_s_getreg((3 << 11) | 20) & 0xFu; }
#define XB_SPIN(cond, bar) do { unsigned _sp = 0; while (cond) { __builtin_amdgcn_s_sleep(1); \
    if ((++_sp & 255u) == 0u) { if (xb_ld(&(bar)[XB_TMO])) break; if (_sp > XB_SPIN_CAP) { atomicAdd(&(bar)[XB_TMO], 1u); break; } } } } while (0)
struct XcdBarrier { unsigned* bar; unsigned x; volatile LAS unsigned* st; };
DI XcdBarrier xcd_barrier_post(unsigned* bar, volatile LAS unsigned* st) {
  XcdBarrier b; b.bar = bar; b.x = xb_xcc_id(); b.st = st;
  if (threadIdx.x == 0) (void)xb_add(&bar[XB_XCNT(b.x)], 1u);
  return b;
}
DI void xcd_barrier_complete(unsigned* bar, unsigned x, unsigned& nloc, unsigned& nx) {
  const unsigned G = gridDim.x * gridDim.y * gridDim.z;
  unsigned sum, cnt, mine, sp = 0u;
  for (;;) {
    sum = 0u; cnt = 0u; mine = 0u;
#pragma unroll
    for (unsigned j = 0; j < 16; ++j) { const unsigned c = xb_ld(&bar[XB_XCNT(j)]); sum += c; cnt += (c > 0u) ? 1u : 0u; mine = (j == x) ? c : mine; }
    if (sum == G) break;
    __builtin_amdgcn_s_sleep(1);
    if ((++sp & 255u) == 0u) { if (xb_ld(&bar[XB_TMO])) break; if (sp > XB_SPIN_CAP) { atomicAdd(&bar[XB_TMO], 1u); break; } }
  }
  nloc = mine > 0u ? mine : 1u; nx = cnt > 0u ? cnt : 1u;
}
DI void xcd_barrier(const XcdBarrier& b) {
  asm volatile("s_waitcnt vmcnt(0)" ::: "memory");
  __syncthreads();
  if (threadIdx.x == 0) {
    unsigned* bar = b.bar;
    __builtin_amdgcn_s_waitcnt(0);
    unsigned nloc = b.st[0], nx = b.st[1];
    if (nloc == 0u) { xcd_barrier_complete(bar, b.x, nloc, nx); b.st[0] = nloc; b.st[1] = nx; }
    const unsigned old = xb_add(&bar[XB_XSUB(b.x)], 1u);
    const unsigned gen = old / nloc;
    if (old + 1u == (gen + 1u) * nloc) {
      __builtin_amdgcn_fence(__ATOMIC_RELEASE, "agent");
      asm volatile("s_waitcnt vmcnt(0)" ::: "memory");
      const unsigned og = xb_add(&bar[XB_TOP], 1u);
      const unsigned tg = og / nx;
      if (og + 1u == (tg + 1u) * nx) xb_add(&bar[XB_TOPGEN], 1u);
      else XB_SPIN(xb_ld(&bar[XB_TOPGEN]) == tg, bar);
      __builtin_amdgcn_fence(__ATOMIC_ACQUIRE, "agent");
      xb_add(&bar[XB_XGEN(b.x)], 1u);
      asm volatile("s_waitcnt vmcnt(0)" ::: "memory");
    } else {
      XB_SPIN(xb_ld(&bar[XB_XGEN(b.x)]) == gen, bar);
      __builtin_amdgcn_fence(__ATOMIC_ACQUIRE, "agent");
      asm volatile("s_waitcnt vmcnt(0)" ::: "memory");
    }
  }
  __syncthreads();
}

__global__ void __launch_bounds__(512, 2) fwd_megakernel(Params p) {
  extern __shared__ __attribute__((aligned(16))) unsigned char lds[];
  cg::grid_group grid = cg::this_grid();
  volatile LAS unsigned* xst = (volatile LAS unsigned*)(lds + LDS_BYTES - 16);
  if (threadIdx.x == 0) { xst[0] = 0u; xst[1] = 0u; }
  __syncthreads();
  const XcdBarrier xb = xcd_barrier_post(reinterpret_cast<unsigned*>(p.ws + WS_BAR), xst);
  for (int ph = p.ph_lo; ph < p.ph_hi; ++ph) {
    unsigned char* hl = lds + HALF_ID * HALF_LDS;
    if (ph == 0) phase_prep(p, hl);
    else if (ph == 1) phase_mod0(p);
    else {
      const int l = (ph - 2) >> 2, s = (ph - 2) & 3;
      if (s == 0) { if (l & 1) gemm_phase<G_IN_ODD>(p, l, lds); else gemm_phase<G_IN_EVEN>(p, l, lds); }
      else if (s == 1) { if (l & 1) phase_mix_odd(p, l, hl, lds); else phase_mix_even(p, l, hl, lds); }
      else if (s == 2) gemm_phase<G_OUT>(p, l, lds);
      else phase_ln(p, l);
    }
    if (ph + 1 < p.ph_hi) {
      if (p.ph_lo < 0) grid.sync();
      xcd_barrier(xb);
    }
  }
}

extern "C" void kernel_launch(void* const* d_in, const int* in_sizes, int n_in, void* d_out, int out_size, void* d_ws, size_t ws_size,
                              hipStream_t stream) {
  static int grid_blocks = 0;
  if (grid_blocks == 0) {
    if (n_in != 52 || ws_size < WS_END) {
      fprintf(stderr, "kernel_launch: expected 52 inputs and >= %zu bytes of workspace; got %d, %zu\n", (size_t)WS_END, n_in, ws_size);
      grid_blocks = -1;
      return;
    }
    int dev = 0, cus = 0, per_cu = 0;
    hipGetDevice(&dev);
    hipDeviceGetAttribute(&cus, hipDeviceAttributeMultiprocessorCount, dev);
    hipFuncSetAttribute((const void*)fwd_megakernel, hipFuncAttributeMaxDynamicSharedMemorySize, LDS_BYTES);
    hipOccupancyMaxActiveBlocksPerMultiprocessor(&per_cu, (const void*)fwd_megakernel, 512, LDS_BYTES);
    (void)hipGetLastError();
    grid_blocks = cus;
  }
  if (grid_blocks < 0) return;
  Params p{};
  for (int i = 0; i < 52; ++i) p.in[i] = (const float*)d_in[i];
  p.out = (float*)d_out;
  p.ws = (unsigned char*)d_ws;
#if MULTI
  for (int ph = 0; ph < NPHASE; ++ph) {
    p.ph_lo = ph; p.ph_hi = ph + 1;
    hipLaunchKernelGGL(fwd_megakernel, dim3(grid_blocks), dim3(512), LDS_BYTES, stream, p);
  }
#else
  p.ph_lo = 0; p.ph_hi = NPHASE;
  if (hipMemsetAsync((char*)d_ws + WS_BAR, 0, XCD_BAR_WORDS * 4, stream) != hipSuccess) { fprintf(stderr, "kernel_launch: memset of barrier words failed\n"); return; }
  void* args[] = {&p};
  hipError_t e = hipLaunchCooperativeKernel((const void*)fwd_megakernel, dim3(grid_blocks), dim3(512), args, LDS_BYTES, stream);
  if (e != hipSuccess) fprintf(stderr, "cooperative launch failed: %s (grid %d)\n", hipGetErrorString(e), grid_blocks);
#endif
}
```

```cpp
#include <hip/hip_runtime.h>
#include <hip/hip_cooperative_groups.h>
#include <cstdio>
namespace cg = cooperative_groups;

#define DI __device__ __forceinline__
typedef unsigned short u16;
typedef unsigned int u32;
using bf16x8 = __attribute__((ext_vector_type(8))) short;
using f32x4 = __attribute__((ext_vector_type(4))) float;
using f32x16 = __attribute__((ext_vector_type(16))) float;
using u32x4 = __attribute__((ext_vector_type(4))) unsigned;
using u32x2 = __attribute__((ext_vector_type(2))) unsigned;
typedef __bf16 bf2_t __attribute__((ext_vector_type(2)));
typedef float f2_t __attribute__((ext_vector_type(2)));

#ifndef MULTI
#define MULTI 0
#endif
#ifndef REP0
#define REP0 1
#endif
#ifndef REP1
#define REP1 1
#endif
#ifndef ZERO_MASK
#define ZERO_MASK 0
#endif

constexpr int T_ALL = 24576, TP = 8192, DM = 2048;
constexpr float LOG2E = 1.4426950408889634f;
constexpr float ALPHA = 1.6817928305074290f;
constexpr float LN_EPS = 1e-5f;
constexpr int HALF_LDS = 76288;
constexpr int LDS_BYTES = 2 * HALF_LDS + 16;
constexpr int NPHASE = 18;

constexpr size_t SZ_WIN_E = (size_t)6144 * 2048 * 2, SZ_WIN_O = (size_t)7168 * 2048 * 2;
constexpr size_t WS_WINT = 0;
constexpr size_t WS_WOUTT = WS_WINT + 2 * SZ_WIN_E + 2 * SZ_WIN_O;
constexpr size_t WS_POOLWT = WS_WOUTT + (size_t)4 * 2048 * 2048 * 2;
constexpr size_t WS_SGUW = WS_POOLWT + (size_t)2 * 4 * 256 * 256 * 2;
constexpr size_t WS_CK = WS_SGUW + (size_t)2 * 4 * 128 * 128 * 2;
constexpr size_t WS_CVT = WS_CK + (size_t)4 * 4194304;
constexpr size_t WS_MOD = WS_CVT + (size_t)4 * 4194304;
constexpr size_t WS_ROPE = WS_MOD + (size_t)4 * 5 * 6144 * 4;
constexpr size_t WS_H = WS_ROPE + 8192;
constexpr size_t WS_PROJ = WS_H + (size_t)T_ALL * 2048 * 2;
constexpr size_t WS_VT = WS_PROJ + (size_t)T_ALL * 7168 * 2;
constexpr size_t WS_BAR = WS_VT + (size_t)T_ALL * 1024 * 2;
constexpr size_t WS_STATS = WS_BAR + 16384;
constexpr size_t WS_END = WS_STATS + (size_t)T_ALL * 8;

struct Params {
  const float* in[52];
  float* out;
  unsigned char* ws;
  int ph_lo, ph_hi;
};

DI size_t ws_wint(int l) { return WS_WINT + (size_t)(l >> 1) * (SZ_WIN_E + SZ_WIN_O) + ((l & 1) ? SZ_WIN_E : 0); }

DI u32 pk2(float a, float b) { f2_t v = {a, b}; bf2_t r = __builtin_convertvector(v, bf2_t); return __builtin_bit_cast(u32, r); }
DI float bflo(u32 w) { return __uint_as_float(w << 16); }
DI float bfhi(u32 w) { return __uint_as_float(w & 0xffff0000u); }
DI float bf1(u16 w) { return __uint_as_float(((u32)w) << 16); }
DI float ex2(float x) { return __builtin_amdgcn_exp2f(x); }
DI float silu(float x) { return x / (1.f + __expf(-x)); }
DI f32x4 mfma16(bf16x8 a, bf16x8 b, f32x4 c) { return __builtin_amdgcn_mfma_f32_16x16x32_bf16(a, b, c, 0, 0, 0); }
DI f32x16 mfma32(bf16x8 a, bf16x8 b, f32x16 c) { return __builtin_amdgcn_mfma_f32_32x32x16_bf16(a, b, c, 0, 0, 0); }
DI bf16x8 ld8(const u16* p) { return *reinterpret_cast<const bf16x8*>(p); }
DI int opq(int x) { asm volatile("" : "+v"(x)); return x; }
#define TIDX (opq((int)threadIdx.x) & 255)
#define TID8 (opq((int)threadIdx.x))
#define HALF_ID (opq((int)threadIdx.x) >> 8)
#define VBID ((int)((blockIdx.x & 7u) | ((unsigned)HALF_ID << 3) | ((blockIdx.x >> 3) << 4)))
#define VGRID ((int)gridDim.x * 2)

enum { G_IN_EVEN = 0, G_IN_ODD = 1, G_OUT = 2 };

namespace pg8 {
#define PG8_LAS __attribute__((address_space(3)))
typedef unsigned short bf16_t;
typedef short bf16x8 __attribute__((ext_vector_type(8)));
typedef float f32x4 __attribute__((ext_vector_type(4)));
typedef unsigned u32x4 __attribute__((ext_vector_type(4)));
constexpr int BM = 256, BK = 64, HALF = 128, HTB = HALF * BK * 2  , STAGE_BYTES = 8 * HTB, NXCD = 8, WGM = 8;

__host__ __device__ __forceinline__ int lds_byte(int r, int c) { const int st = (r >> 4) * 2 + (c >> 5), rr = r & 15, cc = c & 31, ob = rr * 64 + cc * 2; return st * 1024 + (ob ^ (((ob >> 9) & 1) << 5)); }
__host__ __device__ __forceinline__ void stage_rc(int b, int& R, int& C) { const int st = b / 1024, sb = b % 1024, swz = sb ^ (((sb >> 9) & 1) << 5); R = (st >> 1) * 16 + swz / 64; C = (st & 1) * 32 + (swz % 64) / 2; }
__host__ __device__ __forceinline__ int perm32(int rho) { const int n = rho >> 4, i = rho & 15; return 8 * (i >> 2) + 4 * n + (i & 3); }

struct Unit { int pm, pn; };
struct Gemm { const bf16_t* A; const bf16_t* Bt; int M, N, K; };

struct StaticOrder {
    int nM, nN, nwg, G, c;
    __host__ __device__ void init(int M, int N, int G_, int c_) { nM = M / BM; nN = N / BM; nwg = nM * nN; G = G_; c = c_; }
    __host__ __device__ bool next(int i, Unit& u) const {
        const long L = (long)i * G + c; if (L >= nwg) return false;
        int wgid = (int)L; { const int q = nwg / NXCD, r = nwg % NXCD, xcd = wgid % NXCD, off = wgid / NXCD; wgid = (xcd < r ? xcd * (q + 1) : r * (q + 1) + (xcd - r) * q) + off; }
        const int nig = WGM * nN, gid = wgid / nig, fm = gid * WGM, gsz = (nM - fm) < WGM ? (nM - fm) : WGM;
        u.pm = fm + ((wgid % nig) % gsz); u.pn = (wgid % nig) / gsz; return true;
    }
    __device__ __forceinline__ void a_ready(const Unit&) const {}
    __device__ __forceinline__ void done(const Unit&) const {}
};

template <class Epi, class Sched, bool STAMP = false>
__device__ __forceinline__ void gemm_phase(PG8_LAS unsigned char* lds, const Gemm g, const Sched& S, const Epi& E, unsigned long long* stamps) {
    const int tid = opq((int)threadIdx.x), wid = __builtin_amdgcn_readfirstlane(tid >> 6), lane = tid & 63, wr = wid >> 2, wc = wid & 3, fr = lane & 15, fq = lane >> 4;
    const int K = g.K, nt = K / BK;
    int ts_lo = 0, ts_hi = 0, nts = 0; const unsigned long long rt_entry = STAMP ? (unsigned long long)wall_clock64() : 0ull;
#define PG8_STAMP() do { if (STAMP && wid == 0 && nts < 64) { const unsigned long long _c = (unsigned long long)clock64(); \
        ts_lo = (lane == nts) ? (int)(unsigned)_c : ts_lo; ts_hi = (lane == nts) ? (int)(unsigned)(_c >> 32) : ts_hi; ++nts; } } while (0)
    PG8_STAMP();
    unsigned voffA[2], voffB[2];
#pragma unroll
    for (int i = 0; i < 2; ++i) { int R, C; stage_rc(tid * 16 + i * 8192, R, C); const int Rb = Epi::PERM ? ((R & ~31) + perm32(R & 31)) : R;
        voffA[i] = (unsigned)(R * K + C) * 2u; voffB[i] = (unsigned)(Rb * K + C) * 2u; }
    const size_t kstep = (size_t)(BK * 2);
    const size_t hstep = (size_t)HALF * K * 2;
    const size_t tstep = 2 * hstep;
    const unsigned ldsw = (unsigned)wid * 1024u;
    const int aoff = lds_byte(wr * 64 + fr, fq * 8), boff = lds_byte(wc * 32 + fr, fq * 8);
#define PG8_SA(b, h) (((b) * 2 + (h)) * HTB)
#define PG8_SB(b, h) ((4 + (b) * 2 + (h)) * HTB)
#define PG8_STAGE(bufoff, gbase, voff) do { _Pragma("unroll") for (int _i = 0; _i < 2; ++_i) \
        __builtin_amdgcn_global_load_lds((const unsigned*)((const char*)(gbase) + (voff)[_i]), (PG8_LAS unsigned*)(lds + (bufoff) + ldsw + _i * 8192), 16, 0, 0); } while (0)
#define PG8_LDA(dst, b, h) do { _Pragma("unroll") for (int m = 0; m < 4; ++m) _Pragma("unroll") for (int k = 0; k < 2; ++k) dst[m][k] = *(const PG8_LAS bf16x8*)(lds + PG8_SA(b, h) + aoff + m * 2048 + k * 1024); } while (0)
#define PG8_LDB(dst, b, h) do { _Pragma("unroll") for (int n = 0; n < 2; ++n) _Pragma("unroll") for (int k = 0; k < 2; ++k) dst[n][k] = *(const PG8_LAS bf16x8*)(lds + PG8_SB(b, h) + boff + n * 2048 + k * 1024); } while (0)
#define PG8_MMA(ai, bj, At, Bt) do { __builtin_amdgcn_s_setprio(1); _Pragma("unroll") for (int m = 0; m < 4; ++m) _Pragma("unroll") for (int n = 0; n < 2; ++n) _Pragma("unroll") for (int k = 0; k < 2; ++k) \
        acc[ai][bj][m][n] = __builtin_amdgcn_mfma_f32_16x16x32_bf16(Bt[n][k], At[m][k], acc[ai][bj][m][n], 0, 0, 0); __builtin_amdgcn_s_setprio(0); } while (0)
#define PG8_WAIT_V(n) asm volatile("s_waitcnt vmcnt(" #n ")" ::: "memory")
#define PG8_WAIT_L(n) asm volatile("s_waitcnt lgkmcnt(" #n ")" ::: "memory")
#define PG8_BAR __builtin_amdgcn_s_barrier()
#define PG8_SCHED __builtin_amdgcn_sched_barrier(0)
    Unit cur, nxt; int ui = 0;
    if (!S.next(0, cur)) return;
    f32x4 acc[2][2][4][2];
#pragma unroll
    for (int a = 0; a < 2; ++a)
#pragma unroll
        for (int b = 0; b < 2; ++b)
#pragma unroll
            for (int m = 0; m < 4; ++m)
#pragma unroll
                for (int n = 0; n < 2; ++n) acc[a][b][m][n] = (f32x4){0.f, 0.f, 0.f, 0.f};
    bf16x8 At[4][2], B0[2][2], B1[2][2];
    const char* cA = (const char*)g.A + (size_t)cur.pm * tstep; const char* cB = (const char*)g.Bt + (size_t)cur.pn * tstep;
    S.a_ready(cur);
    PG8_STAGE(PG8_SB(0, 0), cB, voffB); PG8_STAGE(PG8_SA(0, 0), cA, voffA); PG8_STAGE(PG8_SB(0, 1), cB + hstep, voffB); PG8_STAGE(PG8_SA(0, 1), cA + hstep, voffA);
    if (wr == 1) PG8_BAR;
    PG8_WAIT_V(4); PG8_BAR;
    PG8_STAGE(PG8_SB(1, 0), cB + kstep, voffB); PG8_STAGE(PG8_SA(1, 0), cA + kstep, voffA); PG8_STAGE(PG8_SB(1, 1), cB + hstep + kstep, voffB);
    PG8_WAIT_V(6); PG8_BAR;
    PG8_STAMP();
    for (;;) {
        const bool has_next = S.next(ui + 1, nxt);
        const char* nA = has_next ? (const char*)g.A + (size_t)nxt.pm * tstep : cA; const char* nB = has_next ? (const char*)g.Bt + (size_t)nxt.pn * tstep : cB;
        for (int t = 0; t < nt; t += 2) {
            const bool last = (t == nt - 2);
            const char* a1 = cA + (size_t)(t + 1) * kstep;
            const char* a2 = last ? nA : cA + (size_t)(t + 2) * kstep; const char* b2 = last ? nB : cB + (size_t)(t + 2) * kstep;
            const char* a3 = a2 + kstep; const char* b3 = b2 + kstep;
            if (last && has_next) S.a_ready(nxt);
            PG8_LDB(B0, 0, 0); PG8_SCHED; PG8_LDA(At, 0, 0); PG8_STAGE(PG8_SA(1, 1), a1 + hstep, voffA);
            PG8_WAIT_L(8); PG8_BAR; PG8_WAIT_L(0); PG8_MMA(0, 0, At, B0); PG8_BAR; PG8_SCHED;
            PG8_LDB(B1, 0, 1); PG8_STAGE(PG8_SB(0, 0), b2, voffB);
            PG8_BAR; PG8_WAIT_L(0); PG8_MMA(0, 1, At, B1); PG8_BAR;
            PG8_LDA(At, 0, 1); PG8_STAGE(PG8_SA(0, 0), a2, voffA);
            PG8_BAR; PG8_WAIT_L(0); PG8_MMA(1, 0, At, B0); PG8_BAR; PG8_SCHED;
            PG8_STAGE(PG8_SB(0, 1), b2 + hstep, voffB);
            PG8_WAIT_V(6); PG8_BAR; PG8_MMA(1, 1, At, B1); PG8_BAR;
            PG8_LDB(B0, 1, 0); PG8_SCHED; PG8_LDA(At, 1, 0); PG8_STAGE(PG8_SA(0, 1), a2 + hstep, voffA);
            PG8_WAIT_L(8); PG8_BAR; PG8_WAIT_L(0); PG8_MMA(0, 0, At, B0); PG8_BAR; PG8_SCHED;
            PG8_LDB(B1, 1, 1); PG8_STAGE(PG8_SB(1, 0), b3, voffB);
            PG8_BAR; PG8_WAIT_L(0); PG8_MMA(0, 1, At, B1); PG8_BAR;
            PG8_LDA(At, 1, 1); PG8_STAGE(PG8_SA(1, 0), a3, voffA);
            PG8_BAR; PG8_WAIT_L(0); PG8_MMA(1, 0, At, B0); PG8_BAR; PG8_SCHED;
            PG8_STAGE(PG8_SB(1, 1), b3 + hstep, voffB);
            PG8_WAIT_V(6); PG8_BAR; PG8_MMA(1, 1, At, B1); PG8_BAR;
        }
        PG8_STAMP();
        if constexpr (!Epi::AFTER_DRAIN) { E(acc, cur, wr, wc, fr, fq); S.done(cur); }
        PG8_STAMP();
        if (!has_next) break;
#pragma unroll
        for (int a = 0; a < 2; ++a)
#pragma unroll
            for (int b = 0; b < 2; ++b)
#pragma unroll
                for (int m = 0; m < 4; ++m)
#pragma unroll
                    for (int n = 0; n < 2; ++n) acc[a][b][m][n] = (f32x4){0.f, 0.f, 0.f, 0.f};
        cur = nxt; cA = nA; cB = nB; ++ui;
    }
    PG8_WAIT_V(0);
    if (wr == 0) PG8_BAR;
    PG8_BAR;
    if constexpr (Epi::AFTER_DRAIN) { E.fused(acc, cur, wr, wc, fr, fq, lds, wid, lane); S.done(cur); }
    PG8_STAMP();
    if (STAMP && wid == 0) { stamps[lane] = lane < nts ? (((unsigned long long)(unsigned)ts_hi << 32) | (unsigned)ts_lo) : 0ull;
        if (lane == 62) stamps[62] = rt_entry; if (lane == 63) stamps[63] = (unsigned long long)wall_clock64(); }
#undef PG8_STAMP
#undef PG8_SA
#undef PG8_SB
#undef PG8_STAGE
#undef PG8_LDA
#undef PG8_LDB
#undef PG8_MMA
#undef PG8_WAIT_V
#undef PG8_WAIT_L
#undef PG8_BAR
#undef PG8_SCHED
}
}

DI void tr_tile(const float* __restrict__ src, size_t ld_src, u16* __restrict__ dst, size_t ld_dst, float* sT) {
  const int tid = TIDX;
  const int r = tid >> 4, c4 = (tid & 15) * 4;
#pragma unroll
  for (int i = 0; i < 4; ++i)
#pragma unroll
    for (int hf = 0; hf < 2; ++hf) {
      float4 v = *reinterpret_cast<const float4*>(src + (size_t)(r + 16 * i) * ld_src + c4 + 64 * hf);
      float* d = sT + (r + 16 * i) * 129 + c4 + 64 * hf;
      d[0] = v.x; d[1] = v.y; d[2] = v.z; d[3] = v.w;
    }
  __syncthreads();
  const int n = tid >> 1, ks = (tid & 1) * 32;
  u32 w[16];
#pragma unroll
  for (int j = 0; j < 16; ++j) w[j] = pk2(sT[(ks + 2 * j) * 129 + n], sT[(ks + 2 * j + 1) * 129 + n]);
  u32x4* o = reinterpret_cast<u32x4*>(dst + (size_t)n * ld_dst + ks);
  o[0] = u32x4{w[0], w[1], w[2], w[3]};
  o[1] = u32x4{w[4], w[5], w[6], w[7]};
  o[2] = u32x4{w[8], w[9], w[10], w[11]};
  o[3] = u32x4{w[12], w[13], w[14], w[15]};
  __syncthreads();
}

DI void cvt8(const float* __restrict__ src, u16* __restrict__ dst) {
  float4 a = *reinterpret_cast<const float4*>(src);
  float4 b = *reinterpret_cast<const float4*>(src + 4);
  *reinterpret_cast<u32x4*>(dst) = u32x4{pk2(a.x, a.y), pk2(a.z, a.w), pk2(b.x, b.y), pk2(b.z, b.w)};
}

DI void mod_item(const Params& p, int i, unsigned char* lds) {
  const int tid = TIDX;
  const int l = i / 96, n0 = (i % 96) * 64;
  float* sS = reinterpret_cast<float*>(lds);
  float* red = sS + 5 * 2048;
  const float* c = p.in[10];
  const float* cctx = p.in[11];
  for (int e = tid; e < 5 * 2048; e += 256) {
    int v = e >> 11, k = e & 2047;
    float x = (v == 0) ? cctx[k] : c[(v - 1) * 2048 + k];
    sS[e] = silu(x);
  }
  __syncthreads();
  const int kk = tid >> 4, c4 = (tid & 15) * 4;
  const float* W = p.in[12 + 10 * l] + n0 + c4;
  f32x4 acc[5];
#pragma unroll
  for (int v = 0; v < 5; ++v) acc[v] = f32x4{0.f, 0.f, 0.f, 0.f};
#pragma unroll 8
  for (int k = kk; k < 2048; k += 16) {
    float4 w = *reinterpret_cast<const float4*>(W + (size_t)k * 6144);
#pragma unroll
    for (int v = 0; v < 5; ++v) {
      float s = sS[v * 2048 + k];
      acc[v][0] += s * w.x; acc[v][1] += s * w.y; acc[v][2] += s * w.z; acc[v][3] += s * w.w;
    }
  }
#pragma unroll
  for (int v = 0; v < 5; ++v)
#pragma unroll
    for (int q = 0; q < 4; ++q) red[(kk * 5 + v) * 64 + c4 + q] = acc[v][q];
  __syncthreads();
  for (int t2 = tid; t2 < 320; t2 += 256) {
    int v = t2 >> 6, n = t2 & 63;
    float s = 0.f;
#pragma unroll
    for (int k2 = 0; k2 < 16; ++k2) s += red[(k2 * 5 + v) * 64 + n];
    float* mod = reinterpret_cast<float*>(p.ws + WS_MOD);
    mod[(size_t)(l * 5 + v) * 6144 + n0 + n] = s + p.in[13 + 10 * l][n0 + n];
  }
  __syncthreads();
}

DI void phase_prep(const Params& p, unsigned char* lds) {
  constexpr int N_MOD = 384, N_TRWIN = 6656, N_TRWOUT = 2048, N_TRPOOL = 64, N_SGU = 64, N_CK = 4096, N_CV = 1024;
  constexpr int TOTAL = N_MOD + N_TRWIN + N_TRWOUT + N_TRPOOL + N_SGU + N_CK + N_CV + 1;
  const int tid = TIDX;
  float* sT = reinterpret_cast<float*>(lds);
  for (int it = VBID; it < TOTAL; it += VGRID) {
    int i = it;
    if (i < N_MOD) { mod_item(p, i, lds); continue; }
    i -= N_MOD;
    if (i < N_TRWIN) {
      int l, base;
      if (i < 1536) { l = 0; base = 0; } else if (i < 3328) { l = 1; base = 1536; } else if (i < 4864) { l = 2; base = 3328; } else { l = 3; base = 4864; }
      i -= base;
      const int N = (l & 1) ? 7168 : 6144, nN = N / 128;
      const int kt = i / nN, nt = i % nN;
      tr_tile(p.in[14 + 10 * l] + (size_t)kt * 64 * N + nt * 128, N,
              reinterpret_cast<u16*>(p.ws + ws_wint(l)) + (size_t)nt * 128 * 2048 + kt * 64, 2048, sT);
      continue;
    }
    i -= N_TRWIN;
    if (i < N_TRWOUT) {
      const int l = i >> 9, r = i & 511, kt = r >> 4, nt = r & 15;
      tr_tile(p.in[15 + 10 * l] + (size_t)kt * 64 * 2048 + nt * 128, 2048,
              reinterpret_cast<u16*>(p.ws + WS_WOUTT) + (size_t)l * 2048 * 2048 + (size_t)nt * 128 * 2048 + kt * 64, 2048, sT);
      continue;
    }
    i -= N_TRWOUT;
    if (i < N_TRPOOL) {
      const int e = i >> 5, r = i & 31, g = r >> 3, t = r & 7, kt = t >> 1, nt = t & 1;
      tr_tile(p.in[18 + 20 * e] + (size_t)g * 65536 + kt * 64 * 256 + nt * 128, 256,
              reinterpret_cast<u16*>(p.ws + WS_POOLWT) + (size_t)e * 262144 + g * 65536 + nt * 128 * 256 + kt * 64, 256, sT);
      continue;
    }
    i -= N_TRPOOL;
    if (i < N_SGU) {
      const int e = i >> 5, ch = i & 31;
      const size_t off = (size_t)ch * 2048 + tid * 8;
      cvt8(p.in[30 + 20 * e] + off, reinterpret_cast<u16*>(p.ws + WS_SGUW) + (size_t)e * 65536 + off);
      continue;
    }
    i -= N_SGU;
    if (i < N_CK) {
      const int l = i >> 10, ch = i & 1023;
      const size_t off = (size_t)ch * 2048 + tid * 8;
      cvt8(p.in[2 + 2 * l] + off, reinterpret_cast<u16*>(p.ws + WS_CK) + (size_t)l * 2097152 + off);
      continue;
    }
    i -= N_CK;
    if (i < N_CV) {
      const int l = i >> 8, r = i & 255, bh = r >> 3, kt = r & 7;
      tr_tile(p.in[3 + 2 * l] + (size_t)bh * 65536 + kt * 64 * 128, 128,
              reinterpret_cast<u16*>(p.ws + WS_CVT) + (size_t)l * 2097152 + (size_t)bh * 65536 + kt * 64, 512, sT);
      continue;
    }
    {
      float* rc = reinterpret_cast<float*>(p.ws + WS_ROPE);
      for (int e = tid; e < 1024; e += 256) {
        int pos = e >> 4, fi = e & 15;
        float inv = 1.0f / powf(10000.0f, (float)(2 * fi) / 32.0f);
        float ang = (float)pos * inv;
        rc[e] = cosf(ang);
        rc[1024 + e] = sinf(ang);
      }
    }
  }
}

DI void phase_mod0(const Params& p) {
  const int tid = TIDX;
  const float* mod = reinterpret_cast<const float*>(p.ws + WS_MOD);
  u16* H = reinterpret_cast<u16*>(p.ws + WS_H);
  for (int it = VBID; it < T_ALL / 4; it += VGRID) {
#pragma unroll
    for (int rr = 0; rr < 4; ++rr) {
      const int row = it * 4 + rr;
      const int cond = row < TP ? 0 : 1 + ((row - TP) >> 12);
      const float* src = row < TP ? p.in[0] + (size_t)row * 2048 : p.in[1] + (size_t)(row - TP) * 2048;
      const int e = tid * 8;
      const float* sh = mod + (size_t)cond * 6144 + e;
      float4 a = *reinterpret_cast<const float4*>(src + e), b = *reinterpret_cast<const float4*>(src + e + 4);
      float4 s0 = *reinterpret_cast<const float4*>(sh), s1 = *reinterpret_cast<const float4*>(sh + 4);
      float4 c0 = *reinterpret_cast<const float4*>(sh + 2048), c1 = *reinterpret_cast<const float4*>(sh + 2052);
      u32x4 o = {pk2(a.x * (1.f + c0.x) + s0.x, a.y * (1.f + c0.y) + s0.y), pk2(a.z * (1.f + c0.z) + s0.z, a.w * (1.f + c0.w) + s0.w),
                 pk2(b.x * (1.f + c1.x) + s1.x, b.y * (1.f + c1.y) + s1.y), pk2(b.z * (1.f + c1.z) + s1.z, b.w * (1.f + c1.w) + s1.w)};
      *reinterpret_cast<u32x4*>(H + (size_t)row * 2048 + e) = o;
    }
  }
}


template <int MODE>
struct EpiIn {
  static constexpr bool PERM = false, AFTER_DRAIN = false;
  u16* PROJ; u16* VT; float* kout; float* vout; const float* ropeC; const float* ropeS;
  DI void operator()(const f32x4 (&acc)[2][2][4][2], const pg8::Unit& u, int wr, int wc, int fr, int fq) const {
    constexpr int NC = (MODE == G_IN_EVEN) ? 6144 : 7168;
    constexpr int SEC_Q = (MODE == G_IN_EVEN) ? 2 : 0, SEC_K = (MODE == G_IN_EVEN) ? 3 : 1, SEC_V = (MODE == G_IN_EVEN) ? 4 : 2;
    const int sec = u.pn >> 2;
    const bool prompt = u.pm < 32;
    const bool isq = sec == SEC_Q, isk = sec == SEC_K;
    const bool rope = (MODE == G_IN_EVEN) && (isq || isk) && !prompt;
    const float sc = isq ? ((MODE == G_IN_EVEN) ? 0.125f * LOG2E : 0.08838834764831845f * LOG2E) : 1.0f;
#pragma unroll
    for (int ai = 0; ai < 2; ++ai)
#pragma unroll
      for (int m = 0; m < 4; ++m) {
        const int row = u.pm * 256 + ai * 128 + wr * 64 + m * 16 + fr;
        int b, t;
        if (prompt) { b = row >> 8; t = row & 255; } else { const int rs = row - TP; b = rs >> 12; t = rs & 4095; }
#pragma unroll
        for (int bj = 0; bj < 2; ++bj) {
          const int hh = (u.pn & 3) * 2 + bj;
          const int d0 = wc * 32 + 4 * fq;
          if (sec == SEC_V) {
#pragma unroll
            for (int n = 0; n < 2; ++n) {
              const f32x4 v = acc[ai][bj][m][n];
              const int dv = d0 + 16 * n;
              const u32 w01 = pk2(v[0], v[1]), w23 = pk2(v[2], v[3]);
              if (prompt) {
                u16* vt = VT + ((size_t)((b * 8 + hh) * 128 + dv)) * 256 + t;
                vt[0] = (u16)(w01 & 0xffffu); vt[256] = (u16)(w01 >> 16); vt[512] = (u16)(w23 & 0xffffu); vt[768] = (u16)(w23 >> 16);
                *reinterpret_cast<float4*>(vout + ((size_t)((b * 8 + hh) * 256 + t)) * 128 + dv) = float4{v[0], v[1], v[2], v[3]};
              } else {
                u16* vt = VT + 8388608 + ((size_t)((b * 8 + hh) * 128 + dv)) * 4096 + t;
                vt[0] = (u16)(w01 & 0xffffu); vt[4096] = (u16)(w01 >> 16); vt[8192] = (u16)(w23 & 0xffffu); vt[12288] = (u16)(w23 >> 16);
              }
            }
          } else {
            f32x4 v0 = acc[ai][bj][m][0], v1 = acc[ai][bj][m][1];
            if (isk && prompt) {
              float* ko = kout + ((size_t)((b * 8 + hh) * 256 + t)) * 128 + d0;
              *reinterpret_cast<float4*>(ko) = float4{v0[0], v0[1], v0[2], v0[3]};
              *reinterpret_cast<float4*>(ko + 16) = float4{v1[0], v1[1], v1[2], v1[3]};
            }
            if (rope) {
              const int pos = (wc & 1) ? (t & 63) : (t >> 6);
              const float4 cs = *reinterpret_cast<const float4*>(ropeC + pos * 16 + 4 * fq);
              const float4 sn = *reinterpret_cast<const float4*>(ropeS + pos * 16 + 4 * fq);
              const float c4[4] = {cs.x, cs.y, cs.z, cs.w}, s4[4] = {sn.x, sn.y, sn.z, sn.w};
#pragma unroll
              for (int j = 0; j < 4; ++j) {
                const float x1 = v0[j], x2 = v1[j];
                v0[j] = x1 * c4[j] - x2 * s4[j];
                v1[j] = x1 * s4[j] + x2 * c4[j];
              }
            }
            u16* dst = PROJ + (size_t)row * NC + u.pn * 256 + bj * 128 + d0;
            *reinterpret_cast<u32x2*>(dst) = u32x2{pk2(v0[0] * sc, v0[1] * sc), pk2(v0[2] * sc, v0[3] * sc)};
            *reinterpret_cast<u32x2*>(dst + 16) = u32x2{pk2(v1[0] * sc, v1[1] * sc), pk2(v1[2] * sc, v1[3] * sc)};
          }
        }
      }
  }
};

struct EpiOut {
  static constexpr bool PERM = false, AFTER_DRAIN = false;
  float* X; const float* x0; const float* x1; const float* mod; const float* lng; const float* lnb; const float2* stats; int l;
  DI void operator()(const f32x4 (&acc)[2][2][4][2], const pg8::Unit& u, int wr, int wc, int fr, int fq) const {
    const bool prompt = u.pm < 32;
    const int cond = prompt ? 0 : 1 + ((u.pm * 256 - TP) >> 12);
    const float* gate = mod + (size_t)(l * 5 + cond) * 6144 + 4096;
    const int col0 = u.pn * 256 + wc * 32 + 4 * fq;
    const int row0 = u.pm * 256 + wr * 64 + fr;
    u16* Xb = reinterpret_cast<u16*>(X);
    if (l != 0) {
      u32x2 zr[2][4][2][2];
      float2 st[2][4];
#pragma unroll
      for (int ai = 0; ai < 2; ++ai)
#pragma unroll
        for (int m = 0; m < 4; ++m) {
          const int row = row0 + ai * 128 + m * 16;
          st[ai][m] = stats[row];
#pragma unroll
          for (int bj = 0; bj < 2; ++bj)
#pragma unroll
            for (int n = 0; n < 2; ++n) zr[ai][m][bj][n] = *reinterpret_cast<const u32x2*>(Xb + (size_t)row * 4096 + col0 + bj * 128 + 16 * n);
        }
#pragma unroll
      for (int bj = 0; bj < 2; ++bj)
#pragma unroll
        for (int n = 0; n < 2; ++n) {
          const int col = col0 + bj * 128 + 16 * n;
          const float4 g4 = *reinterpret_cast<const float4*>(gate + col);
          const float4 lg = *reinterpret_cast<const float4*>(lng + col), lb = *reinterpret_cast<const float4*>(lnb + col);
#pragma unroll
          for (int ai = 0; ai < 2; ++ai)
#pragma unroll
            for (int m = 0; m < 4; ++m) {
              const int row = row0 + ai * 128 + m * 16;
              const u32x2 zw = zr[ai][m][bj][n];
              const float mu = st[ai][m].x, rs = st[ai][m].y;
              const float x_0 = (bflo(zw[0]) - mu) * rs * lg.x + lb.x, x_1 = (bfhi(zw[0]) - mu) * rs * lg.y + lb.y;
              const float x_2 = (bflo(zw[1]) - mu) * rs * lg.z + lb.z, x_3 = (bfhi(zw[1]) - mu) * rs * lg.w + lb.w;
              const f32x4 a = acc[ai][bj][m][n];
              *reinterpret_cast<u32x2*>(Xb + (size_t)row * 4096 + col) =
                  u32x2{pk2(ALPHA * x_0 + g4.x * a[0], ALPHA * x_1 + g4.y * a[1]), pk2(ALPHA * x_2 + g4.z * a[2], ALPHA * x_3 + g4.w * a[3])};
            }
        }
    } else {
#pragma unroll
      for (int bj = 0; bj < 2; ++bj)
#pragma unroll
        for (int n = 0; n < 2; ++n) {
          const int col = col0 + bj * 128 + 16 * n;
          const float4 g4 = *reinterpret_cast<const float4*>(gate + col);
#pragma unroll
          for (int ai = 0; ai < 2; ++ai)
#pragma unroll
            for (int m = 0; m < 4; ++m) {
              const int row = row0 + ai * 128 + m * 16;
              const float4 xo = prompt ? *reinterpret_cast<const float4*>(x0 + (size_t)row * 2048 + col)
                                       : *reinterpret_cast<const float4*>(x1 + (size_t)(row - TP) * 2048 + col);
              const f32x4 a = acc[ai][bj][m][n];
              *reinterpret_cast<u32x2*>(Xb + (size_t)row * 4096 + col) =
                  u32x2{pk2(ALPHA * xo.x + g4.x * a[0], ALPHA * xo.y + g4.y * a[1]), pk2(ALPHA * xo.z + g4.z * a[2], ALPHA * xo.w + g4.w * a[3])};
            }
        }
    }
  }
};

template <int MODE>
DI void gemm_phase(const Params& p, int l, unsigned char* lds) {
  constexpr int N = (MODE == G_OUT) ? 2048 : (MODE == G_IN_EVEN ? 6144 : 7168);
  pg8::Gemm g;
  g.A = reinterpret_cast<const u16*>(p.ws + WS_H);
  g.Bt = (MODE == G_OUT) ? reinterpret_cast<const u16*>(p.ws + WS_WOUTT) + (size_t)l * 2048 * 2048
                         : reinterpret_cast<const u16*>(p.ws + ws_wint(l));
  g.M = T_ALL; g.N = N; g.K = 2048;
  pg8::StaticOrder S;
  S.init(T_ALL, N, (int)gridDim.x, (int)blockIdx.x);
  PG8_LAS unsigned char* l3 = (PG8_LAS unsigned char*)lds;
  if constexpr (MODE == G_OUT) {
    EpiOut E;
    E.X = p.out; E.x0 = p.in[0]; E.x1 = p.in[1]; E.mod = reinterpret_cast<const float*>(p.ws + WS_MOD); E.l = l;
    E.lng = p.in[16 + 10 * (l > 0 ? l - 1 : 0)]; E.lnb = p.in[17 + 10 * (l > 0 ? l - 1 : 0)];
    E.stats = reinterpret_cast<const float2*>(p.ws + WS_STATS);
    pg8::gemm_phase<EpiOut, pg8::StaticOrder, false>(l3, g, S, E, nullptr);
  } else {
    EpiIn<MODE> E;
    E.PROJ = reinterpret_cast<u16*>(p.ws + WS_PROJ); E.VT = reinterpret_cast<u16*>(p.ws + WS_VT);
    E.kout = p.out + (size_t)T_ALL * 2048 + (size_t)(2 * l) * 8388608;
    E.vout = p.out + (size_t)T_ALL * 2048 + (size_t)(2 * l + 1) * 8388608;
    E.ropeC = reinterpret_cast<const float*>(p.ws + WS_ROPE); E.ropeS = E.ropeC + 1024;
    pg8::gemm_phase<EpiIn<MODE>, pg8::StaticOrder, false>(l3, g, S, E, nullptr);
  }
}

DI void phase_ln(const Params& p, int l) {
  const int tid_ = TIDX, lane = tid_ & 63, wid = tid_ >> 6;
  const float* g = p.in[16 + 10 * l];
  const float* bb = p.in[17 + 10 * l];
  const float* mod = reinterpret_cast<const float*>(p.ws + WS_MOD);
  u16* H = reinterpret_cast<u16*>(p.ws + WS_H);
  float* X = p.out;
  float4 gq[8], bq[8];
#pragma unroll
  for (int i = 0; i < 8; ++i) {
    gq[i] = *reinterpret_cast<const float4*>(g + (i * 64 + lane) * 4);
    bq[i] = *reinterpret_cast<const float4*>(bb + (i * 64 + lane) * 4);
  }
  for (int it = VBID; it < T_ALL / 4; it += VGRID) {
    const int row = it * 4 + wid;
    float* xr = X + (size_t)row * 2048;
    const u16* zr = reinterpret_cast<const u16*>(xr);
    float4 v[8];
    float s = 0.f;
#pragma unroll
    for (int i = 0; i < 8; ++i) {
      const u32x2 w = *reinterpret_cast<const u32x2*>(zr + (i * 64 + lane) * 4);
      v[i] = float4{bflo(w[0]), bfhi(w[0]), bflo(w[1]), bfhi(w[1])};
      s += v[i].x + v[i].y + v[i].z + v[i].w;
    }
#pragma unroll
    for (int o = 32; o >= 1; o >>= 1) s += __shfl_xor(s, o);
    const float mu = s * (1.f / 2048.f);
    float ss = 0.f;
#pragma unroll
    for (int i = 0; i < 8; ++i) {
      float a = v[i].x - mu, b = v[i].y - mu, c = v[i].z - mu, d = v[i].w - mu;
      ss += a * a + b * b + c * c + d * d;
    }
#pragma unroll
    for (int o = 32; o >= 1; o >>= 1) ss += __shfl_xor(ss, o);
    const float rstd = rsqrtf(ss * (1.f / 2048.f) + LN_EPS);
    if (lane == 0) *reinterpret_cast<float2*>(p.ws + WS_STATS + (size_t)row * 8) = float2{mu, rstd};
    const int cond = row < TP ? 0 : 1 + ((row - TP) >> 12);
    const float* sh = mod + (size_t)((l + 1) * 5 + cond) * 6144;
#pragma unroll
    for (int i = 0; i < 8; ++i) {
      const int e = (i * 64 + lane) * 4;
      const float4 gg = gq[i], b4 = bq[i];
      float4 y;
      y.x = (v[i].x - mu) * rstd * gg.x + b4.x; y.y = (v[i].y - mu) * rstd * gg.y + b4.y;
      y.z = (v[i].z - mu) * rstd * gg.z + b4.z; y.w = (v[i].w - mu) * rstd * gg.w + b4.w;
      if (l == 3) *reinterpret_cast<float4*>(xr + e) = y;
      if (l < 3) {
        float4 s0 = *reinterpret_cast<const float4*>(sh + e), c0 = *reinterpret_cast<const float4*>(sh + 2048 + e);
        u32x2 o = {pk2(y.x * (1.f + c0.x) + s0.x, y.y * (1.f + c0.y) + s0.y), pk2(y.z * (1.f + c0.z) + s0.z, y.w * (1.f + c0.w) + s0.w)};
        *reinterpret_cast<u32x2*>(H + (size_t)row * 2048 + e) = o;
      }
    }
  }
}

struct AttnSrc {
  const u16* k0; const u16* vt0; int ks0, vs0, n0;
  const u16* k1; const u16* vt1; int ks1, vs1, n1;
};

template <int DQK>
DI void attn_ldg(const AttnSrc& s, int j, u32x4 (&rk)[DQK / 64], u32x4 (&rv)[2]) {
  const u16* kb; const u16* vb; int ks, vs;
  if (j < s.n0) { kb = s.k0 + (size_t)j * 64 * s.ks0; vb = s.vt0 + j * 64; ks = s.ks0; vs = s.vs0; }
  else { const int jj = j - s.n0; kb = s.k1 + (size_t)jj * 64 * s.ks1; vb = s.vt1 + jj * 64; ks = s.ks1; vs = s.vs1; }
  constexpr int CPR = DQK / 8;
  const int tid = TID8;
#pragma unroll
  for (int i = 0; i < DQK / 64; ++i) {
    const int c = tid + 512 * i, row = c / CPR, kc = c % CPR;
    rk[i] = *reinterpret_cast<const u32x4*>(kb + (size_t)row * ks + kc * 8);
  }
#pragma unroll
  for (int i = 0; i < 2; ++i) {
    const int c = tid + 512 * i, row = c >> 3, kc = c & 7;
    rv[i] = *reinterpret_cast<const u32x4*>(vb + (size_t)row * vs + kc * 8);
  }
}
template <int DQK>
DI void attn_sts(u16* sK, u16* sVT, const u32x4 (&rk)[DQK / 64], const u32x4 (&rv)[2]) {
  constexpr int CPR = DQK / 8;
  const int tid = TID8;
#pragma unroll
  for (int i = 0; i < DQK / 64; ++i) {
    const int c = tid + 512 * i, row = c / CPR, kc = c % CPR;
    *reinterpret_cast<u32x4*>(sK + row * (DQK + 8) + kc * 8) = rk[i];
  }
#pragma unroll
  for (int i = 0; i < 2; ++i) {
    const int c = tid + 512 * i, row = c >> 3, kc = c & 7;
    *reinterpret_cast<u32x4*>(sVT + row * 72 + kc * 8) = rv[i];
  }
}

DI void attn_pv(const f32x16 (&s)[2], const u16* vw, f32x16 (&O)[4]) {
  __builtin_amdgcn_s_setprio(1);
#pragma unroll
  for (int s4 = 0; s4 < 4; ++s4) {
    const int t = s4 >> 1, b0 = (s4 & 1) * 8;
    u32x4 w = {pk2(s[t][b0], s[t][b0 + 1]), pk2(s[t][b0 + 2], s[t][b0 + 3]), pk2(s[t][b0 + 4], s[t][b0 + 5]), pk2(s[t][b0 + 6], s[t][b0 + 7])};
    const bf16x8 pf = __builtin_bit_cast(bf16x8, w);
#pragma unroll
    for (int d = 0; d < 4; ++d) {
      bf16x8 a = ld8(vw + d * 32 * 72 + s4 * 16);
      O[d] = mfma32(a, pf, O[d]);
    }
  }
  __builtin_amdgcn_s_setprio(0);
}

template <int DQK, bool NA>
DI void attn_run(const AttnSrc& src, const u16* qblk, int qstride, u16* sQ, u16* sK, u16* sVT, f32x16 (&O)[4], float& l_out,
                 int qr, int qc, int rsmin, const float* sBias) {
  const int tid = TID8, lane = tid & 63, wid = tid >> 6;
  const int r = lane & 31, h = lane >> 5;
  const int pr = (r & 0x13) | ((r & 4) << 1) | ((r & 8) >> 1);
  constexpr int CPR = DQK / 8, QS = DQK + 8;
  __syncthreads();
  constexpr bool QREG = (DQK == 64);
  bf16x8 qf[QREG ? DQK / 16 : 1];
  if constexpr (QREG) {
#pragma unroll
    for (int ks = 0; ks < DQK / 16; ++ks) qf[ks] = ld8(qblk + (size_t)(wid * 32 + r) * qstride + ks * 16 + 8 * h);
  } else {
#pragma unroll
    for (int i = 0; i < DQK / 16; ++i) {
      const int c = tid + 512 * i, row = c / CPR, kc = c % CPR;
      *reinterpret_cast<u32x4*>(sQ + row * QS + kc * 8) = *reinterpret_cast<const u32x4*>(qblk + (size_t)row * qstride + kc * 8);
    }
  }
#pragma unroll
  for (int d = 0; d < 4; ++d)
#pragma unroll
    for (int i = 0; i < 16; ++i) O[d][i] = 0.f;
  float m = -1e30f, l = 0.f;
  const int nt = src.n0 + src.n1;
  const int rsq = min(max(qr - 4, 0), 56);
  const int cs = min(max(qc - 8, 0), 48);
  const u16* qw = sQ + (wid * 32 + r) * QS + 8 * h;
  u16* sVT1 = sVT + 128 * 72 + 2048;
  const bool grpB = wid >= 4;
  bool pend = false;
  f32x16 s[2];
  u32x4 rk[DQK / 64], rv[2];
  attn_ldg<DQK>(src, 0, rk, rv);
  constexpr bool SB = QREG;
  u16* sKb1 = sQ + 16384;
  int vi = 0;
  if constexpr (SB) {
    attn_sts<DQK>(sK, sVT, rk, rv);
    if (nt > 1) attn_ldg<DQK>(src, 1, rk, rv);
    __syncthreads();
  }
#pragma unroll 1
  for (int j = 0; j < nt; ++j) {
    const u16* kw;
    u16* vcur;
    const u16* vprev;
    if constexpr (SB) {
      u16* vnext = (vi == 0) ? sVT1 : ((vi == 1) ? sQ : sVT);
      vcur = (vi == 0) ? sVT : ((vi == 1) ? sVT1 : sQ);
      vprev = (vi == 0) ? sQ : ((vi == 1) ? sVT : sVT1);
      if (j + 1 < nt) attn_sts<DQK>((j & 1) ? sK : sKb1, vnext, rk, rv);
      if (j + 2 < nt) attn_ldg<DQK>(src, j + 2, rk, rv);
      kw = ((j & 1) ? sKb1 : sK) + pr * QS + 8 * h;
      vi = (vi == 2) ? 0 : vi + 1;
    } else {
      if (j > 0) __syncthreads();
      vcur = (j & 1) ? sVT1 : sVT;
      vprev = (j & 1) ? sVT : sVT1;
      attn_sts<DQK>(sK, vcur, rk, rv);
      __syncthreads();
      if (j + 1 < nt) attn_ldg<DQK>(src, j + 1, rk, rv);
      kw = sK + pr * QS + 8 * h;
    }
    __builtin_amdgcn_sched_barrier(0);
    if (grpB && pend) { attn_pv(s, vprev + r * 72 + 8 * h, O); pend = false; }
    bool active = true;
    int kr = 0;
    if (NA && j >= src.n0) { kr = rsmin + (j - src.n0); active = (kr >= rsq) && (kr < rsq + 8); }
    if (active) {
      __builtin_amdgcn_s_setprio(1);
#pragma unroll
      for (int t = 0; t < 2; ++t) {
#pragma unroll
        for (int i = 0; i < 16; ++i) s[t][i] = 0.f;
#pragma unroll
        for (int ks = 0; ks < DQK / 16; ++ks) {
          bf16x8 a = ld8(kw + t * 32 * QS + ks * 16);
          bf16x8 q;
          if constexpr (QREG) q = qf[ks]; else q = ld8(qw + ks * 16);
          s[t] = mfma32(a, q, s[t]);
        }
      }
      __builtin_amdgcn_s_setprio(0);
      if (NA && j >= src.n0) {
        const float* bp = sBias + (kr - qr + 7) * 31 + (8 * h - qc + 15);
        const int kb = 8 * h - cs;
#pragma unroll
        for (int t = 0; t < 2; ++t)
#pragma unroll
          for (int i = 0; i < 16; ++i) {
            const int ko = t * 32 + 16 * (i >> 3) + (i & 7);
            const bool ok = (unsigned)(ko + kb) < 16u;
            const float bv = bp[ko];
            s[t][i] = ok ? s[t][i] + bv : -1e30f;
          }
      }
      float mx = -1e30f;
#pragma unroll
      for (int t = 0; t < 2; ++t)
#pragma unroll
        for (int i = 0; i < 16; ++i) mx = fmaxf(mx, s[t][i]);
      if (__builtin_amdgcn_ballot_w64(mx > m + 8.0f) != 0ull) {
        mx = fmaxf(mx, __shfl_xor(mx, 32));
        const float mn = fmaxf(m, mx);
        const float alpha = ex2(m - mn);
        l *= alpha;
        m = mn;
#pragma unroll
        for (int d = 0; d < 4; ++d)
#pragma unroll
          for (int i = 0; i < 16; ++i) O[d][i] *= alpha;
      }
      float rsum = 0.f;
#pragma unroll
      for (int t = 0; t < 2; ++t)
#pragma unroll
        for (int i = 0; i < 16; ++i) { const float e = ex2(s[t][i] - m); s[t][i] = e; rsum += e; }
      l += rsum;
      if (!grpB) attn_pv(s, vcur + r * 72 + 8 * h, O);
      else pend = true;
    }
    if constexpr (SB) __syncthreads();
  }
  if (grpB && pend) {
    const u16* vlast;
    if constexpr (SB) vlast = (vi == 1) ? sVT : ((vi == 2) ? sVT1 : sQ);
    else vlast = ((nt - 1) & 1) ? sVT1 : sVT;
    attn_pv(s, vlast + r * 72 + 8 * h, O);
  }
  l_out = l + __shfl_xor(l, 32);
}

DI void heavy_map(int it, int& bh, int& qb) { const int x = it & 7, rest = it >> 3; qb = rest & 15; bh = x + 8 * (rest >> 4); }

DI void diff_item(const Params& p, int l, bool sample, int bh, int qb, unsigned char* lds) {
  constexpr int NC = 6144;
  const int tid_ = TID8, lane = tid_ & 63, wid = tid_ >> 6, r = lane & 31, h = lane >> 5;
  const int b = bh >> 3, hd = bh & 7;
  u16* sQ = reinterpret_cast<u16*>(lds);
  u16* sK = sQ + 256 * 136;
  u16* sVT = sK + 64 * 136;
  const u16* PROJ = reinterpret_cast<const u16*>(p.ws + WS_PROJ);
  const u16* VT = reinterpret_cast<const u16*>(p.ws + WS_VT);
  const int seq0 = sample ? TP + b * 4096 : b * 256;
  const int token = seq0 + qb * 256 + wid * 32 + r;
  const float* dl = p.in[20 + 10 * l];
  float pa = dl[lane] * dl[64 + lane], pb = dl[128 + lane] * dl[192 + lane];
#pragma unroll
  for (int o = 32; o >= 1; o >>= 1) { pa += __shfl_xor(pa, o); pb += __shfl_xor(pb, o); }
  const float lam_init = 0.8f - 0.6f * __expf(-0.3f * (float)l);
  const float lam = __expf(pa) - __expf(pb) + lam_init;

  u32 o1p[32];
  f32x16 O[4];
  float lsum;
#pragma unroll
  for (int comp = 0; comp < 2; ++comp) {
    AttnSrc s;
    if (sample) {
      s.k0 = reinterpret_cast<const u16*>(p.ws + WS_CK) + (size_t)l * 2097152 + (size_t)bh * 65536 + comp * 64; s.ks0 = 128;
      s.vt0 = reinterpret_cast<const u16*>(p.ws + WS_CVT) + (size_t)l * 2097152 + (size_t)bh * 65536; s.vs0 = 512; s.n0 = 8;
      s.k1 = PROJ + (size_t)seq0 * NC + 3072 + hd * 128 + comp * 64; s.ks1 = NC;
      s.vt1 = VT + 8388608 + (size_t)bh * 128 * 4096; s.vs1 = 4096; s.n1 = 64;
    } else {
      s.k0 = nullptr; s.vt0 = nullptr; s.ks0 = 0; s.vs0 = 0; s.n0 = 0;
      s.k1 = PROJ + (size_t)seq0 * NC + 3072 + hd * 128 + comp * 64; s.ks1 = NC;
      s.vt1 = VT + (size_t)bh * 128 * 256; s.vs1 = 256; s.n1 = 4;
    }
    const u16* qblk = PROJ + (size_t)(seq0 + qb * 256) * NC + 2048 + hd * 128 + comp * 64;
    attn_run<64, false>(s, qblk, NC, sQ, sK, sVT, O, lsum, 0, 0, 0, nullptr);
    const float inv = 1.f / lsum;
    if (comp == 0) {
#pragma unroll
      for (int d = 0; d < 4; ++d)
#pragma unroll
        for (int i = 0; i < 8; ++i) o1p[d * 8 + i] = pk2(O[d][2 * i] * inv, O[d][2 * i + 1] * inv);
    } else {
      float ssq = 0.f;
#pragma unroll
      for (int d = 0; d < 4; ++d)
#pragma unroll
        for (int i = 0; i < 8; ++i) {
          const u32 w = o1p[d * 8 + i];
          const float a = bflo(w) - lam * O[d][2 * i] * inv, c = bfhi(w) - lam * O[d][2 * i + 1] * inv;
          O[d][2 * i] = a; O[d][2 * i + 1] = c;
          ssq += a * a + c * c;
        }
      ssq += __shfl_xor(ssq, 32);
      const float rn = rsqrtf(ssq * (1.f / 128.f) + LN_EPS) * (1.f - lam_init);
      const float* subln = p.in[21 + 10 * l];
      const u16* gp = PROJ + (size_t)token * NC + 5120 + hd * 128;
      u16* yp = reinterpret_cast<u16*>(p.ws + WS_H) + (size_t)token * 2048 + 1024 + hd * 128;
#pragma unroll
      for (int d = 0; d < 4; ++d)
#pragma unroll
        for (int q = 0; q < 4; ++q) {
          const int dv = d * 32 + 8 * q + 4 * h;
          const u32x2 gw = *reinterpret_cast<const u32x2*>(gp + dv);
          const float4 sl = *reinterpret_cast<const float4*>(subln + dv);
          const float y0 = O[d][4 * q] * rn * sl.x * silu(bflo(gw[0]));
          const float y1 = O[d][4 * q + 1] * rn * sl.y * silu(bfhi(gw[0]));
          const float y2 = O[d][4 * q + 2] * rn * sl.z * silu(bflo(gw[1]));
          const float y3 = O[d][4 * q + 3] * rn * sl.w * silu(bfhi(gw[1]));
          *reinterpret_cast<u32x2*>(yp + dv) = (ZERO_MASK & 2) ? u32x2{0u, 0u} : u32x2{pk2(y0, y1), pk2(y2, y3)};
        }
    }
  }
}

template <int H>
DI void pool_window(const u16* sIn, u16* sP, int oc, int seg, int t0, int L) {
  const int tl0 = seg * 8;
  const u16* base = sIn + (tl0 + 8 - H) * 264 + oc * 8;
  float a[8];
#pragma unroll
  for (int k = 0; k < 8; ++k) a[k] = 0.f;
#pragma unroll
  for (int o = 0; o < 2 * H; ++o) {
    const u32x4 v = *reinterpret_cast<const u32x4*>(base + o * 264);
#pragma unroll
    for (int k = 0; k < 4; ++k) { a[2 * k] += bflo(v[k]); a[2 * k + 1] += bfhi(v[k]); }
  }
#pragma unroll
  for (int tt = 0; tt < 8; ++tt) {
    const int t = t0 + tl0 + tt;
    const int lo = max(t - H, 0), hi = min(t + H, L);
    const float ic = 1.f / (float)(hi - lo);
    const u32x4 x = *reinterpret_cast<const u32x4*>(sIn + (tl0 + tt + 8) * 264 + oc * 8);
    u32x4 o;
#pragma unroll
    for (int k = 0; k < 4; ++k) o[k] = pk2(a[2 * k] * ic - bflo(x[k]), a[2 * k + 1] * ic - bfhi(x[k]));
    *reinterpret_cast<u32x4*>(sP + (tl0 + tt) * 264 + oc * 8) = o;
    if (tt < 7) {
      const u32x4 vin = *reinterpret_cast<const u32x4*>(base + (2 * H + tt) * 264);
      const u32x4 vout = *reinterpret_cast<const u32x4*>(base + tt * 264);
#pragma unroll
      for (int k = 0; k < 4; ++k) { a[2 * k] += bflo(vin[k]) - bflo(vout[k]); a[2 * k + 1] += bfhi(vin[k]) - bfhi(vout[k]); }
    }
  }
}

DI void pool_item(const Params& p, int l, int pi, unsigned char* lds) {
  constexpr int NC = 6144;
  const int tid = TIDX, lane = tid & 63, wid = tid >> 6, fr = lane & 15, fq = lane >> 4;
  const int tb = pi >> 2, g = pi & 3, row0 = tb * 64;
  const int L = row0 < TP ? 256 : 4096;
  const int t0 = row0 < TP ? (row0 & 255) : ((row0 - TP) & 4095);
  u16* sIn = reinterpret_cast<u16*>(lds);
  u16* sP = sIn + 80 * 264;
  const u16* PROJ = reinterpret_cast<const u16*>(p.ws + WS_PROJ);
  __syncthreads();
#pragma unroll
  for (int i = 0; i < 10; ++i) {
    const int c = tid + 256 * i, rr = c >> 5, oc = c & 31;
    const int t = t0 - 8 + rr;
    u32x4 v = {0u, 0u, 0u, 0u};
    if (t >= 0 && t < L) v = *reinterpret_cast<const u32x4*>(PROJ + (size_t)(row0 - 8 + rr) * NC + g * 256 + oc * 8);
    *reinterpret_cast<u32x4*>(sIn + rr * 264 + oc * 8) = v;
  }
  __syncthreads();
  {
    const int oc = tid & 31, seg = tid >> 5;
    switch (g) {
      case 0: pool_window<1>(sIn, sP, oc, seg, t0, L); break;
      case 1: pool_window<2>(sIn, sP, oc, seg, t0, L); break;
      case 2: pool_window<4>(sIn, sP, oc, seg, t0, L); break;
      default: pool_window<8>(sIn, sP, oc, seg, t0, L); break;
    }
  }
  __syncthreads();
  const u16* W = reinterpret_cast<const u16*>(p.ws + WS_POOLWT) + (size_t)(l >> 1) * 262144 + (size_t)g * 65536;
  u32x2 gpre[4][4];
#pragma unroll
  for (int n = 0; n < 4; ++n)
#pragma unroll
    for (int m = 0; m < 4; ++m)
      gpre[n][m] = *reinterpret_cast<const u32x2*>(PROJ + (size_t)(row0 + m * 16 + fr) * NC + 1024 + g * 256 + wid * 64 + n * 16 + 4 * fq);
  f32x4 acc[4][4];
#pragma unroll
  for (int a = 0; a < 4; ++a)
#pragma unroll
    for (int b = 0; b < 4; ++b) acc[a][b] = f32x4{0.f, 0.f, 0.f, 0.f};
#pragma unroll 4
  for (int ks = 0; ks < 8; ++ks) {
    bf16x8 af[4], bfr[4];
#pragma unroll
    for (int m = 0; m < 4; ++m) af[m] = ld8(sP + (m * 16 + fr) * 264 + ks * 32 + fq * 8);
#pragma unroll
    for (int n = 0; n < 4; ++n) bfr[n] = ld8(W + (size_t)(wid * 64 + n * 16 + fr) * 256 + ks * 32 + fq * 8);
#pragma unroll
    for (int m = 0; m < 4; ++m)
#pragma unroll
      for (int n = 0; n < 4; ++n) acc[m][n] = mfma16(bfr[n], af[m], acc[m][n]);
  }
  const float* pscale = p.in[19 + 10 * l];
  u16* Y = reinterpret_cast<u16*>(p.ws + WS_H);
#pragma unroll
  for (int n = 0; n < 4; ++n) {
    const int col = g * 256 + wid * 64 + n * 16 + 4 * fq;
    const float4 sc = *reinterpret_cast<const float4*>(pscale + col);
#pragma unroll
    for (int m = 0; m < 4; ++m) {
      const int row = row0 + m * 16 + fr;
      const u32x2 gw = gpre[n][m];
      float y0 = acc[m][n][0] * sc.x * silu(bflo(gw[0])), y1 = acc[m][n][1] * sc.y * silu(bfhi(gw[0]));
      float y2 = acc[m][n][2] * sc.z * silu(bflo(gw[1])), y3 = acc[m][n][3] * sc.w * silu(bfhi(gw[1]));
      if (ZERO_MASK & 1) { y0 = y1 = y2 = y3 = 0.f; }
      *reinterpret_cast<u32x2*>(Y + (size_t)row * 2048 + col) = u32x2{pk2(y0, y1), pk2(y2, y3)};
    }
  }
}

DI void phase_mix_even(const Params& p, int l, unsigned char* lds, unsigned char* lds_all) {
#pragma unroll 1
  for (int it = blockIdx.x; it < 512; it += gridDim.x) { int bh, qb; heavy_map(it, bh, qb); diff_item(p, l, true, bh, qb, lds_all); }
#pragma unroll 1
  for (int it = blockIdx.x; it < 256; it += gridDim.x) diff_item(p, l, false, it, 0, lds_all);
#pragma unroll 1
  for (int it = VBID; it < 1536; it += VGRID) pool_item(p, l, it, lds);
}

DI void na_item(const Params& p, int l, bool sample, int bh, int qb, unsigned char* lds) {
  constexpr int NC = 7168;
  const int tid = TID8, lane = tid & 63, wid = tid >> 6, r = lane & 31, h = lane >> 5;
  const int b = bh >> 3, hd = bh & 7;
  u16* sQ = reinterpret_cast<u16*>(lds);
  u16* sK = sQ + 256 * 136;
  u16* sVT = sK + 64 * 136;
  float* sBias = reinterpret_cast<float*>(sVT + 128 * 72) + 64;
  const u16* PROJ = reinterpret_cast<const u16*>(p.ws + WS_PROJ);
  const u16* VT = reinterpret_cast<const u16*>(p.ws + WS_VT);
  const int seq0 = sample ? TP + b * 4096 : b * 256;
  const int token = seq0 + qb * 256 + wid * 32 + r;
  AttnSrc s;
  int qr = 0, qc = 0, rsmin = 0;
  f32x16 O[4];
  float lsum;
  const u16* qblk = PROJ + (size_t)(seq0 + qb * 256) * NC + hd * 128;
  if (sample) {
    __syncthreads();
    const float* rpb = p.in[18 + 10 * l] + hd * 465;
    for (int e = tid; e < 465; e += 512) sBias[e] = rpb[e] * LOG2E;
    const int r0 = qb * 4;
    qr = r0 + (wid >> 1); qc = (wid & 1) * 32 + r;
    rsmin = min(max(r0 - 4, 0), 56);
    const int rs1 = min(max(r0 - 1, 0), 56);
    s.k0 = reinterpret_cast<const u16*>(p.ws + WS_CK) + (size_t)l * 2097152 + (size_t)bh * 65536; s.ks0 = 128;
    s.vt0 = reinterpret_cast<const u16*>(p.ws + WS_CVT) + (size_t)l * 2097152 + (size_t)bh * 65536; s.vs0 = 512; s.n0 = 8;
    s.k1 = PROJ + (size_t)(seq0 + rsmin * 64) * NC + 1024 + hd * 128; s.ks1 = NC;
    s.vt1 = VT + 8388608 + (size_t)bh * 128 * 4096 + rsmin * 64; s.vs1 = 4096; s.n1 = rs1 + 8 - rsmin;
    attn_run<128, true>(s, qblk, NC, sQ, sK, sVT, O, lsum, qr, qc, rsmin, sBias);
  } else {
    s.k0 = nullptr; s.vt0 = nullptr; s.ks0 = 0; s.vs0 = 0; s.n0 = 0;
    s.k1 = PROJ + (size_t)seq0 * NC + 1024 + hd * 128; s.ks1 = NC;
    s.vt1 = VT + (size_t)bh * 128 * 256; s.vs1 = 256; s.n1 = 4;
    attn_run<128, false>(s, qblk, NC, sQ, sK, sVT, O, lsum, 0, 0, 0, nullptr);
  }
  const float inv = 1.f / lsum;
  const u16* gp = PROJ + (size_t)token * NC + 3072 + hd * 128;
  u16* yp = reinterpret_cast<u16*>(p.ws + WS_H) + (size_t)token * 2048 + hd * 128;
#pragma unroll
  for (int d = 0; d < 4; ++d)
#pragma unroll
    for (int q = 0; q < 4; ++q) {
      const int dv = d * 32 + 8 * q + 4 * h;
      const u32x2 gw = *reinterpret_cast<const u32x2*>(gp + dv);
      const float y0 = O[d][4 * q] * inv * silu(bflo(gw[0]));
      const float y1 = O[d][4 * q + 1] * inv * silu(bfhi(gw[0]));
      const float y2 = O[d][4 * q + 2] * inv * silu(bflo(gw[1]));
      const float y3 = O[d][4 * q + 3] * inv * silu(bfhi(gw[1]));
      *reinterpret_cast<u32x2*>(yp + dv) = (ZERO_MASK & 4) ? u32x2{0u, 0u} : u32x2{pk2(y0, y1), pk2(y2, y3)};
    }
}

DI void sgu_item(const Params& p, int l, int si, unsigned char* lds) {
  constexpr int NC = 7168;
  const int tid = TIDX, lane = tid & 63, wid = tid >> 6, fr = lane & 15, fq = lane >> 4;
  const int ch = si >> 2, g = si & 3, row0 = ch * 128;
  u16* vnT = reinterpret_cast<u16*>(lds);
  float* sMu = reinterpret_cast<float*>(vnT + 256 * 136);
  float* sRs = sMu + 128;
  const u16* PROJ = reinterpret_cast<const u16*>(p.ws + WS_PROJ);
  __syncthreads();
  {
    const int grp = tid >> 4, ln = tid & 15;
#pragma unroll 2
    for (int rr = 0; rr < 8; ++rr) {
      const u16* src = PROJ + (size_t)(row0 + grp * 8 + rr) * NC + 5120;
      float s = 0.f, ss = 0.f;
#pragma unroll
      for (int c8 = 0; c8 < 8; ++c8) {
        const u32x4 v = *reinterpret_cast<const u32x4*>(src + (ln + 16 * c8) * 8);
#pragma unroll
        for (int k = 0; k < 4; ++k) { const float a = bflo(v[k]), b = bfhi(v[k]); s += a + b; ss += a * a + b * b; }
      }
#pragma unroll
      for (int o = 8; o >= 1; o >>= 1) { s += __shfl_xor(s, o); ss += __shfl_xor(ss, o); }
      const float mu = s * (1.f / 1024.f);
      const float var = fmaxf(ss * (1.f / 1024.f) - mu * mu, 0.f);
      if (ln == 0) { sMu[grp * 8 + rr] = mu; sRs[grp * 8 + rr] = rsqrtf(var + LN_EPS); }
    }
  }
  __syncthreads();
  {
    const int j = tid & 127, hf = tid >> 7;
    const float mu = sMu[j], rs = sRs[j];
    const float* lng = p.in[19 + 10 * l] + g * 256;
    const u16* src = PROJ + (size_t)(row0 + j) * NC + 5120 + g * 256;
#pragma unroll 8
    for (int oc = hf * 16; oc < hf * 16 + 16; ++oc) {
      const u32x4 v = *reinterpret_cast<const u32x4*>(src + oc * 8);
      const float4 g0 = *reinterpret_cast<const float4*>(lng + oc * 8), g1 = *reinterpret_cast<const float4*>(lng + oc * 8 + 4);
      const float gg[8] = {g0.x, g0.y, g0.z, g0.w, g1.x, g1.y, g1.z, g1.w};
#pragma unroll
      for (int k = 0; k < 4; ++k) {
        const float a = (bflo(v[k]) - mu) * rs * gg[2 * k], b = (bfhi(v[k]) - mu) * rs * gg[2 * k + 1];
        const u32 w = pk2(a, b);
        vnT[(oc * 8 + 2 * k) * 136 + j] = (u16)(w & 0xffffu);
        vnT[(oc * 8 + 2 * k + 1) * 136 + j] = (u16)(w >> 16);
      }
    }
  }
  __syncthreads();
  const u16* W = reinterpret_cast<const u16*>(p.ws + WS_SGUW) + (size_t)(l >> 1) * 65536 + (size_t)g * 16384;
  const float* bs = p.in[21 + 10 * l] + g * 128;
  u16* Y = reinterpret_cast<u16*>(p.ws + WS_H);
#pragma unroll 1
  for (int ih = 0; ih < 2; ++ih) {
    f32x4 acc[4][4];
#pragma unroll
    for (int a = 0; a < 4; ++a)
#pragma unroll
      for (int b = 0; b < 4; ++b) acc[a][b] = f32x4{0.f, 0.f, 0.f, 0.f};
#pragma unroll
    for (int ks = 0; ks < 4; ++ks) {
      bf16x8 af[4], bfr[4];
#pragma unroll
      for (int m = 0; m < 4; ++m) af[m] = ld8(W + (size_t)(ih * 64 + m * 16 + fr) * 128 + ks * 32 + fq * 8);
#pragma unroll
      for (int n = 0; n < 4; ++n) bfr[n] = ld8(vnT + (wid * 64 + n * 16 + fr) * 136 + ks * 32 + fq * 8);
#pragma unroll
      for (int m = 0; m < 4; ++m)
#pragma unroll
        for (int n = 0; n < 4; ++n) acc[m][n] = mfma16(bfr[n], af[m], acc[m][n]);
    }
#pragma unroll
    for (int m = 0; m < 4; ++m) {
      const int ii = ih * 64 + m * 16 + fr;
      const float bias = bs[ii];
      const size_t rb = (size_t)(row0 + ii) * NC;
#pragma unroll
      for (int n = 0; n < 4; ++n) {
        const int c = g * 256 + wid * 64 + n * 16 + 4 * fq;
        const u32x2 uw = *reinterpret_cast<const u32x2*>(PROJ + rb + 4096 + c);
        const u32x2 dw = *reinterpret_cast<const u32x2*>(PROJ + rb + 6144 + c);
        float y0 = bflo(uw[0]) * (acc[m][n][0] + bias) * silu(bflo(dw[0])), y1 = bfhi(uw[0]) * (acc[m][n][1] + bias) * silu(bfhi(dw[0]));
        float y2 = bflo(uw[1]) * (acc[m][n][2] + bias) * silu(bflo(dw[1])), y3 = bfhi(uw[1]) * (acc[m][n][3] + bias) * silu(bfhi(dw[1]));
        if (ZERO_MASK & 8) { y0 = y1 = y2 = y3 = 0.f; }
        *reinterpret_cast<u32x2*>(Y + (size_t)(row0 + ii) * 2048 + 1024 + c) = u32x2{pk2(y0, y1), pk2(y2, y3)};
      }
    }
  }
}

DI void phase_mix_odd(const Params& p, int l, unsigned char* lds, unsigned char* lds_all) {
#pragma unroll 1
  for (int it = blockIdx.x; it < 512; it += gridDim.x) { int bh, qb; heavy_map(it, bh, qb); na_item(p, l, true, bh, qb, lds_all); }
#pragma unroll 1
  for (int it = blockIdx.x; it < 256; it += gridDim.x) na_item(p, l, false, it, 0, lds_all);
#pragma unroll 1
  for (int it = VBID; it < 768; it += VGRID) sgu_item(p, l, it, lds);
}

#define XB_TMO      128
#define XB_XCNT(j)  (256  + 64 * (j))
#define XB_XSUB(j)  (1280 + 64 * (j))
#define XB_XGEN(j)  (2304 + 64 * (j))
#define XB_TOP      3328
#define XB_TOPGEN   3392
#define XCD_BAR_WORDS 3456
#define XB_SPIN_CAP (1u << 18)
#define LAS __attribute__((address_space(3)))
DI unsigned xb_ld(unsigned* p)              { return __hip_atomic_load(p, __ATOMIC_RELAXED, __HIP_MEMORY_SCOPE_AGENT); }
DI unsigned xb_add(unsigned* p, unsigned v) { return __hip_atomic_fetch_add(p, v, __ATOMIC_RELAXED, __HIP_MEMORY_SCOPE_AGENT); }
DI unsigned xb_xcc_id() { return (unsigned)__builtin_amdgcn_s_getreg((3 << 11) | 20) & 0xFu; }
#define XB_SPIN(cond, bar) do { unsigned _sp = 0; while (cond) { __builtin_amdgcn_s_sleep(1); \
    if ((++_sp & 255u) == 0u) { if (xb_ld(&(bar)[XB_TMO])) break; if (_sp > XB_SPIN_CAP) { atomicAdd(&(bar)[XB_TMO], 1u); break; } } } } while (0)
struct XcdBarrier { unsigned* bar; unsigned x; volatile LAS unsigned* st; };
DI XcdBarrier xcd_barrier_post(unsigned* bar, volatile LAS unsigned* st) {
  XcdBarrier b; b.bar = bar; b.x = xb_xcc_id(); b.st = st;
  if (threadIdx.x == 0) (void)xb_add(&bar[XB_XCNT(b.x)], 1u);
  return b;
}
DI void xcd_barrier_complete(unsigned* bar, unsigned x, unsigned& nloc, unsigned& nx) {
  const unsigned G = gridDim.x * gridDim.y * gridDim.z;
  unsigned sum, cnt, mine, sp = 0u;
  for (;;) {
    sum = 0u; cnt = 0u; mine = 0u;
#pragma unroll
    for (unsigned j = 0; j < 16; ++j) { const unsigned c = xb_ld(&bar[XB_XCNT(j)]); sum += c; cnt += (c > 0u) ? 1u : 0u; mine = (j == x) ? c : mine; }
    if (sum == G) break;
    __builtin_amdgcn_s_sleep(1);
    if ((++sp & 255u) == 0u) { if (xb_ld(&bar[XB_TMO])) break; if (sp > XB_SPIN_CAP) { atomicAdd(&bar[XB_TMO], 1u); break; } }
  }
  nloc = mine > 0u ? mine : 1u; nx = cnt > 0u ? cnt : 1u;
}
DI void xcd_barrier(const XcdBarrier& b) {
  asm volatile("s_waitcnt vmcnt(0)" ::: "memory");
  __syncthreads();
  if (threadIdx.x == 0) {
    unsigned* bar = b.bar;
    __builtin_amdgcn_s_waitcnt(0);
    unsigned nloc = b.st[0], nx = b.st[1];
    if (nloc == 0u) { xcd_barrier_complete(bar, b.x, nloc, nx); b.st[0] = nloc; b.st[1] = nx; }
    const unsigned old = xb_add(&bar[XB_XSUB(b.x)], 1u);
    const unsigned gen = old / nloc;
    if (old + 1u == (gen + 1u) * nloc) {
      __builtin_amdgcn_fence(__ATOMIC_RELEASE, "agent");
      asm volatile("s_waitcnt vmcnt(0)" ::: "memory");
      const unsigned og = xb_add(&bar[XB_TOP], 1u);
      const unsigned tg = og / nx;
      if (og + 1u == (tg + 1u) * nx) xb_add(&bar[XB_TOPGEN], 1u);
      else XB_SPIN(xb_ld(&bar[XB_TOPGEN]) == tg, bar);
      __builtin_amdgcn_fence(__ATOMIC_ACQUIRE, "agent");
      xb_add(&bar[XB_XGEN(b.x)], 1u);
      asm volatile("s_waitcnt vmcnt(0)" ::: "memory");
    } else {
      XB_SPIN(xb_ld(&bar[XB_XGEN(b.x)]) == gen, bar);
      __builtin_amdgcn_fence(__ATOMIC_ACQUIRE, "agent");
      asm volatile("s_waitcnt vmcnt(0)" ::: "memory");
    }
  }
  __syncthreads();
}

__global__ void __launch_bounds__(512, 2) fwd_megakernel(Params p) {
  extern __shared__ __attribute__((aligned(16))) unsigned char lds[];
  cg::grid_group grid = cg::this_grid();
  volatile LAS unsigned* xst = (volatile LAS unsigned*)(lds + LDS_BYTES - 16);
  if (threadIdx.x == 0) { xst[0] = 0u; xst[1] = 0u; }
  __syncthreads();
  const XcdBarrier xb = xcd_barrier_post(reinterpret_cast<unsigned*>(p.ws + WS_BAR), xst);
  for (int ph = p.ph_lo; ph < p.ph_hi; ++ph) {
    unsigned char* hl = lds + HALF_ID * HALF_LDS;
    if (ph == 0) phase_prep(p, hl);
    else if (ph == 1) phase_mod0(p);
    else {
      const int l = (ph - 2) >> 2, s = (ph - 2) & 3;
      if (s == 0) { if (l & 1) gemm_phase<G_IN_ODD>(p, l, lds); else gemm_phase<G_IN_EVEN>(p, l, lds); }
      else if (s == 1) { if (l & 1) phase_mix_odd(p, l, hl, lds); else phase_mix_even(p, l, hl, lds); }
      else if (s == 2) gemm_phase<G_OUT>(p, l, lds);
      else phase_ln(p, l);
    }
    if (ph + 1 < p.ph_hi) {
      if (p.ph_lo < 0) grid.sync();
      xcd_barrier(xb);
    }
  }
}

extern "C" void kernel_launch(void* const* d_in, const int* in_sizes, int n_in, void* d_out, int out_size, void* d_ws, size_t ws_size,
                              hipStream_t stream) {
  static int grid_blocks = 0;
  if (grid_blocks == 0) {
    if (n_in != 52 || ws_size < WS_END) {
      fprintf(stderr, "kernel_launch: expected 52 inputs and >= %zu bytes of workspace; got %d, %zu\n", (size_t)WS_END, n_in, ws_size);
      grid_blocks = -1;
      return;
    }
    int dev = 0, cus = 0, per_cu = 0;
    hipGetDevice(&dev);
    hipDeviceGetAttribute(&cus, hipDeviceAttributeMultiprocessorCount, dev);
    hipFuncSetAttribute((const void*)fwd_megakernel, hipFuncAttributeMaxDynamicSharedMemorySize, LDS_BYTES);
    hipOccupancyMaxActiveBlocksPerMultiprocessor(&per_cu, (const void*)fwd_megakernel, 512, LDS_BYTES);
    (void)hipGetLastError();
    grid_blocks = cus;
  }
  if (grid_blocks < 0) return;
  Params p{};
  for (int i = 0; i < 52; ++i) p.in[i] = (const float*)d_in[i];
  p.out = (float*)d_out;
  p.ws = (unsigned char*)d_ws;
#if MULTI
  for (int ph = 0; ph < NPHASE; ++ph) {
    p.ph_lo = ph; p.ph_hi = ph + 1;
    hipLaunchKernelGGL(fwd_megakernel, dim3(grid_blocks), dim3(512), LDS_BYTES, stream, p);
  }
#else
  p.ph_lo = 0; p.ph_hi = NPHASE;
  if (hipMemsetAsync((char*)d_ws + WS_BAR, 0, XCD_BAR_WORDS * 4, stream) != hipSuccess) { fprintf(stderr, "kernel_launch: memset of barrier words failed\n"); return; }
  void* args[] = {&p};
  hipError_t e = hipLaunchCooperativeKernel((const void*)fwd_megakernel, dim3(grid_blocks), dim3(512), args, LDS_BYTES, stream);
  if (e != hipSuccess) fprintf(stderr, "cooperative launch failed: %s (grid %d)\n", hipGetErrorString(e), grid_blocks);
#endif
}
```

```cpp
#include <hip/hip_runtime.h>
#include <hip/hip_cooperative_groups.h>
#include <cstdio>
namespace cg = cooperative_groups;

#define DI __device__ __forceinline__
typedef unsigned short u16;
typedef unsigned int u32;
using bf16x8 = __attribute__((ext_vector_type(8))) short;
using f32x4 = __attribute__((ext_vector_type(4))) float;
using f32x16 = __attribute__((ext_vector_type(16))) float;
using u32x4 = __attribute__((ext_vector_type(4))) unsigned;
using u32x2 = __attribute__((ext_vector_type(2))) unsigned;
typedef __bf16 bf2_t __attribute__((ext_vector_type(2)));
typedef float f2_t __attribute__((ext_vector_type(2)));

#ifndef MULTI
#define MULTI 0
#endif
#ifndef REP0
#define REP0 1
#endif
#ifndef REP1
#define REP1 1
#endif
#ifndef ZERO_MASK
#define ZERO_MASK 0
#endif

constexpr int T_ALL = 24576, TP = 8192, DM = 2048;
constexpr float LOG2E = 1.4426950408889634f;
constexpr float ALPHA = 1.6817928305074290f;
constexpr float LN_EPS = 1e-5f;
constexpr int HALF_LDS = 76288;
constexpr int LDS_BYTES = 2 * HALF_LDS + 16;
constexpr int NPHASE = 18;

constexpr size_t SZ_WIN_E = (size_t)6144 * 2048 * 2, SZ_WIN_O = (size_t)7168 * 2048 * 2;
constexpr size_t WS_WINT = 0;
constexpr size_t WS_WOUTT = WS_WINT + 2 * SZ_WIN_E + 2 * SZ_WIN_O;
constexpr size_t WS_POOLWT = WS_WOUTT + (size_t)4 * 2048 * 2048 * 2;
constexpr size_t WS_SGUW = WS_POOLWT + (size_t)2 * 4 * 256 * 256 * 2;
constexpr size_t WS_CK = WS_SGUW + (size_t)2 * 4 * 128 * 128 * 2;
constexpr size_t WS_CVT = WS_CK + (size_t)4 * 4194304;
constexpr size_t WS_MOD = WS_CVT + (size_t)4 * 4194304;
constexpr size_t WS_ROPE = WS_MOD + (size_t)4 * 5 * 6144 * 4;
constexpr size_t WS_H = WS_ROPE + 8192;
constexpr size_t WS_PROJ = WS_H + (size_t)T_ALL * 2048 * 2;
constexpr size_t WS_VT = WS_PROJ + (size_t)T_ALL * 7168 * 2;
constexpr size_t WS_BAR = WS_VT + (size_t)T_ALL * 1024 * 2;
constexpr size_t WS_STATS = WS_BAR + 16384;
constexpr size_t WS_END = WS_STATS + (size_t)T_ALL * 8;

struct Params {
  const float* in[52];
  float* out;
  unsigned char* ws;
  int ph_lo, ph_hi;
};

DI size_t ws_wint(int l) { return WS_WINT + (size_t)(l >> 1) * (SZ_WIN_E + SZ_WIN_O) + ((l & 1) ? SZ_WIN_E : 0); }

DI u32 pk2(float a, float b) { f2_t v = {a, b}; bf2_t r = __builtin_convertvector(v, bf2_t); return __builtin_bit_cast(u32, r); }
DI float bflo(u32 w) { return __uint_as_float(w << 16); }
DI float bfhi(u32 w) { return __uint_as_float(w & 0xffff0000u); }
DI float bf1(u16 w) { return __uint_as_float(((u32)w) << 16); }
DI float ex2(float x) { return __builtin_amdgcn_exp2f(x); }
DI float silu(float x) { return x / (1.f + __expf(-x)); }
DI f32x4 mfma16(bf16x8 a, bf16x8 b, f32x4 c) { return __builtin_amdgcn_mfma_f32_16x16x32_bf16(a, b, c, 0, 0, 0); }
DI f32x16 mfma32(bf16x8 a, bf16x8 b, f32x16 c) { return __builtin_amdgcn_mfma_f32_32x32x16_bf16(a, b, c, 0, 0, 0); }
DI bf16x8 ld8(const u16* p) { return *reinterpret_cast<const bf16x8*>(p); }
DI int opq(int x) { asm volatile("" : "+v"(x)); return x; }
#define TIDX (opq((int)threadIdx.x) & 255)
#define TID8 (opq((int)threadIdx.x))
#define HALF_ID (opq((int)threadIdx.x) >> 8)
#define VBID ((int)((blockIdx.x & 7u) | ((unsigned)HALF_ID << 3) | ((blockIdx.x >> 3) << 4)))
#define VGRID ((int)gridDim.x * 2)

enum { G_IN_EVEN = 0, G_IN_ODD = 1, G_OUT = 2 };

namespace pg8 {
#define PG8_LAS __attribute__((address_space(3)))
typedef unsigned short bf16_t;
typedef short bf16x8 __attribute__((ext_vector_type(8)));
typedef float f32x4 __attribute__((ext_vector_type(4)));
typedef unsigned u32x4 __attribute__((ext_vector_type(4)));
constexpr int BM = 256, BK = 64, HALF = 128, HTB = HALF * BK * 2  , STAGE_BYTES = 8 * HTB, NXCD = 8, WGM = 8;

__host__ __device__ __forceinline__ int lds_byte(int r, int c) { const int st = (r >> 4) * 2 + (c >> 5), rr = r & 15, cc = c & 31, ob = rr * 64 + cc * 2; return st * 1024 + (ob ^ (((ob >> 9) & 1) << 5)); }
__host__ __device__ __forceinline__ void stage_rc(int b, int& R, int& C) { const int st = b / 1024, sb = b % 1024, swz = sb ^ (((sb >> 9) & 1) << 5); R = (st >> 1) * 16 + swz / 64; C = (st & 1) * 32 + (swz % 64) / 2; }
__host__ __device__ __forceinline__ int perm32(int rho) { const int n = rho >> 4, i = rho & 15; return 8 * (i >> 2) + 4 * n + (i & 3); }

struct Unit { int pm, pn; };
struct Gemm { const bf16_t* A; const bf16_t* Bt; int M, N, K; };

struct StaticOrder {
    int nM, nN, nwg, G, c;
    __host__ __device__ void init(int M, int N, int G_, int c_) { nM = M / BM; nN = N / BM; nwg = nM * nN; G = G_; c = c_; }
    __host__ __device__ bool next(int i, Unit& u) const {
        const long L = (long)i * G + c; if (L >= nwg) return false;
        int wgid = (int)L; { const int q = nwg / NXCD, r = nwg % NXCD, xcd = wgid % NXCD, off = wgid / NXCD; wgid = (xcd < r ? xcd * (q + 1) : r * (q + 1) + (xcd - r) * q) + off; }
        const int nig = WGM * nN, gid = wgid / nig, fm = gid * WGM, gsz = (nM - fm) < WGM ? (nM - fm) : WGM;
        u.pm = fm + ((wgid % nig) % gsz); u.pn = (wgid % nig) / gsz; return true;
    }
    __device__ __forceinline__ void a_ready(const Unit&) const {}
    __device__ __forceinline__ void done(const Unit&) const {}
};

template <class Epi, class Sched, bool STAMP = false>
__device__ __forceinline__ void gemm_phase(PG8_LAS unsigned char* lds, const Gemm g, const Sched& S, const Epi& E, unsigned long long* stamps) {
    const int tid = opq((int)threadIdx.x), wid = __builtin_amdgcn_readfirstlane(tid >> 6), lane = tid & 63, wr = wid >> 2, wc = wid & 3, fr = lane & 15, fq = lane >> 4;
    const int K = g.K, nt = K / BK;
    int ts_lo = 0, ts_hi = 0, nts = 0; const unsigned long long rt_entry = STAMP ? (unsigned long long)wall_clock64() : 0ull;
#define PG8_STAMP() do { if (STAMP && wid == 0 && nts < 64) { const unsigned long long _c = (unsigned long long)clock64(); \
        ts_lo = (lane == nts) ? (int)(unsigned)_c : ts_lo; ts_hi = (lane == nts) ? (int)(unsigned)(_c >> 32) : ts_hi; ++nts; } } while (0)
    PG8_STAMP();
    unsigned voffA[2], voffB[2];
#pragma unroll
    for (int i = 0; i < 2; ++i) { int R, C; stage_rc(tid * 16 + i * 8192, R, C); const int Rb = Epi::PERM ? ((R & ~31) + perm32(R & 31)) : R;
        voffA[i] = (unsigned)(R * K + C) * 2u; voffB[i] = (unsigned)(Rb * K + C) * 2u; }
    const size_t kstep = (size_t)(BK * 2);
    const size_t hstep = (size_t)HALF * K * 2;
    const size_t tstep = 2 * hstep;
    const unsigned ldsw = (unsigned)wid * 1024u;
    const int aoff = lds_byte(wr * 64 + fr, fq * 8), boff = lds_byte(wc * 32 + fr, fq * 8);
#define PG8_SA(b, h) (((b) * 2 + (h)) * HTB)
#define PG8_SB(b, h) ((4 + (b) * 2 + (h)) * HTB)
#define PG8_STAGE(bufoff, gbase, voff) do { _Pragma("unroll") for (int _i = 0; _i < 2; ++_i) \
        __builtin_amdgcn_global_load_lds((const unsigned*)((const char*)(gbase) + (voff)[_i]), (PG8_LAS unsigned*)(lds + (bufoff) + ldsw + _i * 8192), 16, 0, 0); } while (0)
#define PG8_LDA(dst, b, h) do { _Pragma("unroll") for (int m = 0; m < 4; ++m) _Pragma("unroll") for (int k = 0; k < 2; ++k) dst[m][k] = *(const PG8_LAS bf16x8*)(lds + PG8_SA(b, h) + aoff + m * 2048 + k * 1024); } while (0)
#define PG8_LDB(dst, b, h) do { _Pragma("unroll") for (int n = 0; n < 2; ++n) _Pragma("unroll") for (int k = 0; k < 2; ++k) dst[n][k] = *(const PG8_LAS bf16x8*)(lds + PG8_SB(b, h) + boff + n * 2048 + k * 1024); } while (0)
#define PG8_MMA(ai, bj, At, Bt) do { __builtin_amdgcn_s_setprio(1); _Pragma("unroll") for (int m = 0; m < 4; ++m) _Pragma("unroll") for (int n = 0; n < 2; ++n) _Pragma("unroll") for (int k = 0; k < 2; ++k) \
        acc[ai][bj][m][n] = __builtin_amdgcn_mfma_f32_16x16x32_bf16(Bt[n][k], At[m][k], acc[ai][bj][m][n], 0, 0, 0); __builtin_amdgcn_s_setprio(0); } while (0)
#define PG8_WAIT_V(n) asm volatile("s_waitcnt vmcnt(" #n ")" ::: "memory")
#define PG8_WAIT_L(n) asm volatile("s_waitcnt lgkmcnt(" #n ")" ::: "memory")
#define PG8_BAR __builtin_amdgcn_s_barrier()
#define PG8_SCHED __builtin_amdgcn_sched_barrier(0)
    Unit cur, nxt; int ui = 0;
    if (!S.next(0, cur)) return;
    f32x4 acc[2][2][4][2];
#pragma unroll
    for (int a = 0; a < 2; ++a)
#pragma unroll
        for (int b = 0; b < 2; ++b)
#pragma unroll
            for (int m = 0; m < 4; ++m)
#pragma unroll
                for (int n = 0; n < 2; ++n) acc[a][b][m][n] = (f32x4){0.f, 0.f, 0.f, 0.f};
    bf16x8 At[4][2], B0[2][2], B1[2][2];
    const char* cA = (const char*)g.A + (size_t)cur.pm * tstep; const char* cB = (const char*)g.Bt + (size_t)cur.pn * tstep;
    S.a_ready(cur);
    PG8_STAGE(PG8_SB(0, 0), cB, voffB); PG8_STAGE(PG8_SA(0, 0), cA, voffA); PG8_STAGE(PG8_SB(0, 1), cB + hstep, voffB); PG8_STAGE(PG8_SA(0, 1), cA + hstep, voffA);
    if (wr == 1) PG8_BAR;
    PG8_WAIT_V(4); PG8_BAR;
    PG8_STAGE(PG8_SB(1, 0), cB + kstep, voffB); PG8_STAGE(PG8_SA(1, 0), cA + kstep, voffA); PG8_STAGE(PG8_SB(1, 1), cB + hstep + kstep, voffB);
    PG8_WAIT_V(6); PG8_BAR;
    PG8_STAMP();
    for (;;) {
        const bool has_next = S.next(ui + 1, nxt);
        const char* nA = has_next ? (const char*)g.A + (size_t)nxt.pm * tstep : cA; const char* nB = has_next ? (const char*)g.Bt + (size_t)nxt.pn * tstep : cB;
        for (int t = 0; t < nt; t += 2) {
            const bool last = (t == nt - 2);
            const char* a1 = cA + (size_t)(t + 1) * kstep;
            const char* a2 = last ? nA : cA + (size_t)(t + 2) * kstep; const char* b2 = last ? nB : cB + (size_t)(t + 2) * kstep;
            const char* a3 = a2 + kstep; const char* b3 = b2 + kstep;
            if (last && has_next) S.a_ready(nxt);
            PG8_LDB(B0, 0, 0); PG8_SCHED; PG8_LDA(At, 0, 0); PG8_STAGE(PG8_SA(1, 1), a1 + hstep, voffA);
            PG8_WAIT_L(8); PG8_BAR; PG8_WAIT_L(0); PG8_MMA(0, 0, At, B0); PG8_BAR; PG8_SCHED;
            PG8_LDB(B1, 0, 1); PG8_STAGE(PG8_SB(0, 0), b2, voffB);
            PG8_BAR; PG8_WAIT_L(0); PG8_MMA(0, 1, At, B1); PG8_BAR;
            PG8_LDA(At, 0, 1); PG8_STAGE(PG8_SA(0, 0), a2, voffA);
            PG8_BAR; PG8_WAIT_L(0); PG8_MMA(1, 0, At, B0); PG8_BAR; PG8_SCHED;
            PG8_STAGE(PG8_SB(0, 1), b2 + hstep, voffB);
            PG8_WAIT_V(6); PG8_BAR; PG8_MMA(1, 1, At, B1); PG8_BAR;
            PG8_LDB(B0, 1, 0); PG8_SCHED; PG8_LDA(At, 1, 0); PG8_STAGE(PG8_SA(0, 1), a2 + hstep, voffA);
            PG8_WAIT_L(8); PG8_BAR; PG8_WAIT_L(0); PG8_MMA(0, 0, At, B0); PG8_BAR; PG8_SCHED;
            PG8_LDB(B1, 1, 1); PG8_STAGE(PG8_SB(1, 0), b3, voffB);
            PG8_BAR; PG8_WAIT_L(0); PG8_MMA(0, 1, At, B1); PG8_BAR;
            PG8_LDA(At, 1, 1); PG8_STAGE(PG8_SA(1, 0), a3, voffA);
            PG8_BAR; PG8_WAIT_L(0); PG8_MMA(1, 0, At, B0); PG8_BAR; PG8_SCHED;
            PG8_STAGE(PG8_SB(1, 1), b3 + hstep, voffB);
            PG8_WAIT_V(6); PG8_BAR; PG8_MMA(1, 1, At, B1); PG8_BAR;
        }
        PG8_STAMP();
        if constexpr (!Epi::AFTER_DRAIN) { E(acc, cur, wr, wc, fr, fq); S.done(cur); }
        PG8_STAMP();
        if (!has_next) break;
#pragma unroll
        for (int a = 0; a < 2; ++a)
#pragma unroll
            for (int b = 0; b < 2; ++b)
#pragma unroll
                for (int m = 0; m < 4; ++m)
#pragma unroll
                    for (int n = 0; n < 2; ++n) acc[a][b][m][n] = (f32x4){0.f, 0.f, 0.f, 0.f};
        cur = nxt; cA = nA; cB = nB; ++ui;
    }
    PG8_WAIT_V(0);
    if (wr == 0) PG8_BAR;
    PG8_BAR;
    if constexpr (Epi::AFTER_DRAIN) { E.fused(acc, cur, wr, wc, fr, fq, lds, wid, lane); S.done(cur); }
    PG8_STAMP();
    if (STAMP && wid == 0) { stamps[lane] = lane < nts ? (((unsigned long long)(unsigned)ts_hi << 32) | (unsigned)ts_lo) : 0ull;
        if (lane == 62) stamps[62] = rt_entry; if (lane == 63) stamps[63] = (unsigned long long)wall_clock64(); }
#undef PG8_STAMP
#undef PG8_SA
#undef PG8_SB
#undef PG8_STAGE
#undef PG8_LDA
#undef PG8_LDB
#undef PG8_MMA
#undef PG8_WAIT_V
#undef PG8_WAIT_L
#undef PG8_BAR
#undef PG8_SCHED
}
}

DI void tr_tile(const float* __restrict__ src, size_t ld_src, u16* __restrict__ dst, size_t ld_dst, float* sT) {
  const int tid = TIDX;
  const int r = tid >> 4, c4 = (tid & 15) * 4;
#pragma unroll
  for (int i = 0; i < 4; ++i)
#pragma unroll
    for (int hf = 0; hf < 2; ++hf) {
      float4 v = *reinterpret_cast<const float4*>(src + (size_t)(r + 16 * i) * ld_src + c4 + 64 * hf);
      float* d = sT + (r + 16 * i) * 129 + c4 + 64 * hf;
      d[0] = v.x; d[1] = v.y; d[2] = v.z; d[3] = v.w;
    }
  __syncthreads();
  const int n = tid >> 1, ks = (tid & 1) * 32;
  u32 w[16];
#pragma unroll
  for (int j = 0; j < 16; ++j) w[j] = pk2(sT[(ks + 2 * j) * 129 + n], sT[(ks + 2 * j + 1) * 129 + n]);
  u32x4* o = reinterpret_cast<u32x4*>(dst + (size_t)n * ld_dst + ks);
  o[0] = u32x4{w[0], w[1], w[2], w[3]};
  o[1] = u32x4{w[4], w[5], w[6], w[7]};
  o[2] = u32x4{w[8], w[9], w[10], w[11]};
  o[3] = u32x4{w[12], w[13], w[14], w[15]};
  __syncthreads();
}

DI void cvt8(const float* __restrict__ src, u16* __restrict__ dst) {
  float4 a = *reinterpret_cast<const float4*>(src);
  float4 b = *reinterpret_cast<const float4*>(src + 4);
  *reinterpret_cast<u32x4*>(dst) = u32x4{pk2(a.x, a.y), pk2(a.z, a.w), pk2(b.x, b.y), pk2(b.z, b.w)};
}

DI void mod_item(const Params& p, int i, unsigned char* lds) {
  const int tid = TIDX;
  const int l = i / 96, n0 = (i % 96) * 64;
  float* sS = reinterpret_cast<float*>(lds);
  float* red = sS + 5 * 2048;
  const float* c = p.in[10];
  const float* cctx = p.in[11];
  for (int e = tid; e < 5 * 2048; e += 256) {
    int v = e >> 11, k = e & 2047;
    float x = (v == 0) ? cctx[k] : c[(v - 1) * 2048 + k];
    sS[e] = silu(x);
  }
  __syncthreads();
  const int kk = tid >> 4, c4 = (tid & 15) * 4;
  const float* W = p.in[12 + 10 * l] + n0 + c4;
  f32x4 acc[5];
#pragma unroll
  for (int v = 0; v < 5; ++v) acc[v] = f32x4{0.f, 0.f, 0.f, 0.f};
#pragma unroll 16
  for (int k = kk; k < 2048; k += 16) {
    float4 w = *reinterpret_cast<const float4*>(W + (size_t)k * 6144);
#pragma unroll
    for (int v = 0; v < 5; ++v) {
      float s = sS[v * 2048 + k];
      acc[v][0] += s * w.x; acc[v][1] += s * w.y; acc[v][2] += s * w.z; acc[v][3] += s * w.w;
    }
  }
#pragma unroll
  for (int v = 0; v < 5; ++v)
#pragma unroll
    for (int q = 0; q < 4; ++q) red[(kk * 5 + v) * 64 + c4 + q] = acc[v][q];
  __syncthreads();
  for (int t2 = tid; t2 < 320; t2 += 256) {
    int v = t2 >> 6, n = t2 & 63;
    float s = 0.f;
#pragma unroll
    for (int k2 = 0; k2 < 16; ++k2) s += red[(k2 * 5 + v) * 64 + n];
    float* mod = reinterpret_cast<float*>(p.ws + WS_MOD);
    mod[(size_t)(l * 5 + v) * 6144 + n0 + n] = s + p.in[13 + 10 * l][n0 + n];
  }
  __syncthreads();
}

DI void phase_prep(const Params& p, unsigned char* lds) {
  constexpr int N_MOD = 384, N_TRWIN = 6656, N_TRWOUT = 2048, N_TRPOOL = 64, N_SGU = 64, N_CK = 4096, N_CV = 1024;
  constexpr int TOTAL = N_MOD + N_TRWIN + N_TRWOUT + N_TRPOOL + N_SGU + N_CK + N_CV + 1;
  const int tid = TIDX;
  float* sT = reinterpret_cast<float*>(lds);
  for (int it = VBID; it < TOTAL; it += VGRID) {
    int i = it;
    if (i < N_MOD) { mod_item(p, i, lds); continue; }
    i -= N_MOD;
    if (i < N_TRWIN) {
      int l, base;
      if (i < 1536) { l = 0; base = 0; } else if (i < 3328) { l = 1; base = 1536; } else if (i < 4864) { l = 2; base = 3328; } else { l = 3; base = 4864; }
      i -= base;
      const int N = (l & 1) ? 7168 : 6144, nN = N / 128;
      const int kt = i / nN, nt = i % nN;
      tr_tile(p.in[14 + 10 * l] + (size_t)kt * 64 * N + nt * 128, N,
              reinterpret_cast<u16*>(p.ws + ws_wint(l)) + (size_t)nt * 128 * 2048 + kt * 64, 2048, sT);
      continue;
    }
    i -= N_TRWIN;
    if (i < N_TRWOUT) {
      const int l = i >> 9, r = i & 511, kt = r >> 4, nt = r & 15;
      tr_tile(p.in[15 + 10 * l] + (size_t)kt * 64 * 2048 + nt * 128, 2048,
              reinterpret_cast<u16*>(p.ws + WS_WOUTT) + (size_t)l * 2048 * 2048 + (size_t)nt * 128 * 2048 + kt * 64, 2048, sT);
      continue;
    }
    i -= N_TRWOUT;
    if (i < N_TRPOOL) {
      const int e = i >> 5, r = i & 31, g = r >> 3, t = r & 7, kt = t >> 1, nt = t & 1;
      tr_tile(p.in[18 + 20 * e] + (size_t)g * 65536 + kt * 64 * 256 + nt * 128, 256,
              reinterpret_cast<u16*>(p.ws + WS_POOLWT) + (size_t)e * 262144 + g * 65536 + nt * 128 * 256 + kt * 64, 256, sT);
      continue;
    }
    i -= N_TRPOOL;
    if (i < N_SGU) {
      const int e = i >> 5, ch = i & 31;
      const size_t off = (size_t)ch * 2048 + tid * 8;
      cvt8(p.in[30 + 20 * e] + off, reinterpret_cast<u16*>(p.ws + WS_SGUW) + (size_t)e * 65536 + off);
      continue;
    }
    i -= N_SGU;
    if (i < N_CK) {
      const int l = i >> 10, ch = i & 1023;
      const size_t off = (size_t)ch * 2048 + tid * 8;
      cvt8(p.in[2 + 2 * l] + off, reinterpret_cast<u16*>(p.ws + WS_CK) + (size_t)l * 2097152 + off);
      continue;
    }
    i -= N_CK;
    if (i < N_CV) {
      const int l = i >> 8, r = i & 255, bh = r >> 3, kt = r & 7;
      tr_tile(p.in[3 + 2 * l] + (size_t)bh * 65536 + kt * 64 * 128, 128,
              reinterpret_cast<u16*>(p.ws + WS_CVT) + (size_t)l * 2097152 + (size_t)bh * 65536 + kt * 64, 512, sT);
      continue;
    }
    {
      float* rc = reinterpret_cast<float*>(p.ws + WS_ROPE);
      for (int e = tid; e < 1024; e += 256) {
        int pos = e >> 4, fi = e & 15;
        float inv = 1.0f / powf(10000.0f, (float)(2 * fi) / 32.0f);
        float ang = (float)pos * inv;
        rc[e] = cosf(ang);
        rc[1024 + e] = sinf(ang);
      }
    }
  }
}

DI void phase_mod0(const Params& p) {
  const int tid = TIDX;
  const float* mod = reinterpret_cast<const float*>(p.ws + WS_MOD);
  u16* H = reinterpret_cast<u16*>(p.ws + WS_H);
  for (int it = VBID; it < T_ALL / 4; it += VGRID) {
#pragma unroll
    for (int rr = 0; rr < 4; ++rr) {
      const int row = it * 4 + rr;
      const int cond = row < TP ? 0 : 1 + ((row - TP) >> 12);
      const float* src = row < TP ? p.in[0] + (size_t)row * 2048 : p.in[1] + (size_t)(row - TP) * 2048;
      const int e = tid * 8;
      const float* sh = mod + (size_t)cond * 6144 + e;
      float4 a = *reinterpret_cast<const float4*>(src + e), b = *reinterpret_cast<const float4*>(src + e + 4);
      float4 s0 = *reinterpret_cast<const float4*>(sh), s1 = *reinterpret_cast<const float4*>(sh + 4);
      float4 c0 = *reinterpret_cast<const float4*>(sh + 2048), c1 = *reinterpret_cast<const float4*>(sh + 2052);
      u32x4 o = {pk2(a.x * (1.f + c0.x) + s0.x, a.y * (1.f + c0.y) + s0.y), pk2(a.z * (1.f + c0.z) + s0.z, a.w * (1.f + c0.w) + s0.w),
                 pk2(b.x * (1.f + c1.x) + s1.x, b.y * (1.f + c1.y) + s1.y), pk2(b.z * (1.f + c1.z) + s1.z, b.w * (1.f + c1.w) + s1.w)};
      *reinterpret_cast<u32x4*>(H + (size_t)row * 2048 + e) = o;
    }
  }
}


template <int MODE>
struct EpiIn {
  static constexpr bool PERM = false, AFTER_DRAIN = false;
  u16* PROJ; u16* VT; float* kout; float* vout; const float* ropeC; const float* ropeS;
  DI void operator()(const f32x4 (&acc)[2][2][4][2], const pg8::Unit& u, int wr, int wc, int fr, int fq) const {
    constexpr int NC = (MODE == G_IN_EVEN) ? 6144 : 7168;
    constexpr int SEC_Q = (MODE == G_IN_EVEN) ? 2 : 0, SEC_K = (MODE == G_IN_EVEN) ? 3 : 1, SEC_V = (MODE == G_IN_EVEN) ? 4 : 2;
    const int sec = u.pn >> 2;
    const bool prompt = u.pm < 32;
    const bool isq = sec == SEC_Q, isk = sec == SEC_K;
    const bool rope = (MODE == G_IN_EVEN) && (isq || isk) && !prompt;
    const float sc = isq ? ((MODE == G_IN_EVEN) ? 0.125f * LOG2E : 0.08838834764831845f * LOG2E) : 1.0f;
#pragma unroll
    for (int ai = 0; ai < 2; ++ai)
#pragma unroll
      for (int m = 0; m < 4; ++m) {
        const int row = u.pm * 256 + ai * 128 + wr * 64 + m * 16 + fr;
        int b, t;
        if (prompt) { b = row >> 8; t = row & 255; } else { const int rs = row - TP; b = rs >> 12; t = rs & 4095; }
#pragma unroll
        for (int bj = 0; bj < 2; ++bj) {
          const int hh = (u.pn & 3) * 2 + bj;
          const int d0 = wc * 32 + 4 * fq;
          if (sec == SEC_V) {
#pragma unroll
            for (int n = 0; n < 2; ++n) {
              const f32x4 v = acc[ai][bj][m][n];
              const int dv = d0 + 16 * n;
              const u32 w01 = pk2(v[0], v[1]), w23 = pk2(v[2], v[3]);
              if (prompt) {
                u16* vt = VT + ((size_t)((b * 8 + hh) * 128 + dv)) * 256 + t;
                vt[0] = (u16)(w01 & 0xffffu); vt[256] = (u16)(w01 >> 16); vt[512] = (u16)(w23 & 0xffffu); vt[768] = (u16)(w23 >> 16);
                *reinterpret_cast<float4*>(vout + ((size_t)((b * 8 + hh) * 256 + t)) * 128 + dv) = float4{v[0], v[1], v[2], v[3]};
              } else {
                u16* vt = VT + 8388608 + ((size_t)((b * 8 + hh) * 128 + dv)) * 4096 + t;
                vt[0] = (u16)(w01 & 0xffffu); vt[4096] = (u16)(w01 >> 16); vt[8192] = (u16)(w23 & 0xffffu); vt[12288] = (u16)(w23 >> 16);
              }
            }
          } else {
            f32x4 v0 = acc[ai][bj][m][0], v1 = acc[ai][bj][m][1];
            if (isk && prompt) {
              float* ko = kout + ((size_t)((b * 8 + hh) * 256 + t)) * 128 + d0;
              *reinterpret_cast<float4*>(ko) = float4{v0[0], v0[1], v0[2], v0[3]};
              *reinterpret_cast<float4*>(ko + 16) = float4{v1[0], v1[1], v1[2], v1[3]};
            }
            if (rope) {
              const int pos = (wc & 1) ? (t & 63) : (t >> 6);
              const float4 cs = *reinterpret_cast<const float4*>(ropeC + pos * 16 + 4 * fq);
              const float4 sn = *reinterpret_cast<const float4*>(ropeS + pos * 16 + 4 * fq);
              const float c4[4] = {cs.x, cs.y, cs.z, cs.w}, s4[4] = {sn.x, sn.y, sn.z, sn.w};
#pragma unroll
              for (int j = 0; j < 4; ++j) {
                const float x1 = v0[j], x2 = v1[j];
                v0[j] = x1 * c4[j] - x2 * s4[j];
                v1[j] = x1 * s4[j] + x2 * c4[j];
              }
            }
            u16* dst = PROJ + (size_t)row * NC + u.pn * 256 + bj * 128 + d0;
            *reinterpret_cast<u32x2*>(dst) = u32x2{pk2(v0[0] * sc, v0[1] * sc), pk2(v0[2] * sc, v0[3] * sc)};
            *reinterpret_cast<u32x2*>(dst + 16) = u32x2{pk2(v1[0] * sc, v1[1] * sc), pk2(v1[2] * sc, v1[3] * sc)};
          }
        }
      }
  }
};

struct EpiOut {
  static constexpr bool PERM = false, AFTER_DRAIN = false;
  float* X; const float* x0; const float* x1; const float* mod; const float* lng; const float* lnb; const float2* stats; int l;
  DI void operator()(const f32x4 (&acc)[2][2][4][2], const pg8::Unit& u, int wr, int wc, int fr, int fq) const {
    const bool prompt = u.pm < 32;
    const int cond = prompt ? 0 : 1 + ((u.pm * 256 - TP) >> 12);
    const float* gate = mod + (size_t)(l * 5 + cond) * 6144 + 4096;
    const int col0 = u.pn * 256 + wc * 32 + 4 * fq;
    const int row0 = u.pm * 256 + wr * 64 + fr;
    u16* Xb = reinterpret_cast<u16*>(X);
    if (l != 0) {
      u32x2 zr[2][4][2][2];
      float2 st[2][4];
#pragma unroll
      for (int ai = 0; ai < 2; ++ai)
#pragma unroll
        for (int m = 0; m < 4; ++m) {
          const int row = row0 + ai * 128 + m * 16;
          st[ai][m] = stats[row];
#pragma unroll
          for (int bj = 0; bj < 2; ++bj)
#pragma unroll
            for (int n = 0; n < 2; ++n) zr[ai][m][bj][n] = *reinterpret_cast<const u32x2*>(Xb + (size_t)row * 4096 + col0 + bj * 128 + 16 * n);
        }
#pragma unroll
      for (int bj = 0; bj < 2; ++bj)
#pragma unroll
        for (int n = 0; n < 2; ++n) {
          const int col = col0 + bj * 128 + 16 * n;
          const float4 g4 = *reinterpret_cast<const float4*>(gate + col);
          const float4 lg = *reinterpret_cast<const float4*>(lng + col), lb = *reinterpret_cast<const float4*>(lnb + col);
#pragma unroll
          for (int ai = 0; ai < 2; ++ai)
#pragma unroll
            for (int m = 0; m < 4; ++m) {
              const int row = row0 + ai * 128 + m * 16;
              const u32x2 zw = zr[ai][m][bj][n];
              const float mu = st[ai][m].x, rs = st[ai][m].y;
              const float x_0 = (bflo(zw[0]) - mu) * rs * lg.x + lb.x, x_1 = (bfhi(zw[0]) - mu) * rs * lg.y + lb.y;
              const float x_2 = (bflo(zw[1]) - mu) * rs * lg.z + lb.z, x_3 = (bfhi(zw[1]) - mu) * rs * lg.w + lb.w;
              const f32x4 a = acc[ai][bj][m][n];
              *reinterpret_cast<u32x2*>(Xb + (size_t)row * 4096 + col) =
                  u32x2{pk2(ALPHA * x_0 + g4.x * a[0], ALPHA * x_1 + g4.y * a[1]), pk2(ALPHA * x_2 + g4.z * a[2], ALPHA * x_3 + g4.w * a[3])};
            }
        }
    } else {
#pragma unroll
      for (int bj = 0; bj < 2; ++bj)
#pragma unroll
        for (int n = 0; n < 2; ++n) {
          const int col = col0 + bj * 128 + 16 * n;
          const float4 g4 = *reinterpret_cast<const float4*>(gate + col);
#pragma unroll
          for (int ai = 0; ai < 2; ++ai)
#pragma unroll
            for (int m = 0; m < 4; ++m) {
              const int row = row0 + ai * 128 + m * 16;
              const float4 xo = prompt ? *reinterpret_cast<const float4*>(x0 + (size_t)row * 2048 + col)
                                       : *reinterpret_cast<const float4*>(x1 + (size_t)(row - TP) * 2048 + col);
              const f32x4 a = acc[ai][bj][m][n];
              *reinterpret_cast<u32x2*>(Xb + (size_t)row * 4096 + col) =
                  u32x2{pk2(ALPHA * xo.x + g4.x * a[0], ALPHA * xo.y + g4.y * a[1]), pk2(ALPHA * xo.z + g4.z * a[2], ALPHA * xo.w + g4.w * a[3])};
            }
        }
    }
  }
};

template <int MODE>
DI void gemm_phase(const Params& p, int l, unsigned char* lds) {
  constexpr int N = (MODE == G_OUT) ? 2048 : (MODE == G_IN_EVEN ? 6144 : 7168);
  pg8::Gemm g;
  g.A = reinterpret_cast<const u16*>(p.ws + WS_H);
  g.Bt = (MODE == G_OUT) ? reinterpret_cast<const u16*>(p.ws + WS_WOUTT) + (size_t)l * 2048 * 2048
                         : reinterpret_cast<const u16*>(p.ws + ws_wint(l));
  g.M = T_ALL; g.N = N; g.K = 2048;
  pg8::StaticOrder S;
  S.init(T_ALL, N, (int)gridDim.x, (int)blockIdx.x);
  PG8_LAS unsigned char* l3 = (PG8_LAS unsigned char*)lds;
  if constexpr (MODE == G_OUT) {
    EpiOut E;
    E.X = p.out; E.x0 = p.in[0]; E.x1 = p.in[1]; E.mod = reinterpret_cast<const float*>(p.ws + WS_MOD); E.l = l;
    E.lng = p.in[16 + 10 * (l > 0 ? l - 1 : 0)]; E.lnb = p.in[17 + 10 * (l > 0 ? l - 1 : 0)];
    E.stats = reinterpret_cast<const float2*>(p.ws + WS_STATS);
    pg8::gemm_phase<EpiOut, pg8::StaticOrder, false>(l3, g, S, E, nullptr);
  } else {
    EpiIn<MODE> E;
    E.PROJ = reinterpret_cast<u16*>(p.ws + WS_PROJ); E.VT = reinterpret_cast<u16*>(p.ws + WS_VT);
    E.kout = p.out + (size_t)T_ALL * 2048 + (size_t)(2 * l) * 8388608;
    E.vout = p.out + (size_t)T_ALL * 2048 + (size_t)(2 * l + 1) * 8388608;
    E.ropeC = reinterpret_cast<const float*>(p.ws + WS_ROPE); E.ropeS = E.ropeC + 1024;
    pg8::gemm_phase<EpiIn<MODE>, pg8::StaticOrder, false>(l3, g, S, E, nullptr);
  }
}

DI void phase_ln(const Params& p, int l) {
  const int tid_ = TIDX, lane = tid_ & 63, wid = tid_ >> 6;
  const float* g = p.in[16 + 10 * l];
  const float* bb = p.in[17 + 10 * l];
  const float* mod = reinterpret_cast<const float*>(p.ws + WS_MOD);
  u16* H = reinterpret_cast<u16*>(p.ws + WS_H);
  float* X = p.out;
  float4 gq[8], bq[8];
#pragma unroll
  for (int i = 0; i < 8; ++i) {
    gq[i] = *reinterpret_cast<const float4*>(g + (i * 64 + lane) * 4);
    bq[i] = *reinterpret_cast<const float4*>(bb + (i * 64 + lane) * 4);
  }
  for (int it = VBID; it < T_ALL / 4; it += VGRID) {
    const int row = it * 4 + wid;
    float* xr = X + (size_t)row * 2048;
    const u16* zr = reinterpret_cast<const u16*>(xr);
    float4 v[8];
    float s = 0.f;
#pragma unroll
    for (int i = 0; i < 8; ++i) {
      const u32x2 w = *reinterpret_cast<const u32x2*>(zr + (i * 64 + lane) * 4);
      v[i] = float4{bflo(w[0]), bfhi(w[0]), bflo(w[1]), bfhi(w[1])};
      s += v[i].x + v[i].y + v[i].z + v[i].w;
    }
    const int cond_ = row < TP ? 0 : 1 + ((row - TP) >> 12);
    const float* shp = mod + (size_t)((l + 1) * 5 + cond_) * 6144;
    float4 s0q[8], c0q[8];
    if (l < 3) {
#pragma unroll
      for (int i = 0; i < 8; ++i) {
        s0q[i] = *reinterpret_cast<const float4*>(shp + (i * 64 + lane) * 4);
        c0q[i] = *reinterpret_cast<const float4*>(shp + 2048 + (i * 64 + lane) * 4);
      }
    }
#pragma unroll
    for (int o = 32; o >= 1; o >>= 1) s += __shfl_xor(s, o);
    const float mu = s * (1.f / 2048.f);
    float ss = 0.f;
#pragma unroll
    for (int i = 0; i < 8; ++i) {
      float a = v[i].x - mu, b = v[i].y - mu, c = v[i].z - mu, d = v[i].w - mu;
      ss += a * a + b * b + c * c + d * d;
    }
#pragma unroll
    for (int o = 32; o >= 1; o >>= 1) ss += __shfl_xor(ss, o);
    const float rstd = rsqrtf(ss * (1.f / 2048.f) + LN_EPS);
    if (lane == 0) *reinterpret_cast<float2*>(p.ws + WS_STATS + (size_t)row * 8) = float2{mu, rstd};
    const int cond = row < TP ? 0 : 1 + ((row - TP) >> 12);
    const float* sh = mod + (size_t)((l + 1) * 5 + cond) * 6144;
#pragma unroll
    for (int i = 0; i < 8; ++i) {
      const int e = (i * 64 + lane) * 4;
      const float4 gg = gq[i], b4 = bq[i];
      float4 y;
      y.x = (v[i].x - mu) * rstd * gg.x + b4.x; y.y = (v[i].y - mu) * rstd * gg.y + b4.y;
      y.z = (v[i].z - mu) * rstd * gg.z + b4.z; y.w = (v[i].w - mu) * rstd * gg.w + b4.w;
      if (l == 3) *reinterpret_cast<float4*>(xr + e) = y;
      if (l < 3) {
        const float4 s0 = s0q[i], c0 = c0q[i];
        u32x2 o = {pk2(y.x * (1.f + c0.x) + s0.x, y.y * (1.f + c0.y) + s0.y), pk2(y.z * (1.f + c0.z) + s0.z, y.w * (1.f + c0.w) + s0.w)};
        *reinterpret_cast<u32x2*>(H + (size_t)row * 2048 + e) = o;
      }
    }
  }
}

struct AttnSrc {
  const u16* k0; const u16* vt0; int ks0, vs0, n0;
  const u16* k1; const u16* vt1; int ks1, vs1, n1;
};

template <int DQK>
DI void attn_ldg(const AttnSrc& s, int j, u32x4 (&rk)[DQK / 64], u32x4 (&rv)[2]) {
  const u16* kb; const u16* vb; int ks, vs;
  if (j < s.n0) { kb = s.k0 + (size_t)j * 64 * s.ks0; vb = s.vt0 + j * 64; ks = s.ks0; vs = s.vs0; }
  else { const int jj = j - s.n0; kb = s.k1 + (size_t)jj * 64 * s.ks1; vb = s.vt1 + jj * 64; ks = s.ks1; vs = s.vs1; }
  constexpr int CPR = DQK / 8;
  const int tid = TID8;
#pragma unroll
  for (int i = 0; i < DQK / 64; ++i) {
    const int c = tid + 512 * i, row = c / CPR, kc = c % CPR;
    rk[i] = *reinterpret_cast<const u32x4*>(kb + (size_t)row * ks + kc * 8);
  }
#pragma unroll
  for (int i = 0; i < 2; ++i) {
    const int c = tid + 512 * i, row = c >> 3, kc = c & 7;
    rv[i] = *reinterpret_cast<const u32x4*>(vb + (size_t)row * vs + kc * 8);
  }
}
template <int DQK>
DI void attn_sts(u16* sK, u16* sVT, const u32x4 (&rk)[DQK / 64], const u32x4 (&rv)[2]) {
  constexpr int CPR = DQK / 8;
  const int tid = TID8;
#pragma unroll
  for (int i = 0; i < DQK / 64; ++i) {
    const int c = tid + 512 * i, row = c / CPR, kc = c % CPR;
    *reinterpret_cast<u32x4*>(sK + row * (DQK + 8) + kc * 8) = rk[i];
  }
#pragma unroll
  for (int i = 0; i < 2; ++i) {
    const int c = tid + 512 * i, row = c >> 3, kc = c & 7;
    *reinterpret_cast<u32x4*>(sVT + row * 72 + kc * 8) = rv[i];
  }
}

DI void attn_pv(const f32x16 (&s)[2], const u16* vw, f32x16 (&O)[4]) {
  __builtin_amdgcn_s_setprio(1);
#pragma unroll
  for (int s4 = 0; s4 < 4; ++s4) {
    const int t = s4 >> 1, b0 = (s4 & 1) * 8;
    u32x4 w = {pk2(s[t][b0], s[t][b0 + 1]), pk2(s[t][b0 + 2], s[t][b0 + 3]), pk2(s[t][b0 + 4], s[t][b0 + 5]), pk2(s[t][b0 + 6], s[t][b0 + 7])};
    const bf16x8 pf = __builtin_bit_cast(bf16x8, w);
#pragma unroll
    for (int d = 0; d < 4; ++d) {
      bf16x8 a = ld8(vw + d * 32 * 72 + s4 * 16);
      O[d] = mfma32(a, pf, O[d]);
    }
  }
  __builtin_amdgcn_s_setprio(0);
}

template <int DQK, bool NA>
DI void attn_run(const AttnSrc& src, const u16* qblk, int qstride, u16* sQ, u16* sK, u16* sVT, f32x16 (&O)[4], float& l_out,
                 int qr, int qc, int rsmin, const float* sBias) {
  const int tid = TID8, lane = tid & 63, wid = tid >> 6;
  const int r = lane & 31, h = lane >> 5;
  const int pr = (r & 0x13) | ((r & 4) << 1) | ((r & 8) >> 1);
  constexpr int CPR = DQK / 8, QS = DQK + 8;
  __syncthreads();
  constexpr bool QREG = (DQK == 64);
  bf16x8 qf[QREG ? DQK / 16 : 1];
  if constexpr (QREG) {
#pragma unroll
    for (int ks = 0; ks < DQK / 16; ++ks) qf[ks] = ld8(qblk + (size_t)(wid * 32 + r) * qstride + ks * 16 + 8 * h);
  } else {
#pragma unroll
    for (int i = 0; i < DQK / 16; ++i) {
      const int c = tid + 512 * i, row = c / CPR, kc = c % CPR;
      *reinterpret_cast<u32x4*>(sQ + row * QS + kc * 8) = *reinterpret_cast<const u32x4*>(qblk + (size_t)row * qstride + kc * 8);
    }
  }
#pragma unroll
  for (int d = 0; d < 4; ++d)
#pragma unroll
    for (int i = 0; i < 16; ++i) O[d][i] = 0.f;
  float m = -1e30f, l = 0.f;
  const int nt = src.n0 + src.n1;
  const int rsq = min(max(qr - 4, 0), 56);
  const int cs = min(max(qc - 8, 0), 48);
  const u16* qw = sQ + (wid * 32 + r) * QS + 8 * h;
  u16* sVT1 = sVT + 128 * 72 + 2048;
  const bool grpB = wid >= 4;
  bool pend = false;
  f32x16 s[2];
  u32x4 rk[DQK / 64], rv[2];
  attn_ldg<DQK>(src, 0, rk, rv);
  constexpr bool SB = QREG;
  u16* sKb1 = sQ + 16384;
  int vi = 0;
  if constexpr (SB) {
    attn_sts<DQK>(sK, sVT, rk, rv);
    if (nt > 1) attn_ldg<DQK>(src, 1, rk, rv);
    __syncthreads();
  }
#pragma unroll 1
  for (int j = 0; j < nt; ++j) {
    const u16* kw;
    u16* vcur;
    const u16* vprev;
    if constexpr (SB) {
      u16* vnext = (vi == 0) ? sVT1 : ((vi == 1) ? sQ : sVT);
      vcur = (vi == 0) ? sVT : ((vi == 1) ? sVT1 : sQ);
      vprev = (vi == 0) ? sQ : ((vi == 1) ? sVT : sVT1);
      if (j + 1 < nt) attn_sts<DQK>((j & 1) ? sK : sKb1, vnext, rk, rv);
      if (j + 2 < nt) attn_ldg<DQK>(src, j + 2, rk, rv);
      kw = ((j & 1) ? sKb1 : sK) + pr * QS + 8 * h;
      vi = (vi == 2) ? 0 : vi + 1;
    } else {
      if (j > 0) __syncthreads();
      vcur = (j & 1) ? sVT1 : sVT;
      vprev = (j & 1) ? sVT : sVT1;
      attn_sts<DQK>(sK, vcur, rk, rv);
      __syncthreads();
      if (j + 1 < nt) attn_ldg<DQK>(src, j + 1, rk, rv);
      kw = sK + pr * QS + 8 * h;
    }
    __builtin_amdgcn_sched_barrier(0);
    if (grpB && pend) { attn_pv(s, vprev + r * 72 + 8 * h, O); pend = false; }
    bool active = true;
    int kr = 0;
    if (NA && j >= src.n0) { kr = rsmin + (j - src.n0); active = (kr >= rsq) && (kr < rsq + 8); }
    if (active) {
      __builtin_amdgcn_s_setprio(1);
#pragma unroll
      for (int t = 0; t < 2; ++t) {
#pragma unroll
        for (int i = 0; i < 16; ++i) s[t][i] = 0.f;
#pragma unroll
        for (int ks = 0; ks < DQK / 16; ++ks) {
          bf16x8 a = ld8(kw + t * 32 * QS + ks * 16);
          bf16x8 q;
          if constexpr (QREG) q = qf[ks]; else q = ld8(qw + ks * 16);
          s[t] = mfma32(a, q, s[t]);
        }
      }
      __builtin_amdgcn_s_setprio(0);
      if (NA && j >= src.n0) {
        const float* bp = sBias + (kr - qr + 7) * 31 + (8 * h - qc + 15);
        const int kb = 8 * h - cs;
#pragma unroll
        for (int t = 0; t < 2; ++t)
#pragma unroll
          for (int i = 0; i < 16; ++i) {
            const int ko = t * 32 + 16 * (i >> 3) + (i & 7);
            const bool ok = (unsigned)(ko + kb) < 16u;
            const float bv = bp[ko];
            s[t][i] = ok ? s[t][i] + bv : -1e30f;
          }
      }
      float mx = -1e30f;
#pragma unroll
      for (int t = 0; t < 2; ++t)
#pragma unroll
        for (int i = 0; i < 16; ++i) mx = fmaxf(mx, s[t][i]);
      if (__builtin_amdgcn_ballot_w64(mx > m + 8.0f) != 0ull) {
        mx = fmaxf(mx, __shfl_xor(mx, 32));
        const float mn = fmaxf(m, mx);
        const float alpha = ex2(m - mn);
        l *= alpha;
        m = mn;
#pragma unroll
        for (int d = 0; d < 4; ++d)
#pragma unroll
          for (int i = 0; i < 16; ++i) O[d][i] *= alpha;
      }
      float rsum = 0.f;
#pragma unroll
      for (int t = 0; t < 2; ++t)
#pragma unroll
        for (int i = 0; i < 16; ++i) { const float e = ex2(s[t][i] - m); s[t][i] = e; rsum += e; }
      l += rsum;
      if (!grpB) attn_pv(s, vcur + r * 72 + 8 * h, O);
      else pend = true;
    }
    if constexpr (SB) __syncthreads();
  }
  if (grpB && pend) {
    const u16* vlast;
    if constexpr (SB) vlast = (vi == 1) ? sVT : ((vi == 2) ? sVT1 : sQ);
    else vlast = ((nt - 1) & 1) ? sVT1 : sVT;
    attn_pv(s, vlast + r * 72 + 8 * h, O);
  }
  l_out = l + __shfl_xor(l, 32);
}

DI void heavy_map(int it, int& bh, int& qb) { const int x = it & 7, rest = it >> 3; qb = rest & 15; bh = x + 8 * (rest >> 4); }

DI void diff_item(const Params& p, int l, bool sample, int bh, int qb, unsigned char* lds) {
  constexpr int NC = 6144;
  const int tid_ = TID8, lane = tid_ & 63, wid = tid_ >> 6, r = lane & 31, h = lane >> 5;
  const int b = bh >> 3, hd = bh & 7;
  u16* sQ = reinterpret_cast<u16*>(lds);
  u16* sK = sQ + 256 * 136;
  u16* sVT = sK + 64 * 136;
  const u16* PROJ = reinterpret_cast<const u16*>(p.ws + WS_PROJ);
  const u16* VT = reinterpret_cast<const u16*>(p.ws + WS_VT);
  const int seq0 = sample ? TP + b * 4096 : b * 256;
  const int token = seq0 + qb * 256 + wid * 32 + r;
  const float* dl = p.in[20 + 10 * l];
  float pa = dl[lane] * dl[64 + lane], pb = dl[128 + lane] * dl[192 + lane];
#pragma unroll
  for (int o = 32; o >= 1; o >>= 1) { pa += __shfl_xor(pa, o); pb += __shfl_xor(pb, o); }
  const float lam_init = 0.8f - 0.6f * __expf(-0.3f * (float)l);
  const float lam = __expf(pa) - __expf(pb) + lam_init;

  u32 o1p[32];
  f32x16 O[4];
  float lsum;
#pragma unroll
  for (int comp = 0; comp < 2; ++comp) {
    AttnSrc s;
    if (sample) {
      s.k0 = reinterpret_cast<const u16*>(p.ws + WS_CK) + (size_t)l * 2097152 + (size_t)bh * 65536 + comp * 64; s.ks0 = 128;
      s.vt0 = reinterpret_cast<const u16*>(p.ws + WS_CVT) + (size_t)l * 2097152 + (size_t)bh * 65536; s.vs0 = 512; s.n0 = 8;
      s.k1 = PROJ + (size_t)seq0 * NC + 3072 + hd * 128 + comp * 64; s.ks1 = NC;
      s.vt1 = VT + 8388608 + (size_t)bh * 128 * 4096; s.vs1 = 4096; s.n1 = 64;
    } else {
      s.k0 = nullptr; s.vt0 = nullptr; s.ks0 = 0; s.vs0 = 0; s.n0 = 0;
      s.k1 = PROJ + (size_t)seq0 * NC + 3072 + hd * 128 + comp * 64; s.ks1 = NC;
      s.vt1 = VT + (size_t)bh * 128 * 256; s.vs1 = 256; s.n1 = 4;
    }
    const u16* qblk = PROJ + (size_t)(seq0 + qb * 256) * NC + 2048 + hd * 128 + comp * 64;
    attn_run<64, false>(s, qblk, NC, sQ, sK, sVT, O, lsum, 0, 0, 0, nullptr);
    const float inv = 1.f / lsum;
    if (comp == 0) {
#pragma unroll
      for (int d = 0; d < 4; ++d)
#pragma unroll
        for (int i = 0; i < 8; ++i) o1p[d * 8 + i] = pk2(O[d][2 * i] * inv, O[d][2 * i + 1] * inv);
    } else {
      float ssq = 0.f;
#pragma unroll
      for (int d = 0; d < 4; ++d)
#pragma unroll
        for (int i = 0; i < 8; ++i) {
          const u32 w = o1p[d * 8 + i];
          const float a = bflo(w) - lam * O[d][2 * i] * inv, c = bfhi(w) - lam * O[d][2 * i + 1] * inv;
          O[d][2 * i] = a; O[d][2 * i + 1] = c;
          ssq += a * a + c * c;
        }
      ssq += __shfl_xor(ssq, 32);
      const float rn = rsqrtf(ssq * (1.f / 128.f) + LN_EPS) * (1.f - lam_init);
      const float* subln = p.in[21 + 10 * l];
      const u16* gp = PROJ + (size_t)token * NC + 5120 + hd * 128;
      u16* yp = reinterpret_cast<u16*>(p.ws + WS_H) + (size_t)token * 2048 + 1024 + hd * 128;
#pragma unroll
      for (int d = 0; d < 4; ++d)
#pragma unroll
        for (int q = 0; q < 4; ++q) {
          const int dv = d * 32 + 8 * q + 4 * h;
          const u32x2 gw = *reinterpret_cast<const u32x2*>(gp + dv);
          const float4 sl = *reinterpret_cast<const float4*>(subln + dv);
          const float y0 = O[d][4 * q] * rn * sl.x * silu(bflo(gw[0]));
          const float y1 = O[d][4 * q + 1] * rn * sl.y * silu(bfhi(gw[0]));
          const float y2 = O[d][4 * q + 2] * rn * sl.z * silu(bflo(gw[1]));
          const float y3 = O[d][4 * q + 3] * rn * sl.w * silu(bfhi(gw[1]));
          *reinterpret_cast<u32x2*>(yp + dv) = (ZERO_MASK & 2) ? u32x2{0u, 0u} : u32x2{pk2(y0, y1), pk2(y2, y3)};
        }
    }
  }
}

template <int H>
DI void pool_window(const u16* sIn, u16* sP, int oc, int seg, int t0, int L) {
  const int tl0 = seg * 8;
  const u16* base = sIn + (tl0 + 8 - H) * 264 + oc * 8;
  float a[8];
#pragma unroll
  for (int k = 0; k < 8; ++k) a[k] = 0.f;
#pragma unroll
  for (int o = 0; o < 2 * H; ++o) {
    const u32x4 v = *reinterpret_cast<const u32x4*>(base + o * 264);
#pragma unroll
    for (int k = 0; k < 4; ++k) { a[2 * k] += bflo(v[k]); a[2 * k + 1] += bfhi(v[k]); }
  }
#pragma unroll
  for (int tt = 0; tt < 8; ++tt) {
    const int t = t0 + tl0 + tt;
    const int lo = max(t - H, 0), hi = min(t + H, L);
    const float ic = 1.f / (float)(hi - lo);
    const u32x4 x = *reinterpret_cast<const u32x4*>(sIn + (tl0 + tt + 8) * 264 + oc * 8);
    u32x4 o;
#pragma unroll
    for (int k = 0; k < 4; ++k) o[k] = pk2(a[2 * k] * ic - bflo(x[k]), a[2 * k + 1] * ic - bfhi(x[k]));
    *reinterpret_cast<u32x4*>(sP + (tl0 + tt) * 264 + oc * 8) = o;
    if (tt < 7) {
      const u32x4 vin = *reinterpret_cast<const u32x4*>(base + (2 * H + tt) * 264);
      const u32x4 vout = *reinterpret_cast<const u32x4*>(base + tt * 264);
#pragma unroll
      for (int k = 0; k < 4; ++k) { a[2 * k] += bflo(vin[k]) - bflo(vout[k]); a[2 * k + 1] += bfhi(vin[k]) - bfhi(vout[k]); }
    }
  }
}

DI void pool_item(const Params& p, int l, int pi, unsigned char* lds) {
  constexpr int NC = 6144;
  const int tid = TIDX, lane = tid & 63, wid = tid >> 6, fr = lane & 15, fq = lane >> 4;
  const int tb = pi >> 2, g = pi & 3, row0 = tb * 64;
  const int L = row0 < TP ? 256 : 4096;
  const int t0 = row0 < TP ? (row0 & 255) : ((row0 - TP) & 4095);
  u16* sIn = reinterpret_cast<u16*>(lds);
  u16* sP = sIn + 80 * 264;
  const u16* PROJ = reinterpret_cast<const u16*>(p.ws + WS_PROJ);
  __syncthreads();
#pragma unroll
  for (int i = 0; i < 10; ++i) {
    const int c = tid + 256 * i, rr = c >> 5, oc = c & 31;
    const int t = t0 - 8 + rr;
    u32x4 v = {0u, 0u, 0u, 0u};
    if (t >= 0 && t < L) v = *reinterpret_cast<const u32x4*>(PROJ + (size_t)(row0 - 8 + rr) * NC + g * 256 + oc * 8);
    *reinterpret_cast<u32x4*>(sIn + rr * 264 + oc * 8) = v;
  }
  __syncthreads();
  {
    const int oc = tid & 31, seg = tid >> 5;
    switch (g) {
      case 0: pool_window<1>(sIn, sP, oc, seg, t0, L); break;
      case 1: pool_window<2>(sIn, sP, oc, seg, t0, L); break;
      case 2: pool_window<4>(sIn, sP, oc, seg, t0, L); break;
      default: pool_window<8>(sIn, sP, oc, seg, t0, L); break;
    }
  }
  __syncthreads();
  const u16* W = reinterpret_cast<const u16*>(p.ws + WS_POOLWT) + (size_t)(l >> 1) * 262144 + (size_t)g * 65536;
  u32x2 gpre[4][4];
#pragma unroll
  for (int n = 0; n < 4; ++n)
#pragma unroll
    for (int m = 0; m < 4; ++m)
      gpre[n][m] = *reinterpret_cast<const u32x2*>(PROJ + (size_t)(row0 + m * 16 + fr) * NC + 1024 + g * 256 + wid * 64 + n * 16 + 4 * fq);
  f32x4 acc[4][4];
#pragma unroll
  for (int a = 0; a < 4; ++a)
#pragma unroll
    for (int b = 0; b < 4; ++b) acc[a][b] = f32x4{0.f, 0.f, 0.f, 0.f};
#pragma unroll 4
  for (int ks = 0; ks < 8; ++ks) {
    bf16x8 af[4], bfr[4];
#pragma unroll
    for (int m = 0; m < 4; ++m) af[m] = ld8(sP + (m * 16 + fr) * 264 + ks * 32 + fq * 8);
#pragma unroll
    for (int n = 0; n < 4; ++n) bfr[n] = ld8(W + (size_t)(wid * 64 + n * 16 + fr) * 256 + ks * 32 + fq * 8);
#pragma unroll
    for (int m = 0; m < 4; ++m)
#pragma unroll
      for (int n = 0; n < 4; ++n) acc[m][n] = mfma16(bfr[n], af[m], acc[m][n]);
  }
  const float* pscale = p.in[19 + 10 * l];
  u16* Y = reinterpret_cast<u16*>(p.ws + WS_H);
#pragma unroll
  for (int n = 0; n < 4; ++n) {
    const int col = g * 256 + wid * 64 + n * 16 + 4 * fq;
    const float4 sc = *reinterpret_cast<const float4*>(pscale + col);
#pragma unroll
    for (int m = 0; m < 4; ++m) {
      const int row = row0 + m * 16 + fr;
      const u32x2 gw = gpre[n][m];
      float y0 = acc[m][n][0] * sc.x * silu(bflo(gw[0])), y1 = acc[m][n][1] * sc.y * silu(bfhi(gw[0]));
      float y2 = acc[m][n][2] * sc.z * silu(bflo(gw[1])), y3 = acc[m][n][3] * sc.w * silu(bfhi(gw[1]));
      if (ZERO_MASK & 1) { y0 = y1 = y2 = y3 = 0.f; }
      *reinterpret_cast<u32x2*>(Y + (size_t)row * 2048 + col) = u32x2{pk2(y0, y1), pk2(y2, y3)};
    }
  }
}

DI void phase_mix_even(const Params& p, int l, unsigned char* lds, unsigned char* lds_all) {
#pragma unroll 1
  for (int it = blockIdx.x; it < 512; it += gridDim.x) { int bh, qb; heavy_map(it, bh, qb); diff_item(p, l, true, bh, qb, lds_all); }
#pragma unroll 1
  for (int it = blockIdx.x; it < 256; it += gridDim.x) diff_item(p, l, false, it, 0, lds_all);
#pragma unroll 1
  for (int it = VBID; it < 1536; it += VGRID) pool_item(p, l, it, lds);
}

DI void na_item(const Params& p, int l, bool sample, int bh, int qb, unsigned char* lds) {
  constexpr int NC = 7168;
  const int tid = TID8, lane = tid & 63, wid = tid >> 6, r = lane & 31, h = lane >> 5;
  const int b = bh >> 3, hd = bh & 7;
  u16* sQ = reinterpret_cast<u16*>(lds);
  u16* sK = sQ + 256 * 136;
  u16* sVT = sK + 64 * 136;
  float* sBias = reinterpret_cast<float*>(sVT + 128 * 72) + 64;
  const u16* PROJ = reinterpret_cast<const u16*>(p.ws + WS_PROJ);
  const u16* VT = reinterpret_cast<const u16*>(p.ws + WS_VT);
  const int seq0 = sample ? TP + b * 4096 : b * 256;
  const int token = seq0 + qb * 256 + wid * 32 + r;
  AttnSrc s;
  int qr = 0, qc = 0, rsmin = 0;
  f32x16 O[4];
  float lsum;
  const u16* qblk = PROJ + (size_t)(seq0 + qb * 256) * NC + hd * 128;
  if (sample) {
    __syncthreads();
    const float* rpb = p.in[18 + 10 * l] + hd * 465;
    for (int e = tid; e < 465; e += 512) sBias[e] = rpb[e] * LOG2E;
    const int r0 = qb * 4;
    qr = r0 + (wid >> 1); qc = (wid & 1) * 32 + r;
    rsmin = min(max(r0 - 4, 0), 56);
    const int rs1 = min(max(r0 - 1, 0), 56);
    s.k0 = reinterpret_cast<const u16*>(p.ws + WS_CK) + (size_t)l * 2097152 + (size_t)bh * 65536; s.ks0 = 128;
    s.vt0 = reinterpret_cast<const u16*>(p.ws + WS_CVT) + (size_t)l * 2097152 + (size_t)bh * 65536; s.vs0 = 512; s.n0 = 8;
    s.k1 = PROJ + (size_t)(seq0 + rsmin * 64) * NC + 1024 + hd * 128; s.ks1 = NC;
    s.vt1 = VT + 8388608 + (size_t)bh * 128 * 4096 + rsmin * 64; s.vs1 = 4096; s.n1 = rs1 + 8 - rsmin;
    attn_run<128, true>(s, qblk, NC, sQ, sK, sVT, O, lsum, qr, qc, rsmin, sBias);
  } else {
    s.k0 = nullptr; s.vt0 = nullptr; s.ks0 = 0; s.vs0 = 0; s.n0 = 0;
    s.k1 = PROJ + (size_t)seq0 * NC + 1024 + hd * 128; s.ks1 = NC;
    s.vt1 = VT + (size_t)bh * 128 * 256; s.vs1 = 256; s.n1 = 4;
    attn_run<128, false>(s, qblk, NC, sQ, sK, sVT, O, lsum, 0, 0, 0, nullptr);
  }
  const float inv = 1.f / lsum;
  const u16* gp = PROJ + (size_t)token * NC + 3072 + hd * 128;
  u16* yp = reinterpret_cast<u16*>(p.ws + WS_H) + (size_t)token * 2048 + hd * 128;
#pragma unroll
  for (int d = 0; d < 4; ++d)
#pragma unroll
    for (int q = 0; q < 4; ++q) {
      const int dv = d * 32 + 8 * q + 4 * h;
      const u32x2 gw = *reinterpret_cast<const u32x2*>(gp + dv);
      const float y0 = O[d][4 * q] * inv * silu(bflo(gw[0]));
      const float y1 = O[d][4 * q + 1] * inv * silu(bfhi(gw[0]));
      const float y2 = O[d][4 * q + 2] * inv * silu(bflo(gw[1]));
      const float y3 = O[d][4 * q + 3] * inv * silu(bfhi(gw[1]));
      *reinterpret_cast<u32x2*>(yp + dv) = (ZERO_MASK & 4) ? u32x2{0u, 0u} : u32x2{pk2(y0, y1), pk2(y2, y3)};
    }
}

DI void sgu_item(const Params& p, int l, int si, unsigned char* lds) {
  constexpr int NC = 7168;
  const int tid = TIDX, lane = tid & 63, wid = tid >> 6, fr = lane & 15, fq = lane >> 4;
  const int ch = si >> 2, g = si & 3, row0 = ch * 128;
  u16* vnT = reinterpret_cast<u16*>(lds);
  float* sMu = reinterpret_cast<float*>(vnT + 256 * 136);
  float* sRs = sMu + 128;
  const u16* PROJ = reinterpret_cast<const u16*>(p.ws + WS_PROJ);
  __syncthreads();
  {
    const int grp = tid >> 4, ln = tid & 15;
#pragma unroll 2
    for (int rr = 0; rr < 8; ++rr) {
      const u16* src = PROJ + (size_t)(row0 + grp * 8 + rr) * NC + 5120;
      float s = 0.f, ss = 0.f;
#pragma unroll
      for (int c8 = 0; c8 < 8; ++c8) {
        const u32x4 v = *reinterpret_cast<const u32x4*>(src + (ln + 16 * c8) * 8);
#pragma unroll
        for (int k = 0; k < 4; ++k) { const float a = bflo(v[k]), b = bfhi(v[k]); s += a + b; ss += a * a + b * b; }
      }
#pragma unroll
      for (int o = 8; o >= 1; o >>= 1) { s += __shfl_xor(s, o); ss += __shfl_xor(ss, o); }
      const float mu = s * (1.f / 1024.f);
      const float var = fmaxf(ss * (1.f / 1024.f) - mu * mu, 0.f);
      if (ln == 0) { sMu[grp * 8 + rr] = mu; sRs[grp * 8 + rr] = rsqrtf(var + LN_EPS); }
    }
  }
  __syncthreads();
  {
    const int j = tid & 127, hf = tid >> 7;
    const float mu = sMu[j], rs = sRs[j];
    const float* lng = p.in[19 + 10 * l] + g * 256;
    const u16* src = PROJ + (size_t)(row0 + j) * NC + 5120 + g * 256;
#pragma unroll 8
    for (int oc = hf * 16; oc < hf * 16 + 16; ++oc) {
      const u32x4 v = *reinterpret_cast<const u32x4*>(src + oc * 8);
      const float4 g0 = *reinterpret_cast<const float4*>(lng + oc * 8), g1 = *reinterpret_cast<const float4*>(lng + oc * 8 + 4);
      const float gg[8] = {g0.x, g0.y, g0.z, g0.w, g1.x, g1.y, g1.z, g1.w};
#pragma unroll
      for (int k = 0; k < 4; ++k) {
        const float a = (bflo(v[k]) - mu) * rs * gg[2 * k], b = (bfhi(v[k]) - mu) * rs * gg[2 * k + 1];
        const u32 w = pk2(a, b);
        vnT[(oc * 8 + 2 * k) * 136 + j] = (u16)(w & 0xffffu);
        vnT[(oc * 8 + 2 * k + 1) * 136 + j] = (u16)(w >> 16);
      }
    }
  }
  __syncthreads();
  const u16* W = reinterpret_cast<const u16*>(p.ws + WS_SGUW) + (size_t)(l >> 1) * 65536 + (size_t)g * 16384;
  const float* bs = p.in[21 + 10 * l] + g * 128;
  u16* Y = reinterpret_cast<u16*>(p.ws + WS_H);
#pragma unroll 1
  for (int ih = 0; ih < 2; ++ih) {
    f32x4 acc[4][4];
#pragma unroll
    for (int a = 0; a < 4; ++a)
#pragma unroll
      for (int b = 0; b < 4; ++b) acc[a][b] = f32x4{0.f, 0.f, 0.f, 0.f};
#pragma unroll
    for (int ks = 0; ks < 4; ++ks) {
      bf16x8 af[4], bfr[4];
#pragma unroll
      for (int m = 0; m < 4; ++m) af[m] = ld8(W + (size_t)(ih * 64 + m * 16 + fr) * 128 + ks * 32 + fq * 8);
#pragma unroll
      for (int n = 0; n < 4; ++n) bfr[n] = ld8(vnT + (wid * 64 + n * 16 + fr) * 136 + ks * 32 + fq * 8);
#pragma unroll
      for (int m = 0; m < 4; ++m)
#pragma unroll
        for (int n = 0; n < 4; ++n) acc[m][n] = mfma16(bfr[n], af[m], acc[m][n]);
    }
#pragma unroll
    for (int m = 0; m < 4; ++m) {
      const int ii = ih * 64 + m * 16 + fr;
      const float bias = bs[ii];
      const size_t rb = (size_t)(row0 + ii) * NC;
#pragma unroll
      for (int n = 0; n < 4; ++n) {
        const int c = g * 256 + wid * 64 + n * 16 + 4 * fq;
        const u32x2 uw = *reinterpret_cast<const u32x2*>(PROJ + rb + 4096 + c);
        const u32x2 dw = *reinterpret_cast<const u32x2*>(PROJ + rb + 6144 + c);
        float y0 = bflo(uw[0]) * (acc[m][n][0] + bias) * silu(bflo(dw[0])), y1 = bfhi(uw[0]) * (acc[m][n][1] + bias) * silu(bfhi(dw[0]));
        float y2 = bflo(uw[1]) * (acc[m][n][2] + bias) * silu(bflo(dw[1])), y3 = bfhi(uw[1]) * (acc[m][n][3] + bias) * silu(bfhi(dw[1]));
        if (ZERO_MASK & 8) { y0 = y1 = y2 = y3 = 0.f; }
        *reinterpret_cast<u32x2*>(Y + (size_t)(row0 + ii) * 2048 + 1024 + c) = u32x2{pk2(y0, y1), pk2(y2, y3)};
      }
    }
  }
}

DI void phase_mix_odd(const Params& p, int l, unsigned char* lds, unsigned char* lds_all) {
#pragma unroll 1
  for (int it = blockIdx.x; it < 512; it += gridDim.x) { int bh, qb; heavy_map(it, bh, qb); na_item(p, l, true, bh, qb, lds_all); }
#pragma unroll 1
  for (int it = blockIdx.x; it < 256; it += gridDim.x) na_item(p, l, false, it, 0, lds_all);
#pragma unroll 1
  for (int it = VBID; it < 768; it += VGRID) sgu_item(p, l, it, lds);
}

#define XB_TMO      128
#define XB_XCNT(j)  (256  + 64 * (j))
#define XB_XSUB(j)  (1280 + 64 * (j))
#define XB_XGEN(j)  (2304 + 64 * (j))
#define XB_TOP      3328
#define XB_TOPGEN   3392
#define XCD_BAR_WORDS 3456
#define XB_SPIN_CAP (1u << 18)
#define LAS __attribute__((address_space(3)))
DI unsigned xb_ld(unsigned* p)              { return __hip_atomic_load(p, __ATOMIC_RELAXED, __HIP_MEMORY_SCOPE_AGENT); }
DI unsigned xb_add(unsigned* p, unsigned v) { return __hip_atomic_fetch_add(p, v, __ATOMIC_RELAXED, __HIP_MEMORY_SCOPE_AGENT); }
DI unsigned xb_xcc_id() { return (unsigned)__builtin_amdgcn_s_getreg((3 << 11) | 20) & 0xFu; }
#define XB_SPIN(cond, bar) do { unsigned _sp = 0; while (cond) { __builtin_amdgcn_s_sleep(1); \
    if ((++_sp & 255u) == 0u) { if (xb_ld(&(bar)[XB_TMO])) break; if (_sp > XB_SPIN_CAP) { atomicAdd(&(bar)[XB_TMO], 1u); break; } } } } while (0)
struct XcdBarrier { unsigned* bar; unsigned x; volatile LAS unsigned* st; };
DI XcdBarrier xcd_barrier_post(unsigned* bar, volatile LAS unsigned* st) {
  XcdBarrier b; b.bar = bar; b.x = xb_xcc_id(); b.st = st;
  if (threadIdx.x == 0) (void)xb_add(&bar[XB_XCNT(b.x)], 1u);
  return b;
}
DI void xcd_barrier_complete(unsigned* bar, unsigned x, unsigned& nloc, unsigned& nx) {
  const unsigned G = gridDim.x * gridDim.y * gridDim.z;
  unsigned sum, cnt, mine, sp = 0u;
  for (;;) {
    sum = 0u; cnt = 0u; mine = 0u;
#pragma unroll
    for (unsigned j = 0; j < 16; ++j) { const unsigned c = xb_ld(&bar[XB_XCNT(j)]); sum += c; cnt += (c > 0u) ? 1u : 0u; mine = (j == x) ? c : mine; }
    if (sum == G) break;
    __builtin_amdgcn_s_sleep(1);
    if ((++sp & 255u) == 0u) { if (xb_ld(&bar[XB_TMO])) break; if (sp > XB_SPIN_CAP) { atomicAdd(&bar[XB_TMO], 1u); break; } }
  }
  nloc = mine > 0u ? mine : 1u; nx = cnt > 0u ? cnt : 1u;
}
DI void xcd_barrier(const XcdBarrier& b) {
  asm volatile("s_waitcnt vmcnt(0)" ::: "memory");
  __syncthreads();
  if (threadIdx.x == 0) {
    unsigned* bar = b.bar;
    __builtin_amdgcn_s_waitcnt(0);
    unsigned nloc = b.st[0], nx = b.st[1];
    if (nloc == 0u) { xcd_barrier_complete(bar, b.x, nloc, nx); b.st[0] = nloc; b.st[1] = nx; }
    const unsigned old = xb_add(&bar[XB_XSUB(b.x)], 1u);
    const unsigned gen = old / nloc;
    if (old + 1u == (gen + 1u) * nloc) {
      __builtin_amdgcn_fence(__ATOMIC_RELEASE, "agent");
      asm volatile("s_waitcnt vmcnt(0)" ::: "memory");
      const unsigned og = xb_add(&bar[XB_TOP], 1u);
      const unsigned tg = og / nx;
      if (og + 1u == (tg + 1u) * nx) xb_add(&bar[XB_TOPGEN], 1u);
      else XB_SPIN(xb_ld(&bar[XB_TOPGEN]) == tg, bar);
      __builtin_amdgcn_fence(__ATOMIC_ACQUIRE, "agent");
      xb_add(&bar[XB_XGEN(b.x)], 1u);
      asm volatile("s_waitcnt vmcnt(0)" ::: "memory");
    } else {
      XB_SPIN(xb_ld(&bar[XB_XGEN(b.x)]) == gen, bar);
      __builtin_amdgcn_fence(__ATOMIC_ACQUIRE, "agent");
      asm volatile("s_waitcnt vmcnt(0)" ::: "memory");
    }
  }
  __syncthreads();
}

__global__ void __launch_bounds__(512, 2) fwd_megakernel(Params p) {
  extern __shared__ __attribute__((aligned(16))) unsigned char lds[];
  cg::grid_group grid = cg::this_grid();
  volatile LAS unsigned* xst = (volatile LAS unsigned*)(lds + LDS_BYTES - 16);
  if (threadIdx.x == 0) { xst[0] = 0u; xst[1] = 0u; }
  __syncthreads();
  const XcdBarrier xb = xcd_barrier_post(reinterpret_cast<unsigned*>(p.ws + WS_BAR), xst);
  for (int ph = p.ph_lo; ph < p.ph_hi; ++ph) {
    unsigned char* hl = lds + HALF_ID * HALF_LDS;
    if (ph == 0) phase_prep(p, hl);
    else if (ph == 1) phase_mod0(p);
    else {
      const int l = (ph - 2) >> 2, s = (ph - 2) & 3;
      if (s == 0) { if (l & 1) gemm_phase<G_IN_ODD>(p, l, lds); else gemm_phase<G_IN_EVEN>(p, l, lds); }
      else if (s == 1) { if (l & 1) phase_mix_odd(p, l, hl, lds); else phase_mix_even(p, l, hl, lds); }
      else if (s == 2) gemm_phase<G_OUT>(p, l, lds);
      else phase_ln(p, l);
    }
    if (ph + 1 < p.ph_hi) {
      if (p.ph_lo < 0) grid.sync();
      xcd_barrier(xb);
    }
  }
}

extern "C" void kernel_launch(void* const* d_in, const int* in_sizes, int n_in, void* d_out, int out_size, void* d_ws, size_t ws_size,
                              hipStream_t stream) {
  static int grid_blocks = 0;
  if (grid_blocks == 0) {
    if (n_in != 52 || ws_size < WS_END) {
      fprintf(stderr, "kernel_launch: expected 52 inputs and >= %zu bytes of workspace; got %d, %zu\n", (size_t)WS_END, n_in, ws_size);
      grid_blocks = -1;
      return;
    }
    int dev = 0, cus = 0, per_cu = 0;
    hipGetDevice(&dev);
    hipDeviceGetAttribute(&cus, hipDeviceAttributeMultiprocessorCount, dev);
    hipFuncSetAttribute((const void*)fwd_megakernel, hipFuncAttributeMaxDynamicSharedMemorySize, LDS_BYTES);
    hipOccupancyMaxActiveBlocksPerMultiprocessor(&per_cu, (const void*)fwd_megakernel, 512, LDS_BYTES);
    (void)hipGetLastError();
    grid_blocks = cus;
  }
  if (grid_blocks < 0) return;
  Params p{};
  for (int i = 0; i < 52; ++i) p.in[i] = (const float*)d_in[i];
  p.out = (float*)d_out;
  p.ws = (unsigned char*)d_ws;
#if MULTI
  for (int ph = 0; ph < NPHASE; ++ph) {
    p.ph_lo = ph; p.ph_hi = ph + 1;
    hipLaunchKernelGGL(fwd_megakernel, dim3(grid_blocks), dim3(512), LDS_BYTES, stream, p);
  }
#else
  p.ph_lo = 0; p.ph_hi = NPHASE;
  if (hipMemsetAsync((char*)d_ws + WS_BAR, 0, XCD_BAR_WORDS * 4, stream) != hipSuccess) { fprintf(stderr, "kernel_launch: memset of barrier words failed\n"); return; }
  void* args[] = {&p};
  hipError_t e = hipLaunchCooperativeKernel((const void*)fwd_megakernel, dim3(grid_blocks), dim3(512), args, LDS_BYTES, stream);
  if (e != hipSuccess) fprintf(stderr, "cooperative launch failed: %s (grid %d)\n", hipGetErrorString(e), grid_blocks);
#endif
}
```
